# Optimizing an MI355X kernel written in HIP

```python
import math
import jax
import jax.numpy as jnp
from jax import lax
import numpy as np

D_MODEL = 1024
BATCH = 8
SEQ = 2048
DEPTH = 2

RW_HEADS = 6
RW_HEAD_DIM = 64
RW_WIDTH = RW_HEADS * RW_HEAD_DIM
SB_HEADS = 6
SB_HEAD_DIM = 64
SB_WIDTH = SB_HEADS * SB_HEAD_DIM
POOL_WINDOWS = (2, 4, 8, 16)
POOL_GROUPS = 4
POOL_GROUP_DIM = 64
POOL_WIDTH = POOL_GROUPS * POOL_GROUP_DIM
MIX_WIDTH = RW_WIDTH + SB_WIDTH + POOL_WIDTH

RW_DECAY_RANK = 32
RW_ICLR_RANK = 32
RW_VRES_RANK = 32
RW_GATE_RANK = 64
RW_GN_EPS = 64e-5

RW_COLS = 3 * RW_WIDTH + RW_DECAY_RANK + RW_ICLR_RANK + RW_GATE_RANK
SB_COLS = 3 * SB_WIDTH
IN_COLS = RW_COLS + SB_COLS + POOL_WIDTH

SB_BLOCK = 128

N_EXPERTS = 64
TOP_K = 6
N_GROUPS = 8
TOPK_GROUPS = 4
EXPERT_DIM = 256
ROUTED_SCALE = 2.5
MOE_BLOCK = 128

RMS_EPS = 1e-6

kernel_name = "hybrid_rwkv7_stickbreak_pool_moe_adaln"


def rms_norm(x, eps=RMS_EPS):
    xf = x.astype(jnp.float32)
    return (xf * lax.rsqrt(jnp.mean(xf * xf, axis=-1, keepdims=True) + eps)).astype(x.dtype)


def token_shift(u, mu):
    prev = jnp.pad(u, ((0, 0), (1, 0), (0, 0)))[:, :-1]
    return u + (prev - u) * mu


def split_heads(t, n_heads, head_dim):
    return t.reshape(t.shape[0], t.shape[1], n_heads, head_dim)


def rwkv7_scan(r, w, k, v, a, b):
    B, S, H, N = r.shape
    xs = (jnp.moveaxis(r, 1, 0), jnp.moveaxis(w, 1, 0), jnp.moveaxis(k, 1, 0),
          jnp.moveaxis(v, 1, 0), jnp.moveaxis(a, 1, 0), jnp.moveaxis(b, 1, 0))

    def step(state, inp):
        r_t, w_t, k_t, v_t, a_t, b_t = inp
        sa = jnp.einsum('bhvk,bhk->bhv', state, a_t)
        state = (state * w_t[:, :, None, :] + sa[..., None] * b_t[:, :, None, :]
                 + v_t[..., None] * k_t[:, :, None, :])
        return state, jnp.einsum('bhvk,bhk->bhv', state, r_t)

    state0 = jnp.zeros((B, H, N, N), jnp.float32)
    _, ys = lax.scan(step, state0, xs)
    return jnp.moveaxis(ys, 0, 1)


def rwkv7_time_mix(p_rw, v_first, v_gate, w0, w2, a0, a2, g2, k_k, k_a, r_k, ln_g, ln_b):
    B, S, _ = p_rw.shape
    C = RW_WIDTH
    f = p_rw.astype(jnp.float32)
    r = f[..., :C]
    k = f[..., C:2 * C]
    v = f[..., 2 * C:3 * C]
    o = 3 * C
    xw = f[..., o:o + RW_DECAY_RANK]
    o += RW_DECAY_RANK
    xa = f[..., o:o + RW_ICLR_RANK]
    o += RW_ICLR_RANK
    xg = f[..., o:o + RW_GATE_RANK]

    w_log = -jax.nn.softplus(-(w0 + jnp.tanh(xw) @ w2)) - 0.5
    decay = jnp.exp(-jnp.exp(w_log))
    a = jax.nn.sigmoid(a0 + xa @ a2)
    if v_gate is not None:
        v = v + (v_first - v) * v_gate
    g = jax.nn.sigmoid(xg) @ g2

    kk = split_heads(k * k_k, RW_HEADS, RW_HEAD_DIM)
    kk = kk / jnp.maximum(jnp.sqrt(jnp.sum(kk * kk, axis=-1, keepdims=True)), 1e-12)
    k = k * (1.0 + (a - 1.0) * k_a)

    rh = split_heads(r, RW_HEADS, RW_HEAD_DIM)
    kh = split_heads(k, RW_HEADS, RW_HEAD_DIM)
    vh = split_heads(v, RW_HEADS, RW_HEAD_DIM)
    ah = split_heads(a, RW_HEADS, RW_HEAD_DIM)
    wh = split_heads(decay, RW_HEADS, RW_HEAD_DIM)
    y = rwkv7_scan(rh, wh, kh, vh, -kk, kk * ah)

    mean = jnp.mean(y, axis=-1, keepdims=True)
    var = jnp.mean(jnp.square(y - mean), axis=-1, keepdims=True)
    y = ((y - mean) * lax.rsqrt(var + RW_GN_EPS)).reshape(B, S, C) * ln_g + ln_b
    bonus = (jnp.sum(rh * kh * r_k, axis=-1, keepdims=True) * vh).reshape(B, S, C)
    return (y + bonus) * g, v


def stick_breaking_attention(q, k, v):
    S = q.shape[1]
    scale = SB_HEAD_DIM ** -0.5
    outs = []
    for i in range(S // SB_BLOCK):
        q0 = i * SB_BLOCK
        q1 = q0 + SB_BLOCK
        z = jnp.einsum('bqhd,bkhd->bhqk', q[:, q0:q1], k[:, :q1],
                       preferred_element_type=jnp.float32) * scale
        valid = jnp.arange(q0, q1)[:, None] > jnp.arange(q1)[None, :]
        log_not = jnp.where(valid, jax.nn.log_sigmoid(-z), 0.0)
        suffix = lax.cumsum(log_not, axis=3, reverse=True) - log_not
        att = jnp.where(valid, jnp.exp(jax.nn.log_sigmoid(z) + suffix), 0.0)
        outs.append(jnp.einsum('bhqk,bkhd->bqhd', att.astype(v.dtype), v[:, :q1]))
    return jnp.concatenate(outs, axis=1)


def multiscale_pool(u, w_pool, pool_scale):
    B, S, _ = u.shape
    ug = u.astype(jnp.float32).reshape(B, S, POOL_GROUPS, POOL_GROUP_DIM)
    positions = jnp.arange(1, S + 1, dtype=jnp.float32)
    pooled = []
    for g, win in enumerate(POOL_WINDOWS):
        xg = ug[:, :, g]
        cs = jnp.cumsum(xg, axis=1)
        cs_lag = jnp.pad(cs, ((0, 0), (win, 0), (0, 0)))[:, :S]
        count = jnp.minimum(positions, float(win))[None, :, None]
        pooled.append((cs - cs_lag) / count - xg)
    pooled = jnp.stack(pooled, axis=2)
    mixed = jnp.einsum('bsgc,gcd->bsgd', pooled, w_pool.astype(jnp.float32))
    return (mixed.reshape(B, S, POOL_WIDTH) * pool_scale).astype(u.dtype)


def swiglu(h, w_gate, w_up, w_down):
    return (jax.nn.silu(h @ w_gate) * (h @ w_up)) @ w_down


def routed_experts(hf, top_idx, top_w, w_gate, w_up, w_down):
    T, D = hf.shape
    n_assign = T * TOP_K
    n_blocks = -(-(n_assign + N_EXPERTS * MOE_BLOCK) // MOE_BLOCK)
    cap = n_blocks * MOE_BLOCK
    flat_e = top_idx.reshape(-1)
    flat_tok = jnp.repeat(jnp.arange(T, dtype=jnp.int32), TOP_K)
    flat_w = top_w.reshape(-1)
    order = jnp.argsort(flat_e)
    e_sorted = flat_e[order]
    counts = jnp.bincount(flat_e, length=N_EXPERTS)
    padded = (counts + MOE_BLOCK - 1) // MOE_BLOCK * MOE_BLOCK
    start = jnp.cumsum(counts) - counts
    pend = jnp.cumsum(padded)
    pstart = pend - padded
    dest = pstart[e_sorted] + (jnp.arange(n_assign) - start[e_sorted])
    slot_tok = jnp.full((cap,), T, jnp.int32).at[dest].set(flat_tok[order])
    slot_w = jnp.zeros((cap,), hf.dtype).at[dest].set(flat_w[order].astype(hf.dtype))
    block_e = jnp.minimum(
        jnp.searchsorted(pend, jnp.arange(n_blocks) * MOE_BLOCK, side='right'), N_EXPERTS - 1)
    h_pad = jnp.concatenate([hf, jnp.zeros((1, D), hf.dtype)], axis=0)

    def expert_block(args):
        tok, wts, e = args
        xb = h_pad[tok]
        yb = (jax.nn.silu(xb @ w_gate[e]) * (xb @ w_up[e])) @ w_down[e]
        return yb * wts[:, None]

    y = lax.map(expert_block, (slot_tok.reshape(n_blocks, MOE_BLOCK),
                               slot_w.reshape(n_blocks, MOE_BLOCK), block_e))
    return jax.ops.segment_sum(y.reshape(cap, D), slot_tok, num_segments=T + 1)[:T]


def moe_ffn(h, w_router, b_router, w_gate, w_up, w_down, ws_gate, ws_up, ws_down):
    B, S, D = h.shape
    T = B * S
    hf = h.reshape(T, D)
    scores = jax.nn.sigmoid(jnp.matmul(hf, w_router, preferred_element_type=jnp.float32))
    sel = scores + b_router.astype(jnp.float32)
    per_group = N_EXPERTS // N_GROUPS
    grp_score = jnp.sum(lax.top_k(sel.reshape(T, N_GROUPS, per_group), 2)[0], axis=-1)
    _, grp_idx = lax.top_k(grp_score, TOPK_GROUPS)
    grp_mask = jnp.any(grp_idx[..., None] == jnp.arange(N_GROUPS), axis=1)
    masked = jnp.where(jnp.repeat(grp_mask, per_group, axis=1), sel, -jnp.inf)
    _, top_idx = lax.top_k(masked, TOP_K)
    top_w = jnp.take_along_axis(scores, top_idx, axis=1)
    top_w = top_w / (jnp.sum(top_w, axis=-1, keepdims=True) + 1e-20) * ROUTED_SCALE
    routed = routed_experts(hf, top_idx, top_w, w_gate, w_up, w_down)
    shared = swiglu(hf, ws_gate, ws_up, ws_down)
    return (routed + shared).reshape(B, S, D)


def setup_inputs(seed: int = 0) -> dict:
    key = jax.random.key(seed)
    keys = iter(jax.random.split(key, 64))
    L = DEPTH
    Lv = DEPTH - 1
    D = D_MODEL

    def nrm(shape, scale):
        return jax.random.normal(next(keys), shape, jnp.float32) * scale

    def uni(shape, lo, hi):
        return jax.random.uniform(next(keys), shape, jnp.float32, lo, hi)

    return {
        "x": nrm((BATCH, SEQ, D), 1.0),
        "c": nrm((BATCH, D), 1.0),
        "w_ada": nrm((L, D, 6 * D), 0.5 * D ** -0.5),
        "b_ada": nrm((L, 6 * D), 0.02),
        "w_in": nrm((L, D, IN_COLS), D ** -0.5),
        "w_vres": nrm((Lv, D, RW_VRES_RANK), D ** -0.5),
        "mu_rw": uni((L, RW_COLS), 0.0, 1.0),
        "mu_vres": uni((Lv, RW_VRES_RANK), 0.0, 1.0),
        "rw_w0": uni((L, RW_WIDTH), -4.0, 1.0),
        "rw_w2": nrm((L, RW_DECAY_RANK, RW_WIDTH), 0.1 * RW_DECAY_RANK ** -0.5),
        "rw_a0": nrm((L, RW_WIDTH), 0.1),
        "rw_a2": nrm((L, RW_ICLR_RANK, RW_WIDTH), 0.5 * RW_ICLR_RANK ** -0.5),
        "rw_v0": nrm((Lv, RW_WIDTH), 0.5),
        "rw_v2": nrm((Lv, RW_VRES_RANK, RW_WIDTH), 0.5 * RW_VRES_RANK ** -0.5),
        "rw_g2": nrm((L, RW_GATE_RANK, RW_WIDTH), RW_GATE_RANK ** -0.5),
        "rw_k_k": 0.85 + nrm((L, RW_WIDTH), 0.05),
        "rw_k_a": 1.0 + nrm((L, RW_WIDTH), 0.05),
        "rw_r_k": nrm((L, RW_HEADS, RW_HEAD_DIM), 0.1),
        "rw_ln_g": 1.0 + nrm((L, RW_WIDTH), 0.05),
        "rw_ln_b": nrm((L, RW_WIDTH), 0.02),
        "sb_norm_g": 1.0 + nrm((L, SB_WIDTH), 0.05),
        "pool_w": nrm((L, POOL_GROUPS, POOL_GROUP_DIM, POOL_GROUP_DIM), POOL_GROUP_DIM ** -0.5),
        "pool_scale": uni((L, POOL_WIDTH), 0.5, 1.5),
        "w_out": nrm((L, MIX_WIDTH, D), MIX_WIDTH ** -0.5),
        "w_router": nrm((L, D, N_EXPERTS), D ** -0.5),
        "b_router": nrm((L, N_EXPERTS), 0.01),
        "w_exp_gate": nrm((L, N_EXPERTS, D, EXPERT_DIM), D ** -0.5),
        "w_exp_up": nrm((L, N_EXPERTS, D, EXPERT_DIM), D ** -0.5),
        "w_exp_down": nrm((L, N_EXPERTS, EXPERT_DIM, D), EXPERT_DIM ** -0.5),
        "w_sh_gate": nrm((L, D, EXPERT_DIM), D ** -0.5),
        "w_sh_up": nrm((L, D, EXPERT_DIM), D ** -0.5),
        "w_sh_down": nrm((L, EXPERT_DIM, D), EXPERT_DIM ** -0.5),
        "g_final": 1.0 + nrm((D,), 0.05),
    }


def reference(x, c, w_ada, b_ada, w_in, w_vres, mu_rw, mu_vres, rw_w0, rw_w2, rw_a0, rw_a2,
              rw_v0, rw_v2, rw_g2, rw_k_k, rw_k_a, rw_r_k, rw_ln_g, rw_ln_b, sb_norm_g,
              pool_w, pool_scale, w_out, w_router, b_router, w_exp_gate, w_exp_up, w_exp_down,
              w_sh_gate, w_sh_up, w_sh_down, g_final):
    B, S, D = x.shape
    cond = jax.nn.silu(c)
    v_first = None
    for l in range(DEPTH):
        mod = cond @ w_ada[l] + b_ada[l]
        sh_m, sc_m, gt_m, sh_f, sc_f, gt_f = (m[:, None, :] for m in jnp.split(mod, 6, axis=-1))

        h = rms_norm(x) * (1.0 + sc_m) + sh_m
        w_in_l = w_in[l] if l == 0 else jnp.concatenate([w_in[l], w_vres[l - 1]], axis=1)
        proj = h @ w_in_l
        p_rw = token_shift(proj[..., :RW_COLS], mu_rw[l])
        p_sb = proj[..., RW_COLS:RW_COLS + SB_COLS]
        p_pool = proj[..., RW_COLS + SB_COLS:IN_COLS]

        if l == 0:
            v_gate = None
        else:
            p_vres = token_shift(proj[..., IN_COLS:], mu_vres[l - 1]).astype(jnp.float32)
            v_gate = jax.nn.sigmoid(rw_v0[l - 1] + p_vres @ rw_v2[l - 1])
        rw_out, v_l = rwkv7_time_mix(p_rw, v_first, v_gate, rw_w0[l], rw_w2[l], rw_a0[l],
                                     rw_a2[l], rw_g2[l], rw_k_k[l], rw_k_a[l], rw_r_k[l],
                                     rw_ln_g[l], rw_ln_b[l])
        if l == 0:
            v_first = v_l

        q_sb = split_heads(p_sb[..., :SB_WIDTH], SB_HEADS, SB_HEAD_DIM)
        k_sb = split_heads(p_sb[..., SB_WIDTH:2 * SB_WIDTH], SB_HEADS, SB_HEAD_DIM)
        v_sb = split_heads(p_sb[..., 2 * SB_WIDTH:], SB_HEADS, SB_HEAD_DIM)
        sb_out = stick_breaking_attention(q_sb, k_sb, v_sb)
        sb_out = (rms_norm(sb_out) * sb_norm_g[l].reshape(SB_HEADS, SB_HEAD_DIM)).reshape(B, S, SB_WIDTH)

        pool_out = multiscale_pool(p_pool, pool_w[l], pool_scale[l])

        mixed = jnp.concatenate([rw_out.astype(x.dtype), sb_out.astype(x.dtype), pool_out], axis=-1)
        x = x + gt_m * (mixed @ w_out[l])

        h = rms_norm(x) * (1.0 + sc_f) + sh_f
        ffn = moe_ffn(h, w_router[l], b_router[l], w_exp_gate[l], w_exp_up[l], w_exp_down[l],
                      w_sh_gate[l], w_sh_up[l], w_sh_down[l])
        x = x + gt_f * ffn.astype(x.dtype)

    return rms_norm(x) * g_final
```

```cpp
#include <hip/hip_runtime.h>
#include <stdint.h>

#ifndef FUSED
#define FUSED 0
#endif

namespace {

constexpr int D = 1024, NBATCH = 8, SEQ = 2048, T = NBATCH * SEQ, NL = 2;
constexpr int RWW = 384, SBW = 384, PLW = 256;
constexpr int RWC = 1280, SBC = 1152, INC = 2688, PJ = 2720;
constexpr int NE = 64, TOPK = 6, ED = 256;
constexpr int NAID = T * 7;

struct P {
    const float *x, *c, *w_ada, *b_ada, *w_in, *w_vres, *mu_rw, *mu_vres, *rw_w0, *rw_w2, *rw_a0, *rw_a2,
        *rw_v0, *rw_v2, *rw_g2, *rw_k_k, *rw_k_a, *rw_r_k, *rw_ln_g, *rw_ln_b, *sb_norm_g, *pool_w, *pool_scale,
        *w_out, *w_router, *b_router, *w_eg, *w_eu, *w_ed, *w_sg, *w_su, *w_sd, *g_final;
    float* out;
    float *mod;
    float *xb;
    float *h;
    float *proj;
    float *r, *w, *k, *v, *na, *bb, *g, *y, *vfirst;
    float *hm;
    float *ffn;
    int *cnt;
    int *list;
    float *topw;
};

enum Stage { ST_MOD = 0, ST_NORM1, ST_INPROJ, ST_VRES, ST_PREP, ST_SCAN, ST_RWOUT, ST_ATTN, ST_POOL, ST_OUTPROJ, ST_NORM2, ST_ROUTER,
             ST_EXP1, ST_EXP2, ST_COMBINE, ST_FINAL };

__device__ __forceinline__ float wave_sum(float v) {
#pragma unroll
    for (int o = 32; o > 0; o >>= 1) v += __shfl_xor(v, o);
    return v;
}
__device__ __forceinline__ float sigmoidf_(float x) { return 1.f / (1.f + __expf(-x)); }
__device__ __forceinline__ float softplusf_(float x) { return fmaxf(x, 0.f) + log1pf(__expf(-fabsf(x))); }
__device__ __forceinline__ float siluf_(float x) { return x / (1.f + __expf(-x)); }

template <int NBM, class AF, class BF, class EF>
__device__ void gemm64(float* smem, int M, int N, int K, int tm, int tn, AF a4, BF b4, EF epi) {
    float(*As)[68] = (float(*)[68])smem;
    float(*Bs)[16][68] = (float(*)[16][68])(smem + 16 * 68);
    const int tid = threadIdx.x, tx = tid & 15, ty = tid >> 4;
    float acc[NBM][4][4];
#pragma unroll
    for (int q = 0; q < NBM; ++q)
#pragma unroll
        for (int i = 0; i < 4; ++i)
#pragma unroll
            for (int j = 0; j < 4; ++j) acc[q][i][j] = 0.f;
    const int am = tid >> 2, ak = (tid & 3) * 4;
    const int bk = tid >> 4, bn = (tid & 15) * 4;
    const int gm = tm * 64 + am, gn = tn * 64 + bn;
    for (int k0 = 0; k0 < K; k0 += 16) {
        float4 av = make_float4(0.f, 0.f, 0.f, 0.f);
        if (gm < M) av = a4(gm, k0 + ak);
        As[ak + 0][am] = av.x; As[ak + 1][am] = av.y; As[ak + 2][am] = av.z; As[ak + 3][am] = av.w;
#pragma unroll
        for (int q = 0; q < NBM; ++q) {
            float4 bv = make_float4(0.f, 0.f, 0.f, 0.f);
            if (gn < N) bv = b4(q, k0 + bk, gn);
            *(float4*)&Bs[q][bk][bn] = bv;
        }
        __syncthreads();
#pragma unroll
        for (int kk = 0; kk < 16; ++kk) {
            const float4 a = *(const float4*)&As[kk][ty * 4];
            const float aa[4] = {a.x, a.y, a.z, a.w};
#pragma unroll
            for (int q = 0; q < NBM; ++q) {
                const float4 b = *(const float4*)&Bs[q][kk][tx * 4];
                const float bbv[4] = {b.x, b.y, b.z, b.w};
#pragma unroll
                for (int i = 0; i < 4; ++i)
#pragma unroll
                    for (int j = 0; j < 4; ++j) acc[q][i][j] += aa[i] * bbv[j];
            }
        }
        __syncthreads();
    }
#pragma unroll
    for (int i = 0; i < 4; ++i) {
        const int m = tm * 64 + ty * 4 + i;
        if (m < M) {
#pragma unroll
            for (int j = 0; j < 4; ++j) {
                const int n = tn * 64 + tx * 4 + j;
                if (n < N) {
                    float vals[NBM];
#pragma unroll
                    for (int q = 0; q < NBM; ++q) vals[q] = acc[q][i][j];
                    epi(m, n, vals);
                }
            }
        }
    }
}

__device__ int stage_nvb(int st) {
    switch (st) {
        case ST_MOD: return NL * 24;
        case ST_NORM1: case ST_NORM2: case ST_FINAL: return T / 4;
        case ST_INPROJ: return (T / 64) * (INC / 64);
        case ST_VRES: return T / 64;
        case ST_PREP: return T;
        case ST_SCAN: return NBATCH * 6 / 4;
        case ST_RWOUT: return T * 6 / 4;
        case ST_ATTN: return NBATCH * 6 * (SEQ / 64) / 4;
        case ST_POOL: return T;
        case ST_OUTPROJ: return (T / 64) * (D / 64);
        case ST_ROUTER: return T / 4;
        case ST_EXP1: return 65 * 256 * 4;
        case ST_EXP2: return 65 * 256 * 16;
        case ST_COMBINE: return T / 4;
    }
    return 0;
}

__device__ void st_mod(const P& p, int vb, float* smem) {
    const int l = vb / 24, j = (vb % 24) * 256 + threadIdx.x;
    float* sc = smem;
    for (int i = threadIdx.x; i < 8 * 1024; i += 256) sc[i] = siluf_(p.c[i]);
    __syncthreads();
    float acc[8];
#pragma unroll
    for (int b = 0; b < 8; ++b) acc[b] = 0.f;
    const float* w = p.w_ada + (size_t)l * 1024 * 6144 + j;
    for (int i = 0; i < 1024; ++i) {
        const float wv = w[(size_t)i * 6144];
#pragma unroll
        for (int b = 0; b < 8; ++b) acc[b] += sc[b * 1024 + i] * wv;
    }
    const float bv = p.b_ada[l * 6144 + j];
#pragma unroll
    for (int b = 0; b < 8; ++b) p.mod[((size_t)l * 8 + b) * 6144 + j] = acc[b] + bv;
    __syncthreads();
}

__device__ void st_norm(const P& p, int l, int which, int vb) {
    const int wv = threadIdx.x >> 6, lane = threadIdx.x & 63;
    const int t = vb * 4 + wv, b = t / SEQ;
    const float* xin = (l == 0 && which == 0) ? p.x : p.xb;
    const float* xr = xin + (size_t)t * D;
    float vals[16];
    float ss = 0.f;
#pragma unroll
    for (int i = 0; i < 4; ++i) {
        const float4 q = *(const float4*)(xr + i * 256 + lane * 4);
        vals[i * 4 + 0] = q.x; vals[i * 4 + 1] = q.y; vals[i * 4 + 2] = q.z; vals[i * 4 + 3] = q.w;
        ss += q.x * q.x + q.y * q.y + q.z * q.z + q.w * q.w;
    }
    ss = wave_sum(ss);
    const float rs = rsqrtf(ss * (1.f / D) + 1e-6f);
    if (which == 2) {
#pragma unroll
        for (int i = 0; i < 4; ++i) {
            const int cidx = i * 256 + lane * 4;
            const float4 gq = *(const float4*)(p.g_final + cidx);
            float4 o;
            o.x = vals[i * 4 + 0] * rs * gq.x; o.y = vals[i * 4 + 1] * rs * gq.y; o.z = vals[i * 4 + 2] * rs * gq.z; o.w = vals[i * 4 + 3] * rs * gq.w;
            *(float4*)(p.out + (size_t)t * D + cidx) = o;
        }
        return;
    }
    const float* md = p.mod + ((size_t)l * 8 + b) * 6144 + (which ? 3072 : 0);
#pragma unroll
    for (int i = 0; i < 4; ++i) {
        const int cidx = i * 256 + lane * 4;
        const float4 sh = *(const float4*)(md + cidx);
        const float4 sc = *(const float4*)(md + 1024 + cidx);
        float4 o;
        o.x = vals[i * 4 + 0] * rs * (1.f + sc.x) + sh.x; o.y = vals[i * 4 + 1] * rs * (1.f + sc.y) + sh.y;
        o.z = vals[i * 4 + 2] * rs * (1.f + sc.z) + sh.z; o.w = vals[i * 4 + 3] * rs * (1.f + sc.w) + sh.w;
        *(float4*)(p.h + (size_t)t * D + cidx) = o;
        if (which == 1) *(float4*)(p.ffn + (size_t)t * D + cidx) = make_float4(0.f, 0.f, 0.f, 0.f);
    }
    if (which == 1 && vb == 0 && threadIdx.x < 64) p.cnt[threadIdx.x] = 0;
}

__device__ void st_inproj(const P& p, int l, int vb, float* smem) {
    const int ntn = INC / 64, tm = vb / ntn, tn = vb % ntn;
    const float* A = p.h; const float* B = p.w_in + (size_t)l * D * INC; float* C = p.proj;
    gemm64<1>(smem, T, INC, D, tm, tn,
        [&](int m, int k) { return *(const float4*)(A + (size_t)m * D + k); },
        [&](int, int k, int n) { return *(const float4*)(B + (size_t)k * INC + n); },
        [&](int m, int n, const float* v) { C[(size_t)m * PJ + n] = v[0]; });
}
__device__ void st_vres(const P& p, int vb, float* smem) {
    const float* A = p.h; const float* B = p.w_vres; float* C = p.proj;
    gemm64<1>(smem, T, 32, D, vb, 0,
        [&](int m, int k) { return *(const float4*)(A + (size_t)m * D + k); },
        [&](int, int k, int n) { return *(const float4*)(B + (size_t)k * 32 + n); },
        [&](int m, int n, const float* v) { C[(size_t)m * PJ + INC + n] = v[0]; });
}

__device__ void st_prep(const P& p, int l, int vb, float* smem) {
    const int t = vb, s = t % SEQ, tid = threadIdx.x;
    float* Pp = smem;
    float* PV = smem + 1280;
    float* TW = smem + 1312;
    float* SG = smem + 1344;
    float* KK = smem + 1408;
    float* AA = smem + 1792;
    const float* u = p.proj + (size_t)t * PJ;
    const float* mu = p.mu_rw + l * RWC;
    for (int j = tid; j < RWC; j += 256) {
        const float uu = u[j], pv = s > 0 ? u[j - PJ] : 0.f;
        Pp[j] = uu + (pv - uu) * mu[j];
    }
    if (l == 1 && tid < 32) {
        const float uu = u[INC + tid], pv = s > 0 ? u[INC + tid - PJ] : 0.f;
        PV[tid] = uu + (pv - uu) * p.mu_vres[tid];
    }
    __syncthreads();
    if (tid < 32) TW[tid] = tanhf(Pp[1152 + tid]);
    if (tid >= 64 && tid < 128) SG[tid - 64] = sigmoidf_(Pp[1216 + tid - 64]);
    __syncthreads();
    for (int c = tid; c < RWW; c += 256) {
        float lw = p.rw_w0[l * RWW + c], la = p.rw_a0[l * RWW + c];
        const float* w2 = p.rw_w2 + (size_t)l * 32 * RWW + c;
        const float* a2 = p.rw_a2 + (size_t)l * 32 * RWW + c;
        for (int i = 0; i < 32; ++i) { lw += TW[i] * w2[i * RWW]; la += Pp[1184 + i] * a2[i * RWW]; }
        const float wlog = -softplusf_(-lw) - 0.5f;
        const float decay = __expf(-__expf(wlog));
        const float a = sigmoidf_(la);
        float v = Pp[768 + c];
        if (l == 1) {
            float lv = p.rw_v0[c];
            const float* v2 = p.rw_v2 + c;
            for (int i = 0; i < 32; ++i) lv += PV[i] * v2[i * RWW];
            const float vg = sigmoidf_(lv);
            v = v + (p.vfirst[(size_t)t * RWW + c] - v) * vg;
        } else {
            p.vfirst[(size_t)t * RWW + c] = v;
        }
        float g = 0.f;
        const float* g2 = p.rw_g2 + (size_t)l * 64 * RWW + c;
        for (int i = 0; i < 64; ++i) g += SG[i] * g2[i * RWW];
        const float k = Pp[384 + c];
        KK[c] = k * p.rw_k_k[l * RWW + c];
        AA[c] = a;
        const size_t o = (size_t)t * RWW + c;
        p.r[o] = Pp[c]; p.w[o] = decay; p.k[o] = k * (1.f + (a - 1.f) * p.rw_k_a[l * RWW + c]); p.v[o] = v; p.g[o] = g;
    }
    __syncthreads();
    for (int c = tid; c < RWW; c += 256) {
        const int h0 = (c >> 6) << 6;
        float ss = 0.f;
        for (int i = 0; i < 64; ++i) ss += KK[h0 + i] * KK[h0 + i];
        const float kk = KK[c] / fmaxf(sqrtf(ss), 1e-12f);
        const size_t o = (size_t)t * RWW + c;
        p.na[o] = -kk; p.bb[o] = kk * AA[c];
    }
    __syncthreads();
}

__device__ void st_scan(const P& p, int vb) {
    const int wv = __builtin_amdgcn_readfirstlane(threadIdx.x >> 6), lane = threadIdx.x & 63;
    const int bh = vb * 4 + wv, b = bh / 6, hh = bh % 6;
    float st[64];
#pragma unroll
    for (int j = 0; j < 64; ++j) st[j] = 0.f;
    size_t o = ((size_t)b * SEQ) * RWW + hh * 64 + lane;
    float rv = p.r[o], wvv = p.w[o], kv = p.k[o], av = p.na[o], bv = p.bb[o], vv = p.v[o];
    for (int s = 0; s < SEQ; ++s) {
        const size_t on = o + RWW;
        float rn = 0.f, wn = 0.f, kn = 0.f, an = 0.f, bn = 0.f, vn = 0.f;
        if (s + 1 < SEQ) { rn = p.r[on]; wn = p.w[on]; kn = p.k[on]; an = p.na[on]; bn = p.bb[on]; vn = p.v[on]; }
        float sa = 0.f;
#pragma unroll
        for (int j = 0; j < 64; ++j) sa += st[j] * __int_as_float(__builtin_amdgcn_readlane(__float_as_int(av), j));
        float yy = 0.f;
#pragma unroll
        for (int j = 0; j < 64; ++j) {
            const float wj = __int_as_float(__builtin_amdgcn_readlane(__float_as_int(wvv), j));
            const float bj = __int_as_float(__builtin_amdgcn_readlane(__float_as_int(bv), j));
            const float kj = __int_as_float(__builtin_amdgcn_readlane(__float_as_int(kv), j));
            const float rj = __int_as_float(__builtin_amdgcn_readlane(__float_as_int(rv), j));
            st[j] = st[j] * wj + sa * bj + vv * kj;
            yy += st[j] * rj;
        }
        p.y[o] = yy;
        o = on; rv = rn; wvv = wn; kv = kn; av = an; bv = bn; vv = vn;
    }
}

__device__ void st_rwout(const P& p, int l, int vb) {
    const int wv = threadIdx.x >> 6, lane = threadIdx.x & 63;
    const int item = vb * 4 + wv, t = item / 6, hh = item % 6;
    const int c = hh * 64 + lane;
    const size_t o = (size_t)t * RWW + c;
    const float y = p.y[o];
    const float mean = wave_sum(y) * (1.f / 64.f);
    const float d = y - mean;
    const float var = wave_sum(d * d) * (1.f / 64.f);
    const float yn = d * rsqrtf(var + 64e-5f) * p.rw_ln_g[l * RWW + c] + p.rw_ln_b[l * RWW + c];
    const float rk = wave_sum(p.r[o] * p.k[o] * p.rw_r_k[l * RWW + c]);
    const float outv = (yn + rk * p.v[o]) * p.g[o];
    p.h[(size_t)t * D + c] = outv;
}

__device__ void st_attn(const P& p, int l, int vb) {
    const int wv = __builtin_amdgcn_readfirstlane(threadIdx.x >> 6), lane = threadIdx.x & 63;
    const int item = vb * 4 + wv;
    const int qb = item % (SEQ / 64), bh = item / (SEQ / 64), b = bh / 6, hh = bh % 6;
    const int i = qb * 64 + lane;
    const float* base = p.proj + (size_t)b * SEQ * PJ + RWC + hh * 64;
    float q[64], o[64];
    {
        const float* qp = base + (size_t)i * PJ;
#pragma unroll
        for (int d = 0; d < 64; d += 4) { const float4 t4 = *(const float4*)(qp + d); q[d] = t4.x * 0.125f; q[d + 1] = t4.y * 0.125f; q[d + 2] = t4.z * 0.125f; q[d + 3] = t4.w * 0.125f; }
    }
#pragma unroll
    for (int d = 0; d < 64; ++d) o[d] = 0.f;
    float R = 0.f;
    for (int j = qb * 64 + 62; j >= 0; --j) {
        const float* kp = base + (size_t)j * PJ + SBW;
        const float* vp = kp + SBW;
        float z = 0.f;
#pragma unroll
        for (int d = 0; d < 64; d += 4) { const float4 t4 = *(const float4*)(kp + d); z += q[d] * t4.x + q[d + 1] * t4.y + q[d + 2] * t4.z + q[d + 3] * t4.w; }
        const bool valid = i > j;
        const float l1p = log1pf(__expf(-fabsf(z)));
        const float logsig = fminf(z, 0.f) - l1p;
        const float lognot = -fmaxf(z, 0.f) - l1p;
        const float att = valid ? __expf(logsig + R) : 0.f;
        if (valid) R += lognot;
#pragma unroll
        for (int d = 0; d < 64; d += 4) { const float4 t4 = *(const float4*)(vp + d); o[d] += att * t4.x; o[d + 1] += att * t4.y; o[d + 2] += att * t4.z; o[d + 3] += att * t4.w; }
    }
    float ss = 0.f;
#pragma unroll
    for (int d = 0; d < 64; ++d) ss += o[d] * o[d];
    const float rs = rsqrtf(ss * (1.f / 64.f) + 1e-6f);
    float* op = p.h + ((size_t)b * SEQ + i) * D + RWW + hh * 64;
    const float* gn = p.sb_norm_g + l * SBW + hh * 64;
#pragma unroll
    for (int d = 0; d < 64; ++d) op[d] = o[d] * rs * gn[d];
}

__device__ void st_pool(const P& p, int l, int vb, float* smem) {
    const int t = vb, s = t % SEQ, tid = threadIdx.x, g = tid >> 6, c = tid & 63;
    const int win = 2 << g;
    const float* u = p.proj + (size_t)t * PJ + RWC + SBC + g * 64 + c;
    float sum = 0.f;
    const int n = min(s + 1, win);
    for (int i = 0; i < n; ++i) sum += u[-(ptrdiff_t)i * PJ];
    smem[tid] = sum / (float)n - u[0];
    __syncthreads();
    const float* pw = p.pool_w + ((size_t)l * 4 + g) * 64 * 64 + c;
    float acc = 0.f;
    for (int i = 0; i < 64; ++i) acc += smem[g * 64 + i] * pw[i * 64];
    p.h[(size_t)t * D + 768 + tid] = acc * p.pool_scale[l * PLW + tid];
    __syncthreads();
}

__device__ void st_outproj(const P& p, int l, int vb, float* smem) {
    const int ntn = D / 64, tm = vb / ntn, tn = vb % ntn;
    const float* A = p.h; const float* B = p.w_out + (size_t)l * D * D;
    const float* xin = l == 0 ? p.x : p.xb;
    gemm64<1>(smem, T, D, D, tm, tn,
        [&](int m, int k) { return *(const float4*)(A + (size_t)m * D + k); },
        [&](int, int k, int n) { return *(const float4*)(B + (size_t)k * D + n); },
        [&](int m, int n, const float* v) {
            const float gt = p.mod[((size_t)l * 8 + m / SEQ) * 6144 + 2048 + n];
            p.xb[(size_t)m * D + n] = xin[(size_t)m * D + n] + gt * v[0];
        });
}

__device__ void st_router(const P& p, int l, int vb, float* smem) {
    const int wv = threadIdx.x >> 6, lane = threadIdx.x & 63;
    const int t = vb * 4 + wv;
    float* sel = smem + wv * 192;
    float* gs = sel + 64;
    float* scs = sel + 128;
    const float* hr = p.h + (size_t)t * D;
    const float* wr = p.w_router + (size_t)l * D * NE + lane;
    float acc = 0.f;
    for (int k = 0; k < D; k += 4) {
        const float4 h4 = *(const float4*)(hr + k);
        acc += h4.x * wr[(size_t)k * NE] + h4.y * wr[(size_t)(k + 1) * NE] + h4.z * wr[(size_t)(k + 2) * NE] + h4.w * wr[(size_t)(k + 3) * NE];
    }
    const float score = sigmoidf_(acc);
    const float sl = score + p.b_router[l * NE + lane];
    sel[lane] = sl; scs[lane] = score;
    __syncthreads();
    if (lane < 8) {
        float m1 = -INFINITY, m2 = -INFINITY;
        for (int i = 0; i < 8; ++i) { const float v = sel[lane * 8 + i]; if (v > m1) { m2 = m1; m1 = v; } else if (v > m2) m2 = v; }
        gs[lane] = m1 + m2;
    }
    __syncthreads();
    const int gI = lane >> 3;
    int grank = 0;
    for (int i = 0; i < 8; ++i) { const float v = gs[i]; grank += (v > gs[gI] || (v == gs[gI] && i < gI)) ? 1 : 0; }
    const bool gsel = grank < 4;
    const float msk = gsel ? sl : -INFINITY;
    __syncthreads();
    sel[lane] = msk;
    __syncthreads();
    int rank = 0;
    for (int i = 0; i < 64; ++i) { const float v = sel[i]; rank += (v > msk || (v == msk && i < lane)) ? 1 : 0; }
    const bool chosen = rank < TOPK;
    const float wsum = wave_sum(chosen ? score : 0.f);
    if (chosen) {
        const int pos = atomicAdd(&p.cnt[lane], 1);
        p.list[(size_t)lane * T + pos] = t * TOPK + rank;
        p.topw[(size_t)t * TOPK + rank] = score / (wsum + 1e-20f) * 2.5f;
    }
    __syncthreads();
}

__device__ void st_exp1(const P& p, int l, int vb, float* smem) {
    const int tn = vb & 3, mt = (vb >> 2) & 255, e = vb >> 10;
    const int cnt = e < NE ? p.cnt[e] : T;
    if (mt * 64 >= cnt) return;
    const float* Wg = e < NE ? p.w_eg + ((size_t)l * NE + e) * D * ED : p.w_sg + (size_t)l * D * ED;
    const float* Wu = e < NE ? p.w_eu + ((size_t)l * NE + e) * D * ED : p.w_su + (size_t)l * D * ED;
    const int* lst = p.list + (size_t)e * T;
    gemm64<2>(smem, cnt, ED, D, mt, tn,
        [&](int m, int k) { const int tok = e < NE ? lst[m] / TOPK : m; return *(const float4*)(p.h + (size_t)tok * D + k); },
        [&](int q, int k, int n) { return *(const float4*)((q ? Wu : Wg) + (size_t)k * ED + n); },
        [&](int m, int n, const float* v) { const int aid = e < NE ? lst[m] : T * TOPK + m; p.hm[(size_t)aid * ED + n] = siluf_(v[0]) * v[1]; });
}
__device__ void st_exp2(const P& p, int l, int vb, float* smem) {
    const int tn = vb & 15, mt = (vb >> 4) & 255, e = vb >> 12;
    const int cnt = e < NE ? p.cnt[e] : T;
    if (mt * 64 >= cnt) return;
    const float* Wd = e < NE ? p.w_ed + ((size_t)l * NE + e) * ED * D : p.w_sd + (size_t)l * ED * D;
    const int* lst = p.list + (size_t)e * T;
    gemm64<1>(smem, cnt, D, ED, mt, tn,
        [&](int m, int k) { const int aid = e < NE ? lst[m] : T * TOPK + m; return *(const float4*)(p.hm + (size_t)aid * ED + k); },
        [&](int, int k, int n) { return *(const float4*)(Wd + (size_t)k * D + n); },
        [&](int m, int n, const float* v) {
            int tok; float w;
            if (e < NE) { const int aid = lst[m]; tok = aid / TOPK; w = p.topw[aid]; } else { tok = m; w = 1.f; }
            atomicAdd(&p.ffn[(size_t)tok * D + n], v[0] * w);
        });
}
__device__ void st_combine(const P& p, int l, int vb) {
    const int wv = threadIdx.x >> 6, lane = threadIdx.x & 63;
    const int t = vb * 4 + wv, b = t / SEQ;
    const float* gt = p.mod + ((size_t)l * 8 + b) * 6144 + 5120;
#pragma unroll
    for (int i = 0; i < 4; ++i) {
        const int cidx = i * 256 + lane * 4;
        const float4 f = *(const float4*)(p.ffn + (size_t)t * D + cidx);
        const float4 g = *(const float4*)(gt + cidx);
        float4 xv = *(const float4*)(p.xb + (size_t)t * D + cidx);
        xv.x += g.x * f.x; xv.y += g.y * f.y; xv.z += g.z * f.z; xv.w += g.w * f.w;
        *(float4*)(p.xb + (size_t)t * D + cidx) = xv;
    }
}

__device__ void run_stage(const P& p, int st, int l, int vb, float* smem) {
    switch (st) {
        case ST_MOD: st_mod(p, vb, smem); break;
        case ST_NORM1: st_norm(p, l, 0, vb); break;
        case ST_INPROJ: st_inproj(p, l, vb, smem); break;
        case ST_VRES: st_vres(p, vb, smem); break;
        case ST_PREP: st_prep(p, l, vb, smem); break;
        case ST_SCAN: st_scan(p, vb); break;
        case ST_RWOUT: st_rwout(p, l, vb); break;
        case ST_ATTN: st_attn(p, l, vb); break;
        case ST_POOL: st_pool(p, l, vb, smem); break;
        case ST_OUTPROJ: st_outproj(p, l, vb, smem); break;
        case ST_NORM2: st_norm(p, l, 1, vb); break;
        case ST_ROUTER: st_router(p, l, vb, smem); break;
        case ST_EXP1: st_exp1(p, l, vb, smem); break;
        case ST_EXP2: st_exp2(p, l, vb, smem); break;
        case ST_COMBINE: st_combine(p, l, vb); break;
        case ST_FINAL: st_norm(p, 0, 2, vb); break;
    }
}

__global__ void __launch_bounds__(256) k_stage(P p, int st, int l) {
    __shared__ __attribute__((aligned(16))) float smem[8 * 1024];
    const int nvb = stage_nvb(st);
    for (int vb = blockIdx.x; vb < nvb; vb += gridDim.x) run_stage(p, st, l, vb, smem);
}

int host_nvb(int st) {
    switch (st) {
        case ST_MOD: return NL * 24;
        case ST_NORM1: case ST_NORM2: case ST_FINAL: return T / 4;
        case ST_INPROJ: return (T / 64) * (INC / 64);
        case ST_VRES: return T / 64;
        case ST_PREP: return T;
        case ST_SCAN: return NBATCH * 6 / 4;
        case ST_RWOUT: return T * 6 / 4;
        case ST_ATTN: return NBATCH * 6 * (SEQ / 64) / 4;
        case ST_POOL: return T;
        case ST_OUTPROJ: return (T / 64) * (D / 64);
        case ST_ROUTER: return T / 4;
        case ST_EXP1: return 65 * 256 * 4;
        case ST_EXP2: return 65 * 256 * 16;
        case ST_COMBINE: return T / 4;
    }
    return 0;
}

}

extern "C" void kernel_launch(void* const* d_in, const int* in_sizes, int n_in, void* d_out, int out_size, void* d_ws, size_t ws_size,
                              hipStream_t stream) {
    P p{};
    const float** fp = (const float**)&p;
    for (int i = 0; i < 33; ++i) fp[i] = (const float*)d_in[i];
    p.out = (float*)d_out;
    char* ws = (char*)d_ws;
    size_t off = 0;
    auto take = [&](size_t bytes) { char* r = ws + off; off += (bytes + 255) & ~(size_t)255; return r; };
    p.mod = (float*)take((size_t)NL * 8 * 6144 * 4);
    p.cnt = (int*)take(64 * 4);
    p.list = (int*)take((size_t)NE * T * 4);
    p.topw = (float*)take((size_t)T * TOPK * 4);
    p.xb = (float*)take((size_t)T * D * 4);
    p.h = (float*)take((size_t)T * D * 4);
    p.vfirst = (float*)take((size_t)T * RWW * 4);
    p.proj = (float*)take((size_t)T * PJ * 4);
    p.hm = p.proj;
    p.r = (float*)take((size_t)T * RWW * 4);
    p.ffn = p.r;
    p.w = (float*)take((size_t)T * RWW * 4);
    p.k = (float*)take((size_t)T * RWW * 4);
    p.v = (float*)take((size_t)T * RWW * 4);
    p.na = (float*)take((size_t)T * RWW * 4);
    p.bb = (float*)take((size_t)T * RWW * 4);
    p.g = (float*)take((size_t)T * RWW * 4);
    p.y = (float*)take((size_t)T * RWW * 4);

    auto launch = [&](int st, int l) {
        int nvb = host_nvb(st);
        hipLaunchKernelGGL(k_stage, dim3(nvb), dim3(256), 0, stream, p, st, l);
    };
    launch(ST_MOD, 0);
    for (int l = 0; l < NL; ++l) {
        launch(ST_NORM1, l);
        launch(ST_INPROJ, l);
        if (l == 1) launch(ST_VRES, l);
        launch(ST_PREP, l);
        launch(ST_SCAN, l);
        launch(ST_RWOUT, l);
        launch(ST_ATTN, l);
        launch(ST_POOL, l);
        launch(ST_OUTPROJ, l);
        launch(ST_NORM2, l);
        launch(ST_ROUTER, l);
        launch(ST_EXP1, l);
        launch(ST_EXP2, l);
        launch(ST_COMBINE, l);
    }
    launch(ST_FINAL, 0);
}
```

```cpp
#include <hip/hip_runtime.h>
#include <stdint.h>

#ifndef FUSED
#define FUSED 1
#endif

namespace {

constexpr int D = 1024, NBATCH = 8, SEQ = 2048, T = NBATCH * SEQ, NL = 2;
constexpr int RWW = 384, SBW = 384, PLW = 256;
constexpr int RWC = 1280, SBC = 1152, INC = 2688, PJ = 2720;
constexpr int NE = 64, TOPK = 6, ED = 256;
constexpr int NAID = T * 7;

struct P {
    const float *x, *c, *w_ada, *b_ada, *w_in, *w_vres, *mu_rw, *mu_vres, *rw_w0, *rw_w2, *rw_a0, *rw_a2,
        *rw_v0, *rw_v2, *rw_g2, *rw_k_k, *rw_k_a, *rw_r_k, *rw_ln_g, *rw_ln_b, *sb_norm_g, *pool_w, *pool_scale,
        *w_out, *w_router, *b_router, *w_eg, *w_eu, *w_ed, *w_sg, *w_su, *w_sd, *g_final;
    float* out;
    float *mod;
    float *xb;
    float *h;
    float *proj;
    float *r, *w, *k, *v, *na, *bb, *g, *y, *vfirst;
    float *hm;
    float *ffn;
    int *cnt;
    int *list;
    float *topw;
};

enum Stage { ST_MOD = 0, ST_NORM1, ST_INPROJ, ST_VRES, ST_PREP, ST_SCAN, ST_RWOUT, ST_ATTN, ST_POOL, ST_OUTPROJ, ST_NORM2, ST_ROUTER,
             ST_EXP1, ST_EXP2, ST_COMBINE, ST_FINAL, ST_MIX };

__device__ __forceinline__ float wave_sum(float v) {
#pragma unroll
    for (int o = 32; o > 0; o >>= 1) v += __shfl_xor(v, o);
    return v;
}
__device__ __forceinline__ float sigmoidf_(float x) { return 1.f / (1.f + __expf(-x)); }
__device__ __forceinline__ float softplusf_(float x) { return fmaxf(x, 0.f) + log1pf(__expf(-fabsf(x))); }
__device__ __forceinline__ float siluf_(float x) { return x / (1.f + __expf(-x)); }

template <int NBM, class AF, class BF, class EF>
__device__ __forceinline__ void gemm64(float* smem, int M, int N, int K, int tm, int tn, AF a4, BF b4, EF epi) {
    float(*As)[68] = (float(*)[68])smem;
    float(*Bs)[16][68] = (float(*)[16][68])(smem + 16 * 68);
    const int tid = threadIdx.x, tx = tid & 15, ty = tid >> 4;
    float acc[NBM][4][4];
#pragma unroll
    for (int q = 0; q < NBM; ++q)
#pragma unroll
        for (int i = 0; i < 4; ++i)
#pragma unroll
            for (int j = 0; j < 4; ++j) acc[q][i][j] = 0.f;
    const int am = tid >> 2, ak = (tid & 3) * 4;
    const int bk = tid >> 4, bn = (tid & 15) * 4;
    const int gm = tm * 64 + am, gn = tn * 64 + bn;
    for (int k0 = 0; k0 < K; k0 += 16) {
        float4 av = make_float4(0.f, 0.f, 0.f, 0.f);
        if (gm < M) av = a4(gm, k0 + ak);
        As[ak + 0][am] = av.x; As[ak + 1][am] = av.y; As[ak + 2][am] = av.z; As[ak + 3][am] = av.w;
#pragma unroll
        for (int q = 0; q < NBM; ++q) {
            float4 bv = make_float4(0.f, 0.f, 0.f, 0.f);
            if (gn < N) bv = b4(q, k0 + bk, gn);
            *(float4*)&Bs[q][bk][bn] = bv;
        }
        __syncthreads();
#pragma unroll
        for (int kk = 0; kk < 16; ++kk) {
            const float4 a = *(const float4*)&As[kk][ty * 4];
            const float aa[4] = {a.x, a.y, a.z, a.w};
#pragma unroll
            for (int q = 0; q < NBM; ++q) {
                const float4 b = *(const float4*)&Bs[q][kk][tx * 4];
                const float bbv[4] = {b.x, b.y, b.z, b.w};
#pragma unroll
                for (int i = 0; i < 4; ++i)
#pragma unroll
                    for (int j = 0; j < 4; ++j) acc[q][i][j] += aa[i] * bbv[j];
            }
        }
        __syncthreads();
    }
#pragma unroll
    for (int i = 0; i < 4; ++i) {
        const int m = tm * 64 + ty * 4 + i;
        if (m < M) {
#pragma unroll
            for (int j = 0; j < 4; ++j) {
                const int n = tn * 64 + tx * 4 + j;
                if (n < N) {
                    float vals[NBM];
#pragma unroll
                    for (int q = 0; q < NBM; ++q) vals[q] = acc[q][i][j];
                    epi(m, n, vals);
                }
            }
        }
    }
}

__device__ __forceinline__ int stage_nvb(int st) {
    switch (st) {
        case ST_MOD: return NL * 24;
        case ST_NORM1: case ST_NORM2: case ST_FINAL: return T / 4;
        case ST_INPROJ: return (T / 64) * (INC / 64);
        case ST_VRES: return T / 64;
        case ST_PREP: return T;
        case ST_SCAN: return NBATCH * 6 / 4;
        case ST_RWOUT: return T * 6 / 4;
        case ST_ATTN: return NBATCH * 6 * (SEQ / 32) / 4;
        case ST_POOL: return T;
        case ST_OUTPROJ: return (T / 64) * (D / 64);
        case ST_ROUTER: return T / 4;
        case ST_EXP1: return 65 * 256 * 4;
        case ST_EXP2: return 65 * 256 * 16;
        case ST_COMBINE: return T / 4;
        case ST_MIX: return NBATCH * 6 / 4 + NBATCH * 6 * (SEQ / 32) / 4 + T;
    }
    return 0;
}

__device__ __forceinline__ void st_mod(const P& p, int vb, float* smem) {
    const int l = vb / 24, j = (vb % 24) * 256 + threadIdx.x;
    float* sc = smem;
    for (int i = threadIdx.x; i < 8 * 1024; i += 256) sc[i] = siluf_(p.c[i]);
    __syncthreads();
    float acc[8];
#pragma unroll
    for (int b = 0; b < 8; ++b) acc[b] = 0.f;
    const float* w = p.w_ada + (size_t)l * 1024 * 6144 + j;
    for (int i = 0; i < 1024; ++i) {
        const float wv = w[(size_t)i * 6144];
#pragma unroll
        for (int b = 0; b < 8; ++b) acc[b] += sc[b * 1024 + i] * wv;
    }
    const float bv = p.b_ada[l * 6144 + j];
#pragma unroll
    for (int b = 0; b < 8; ++b) p.mod[((size_t)l * 8 + b) * 6144 + j] = acc[b] + bv;
    __syncthreads();
}

__device__ __forceinline__ void st_norm(const P& p, int l, int which, int vb) {
    const int wv = threadIdx.x >> 6, lane = threadIdx.x & 63;
    const int t = vb * 4 + wv, b = t / SEQ;
    const float* xin = (l == 0 && which == 0) ? p.x : p.xb;
    const float* xr = xin + (size_t)t * D;
    float vals[16];
    float ss = 0.f;
#pragma unroll
    for (int i = 0; i < 4; ++i) {
        const float4 q = *(const float4*)(xr + i * 256 + lane * 4);
        vals[i * 4 + 0] = q.x; vals[i * 4 + 1] = q.y; vals[i * 4 + 2] = q.z; vals[i * 4 + 3] = q.w;
        ss += q.x * q.x + q.y * q.y + q.z * q.z + q.w * q.w;
    }
    ss = wave_sum(ss);
    const float rs = rsqrtf(ss * (1.f / D) + 1e-6f);
    if (which == 2) {
#pragma unroll
        for (int i = 0; i < 4; ++i) {
            const int cidx = i * 256 + lane * 4;
            const float4 gq = *(const float4*)(p.g_final + cidx);
            float4 o;
            o.x = vals[i * 4 + 0] * rs * gq.x; o.y = vals[i * 4 + 1] * rs * gq.y; o.z = vals[i * 4 + 2] * rs * gq.z; o.w = vals[i * 4 + 3] * rs * gq.w;
            *(float4*)(p.out + (size_t)t * D + cidx) = o;
        }
        return;
    }
    const float* md = p.mod + ((size_t)l * 8 + b) * 6144 + (which ? 3072 : 0);
#pragma unroll
    for (int i = 0; i < 4; ++i) {
        const int cidx = i * 256 + lane * 4;
        const float4 sh = *(const float4*)(md + cidx);
        const float4 sc = *(const float4*)(md + 1024 + cidx);
        float4 o;
        o.x = vals[i * 4 + 0] * rs * (1.f + sc.x) + sh.x; o.y = vals[i * 4 + 1] * rs * (1.f + sc.y) + sh.y;
        o.z = vals[i * 4 + 2] * rs * (1.f + sc.z) + sh.z; o.w = vals[i * 4 + 3] * rs * (1.f + sc.w) + sh.w;
        *(float4*)(p.h + (size_t)t * D + cidx) = o;
        if (which == 1) *(float4*)(p.ffn + (size_t)t * D + cidx) = make_float4(0.f, 0.f, 0.f, 0.f);
    }
    if (which == 1 && vb == 0 && threadIdx.x < 64) p.cnt[threadIdx.x] = 0;
}

__device__ __forceinline__ void st_inproj(const P& p, int l, int vb, float* smem) {
    const int ntn = INC / 64, tm = vb / ntn, tn = vb % ntn;
    const float* A = p.h; const float* B = p.w_in + (size_t)l * D * INC; float* C = p.proj;
    gemm64<1>(smem, T, INC, D, tm, tn,
        [&](int m, int k) { return *(const float4*)(A + (size_t)m * D + k); },
        [&](int, int k, int n) { return *(const float4*)(B + (size_t)k * INC + n); },
        [&](int m, int n, const float* v) { C[(size_t)m * PJ + n] = v[0]; });
}
__device__ __forceinline__ void st_vres(const P& p, int vb, float* smem) {
    const float* A = p.h; const float* B = p.w_vres; float* C = p.proj;
    gemm64<1>(smem, T, 32, D, vb, 0,
        [&](int m, int k) { return *(const float4*)(A + (size_t)m * D + k); },
        [&](int, int k, int n) { return *(const float4*)(B + (size_t)k * 32 + n); },
        [&](int m, int n, const float* v) { C[(size_t)m * PJ + INC + n] = v[0]; });
}

__device__ __forceinline__ void st_prep(const P& p, int l, int vb, float* smem) {
    const int t = vb, s = t % SEQ, tid = threadIdx.x;
    float* Pp = smem;
    float* PV = smem + 1280;
    float* TW = smem + 1312;
    float* SG = smem + 1344;
    float* KK = smem + 1408;
    float* AA = smem + 1792;
    const float* u = p.proj + (size_t)t * PJ;
    const float* mu = p.mu_rw + l * RWC;
    for (int j = tid; j < RWC; j += 256) {
        const float uu = u[j], pv = s > 0 ? u[j - PJ] : 0.f;
        Pp[j] = uu + (pv - uu) * mu[j];
    }
    if (l == 1 && tid < 32) {
        const float uu = u[INC + tid], pv = s > 0 ? u[INC + tid - PJ] : 0.f;
        PV[tid] = uu + (pv - uu) * p.mu_vres[tid];
    }
    __syncthreads();
    if (tid < 32) TW[tid] = tanhf(Pp[1152 + tid]);
    if (tid >= 64 && tid < 128) SG[tid - 64] = sigmoidf_(Pp[1216 + tid - 64]);
    __syncthreads();
    for (int c = tid; c < RWW; c += 256) {
        float lw = p.rw_w0[l * RWW + c], la = p.rw_a0[l * RWW + c];
        const float* w2 = p.rw_w2 + (size_t)l * 32 * RWW + c;
        const float* a2 = p.rw_a2 + (size_t)l * 32 * RWW + c;
        for (int i = 0; i < 32; ++i) { lw += TW[i] * w2[i * RWW]; la += Pp[1184 + i] * a2[i * RWW]; }
        const float wlog = -softplusf_(-lw) - 0.5f;
        const float decay = __expf(-__expf(wlog));
        const float a = sigmoidf_(la);
        float v = Pp[768 + c];
        if (l == 1) {
            float lv = p.rw_v0[c];
            const float* v2 = p.rw_v2 + c;
            for (int i = 0; i < 32; ++i) lv += PV[i] * v2[i * RWW];
            const float vg = sigmoidf_(lv);
            v = v + (p.vfirst[(size_t)t * RWW + c] - v) * vg;
        } else {
            p.vfirst[(size_t)t * RWW + c] = v;
        }
        float g = 0.f;
        const float* g2 = p.rw_g2 + (size_t)l * 64 * RWW + c;
        for (int i = 0; i < 64; ++i) g += SG[i] * g2[i * RWW];
        const float k = Pp[384 + c];
        KK[c] = k * p.rw_k_k[l * RWW + c];
        AA[c] = a;
        const size_t o = (size_t)t * RWW + c;
        p.r[o] = Pp[c]; p.w[o] = decay; p.k[o] = k * (1.f + (a - 1.f) * p.rw_k_a[l * RWW + c]); p.v[o] = v; p.g[o] = g;
    }
    __syncthreads();
    for (int c = tid; c < RWW; c += 256) {
        const int h0 = (c >> 6) << 6;
        float ss = 0.f;
        for (int i = 0; i < 64; ++i) ss += KK[h0 + i] * KK[h0 + i];
        const float kk = KK[c] / fmaxf(sqrtf(ss), 1e-12f);
        const size_t o = (size_t)t * RWW + c;
        p.na[o] = -kk; p.bb[o] = kk * AA[c];
    }
    __syncthreads();
}

__device__ __forceinline__ void st_scan(const P& p, int vb) {
    const int wv = __builtin_amdgcn_readfirstlane(threadIdx.x >> 6), lane = threadIdx.x & 63;
    const int bh = vb * 4 + wv, b = bh / 6, hh = bh % 6;
    float st[64];
#pragma unroll
    for (int j = 0; j < 64; ++j) st[j] = 0.f;
    size_t o = ((size_t)b * SEQ) * RWW + hh * 64 + lane;
    float rv = p.r[o], wvv = p.w[o], kv = p.k[o], av = p.na[o], bv = p.bb[o], vv = p.v[o];
    for (int s = 0; s < SEQ; ++s) {
        const size_t on = o + RWW;
        float rn = 0.f, wn = 0.f, kn = 0.f, an = 0.f, bn = 0.f, vn = 0.f;
        if (s + 1 < SEQ) { rn = p.r[on]; wn = p.w[on]; kn = p.k[on]; an = p.na[on]; bn = p.bb[on]; vn = p.v[on]; }
        float sa = 0.f;
#pragma unroll
        for (int j = 0; j < 64; ++j) sa += st[j] * __int_as_float(__builtin_amdgcn_readlane(__float_as_int(av), j));
        float yy = 0.f;
#pragma unroll
        for (int j = 0; j < 64; ++j) {
            const float wj = __int_as_float(__builtin_amdgcn_readlane(__float_as_int(wvv), j));
            const float bj = __int_as_float(__builtin_amdgcn_readlane(__float_as_int(bv), j));
            const float kj = __int_as_float(__builtin_amdgcn_readlane(__float_as_int(kv), j));
            const float rj = __int_as_float(__builtin_amdgcn_readlane(__float_as_int(rv), j));
            st[j] = st[j] * wj + sa * bj + vv * kj;
            yy += st[j] * rj;
        }
        p.y[o] = yy;
        o = on; rv = rn; wvv = wn; kv = kn; av = an; bv = bn; vv = vn;
    }
}

__device__ __forceinline__ void st_rwout(const P& p, int l, int vb) {
    const int wv = threadIdx.x >> 6, lane = threadIdx.x & 63;
    const int item = vb * 4 + wv, t = item / 6, hh = item % 6;
    const int c = hh * 64 + lane;
    const size_t o = (size_t)t * RWW + c;
    const float y = p.y[o];
    const float mean = wave_sum(y) * (1.f / 64.f);
    const float d = y - mean;
    const float var = wave_sum(d * d) * (1.f / 64.f);
    const float yn = d * rsqrtf(var + 64e-5f) * p.rw_ln_g[l * RWW + c] + p.rw_ln_b[l * RWW + c];
    const float rk = wave_sum(p.r[o] * p.k[o] * p.rw_r_k[l * RWW + c]);
    const float outv = (yn + rk * p.v[o]) * p.g[o];
    p.h[(size_t)t * D + c] = outv;
}

__device__ __forceinline__ void st_attn(const P& p, int l, int vb) {
    const int wv = __builtin_amdgcn_readfirstlane(threadIdx.x >> 6), lane = threadIdx.x & 63;
    const int item = vb * 4 + wv;
    const int qb = item % (SEQ / 32), bh = item / (SEQ / 32), b = bh / 6, hh = bh % 6;
    const int i = qb * 32 + (lane >> 1), hf = (lane & 1) * 32;
    const float* base = p.proj + (size_t)b * SEQ * PJ + RWC + hh * 64 + hf;
    float q[32], o[32];
    {
        const float* qp = base + (size_t)i * PJ;
#pragma unroll
        for (int d = 0; d < 32; d += 4) { const float4 t4 = *(const float4*)(qp + d); q[d] = t4.x * 0.125f; q[d + 1] = t4.y * 0.125f; q[d + 2] = t4.z * 0.125f; q[d + 3] = t4.w * 0.125f; }
    }
#pragma unroll
    for (int d = 0; d < 32; ++d) o[d] = 0.f;
    float R = 0.f;
    for (int j = qb * 32 + 30; j >= 0; --j) {
        const float* kp = base + (size_t)j * PJ + SBW;
        const float* vp = kp + SBW;
        float z = 0.f;
#pragma unroll
        for (int d = 0; d < 32; d += 4) { const float4 t4 = *(const float4*)(kp + d); z += q[d] * t4.x + q[d + 1] * t4.y + q[d + 2] * t4.z + q[d + 3] * t4.w; }
        z += __shfl_xor(z, 1);
        const bool valid = i > j;
        const float l1p = log1pf(__expf(-fabsf(z)));
        const float logsig = fminf(z, 0.f) - l1p;
        const float lognot = -fmaxf(z, 0.f) - l1p;
        const float att = valid ? __expf(logsig + R) : 0.f;
        if (valid) R += lognot;
#pragma unroll
        for (int d = 0; d < 32; d += 4) { const float4 t4 = *(const float4*)(vp + d); o[d] += att * t4.x; o[d + 1] += att * t4.y; o[d + 2] += att * t4.z; o[d + 3] += att * t4.w; }
    }
    float ss = 0.f;
#pragma unroll
    for (int d = 0; d < 32; ++d) ss += o[d] * o[d];
    ss += __shfl_xor(ss, 1);
    const float rs = rsqrtf(ss * (1.f / 64.f) + 1e-6f);
    float* op = p.h + ((size_t)b * SEQ + i) * D + RWW + hh * 64 + hf;
    const float* gn = p.sb_norm_g + l * SBW + hh * 64 + hf;
#pragma unroll
    for (int d = 0; d < 32; ++d) op[d] = o[d] * rs * gn[d];
}

__device__ __forceinline__ void st_pool(const P& p, int l, int vb, float* smem) {
    const int t = vb, s = t % SEQ, tid = threadIdx.x, g = tid >> 6, c = tid & 63;
    const int win = 2 << g;
    const float* u = p.proj + (size_t)t * PJ + RWC + SBC + g * 64 + c;
    float sum = 0.f;
    const int n = min(s + 1, win);
    for (int i = 0; i < n; ++i) sum += u[-(ptrdiff_t)i * PJ];
    smem[tid] = sum / (float)n - u[0];
    __syncthreads();
    const float* pw = p.pool_w + ((size_t)l * 4 + g) * 64 * 64 + c;
    float acc = 0.f;
    for (int i = 0; i < 64; ++i) acc += smem[g * 64 + i] * pw[i * 64];
    p.h[(size_t)t * D + 768 + tid] = acc * p.pool_scale[l * PLW + tid];
    __syncthreads();
}

__device__ __forceinline__ void st_outproj(const P& p, int l, int vb, float* smem) {
    const int ntn = D / 64, tm = vb / ntn, tn = vb % ntn;
    const float* A = p.h; const float* B = p.w_out + (size_t)l * D * D;
    const float* xin = l == 0 ? p.x : p.xb;
    gemm64<1>(smem, T, D, D, tm, tn,
        [&](int m, int k) { return *(const float4*)(A + (size_t)m * D + k); },
        [&](int, int k, int n) { return *(const float4*)(B + (size_t)k * D + n); },
        [&](int m, int n, const float* v) {
            const float gt = p.mod[((size_t)l * 8 + m / SEQ) * 6144 + 2048 + n];
            p.xb[(size_t)m * D + n] = xin[(size_t)m * D + n] + gt * v[0];
        });
}

__device__ __forceinline__ void st_router(const P& p, int l, int vb, float* smem) {
    const int wv = threadIdx.x >> 6, lane = threadIdx.x & 63;
    const int t = vb * 4 + wv;
    float* sel = smem + wv * 192;
    float* gs = sel + 64;
    float* scs = sel + 128;
    const float* hr = p.h + (size_t)t * D;
    const float* wr = p.w_router + (size_t)l * D * NE + lane;
    float acc = 0.f;
    for (int k = 0; k < D; k += 4) {
        const float4 h4 = *(const float4*)(hr + k);
        acc += h4.x * wr[(size_t)k * NE] + h4.y * wr[(size_t)(k + 1) * NE] + h4.z * wr[(size_t)(k + 2) * NE] + h4.w * wr[(size_t)(k + 3) * NE];
    }
    const float score = sigmoidf_(acc);
    const float sl = score + p.b_router[l * NE + lane];
    sel[lane] = sl; scs[lane] = score;
    __syncthreads();
    if (lane < 8) {
        float m1 = -INFINITY, m2 = -INFINITY;
        for (int i = 0; i < 8; ++i) { const float v = sel[lane * 8 + i]; if (v > m1) { m2 = m1; m1 = v; } else if (v > m2) m2 = v; }
        gs[lane] = m1 + m2;
    }
    __syncthreads();
    const int gI = lane >> 3;
    int grank = 0;
    for (int i = 0; i < 8; ++i) { const float v = gs[i]; grank += (v > gs[gI] || (v == gs[gI] && i < gI)) ? 1 : 0; }
    const bool gsel = grank < 4;
    const float msk = gsel ? sl : -INFINITY;
    __syncthreads();
    sel[lane] = msk;
    __syncthreads();
    int rank = 0;
    for (int i = 0; i < 64; ++i) { const float v = sel[i]; rank += (v > msk || (v == msk && i < lane)) ? 1 : 0; }
    const bool chosen = rank < TOPK;
    const float wsum = wave_sum(chosen ? score : 0.f);
    if (chosen) {
        const int pos = atomicAdd(&p.cnt[lane], 1);
        p.list[(size_t)lane * T + pos] = t * TOPK + rank;
        p.topw[(size_t)t * TOPK + rank] = score / (wsum + 1e-20f) * 2.5f;
    }
    __syncthreads();
}

__device__ __forceinline__ void st_exp1(const P& p, int l, int vb, float* smem) {
    const int tn = vb & 3, mt = (vb >> 2) & 255, e = vb >> 10;
    const int cnt = e < NE ? p.cnt[e] : T;
    if (mt * 64 >= cnt) return;
    const float* Wg = e < NE ? p.w_eg + ((size_t)l * NE + e) * D * ED : p.w_sg + (size_t)l * D * ED;
    const float* Wu = e < NE ? p.w_eu + ((size_t)l * NE + e) * D * ED : p.w_su + (size_t)l * D * ED;
    const int* lst = p.list + (size_t)e * T;
    gemm64<2>(smem, cnt, ED, D, mt, tn,
        [&](int m, int k) { const int tok = e < NE ? lst[m] / TOPK : m; return *(const float4*)(p.h + (size_t)tok * D + k); },
        [&](int q, int k, int n) { return *(const float4*)((q ? Wu : Wg) + (size_t)k * ED + n); },
        [&](int m, int n, const float* v) { const int aid = e < NE ? lst[m] : T * TOPK + m; p.hm[(size_t)aid * ED + n] = siluf_(v[0]) * v[1]; });
}
__device__ __forceinline__ void st_exp2(const P& p, int l, int vb, float* smem) {
    const int tn = vb & 15, mt = (vb >> 4) & 255, e = vb >> 12;
    const int cnt = e < NE ? p.cnt[e] : T;
    if (mt * 64 >= cnt) return;
    const float* Wd = e < NE ? p.w_ed + ((size_t)l * NE + e) * ED * D : p.w_sd + (size_t)l * ED * D;
    const int* lst = p.list + (size_t)e * T;
    gemm64<1>(smem, cnt, D, ED, mt, tn,
        [&](int m, int k) { const int aid = e < NE ? lst[m] : T * TOPK + m; return *(const float4*)(p.hm + (size_t)aid * ED + k); },
        [&](int, int k, int n) { return *(const float4*)(Wd + (size_t)k * D + n); },
        [&](int m, int n, const float* v) {
            int tok; float w;
            if (e < NE) { const int aid = lst[m]; tok = aid / TOPK; w = p.topw[aid]; } else { tok = m; w = 1.f; }
            atomicAdd(&p.ffn[(size_t)tok * D + n], v[0] * w);
        });
}
__device__ __forceinline__ void st_combine(const P& p, int l, int vb) {
    const int wv = threadIdx.x >> 6, lane = threadIdx.x & 63;
    const int t = vb * 4 + wv, b = t / SEQ;
    const float* gt = p.mod + ((size_t)l * 8 + b) * 6144 + 5120;
#pragma unroll
    for (int i = 0; i < 4; ++i) {
        const int cidx = i * 256 + lane * 4;
        const float4 f = *(const float4*)(p.ffn + (size_t)t * D + cidx);
        const float4 g = *(const float4*)(gt + cidx);
        float4 xv = *(const float4*)(p.xb + (size_t)t * D + cidx);
        xv.x += g.x * f.x; xv.y += g.y * f.y; xv.z += g.z * f.z; xv.w += g.w * f.w;
        *(float4*)(p.xb + (size_t)t * D + cidx) = xv;
    }
}

__device__ __forceinline__ void run_stage(const P& p, int st, int l, int vb, float* smem) {
    switch (st) {
        case ST_MOD: st_mod(p, vb, smem); break;
        case ST_NORM1: st_norm(p, l, 0, vb); break;
        case ST_INPROJ: if (vb < (T / 64) * (INC / 64)) st_inproj(p, l, vb, smem); else st_vres(p, vb - (T / 64) * (INC / 64), smem); break;
        case ST_VRES: st_vres(p, vb, smem); break;
        case ST_PREP: st_prep(p, l, vb, smem); break;
        case ST_SCAN: st_scan(p, vb); break;
        case ST_RWOUT: st_rwout(p, l, vb); break;
        case ST_ATTN: st_attn(p, l, vb); break;
        case ST_POOL: st_pool(p, l, vb, smem); break;
        case ST_OUTPROJ: st_outproj(p, l, vb, smem); break;
        case ST_NORM2: st_norm(p, l, 1, vb); break;
        case ST_ROUTER: st_router(p, l, vb, smem); break;
        case ST_EXP1: st_exp1(p, l, vb, smem); break;
        case ST_EXP2: st_exp2(p, l, vb, smem); break;
        case ST_COMBINE: st_combine(p, l, vb); break;
        case ST_FINAL: st_norm(p, 0, 2, vb); break;
        case ST_MIX: {
            const int n1 = NBATCH * 6 / 4, n2 = NBATCH * 6 * (SEQ / 32) / 4;
            if (vb < n1) st_scan(p, vb); else if (vb < n1 + n2) st_attn(p, l, vb - n1); else st_pool(p, l, vb - n1 - n2, smem);
        } break;
    }
}

__global__ void __launch_bounds__(256) k_stage(P p, int st, int l) {
    __shared__ __attribute__((aligned(16))) float smem[8 * 1024];
    const int nvb = stage_nvb(st);
    for (int vb = blockIdx.x; vb < nvb; vb += gridDim.x) run_stage(p, st, l, vb, smem);
}


#define XB_TMO      128
#define XB_XCNT(j)  (256  + 64 * (j))
#define XB_XSUB(j)  (1280 + 64 * (j))
#define XB_XGEN(j)  (2304 + 64 * (j))
#define XB_TOP      3328
#define XB_TOPGEN   3392
#define XCD_BAR_WORDS 3456
#define XB_SPIN_CAP (1u << 22)
#define LAS __attribute__((address_space(3)))
__device__ __forceinline__ unsigned xb_ld(unsigned* p)              { return __hip_atomic_load(p, __ATOMIC_RELAXED, __HIP_MEMORY_SCOPE_AGENT); }
__device__ __forceinline__ unsigned xb_add(unsigned* p, unsigned v) { return __hip_atomic_fetch_add(p, v, __ATOMIC_RELAXED, __HIP_MEMORY_SCOPE_AGENT); }
__device__ __forceinline__ unsigned xb_xcc_id() { return (unsigned)__builtin_amdgcn_s_getreg((3 << 11) | 20) & 0xFu; }
#define XB_SPIN(cond, bar) do { unsigned _sp = 0; while (cond) { __builtin_amdgcn_s_sleep(1); \
    if ((++_sp & 255u) == 0u) { if (xb_ld(&(bar)[XB_TMO])) break; if (_sp > XB_SPIN_CAP) { atomicAdd(&(bar)[XB_TMO], 1u); break; } } } } while (0)
struct XcdBarrier { unsigned* bar; unsigned x; volatile LAS unsigned* st; };
__device__ __forceinline__ XcdBarrier xcd_barrier_post(unsigned* bar, volatile LAS unsigned* st) {
    XcdBarrier b; b.bar = bar; b.x = xb_xcc_id(); b.st = st;
    if (threadIdx.x == 0) (void)xb_add(&bar[XB_XCNT(b.x)], 1u);
    return b;
}
__device__ __forceinline__ void xcd_barrier_complete(unsigned* bar, unsigned x, unsigned& nloc, unsigned& nx) {
    const unsigned G = gridDim.x * gridDim.y * gridDim.z;
    unsigned sum, cnt, mine, sp = 0u;
    for (;;) {
        sum = 0u; cnt = 0u; mine = 0u;
#pragma unroll
        for (unsigned j = 0; j < 16; ++j) { const unsigned c = xb_ld(&bar[XB_XCNT(j)]); sum += c; cnt += (c > 0u) ? 1u : 0u; mine = (j == x) ? c : mine; }
        if (sum == G) break;
        __builtin_amdgcn_s_sleep(1);
        if ((++sp & 255u) == 0u) { if (xb_ld(&bar[XB_TMO])) break; if (sp > XB_SPIN_CAP) { atomicAdd(&bar[XB_TMO], 1u); break; } }
    }
    nloc = mine > 0u ? mine : 1u; nx = cnt > 0u ? cnt : 1u;
}
__device__ __forceinline__ void xcd_barrier(const XcdBarrier& b) {
    asm volatile("s_waitcnt vmcnt(0)" ::: "memory");
    __syncthreads();
    if (threadIdx.x == 0) {
        unsigned* bar = b.bar;
        __builtin_amdgcn_s_waitcnt(0);
        unsigned nloc = b.st[0], nx = b.st[1];
        if (nloc == 0u) { xcd_barrier_complete(bar, b.x, nloc, nx); b.st[0] = nloc; b.st[1] = nx; }
        const unsigned old = xb_add(&bar[XB_XSUB(b.x)], 1u);
        const unsigned gen = old / nloc;
        if (old + 1u == (gen + 1u) * nloc) {
            __builtin_amdgcn_fence(__ATOMIC_RELEASE, "agent");
            asm volatile("s_waitcnt vmcnt(0)" ::: "memory");
            const unsigned og = xb_add(&bar[XB_TOP], 1u);
            const unsigned tg = og / nx;
            if (og + 1u == (tg + 1u) * nx) xb_add(&bar[XB_TOPGEN], 1u);
            else XB_SPIN(xb_ld(&bar[XB_TOPGEN]) == tg, bar);
            __builtin_amdgcn_fence(__ATOMIC_ACQUIRE, "agent");
            xb_add(&bar[XB_XGEN(b.x)], 1u);
            asm volatile("s_waitcnt vmcnt(0)" ::: "memory");
        } else {
            XB_SPIN(xb_ld(&bar[XB_XGEN(b.x)]) == gen, bar);
            __builtin_amdgcn_fence(__ATOMIC_ACQUIRE, "agent");
            asm volatile("s_waitcnt vmcnt(0)" ::: "memory");
        }
    }
    __syncthreads();
}

__global__ void __launch_bounds__(256) k_fused(P p, unsigned* bar) {
    __shared__ __attribute__((aligned(16))) float smem[8 * 1024 + 4];
    if (threadIdx.x < 4) ((unsigned*)smem)[8 * 1024 + threadIdx.x] = 0u;
    __syncthreads();
    XcdBarrier xb = xcd_barrier_post(bar, (volatile LAS unsigned*)(smem + 8 * 1024));
    for (int ph = 0; ph < 24; ++ph) {
        int st, l = 0;
        if (ph == 0) st = ST_MOD;
        else if (ph == 23) st = ST_FINAL;
        else {
            l = (ph - 1) / 11;
            const int idx = (ph - 1) % 11;
            const int tab[11] = {ST_NORM1, ST_INPROJ, ST_PREP, ST_MIX, ST_RWOUT, ST_OUTPROJ, ST_NORM2, ST_ROUTER, ST_EXP1, ST_EXP2, ST_COMBINE};
            st = ST_NORM1;
#pragma unroll
            for (int i = 0; i < 11; ++i) if (idx == i) st = tab[i];
        }
        int nvb = stage_nvb(st);
        if (st == ST_INPROJ && l == 1) nvb += stage_nvb(ST_VRES);
        for (int vb = blockIdx.x; vb < nvb; vb += gridDim.x) run_stage(p, st, l, vb, smem);
        if (ph != 23) xcd_barrier(xb);
    }
}

int host_nvb(int st) {
    switch (st) {
        case ST_MOD: return NL * 24;
        case ST_NORM1: case ST_NORM2: case ST_FINAL: return T / 4;
        case ST_INPROJ: return (T / 64) * (INC / 64);
        case ST_VRES: return T / 64;
        case ST_PREP: return T;
        case ST_SCAN: return NBATCH * 6 / 4;
        case ST_RWOUT: return T * 6 / 4;
        case ST_ATTN: return NBATCH * 6 * (SEQ / 32) / 4;
        case ST_POOL: return T;
        case ST_OUTPROJ: return (T / 64) * (D / 64);
        case ST_ROUTER: return T / 4;
        case ST_EXP1: return 65 * 256 * 4;
        case ST_EXP2: return 65 * 256 * 16;
        case ST_COMBINE: return T / 4;
    }
    return 0;
}

}

extern "C" void kernel_launch(void* const* d_in, const int* in_sizes, int n_in, void* d_out, int out_size, void* d_ws, size_t ws_size,
                              hipStream_t stream) {
    P p{};
    const float** fp = (const float**)&p;
    for (int i = 0; i < 33; ++i) fp[i] = (const float*)d_in[i];
    p.out = (float*)d_out;
    char* ws = (char*)d_ws;
    size_t off = 0;
    auto take = [&](size_t bytes) { char* r = ws + off; off += (bytes + 255) & ~(size_t)255; return r; };
    p.mod = (float*)take((size_t)NL * 8 * 6144 * 4);
    p.cnt = (int*)take(64 * 4);
    p.list = (int*)take((size_t)NE * T * 4);
    p.topw = (float*)take((size_t)T * TOPK * 4);
    p.xb = (float*)take((size_t)T * D * 4);
    p.h = (float*)take((size_t)T * D * 4);
    p.vfirst = (float*)take((size_t)T * RWW * 4);
    p.proj = (float*)take((size_t)T * PJ * 4);
    p.hm = p.proj;
    p.r = (float*)take((size_t)T * RWW * 4);
    p.ffn = p.r;
    p.w = (float*)take((size_t)T * RWW * 4);
    p.k = (float*)take((size_t)T * RWW * 4);
    p.v = (float*)take((size_t)T * RWW * 4);
    p.na = (float*)take((size_t)T * RWW * 4);
    p.bb = (float*)take((size_t)T * RWW * 4);
    p.g = (float*)take((size_t)T * RWW * 4);
    p.y = (float*)take((size_t)T * RWW * 4);

    unsigned* bar = (unsigned*)take(XCD_BAR_WORDS * 4);
#if FUSED
    hipMemsetAsync(bar, 0, XCD_BAR_WORDS * 4, stream);
    int dev = 0, cus = 0;
    hipGetDevice(&dev);
    hipDeviceGetAttribute(&cus, hipDeviceAttributeMultiprocessorCount, dev);
    if (cus <= 0) cus = 256;
    void* args[] = {(void*)&p, (void*)&bar};
    hipLaunchCooperativeKernel((const void*)k_fused, dim3(cus), dim3(256), args, 0, stream);
#else
    auto launch = [&](int st, int l) {
        int nvb = host_nvb(st);
        hipLaunchKernelGGL(k_stage, dim3(nvb), dim3(256), 0, stream, p, st, l);
    };
    launch(ST_MOD, 0);
    for (int l = 0; l < NL; ++l) {
        launch(ST_NORM1, l);
        launch(ST_INPROJ, l);
        if (l == 1) launch(ST_VRES, l);
        launch(ST_PREP, l);
        launch(ST_SCAN, l);
        launch(ST_RWOUT, l);
        launch(ST_ATTN, l);
        launch(ST_POOL, l);
        launch(ST_OUTPROJ, l);
        launch(ST_NORM2, l);
        launch(ST_ROUTER, l);
        launch(ST_EXP1, l);
        launch(ST_EXP2, l);
        launch(ST_COMBINE, l);
    }
    launch(ST_FINAL, 0);
#endif
}
```

```cpp
#include <hip/hip_runtime.h>
#include <stdint.h>

namespace {

typedef unsigned short bf16_t;
typedef short bf16x8 __attribute__((ext_vector_type(8)));
typedef float f32x4 __attribute__((ext_vector_type(4)));
typedef unsigned u32x4 __attribute__((ext_vector_type(4)));
typedef unsigned u32x2 __attribute__((ext_vector_type(2)));
#define LAS __attribute__((address_space(3)))

constexpr int D = 1024, NBATCH = 8, SEQ = 2048, T = NBATCH * SEQ, NL = 2;
constexpr int RWW = 384, SBW = 384, PLW = 256;
constexpr int RWC = 1280, SBC = 1152, INC = 2688;
constexpr int PJB = 2816;
constexpr int NE = 64, TOPK = 6, ED = 256;
constexpr int MAXRT = 512;
constexpr int NTHREADS = 512;
constexpr int LDS_STAGE = 131072, LDS_CTL = 1024, LDS_BYTES = LDS_STAGE + LDS_CTL;

struct P {
    const float *x, *c, *w_ada, *b_ada, *w_in, *w_vres, *mu_rw, *mu_vres, *rw_w0, *rw_w2, *rw_a0, *rw_a2,
        *rw_v0, *rw_v2, *rw_g2, *rw_k_k, *rw_k_a, *rw_r_k, *rw_ln_g, *rw_ln_b, *sb_norm_g, *pool_w, *pool_scale,
        *w_out, *w_router, *b_router, *w_eg, *w_eu, *w_ed, *w_sg, *w_su, *w_sd, *g_final;
    float* out;
    unsigned* bar;
    float* mod;
    int* cnt;
    int* list;
    float* topw;
    bf16_t* wt_in;
    bf16_t* wt_out;
    bf16_t* wt1;
    bf16_t* wt2;
    float* xb;
    bf16_t* h;
    float* vfirst;
    bf16_t* proj;
    float *r, *w, *k, *v, *na, *bb, *g;
    bf16_t* hm;
    bf16_t* slab;
};

__device__ __forceinline__ int opaque(int x) { asm volatile("" : "+v"(x)); return x; }
__device__ __forceinline__ float wave_sum(float v) {
#pragma unroll
    for (int o = 32; o > 0; o >>= 1) v += __shfl_xor(v, o);
    return v;
}
__device__ __forceinline__ float sigmoidf_(float x) { return 1.f / (1.f + __expf(-x)); }
__device__ __forceinline__ float softplusf_(float x) { return fmaxf(x, 0.f) + log1pf(__expf(-fabsf(x))); }
__device__ __forceinline__ float siluf_(float x) { return x / (1.f + __expf(-x)); }
__device__ __forceinline__ unsigned f2bf(float f) { unsigned u = __builtin_bit_cast(unsigned, f); return (u + 0x7fffu + ((u >> 16) & 1u)) >> 16; }
__device__ __forceinline__ unsigned pk2(float lo, float hi) { return f2bf(lo) | (f2bf(hi) << 16); }
__device__ __forceinline__ float bf2f(bf16_t h) { return __builtin_bit_cast(float, (unsigned)h << 16); }
__device__ __forceinline__ float bflo(unsigned u) { return __builtin_bit_cast(float, u << 16); }
__device__ __forceinline__ float bfhi(unsigned u) { return __builtin_bit_cast(float, u & 0xffff0000u); }

namespace pg8 {
constexpr int BM = 256, BK = 64, HALF = 128, HTB = HALF * BK * 2, STAGE_BYTES = 8 * HTB;
__device__ __forceinline__ int lds_byte(int r, int c) { const int st = (r >> 4) * 2 + (c >> 5), rr = r & 15, cc = c & 31, ob = rr * 64 + cc * 2; return st * 1024 + (ob ^ (((ob >> 9) & 1) << 5)); }
__device__ __forceinline__ void stage_rc(int b, int& R, int& C) { const int st = b / 1024, sb = b % 1024, swz = sb ^ (((sb >> 9) & 1) << 5); R = (st >> 1) * 16 + swz / 64; C = (st & 1) * 32 + (swz % 64) / 2; }
__device__ __forceinline__ int perm32(int rho) { const int n = rho >> 4, i = rho & 15; return 8 * (i >> 2) + 4 * n + (i & 3); }

struct Unit { int pm, pn, e, mt; };

template <class Epi, class Sched, bool ALIGN_EPI, bool SP2>
__device__ __forceinline__ void gemm_phase(LAS unsigned char* lds, const int K, const Sched& S, const Epi& E) {
    const int tid = opaque(threadIdx.x), wid = __builtin_amdgcn_readfirstlane(tid >> 6), lane = tid & 63, wr = wid >> 2, wc = wid & 3, fr = lane & 15, fq = lane >> 4;
    const int nt = K / BK;
    unsigned voffA[2], voffB[2];
#pragma unroll
    for (int i = 0; i < 2; ++i) { int R, C; stage_rc(tid * 16 + i * 8192, R, C); const int Rb = Epi::PERM ? ((R & ~31) + perm32(R & 31)) : R;
        voffA[i] = Sched::GATHER ? (unsigned)(C * 2) : (unsigned)(R * K + C) * 2u; voffB[i] = (unsigned)(Rb * K + C) * 2u; }
    const size_t kstep = (size_t)(BK * 2);
    const size_t hstep = (size_t)HALF * K * 2;
    const unsigned ldsw = (unsigned)wid * 1024u;
    const int aoff = lds_byte(wr * 64 + fr, fq * 8), boff = lds_byte(wc * 32 + fr, fq * 8);
#define PG8_SA(b, h) (((b) * 2 + (h)) * HTB)
#define PG8_SB(b, h) ((4 + (b) * 2 + (h)) * HTB)
#define PG8_STAGE(bufoff, gbase, voff) do { _Pragma("unroll") for (int _i = 0; _i < 2; ++_i) \
        __builtin_amdgcn_global_load_lds((const unsigned*)((const char*)(gbase) + (voff)[_i]), (LAS unsigned*)(lds + (bufoff) + ldsw + _i * 8192), 16, 0, 0); } while (0)
#define PG8_LDA(dst, b, h) do { _Pragma("unroll") for (int m = 0; m < 4; ++m) _Pragma("unroll") for (int k = 0; k < 2; ++k) dst[m][k] = *(const LAS bf16x8*)(lds + PG8_SA(b, h) + aoff + m * 2048 + k * 1024); } while (0)
#define PG8_LDB(dst, b, h) do { _Pragma("unroll") for (int n = 0; n < 2; ++n) _Pragma("unroll") for (int k = 0; k < 2; ++k) dst[n][k] = *(const LAS bf16x8*)(lds + PG8_SB(b, h) + boff + n * 2048 + k * 1024); } while (0)
#define PG8_MMA(ai, bj, At, Bt) do { __builtin_amdgcn_s_setprio(1); _Pragma("unroll") for (int m = 0; m < 4; ++m) _Pragma("unroll") for (int n = 0; n < 2; ++n) _Pragma("unroll") for (int k = 0; k < 2; ++k) \
        acc[ai][bj][m][n] = __builtin_amdgcn_mfma_f32_16x16x32_bf16(Bt[n][k], At[m][k], acc[ai][bj][m][n], 0, 0, 0); __builtin_amdgcn_s_setprio(0); } while (0)
#define PG8_WAIT_V(n) asm volatile("s_waitcnt vmcnt(" #n ")" ::: "memory")
#define PG8_WAIT_L(n) asm volatile("s_waitcnt lgkmcnt(" #n ")" ::: "memory")
#define PG8_BAR __builtin_amdgcn_s_barrier()
#define PG8_SCHED __builtin_amdgcn_sched_barrier(0)
    Unit cur, nxt; int ui = 0;
    if (!S.next(0, cur)) return;
    f32x4 acc[2][2][4][2];
#pragma unroll
    for (int a = 0; a < 2; ++a)
#pragma unroll
        for (int b = 0; b < 2; ++b)
#pragma unroll
            for (int m = 0; m < 4; ++m)
#pragma unroll
                for (int n = 0; n < 2; ++n) acc[a][b][m][n] = (f32x4){0.f, 0.f, 0.f, 0.f};
    bf16x8 At[4][2], B0[2][2], B1[2][2];
    const char* cA = S.a_base(cur); const char* cB = S.b_base(cur);
    unsigned pk[2] = {0u, 0u}, npk[2] = {0u, 0u};
    if constexpr (Sched::GATHER) S.a_tok(cur, tid, pk);
    const unsigned k2 = (unsigned)K * 2u;
#define PG8_STAGE_A(bufoff, gbase, hh, PK) do { if constexpr (Sched::GATHER) { unsigned _v[2]; _v[0] = (((PK)[0] >> (16 * (hh))) & 0xffffu) * k2 + voffA[0]; _v[1] = (((PK)[1] >> (16 * (hh))) & 0xffffu) * k2 + voffA[1]; \
        PG8_STAGE(bufoff, gbase, _v); } else { PG8_STAGE(bufoff, (gbase) + (hh) * hstep, voffA); } } while (0)
    static_assert(SP2, "only the SP2 loop is kept");
    PG8_STAGE(PG8_SB(0, 0), cB, voffB); PG8_STAGE(PG8_SB(0, 1), cB + hstep, voffB); PG8_STAGE_A(PG8_SA(0, 0), cA, 0, pk); PG8_STAGE_A(PG8_SA(0, 1), cA, 1, pk);
    if (wr == 1) PG8_BAR;
    PG8_WAIT_V(2); PG8_BAR;
    PG8_STAGE(PG8_SB(1, 0), cB + kstep, voffB); PG8_STAGE_A(PG8_SA(1, 0), cA + kstep, 0, pk); PG8_STAGE(PG8_SB(1, 1), cB + hstep + kstep, voffB);
    PG8_WAIT_V(6); PG8_BAR;
    for (;;) {
        const bool has_next = S.next(ui + 1, nxt);
        const char* nA = has_next ? S.a_base(nxt) : cA; const char* nB = has_next ? S.b_base(nxt) : cB;
        if constexpr (Sched::GATHER) { if (has_next) S.a_tok(nxt, tid, npk); else { npk[0] = pk[0]; npk[1] = pk[1]; } }
#pragma unroll 1
        for (int t = 0; t < nt; t += 2) {
            const bool last = (t == nt - 2);
            const char* a1 = cA + (size_t)(t + 1) * kstep;
            const char* a2 = last ? nA : cA + (size_t)(t + 2) * kstep; const char* b2 = last ? nB : cB + (size_t)(t + 2) * kstep;
            const char* a3 = a2 + kstep; const char* b3 = b2 + kstep;
            unsigned sp[2]; sp[0] = last ? npk[0] : pk[0]; sp[1] = last ? npk[1] : pk[1];
            PG8_LDB(B0, 0, 0); PG8_LDB(B1, 0, 1); PG8_SCHED; PG8_LDA(At, 0, 0); PG8_STAGE_A(PG8_SA(1, 1), a1, 1, pk);
            PG8_WAIT_V(8); PG8_WAIT_L(0); PG8_BAR; PG8_MMA(0, 0, At, B0); PG8_MMA(0, 1, At, B1); PG8_BAR; PG8_SCHED;
            PG8_LDA(At, 0, 1); PG8_STAGE(PG8_SB(0, 0), b2, voffB); PG8_STAGE(PG8_SB(0, 1), b2 + hstep, voffB); PG8_STAGE_A(PG8_SA(0, 0), a2, 0, sp);
            PG8_WAIT_V(8); PG8_WAIT_L(0); PG8_BAR; PG8_MMA(1, 0, At, B0); PG8_MMA(1, 1, At, B1); PG8_BAR; PG8_SCHED;
            PG8_LDB(B0, 1, 0); PG8_LDB(B1, 1, 1); PG8_SCHED; PG8_LDA(At, 1, 0); PG8_STAGE_A(PG8_SA(0, 1), a2, 1, sp);
            PG8_WAIT_V(8); PG8_WAIT_L(0); PG8_BAR; PG8_MMA(0, 0, At, B0); PG8_MMA(0, 1, At, B1); PG8_BAR; PG8_SCHED;
            PG8_LDA(At, 1, 1); PG8_STAGE(PG8_SB(1, 0), b3, voffB); PG8_STAGE(PG8_SB(1, 1), b3 + hstep, voffB); PG8_STAGE_A(PG8_SA(1, 0), a3, 0, sp);
            PG8_WAIT_V(8); PG8_WAIT_L(0); PG8_BAR; PG8_MMA(1, 0, At, B0); PG8_MMA(1, 1, At, B1); PG8_BAR; PG8_SCHED;
        }
        if constexpr (ALIGN_EPI) { if (wr == 0) PG8_BAR; }
        { const int t2 = opaque(threadIdx.x), w2 = __builtin_amdgcn_readfirstlane(t2 >> 6), l2 = t2 & 63; E(acc, cur, w2 >> 2, w2 & 3, l2 & 15, l2 >> 4); }
        if (!has_next) break;
#pragma unroll
        for (int a = 0; a < 2; ++a)
#pragma unroll
            for (int b = 0; b < 2; ++b)
#pragma unroll
                for (int m = 0; m < 4; ++m)
#pragma unroll
                    for (int n = 0; n < 2; ++n) acc[a][b][m][n] = (f32x4){0.f, 0.f, 0.f, 0.f};
        cur = nxt; cA = nA; cB = nB; ++ui;
        pk[0] = npk[0]; pk[1] = npk[1];
        if constexpr (ALIGN_EPI) { if (wr == 1) PG8_BAR; }
    }
    PG8_WAIT_V(0);
    if constexpr (!ALIGN_EPI) { if (wr == 0) PG8_BAR; }
    PG8_BAR;
#undef PG8_SA
#undef PG8_SB
#undef PG8_STAGE
#undef PG8_STAGE_A
#undef PG8_LDA
#undef PG8_LDB
#undef PG8_MMA
#undef PG8_WAIT_V
#undef PG8_WAIT_L
#undef PG8_BAR
#undef PG8_SCHED
}

struct DenseOrder {
    const bf16_t* A; const bf16_t* Bt; int K; int nM, nN, nwg, G, c;
    __device__ __forceinline__ void init(const bf16_t* A_, const bf16_t* Bt_, int M, int N, int K_, int G_, int c_) { A = A_; Bt = Bt_; K = K_; nM = M / BM; nN = N / BM; nwg = nM * nN; G = G_; c = c_; }
    __device__ __forceinline__ bool next(int i, Unit& u) const {
        const long L = (long)i * G + c; if (L >= nwg) return false;
        int wgid = (int)L; { const int q = nwg / 8, r = nwg % 8, xcd = wgid % 8, off = wgid / 8; wgid = (xcd < r ? xcd * (q + 1) : r * (q + 1) + (xcd - r) * q) + off; }
        const int nig = 8 * nN, gid = wgid / nig, fm = gid * 8, gsz = (nM - fm) < 8 ? (nM - fm) : 8;
        u.pm = fm + ((wgid % nig) % gsz); u.pn = (wgid % nig) / gsz; u.e = 0; u.mt = 0; return true;
    }
    __device__ __forceinline__ const char* a_base(const Unit& u) const { return (const char*)A + (size_t)u.pm * BM * K * 2; }
    __device__ __forceinline__ const char* b_base(const Unit& u) const { return (const char*)Bt + (size_t)u.pn * BM * K * 2; }
    static constexpr bool GATHER = false;
    __device__ __forceinline__ void a_tok(const Unit&, int, unsigned (&)[2]) const {}
};

template <bool GATHER_>
struct MoeOrder {
    static constexpr bool GATHER = GATHER_;
    const LAS int* tstart;
    const LAS int* cnts;
    const int* list;
    const bf16_t* A;
    const bf16_t* Bt;
    int K, N, lognpn, G, c;
    __device__ __forceinline__ bool next(int i, Unit& u) const {
        const int L = i * G + c; const int total = __builtin_amdgcn_readfirstlane(tstart[65]) << lognpn; if (L >= total) return false;
        const int rt = L >> lognpn; u.pn = L & ((1 << lognpn) - 1); u.pm = rt;
        int e = 0;
        for (int j = 1; j < 65; ++j) e += (tstart[j] <= rt) ? 1 : 0;
        e = __builtin_amdgcn_readfirstlane(e);
        u.e = e; u.mt = rt - __builtin_amdgcn_readfirstlane(tstart[e]); return true;
    }
    __device__ __forceinline__ const char* a_base(const Unit& u) const { return GATHER ? (const char*)A : (const char*)A + (size_t)u.pm * BM * K * 2; }
    __device__ __forceinline__ const char* b_base(const Unit& u) const { return (const char*)Bt + ((size_t)u.e * N + (size_t)u.pn * BM) * K * 2; }
    __device__ __forceinline__ void a_tok(const Unit& u, int tid, unsigned (&pkv)[2]) const {
        const int ce = cnts[u.e];
#pragma unroll
        for (int i = 0; i < 2; ++i) {
            int R, C; stage_rc(tid * 16 + i * 8192, R, C); (void)C;
            unsigned v = 0u;
#pragma unroll
            for (int hh = 0; hh < 2; ++hh) {
                const int idx = u.mt * BM + hh * HALF + R;
                int tok = 0;
                if (idx < ce) tok = (u.e < NE) ? (list[(size_t)u.e * T + idx] / TOPK) : idx;
                v |= (unsigned)tok << (16 * hh);
            }
            pkv[i] = v;
        }
    }
};

struct EpiProj {
    static constexpr bool PERM = true;
    bf16_t* O;
    __device__ __forceinline__ void operator()(const f32x4 (&acc)[2][2][4][2], const Unit& u, int wr, int wc, int fr, int fq) const {
        const int row0 = u.pm * BM + wr * 64 + fr, col0 = u.pn * BM + wc * 32 + 8 * fq;
#pragma unroll
        for (int ai = 0; ai < 2; ++ai)
#pragma unroll
            for (int m = 0; m < 4; ++m) { bf16_t* rowp = O + (size_t)(row0 + ai * HALF + m * 16) * PJB + col0;
#pragma unroll
                for (int bj = 0; bj < 2; ++bj) { const f32x4 v0 = acc[ai][bj][m][0], v1 = acc[ai][bj][m][1];
                    u32x4 w; w.x = pk2(v0[0], v0[1]); w.y = pk2(v0[2], v0[3]); w.z = pk2(v1[0], v1[1]); w.w = pk2(v1[2], v1[3]);
                    *(u32x4*)(rowp + bj * HALF) = w; } }
    }
};
struct EpiOut {
    static constexpr bool PERM = false;
    const float* xin; float* xo; const float* gt;
    __device__ __forceinline__ void operator()(const f32x4 (&acc)[2][2][4][2], const Unit& u, int wr, int wc, int fr, int fq) const {
        const int row0 = u.pm * BM + wr * 64 + fr, col0 = u.pn * BM + wc * 32 + 4 * fq;
#pragma unroll
        for (int ai = 0; ai < 2; ++ai)
#pragma unroll
            for (int m = 0; m < 4; ++m) { const int row = row0 + ai * HALF + m * 16; const float* gr = gt + (size_t)(row / SEQ) * 6144;
#pragma unroll
                for (int bj = 0; bj < 2; ++bj)
#pragma unroll
                    for (int n = 0; n < 2; ++n) { const int col = col0 + bj * HALF + 16 * n;
                        const f32x4 xi = *(const f32x4*)(xin + (size_t)row * D + col); const f32x4 gg = *(const f32x4*)(gr + col);
                        *(f32x4*)(xo + (size_t)row * D + col) = xi + gg * acc[ai][bj][m][n]; } }
    }
};
struct EpiExp1 {
    static constexpr bool PERM = true;
    bf16_t* hm;
    __device__ __forceinline__ void operator()(const f32x4 (&acc)[2][2][4][2], const Unit& u, int wr, int wc, int fr, int fq) const {
        const int row0 = u.pm * BM + wr * 64 + fr, col0 = u.pn * HALF + wc * 32 + 8 * fq;
#pragma unroll
        for (int ai = 0; ai < 2; ++ai)
#pragma unroll
            for (int m = 0; m < 4; ++m) { bf16_t* rowp = hm + (size_t)(row0 + ai * HALF + m * 16) * ED + col0;
                float o[8];
#pragma unroll
                for (int n = 0; n < 2; ++n)
#pragma unroll
                    for (int j = 0; j < 4; ++j) o[n * 4 + j] = siluf_(acc[ai][0][m][n][j]) * acc[ai][1][m][n][j];
                u32x4 w; w.x = pk2(o[0], o[1]); w.y = pk2(o[2], o[3]); w.z = pk2(o[4], o[5]); w.w = pk2(o[6], o[7]);
                *(u32x4*)rowp = w; }
    }
};
struct EpiExp2 {
    static constexpr bool PERM = true;
    bf16_t* slab; float* xb; const float* gt; const int* list; const float* topw; const LAS int* cnts;
    __device__ __forceinline__ void operator()(const f32x4 (&acc)[2][2][4][2], const Unit& u, int wr, int wc, int fr, int fq) const {
        const int col0 = u.pn * BM + wc * 32 + 8 * fq; const int ce = cnts[u.e];
#pragma unroll
        for (int ai = 0; ai < 2; ++ai)
#pragma unroll
            for (int m = 0; m < 4; ++m) { const int idx = u.mt * BM + ai * HALF + wr * 64 + m * 16 + fr;
                if (idx < ce) {
                    if (u.e < NE) {
                        const int aid = list[(size_t)u.e * T + idx]; const float wgt = topw[aid]; bf16_t* rowp = slab + (size_t)aid * D + col0;
#pragma unroll
                        for (int bj = 0; bj < 2; ++bj) { const f32x4 v0 = acc[ai][bj][m][0] * wgt, v1 = acc[ai][bj][m][1] * wgt;
                            u32x4 w; w.x = pk2(v0[0], v0[1]); w.y = pk2(v0[2], v0[3]); w.z = pk2(v1[0], v1[1]); w.w = pk2(v1[2], v1[3]);
                            *(u32x4*)(rowp + bj * HALF) = w; }
                    } else {
                        const int tok = idx; float* xr = xb + (size_t)tok * D + col0; const float* gr = gt + (size_t)(tok / SEQ) * 6144 + col0;
#pragma unroll
                        for (int bj = 0; bj < 2; ++bj)
#pragma unroll
                            for (int n = 0; n < 2; ++n) { const f32x4 xi = *(const f32x4*)(xr + bj * HALF + 4 * n); const f32x4 gg = *(const f32x4*)(gr + bj * HALF + 4 * n);
                                *(f32x4*)(xr + bj * HALF + 4 * n) = xi + gg * acc[ai][bj][m][n]; }
                    }
                } }
    }
};
}

__device__ __forceinline__ void st_mod(const P& p, int vb, float* smem) {
    const int tid = opaque(threadIdx.x) & 255;
    const int l = vb / 24, j = (vb % 24) * 256 + tid;
    float* sc = smem;
    for (int i = tid; i < 8 * 1024; i += 256) sc[i] = siluf_(p.c[i]);
    __syncthreads();
    float acc[8];
#pragma unroll
    for (int b = 0; b < 8; ++b) acc[b] = 0.f;
    const float* w = p.w_ada + (size_t)l * 1024 * 6144 + j;
    for (int i = 0; i < 1024; ++i) {
        const float wv = w[(size_t)i * 6144];
#pragma unroll
        for (int b = 0; b < 8; ++b) acc[b] += sc[b * 1024 + i] * wv;
    }
    const float bv = p.b_ada[l * 6144 + j];
#pragma unroll
    for (int b = 0; b < 8; ++b) p.mod[((size_t)l * 8 + b) * 6144 + j] = acc[b] + bv;
    __syncthreads();
}

__device__ __forceinline__ void st_norm(const P& p, int l, int which, int vb) {
    const int tid = opaque(threadIdx.x) & 255;
    const int wv = tid >> 6, lane = tid & 63;
    const int t = vb * 4 + wv, b = t / SEQ;
    const float* xin = (l == 0 && which == 0) ? p.x : p.xb;
    const float* xr = xin + (size_t)t * D;
    float vals[16];
    float ss = 0.f;
#pragma unroll
    for (int i = 0; i < 4; ++i) {
        const float4 q = *(const float4*)(xr + i * 256 + lane * 4);
        vals[i * 4 + 0] = q.x; vals[i * 4 + 1] = q.y; vals[i * 4 + 2] = q.z; vals[i * 4 + 3] = q.w;
        ss += q.x * q.x + q.y * q.y + q.z * q.z + q.w * q.w;
    }
    ss = wave_sum(ss);
    const float rs = rsqrtf(ss * (1.f / D) + 1e-6f);
    if (which == 2) {
#pragma unroll
        for (int i = 0; i < 4; ++i) {
            const int cidx = i * 256 + lane * 4;
            const float4 gq = *(const float4*)(p.g_final + cidx);
            float4 o;
            o.x = vals[i * 4 + 0] * rs * gq.x; o.y = vals[i * 4 + 1] * rs * gq.y; o.z = vals[i * 4 + 2] * rs * gq.z; o.w = vals[i * 4 + 3] * rs * gq.w;
            *(float4*)(p.out + (size_t)t * D + cidx) = o;
        }
        return;
    }
    const float* md = p.mod + ((size_t)l * 8 + b) * 6144 + (which ? 3072 : 0);
#pragma unroll
    for (int i = 0; i < 4; ++i) {
        const int cidx = i * 256 + lane * 4;
        const float4 sh = *(const float4*)(md + cidx);
        const float4 sc = *(const float4*)(md + 1024 + cidx);
        u32x2 o;
        o.x = pk2(vals[i * 4 + 0] * rs * (1.f + sc.x) + sh.x, vals[i * 4 + 1] * rs * (1.f + sc.y) + sh.y);
        o.y = pk2(vals[i * 4 + 2] * rs * (1.f + sc.z) + sh.z, vals[i * 4 + 3] * rs * (1.f + sc.w) + sh.w);
        *(u32x2*)(p.h + (size_t)t * D + cidx) = o;
    }
    if (which == 1 && vb == 0 && tid < 64) p.cnt[tid] = 0;
}

__device__ __forceinline__ void st_prep(const P& p, int l, int vb, float* smem) {
    const int tid = opaque(threadIdx.x) & 255;
    const int t = vb, s = t % SEQ;
    float* Pp = smem;
    float* PV = smem + 1280;
    float* TW = smem + 1312;
    float* SG = smem + 1344;
    float* KK = smem + 1408;
    float* AA = smem + 1792;
    const bf16_t* u = p.proj + (size_t)t * PJB;
    const float* mu = p.mu_rw + l * RWC;
    for (int j = tid; j < RWC; j += 256) {
        const float uu = bf2f(u[j]), pv = s > 0 ? bf2f(u[j - PJB]) : 0.f;
        Pp[j] = uu + (pv - uu) * mu[j];
    }
    if (l == 1 && tid < 32) {
        const float uu = bf2f(u[INC + tid]), pv = s > 0 ? bf2f(u[INC + tid - PJB]) : 0.f;
        PV[tid] = uu + (pv - uu) * p.mu_vres[tid];
    }
    __syncthreads();
    if (tid < 32) TW[tid] = tanhf(Pp[1152 + tid]);
    if (tid >= 64 && tid < 128) SG[tid - 64] = sigmoidf_(Pp[1216 + tid - 64]);
    __syncthreads();
    for (int c = tid; c < RWW; c += 256) {
        float lw = p.rw_w0[l * RWW + c], la = p.rw_a0[l * RWW + c];
        const float* w2 = p.rw_w2 + (size_t)l * 32 * RWW + c;
        const float* a2 = p.rw_a2 + (size_t)l * 32 * RWW + c;
        for (int i = 0; i < 32; ++i) { lw += TW[i] * w2[i * RWW]; la += Pp[1184 + i] * a2[i * RWW]; }
        const float wlog = -softplusf_(-lw) - 0.5f;
        const float decay = __expf(-__expf(wlog));
        const float a = sigmoidf_(la);
        float v = Pp[768 + c];
        if (l == 1) {
            float lv = p.rw_v0[c];
            const float* v2 = p.rw_v2 + c;
            for (int i = 0; i < 32; ++i) lv += PV[i] * v2[i * RWW];
            const float vg = sigmoidf_(lv);
            v = v + (p.vfirst[(size_t)t * RWW + c] - v) * vg;
        } else {
            p.vfirst[(size_t)t * RWW + c] = v;
        }
        float g = 0.f;
        const float* g2 = p.rw_g2 + (size_t)l * 64 * RWW + c;
        for (int i = 0; i < 64; ++i) g += SG[i] * g2[i * RWW];
        const float k = Pp[384 + c];
        KK[c] = k * p.rw_k_k[l * RWW + c];
        AA[c] = a;
        const size_t o = (size_t)t * RWW + c;
        p.r[o] = Pp[c]; p.w[o] = decay; p.k[o] = k * (1.f + (a - 1.f) * p.rw_k_a[l * RWW + c]); p.v[o] = v; p.g[o] = g;
    }
    __syncthreads();
    for (int c = tid; c < RWW; c += 256) {
        const int h0 = (c >> 6) << 6;
        float ss = 0.f;
        for (int i = 0; i < 64; ++i) ss += KK[h0 + i] * KK[h0 + i];
        const float kk = KK[c] / fmaxf(sqrtf(ss), 1e-12f);
        const size_t o = (size_t)t * RWW + c;
        p.na[o] = -kk; p.bb[o] = kk * AA[c];
    }
    __syncthreads();
}

__device__ __forceinline__ void st_scan(const P& p, int vb) {
    const int tid = opaque(threadIdx.x) & 255;
    const int wv = __builtin_amdgcn_readfirstlane(tid >> 6), lane = tid & 63;
    const int bh = vb * 4 + wv, b = bh / 6, hh = bh % 6;
    float st[64];
#pragma unroll
    for (int j = 0; j < 64; ++j) st[j] = 0.f;
    size_t o = ((size_t)b * SEQ) * RWW + hh * 64 + lane;
    float rv = p.r[o], wvv = p.w[o], kv = p.k[o], av = p.na[o], bv = p.bb[o], vv = p.v[o];
    for (int s = 0; s < SEQ; ++s) {
        const size_t on = o + RWW;
        float rn = 0.f, wn = 0.f, kn = 0.f, an = 0.f, bn = 0.f, vn = 0.f;
        if (s + 1 < SEQ) { rn = p.r[on]; wn = p.w[on]; kn = p.k[on]; an = p.na[on]; bn = p.bb[on]; vn = p.v[on]; }
        float sa = 0.f;
#pragma unroll
        for (int j = 0; j < 64; ++j) sa += st[j] * __int_as_float(__builtin_amdgcn_readlane(__float_as_int(av), j));
        float yy = 0.f;
#pragma unroll
        for (int j = 0; j < 64; ++j) {
            const float wj = __int_as_float(__builtin_amdgcn_readlane(__float_as_int(wvv), j));
            const float bj = __int_as_float(__builtin_amdgcn_readlane(__float_as_int(bv), j));
            const float kj = __int_as_float(__builtin_amdgcn_readlane(__float_as_int(kv), j));
            const float rj = __int_as_float(__builtin_amdgcn_readlane(__float_as_int(rv), j));
            st[j] = st[j] * wj + sa * bj + vv * kj;
            yy += st[j] * rj;
        }
        p.na[o] = yy;
        o = on; rv = rn; wvv = wn; kv = kn; av = an; bv = bn; vv = vn;
    }
}

__device__ __forceinline__ void st_rwout(const P& p, int l, int vb) {
    const int tid = opaque(threadIdx.x) & 255;
    const int wv = tid >> 6, lane = tid & 63;
    const int item = vb * 4 + wv, t = item / 6, hh = item % 6;
    const int c = hh * 64 + lane;
    const size_t o = (size_t)t * RWW + c;
    const float y = p.na[o];
    const float mean = wave_sum(y) * (1.f / 64.f);
    const float d = y - mean;
    const float var = wave_sum(d * d) * (1.f / 64.f);
    const float yn = d * rsqrtf(var + 64e-5f) * p.rw_ln_g[l * RWW + c] + p.rw_ln_b[l * RWW + c];
    const float rk = wave_sum(p.r[o] * p.k[o] * p.rw_r_k[l * RWW + c]);
    const float outv = (yn + rk * p.v[o]) * p.g[o];
    p.h[(size_t)t * D + c] = (bf16_t)f2bf(outv);
}

__device__ __forceinline__ void st_attn(const P& p, int l, int vb) {
    const int tid = opaque(threadIdx.x) & 255;
    const int wv = __builtin_amdgcn_readfirstlane(tid >> 6), lane = tid & 63;
    const int item = vb * 4 + wv;
    const int qb = item % (SEQ / 32), bh = item / (SEQ / 32), b = bh / 6, hh = bh % 6;
    const int i = qb * 32 + (lane >> 1), hf = (lane & 1) * 32;
    const bf16_t* base = p.proj + (size_t)b * SEQ * PJB + RWC + hh * 64 + hf;
    float q[32], o[32];
    {
        const bf16_t* qp = base + (size_t)i * PJB;
#pragma unroll
        for (int d = 0; d < 32; d += 8) { const u32x4 t4 = *(const u32x4*)(qp + d);
            q[d] = bflo(t4.x) * 0.125f; q[d + 1] = bfhi(t4.x) * 0.125f; q[d + 2] = bflo(t4.y) * 0.125f; q[d + 3] = bfhi(t4.y) * 0.125f;
            q[d + 4] = bflo(t4.z) * 0.125f; q[d + 5] = bfhi(t4.z) * 0.125f; q[d + 6] = bflo(t4.w) * 0.125f; q[d + 7] = bfhi(t4.w) * 0.125f; }
    }
#pragma unroll
    for (int d = 0; d < 32; ++d) o[d] = 0.f;
    float R = 0.f;
    for (int j = qb * 32 + 30; j >= 0; --j) {
        const bf16_t* kp = base + (size_t)j * PJB + SBW;
        const bf16_t* vp = kp + SBW;
        float z = 0.f;
#pragma unroll
        for (int d = 0; d < 32; d += 8) { const u32x4 t4 = *(const u32x4*)(kp + d);
            z += q[d] * bflo(t4.x) + q[d + 1] * bfhi(t4.x) + q[d + 2] * bflo(t4.y) + q[d + 3] * bfhi(t4.y) + q[d + 4] * bflo(t4.z) + q[d + 5] * bfhi(t4.z) + q[d + 6] * bflo(t4.w) + q[d + 7] * bfhi(t4.w); }
        z += __shfl_xor(z, 1);
        const bool valid = i > j;
        const float l1p = log1pf(__expf(-fabsf(z)));
        const float logsig = fminf(z, 0.f) - l1p;
        const float lognot = -fmaxf(z, 0.f) - l1p;
        const float att = valid ? __expf(logsig + R) : 0.f;
        if (valid) R += lognot;
#pragma unroll
        for (int d = 0; d < 32; d += 8) { const u32x4 t4 = *(const u32x4*)(vp + d);
            o[d] += att * bflo(t4.x); o[d + 1] += att * bfhi(t4.x); o[d + 2] += att * bflo(t4.y); o[d + 3] += att * bfhi(t4.y);
            o[d + 4] += att * bflo(t4.z); o[d + 5] += att * bfhi(t4.z); o[d + 6] += att * bflo(t4.w); o[d + 7] += att * bfhi(t4.w); }
    }
    float ss = 0.f;
#pragma unroll
    for (int d = 0; d < 32; ++d) ss += o[d] * o[d];
    ss += __shfl_xor(ss, 1);
    const float rs = rsqrtf(ss * (1.f / 64.f) + 1e-6f);
    bf16_t* op = p.h + ((size_t)b * SEQ + i) * D + RWW + hh * 64 + hf;
    const float* gn = p.sb_norm_g + l * SBW + hh * 64 + hf;
#pragma unroll
    for (int d = 0; d < 32; d += 2) *(unsigned*)(op + d) = pk2(o[d] * rs * gn[d], o[d + 1] * rs * gn[d + 1]);
}

__device__ __forceinline__ void st_pool(const P& p, int l, int vb, float* smem) {
    const int tid = opaque(threadIdx.x) & 255;
    const int t = vb, s = t % SEQ, g = tid >> 6, c = tid & 63;
    const int win = 2 << g;
    const bf16_t* u = p.proj + (size_t)t * PJB + RWC + SBC + g * 64 + c;
    float sum = 0.f;
    const int n = min(s + 1, win);
    for (int i = 0; i < n; ++i) sum += bf2f(u[-(ptrdiff_t)i * PJB]);
    smem[tid] = sum / (float)n - bf2f(u[0]);
    __syncthreads();
    const float* pw = p.pool_w + ((size_t)l * 4 + g) * 64 * 64 + c;
    float acc = 0.f;
    for (int i = 0; i < 64; ++i) acc += smem[g * 64 + i] * pw[i * 64];
    p.h[(size_t)t * D + 768 + tid] = (bf16_t)f2bf(acc * p.pool_scale[l * PLW + tid]);
    __syncthreads();
}

__device__ __forceinline__ void st_router(const P& p, int l, int vb, float* smem) {
    const int tid = opaque(threadIdx.x) & 255;
    const int wv = tid >> 6, lane = tid & 63;
    const int t = vb * 4 + wv;
    float* sel = smem + wv * 192;
    float* gs = sel + 64;
    const bf16_t* hr = p.h + (size_t)t * D;
    const float* wr = p.w_router + (size_t)l * D * NE + lane;
    float acc = 0.f;
    for (int k = 0; k < D; k += 8) {
        const u32x4 h4 = *(const u32x4*)(hr + k);
        acc += bflo(h4.x) * wr[(size_t)k * NE] + bfhi(h4.x) * wr[(size_t)(k + 1) * NE] + bflo(h4.y) * wr[(size_t)(k + 2) * NE] + bfhi(h4.y) * wr[(size_t)(k + 3) * NE]
             + bflo(h4.z) * wr[(size_t)(k + 4) * NE] + bfhi(h4.z) * wr[(size_t)(k + 5) * NE] + bflo(h4.w) * wr[(size_t)(k + 6) * NE] + bfhi(h4.w) * wr[(size_t)(k + 7) * NE];
    }
    const float score = sigmoidf_(acc);
    const float sl = score + p.b_router[l * NE + lane];
    sel[lane] = sl;
    __syncthreads();
    if (lane < 8) {
        float m1 = -INFINITY, m2 = -INFINITY;
        for (int i = 0; i < 8; ++i) { const float v = sel[lane * 8 + i]; if (v > m1) { m2 = m1; m1 = v; } else if (v > m2) m2 = v; }
        gs[lane] = m1 + m2;
    }
    __syncthreads();
    const int gI = lane >> 3;
    int grank = 0;
    for (int i = 0; i < 8; ++i) { const float v = gs[i]; grank += (v > gs[gI] || (v == gs[gI] && i < gI)) ? 1 : 0; }
    const bool gsel = grank < 4;
    const float msk = gsel ? sl : -INFINITY;
    __syncthreads();
    sel[lane] = msk;
    __syncthreads();
    int rank = 0;
    for (int i = 0; i < 64; ++i) { const float v = sel[i]; rank += (v > msk || (v == msk && i < lane)) ? 1 : 0; }
    const bool chosen = rank < TOPK;
    const float wsum = wave_sum(chosen ? score : 0.f);
    if (chosen) {
        const int pos = atomicAdd(&p.cnt[lane], 1);
        p.list[(size_t)lane * T + pos] = t * TOPK + rank;
        p.topw[(size_t)t * TOPK + rank] = score / (wsum + 1e-20f) * 2.5f;
    }
    __syncthreads();
}

__device__ __forceinline__ void st_combine(const P& p, int l, int vb) {
    const int tid = opaque(threadIdx.x) & 255;
    const int wv = tid >> 6, lane = tid & 63;
    const int t = vb * 4 + wv, b = t / SEQ;
    const float* gt = p.mod + ((size_t)l * 8 + b) * 6144 + 5120;
    const bf16_t* sl = p.slab + (size_t)t * TOPK * D;
#pragma unroll
    for (int i = 0; i < 2; ++i) {
        const int cidx = i * 512 + lane * 8;
        float f[8];
#pragma unroll
        for (int j = 0; j < 8; ++j) f[j] = 0.f;
#pragma unroll
        for (int s = 0; s < TOPK; ++s) {
            const u32x4 q = *(const u32x4*)(sl + (size_t)s * D + cidx);
            f[0] += bflo(q.x); f[1] += bfhi(q.x); f[2] += bflo(q.y); f[3] += bfhi(q.y); f[4] += bflo(q.z); f[5] += bfhi(q.z); f[6] += bflo(q.w); f[7] += bfhi(q.w);
        }
        float* xr = p.xb + (size_t)t * D + cidx;
        float4 x0 = *(float4*)xr, x1 = *(float4*)(xr + 4);
        const float4 g0 = *(const float4*)(gt + cidx), g1 = *(const float4*)(gt + cidx + 4);
        x0.x += g0.x * f[0]; x0.y += g0.y * f[1]; x0.z += g0.z * f[2]; x0.w += g0.w * f[3];
        x1.x += g1.x * f[4]; x1.y += g1.y * f[5]; x1.z += g1.z * f[6]; x1.w += g1.w * f[7];
        *(float4*)xr = x0; *(float4*)(xr + 4) = x1;
    }
}

__device__ __forceinline__ void cvt_item(const float* W, int K, int N, int k0, int n0, bf16_t* WT, int dst_row0, LAS float* scr, int lane) {
#pragma unroll 8
    for (int i = 0; i < 32; ++i) { const int kk = 2 * i + (lane >> 5); scr[kk * 33 + (lane & 31)] = W[(size_t)(k0 + kk) * N + n0 + (lane & 31)]; }
    asm volatile("s_waitcnt lgkmcnt(0)" ::: "memory");
    const int c = lane & 7;
#pragma unroll
    for (int j = 0; j < 4; ++j) { const int n = (lane >> 3) + 8 * j; const LAS float* s = scr + (8 * c) * 33 + n;
        u32x4 o; o.x = pk2(s[0 * 33], s[1 * 33]); o.y = pk2(s[2 * 33], s[3 * 33]); o.z = pk2(s[4 * 33], s[5 * 33]); o.w = pk2(s[6 * 33], s[7 * 33]);
        *(u32x4*)(WT + (size_t)(dst_row0 + n) * K + k0 + 8 * c) = o; }
    asm volatile("s_waitcnt lgkmcnt(0)" ::: "memory");
}
constexpr int CV_IN = 16 * 84, CV_VR = 16, CV_OUT = 16 * 32, CV_DENSE_L = CV_IN + CV_VR + CV_OUT, CV_DENSE = NL * CV_DENSE_L;
__device__ __forceinline__ void cvt_dense_item(const P& p, int it, LAS float* scr, int lane) {
    const int l = it / CV_DENSE_L; int r = it % CV_DENSE_L;
    bf16_t* wti = p.wt_in + (size_t)l * PJB * D;
    if (r < CV_IN) { const int kb = r / 84, nb = r % 84; cvt_item(p.w_in + (size_t)l * D * INC, D, INC, kb * 64, nb * 32, wti, nb * 32, scr, lane); return; }
    r -= CV_IN;
    if (r < CV_VR) {
        if (l == 1) cvt_item(p.w_vres, D, 32, r * 64, 0, wti, INC, scr, lane);
        const int rz0 = (l == 1) ? INC + 32 : INC;
        for (int row = rz0 + (lane >> 3); row < PJB; row += 8) *(u32x4*)(wti + (size_t)row * D + r * 64 + (lane & 7) * 8) = (u32x4){0u, 0u, 0u, 0u};
        return;
    }
    r -= CV_VR;
    { const int kb = r / 32, nb = r % 32; cvt_item(p.w_out + (size_t)l * D * D, D, D, kb * 64, nb * 32, p.wt_out + (size_t)l * D * D, nb * 32, scr, lane); }
}
constexpr int CV_EXP_E = 128 + 128 + 128, CV_EXP = 65 * CV_EXP_E;
__device__ __forceinline__ void cvt_exp_item(const P& p, int l, int it, LAS float* scr, int lane) {
    const int e = it / CV_EXP_E; int r = it % CV_EXP_E;
    if (r < 256) {
        const int which = r >> 7; r &= 127; const int kb = r >> 3, nb = r & 7;
        const float* W = e < NE ? (which ? p.w_eu : p.w_eg) + ((size_t)l * NE + e) * D * ED : (which ? p.w_su : p.w_sg) + (size_t)l * D * ED;
        const int n0 = nb * 32, pn = n0 >> 7;
        cvt_item(W, D, ED, kb * 64, n0, p.wt1 + (size_t)e * 512 * D, pn * 256 + which * 128 + (n0 & 127), scr, lane);
    } else {
        r -= 256; const int kb = r >> 5, nb = r & 31;
        const float* W = e < NE ? p.w_ed + ((size_t)l * NE + e) * ED * D : p.w_sd + (size_t)l * ED * D;
        cvt_item(W, ED, D, kb * 64, nb * 32, p.wt2 + (size_t)e * D * ED, nb * 32, scr, lane);
    }
}

#define XB_TMO      128
#define XB_XCNT(j)  (256  + 64 * (j))
#define XB_XSUB(j)  (1280 + 64 * (j))
#define XB_XGEN(j)  (2304 + 64 * (j))
#define XB_TOP      3328
#define XB_TOPGEN   3392
#define XCD_BAR_WORDS 3456
#define XB_SPIN_CAP (1u << 22)
__device__ __forceinline__ unsigned xb_ld(unsigned* p)              { return __hip_atomic_load(p, __ATOMIC_RELAXED, __HIP_MEMORY_SCOPE_AGENT); }
__device__ __forceinline__ unsigned xb_add(unsigned* p, unsigned v) { return __hip_atomic_fetch_add(p, v, __ATOMIC_RELAXED, __HIP_MEMORY_SCOPE_AGENT); }
__device__ __forceinline__ unsigned xb_xcc_id() { return (unsigned)__builtin_amdgcn_s_getreg((3 << 11) | 20) & 0xFu; }
#define XB_SPIN(cond, bar) do { unsigned _sp = 0; while (cond) { __builtin_amdgcn_s_sleep(1); \
    if ((++_sp & 255u) == 0u) { if (xb_ld(&(bar)[XB_TMO])) break; if (_sp > XB_SPIN_CAP) { atomicAdd(&(bar)[XB_TMO], 1u); break; } } } } while (0)
struct XcdBarrier { unsigned* bar; unsigned x; volatile LAS unsigned* st; };
__device__ __forceinline__ XcdBarrier xcd_barrier_post(unsigned* bar, volatile LAS unsigned* st) {
    XcdBarrier b; b.bar = bar; b.x = xb_xcc_id(); b.st = st;
    if (threadIdx.x == 0) (void)xb_add(&bar[XB_XCNT(b.x)], 1u);
    return b;
}
__device__ __forceinline__ void xcd_barrier_complete(unsigned* bar, unsigned x, unsigned& nloc, unsigned& nx) {
    const unsigned G = gridDim.x * gridDim.y * gridDim.z;
    unsigned sum, cnt, mine, sp = 0u;
    for (;;) {
        sum = 0u; cnt = 0u; mine = 0u;
#pragma unroll
        for (unsigned j = 0; j < 16; ++j) { const unsigned c = xb_ld(&bar[XB_XCNT(j)]); sum += c; cnt += (c > 0u) ? 1u : 0u; mine = (j == x) ? c : mine; }
        if (sum == G) break;
        __builtin_amdgcn_s_sleep(1);
        if ((++sp & 255u) == 0u) { if (xb_ld(&bar[XB_TMO])) break; if (sp > XB_SPIN_CAP) { atomicAdd(&bar[XB_TMO], 1u); break; } }
    }
    nloc = mine > 0u ? mine : 1u; nx = cnt > 0u ? cnt : 1u;
}
__device__ __forceinline__ void xcd_barrier(const XcdBarrier& b) {
    asm volatile("s_waitcnt vmcnt(0)" ::: "memory");
    __syncthreads();
    if (threadIdx.x == 0) {
        unsigned* bar = b.bar;
        __builtin_amdgcn_s_waitcnt(0);
        unsigned nloc = b.st[0], nx = b.st[1];
        if (nloc == 0u) { xcd_barrier_complete(bar, b.x, nloc, nx); b.st[0] = nloc; b.st[1] = nx; }
        const unsigned old = xb_add(&bar[XB_XSUB(b.x)], 1u);
        const unsigned gen = old / nloc;
        if (old + 1u == (gen + 1u) * nloc) {
            __builtin_amdgcn_fence(__ATOMIC_RELEASE, "agent");
            asm volatile("s_waitcnt vmcnt(0)" ::: "memory");
            const unsigned og = xb_add(&bar[XB_TOP], 1u);
            const unsigned tg = og / nx;
            if (og + 1u == (tg + 1u) * nx) xb_add(&bar[XB_TOPGEN], 1u);
            else XB_SPIN(xb_ld(&bar[XB_TOPGEN]) == tg, bar);
            __builtin_amdgcn_fence(__ATOMIC_ACQUIRE, "agent");
            xb_add(&bar[XB_XGEN(b.x)], 1u);
            asm volatile("s_waitcnt vmcnt(0)" ::: "memory");
        } else {
            XB_SPIN(xb_ld(&bar[XB_XGEN(b.x)]) == gen, bar);
            __builtin_amdgcn_fence(__ATOMIC_ACQUIRE, "agent");
            asm volatile("s_waitcnt vmcnt(0)" ::: "memory");
        }
    }
    __syncthreads();
}

enum Ph { PH_NORM1 = 0, PH_INPROJ, PH_PREP, PH_MIX, PH_RWOUT, PH_OUTPROJ, PH_NORM2, PH_ROUTER, PH_EXP1, PH_EXP2, PH_COMBINE, PH_PER_LAYER };

__global__ void __launch_bounds__(NTHREADS, 2) k_fused(P p) {
    extern __shared__ __attribute__((aligned(16))) unsigned char lds_raw[];
    LAS unsigned char* lds = (LAS unsigned char*)lds_raw;
    LAS int* tstart = (LAS int*)(lds + LDS_STAGE);
    LAS int* cnts = (LAS int*)(lds + LDS_STAGE + 272);
    volatile LAS unsigned* bst = (volatile LAS unsigned*)(lds + LDS_STAGE + 1008);
    const int G = gridDim.x, bx = blockIdx.x;
    const int vcu = (G % 8 == 0) ? (bx % 8) * (G / 8) + bx / 8 : bx;
    if (threadIdx.x < 4) bst[threadIdx.x] = 0u;
    __syncthreads();
    XcdBarrier xb = xcd_barrier_post(p.bar, bst);
#define PHASE_COORDS() const int tid = opaque(threadIdx.x), half = tid >> 8, lane = tid & 63, wave = __builtin_amdgcn_readfirstlane(tid >> 6); \
    float* smem = (float*)lds_raw + half * 8192; LAS float* scr = (LAS float*)(lds + wave * 16384); (void)lane; (void)smem; (void)scr; (void)tid

    {
        PHASE_COORDS();
        for (int wb = bx; wb < 24; wb += G) st_mod(p, wb * 2 + half, smem);
        __syncthreads();
        for (int it = (bx * 8 + wave); it < CV_DENSE; it += G * 8) cvt_dense_item(p, it, scr, lane);
    }
    xcd_barrier(xb);

    for (int ph = 0; ph < NL * PH_PER_LAYER; ++ph) {
        const int l = ph / PH_PER_LAYER, st = ph % PH_PER_LAYER;
        PHASE_COORDS();
        if (st == PH_NORM1) {
            for (int wb = bx; wb < T / 8; wb += G) st_norm(p, l, 0, wb * 2 + half);
        } else if (st == PH_INPROJ) {
            pg8::DenseOrder S; S.init(p.h, p.wt_in + (size_t)l * PJB * D, T, PJB, D, G, bx);
            pg8::EpiProj E{p.proj};
            pg8::gemm_phase<pg8::EpiProj, pg8::DenseOrder, true, true>(lds, D, S, E);
        } else if (st == PH_PREP) {
            for (int wb = bx; wb < T / 2; wb += G) st_prep(p, l, wb * 2 + half, smem);
        } else if (st == PH_MIX) {
            constexpr int N1 = 6, N2 = NBATCH * 6 * (SEQ / 32) / 8, N3 = T / 2, N4 = (CV_EXP + 7) / 8;
            for (int wb = bx; wb < N1 + N2 + N3 + N4; wb += G) {
                if (wb < N1) st_scan(p, wb * 2 + half);
                else if (wb < N1 + N2) st_attn(p, l, (wb - N1) * 2 + half);
                else if (wb < N1 + N2 + N3) st_pool(p, l, (wb - N1 - N2) * 2 + half, smem);
                else { const int it = (wb - N1 - N2 - N3) * 8 + wave; __syncthreads(); if (it < CV_EXP) cvt_exp_item(p, l, it, scr, lane); __syncthreads(); }
            }
        } else if (st == PH_RWOUT) {
            for (int wb = bx; wb < T * 6 / 8; wb += G) st_rwout(p, l, wb * 2 + half);
        } else if (st == PH_OUTPROJ) {
            pg8::DenseOrder S; S.init(p.h, p.wt_out + (size_t)l * D * D, T, D, D, G, bx);
            pg8::EpiOut E{l == 0 ? p.x : p.xb, p.xb, p.mod + (size_t)l * 8 * 6144 + 2048};
            pg8::gemm_phase<pg8::EpiOut, pg8::DenseOrder, true, true>(lds, D, S, E);
        } else if (st == PH_NORM2) {
            for (int wb = bx; wb < T / 8; wb += G) st_norm(p, l, 1, wb * 2 + half);
        } else if (st == PH_ROUTER) {
            for (int wb = bx; wb < T / 8; wb += G) st_router(p, l, wb * 2 + half, smem);
        } else if (st == PH_EXP1 || st == PH_EXP2) {
            __syncthreads();
            if (tid == 0) {
                int acc = 0;
                for (int e = 0; e < 65; ++e) { const int c = e < NE ? p.cnt[e] : T; cnts[e] = c; tstart[e] = acc; acc += (c + 255) >> 8; }
                tstart[65] = acc;
            }
            __syncthreads();
            if (st == PH_EXP1) {
                pg8::MoeOrder<true> S{tstart, cnts, p.list, p.h, p.wt1, D, 512, 1, G, vcu};
                pg8::EpiExp1 E{p.hm};
                pg8::gemm_phase<pg8::EpiExp1, pg8::MoeOrder<true>, true, true>(lds, D, S, E);
            } else {
                pg8::MoeOrder<false> S{tstart, cnts, p.list, p.hm, p.wt2, ED, D, 2, G, vcu};
                pg8::EpiExp2 E{p.slab, p.xb, p.mod + (size_t)l * 8 * 6144 + 5120, p.list, p.topw, cnts};
                pg8::gemm_phase<pg8::EpiExp2, pg8::MoeOrder<false>, true, true>(lds, ED, S, E);
            }
        } else {
            for (int wb = bx; wb < T / 8; wb += G) st_combine(p, l, wb * 2 + half);
        }
        xcd_barrier(xb);
    }
    { PHASE_COORDS(); for (int wb = bx; wb < T / 8; wb += G) st_norm(p, 0, 2, wb * 2 + half); }
#undef PHASE_COORDS
}

}

extern "C" void kernel_launch(void* const* d_in, const int* in_sizes, int n_in, void* d_out, int out_size, void* d_ws, size_t ws_size,
                              hipStream_t stream) {
    P p{};
    const float** fp = (const float**)&p;
    for (int i = 0; i < 33; ++i) fp[i] = (const float*)d_in[i];
    p.out = (float*)d_out;
    char* ws = (char*)d_ws;
    size_t off = 0;
    auto take = [&](size_t bytes) { char* r = ws + off; off += (bytes + 255) & ~(size_t)255; return r; };
    p.bar = (unsigned*)take(16384);
    p.cnt = (int*)take(256);
    p.mod = (float*)take((size_t)NL * 8 * 6144 * 4);
    p.list = (int*)take((size_t)NE * T * 4);
    p.topw = (float*)take((size_t)T * TOPK * 4);
    p.wt_in = (bf16_t*)take((size_t)NL * PJB * D * 2);
    p.wt_out = (bf16_t*)take((size_t)NL * D * D * 2);
    p.wt1 = (bf16_t*)take((size_t)65 * 512 * D * 2);
    p.wt2 = (bf16_t*)take((size_t)65 * D * ED * 2);
    p.xb = (float*)take((size_t)T * D * 4);
    p.h = (bf16_t*)take((size_t)T * D * 2);
    p.vfirst = (float*)take((size_t)T * RWW * 4);
    const size_t ov = off;
    p.proj = (bf16_t*)take((size_t)T * PJB * 2);
    p.r = (float*)take((size_t)T * RWW * 4);
    p.w = (float*)take((size_t)T * RWW * 4);
    p.k = (float*)take((size_t)T * RWW * 4);
    p.v = (float*)take((size_t)T * RWW * 4);
    p.na = (float*)take((size_t)T * RWW * 4);
    p.bb = (float*)take((size_t)T * RWW * 4);
    p.g = (float*)take((size_t)T * RWW * 4);
    p.hm = (bf16_t*)(ws + ov);
    p.slab = (bf16_t*)(ws + ov + (size_t)MAXRT * 256 * ED * 2);
    const size_t end_moe = ov + (size_t)MAXRT * 256 * ED * 2 + (size_t)T * TOPK * D * 2;
    if (end_moe > off) off = end_moe;
    if (off > ws_size) return;

    static int cus = 0;
    if (cus == 0) {
        int dev = 0, n = 0;
        if (hipGetDevice(&dev) != hipSuccess || hipDeviceGetAttribute(&n, hipDeviceAttributeMultiprocessorCount, dev) != hipSuccess || n <= 0) n = 256;
        (void)hipFuncSetAttribute((const void*)k_fused, hipFuncAttributeMaxDynamicSharedMemorySize, LDS_BYTES);
        cus = n;
    }
    (void)hipMemsetAsync(p.bar, 0, 16384 + 256, stream);
    void* args[] = {(void*)&p};
    (void)hipLaunchCooperativeKernel((const void*)k_fused, dim3(cus), dim3(NTHREADS), args, LDS_BYTES, stream);
}
```

```cpp
#include <hip/hip_runtime.h>
#include <stdint.h>

namespace {

typedef unsigned short bf16_t;
typedef short bf16x8 __attribute__((ext_vector_type(8)));
typedef float f32x4 __attribute__((ext_vector_type(4)));
typedef unsigned u32x4 __attribute__((ext_vector_type(4)));
typedef unsigned u32x2 __attribute__((ext_vector_type(2)));
#define LAS __attribute__((address_space(3)))

constexpr int D = 1024, NBATCH = 8, SEQ = 2048, T = NBATCH * SEQ, NL = 2;
constexpr int RWW = 384, SBW = 384, PLW = 256;
constexpr int RWC = 1280, SBC = 1152, INC = 2688;
constexpr int PJB = 2816;
constexpr int NE = 64, TOPK = 6, ED = 256;
constexpr int MAXRT = 512;
constexpr int NTHREADS = 512;
constexpr int LDS_STAGE = 131072, LDS_CTL = 1024, LDS_BYTES = LDS_STAGE + LDS_CTL;

struct P {
    const float *x, *c, *w_ada, *b_ada, *w_in, *w_vres, *mu_rw, *mu_vres, *rw_w0, *rw_w2, *rw_a0, *rw_a2,
        *rw_v0, *rw_v2, *rw_g2, *rw_k_k, *rw_k_a, *rw_r_k, *rw_ln_g, *rw_ln_b, *sb_norm_g, *pool_w, *pool_scale,
        *w_out, *w_router, *b_router, *w_eg, *w_eu, *w_ed, *w_sg, *w_su, *w_sd, *g_final;
    float* out;
    unsigned* bar;
    float* mod;
    int* cnt;
    int* list;
    float* topw;
    bf16_t* wt_in;
    bf16_t* wt_out;
    bf16_t* wt1;
    bf16_t* wt2;
    float* xb;
    bf16_t* h;
    float* vfirst;
    bf16_t* proj;
    bf16_t* vt;
    float* rec;
    float *g, *y;
    bf16_t* hm;
    bf16_t* slab;
};

__device__ __forceinline__ int opaque(int x) { asm volatile("" : "+v"(x)); return x; }
__device__ __forceinline__ float wave_sum(float v) {
#pragma unroll
    for (int o = 32; o > 0; o >>= 1) v += __shfl_xor(v, o);
    return v;
}
__device__ __forceinline__ float sigmoidf_(float x) { return 1.f / (1.f + __expf(-x)); }
__device__ __forceinline__ float softplusf_(float x) { return fmaxf(x, 0.f) + log1pf(__expf(-fabsf(x))); }
__device__ __forceinline__ float siluf_(float x) { return x / (1.f + __expf(-x)); }
__device__ __forceinline__ unsigned f2bf(float f) { unsigned u = __builtin_bit_cast(unsigned, f); return (u + 0x7fffu + ((u >> 16) & 1u)) >> 16; }
__device__ __forceinline__ unsigned pk2(float lo, float hi) { return f2bf(lo) | (f2bf(hi) << 16); }
__device__ __forceinline__ float bf2f(bf16_t h) { return __builtin_bit_cast(float, (unsigned)h << 16); }
__device__ __forceinline__ float bflo(unsigned u) { return __builtin_bit_cast(float, u << 16); }
__device__ __forceinline__ float bfhi(unsigned u) { return __builtin_bit_cast(float, u & 0xffff0000u); }

namespace pg8 {
constexpr int BM = 256, BK = 64, HALF = 128, HTB = HALF * BK * 2, STAGE_BYTES = 8 * HTB;
__device__ __forceinline__ int lds_byte(int r, int c) { const int st = (r >> 4) * 2 + (c >> 5), rr = r & 15, cc = c & 31, ob = rr * 64 + cc * 2; return st * 1024 + (ob ^ (((ob >> 9) & 1) << 5)); }
__device__ __forceinline__ void stage_rc(int b, int& R, int& C) { const int st = b / 1024, sb = b % 1024, swz = sb ^ (((sb >> 9) & 1) << 5); R = (st >> 1) * 16 + swz / 64; C = (st & 1) * 32 + (swz % 64) / 2; }
__device__ __forceinline__ int perm32(int rho) { const int n = rho >> 4, i = rho & 15; return 8 * (i >> 2) + 4 * n + (i & 3); }

struct Unit { int pm, pn, e, mt; };

template <class Epi, class Sched, bool ALIGN_EPI, bool SP2>
__device__ __forceinline__ void gemm_phase(LAS unsigned char* lds, const int K, const Sched& S, const Epi& E) {
    const int tid = opaque(threadIdx.x), wid = __builtin_amdgcn_readfirstlane(tid >> 6), lane = tid & 63, wr = wid >> 2, wc = wid & 3, fr = lane & 15, fq = lane >> 4;
    const int nt = K / BK;
    unsigned voffA[2], voffB[2];
#pragma unroll
    for (int i = 0; i < 2; ++i) { int R, C; stage_rc(tid * 16 + i * 8192, R, C); const int Rb = Epi::PERM ? ((R & ~31) + perm32(R & 31)) : R;
        voffA[i] = Sched::GATHER ? (unsigned)(C * 2) : (unsigned)(R * K + C) * 2u; voffB[i] = (unsigned)(Rb * K + C) * 2u; }
    const size_t kstep = (size_t)(BK * 2);
    const size_t hstep = (size_t)HALF * K * 2;
    const unsigned ldsw = (unsigned)wid * 1024u;
    const int aoff = lds_byte(wr * 64 + fr, fq * 8), boff = lds_byte(wc * 32 + fr, fq * 8);
#define PG8_SA(b, h) (((b) * 2 + (h)) * HTB)
#define PG8_SB(b, h) ((4 + (b) * 2 + (h)) * HTB)
#define PG8_STAGE(bufoff, gbase, voff) do { _Pragma("unroll") for (int _i = 0; _i < 2; ++_i) \
        __builtin_amdgcn_global_load_lds((const unsigned*)((const char*)(gbase) + (voff)[_i]), (LAS unsigned*)(lds + (bufoff) + ldsw + _i * 8192), 16, 0, 0); } while (0)
#define PG8_LDA(dst, b, h) do { _Pragma("unroll") for (int m = 0; m < 4; ++m) _Pragma("unroll") for (int k = 0; k < 2; ++k) dst[m][k] = *(const LAS bf16x8*)(lds + PG8_SA(b, h) + aoff + m * 2048 + k * 1024); } while (0)
#define PG8_LDB(dst, b, h) do { _Pragma("unroll") for (int n = 0; n < 2; ++n) _Pragma("unroll") for (int k = 0; k < 2; ++k) dst[n][k] = *(const LAS bf16x8*)(lds + PG8_SB(b, h) + boff + n * 2048 + k * 1024); } while (0)
#define PG8_MMA(ai, bj, At, Bt) do { __builtin_amdgcn_s_setprio(1); _Pragma("unroll") for (int m = 0; m < 4; ++m) _Pragma("unroll") for (int n = 0; n < 2; ++n) _Pragma("unroll") for (int k = 0; k < 2; ++k) \
        acc[ai][bj][m][n] = __builtin_amdgcn_mfma_f32_16x16x32_bf16(Bt[n][k], At[m][k], acc[ai][bj][m][n], 0, 0, 0); __builtin_amdgcn_s_setprio(0); } while (0)
#define PG8_WAIT_V(n) asm volatile("s_waitcnt vmcnt(" #n ")" ::: "memory")
#define PG8_WAIT_L(n) asm volatile("s_waitcnt lgkmcnt(" #n ")" ::: "memory")
#define PG8_BAR __builtin_amdgcn_s_barrier()
#define PG8_SCHED __builtin_amdgcn_sched_barrier(0)
    Unit cur, nxt; int ui = 0;
    if (!S.next(0, cur)) return;
    f32x4 acc[2][2][4][2];
#pragma unroll
    for (int a = 0; a < 2; ++a)
#pragma unroll
        for (int b = 0; b < 2; ++b)
#pragma unroll
            for (int m = 0; m < 4; ++m)
#pragma unroll
                for (int n = 0; n < 2; ++n) acc[a][b][m][n] = (f32x4){0.f, 0.f, 0.f, 0.f};
    bf16x8 At[4][2], B0[2][2], B1[2][2];
    const char* cA = S.a_base(cur); const char* cB = S.b_base(cur);
    unsigned pk[2] = {0u, 0u}, npk[2] = {0u, 0u};
    if constexpr (Sched::GATHER) S.a_tok(cur, tid, pk);
    const unsigned k2 = (unsigned)K * 2u;
#define PG8_STAGE_A(bufoff, gbase, hh, PK) do { if constexpr (Sched::GATHER) { unsigned _v[2]; _v[0] = (((PK)[0] >> (16 * (hh))) & 0xffffu) * k2 + voffA[0]; _v[1] = (((PK)[1] >> (16 * (hh))) & 0xffffu) * k2 + voffA[1]; \
        PG8_STAGE(bufoff, gbase, _v); } else { PG8_STAGE(bufoff, (gbase) + (hh) * hstep, voffA); } } while (0)
    static_assert(SP2, "only the SP2 loop is kept");
    PG8_STAGE(PG8_SB(0, 0), cB, voffB); PG8_STAGE(PG8_SB(0, 1), cB + hstep, voffB); PG8_STAGE_A(PG8_SA(0, 0), cA, 0, pk); PG8_STAGE_A(PG8_SA(0, 1), cA, 1, pk);
    if (wr == 1) PG8_BAR;
    PG8_WAIT_V(2); PG8_BAR;
    PG8_STAGE(PG8_SB(1, 0), cB + kstep, voffB); PG8_STAGE_A(PG8_SA(1, 0), cA + kstep, 0, pk); PG8_STAGE(PG8_SB(1, 1), cB + hstep + kstep, voffB);
    PG8_WAIT_V(6); PG8_BAR;
    for (;;) {
        const bool has_next = S.next(ui + 1, nxt);
        const char* nA = has_next ? S.a_base(nxt) : cA; const char* nB = has_next ? S.b_base(nxt) : cB;
        if constexpr (Sched::GATHER) { if (has_next) S.a_tok(nxt, tid, npk); else { npk[0] = pk[0]; npk[1] = pk[1]; } }
#pragma unroll 1
        for (int t = 0; t < nt; t += 2) {
            const bool last = (t == nt - 2);
            const char* a1 = cA + (size_t)(t + 1) * kstep;
            const char* a2 = last ? nA : cA + (size_t)(t + 2) * kstep; const char* b2 = last ? nB : cB + (size_t)(t + 2) * kstep;
            const char* a3 = a2 + kstep; const char* b3 = b2 + kstep;
            unsigned sp[2]; sp[0] = last ? npk[0] : pk[0]; sp[1] = last ? npk[1] : pk[1];
            PG8_LDB(B0, 0, 0); PG8_LDB(B1, 0, 1); PG8_SCHED; PG8_LDA(At, 0, 0); PG8_STAGE_A(PG8_SA(1, 1), a1, 1, pk);
            PG8_WAIT_V(8); PG8_WAIT_L(0); PG8_BAR; PG8_MMA(0, 0, At, B0); PG8_MMA(0, 1, At, B1); PG8_BAR; PG8_SCHED;
            PG8_LDA(At, 0, 1); PG8_STAGE(PG8_SB(0, 0), b2, voffB); PG8_STAGE(PG8_SB(0, 1), b2 + hstep, voffB); PG8_STAGE_A(PG8_SA(0, 0), a2, 0, sp);
            PG8_WAIT_V(8); PG8_WAIT_L(0); PG8_BAR; PG8_MMA(1, 0, At, B0); PG8_MMA(1, 1, At, B1); PG8_BAR; PG8_SCHED;
            PG8_LDB(B0, 1, 0); PG8_LDB(B1, 1, 1); PG8_SCHED; PG8_LDA(At, 1, 0); PG8_STAGE_A(PG8_SA(0, 1), a2, 1, sp);
            PG8_WAIT_V(8); PG8_WAIT_L(0); PG8_BAR; PG8_MMA(0, 0, At, B0); PG8_MMA(0, 1, At, B1); PG8_BAR; PG8_SCHED;
            PG8_LDA(At, 1, 1); PG8_STAGE(PG8_SB(1, 0), b3, voffB); PG8_STAGE(PG8_SB(1, 1), b3 + hstep, voffB); PG8_STAGE_A(PG8_SA(1, 0), a3, 0, sp);
            PG8_WAIT_V(8); PG8_WAIT_L(0); PG8_BAR; PG8_MMA(1, 0, At, B0); PG8_MMA(1, 1, At, B1); PG8_BAR; PG8_SCHED;
        }
        if constexpr (ALIGN_EPI) { if (wr == 0) PG8_BAR; }
        { const int t2 = opaque(threadIdx.x), w2 = __builtin_amdgcn_readfirstlane(t2 >> 6), l2 = t2 & 63; E(acc, cur, w2 >> 2, w2 & 3, l2 & 15, l2 >> 4); }
        if (!has_next) break;
#pragma unroll
        for (int a = 0; a < 2; ++a)
#pragma unroll
            for (int b = 0; b < 2; ++b)
#pragma unroll
                for (int m = 0; m < 4; ++m)
#pragma unroll
                    for (int n = 0; n < 2; ++n) acc[a][b][m][n] = (f32x4){0.f, 0.f, 0.f, 0.f};
        cur = nxt; cA = nA; cB = nB; ++ui;
        pk[0] = npk[0]; pk[1] = npk[1];
        if constexpr (ALIGN_EPI) { if (wr == 1) PG8_BAR; }
    }
    PG8_WAIT_V(0);
    if constexpr (!ALIGN_EPI) { if (wr == 0) PG8_BAR; }
    PG8_BAR;
#undef PG8_SA
#undef PG8_SB
#undef PG8_STAGE
#undef PG8_STAGE_A
#undef PG8_LDA
#undef PG8_LDB
#undef PG8_MMA
#undef PG8_WAIT_V
#undef PG8_WAIT_L
#undef PG8_BAR
#undef PG8_SCHED
}

struct DenseOrder {
    const bf16_t* A; const bf16_t* Bt; int K; int nM, nN, nwg, G, c;
    __device__ __forceinline__ void init(const bf16_t* A_, const bf16_t* Bt_, int M, int N, int K_, int G_, int c_) { A = A_; Bt = Bt_; K = K_; nM = M / BM; nN = N / BM; nwg = nM * nN; G = G_; c = c_; }
    __device__ __forceinline__ bool next(int i, Unit& u) const {
        const long L = (long)i * G + c; if (L >= nwg) return false;
        int wgid = (int)L; { const int q = nwg / 8, r = nwg % 8, xcd = wgid % 8, off = wgid / 8; wgid = (xcd < r ? xcd * (q + 1) : r * (q + 1) + (xcd - r) * q) + off; }
        const int nig = 8 * nN, gid = wgid / nig, fm = gid * 8, gsz = (nM - fm) < 8 ? (nM - fm) : 8;
        u.pm = fm + ((wgid % nig) % gsz); u.pn = (wgid % nig) / gsz; u.e = 0; u.mt = 0; return true;
    }
    __device__ __forceinline__ const char* a_base(const Unit& u) const { return (const char*)A + (size_t)u.pm * BM * K * 2; }
    __device__ __forceinline__ const char* b_base(const Unit& u) const { return (const char*)Bt + (size_t)u.pn * BM * K * 2; }
    static constexpr bool GATHER = false;
    __device__ __forceinline__ void a_tok(const Unit&, int, unsigned (&)[2]) const {}
};

template <bool GATHER_>
struct MoeOrder {
    static constexpr bool GATHER = GATHER_;
    const LAS int* tstart;
    const LAS int* cnts;
    const int* list;
    const bf16_t* A;
    const bf16_t* Bt;
    int K, N, lognpn, G, c;
    __device__ __forceinline__ bool next(int i, Unit& u) const {
        const int L = i * G + c; const int total = __builtin_amdgcn_readfirstlane(tstart[65]) << lognpn; if (L >= total) return false;
        const int rt = L >> lognpn; u.pn = L & ((1 << lognpn) - 1); u.pm = rt;
        int e = 0;
        for (int j = 1; j < 65; ++j) e += (tstart[j] <= rt) ? 1 : 0;
        e = __builtin_amdgcn_readfirstlane(e);
        u.e = e; u.mt = rt - __builtin_amdgcn_readfirstlane(tstart[e]); return true;
    }
    __device__ __forceinline__ const char* a_base(const Unit& u) const { return GATHER ? (const char*)A : (const char*)A + (size_t)u.pm * BM * K * 2; }
    __device__ __forceinline__ const char* b_base(const Unit& u) const { return (const char*)Bt + ((size_t)u.e * N + (size_t)u.pn * BM) * K * 2; }
    __device__ __forceinline__ void a_tok(const Unit& u, int tid, unsigned (&pkv)[2]) const {
        const int ce = cnts[u.e];
#pragma unroll
        for (int i = 0; i < 2; ++i) {
            int R, C; stage_rc(tid * 16 + i * 8192, R, C); (void)C;
            unsigned v = 0u;
#pragma unroll
            for (int hh = 0; hh < 2; ++hh) {
                const int idx = u.mt * BM + hh * HALF + R;
                int tok = 0;
                if (idx < ce) tok = (u.e < NE) ? (list[(size_t)u.e * T + idx] / TOPK) : idx;
                v |= (unsigned)tok << (16 * hh);
            }
            pkv[i] = v;
        }
    }
};

struct EpiProj {
    static constexpr bool PERM = true;
    bf16_t* O; bf16_t* vt;
    __device__ __forceinline__ void operator()(const f32x4 (&acc)[2][2][4][2], const Unit& u, int wr, int wc, int fr, int fq) const {
        const int row0 = u.pm * BM + wr * 64 + fr, col0 = u.pn * BM + wc * 32 + 8 * fq;
#pragma unroll
        for (int bj = 0; bj < 2; ++bj) {
            const bool isv = (u.pn == 8) || (u.pn == 9 && bj == 0);
            if (!isv) {
#pragma unroll
                for (int ai = 0; ai < 2; ++ai)
#pragma unroll
                    for (int m = 0; m < 4; ++m) { bf16_t* rowp = O + (size_t)(row0 + ai * HALF + m * 16) * PJB + col0 + bj * HALF;
                        const f32x4 v0 = acc[ai][bj][m][0], v1 = acc[ai][bj][m][1];
                        u32x4 w; w.x = pk2(v0[0], v0[1]); w.y = pk2(v0[2], v0[3]); w.z = pk2(v1[0], v1[1]); w.w = pk2(v1[2], v1[3]);
                        *(u32x4*)rowp = w; }
            } else {
                const int vc0 = col0 + bj * HALF - 2048;
#pragma unroll
                for (int ai = 0; ai < 2; ++ai)
#pragma unroll
                    for (int m = 0; m < 4; ++m) { const int row = row0 + ai * HALF + m * 16; const int b = row / SEQ, s = row % SEQ;
                        bf16_t* base = vt + ((size_t)b * SBW + vc0) * SEQ + s;
#pragma unroll
                        for (int n = 0; n < 2; ++n)
#pragma unroll
                            for (int j = 0; j < 4; ++j) base[(size_t)(4 * n + j) * SEQ] = (bf16_t)f2bf(acc[ai][bj][m][n][j]); }
            }
        }
    }
};
struct EpiOut {
    static constexpr bool PERM = false;
    const float* xin; float* xo; const float* gt;
    __device__ __forceinline__ void operator()(const f32x4 (&acc)[2][2][4][2], const Unit& u, int wr, int wc, int fr, int fq) const {
        const int row0 = u.pm * BM + wr * 64 + fr, col0 = u.pn * BM + wc * 32 + 4 * fq;
#pragma unroll
        for (int ai = 0; ai < 2; ++ai)
#pragma unroll
            for (int m = 0; m < 4; ++m) { const int row = row0 + ai * HALF + m * 16; const float* gr = gt + (size_t)(row / SEQ) * 6144;
#pragma unroll
                for (int bj = 0; bj < 2; ++bj)
#pragma unroll
                    for (int n = 0; n < 2; ++n) { const int col = col0 + bj * HALF + 16 * n;
                        const f32x4 xi = *(const f32x4*)(xin + (size_t)row * D + col); const f32x4 gg = *(const f32x4*)(gr + col);
                        *(f32x4*)(xo + (size_t)row * D + col) = xi + gg * acc[ai][bj][m][n]; } }
    }
};
struct EpiExp1 {
    static constexpr bool PERM = true;
    bf16_t* hm;
    __device__ __forceinline__ void operator()(const f32x4 (&acc)[2][2][4][2], const Unit& u, int wr, int wc, int fr, int fq) const {
        const int row0 = u.pm * BM + wr * 64 + fr, col0 = u.pn * HALF + wc * 32 + 8 * fq;
#pragma unroll
        for (int ai = 0; ai < 2; ++ai)
#pragma unroll
            for (int m = 0; m < 4; ++m) { bf16_t* rowp = hm + (size_t)(row0 + ai * HALF + m * 16) * ED + col0;
                float o[8];
#pragma unroll
                for (int n = 0; n < 2; ++n)
#pragma unroll
                    for (int j = 0; j < 4; ++j) o[n * 4 + j] = siluf_(acc[ai][0][m][n][j]) * acc[ai][1][m][n][j];
                u32x4 w; w.x = pk2(o[0], o[1]); w.y = pk2(o[2], o[3]); w.z = pk2(o[4], o[5]); w.w = pk2(o[6], o[7]);
                *(u32x4*)rowp = w; }
    }
};
struct EpiExp2 {
    static constexpr bool PERM = true;
    bf16_t* slab; float* xb; const float* gt; const int* list; const float* topw; const LAS int* cnts;
    __device__ __forceinline__ void operator()(const f32x4 (&acc)[2][2][4][2], const Unit& u, int wr, int wc, int fr, int fq) const {
        const int col0 = u.pn * BM + wc * 32 + 8 * fq; const int ce = cnts[u.e];
#pragma unroll
        for (int ai = 0; ai < 2; ++ai)
#pragma unroll
            for (int m = 0; m < 4; ++m) { const int idx = u.mt * BM + ai * HALF + wr * 64 + m * 16 + fr;
                if (idx < ce) {
                    if (u.e < NE) {
                        const int aid = list[(size_t)u.e * T + idx]; const float wgt = topw[aid]; bf16_t* rowp = slab + (size_t)aid * D + col0;
#pragma unroll
                        for (int bj = 0; bj < 2; ++bj) { const f32x4 v0 = acc[ai][bj][m][0] * wgt, v1 = acc[ai][bj][m][1] * wgt;
                            u32x4 w; w.x = pk2(v0[0], v0[1]); w.y = pk2(v0[2], v0[3]); w.z = pk2(v1[0], v1[1]); w.w = pk2(v1[2], v1[3]);
                            *(u32x4*)(rowp + bj * HALF) = w; }
                    } else {
                        const int tok = idx; float* xr = xb + (size_t)tok * D + col0; const float* gr = gt + (size_t)(tok / SEQ) * 6144 + col0;
#pragma unroll
                        for (int bj = 0; bj < 2; ++bj)
#pragma unroll
                            for (int n = 0; n < 2; ++n) { const f32x4 xi = *(const f32x4*)(xr + bj * HALF + 4 * n); const f32x4 gg = *(const f32x4*)(gr + bj * HALF + 4 * n);
                                *(f32x4*)(xr + bj * HALF + 4 * n) = xi + gg * acc[ai][bj][m][n]; }
                    }
                } }
    }
};
}

__device__ __forceinline__ void st_mod(const P& p, int vb, float* smem) {
    const int tid = opaque(threadIdx.x) & 255;
    const int l = vb / 24, j = (vb % 24) * 256 + tid;
    float* sc = smem;
    for (int i = tid; i < 8 * 1024; i += 256) sc[i] = siluf_(p.c[i]);
    __syncthreads();
    float acc[8];
#pragma unroll
    for (int b = 0; b < 8; ++b) acc[b] = 0.f;
    const float* w = p.w_ada + (size_t)l * 1024 * 6144 + j;
    for (int i = 0; i < 1024; ++i) {
        const float wv = w[(size_t)i * 6144];
#pragma unroll
        for (int b = 0; b < 8; ++b) acc[b] += sc[b * 1024 + i] * wv;
    }
    const float bv = p.b_ada[l * 6144 + j];
#pragma unroll
    for (int b = 0; b < 8; ++b) p.mod[((size_t)l * 8 + b) * 6144 + j] = acc[b] + bv;
    __syncthreads();
}

__device__ __forceinline__ void st_norm(const P& p, int l, int which, int vb) {
    const int tid = opaque(threadIdx.x) & 255;
    const int wv = tid >> 6, lane = tid & 63;
    const int t = vb * 4 + wv, b = t / SEQ;
    const float* xin = (l == 0 && which == 0) ? p.x : p.xb;
    const float* xr = xin + (size_t)t * D;
    float vals[16];
    float ss = 0.f;
#pragma unroll
    for (int i = 0; i < 4; ++i) {
        const float4 q = *(const float4*)(xr + i * 256 + lane * 4);
        vals[i * 4 + 0] = q.x; vals[i * 4 + 1] = q.y; vals[i * 4 + 2] = q.z; vals[i * 4 + 3] = q.w;
        ss += q.x * q.x + q.y * q.y + q.z * q.z + q.w * q.w;
    }
    ss = wave_sum(ss);
    const float rs = rsqrtf(ss * (1.f / D) + 1e-6f);
    if (which == 2) {
#pragma unroll
        for (int i = 0; i < 4; ++i) {
            const int cidx = i * 256 + lane * 4;
            const float4 gq = *(const float4*)(p.g_final + cidx);
            float4 o;
            o.x = vals[i * 4 + 0] * rs * gq.x; o.y = vals[i * 4 + 1] * rs * gq.y; o.z = vals[i * 4 + 2] * rs * gq.z; o.w = vals[i * 4 + 3] * rs * gq.w;
            *(float4*)(p.out + (size_t)t * D + cidx) = o;
        }
        return;
    }
    const float* md = p.mod + ((size_t)l * 8 + b) * 6144 + (which ? 3072 : 0);
#pragma unroll
    for (int i = 0; i < 4; ++i) {
        const int cidx = i * 256 + lane * 4;
        const float4 sh = *(const float4*)(md + cidx);
        const float4 sc = *(const float4*)(md + 1024 + cidx);
        u32x2 o;
        o.x = pk2(vals[i * 4 + 0] * rs * (1.f + sc.x) + sh.x, vals[i * 4 + 1] * rs * (1.f + sc.y) + sh.y);
        o.y = pk2(vals[i * 4 + 2] * rs * (1.f + sc.z) + sh.z, vals[i * 4 + 3] * rs * (1.f + sc.w) + sh.w);
        *(u32x2*)(p.h + (size_t)t * D + cidx) = o;
    }
    if (which == 1 && vb == 0 && tid < 64) p.cnt[tid] = 0;
}

constexpr int REC_T = 6 * 6 * 64;
__device__ __forceinline__ void st_prep(const P& p, int l, int vb, LAS float* X  ) {
    const int tid = opaque(threadIdx.x);
    const int t0 = vb * 32, s0 = t0 % SEQ;
    for (int it = tid; it < 32 * 160; it += NTHREADS) {
        const int tt = it / 160, i = it % 160;
        if (i >= 128 && l == 0) { X[it] = 0.f; continue; }
        const int col = (i < 128) ? 1152 + i : INC + (i - 128);
        const float mu = (i < 128) ? p.mu_rw[l * RWC + col] : p.mu_vres[i - 128];
        const bf16_t* u = p.proj + (size_t)(t0 + tt) * PJB + col;
        const float uu = bf2f(u[0]), pv = (s0 + tt) > 0 ? bf2f(u[-PJB]) : 0.f;
        float x = uu + (pv - uu) * mu;
        if (i < 32) x = tanhf(x); else if (i >= 64 && i < 128) x = sigmoidf_(x);
        X[it] = x;
    }
    __syncthreads();
    if (tid < RWW) {
        const int c = tid, hh = c >> 6, lane = c & 63;
        const float w0 = p.rw_w0[l * RWW + c], a0 = p.rw_a0[l * RWW + c], v0 = (l == 1) ? p.rw_v0[c] : 0.f;
        const float kkc = p.rw_k_k[l * RWW + c], kac = p.rw_k_a[l * RWW + c];
        const float mur = p.mu_rw[l * RWC + c], muk = p.mu_rw[l * RWC + 384 + c], muv = p.mu_rw[l * RWC + 768 + c];
        const float* w2 = p.rw_w2 + (size_t)l * 32 * RWW + c;
        const float* a2 = p.rw_a2 + (size_t)l * 32 * RWW + c;
        const float* v2 = p.rw_v2 + c;
        const float* g2 = p.rw_g2 + (size_t)l * 64 * RWW + c;
        for (int grp = 0; grp < 4; ++grp) {
            float aw[8], aa[8], av[8], ag[8];
#pragma unroll
            for (int j = 0; j < 8; ++j) { aw[j] = w0; aa[j] = a0; av[j] = v0; ag[j] = 0.f; }
            for (int i = 0; i < 32; i += 4) {
                float ww[4], wa[4], wv[4];
#pragma unroll
                for (int q = 0; q < 4; ++q) { ww[q] = w2[(i + q) * RWW]; wa[q] = a2[(i + q) * RWW]; wv[q] = (l == 1) ? v2[(i + q) * RWW] : 0.f; }
#pragma unroll
                for (int j = 0; j < 8; ++j) {
                    const LAS float* xr = X + (grp * 8 + j) * 160;
                    const f32x4 xw = *(const LAS f32x4*)(xr + i), xa = *(const LAS f32x4*)(xr + 32 + i), xv = *(const LAS f32x4*)(xr + 128 + i);
#pragma unroll
                    for (int q = 0; q < 4; ++q) { aw[j] += xw[q] * ww[q]; aa[j] += xa[q] * wa[q]; av[j] += xv[q] * wv[q]; }
                }
            }
            for (int i = 0; i < 64; i += 4) {
                float wg[4];
#pragma unroll
                for (int q = 0; q < 4; ++q) wg[q] = g2[(i + q) * RWW];
#pragma unroll
                for (int j = 0; j < 8; ++j) {
                    const f32x4 xg = *(const LAS f32x4*)(X + (grp * 8 + j) * 160 + 64 + i);
#pragma unroll
                    for (int q = 0; q < 4; ++q) ag[j] += xg[q] * wg[q];
                }
            }
#pragma unroll
            for (int j = 0; j < 8; ++j) {
                const int tt = grp * 8 + j, t = t0 + tt;
                const bf16_t* u = p.proj + (size_t)t * PJB + c;
                const bool hp = (s0 + tt) > 0;
                float r = bf2f(u[0]), k = bf2f(u[384]), v = bf2f(u[768]);
                const float rp = hp ? bf2f(u[-PJB]) : 0.f, kp = hp ? bf2f(u[384 - PJB]) : 0.f, vp = hp ? bf2f(u[768 - PJB]) : 0.f;
                r += (rp - r) * mur; k += (kp - k) * muk; v += (vp - v) * muv;
                const float wlog = -softplusf_(-aw[j]) - 0.5f;
                const float decay = __expf(-__expf(wlog));
                const float a = sigmoidf_(aa[j]);
                if (l == 1) { const float vg = sigmoidf_(av[j]); v = v + (p.vfirst[(size_t)t * RWW + c] - v) * vg; }
                else p.vfirst[(size_t)t * RWW + c] = v;
                const float kkr = k * kkc;
                const float ss = wave_sum(kkr * kkr);
                const float kk = kkr / fmaxf(sqrtf(ss), 1e-12f);
                float* rc = p.rec + (size_t)t * REC_T + hh * 384 + lane;
                rc[0] = -kk; rc[64] = decay; rc[128] = kk * a; rc[192] = k * (1.f + (a - 1.f) * kac); rc[256] = r; rc[320] = v;
                p.g[(size_t)t * RWW + c] = ag[j];
            }
        }
    }
    __syncthreads();
}

__device__ __forceinline__ float dpp_add16(float x) {
    x += __builtin_bit_cast(float, __builtin_amdgcn_update_dpp(0, __builtin_bit_cast(int, x), 0xB1, 0xF, 0xF, true));
    x += __builtin_bit_cast(float, __builtin_amdgcn_update_dpp(0, __builtin_bit_cast(int, x), 0x4E, 0xF, 0xF, true));
    x += __builtin_bit_cast(float, __builtin_amdgcn_update_dpp(0, __builtin_bit_cast(int, x), 0x141, 0xF, 0xF, true));
    x += __builtin_bit_cast(float, __builtin_amdgcn_update_dpp(0, __builtin_bit_cast(int, x), 0x140, 0xF, 0xF, true));
    return x;
}
constexpr int SC_CH = 32, SC_CHB = SC_CH * 1536;
__device__ __forceinline__ void st_scan(const P& p, int vb, LAS unsigned char* lds) {
    const int tid = opaque(threadIdx.x), wave = __builtin_amdgcn_readfirstlane(tid >> 6), lane = tid & 63;
    const int bh = vb >> 1, rh = vb & 1, b = bh / 6, hh = bh % 6;
    const int cg = lane & 15, row = rh * 32 + wave * 4 + (lane >> 4);
    const char* recb = (const char*)(p.rec + ((size_t)b * SEQ * 6 + hh) * 384);
    float* yb = p.y + (size_t)b * SEQ * RWW + hh * 64 + row;
    unsigned goff[6];
#pragma unroll
    for (int j = 0; j < 6; ++j) { const int o = (wave * 6 + j) * 1024 + lane * 16; goff[j] = (unsigned)((o / 1536) * (REC_T * 4) + (o % 1536)); }
#define SC_LOAD(chunk, buf) do { const char* gb = recb + (size_t)(chunk) * SC_CH * (REC_T * 4); _Pragma("unroll") for (int j = 0; j < 6; ++j) \
        __builtin_amdgcn_global_load_lds((const unsigned*)(gb + goff[j]), (LAS unsigned*)(lds + (buf) * SC_CHB + (wave * 6 + j) * 1024), 16, 0, 0); } while (0)
    float s0 = 0.f, s1 = 0.f, s2 = 0.f, s3 = 0.f;
    SC_LOAD(0, 0);
    asm volatile("s_waitcnt vmcnt(0)" ::: "memory");
    __syncthreads();
    for (int ch = 0; ch < SEQ / SC_CH; ++ch) {
        if (ch + 1 < SEQ / SC_CH) SC_LOAD(ch + 1, (ch + 1) & 1);
        const LAS unsigned char* cb = lds + (ch & 1) * SC_CHB + cg * 16;
        const LAS unsigned char* vbp = lds + (ch & 1) * SC_CHB + 1280 + row * 4;
        f32x4 a4 = *(const LAS f32x4*)(cb), w4 = *(const LAS f32x4*)(cb + 256), b4 = *(const LAS f32x4*)(cb + 512), k4 = *(const LAS f32x4*)(cb + 768), r4 = *(const LAS f32x4*)(cb + 1024);
        float vv = *(const LAS float*)(vbp);
#pragma unroll 4
        for (int st = 0; st < SC_CH; ++st) {
            const int nx = (st + 1 < SC_CH) ? (st + 1) * 1536 : st * 1536;
            const f32x4 a4n = *(const LAS f32x4*)(cb + nx), w4n = *(const LAS f32x4*)(cb + nx + 256), b4n = *(const LAS f32x4*)(cb + nx + 512), k4n = *(const LAS f32x4*)(cb + nx + 768), r4n = *(const LAS f32x4*)(cb + nx + 1024);
            const float vvn = *(const LAS float*)(vbp + nx);
            float pa = s0 * a4[0]; pa = fmaf(s1, a4[1], pa); pa = fmaf(s2, a4[2], pa); pa = fmaf(s3, a4[3], pa);
            const float t0 = fmaf(s0, w4[0], vv * k4[0]), t1 = fmaf(s1, w4[1], vv * k4[1]), t2 = fmaf(s2, w4[2], vv * k4[2]), t3 = fmaf(s3, w4[3], vv * k4[3]);
            const float sa = dpp_add16(pa);
            s0 = fmaf(sa, b4[0], t0); s1 = fmaf(sa, b4[1], t1); s2 = fmaf(sa, b4[2], t2); s3 = fmaf(sa, b4[3], t3);
            float py = s0 * r4[0]; py = fmaf(s1, r4[1], py); py = fmaf(s2, r4[2], py); py = fmaf(s3, r4[3], py);
            const float yy = dpp_add16(py);
            if (cg == 0) yb[(size_t)(ch * SC_CH + st) * RWW] = yy;
            a4 = a4n; w4 = w4n; b4 = b4n; k4 = k4n; r4 = r4n; vv = vvn;
        }
        asm volatile("s_waitcnt vmcnt(0)" ::: "memory");
        __syncthreads();
    }
#undef SC_LOAD
}

__device__ __forceinline__ void st_rwout(const P& p, int l, int vb) {
    const int tid = opaque(threadIdx.x) & 255;
    const int wv = tid >> 6, lane = tid & 63;
    const int item = vb * 4 + wv, t = item / 6, hh = item % 6;
    const int c = hh * 64 + lane;
    const size_t o = (size_t)t * RWW + c;
    const float* rc = p.rec + (size_t)t * REC_T + hh * 384 + lane;
    const float y = p.y[o];
    const float mean = wave_sum(y) * (1.f / 64.f);
    const float d = y - mean;
    const float var = wave_sum(d * d) * (1.f / 64.f);
    const float yn = d * rsqrtf(var + 64e-5f) * p.rw_ln_g[l * RWW + c] + p.rw_ln_b[l * RWW + c];
    const float rk = wave_sum(rc[256] * rc[192] * p.rw_r_k[l * RWW + c]);
    const float outv = (yn + rk * rc[320]) * p.g[o];
    p.h[(size_t)t * D + c] = (bf16_t)f2bf(outv);
}

typedef float f32x16 __attribute__((ext_vector_type(16)));
constexpr float ATT_EXIT = -60.f;
__device__ __forceinline__ float xhalf(float x) { return __shfl_xor(x, 32); }
__device__ __forceinline__ void st_attn(const P& p, int l, int item) {
    const int lane = opaque(threadIdx.x) & 63;
    const int qt = item % (SEQ / 32), bh = item / (SEQ / 32), b = bh / 6, hh = bh % 6;
    const int r = lane & 31, hf = lane >> 5;
    const bf16_t* qkb = p.proj + (size_t)b * SEQ * PJB + RWC + hh * 64 + 8 * hf;
    const bf16_t* vtb = p.vt + ((size_t)(b * 6 + hh) * 64 + r) * SEQ + 4 * hf;
    bf16x8 qf[4];
    {
        const bf16_t* qp = qkb + (size_t)(qt * 32 + r) * PJB;
#pragma unroll
        for (int s = 0; s < 4; ++s) {
            u32x4 t4 = *(const u32x4*)(qp + 16 * s);
            unsigned w[4] = {t4.x, t4.y, t4.z, t4.w};
#pragma unroll
            for (int q = 0; q < 4; ++q) { const float lo = bflo(w[q]) * 0.125f, hi = bfhi(w[q]) * 0.125f; w[q] = (__builtin_bit_cast(unsigned, lo) >> 16) | (__builtin_bit_cast(unsigned, hi) & 0xffff0000u); }
            t4.x = w[0]; t4.y = w[1]; t4.z = w[2]; t4.w = w[3];
            qf[s] = __builtin_bit_cast(bf16x8, t4);
        }
    }
    f32x16 o0, o1;
#pragma unroll
    for (int i = 0; i < 16; ++i) { o0[i] = 0.f; o1[i] = 0.f; }
    float R = 0.f;
    for (int kt = qt; kt >= 0; --kt) {
        const int key0 = kt * 32;
        bf16x8 kf[4]; u32x2 vf[2][2][2];
        {
            const bf16_t* kp = qkb + SBW + (size_t)(key0 + r) * PJB;
#pragma unroll
            for (int s = 0; s < 4; ++s) kf[s] = *(const bf16x8*)(kp + 16 * s);
#pragma unroll
            for (int dt = 0; dt < 2; ++dt)
#pragma unroll
                for (int s = 0; s < 2; ++s) { const bf16_t* vp = vtb + (size_t)dt * 32 * SEQ + key0 + 16 * s; vf[dt][s][0] = *(const u32x2*)vp; vf[dt][s][1] = *(const u32x2*)(vp + 8); }
        }
        f32x16 z;
#pragma unroll
        for (int i = 0; i < 16; ++i) z[i] = 0.f;
#pragma unroll
        for (int s = 0; s < 4; ++s) z = __builtin_amdgcn_mfma_f32_32x32x16_bf16(kf[s], qf[s], z, 0, 0, 0);
        const bool diag = (kt == qt);
        float c[16], gs[4];
#pragma unroll
        for (int gi = 0; gi < 4; ++gi) {
            float run = 0.f;
#pragma unroll
            for (int e = 3; e >= 0; --e) {
                const int reg = gi * 4 + e;
                const float zz = z[reg];
                float L = -(fmaxf(zz, 0.f) + __logf(1.f + __expf(-fabsf(zz))));
                if (diag && !(r > e + 8 * gi + 4 * hf)) L = 0.f;
                run += L; c[reg] = run;
            }
            gs[gi] = run;
        }
        float go[4], pp[4], ob[4], off[4];
#pragma unroll
        for (int gi = 0; gi < 4; ++gi) { go[gi] = xhalf(gs[gi]); pp[gi] = gs[gi] + go[gi]; }
        ob[3] = 0.f; ob[2] = pp[3]; ob[1] = pp[3] + pp[2]; ob[0] = ob[1] + pp[1];
#pragma unroll
        for (int gi = 0; gi < 4; ++gi) off[gi] = ob[gi] + (hf == 0 ? go[gi] : 0.f) + R;
        const float total = ob[0] + pp[0];
        unsigned af[8];
#pragma unroll
        for (int i = 0; i < 8; ++i) {
            float a2[2];
#pragma unroll
            for (int q = 0; q < 2; ++q) {
                const int reg = 2 * i + q, gi = reg >> 2, e = reg & 3;
                float a = __expf(z[reg] + c[reg] + off[gi]);
                if (diag && !(r > e + 8 * gi + 4 * hf)) a = 0.f;
                a2[q] = a;
            }
            af[i] = pk2(a2[0], a2[1]);
        }
        R += total;
        const bf16x8 a0 = __builtin_bit_cast(bf16x8, (u32x4){af[0], af[1], af[2], af[3]});
        const bf16x8 a1 = __builtin_bit_cast(bf16x8, (u32x4){af[4], af[5], af[6], af[7]});
        o0 = __builtin_amdgcn_mfma_f32_32x32x16_bf16(__builtin_bit_cast(bf16x8, (u32x4){vf[0][0][0].x, vf[0][0][0].y, vf[0][0][1].x, vf[0][0][1].y}), a0, o0, 0, 0, 0);
        o0 = __builtin_amdgcn_mfma_f32_32x32x16_bf16(__builtin_bit_cast(bf16x8, (u32x4){vf[0][1][0].x, vf[0][1][0].y, vf[0][1][1].x, vf[0][1][1].y}), a1, o0, 0, 0, 0);
        o1 = __builtin_amdgcn_mfma_f32_32x32x16_bf16(__builtin_bit_cast(bf16x8, (u32x4){vf[1][0][0].x, vf[1][0][0].y, vf[1][0][1].x, vf[1][0][1].y}), a0, o1, 0, 0, 0);
        o1 = __builtin_amdgcn_mfma_f32_32x32x16_bf16(__builtin_bit_cast(bf16x8, (u32x4){vf[1][1][0].x, vf[1][1][0].y, vf[1][1][1].x, vf[1][1][1].y}), a1, o1, 0, 0, 0);
        if (__all(R < ATT_EXIT)) break;
    }
    float ss = 0.f;
#pragma unroll
    for (int i = 0; i < 16; ++i) ss += o0[i] * o0[i] + o1[i] * o1[i];
    ss += xhalf(ss);
    const float rs = rsqrtf(ss * (1.f / 64.f) + 1e-6f);
    bf16_t* op = p.h + ((size_t)b * SEQ + qt * 32 + r) * D + RWW + hh * 64 + 4 * hf;
    const float* gn = p.sb_norm_g + l * SBW + hh * 64 + 4 * hf;
#pragma unroll
    for (int gi = 0; gi < 4; ++gi) {
        const f32x4 g0 = *(const f32x4*)(gn + 8 * gi), g1 = *(const f32x4*)(gn + 32 + 8 * gi);
        u32x2 w0, w1;
        w0.x = pk2(o0[4 * gi] * rs * g0[0], o0[4 * gi + 1] * rs * g0[1]); w0.y = pk2(o0[4 * gi + 2] * rs * g0[2], o0[4 * gi + 3] * rs * g0[3]);
        w1.x = pk2(o1[4 * gi] * rs * g1[0], o1[4 * gi + 1] * rs * g1[1]); w1.y = pk2(o1[4 * gi + 2] * rs * g1[2], o1[4 * gi + 3] * rs * g1[3]);
        *(u32x2*)(op + 8 * gi) = w0; *(u32x2*)(op + 32 + 8 * gi) = w1;
    }
}

__device__ __forceinline__ void st_pool(const P& p, int l, int vb, float* smem) {
    const int tid = opaque(threadIdx.x) & 255;
    const int t = vb, s = t % SEQ, g = tid >> 6, c = tid & 63;
    const int win = 2 << g;
    const bf16_t* u = p.proj + (size_t)t * PJB + RWC + SBC + g * 64 + c;
    float sum = 0.f;
    const int n = min(s + 1, win);
    for (int i = 0; i < n; ++i) sum += bf2f(u[-(ptrdiff_t)i * PJB]);
    smem[tid] = sum / (float)n - bf2f(u[0]);
    __syncthreads();
    const float* pw = p.pool_w + ((size_t)l * 4 + g) * 64 * 64 + c;
    float acc = 0.f;
    for (int i = 0; i < 64; ++i) acc += smem[g * 64 + i] * pw[i * 64];
    p.h[(size_t)t * D + 768 + tid] = (bf16_t)f2bf(acc * p.pool_scale[l * PLW + tid]);
    __syncthreads();
}

__device__ __forceinline__ void st_router(const P& p, int l, int vb, float* smem) {
    const int tid = opaque(threadIdx.x) & 255;
    const int wv = tid >> 6, lane = tid & 63;
    const int t = vb * 4 + wv;
    float* sel = smem + wv * 192;
    float* gs = sel + 64;
    const bf16_t* hr = p.h + (size_t)t * D;
    const float* wr = p.w_router + (size_t)l * D * NE + lane;
    float acc = 0.f;
    for (int k = 0; k < D; k += 8) {
        const u32x4 h4 = *(const u32x4*)(hr + k);
        acc += bflo(h4.x) * wr[(size_t)k * NE] + bfhi(h4.x) * wr[(size_t)(k + 1) * NE] + bflo(h4.y) * wr[(size_t)(k + 2) * NE] + bfhi(h4.y) * wr[(size_t)(k + 3) * NE]
             + bflo(h4.z) * wr[(size_t)(k + 4) * NE] + bfhi(h4.z) * wr[(size_t)(k + 5) * NE] + bflo(h4.w) * wr[(size_t)(k + 6) * NE] + bfhi(h4.w) * wr[(size_t)(k + 7) * NE];
    }
    const float score = sigmoidf_(acc);
    const float sl = score + p.b_router[l * NE + lane];
    sel[lane] = sl;
    __syncthreads();
    if (lane < 8) {
        float m1 = -INFINITY, m2 = -INFINITY;
        for (int i = 0; i < 8; ++i) { const float v = sel[lane * 8 + i]; if (v > m1) { m2 = m1; m1 = v; } else if (v > m2) m2 = v; }
        gs[lane] = m1 + m2;
    }
    __syncthreads();
    const int gI = lane >> 3;
    int grank = 0;
    for (int i = 0; i < 8; ++i) { const float v = gs[i]; grank += (v > gs[gI] || (v == gs[gI] && i < gI)) ? 1 : 0; }
    const bool gsel = grank < 4;
    const float msk = gsel ? sl : -INFINITY;
    __syncthreads();
    sel[lane] = msk;
    __syncthreads();
    int rank = 0;
    for (int i = 0; i < 64; ++i) { const float v = sel[i]; rank += (v > msk || (v == msk && i < lane)) ? 1 : 0; }
    const bool chosen = rank < TOPK;
    const float wsum = wave_sum(chosen ? score : 0.f);
    if (chosen) {
        const int pos = atomicAdd(&p.cnt[lane], 1);
        p.list[(size_t)lane * T + pos] = t * TOPK + rank;
        p.topw[(size_t)t * TOPK + rank] = score / (wsum + 1e-20f) * 2.5f;
    }
    __syncthreads();
}

__device__ __forceinline__ void st_combine(const P& p, int l, int vb) {
    const int tid = opaque(threadIdx.x) & 255;
    const int wv = tid >> 6, lane = tid & 63;
    const int t = vb * 4 + wv, b = t / SEQ;
    const float* gt = p.mod + ((size_t)l * 8 + b) * 6144 + 5120;
    const bf16_t* sl = p.slab + (size_t)t * TOPK * D;
#pragma unroll
    for (int i = 0; i < 2; ++i) {
        const int cidx = i * 512 + lane * 8;
        float f[8];
#pragma unroll
        for (int j = 0; j < 8; ++j) f[j] = 0.f;
#pragma unroll
        for (int s = 0; s < TOPK; ++s) {
            const u32x4 q = *(const u32x4*)(sl + (size_t)s * D + cidx);
            f[0] += bflo(q.x); f[1] += bfhi(q.x); f[2] += bflo(q.y); f[3] += bfhi(q.y); f[4] += bflo(q.z); f[5] += bfhi(q.z); f[6] += bflo(q.w); f[7] += bfhi(q.w);
        }
        float* xr = p.xb + (size_t)t * D + cidx;
        float4 x0 = *(float4*)xr, x1 = *(float4*)(xr + 4);
        const float4 g0 = *(const float4*)(gt + cidx), g1 = *(const float4*)(gt + cidx + 4);
        x0.x += g0.x * f[0]; x0.y += g0.y * f[1]; x0.z += g0.z * f[2]; x0.w += g0.w * f[3];
        x1.x += g1.x * f[4]; x1.y += g1.y * f[5]; x1.z += g1.z * f[6]; x1.w += g1.w * f[7];
        *(float4*)xr = x0; *(float4*)(xr + 4) = x1;
    }
}

__device__ __forceinline__ void cvt_item(const float* W, int K, int N, int k0, int n0, bf16_t* WT, int dst_row0, LAS float* scr, int lane) {
#pragma unroll 8
    for (int i = 0; i < 32; ++i) { const int kk = 2 * i + (lane >> 5); scr[kk * 33 + (lane & 31)] = W[(size_t)(k0 + kk) * N + n0 + (lane & 31)]; }
    asm volatile("s_waitcnt lgkmcnt(0)" ::: "memory");
    const int c = lane & 7;
#pragma unroll
    for (int j = 0; j < 4; ++j) { const int n = (lane >> 3) + 8 * j; const LAS float* s = scr + (8 * c) * 33 + n;
        u32x4 o; o.x = pk2(s[0 * 33], s[1 * 33]); o.y = pk2(s[2 * 33], s[3 * 33]); o.z = pk2(s[4 * 33], s[5 * 33]); o.w = pk2(s[6 * 33], s[7 * 33]);
        *(u32x4*)(WT + (size_t)(dst_row0 + n) * K + k0 + 8 * c) = o; }
    asm volatile("s_waitcnt lgkmcnt(0)" ::: "memory");
}
constexpr int CV_IN = 16 * 84, CV_VR = 16, CV_OUT = 16 * 32, CV_DENSE_L = CV_IN + CV_VR + CV_OUT, CV_DENSE = NL * CV_DENSE_L;
__device__ __forceinline__ void cvt_dense_item(const P& p, int it, LAS float* scr, int lane) {
    const int l = it / CV_DENSE_L; int r = it % CV_DENSE_L;
    bf16_t* wti = p.wt_in + (size_t)l * PJB * D;
    if (r < CV_IN) { const int kb = r / 84, nb = r % 84; cvt_item(p.w_in + (size_t)l * D * INC, D, INC, kb * 64, nb * 32, wti, nb * 32, scr, lane); return; }
    r -= CV_IN;
    if (r < CV_VR) {
        if (l == 1) cvt_item(p.w_vres, D, 32, r * 64, 0, wti, INC, scr, lane);
        const int rz0 = (l == 1) ? INC + 32 : INC;
        for (int row = rz0 + (lane >> 3); row < PJB; row += 8) *(u32x4*)(wti + (size_t)row * D + r * 64 + (lane & 7) * 8) = (u32x4){0u, 0u, 0u, 0u};
        return;
    }
    r -= CV_VR;
    { const int kb = r / 32, nb = r % 32; cvt_item(p.w_out + (size_t)l * D * D, D, D, kb * 64, nb * 32, p.wt_out + (size_t)l * D * D, nb * 32, scr, lane); }
}
constexpr int CV_EXP_E = 128 + 128 + 128, CV_EXP = 65 * CV_EXP_E;
__device__ __forceinline__ void cvt_exp_item(const P& p, int l, int it, LAS float* scr, int lane) {
    const int e = it / CV_EXP_E; int r = it % CV_EXP_E;
    if (r < 256) {
        const int which = r >> 7; r &= 127; const int kb = r >> 3, nb = r & 7;
        const float* W = e < NE ? (which ? p.w_eu : p.w_eg) + ((size_t)l * NE + e) * D * ED : (which ? p.w_su : p.w_sg) + (size_t)l * D * ED;
        const int n0 = nb * 32, pn = n0 >> 7;
        cvt_item(W, D, ED, kb * 64, n0, p.wt1 + (size_t)e * 512 * D, pn * 256 + which * 128 + (n0 & 127), scr, lane);
    } else {
        r -= 256; const int kb = r >> 5, nb = r & 31;
        const float* W = e < NE ? p.w_ed + ((size_t)l * NE + e) * ED * D : p.w_sd + (size_t)l * ED * D;
        cvt_item(W, ED, D, kb * 64, nb * 32, p.wt2 + (size_t)e * D * ED, nb * 32, scr, lane);
    }
}

#define XB_TMO      128
#define XB_XCNT(j)  (256  + 64 * (j))
#define XB_XSUB(j)  (1280 + 64 * (j))
#define XB_XGEN(j)  (2304 + 64 * (j))
#define XB_TOP      3328
#define XB_TOPGEN   3392
#define XCD_BAR_WORDS 3456
#define XB_SPIN_CAP (1u << 22)
__device__ __forceinline__ unsigned xb_ld(unsigned* p)              { return __hip_atomic_load(p, __ATOMIC_RELAXED, __HIP_MEMORY_SCOPE_AGENT); }
__device__ __forceinline__ unsigned xb_add(unsigned* p, unsigned v) { return __hip_atomic_fetch_add(p, v, __ATOMIC_RELAXED, __HIP_MEMORY_SCOPE_AGENT); }
__device__ __forceinline__ unsigned xb_xcc_id() { return (unsigned)__builtin_amdgcn_s_getreg((3 << 11) | 20) & 0xFu; }
#define XB_SPIN(cond, bar) do { unsigned _sp = 0; while (cond) { __builtin_amdgcn_s_sleep(1); \
    if ((++_sp & 255u) == 0u) { if (xb_ld(&(bar)[XB_TMO])) break; if (_sp > XB_SPIN_CAP) { atomicAdd(&(bar)[XB_TMO], 1u); break; } } } } while (0)
struct XcdBarrier { unsigned* bar; unsigned x; volatile LAS unsigned* st; };
__device__ __forceinline__ XcdBarrier xcd_barrier_post(unsigned* bar, volatile LAS unsigned* st) {
    XcdBarrier b; b.bar = bar; b.x = xb_xcc_id(); b.st = st;
    if (threadIdx.x == 0) (void)xb_add(&bar[XB_XCNT(b.x)], 1u);
    return b;
}
__device__ __forceinline__ void xcd_barrier_complete(unsigned* bar, unsigned x, unsigned& nloc, unsigned& nx) {
    const unsigned G = gridDim.x * gridDim.y * gridDim.z;
    unsigned sum, cnt, mine, sp = 0u;
    for (;;) {
        sum = 0u; cnt = 0u; mine = 0u;
#pragma unroll
        for (unsigned j = 0; j < 16; ++j) { const unsigned c = xb_ld(&bar[XB_XCNT(j)]); sum += c; cnt += (c > 0u) ? 1u : 0u; mine = (j == x) ? c : mine; }
        if (sum == G) break;
        __builtin_amdgcn_s_sleep(1);
        if ((++sp & 255u) == 0u) { if (xb_ld(&bar[XB_TMO])) break; if (sp > XB_SPIN_CAP) { atomicAdd(&bar[XB_TMO], 1u); break; } }
    }
    nloc = mine > 0u ? mine : 1u; nx = cnt > 0u ? cnt : 1u;
}
__device__ __forceinline__ void xcd_barrier(const XcdBarrier& b0) {
    XcdBarrier b = b0; { unsigned xx = b0.x; asm volatile("" : "+s"(xx)); b.x = xx; }
    asm volatile("s_waitcnt vmcnt(0)" ::: "memory");
    __syncthreads();
    if (threadIdx.x == 0) {
        unsigned* bar = b.bar;
        __builtin_amdgcn_s_waitcnt(0);
        unsigned nloc = b.st[0], nx = b.st[1];
        if (nloc == 0u) { xcd_barrier_complete(bar, b.x, nloc, nx); b.st[0] = nloc; b.st[1] = nx; }
        const unsigned old = xb_add(&bar[XB_XSUB(b.x)], 1u);
        const unsigned gen = old / nloc;
        if (old + 1u == (gen + 1u) * nloc) {
            __builtin_amdgcn_fence(__ATOMIC_RELEASE, "agent");
            asm volatile("s_waitcnt vmcnt(0)" ::: "memory");
            const unsigned og = xb_add(&bar[XB_TOP], 1u);
            const unsigned tg = og / nx;
            if (og + 1u == (tg + 1u) * nx) xb_add(&bar[XB_TOPGEN], 1u);
            else XB_SPIN(xb_ld(&bar[XB_TOPGEN]) == tg, bar);
            __builtin_amdgcn_fence(__ATOMIC_ACQUIRE, "agent");
            xb_add(&bar[XB_XGEN(b.x)], 1u);
            asm volatile("s_waitcnt vmcnt(0)" ::: "memory");
        } else {
            XB_SPIN(xb_ld(&bar[XB_XGEN(b.x)]) == gen, bar);
            __builtin_amdgcn_fence(__ATOMIC_ACQUIRE, "agent");
            asm volatile("s_waitcnt vmcnt(0)" ::: "memory");
        }
    }
    __syncthreads();
}

enum Ph { PH_NORM1 = 0, PH_INPROJ, PH_PREP, PH_MIX, PH_RWOUT, PH_OUTPROJ, PH_NORM2, PH_ROUTER, PH_EXP1, PH_EXP2, PH_COMBINE, PH_PER_LAYER };

__global__ void __launch_bounds__(NTHREADS, 2) k_fused(P p) {
    extern __shared__ __attribute__((aligned(16))) unsigned char lds_raw[];
    LAS unsigned char* lds = (LAS unsigned char*)lds_raw;
    LAS int* tstart = (LAS int*)(lds + LDS_STAGE);
    LAS int* cnts = (LAS int*)(lds + LDS_STAGE + 272);
    volatile LAS unsigned* bst = (volatile LAS unsigned*)(lds + LDS_STAGE + 1008);
    const int G = gridDim.x, bx = blockIdx.x;
    const int vcu = (G % 8 == 0) ? (bx % 8) * (G / 8) + bx / 8 : bx;
    if (threadIdx.x < 4) bst[threadIdx.x] = 0u;
    __syncthreads();
    XcdBarrier xb = xcd_barrier_post(p.bar, bst);
#define PHASE_COORDS() const int tid = opaque(threadIdx.x), half = tid >> 8, lane = tid & 63, wave = __builtin_amdgcn_readfirstlane(tid >> 6); \
    float* smem = (float*)lds_raw + half * 8192; LAS float* scr = (LAS float*)(lds + wave * 16384); (void)lane; (void)smem; (void)scr; (void)tid

    {
        PHASE_COORDS();
        for (int wb = bx; wb < 24; wb += G) st_mod(p, wb * 2 + half, smem);
        __syncthreads();
        for (int it = (bx * 8 + wave); it < CV_DENSE; it += G * 8) cvt_dense_item(p, it, scr, lane);
    }
    xcd_barrier(xb);

    for (int ph = 0; ph < NL * PH_PER_LAYER; ++ph) {
        const int l = ph / PH_PER_LAYER, st = ph % PH_PER_LAYER;
        PHASE_COORDS();
        if (st == PH_NORM1) {
            for (int wb = bx; wb < T / 8; wb += G) st_norm(p, l, 0, wb * 2 + half);
        } else if (st == PH_INPROJ) {
            pg8::DenseOrder S; S.init(p.h, p.wt_in + (size_t)l * PJB * D, T, PJB, D, G, bx);
            pg8::EpiProj E{p.proj, p.vt};
            pg8::gemm_phase<pg8::EpiProj, pg8::DenseOrder, true, true>(lds, D, S, E);
        } else if (st == PH_PREP) {
            for (int wb = bx; wb < T / 32; wb += G) st_prep(p, l, wb, (LAS float*)lds);
        } else if (st == PH_MIX) {
            constexpr int N1 = NBATCH * 6 * 2, N2 = NBATCH * 6 * (SEQ / 32) / 8, N3 = T / 2, N4 = (CV_EXP + 7) / 8;
            const bool split = G >= 2 * N1;
            const int ob = split ? bx - N1 : bx, og = split ? G - N1 : G;
            if (split ? (bx < N1) : true) for (int wb = bx; wb < N1; wb += G) st_scan(p, wb, lds);
            if (ob >= 0) for (int wb = ob; wb < N2 + N3 + N4; wb += og) {
                if (wb < N2) st_attn(p, l, wb * 8 + wave);
                else if (wb < N2 + N3) st_pool(p, l, (wb - N2) * 2 + half, smem);
                else { const int it = (wb - N2 - N3) * 8 + wave; __syncthreads(); if (it < CV_EXP) cvt_exp_item(p, l, it, scr, lane); __syncthreads(); }
            }
        } else if (st == PH_RWOUT) {
            for (int wb = bx; wb < T * 6 / 8; wb += G) st_rwout(p, l, wb * 2 + half);
        } else if (st == PH_OUTPROJ) {
            pg8::DenseOrder S; S.init(p.h, p.wt_out + (size_t)l * D * D, T, D, D, G, bx);
            pg8::EpiOut E{l == 0 ? p.x : p.xb, p.xb, p.mod + (size_t)l * 8 * 6144 + 2048};
            pg8::gemm_phase<pg8::EpiOut, pg8::DenseOrder, true, true>(lds, D, S, E);
        } else if (st == PH_NORM2) {
            for (int wb = bx; wb < T / 8; wb += G) st_norm(p, l, 1, wb * 2 + half);
        } else if (st == PH_ROUTER) {
            for (int wb = bx; wb < T / 8; wb += G) st_router(p, l, wb * 2 + half, smem);
        } else if (st == PH_EXP1 || st == PH_EXP2) {
            __syncthreads();
            if (tid == 0) {
                int acc = 0;
                for (int e = 0; e < 65; ++e) { const int c = e < NE ? p.cnt[e] : T; cnts[e] = c; tstart[e] = acc; acc += (c + 255) >> 8; }
                tstart[65] = acc;
            }
            __syncthreads();
            if (st == PH_EXP1) {
                pg8::MoeOrder<true> S{tstart, cnts, p.list, p.h, p.wt1, D, 512, 1, G, vcu};
                pg8::EpiExp1 E{p.hm};
                pg8::gemm_phase<pg8::EpiExp1, pg8::MoeOrder<true>, true, true>(lds, D, S, E);
            } else {
                pg8::MoeOrder<false> S{tstart, cnts, p.list, p.hm, p.wt2, ED, D, 2, G, vcu};
                pg8::EpiExp2 E{p.slab, p.xb, p.mod + (size_t)l * 8 * 6144 + 5120, p.list, p.topw, cnts};
                pg8::gemm_phase<pg8::EpiExp2, pg8::MoeOrder<false>, true, true>(lds, ED, S, E);
            }
        } else {
            for (int wb = bx; wb < T / 8; wb += G) st_combine(p, l, wb * 2 + half);
        }
        xcd_barrier(xb);
    }
    { PHASE_COORDS(); for (int wb = bx; wb < T / 8; wb += G) st_norm(p, 0, 2, wb * 2 + half); }
#undef PHASE_COORDS
}

}

extern "C" void kernel_launch(void* const* d_in, const int* in_sizes, int n_in, void* d_out, int out_size, void* d_ws, size_t ws_size,
                              hipStream_t stream) {
    P p{};
    const float** fp = (const float**)&p;
    for (int i = 0; i < 33; ++i) fp[i] = (const float*)d_in[i];
    p.out = (float*)d_out;
    char* ws = (char*)d_ws;
    size_t off = 0;
    auto take = [&](size_t bytes) { char* r = ws + off; off += (bytes + 255) & ~(size_t)255; return r; };
    p.bar = (unsigned*)take(16384);
    p.cnt = (int*)take(256);
    p.mod = (float*)take((size_t)NL * 8 * 6144 * 4);
    p.list = (int*)take((size_t)NE * T * 4);
    p.topw = (float*)take((size_t)T * TOPK * 4);
    p.wt_in = (bf16_t*)take((size_t)NL * PJB * D * 2);
    p.wt_out = (bf16_t*)take((size_t)NL * D * D * 2);
    p.wt1 = (bf16_t*)take((size_t)65 * 512 * D * 2);
    p.wt2 = (bf16_t*)take((size_t)65 * D * ED * 2);
    p.xb = (float*)take((size_t)T * D * 4);
    p.h = (bf16_t*)take((size_t)T * D * 2);
    p.vfirst = (float*)take((size_t)T * RWW * 4);
    const size_t ov = off;
    p.proj = (bf16_t*)take((size_t)T * PJB * 2);
    p.vt = (bf16_t*)take((size_t)T * SBW * 2);
    p.rec = (float*)take((size_t)T * 6 * 6 * 64 * 4);
    p.g = (float*)take((size_t)T * RWW * 4);
    p.y = (float*)take((size_t)T * RWW * 4);
    p.hm = (bf16_t*)(ws + ov);
    p.slab = (bf16_t*)(ws + ov + (size_t)MAXRT * 256 * ED * 2);
    const size_t end_moe = ov + (size_t)MAXRT * 256 * ED * 2 + (size_t)T * TOPK * D * 2;
    if (end_moe > off) off = end_moe;
    if (off > ws_size) return;

    static int cus = 0;
    if (cus == 0) {
        int dev = 0, n = 0;
        if (hipGetDevice(&dev) != hipSuccess || hipDeviceGetAttribute(&n, hipDeviceAttributeMultiprocessorCount, dev) != hipSuccess || n <= 0) n = 256;
        (void)hipFuncSetAttribute((const void*)k_fused, hipFuncAttributeMaxDynamicSharedMemorySize, LDS_BYTES);
        cus = n;
    }
    (void)hipMemsetAsync(p.bar, 0, 16384 + 256, stream);
    void* args[] = {(void*)&p};
    (void)hipLaunchCooperativeKernel((const void*)k_fused, dim3(cus), dim3(NTHREADS), args, LDS_BYTES, stream);
}
```

```cpp
#include <hip/hip_runtime.h>
#include <stdint.h>
#include <stdio.h>

#define REP_PH -2
#define REP_N 1
#define REP_SEL 15

namespace {

typedef unsigned short bf16_t;
typedef short bf16x8 __attribute__((ext_vector_type(8)));
typedef float f32x4 __attribute__((ext_vector_type(4)));
typedef unsigned u32x4 __attribute__((ext_vector_type(4)));
typedef unsigned u32x2 __attribute__((ext_vector_type(2)));
#define LAS __attribute__((address_space(3)))

constexpr int D = 1024, NBATCH = 8, SEQ = 2048, T = NBATCH * SEQ, NL = 2;
constexpr int RWW = 384, SBW = 384, PLW = 256;
constexpr int RWC = 1280, SBC = 1152, INC = 2688;
constexpr int PJB = 2816;
constexpr int NE = 64, TOPK = 6, ED = 256;
constexpr int MAXRT = 512;
constexpr int NTHREADS = 512;
constexpr int LDS_STAGE = 131072, LDS_CTL = 1024, LDS_BYTES = LDS_STAGE + LDS_CTL;

struct P {
    const float *x, *c, *w_ada, *b_ada, *w_in, *w_vres, *mu_rw, *mu_vres, *rw_w0, *rw_w2, *rw_a0, *rw_a2,
        *rw_v0, *rw_v2, *rw_g2, *rw_k_k, *rw_k_a, *rw_r_k, *rw_ln_g, *rw_ln_b, *sb_norm_g, *pool_w, *pool_scale,
        *w_out, *w_router, *b_router, *w_eg, *w_eu, *w_ed, *w_sg, *w_su, *w_sd, *g_final;
    float* out;
    unsigned* bar;
    float* mod;
    int* cnt;
    int* list;
    int* cnt2;
    int* seg;
    float* topw;
    bf16_t* wt_in;
    bf16_t* wt_out;
    bf16_t* wt1;
    bf16_t* wt2;
    float* xb;
    bf16_t* h;
    bf16_t* vfirst;
    bf16_t* proj;
    bf16_t* vt;
    float* rec;
    bf16_t* g;
    float* y;
    bf16_t* hm;
    bf16_t* slab;
};

__device__ __forceinline__ int opaque(int x) { asm volatile("" : "+v"(x)); return x; }
__device__ __forceinline__ float wave_sum(float v) {
#pragma unroll
    for (int o = 32; o > 0; o >>= 1) v += __shfl_xor(v, o);
    return v;
}
__device__ __forceinline__ float sigmoidf_(float x) { return 1.f / (1.f + __expf(-x)); }
__device__ __forceinline__ float softplusf_(float x) { return fmaxf(x, 0.f) + log1pf(__expf(-fabsf(x))); }
__device__ __forceinline__ float siluf_(float x) { return x / (1.f + __expf(-x)); }
__device__ __forceinline__ unsigned f2bf(float f) { unsigned u = __builtin_bit_cast(unsigned, f); return (u + 0x7fffu + ((u >> 16) & 1u)) >> 16; }
__device__ __forceinline__ unsigned pk2(float lo, float hi) { return f2bf(lo) | (f2bf(hi) << 16); }
__device__ __forceinline__ float bf2f(bf16_t h) { return __builtin_bit_cast(float, (unsigned)h << 16); }
__device__ __forceinline__ float bflo(unsigned u) { return __builtin_bit_cast(float, u << 16); }
__device__ __forceinline__ float bfhi(unsigned u) { return __builtin_bit_cast(float, u & 0xffff0000u); }

namespace pg8 {
constexpr int BM = 256, BK = 64, HALF = 128, HTB = HALF * BK * 2, STAGE_BYTES = 8 * HTB;
__device__ __forceinline__ int lds_byte(int r, int c) { const int st = (r >> 4) * 2 + (c >> 5), rr = r & 15, cc = c & 31, ob = rr * 64 + cc * 2; return st * 1024 + (ob ^ (((ob >> 9) & 1) << 5)); }
__device__ __forceinline__ void stage_rc(int b, int& R, int& C) { const int st = b / 1024, sb = b % 1024, swz = sb ^ (((sb >> 9) & 1) << 5); R = (st >> 1) * 16 + swz / 64; C = (st & 1) * 32 + (swz % 64) / 2; }
__device__ __forceinline__ int perm32(int rho) { const int n = rho >> 4, i = rho & 15; return 8 * (i >> 2) + 4 * n + (i & 3); }

struct Unit { int pm, pn, e, mt; };

template <class Epi, class Sched, bool ALIGN_EPI, bool SP2>
__device__ __forceinline__ void gemm_phase(LAS unsigned char* lds, const int K, const Sched& S, const Epi& E) {
    const int tid = opaque(threadIdx.x), wid = __builtin_amdgcn_readfirstlane(tid >> 6), lane = tid & 63, wr = wid >> 2, wc = wid & 3, fr = lane & 15, fq = lane >> 4;
    const int nt = K / BK;
    unsigned voffA[2], voffB[2];
#pragma unroll
    for (int i = 0; i < 2; ++i) { int R, C; stage_rc(tid * 16 + i * 8192, R, C); const int Rb = Epi::PERM ? ((R & ~31) + perm32(R & 31)) : R;
        voffA[i] = Sched::GATHER ? (unsigned)(C * 2) : (unsigned)(R * K + C) * 2u; voffB[i] = (unsigned)(Rb * K + C) * 2u; }
    const size_t kstep = (size_t)(BK * 2);
    const size_t hstep = (size_t)HALF * K * 2;
    const unsigned ldsw = (unsigned)wid * 1024u;
    const int aoff = lds_byte(wr * 64 + fr, fq * 8), boff = lds_byte(wc * 32 + fr, fq * 8);
#define PG8_SA(b, h) (((b) * 2 + (h)) * HTB)
#define PG8_SB(b, h) ((4 + (b) * 2 + (h)) * HTB)
#define PG8_STAGE(bufoff, gbase, voff) do { _Pragma("unroll") for (int _i = 0; _i < 2; ++_i) \
        __builtin_amdgcn_global_load_lds((const unsigned*)((const char*)(gbase) + (voff)[_i]), (LAS unsigned*)(lds + (bufoff) + ldsw + _i * 8192), 16, 0, 0); } while (0)
#define PG8_LDA(dst, b, h) do { _Pragma("unroll") for (int m = 0; m < 4; ++m) _Pragma("unroll") for (int k = 0; k < 2; ++k) dst[m][k] = *(const LAS bf16x8*)(lds + PG8_SA(b, h) + aoff + m * 2048 + k * 1024); } while (0)
#define PG8_LDB(dst, b, h) do { _Pragma("unroll") for (int n = 0; n < 2; ++n) _Pragma("unroll") for (int k = 0; k < 2; ++k) dst[n][k] = *(const LAS bf16x8*)(lds + PG8_SB(b, h) + boff + n * 2048 + k * 1024); } while (0)
#define PG8_MMA(ai, bj, At, Bt) do { __builtin_amdgcn_s_setprio(1); _Pragma("unroll") for (int m = 0; m < 4; ++m) _Pragma("unroll") for (int n = 0; n < 2; ++n) _Pragma("unroll") for (int k = 0; k < 2; ++k) \
        acc[ai][bj][m][n] = __builtin_amdgcn_mfma_f32_16x16x32_bf16(Bt[n][k], At[m][k], acc[ai][bj][m][n], 0, 0, 0); __builtin_amdgcn_s_setprio(0); } while (0)
#define PG8_WAIT_V(n) asm volatile("s_waitcnt vmcnt(" #n ")" ::: "memory")
#define PG8_WAIT_L(n) asm volatile("s_waitcnt lgkmcnt(" #n ")" ::: "memory")
#define PG8_BAR __builtin_amdgcn_s_barrier()
#define PG8_SCHED __builtin_amdgcn_sched_barrier(0)
    Unit cur, nxt; int ui = 0;
    if (!S.next(0, cur)) return;
    f32x4 acc[2][2][4][2];
#pragma unroll
    for (int a = 0; a < 2; ++a)
#pragma unroll
        for (int b = 0; b < 2; ++b)
#pragma unroll
            for (int m = 0; m < 4; ++m)
#pragma unroll
                for (int n = 0; n < 2; ++n) acc[a][b][m][n] = (f32x4){0.f, 0.f, 0.f, 0.f};
    bf16x8 At[4][2], B0[2][2], B1[2][2];
    const char* cA = S.a_base(cur); const char* cB = S.b_base(cur);
    unsigned pk[2] = {0u, 0u}, npk[2] = {0u, 0u};
    if constexpr (Sched::GATHER) S.a_tok(cur, tid, pk);
    const unsigned k2 = (unsigned)K * 2u;
#define PG8_STAGE_A(bufoff, gbase, hh, PK) do { if constexpr (Sched::GATHER) { unsigned _v[2]; _v[0] = (((PK)[0] >> (16 * (hh))) & 0xffffu) * k2 + voffA[0]; _v[1] = (((PK)[1] >> (16 * (hh))) & 0xffffu) * k2 + voffA[1]; \
        PG8_STAGE(bufoff, gbase, _v); } else { PG8_STAGE(bufoff, (gbase) + (hh) * hstep, voffA); } } while (0)
    static_assert(SP2, "only the SP2 loop is kept");
    PG8_STAGE(PG8_SB(0, 0), cB, voffB); PG8_STAGE(PG8_SB(0, 1), cB + hstep, voffB); PG8_STAGE_A(PG8_SA(0, 0), cA, 0, pk); PG8_STAGE_A(PG8_SA(0, 1), cA, 1, pk);
    if (wr == 1) PG8_BAR;
    PG8_WAIT_V(2); PG8_BAR;
    PG8_STAGE(PG8_SB(1, 0), cB + kstep, voffB); PG8_STAGE_A(PG8_SA(1, 0), cA + kstep, 0, pk); PG8_STAGE(PG8_SB(1, 1), cB + hstep + kstep, voffB);
    PG8_WAIT_V(6); PG8_BAR;
    for (;;) {
        const bool has_next = S.next(ui + 1, nxt);
        const char* nA = has_next ? S.a_base(nxt) : cA; const char* nB = has_next ? S.b_base(nxt) : cB;
        if constexpr (Sched::GATHER) { if (has_next) S.a_tok(nxt, tid, npk); else { npk[0] = pk[0]; npk[1] = pk[1]; } }
#pragma unroll 1
        for (int t = 0; t < nt; t += 2) {
            const bool last = (t == nt - 2);
            const char* a1 = cA + (size_t)(t + 1) * kstep;
            const char* a2 = last ? nA : cA + (size_t)(t + 2) * kstep; const char* b2 = last ? nB : cB + (size_t)(t + 2) * kstep;
            const char* a3 = a2 + kstep; const char* b3 = b2 + kstep;
            unsigned sp[2]; sp[0] = last ? npk[0] : pk[0]; sp[1] = last ? npk[1] : pk[1];
            PG8_LDB(B0, 0, 0); PG8_LDB(B1, 0, 1); PG8_SCHED; PG8_LDA(At, 0, 0); PG8_STAGE_A(PG8_SA(1, 1), a1, 1, pk);
            PG8_WAIT_V(8); PG8_WAIT_L(0); PG8_BAR; PG8_MMA(0, 0, At, B0); PG8_MMA(0, 1, At, B1); PG8_BAR; PG8_SCHED;
            PG8_LDA(At, 0, 1); PG8_STAGE(PG8_SB(0, 0), b2, voffB); PG8_STAGE(PG8_SB(0, 1), b2 + hstep, voffB); PG8_STAGE_A(PG8_SA(0, 0), a2, 0, sp);
            PG8_WAIT_V(8); PG8_WAIT_L(0); PG8_BAR; PG8_MMA(1, 0, At, B0); PG8_MMA(1, 1, At, B1); PG8_BAR; PG8_SCHED;
            PG8_LDB(B0, 1, 0); PG8_LDB(B1, 1, 1); PG8_SCHED; PG8_LDA(At, 1, 0); PG8_STAGE_A(PG8_SA(0, 1), a2, 1, sp);
            PG8_WAIT_V(8); PG8_WAIT_L(0); PG8_BAR; PG8_MMA(0, 0, At, B0); PG8_MMA(0, 1, At, B1); PG8_BAR; PG8_SCHED;
            PG8_LDA(At, 1, 1); PG8_STAGE(PG8_SB(1, 0), b3, voffB); PG8_STAGE(PG8_SB(1, 1), b3 + hstep, voffB); PG8_STAGE_A(PG8_SA(1, 0), a3, 0, sp);
            PG8_WAIT_V(8); PG8_WAIT_L(0); PG8_BAR; PG8_MMA(1, 0, At, B0); PG8_MMA(1, 1, At, B1); PG8_BAR; PG8_SCHED;
        }
        if constexpr (ALIGN_EPI) { if (wr == 0) PG8_BAR; }
        { const int t2 = opaque(threadIdx.x), w2 = __builtin_amdgcn_readfirstlane(t2 >> 6), l2 = t2 & 63; E(acc, cur, w2 >> 2, w2 & 3, l2 & 15, l2 >> 4); }
        if (!has_next) break;
#pragma unroll
        for (int a = 0; a < 2; ++a)
#pragma unroll
            for (int b = 0; b < 2; ++b)
#pragma unroll
                for (int m = 0; m < 4; ++m)
#pragma unroll
                    for (int n = 0; n < 2; ++n) acc[a][b][m][n] = (f32x4){0.f, 0.f, 0.f, 0.f};
        cur = nxt; cA = nA; cB = nB; ++ui;
        pk[0] = npk[0]; pk[1] = npk[1];
        if constexpr (ALIGN_EPI) { if (wr == 1) PG8_BAR; }
    }
    PG8_WAIT_V(0);
    if constexpr (!ALIGN_EPI) { if (wr == 0) PG8_BAR; }
    PG8_BAR;
#undef PG8_SA
#undef PG8_SB
#undef PG8_STAGE
#undef PG8_STAGE_A
#undef PG8_LDA
#undef PG8_LDB
#undef PG8_MMA
#undef PG8_WAIT_V
#undef PG8_WAIT_L
#undef PG8_BAR
#undef PG8_SCHED
}

struct DenseOrder {
    const bf16_t* A; const bf16_t* Bt; int K; int nM, nN, nwg, G, c;
    __device__ __forceinline__ void init(const bf16_t* A_, const bf16_t* Bt_, int M, int N, int K_, int G_, int c_) { A = A_; Bt = Bt_; K = K_; nM = M / BM; nN = N / BM; nwg = nM * nN; G = G_; c = c_; }
    __device__ __forceinline__ bool next(int i, Unit& u) const {
        const long L = (long)i * G + c; if (L >= nwg) return false;
        int wgid = (int)L; { const int q = nwg / 8, r = nwg % 8, xcd = wgid % 8, off = wgid / 8; wgid = (xcd < r ? xcd * (q + 1) : r * (q + 1) + (xcd - r) * q) + off; }
        const int nig = 8 * nN, gid = wgid / nig, fm = gid * 8, gsz = (nM - fm) < 8 ? (nM - fm) : 8;
        u.pm = fm + ((wgid % nig) % gsz); u.pn = (wgid % nig) / gsz; u.e = 0; u.mt = 0; return true;
    }
    __device__ __forceinline__ const char* a_base(const Unit& u) const { return (const char*)A + (size_t)u.pm * BM * K * 2; }
    __device__ __forceinline__ const char* b_base(const Unit& u) const { return (const char*)Bt + (size_t)u.pn * BM * K * 2; }
    static constexpr bool GATHER = false;
    __device__ __forceinline__ void a_tok(const Unit&, int, unsigned (&)[2]) const {}
};

template <bool GATHER_>
struct MoeOrder {
    static constexpr bool GATHER = GATHER_;
    const LAS int* tstart;
    const LAS int* cnts;
    const int* list;
    const bf16_t* A;
    const bf16_t* Bt;
    int K, N, lognpn, G, c;
    __device__ __forceinline__ bool next(int i, Unit& u) const {
        const int L = i * G + c; const int total = __builtin_amdgcn_readfirstlane(tstart[65]) << lognpn; if (L >= total) return false;
        const int rt = L >> lognpn; u.pn = L & ((1 << lognpn) - 1); u.pm = rt;
        int e = 0;
        for (int j = 1; j < 65; ++j) e += (tstart[j] <= rt) ? 1 : 0;
        e = __builtin_amdgcn_readfirstlane(e);
        u.e = e; u.mt = rt - __builtin_amdgcn_readfirstlane(tstart[e]); return true;
    }
    __device__ __forceinline__ const char* a_base(const Unit& u) const { return GATHER ? (const char*)A : (const char*)A + (size_t)u.pm * BM * K * 2; }
    __device__ __forceinline__ const char* b_base(const Unit& u) const { return (const char*)Bt + ((size_t)u.e * N + (size_t)u.pn * BM) * K * 2; }
    __device__ __forceinline__ void a_tok(const Unit& u, int tid, unsigned (&pkv)[2]) const {
        const int ce = cnts[u.e];
#pragma unroll
        for (int i = 0; i < 2; ++i) {
            int R, C; stage_rc(tid * 16 + i * 8192, R, C); (void)C;
            unsigned v = 0u;
#pragma unroll
            for (int hh = 0; hh < 2; ++hh) {
                const int idx = u.mt * BM + hh * HALF + R;
                int tok = 0;
                if (idx < ce) tok = (u.e < NE) ? (list[(size_t)u.e * T + idx] / TOPK) : idx;
                v |= (unsigned)tok << (16 * hh);
            }
            pkv[i] = v;
        }
    }
};

struct EpiProj {
    static constexpr bool PERM = true;
    bf16_t* O; bf16_t* vt;
    __device__ __forceinline__ void operator()(const f32x4 (&acc)[2][2][4][2], const Unit& u, int wr, int wc, int fr, int fq) const {
        const int row0 = u.pm * BM + wr * 64 + fr, col0 = u.pn * BM + wc * 32 + 8 * fq;
#pragma unroll
        for (int bj = 0; bj < 2; ++bj) {
            const bool isv = (u.pn == 8) || (u.pn == 9 && bj == 0);
            if (!isv) {
#pragma unroll
                for (int ai = 0; ai < 2; ++ai)
#pragma unroll
                    for (int m = 0; m < 4; ++m) { bf16_t* rowp = O + (size_t)(row0 + ai * HALF + m * 16) * PJB + col0 + bj * HALF;
                        const f32x4 v0 = acc[ai][bj][m][0], v1 = acc[ai][bj][m][1];
                        u32x4 w; w.x = pk2(v0[0], v0[1]); w.y = pk2(v0[2], v0[3]); w.z = pk2(v1[0], v1[1]); w.w = pk2(v1[2], v1[3]);
                        *(u32x4*)rowp = w; }
            } else {
                const int vc0 = col0 + bj * HALF - 2048;
#pragma unroll
                for (int ai = 0; ai < 2; ++ai)
#pragma unroll
                    for (int m = 0; m < 4; ++m) { const int row = row0 + ai * HALF + m * 16; const int b = row / SEQ, s = row % SEQ;
                        bf16_t* base = vt + ((size_t)b * SBW + vc0) * SEQ + s;
#pragma unroll
                        for (int n = 0; n < 2; ++n)
#pragma unroll
                            for (int j = 0; j < 4; ++j) base[(size_t)(4 * n + j) * SEQ] = (bf16_t)f2bf(acc[ai][bj][m][n][j]); }
            }
        }
    }
};
struct EpiOut {
    static constexpr bool PERM = false;
    const float* xin; float* xo; const float* gt;
    __device__ __forceinline__ void operator()(const f32x4 (&acc)[2][2][4][2], const Unit& u, int wr, int wc, int fr, int fq) const {
        const int row0 = u.pm * BM + wr * 64 + fr, col0 = u.pn * BM + wc * 32 + 4 * fq;
#pragma unroll
        for (int ai = 0; ai < 2; ++ai)
#pragma unroll
            for (int m = 0; m < 4; ++m) { const int row = row0 + ai * HALF + m * 16; const float* gr = gt + (size_t)(row / SEQ) * 6144;
#pragma unroll
                for (int bj = 0; bj < 2; ++bj)
#pragma unroll
                    for (int n = 0; n < 2; ++n) { const int col = col0 + bj * HALF + 16 * n;
                        const f32x4 xi = *(const f32x4*)(xin + (size_t)row * D + col); const f32x4 gg = *(const f32x4*)(gr + col);
                        *(f32x4*)(xo + (size_t)row * D + col) = xi + gg * acc[ai][bj][m][n]; } }
    }
};
struct EpiExp1 {
    static constexpr bool PERM = true;
    bf16_t* hm;
    __device__ __forceinline__ void operator()(const f32x4 (&acc)[2][2][4][2], const Unit& u, int wr, int wc, int fr, int fq) const {
        const int row0 = u.pm * BM + wr * 64 + fr, col0 = u.pn * HALF + wc * 32 + 8 * fq;
#pragma unroll
        for (int ai = 0; ai < 2; ++ai)
#pragma unroll
            for (int m = 0; m < 4; ++m) { bf16_t* rowp = hm + (size_t)(row0 + ai * HALF + m * 16) * ED + col0;
                float o[8];
#pragma unroll
                for (int n = 0; n < 2; ++n)
#pragma unroll
                    for (int j = 0; j < 4; ++j) o[n * 4 + j] = siluf_(acc[ai][0][m][n][j]) * acc[ai][1][m][n][j];
                u32x4 w; w.x = pk2(o[0], o[1]); w.y = pk2(o[2], o[3]); w.z = pk2(o[4], o[5]); w.w = pk2(o[6], o[7]);
                *(u32x4*)rowp = w; }
    }
};
struct EpiExp2 {
    static constexpr bool PERM = true;
    bf16_t* slab; float* xb; const float* gt; const int* list; const float* topw; const LAS int* cnts;
    __device__ __forceinline__ void operator()(const f32x4 (&acc)[2][2][4][2], const Unit& u, int wr, int wc, int fr, int fq) const {
        const int col0 = u.pn * BM + wc * 32 + 8 * fq; const int ce = cnts[u.e];
#pragma unroll
        for (int ai = 0; ai < 2; ++ai)
#pragma unroll
            for (int m = 0; m < 4; ++m) { const int idx = u.mt * BM + ai * HALF + wr * 64 + m * 16 + fr;
                if (idx < ce) {
                    if (u.e < NE) {
                        const int aid = list[(size_t)u.e * T + idx]; const float wgt = topw[aid]; bf16_t* rowp = slab + (size_t)aid * D + col0;
#pragma unroll
                        for (int bj = 0; bj < 2; ++bj) { const f32x4 v0 = acc[ai][bj][m][0] * wgt, v1 = acc[ai][bj][m][1] * wgt;
                            u32x4 w; w.x = pk2(v0[0], v0[1]); w.y = pk2(v0[2], v0[3]); w.z = pk2(v1[0], v1[1]); w.w = pk2(v1[2], v1[3]);
                            *(u32x4*)(rowp + bj * HALF) = w; }
                    } else {
                        const int tok = idx; float* xr = xb + (size_t)tok * D + col0; const float* gr = gt + (size_t)(tok / SEQ) * 6144 + col0;
#pragma unroll
                        for (int bj = 0; bj < 2; ++bj)
#pragma unroll
                            for (int n = 0; n < 2; ++n) { const f32x4 xi = *(const f32x4*)(xr + bj * HALF + 4 * n); const f32x4 gg = *(const f32x4*)(gr + bj * HALF + 4 * n);
                                *(f32x4*)(xr + bj * HALF + 4 * n) = xi + gg * acc[ai][bj][m][n]; }
                    }
                } }
    }
};
}

__device__ __forceinline__ void st_mod(const P& p, int item, LAS float* L  ) {
    const int tid = opaque(threadIdx.x), wave = tid >> 6, lane = tid & 63;
    const int l = item / 96, j0 = (item % 96) * 64;
    for (int i = tid; i < 8 * 1024; i += NTHREADS) L[i] = siluf_(p.c[i]);
    __syncthreads();
    float acc[8];
#pragma unroll
    for (int b = 0; b < 8; ++b) acc[b] = 0.f;
    const float* w = p.w_ada + ((size_t)l * 1024 + wave * 128) * 6144 + j0 + lane;
#pragma unroll 8
    for (int i = 0; i < 128; ++i) {
        const float wv = w[(size_t)i * 6144];
#pragma unroll
        for (int b = 0; b < 8; ++b) acc[b] += L[b * 1024 + wave * 128 + i] * wv;
    }
    LAS float* red = L + 8 * 1024;
#pragma unroll
    for (int b = 0; b < 8; ++b) red[(wave * 8 + b) * 64 + lane] = acc[b];
    __syncthreads();
    {
        const int b = tid >> 6;
        float s = p.b_ada[l * 6144 + j0 + lane];
#pragma unroll
        for (int wv = 0; wv < 8; ++wv) s += red[(wv * 8 + b) * 64 + lane];
        p.mod[((size_t)l * 8 + b) * 6144 + j0 + lane] = s;
    }
    __syncthreads();
}

constexpr int REC_T = 6 * 6 * 64;
__device__ __forceinline__ void st_prep(const P& p, int l, int vb, LAS float* X  ) {
    const int tid = opaque(threadIdx.x);
    const int t0 = vb * 32, s0 = t0 % SEQ;
#pragma unroll
    for (int q = 0; q < 10; ++q) {
        const int it = tid + q * NTHREADS;
        const int tt = it / 160, i = it % 160;
        const int col = (i < 128) ? 1152 + i : INC + (i - 128);
        const float mu = (i < 128) ? p.mu_rw[l * RWC + col] : p.mu_vres[i - 128];
        const bf16_t* u = p.proj + (size_t)(t0 + tt) * PJB + col;
        const float uu = bf2f(u[0]), pv = (s0 + tt) > 0 ? bf2f(u[-PJB]) : 0.f;
        float x = uu + (pv - uu) * mu;
        if (i < 32) x = tanhf(x); else if (i >= 64 && i < 128) x = sigmoidf_(x);
        if (i >= 128 && l == 0) x = 0.f;
        X[it] = x;
    }
    __syncthreads();
    if (tid < RWW) {
        const int c = tid, hh = c >> 6, lane = c & 63;
        const float w0 = p.rw_w0[l * RWW + c], a0 = p.rw_a0[l * RWW + c], v0 = (l == 1) ? p.rw_v0[c] : 0.f;
        const float kkc = p.rw_k_k[l * RWW + c], kac = p.rw_k_a[l * RWW + c];
        const float mur = p.mu_rw[l * RWC + c], muk = p.mu_rw[l * RWC + 384 + c], muv = p.mu_rw[l * RWC + 768 + c];
        const float* w2 = p.rw_w2 + (size_t)l * 32 * RWW + c;
        const float* a2 = p.rw_a2 + (size_t)l * 32 * RWW + c;
        const float* v2 = p.rw_v2 + c;
        const float* g2 = p.rw_g2 + (size_t)l * 64 * RWW + c;
        for (int grp = 0; grp < 4; ++grp) {
            float aw[8], aa[8], av[8], ag[8];
            float pr[8], pk_[8], pv_[8], pvf[8];
#pragma unroll
            for (int j = 0; j < 8; ++j) {
                aw[j] = w0; aa[j] = a0; av[j] = v0; ag[j] = 0.f;
                const int tt = grp * 8 + j; const bf16_t* u = p.proj + (size_t)(t0 + tt) * PJB + c; const bool hp = (s0 + tt) > 0;
                float r = bf2f(u[0]), k = bf2f(u[384]), v = bf2f(u[768]);
                const float rp = hp ? bf2f(u[-PJB]) : 0.f, kp = hp ? bf2f(u[384 - PJB]) : 0.f, vp = hp ? bf2f(u[768 - PJB]) : 0.f;
                pr[j] = r + (rp - r) * mur; pk_[j] = k + (kp - k) * muk; pv_[j] = v + (vp - v) * muv;
                pvf[j] = (l == 1) ? bf2f(p.vfirst[(size_t)(t0 + tt) * RWW + c]) : 0.f;
            }
            for (int i = 0; i < 32; i += 4) {
                float ww[4], wa[4], wv[4];
#pragma unroll
                for (int q = 0; q < 4; ++q) { ww[q] = w2[(i + q) * RWW]; wa[q] = a2[(i + q) * RWW]; wv[q] = (l == 1) ? v2[(i + q) * RWW] : 0.f; }
#pragma unroll
                for (int j = 0; j < 8; ++j) {
                    const LAS float* xr = X + (grp * 8 + j) * 160;
                    const f32x4 xw = *(const LAS f32x4*)(xr + i), xa = *(const LAS f32x4*)(xr + 32 + i), xv = *(const LAS f32x4*)(xr + 128 + i);
#pragma unroll
                    for (int q = 0; q < 4; ++q) { aw[j] += xw[q] * ww[q]; aa[j] += xa[q] * wa[q]; av[j] += xv[q] * wv[q]; }
                }
            }
            for (int i = 0; i < 64; i += 4) {
                float wg[4];
#pragma unroll
                for (int q = 0; q < 4; ++q) wg[q] = g2[(i + q) * RWW];
#pragma unroll
                for (int j = 0; j < 8; ++j) {
                    const f32x4 xg = *(const LAS f32x4*)(X + (grp * 8 + j) * 160 + 64 + i);
#pragma unroll
                    for (int q = 0; q < 4; ++q) ag[j] += xg[q] * wg[q];
                }
            }
#pragma unroll
            for (int j = 0; j < 8; ++j) {
                const int tt = grp * 8 + j, t = t0 + tt;
                const float r = pr[j], k = pk_[j]; float v = pv_[j];
                const float wlog = -softplusf_(-aw[j]) - 0.5f;
                const float decay = __expf(-__expf(wlog));
                const float a = sigmoidf_(aa[j]);
                if (l == 1) { const float vg = sigmoidf_(av[j]); v = v + (pvf[j] - v) * vg; }
                else p.vfirst[(size_t)t * RWW + c] = (bf16_t)f2bf(v);
                const float kkr = k * kkc;
                const float ss = wave_sum(kkr * kkr);
                const float kk = kkr / fmaxf(sqrtf(ss), 1e-12f);
                float* rc = p.rec + (size_t)t * REC_T + hh * 384 + lane;
                rc[0] = -kk; rc[64] = decay; rc[128] = kk * a; rc[192] = k * (1.f + (a - 1.f) * kac); rc[256] = r; rc[320] = v;
                p.g[(size_t)t * RWW + c] = (bf16_t)f2bf(ag[j]);
            }
        }
    }
    __syncthreads();
}

__device__ __forceinline__ float dpp_add16(float x) {
    x += __builtin_bit_cast(float, __builtin_amdgcn_update_dpp(0, __builtin_bit_cast(int, x), 0xB1, 0xF, 0xF, true));
    x += __builtin_bit_cast(float, __builtin_amdgcn_update_dpp(0, __builtin_bit_cast(int, x), 0x4E, 0xF, 0xF, true));
    x += __builtin_bit_cast(float, __builtin_amdgcn_update_dpp(0, __builtin_bit_cast(int, x), 0x141, 0xF, 0xF, true));
    x += __builtin_bit_cast(float, __builtin_amdgcn_update_dpp(0, __builtin_bit_cast(int, x), 0x140, 0xF, 0xF, true));
    return x;
}
constexpr int SC_CH = 32, SC_CHB = SC_CH * 1536;
__device__ __forceinline__ void st_scan(const P& p, int vb, LAS unsigned char* lds) {
    const int tid = opaque(threadIdx.x), wave = __builtin_amdgcn_readfirstlane(tid >> 6), lane = tid & 63;
    const int bh = vb >> 1, rh = vb & 1, b = bh / 6, hh = bh % 6;
    const int cg = lane & 15, row = rh * 32 + wave * 4 + (lane >> 4);
    const char* recb = (const char*)(p.rec + ((size_t)b * SEQ * 6 + hh) * 384);
    float* yb = p.y + (size_t)b * SEQ * RWW + hh * 64 + row;
    unsigned goff[6];
#pragma unroll
    for (int j = 0; j < 6; ++j) { const int o = (wave * 6 + j) * 1024 + lane * 16; goff[j] = (unsigned)((o / 1536) * (REC_T * 4) + (o % 1536)); }
#define SC_LOAD(chunk, buf) do { const char* gb = recb + (size_t)(chunk) * SC_CH * (REC_T * 4); _Pragma("unroll") for (int j = 0; j < 6; ++j) \
        __builtin_amdgcn_global_load_lds((const unsigned*)(gb + goff[j]), (LAS unsigned*)(lds + (buf) * SC_CHB + (wave * 6 + j) * 1024), 16, 0, 0); } while (0)
    float s0 = 0.f, s1 = 0.f, s2 = 0.f, s3 = 0.f;
    SC_LOAD(0, 0);
    asm volatile("s_waitcnt vmcnt(0)" ::: "memory");
    __syncthreads();
    for (int ch = 0; ch < SEQ / SC_CH; ++ch) {
        if (ch + 1 < SEQ / SC_CH) SC_LOAD(ch + 1, (ch + 1) & 1);
        const LAS unsigned char* cb = lds + (ch & 1) * SC_CHB + cg * 16;
        const LAS unsigned char* vbp = lds + (ch & 1) * SC_CHB + 1280 + row * 4;
        f32x4 a4 = *(const LAS f32x4*)(cb), w4 = *(const LAS f32x4*)(cb + 256), b4 = *(const LAS f32x4*)(cb + 512), k4 = *(const LAS f32x4*)(cb + 768), r4 = *(const LAS f32x4*)(cb + 1024);
        float vv = *(const LAS float*)(vbp);
#pragma unroll 4
        for (int st = 0; st < SC_CH; ++st) {
            const int nx = (st + 1 < SC_CH) ? (st + 1) * 1536 : st * 1536;
            const f32x4 a4n = *(const LAS f32x4*)(cb + nx), w4n = *(const LAS f32x4*)(cb + nx + 256), b4n = *(const LAS f32x4*)(cb + nx + 512), k4n = *(const LAS f32x4*)(cb + nx + 768), r4n = *(const LAS f32x4*)(cb + nx + 1024);
            const float vvn = *(const LAS float*)(vbp + nx);
            float pa = s0 * a4[0]; pa = fmaf(s1, a4[1], pa); pa = fmaf(s2, a4[2], pa); pa = fmaf(s3, a4[3], pa);
            const float t0 = fmaf(s0, w4[0], vv * k4[0]), t1 = fmaf(s1, w4[1], vv * k4[1]), t2 = fmaf(s2, w4[2], vv * k4[2]), t3 = fmaf(s3, w4[3], vv * k4[3]);
            const float sa = dpp_add16(pa);
            s0 = fmaf(sa, b4[0], t0); s1 = fmaf(sa, b4[1], t1); s2 = fmaf(sa, b4[2], t2); s3 = fmaf(sa, b4[3], t3);
            float py = s0 * r4[0]; py = fmaf(s1, r4[1], py); py = fmaf(s2, r4[2], py); py = fmaf(s3, r4[3], py);
            const float yy = dpp_add16(py);
            if (cg == 0) yb[(size_t)(ch * SC_CH + st) * RWW] = yy;
            a4 = a4n; w4 = w4n; b4 = b4n; k4 = k4n; r4 = r4n; vv = vvn;
        }
        asm volatile("s_waitcnt vmcnt(0)" ::: "memory");
        __syncthreads();
    }
#undef SC_LOAD
}

__device__ __forceinline__ void st_rwout(const P& p, int l, int t, int lane) {
    float y[6], rr[6], kk[6], vv[6], gg[6];
#pragma unroll
    for (int hh = 0; hh < 6; ++hh) {
        const float* rc = p.rec + (size_t)t * REC_T + hh * 384 + lane;
        y[hh] = p.y[(size_t)t * RWW + hh * 64 + lane]; rr[hh] = rc[256]; kk[hh] = rc[192]; vv[hh] = rc[320]; gg[hh] = bf2f(p.g[(size_t)t * RWW + hh * 64 + lane]);
    }
#pragma unroll
    for (int hh = 0; hh < 6; ++hh) {
        const int c = hh * 64 + lane;
        const float mean = wave_sum(y[hh]) * (1.f / 64.f);
        const float d = y[hh] - mean;
        const float var = wave_sum(d * d) * (1.f / 64.f);
        const float yn = d * rsqrtf(var + 64e-5f) * p.rw_ln_g[l * RWW + c] + p.rw_ln_b[l * RWW + c];
        const float rk = wave_sum(rr[hh] * kk[hh] * p.rw_r_k[l * RWW + c]);
        p.h[(size_t)t * D + c] = (bf16_t)f2bf((yn + rk * vv[hh]) * gg[hh]);
    }
}

typedef float f32x16 __attribute__((ext_vector_type(16)));
constexpr float ATT_EXIT = -60.f;
__device__ __forceinline__ float xhalf(float x) { return __shfl_xor(x, 32); }
__device__ __forceinline__ void st_attn(const P& p, int l, int item) {
    const int lane = opaque(threadIdx.x) & 63;
    const int qt = item % (SEQ / 32), bh = item / (SEQ / 32), b = bh / 6, hh = bh % 6;
    const int r = lane & 31, hf = lane >> 5;
    const bf16_t* qkb = p.proj + (size_t)b * SEQ * PJB + RWC + hh * 64 + 8 * hf;
    const bf16_t* vtb = p.vt + ((size_t)(b * 6 + hh) * 64 + r) * SEQ + 4 * hf;
    bf16x8 qf[4];
    {
        const bf16_t* qp = qkb + (size_t)(qt * 32 + r) * PJB;
#pragma unroll
        for (int s = 0; s < 4; ++s) {
            u32x4 t4 = *(const u32x4*)(qp + 16 * s);
            unsigned w[4] = {t4.x, t4.y, t4.z, t4.w};
#pragma unroll
            for (int q = 0; q < 4; ++q) { const float lo = bflo(w[q]) * 0.125f, hi = bfhi(w[q]) * 0.125f; w[q] = (__builtin_bit_cast(unsigned, lo) >> 16) | (__builtin_bit_cast(unsigned, hi) & 0xffff0000u); }
            t4.x = w[0]; t4.y = w[1]; t4.z = w[2]; t4.w = w[3];
            qf[s] = __builtin_bit_cast(bf16x8, t4);
        }
    }
    f32x16 o0, o1;
#pragma unroll
    for (int i = 0; i < 16; ++i) { o0[i] = 0.f; o1[i] = 0.f; }
    float R = 0.f;
    for (int kt = qt; kt >= 0; --kt) {
        const int key0 = kt * 32;
        bf16x8 kf[4]; u32x2 vf[2][2][2];
        {
            const bf16_t* kp = qkb + SBW + (size_t)(key0 + r) * PJB;
#pragma unroll
            for (int s = 0; s < 4; ++s) kf[s] = *(const bf16x8*)(kp + 16 * s);
#pragma unroll
            for (int dt = 0; dt < 2; ++dt)
#pragma unroll
                for (int s = 0; s < 2; ++s) { const bf16_t* vp = vtb + (size_t)dt * 32 * SEQ + key0 + 16 * s; vf[dt][s][0] = *(const u32x2*)vp; vf[dt][s][1] = *(const u32x2*)(vp + 8); }
        }
        f32x16 z;
#pragma unroll
        for (int i = 0; i < 16; ++i) z[i] = 0.f;
#pragma unroll
        for (int s = 0; s < 4; ++s) z = __builtin_amdgcn_mfma_f32_32x32x16_bf16(kf[s], qf[s], z, 0, 0, 0);
        const bool diag = (kt == qt);
        float c[16], gs[4];
#pragma unroll
        for (int gi = 0; gi < 4; ++gi) {
            float run = 0.f;
#pragma unroll
            for (int e = 3; e >= 0; --e) {
                const int reg = gi * 4 + e;
                const float zz = z[reg];
                float L = -(fmaxf(zz, 0.f) + __logf(1.f + __expf(-fabsf(zz))));
                if (diag && !(r > e + 8 * gi + 4 * hf)) L = 0.f;
                run += L; c[reg] = run;
            }
            gs[gi] = run;
        }
        float go[4], pp[4], ob[4], off[4];
#pragma unroll
        for (int gi = 0; gi < 4; ++gi) { go[gi] = xhalf(gs[gi]); pp[gi] = gs[gi] + go[gi]; }
        ob[3] = 0.f; ob[2] = pp[3]; ob[1] = pp[3] + pp[2]; ob[0] = ob[1] + pp[1];
#pragma unroll
        for (int gi = 0; gi < 4; ++gi) off[gi] = ob[gi] + (hf == 0 ? go[gi] : 0.f) + R;
        const float total = ob[0] + pp[0];
        unsigned af[8];
#pragma unroll
        for (int i = 0; i < 8; ++i) {
            float a2[2];
#pragma unroll
            for (int q = 0; q < 2; ++q) {
                const int reg = 2 * i + q, gi = reg >> 2, e = reg & 3;
                float a = __expf(z[reg] + c[reg] + off[gi]);
                if (diag && !(r > e + 8 * gi + 4 * hf)) a = 0.f;
                a2[q] = a;
            }
            af[i] = pk2(a2[0], a2[1]);
        }
        R += total;
        const bf16x8 a0 = __builtin_bit_cast(bf16x8, (u32x4){af[0], af[1], af[2], af[3]});
        const bf16x8 a1 = __builtin_bit_cast(bf16x8, (u32x4){af[4], af[5], af[6], af[7]});
        o0 = __builtin_amdgcn_mfma_f32_32x32x16_bf16(__builtin_bit_cast(bf16x8, (u32x4){vf[0][0][0].x, vf[0][0][0].y, vf[0][0][1].x, vf[0][0][1].y}), a0, o0, 0, 0, 0);
        o0 = __builtin_amdgcn_mfma_f32_32x32x16_bf16(__builtin_bit_cast(bf16x8, (u32x4){vf[0][1][0].x, vf[0][1][0].y, vf[0][1][1].x, vf[0][1][1].y}), a1, o0, 0, 0, 0);
        o1 = __builtin_amdgcn_mfma_f32_32x32x16_bf16(__builtin_bit_cast(bf16x8, (u32x4){vf[1][0][0].x, vf[1][0][0].y, vf[1][0][1].x, vf[1][0][1].y}), a0, o1, 0, 0, 0);
        o1 = __builtin_amdgcn_mfma_f32_32x32x16_bf16(__builtin_bit_cast(bf16x8, (u32x4){vf[1][1][0].x, vf[1][1][0].y, vf[1][1][1].x, vf[1][1][1].y}), a1, o1, 0, 0, 0);
        if (__all(R < ATT_EXIT)) break;
    }
    float ss = 0.f;
#pragma unroll
    for (int i = 0; i < 16; ++i) ss += o0[i] * o0[i] + o1[i] * o1[i];
    ss += xhalf(ss);
    const float rs = rsqrtf(ss * (1.f / 64.f) + 1e-6f);
    bf16_t* op = p.h + ((size_t)b * SEQ + qt * 32 + r) * D + RWW + hh * 64 + 4 * hf;
    const float* gn = p.sb_norm_g + l * SBW + hh * 64 + 4 * hf;
#pragma unroll
    for (int gi = 0; gi < 4; ++gi) {
        const f32x4 g0 = *(const f32x4*)(gn + 8 * gi), g1 = *(const f32x4*)(gn + 32 + 8 * gi);
        u32x2 w0, w1;
        w0.x = pk2(o0[4 * gi] * rs * g0[0], o0[4 * gi + 1] * rs * g0[1]); w0.y = pk2(o0[4 * gi + 2] * rs * g0[2], o0[4 * gi + 3] * rs * g0[3]);
        w1.x = pk2(o1[4 * gi] * rs * g1[0], o1[4 * gi + 1] * rs * g1[1]); w1.y = pk2(o1[4 * gi + 2] * rs * g1[2], o1[4 * gi + 3] * rs * g1[3]);
        *(u32x2*)(op + 8 * gi) = w0; *(u32x2*)(op + 32 + 8 * gi) = w1;
    }
}

__device__ __forceinline__ void st_pool(const P& p, int l, int vb, LAS float* PL  ) {
    const int tid = opaque(threadIdx.x);
    const int t0 = vb * 32, s0 = t0 % SEQ;
    {
        const int col = tid & 255, th = tid >> 8, g = col >> 6, win = 2 << g;
        const int sA = s0 + th * 16;
        const bf16_t* u = p.proj + (size_t)(t0 + th * 16) * PJB + RWC + SBC + col;
        float xv[31];
#pragma unroll
        for (int i = 0; i < 31; ++i) { const int s = sA - 15 + i; xv[i] = (s >= 0 && (i >= 15 || 15 - i < win)) ? bf2f(u[(ptrdiff_t)(i - 15) * PJB]) : 0.f; }
        float run = 0.f;
#pragma unroll
        for (int i = 0; i < 15; ++i) run += (15 - i < win) ? xv[i] : 0.f;
#pragma unroll
        for (int j = 0; j < 16; ++j) {
            run += xv[15 + j];
            const int s = sA + j, n = min(s + 1, win);
            PL[(th * 16 + j) * 256 + col] = run / (float)n - xv[15 + j];
            float drop = 0.f;
#pragma unroll
            for (int q = 1; q <= 4; ++q) if (win == (1 << q)) drop = xv[15 + j - (1 << q) + 1];
            run -= drop;
        }
    }
    __syncthreads();
    {
        const int wave = tid >> 6, lane = tid & 63, g = wave & 3, th = wave >> 2;
        float acc[16];
#pragma unroll
        for (int j = 0; j < 16; ++j) acc[j] = 0.f;
        const float* pw = p.pool_w + ((size_t)l * 4 + g) * 64 * 64 + lane;
        for (int c = 0; c < 64; c += 4) {
            const float w0 = pw[c * 64], w1 = pw[(c + 1) * 64], w2 = pw[(c + 2) * 64], w3 = pw[(c + 3) * 64];
#pragma unroll
            for (int j = 0; j < 16; ++j) { const f32x4 x = *(const LAS f32x4*)(PL + (th * 16 + j) * 256 + g * 64 + c); acc[j] += x[0] * w0 + x[1] * w1 + x[2] * w2 + x[3] * w3; }
        }
        const float sc = p.pool_scale[l * PLW + g * 64 + lane];
#pragma unroll
        for (int j = 0; j < 16; ++j) p.h[(size_t)(t0 + th * 16 + j) * D + 768 + g * 64 + lane] = (bf16_t)f2bf(acc[j] * sc);
    }
    __syncthreads();
}

template <bool TOLDS>
__device__ __forceinline__ void norm_row(const float* xr, const float* md  , bf16_t* hrow, LAS float* hl, int lane) {
    f32x4 v[4]; float ss = 0.f;
#pragma unroll
    for (int i = 0; i < 4; ++i) { v[i] = *(const f32x4*)(xr + i * 256 + lane * 4); ss += v[i][0] * v[i][0] + v[i][1] * v[i][1] + v[i][2] * v[i][2] + v[i][3] * v[i][3]; }
    ss = wave_sum(ss);
    const float rs = rsqrtf(ss * (1.f / D) + 1e-6f);
#pragma unroll
    for (int i = 0; i < 4; ++i) {
        const int cidx = i * 256 + lane * 4;
        const f32x4 sh = *(const f32x4*)(md + cidx), sc = *(const f32x4*)(md + 1024 + cidx);
        const f32x4 o = v[i] * rs * (sc + 1.f) + sh;
        u32x2 w; w.x = pk2(o[0], o[1]); w.y = pk2(o[2], o[3]);
        *(u32x2*)(hrow + cidx) = w;
        if constexpr (TOLDS) *(LAS f32x4*)(hl + cidx) = o;
    }
}

__device__ __forceinline__ void st_normrouter(const P& p, int l, int vb, LAS float* L  ) {
    const int tid = opaque(threadIdx.x), wave = tid >> 6, lane = tid & 63;
    const int t0 = vb * 16, b = t0 / SEQ;
    const float* md = p.mod + ((size_t)l * 8 + b) * 6144 + 3072;
    LAS float* H = L; LAS float* PART = L + 16 * 1024; LAS float* SEL = PART + 8 * 16 * 64; LAS int* lcnt = (LAS int*)(SEL + 16 * 72);
    if (tid < 64) lcnt[tid] = 0;
#pragma unroll
    for (int q = 0; q < 2; ++q) { const int tt = wave * 2 + q; norm_row<true>(p.xb + (size_t)(t0 + tt) * D, md, p.h + (size_t)(t0 + tt) * D, H + tt * 1024, lane); }
    __syncthreads();
    {
        float acc[16];
#pragma unroll
        for (int j = 0; j < 16; ++j) acc[j] = 0.f;
        const float* wr = p.w_router + ((size_t)l * D + wave * 128) * NE + lane;
        for (int k = 0; k < 128; k += 4) {
            const float w0 = wr[k * NE], w1 = wr[(k + 1) * NE], w2 = wr[(k + 2) * NE], w3 = wr[(k + 3) * NE];
#pragma unroll
            for (int j = 0; j < 16; ++j) { const f32x4 x = *(const LAS f32x4*)(H + j * 1024 + wave * 128 + k); acc[j] += x[0] * w0 + x[1] * w1 + x[2] * w2 + x[3] * w3; }
        }
#pragma unroll
        for (int j = 0; j < 16; ++j) PART[(wave * 16 + j) * 64 + lane] = acc[j];
    }
    __syncthreads();
#pragma unroll
    for (int q = 0; q < 2; ++q) {
        const int tt = wave * 2 + q, t = t0 + tt;
        float logit = 0.f;
#pragma unroll
        for (int w = 0; w < 8; ++w) logit += PART[(w * 16 + tt) * 64 + lane];
        const float score = sigmoidf_(logit);
        const float sl = score + p.b_router[l * NE + lane];
        LAS float* sel = SEL + (wave * 2 + q) * 72; LAS float* gs = sel + 64;
        sel[lane] = sl;
        if (lane < 8) {
            float m1 = -INFINITY, m2 = -INFINITY;
            for (int i = 0; i < 8; ++i) { const float v = sel[lane * 8 + i]; if (v > m1) { m2 = m1; m1 = v; } else if (v > m2) m2 = v; }
            gs[lane] = m1 + m2;
        }
        const int gI = lane >> 3;
        int grank = 0;
        for (int i = 0; i < 8; ++i) { const float v = gs[i]; grank += (v > gs[gI] || (v == gs[gI] && i < gI)) ? 1 : 0; }
        const float msk = (grank < 4) ? sl : -INFINITY;
        sel[lane] = msk;
        int rank = 0;
        for (int i = 0; i < 64; ++i) { const float v = sel[i]; rank += (v > msk || (v == msk && i < lane)) ? 1 : 0; }
        const bool chosen = rank < TOPK;
        const float wsum = wave_sum(chosen ? score : 0.f);
        if (chosen) {
            const int pos = __hip_atomic_fetch_add(&lcnt[lane], 1, __ATOMIC_RELAXED, __HIP_MEMORY_SCOPE_WORKGROUP);
            p.seg[((size_t)lane * 1024 + vb) * 16 + pos] = t * TOPK + rank;
            p.topw[(size_t)t * TOPK + rank] = score / (wsum + 1e-20f) * 2.5f;
        }
    }
    __syncthreads();
    if (tid < 64) p.cnt2[tid * 1024 + vb] = lcnt[tid];
    __syncthreads();
}

__device__ __forceinline__ void st_compact(const P& p, int e, LAS int* wt  ) {
    const int tid = opaque(threadIdx.x), wave = tid >> 6, lane = tid & 63;
    const int c0 = p.cnt2[e * 1024 + 2 * tid], c1 = p.cnt2[e * 1024 + 2 * tid + 1], s = c0 + c1;
    int incl = s;
#pragma unroll
    for (int o = 1; o < 64; o <<= 1) { const int v = __shfl_up(incl, o); if (lane >= o) incl += v; }
    if (lane == 63) wt[wave] = incl;
    __syncthreads();
    int base = 0;
    for (int w = 0; w < wave; ++w) base += wt[w];
    const int excl = base + incl - s;
    int* dst = p.list + (size_t)e * T + excl;
    const int* s0 = p.seg + ((size_t)e * 1024 + 2 * tid) * 16;
    for (int j = 0; j < c0; ++j) dst[j] = s0[j];
    for (int j = 0; j < c1; ++j) dst[c0 + j] = s0[16 + j];
    if (tid == NTHREADS - 1) p.cnt[e] = base + incl;
    __syncthreads();
}

__device__ __forceinline__ void st_combine(const P& p, int l, int t, int lane) {
    const int b = t / SEQ;
    const float* gt = p.mod + ((size_t)l * 8 + b) * 6144 + 5120;
    const bf16_t* sl = p.slab + (size_t)t * TOPK * D;
    float* xr = p.xb + (size_t)t * D;
    float xv[16]; float ss = 0.f;
#pragma unroll
    for (int i = 0; i < 2; ++i) {
        const int cidx = i * 512 + lane * 8;
        float f[8];
#pragma unroll
        for (int j = 0; j < 8; ++j) f[j] = 0.f;
#pragma unroll
        for (int s = 0; s < TOPK; ++s) {
            const u32x4 q = *(const u32x4*)(sl + (size_t)s * D + cidx);
            f[0] += bflo(q.x); f[1] += bfhi(q.x); f[2] += bflo(q.y); f[3] += bfhi(q.y); f[4] += bflo(q.z); f[5] += bfhi(q.z); f[6] += bflo(q.w); f[7] += bfhi(q.w);
        }
        const f32x4 x0 = *(const f32x4*)(xr + cidx), x1 = *(const f32x4*)(xr + cidx + 4);
        const f32x4 g0 = *(const f32x4*)(gt + cidx), g1 = *(const f32x4*)(gt + cidx + 4);
#pragma unroll
        for (int j = 0; j < 4; ++j) { xv[i * 8 + j] = x0[j] + g0[j] * f[j]; xv[i * 8 + 4 + j] = x1[j] + g1[j] * f[4 + j]; }
#pragma unroll
        for (int j = 0; j < 8; ++j) ss += xv[i * 8 + j] * xv[i * 8 + j];
    }
    ss = wave_sum(ss);
    const float rs = rsqrtf(ss * (1.f / D) + 1e-6f);
    if (l + 1 < NL) {
        const float* md = p.mod + ((size_t)(l + 1) * 8 + b) * 6144;
#pragma unroll
        for (int i = 0; i < 2; ++i) {
            const int cidx = i * 512 + lane * 8;
            *(f32x4*)(xr + cidx) = (f32x4){xv[i * 8], xv[i * 8 + 1], xv[i * 8 + 2], xv[i * 8 + 3]};
            *(f32x4*)(xr + cidx + 4) = (f32x4){xv[i * 8 + 4], xv[i * 8 + 5], xv[i * 8 + 6], xv[i * 8 + 7]};
            float o[8];
#pragma unroll
            for (int j = 0; j < 8; ++j) o[j] = xv[i * 8 + j] * rs * (1.f + md[1024 + cidx + j]) + md[cidx + j];
            u32x4 w; w.x = pk2(o[0], o[1]); w.y = pk2(o[2], o[3]); w.z = pk2(o[4], o[5]); w.w = pk2(o[6], o[7]);
            *(u32x4*)(p.h + (size_t)t * D + cidx) = w;
        }
    } else {
#pragma unroll
        for (int i = 0; i < 2; ++i) {
            const int cidx = i * 512 + lane * 8;
            const f32x4 g0 = *(const f32x4*)(p.g_final + cidx), g1 = *(const f32x4*)(p.g_final + cidx + 4);
            *(f32x4*)(p.out + (size_t)t * D + cidx) = (f32x4){xv[i * 8] * rs * g0[0], xv[i * 8 + 1] * rs * g0[1], xv[i * 8 + 2] * rs * g0[2], xv[i * 8 + 3] * rs * g0[3]};
            *(f32x4*)(p.out + (size_t)t * D + cidx + 4) = (f32x4){xv[i * 8 + 4] * rs * g1[0], xv[i * 8 + 5] * rs * g1[1], xv[i * 8 + 6] * rs * g1[2], xv[i * 8 + 7] * rs * g1[3]};
        }
    }
}

__device__ __forceinline__ void cvt_item(const float* W, int K, int N, int k0, int n0, bf16_t* WT, int dst_row0, LAS float* scr, int lane) {
    float wv[32];
#pragma unroll
    for (int i = 0; i < 32; ++i) wv[i] = W[(size_t)(k0 + 2 * i + (lane >> 5)) * N + n0 + (lane & 31)];
#pragma unroll
    for (int i = 0; i < 32; ++i) scr[(2 * i + (lane >> 5)) * 33 + (lane & 31)] = wv[i];
    asm volatile("s_waitcnt lgkmcnt(0)" ::: "memory");
    const int c = lane & 7;
#pragma unroll
    for (int j = 0; j < 4; ++j) { const int n = (lane >> 3) + 8 * j; const LAS float* s = scr + (8 * c) * 33 + n;
        u32x4 o; o.x = pk2(s[0 * 33], s[1 * 33]); o.y = pk2(s[2 * 33], s[3 * 33]); o.z = pk2(s[4 * 33], s[5 * 33]); o.w = pk2(s[6 * 33], s[7 * 33]);
        *(u32x4*)(WT + (size_t)(dst_row0 + n) * K + k0 + 8 * c) = o; }
    asm volatile("s_waitcnt lgkmcnt(0)" ::: "memory");
}
constexpr int CV_IN = 16 * 84, CV_VR = 16, CV_OUT = 16 * 32, CV_DENSE_L = CV_IN + CV_VR + CV_OUT, CV_DENSE = NL * CV_DENSE_L;
__device__ __forceinline__ void cvt_dense_item(const P& p, int it, LAS float* scr, int lane) {
    const int l = it / CV_DENSE_L; int r = it % CV_DENSE_L;
    bf16_t* wti = p.wt_in + (size_t)l * PJB * D;
    if (r < CV_IN) { const int kb = r / 84, nb = r % 84; cvt_item(p.w_in + (size_t)l * D * INC, D, INC, kb * 64, nb * 32, wti, nb * 32, scr, lane); return; }
    r -= CV_IN;
    if (r < CV_VR) {
        if (l == 1) cvt_item(p.w_vres, D, 32, r * 64, 0, wti, INC, scr, lane);
        const int rz0 = (l == 1) ? INC + 32 : INC;
        for (int row = rz0 + (lane >> 3); row < PJB; row += 8) *(u32x4*)(wti + (size_t)row * D + r * 64 + (lane & 7) * 8) = (u32x4){0u, 0u, 0u, 0u};
        return;
    }
    r -= CV_VR;
    { const int kb = r / 32, nb = r % 32; cvt_item(p.w_out + (size_t)l * D * D, D, D, kb * 64, nb * 32, p.wt_out + (size_t)l * D * D, nb * 32, scr, lane); }
}
constexpr int CV_EXP_E = 128 + 128 + 128, CV_EXP = 65 * CV_EXP_E;
__device__ __forceinline__ void cvt_exp_item(const P& p, int l, int it, LAS float* scr, int lane) {
    const int e = it / CV_EXP_E; int r = it % CV_EXP_E;
    if (r < 256) {
        const int which = r >> 7; r &= 127; const int kb = r >> 3, nb = r & 7;
        const float* W = e < NE ? (which ? p.w_eu : p.w_eg) + ((size_t)l * NE + e) * D * ED : (which ? p.w_su : p.w_sg) + (size_t)l * D * ED;
        const int n0 = nb * 32, pn = n0 >> 7;
        cvt_item(W, D, ED, kb * 64, n0, p.wt1 + (size_t)e * 512 * D, pn * 256 + which * 128 + (n0 & 127), scr, lane);
    } else {
        r -= 256; const int kb = r >> 5, nb = r & 31;
        const float* W = e < NE ? p.w_ed + ((size_t)l * NE + e) * ED * D : p.w_sd + (size_t)l * ED * D;
        cvt_item(W, ED, D, kb * 64, nb * 32, p.wt2 + (size_t)e * D * ED, nb * 32, scr, lane);
    }
}

#define XB_TMO      128
#define XB_XCNT(j)  (256  + 64 * (j))
#define XB_XSUB(j)  (1280 + 64 * (j))
#define XB_XGEN(j)  (2304 + 64 * (j))
#define XB_TOP      3328
#define XB_TOPGEN   3392
#define XCD_BAR_WORDS 3456
#define XB_SPIN_CAP (1u << 22)
__device__ __forceinline__ unsigned xb_ld(unsigned* p)              { return __hip_atomic_load(p, __ATOMIC_RELAXED, __HIP_MEMORY_SCOPE_AGENT); }
__device__ __forceinline__ unsigned xb_add(unsigned* p, unsigned v) { return __hip_atomic_fetch_add(p, v, __ATOMIC_RELAXED, __HIP_MEMORY_SCOPE_AGENT); }
__device__ __forceinline__ unsigned xb_xcc_id() { return (unsigned)__builtin_amdgcn_s_getreg((3 << 11) | 20) & 0xFu; }
#define XB_SPIN(cond, bar) do { unsigned _sp = 0; while (cond) { __builtin_amdgcn_s_sleep(1); \
    if ((++_sp & 255u) == 0u) { if (xb_ld(&(bar)[XB_TMO])) break; if (_sp > XB_SPIN_CAP) { atomicAdd(&(bar)[XB_TMO], 1u); break; } } } } while (0)
struct XcdBarrier { unsigned* bar; unsigned x; volatile LAS unsigned* st; };
__device__ __forceinline__ XcdBarrier xcd_barrier_post(unsigned* bar, volatile LAS unsigned* st) {
    XcdBarrier b; b.bar = bar; b.x = xb_xcc_id(); b.st = st;
    if (threadIdx.x == 0) (void)xb_add(&bar[XB_XCNT(b.x)], 1u);
    return b;
}
__device__ __forceinline__ void xcd_barrier_complete(unsigned* bar, unsigned x, unsigned& nloc, unsigned& nx) {
    const unsigned G = gridDim.x * gridDim.y * gridDim.z;
    unsigned sum, cnt, mine, sp = 0u;
    for (;;) {
        sum = 0u; cnt = 0u; mine = 0u;
#pragma unroll
        for (unsigned j = 0; j < 16; ++j) { const unsigned c = xb_ld(&bar[XB_XCNT(j)]); sum += c; cnt += (c > 0u) ? 1u : 0u; mine = (j == x) ? c : mine; }
        if (sum == G) break;
        __builtin_amdgcn_s_sleep(1);
        if ((++sp & 255u) == 0u) { if (xb_ld(&bar[XB_TMO])) break; if (sp > XB_SPIN_CAP) { atomicAdd(&bar[XB_TMO], 1u); break; } }
    }
    nloc = mine > 0u ? mine : 1u; nx = cnt > 0u ? cnt : 1u;
}
__device__ __forceinline__ void xcd_barrier(const XcdBarrier& b0) {
    XcdBarrier b = b0; { unsigned xx = b0.x; asm volatile("" : "+s"(xx)); b.x = xx; }
    asm volatile("s_waitcnt vmcnt(0)" ::: "memory");
    __syncthreads();
    if (threadIdx.x == 0) {
        unsigned* bar = b.bar;
        __builtin_amdgcn_s_waitcnt(0);
        unsigned nloc = b.st[0], nx = b.st[1];
        if (nloc == 0u) { xcd_barrier_complete(bar, b.x, nloc, nx); b.st[0] = nloc; b.st[1] = nx; }
        const unsigned old = xb_add(&bar[XB_XSUB(b.x)], 1u);
        const unsigned gen = old / nloc;
        if (old + 1u == (gen + 1u) * nloc) {
            __builtin_amdgcn_fence(__ATOMIC_RELEASE, "agent");
            asm volatile("s_waitcnt vmcnt(0)" ::: "memory");
            const unsigned og = xb_add(&bar[XB_TOP], 1u);
            const unsigned tg = og / nx;
            if (og + 1u == (tg + 1u) * nx) xb_add(&bar[XB_TOPGEN], 1u);
            else XB_SPIN(xb_ld(&bar[XB_TOPGEN]) == tg, bar);
            __builtin_amdgcn_fence(__ATOMIC_ACQUIRE, "agent");
            xb_add(&bar[XB_XGEN(b.x)], 1u);
            asm volatile("s_waitcnt vmcnt(0)" ::: "memory");
        } else {
            XB_SPIN(xb_ld(&bar[XB_XGEN(b.x)]) == gen, bar);
            __builtin_amdgcn_fence(__ATOMIC_ACQUIRE, "agent");
            asm volatile("s_waitcnt vmcnt(0)" ::: "memory");
        }
    }
    __syncthreads();
}

enum Ph { PH_NORM1 = 0, PH_INPROJ, PH_PREP, PH_MIX, PH_RWOUT, PH_OUTPROJ, PH_ROUTER, PH_COMPACT, PH_EXP1, PH_EXP2, PH_COMBINE, PH_PER_LAYER };

__global__ void __launch_bounds__(NTHREADS, 2) k_fused(P p) {
    extern __shared__ __attribute__((aligned(16))) unsigned char lds_raw[];
    LAS unsigned char* lds = (LAS unsigned char*)lds_raw;
    LAS int* tstart = (LAS int*)(lds + LDS_STAGE);
    LAS int* cnts = (LAS int*)(lds + LDS_STAGE + 272);
    volatile LAS unsigned* bst = (volatile LAS unsigned*)(lds + LDS_STAGE + 1008);
    const int G = gridDim.x, bx = blockIdx.x;
    const int vcu = (G % 8 == 0) ? (bx % 8) * (G / 8) + bx / 8 : bx;
    if (threadIdx.x < 4) bst[threadIdx.x] = 0u;
    __syncthreads();
    XcdBarrier xb = xcd_barrier_post(p.bar, bst);
#define PHASE_COORDS() const int tid = opaque(threadIdx.x), half = tid >> 8, lane = tid & 63, wave = __builtin_amdgcn_readfirstlane(tid >> 6); \
    float* smem = (float*)lds_raw + half * 8192; LAS float* scr = (LAS float*)(lds + wave * 16384); (void)lane; (void)smem; (void)scr; (void)tid

    for (int rep = 0; rep < (REP_PH == -1 ? REP_N : 1); ++rep) {
        PHASE_COORDS();
        for (int it = bx; it < NL * 96; it += G) st_mod(p, it, (LAS float*)lds);
        __syncthreads();
        for (int it = (bx * 8 + wave); it < CV_DENSE; it += G * 8) cvt_dense_item(p, it, scr, lane);
        xcd_barrier(xb);
    }

    for (int ph = 0; ph < NL * PH_PER_LAYER; ++ph) {
      for (int rep = 0; rep < (REP_PH == ph ? REP_N : 1); ++rep) {
        const int l = ph / PH_PER_LAYER, st = ph % PH_PER_LAYER;
        PHASE_COORDS();
        if (st == PH_NORM1) {
            if (l == 0) {
                for (int t = bx * 8 + wave; t < T; t += G * 8) norm_row<false>(p.x + (size_t)t * D, p.mod + (size_t)(t / SEQ) * 6144, p.h + (size_t)t * D, (LAS float*)lds, lane);
            }
        } else if (st == PH_INPROJ) {
            pg8::DenseOrder S; S.init(p.h, p.wt_in + (size_t)l * PJB * D, T, PJB, D, G, bx);
            pg8::EpiProj E{p.proj, p.vt};
            pg8::gemm_phase<pg8::EpiProj, pg8::DenseOrder, true, true>(lds, D, S, E);
        } else if (st == PH_PREP) {
            for (int wb = bx; wb < T / 32; wb += G) st_prep(p, l, wb, (LAS float*)lds);
        } else if (st == PH_MIX) {
            constexpr int N1 = NBATCH * 6 * 2, N2 = NBATCH * 6 * (SEQ / 32) / 8, N3 = T / 32, N4 = (CV_EXP + 7) / 8;
            const bool split = G >= 2 * N1;
            const int ob = split ? bx - N1 : bx, og = split ? G - N1 : G;
            const int sel = (rep == 0) ? 15 : REP_SEL;
            if ((sel & 1) && (split ? (bx < N1) : true)) for (int wb = bx; wb < N1; wb += G) st_scan(p, wb, lds);
            if (ob >= 0) for (int wb = ob; wb < N2 + N3 + N4; wb += og) {
                if (wb < N2) { if (sel & 2) st_attn(p, l, wb * 8 + wave); }
                else if (wb < N2 + N3) { if (sel & 4) st_pool(p, l, wb - N2, (LAS float*)lds); }
                else if (sel & 8) { const int it = (wb - N2 - N3) * 8 + wave; if (it < CV_EXP) cvt_exp_item(p, l, it, scr, lane); }
            }
        } else if (st == PH_RWOUT) {
            for (int t = bx * 8 + wave; t < T; t += G * 8) st_rwout(p, l, t, lane);
        } else if (st == PH_OUTPROJ) {
            pg8::DenseOrder S; S.init(p.h, p.wt_out + (size_t)l * D * D, T, D, D, G, bx);
            pg8::EpiOut E{l == 0 ? p.x : p.xb, p.xb, p.mod + (size_t)l * 8 * 6144 + 2048};
            pg8::gemm_phase<pg8::EpiOut, pg8::DenseOrder, true, true>(lds, D, S, E);
        } else if (st == PH_ROUTER) {
            for (int wb = bx; wb < T / 16; wb += G) st_normrouter(p, l, wb, (LAS float*)lds);
        } else if (st == PH_COMPACT) {
            if (bx < NE) st_compact(p, bx, (LAS int*)lds);
        } else if (st == PH_EXP1 || st == PH_EXP2) {
            __syncthreads();
            if (tid == 0) {
                int acc = 0;
                for (int e = 0; e < 65; ++e) { const int c = e < NE ? p.cnt[e] : T; cnts[e] = c; tstart[e] = acc; acc += (c + 255) >> 8; }
                tstart[65] = acc;
            }
            __syncthreads();
            if (st == PH_EXP1) {
                pg8::MoeOrder<true> S{tstart, cnts, p.list, p.h, p.wt1, D, 512, 1, G, vcu};
                pg8::EpiExp1 E{p.hm};
                pg8::gemm_phase<pg8::EpiExp1, pg8::MoeOrder<true>, true, true>(lds, D, S, E);
            } else {
                pg8::MoeOrder<false> S{tstart, cnts, p.list, p.hm, p.wt2, ED, D, 2, G, vcu};
                pg8::EpiExp2 E{p.slab, p.xb, p.mod + (size_t)l * 8 * 6144 + 5120, p.list, p.topw, cnts};
                pg8::gemm_phase<pg8::EpiExp2, pg8::MoeOrder<false>, true, true>(lds, ED, S, E);
            }
        } else {
            for (int t = bx * 8 + wave; t < T; t += G * 8) st_combine(p, l, t, lane);
        }
        if (!(ph == NL * PH_PER_LAYER - 1)) { if (!(st == PH_NORM1 && l > 0)) xcd_barrier(xb); }
      }
    }
#undef PHASE_COORDS
}

}

extern "C" void kernel_launch(void* const* d_in, const int* in_sizes, int n_in, void* d_out, int out_size, void* d_ws, size_t ws_size,
                              hipStream_t stream) {
    P p{};
    const float** fp = (const float**)&p;
    for (int i = 0; i < 33; ++i) fp[i] = (const float*)d_in[i];
    p.out = (float*)d_out;
    char* ws = (char*)d_ws;
    size_t off = 0;
    auto take = [&](size_t bytes) { char* r = ws + off; off += (bytes + 255) & ~(size_t)255; return r; };
    p.bar = (unsigned*)take(16384);
    p.cnt = (int*)take(256);
    p.mod = (float*)take((size_t)NL * 8 * 6144 * 4);
    p.list = (int*)take((size_t)NE * T * 4);
    p.cnt2 = (int*)take((size_t)NE * 1024 * 4);
    p.seg = (int*)take((size_t)NE * 1024 * 16 * 4);
    p.topw = (float*)take((size_t)T * TOPK * 4);
    p.wt_in = (bf16_t*)take((size_t)NL * PJB * D * 2);
    p.wt_out = (bf16_t*)take((size_t)NL * D * D * 2);
    p.wt1 = (bf16_t*)take((size_t)65 * 512 * D * 2);
    p.wt2 = (bf16_t*)take((size_t)65 * D * ED * 2);
    p.xb = (float*)take((size_t)T * D * 4);
    p.h = (bf16_t*)take((size_t)T * D * 2);
    p.vfirst = (bf16_t*)take((size_t)T * RWW * 2);
    const size_t ov = off;
    p.proj = (bf16_t*)take((size_t)T * PJB * 2);
    p.vt = (bf16_t*)take((size_t)T * SBW * 2);
    p.rec = (float*)take((size_t)T * 6 * 6 * 64 * 4);
    p.g = (bf16_t*)take((size_t)T * RWW * 2);
    p.y = (float*)take((size_t)T * RWW * 4);
    p.hm = (bf16_t*)(ws + ov);
    p.slab = (bf16_t*)(ws + ov + (size_t)MAXRT * 256 * ED * 2);
    const size_t end_moe = ov + (size_t)MAXRT * 256 * ED * 2 + (size_t)T * TOPK * D * 2;
    if (end_moe > off) off = end_moe;
    if (off > ws_size) { fprintf(stderr, "kernel_launch: workspace too small: need %zu, have %zu\n", off, ws_size); return; }

    static int cus = 0;
    if (cus == 0) {
        int dev = 0, n = 0;
        if (hipGetDevice(&dev) != hipSuccess || hipDeviceGetAttribute(&n, hipDeviceAttributeMultiprocessorCount, dev) != hipSuccess || n <= 0) n = 256;
        (void)hipFuncSetAttribute((const void*)k_fused, hipFuncAttributeMaxDynamicSharedMemorySize, LDS_BYTES);
        cus = n;
    }
    (void)hipMemsetAsync(p.bar, 0, 16384 + 256, stream);
    void* args[] = {(void*)&p};
    (void)hipLaunchCooperativeKernel((const void*)k_fused, dim3(cus), dim3(NTHREADS), args, LDS_BYTES, stream);
}
```

```cpp
#include <hip/hip_runtime.h>
#include <stdint.h>
#include <stdio.h>

#define REP_PH -2
#define REP_N 1
#define REP_SEL 15

namespace {

typedef unsigned short bf16_t;
typedef short bf16x8 __attribute__((ext_vector_type(8)));
typedef float f32x4 __attribute__((ext_vector_type(4)));
typedef float f32x2 __attribute__((ext_vector_type(2)));
typedef unsigned u32x4 __attribute__((ext_vector_type(4)));
typedef unsigned u32x2 __attribute__((ext_vector_type(2)));
#define LAS __attribute__((address_space(3)))

constexpr int D = 1024, NBATCH = 8, SEQ = 2048, T = NBATCH * SEQ, NL = 2;
constexpr int RWW = 384, SBW = 384, PLW = 256;
constexpr int RWC = 1280, SBC = 1152, INC = 2688;
constexpr int PJB = 2816;
constexpr int NE = 64, TOPK = 6, ED = 256;
constexpr int MAXRT = 512;
constexpr int NTHREADS = 512;
constexpr int LDS_STAGE = 131072, LDS_CTL = 1024, LDS_BYTES = LDS_STAGE + LDS_CTL;

struct P {
    const float *x, *c, *w_ada, *b_ada, *w_in, *w_vres, *mu_rw, *mu_vres, *rw_w0, *rw_w2, *rw_a0, *rw_a2,
        *rw_v0, *rw_v2, *rw_g2, *rw_k_k, *rw_k_a, *rw_r_k, *rw_ln_g, *rw_ln_b, *sb_norm_g, *pool_w, *pool_scale,
        *w_out, *w_router, *b_router, *w_eg, *w_eu, *w_ed, *w_sg, *w_su, *w_sd, *g_final;
    float* out;
    unsigned* bar;
    float* mod;
    int* cnt;
    int* list;
    int* cnt2;
    int* seg;
    float* topw;
    bf16_t* wt_in;
    bf16_t* wt_out;
    bf16_t* wt1;
    bf16_t* wt2;
    float* xb;
    bf16_t* h;
    bf16_t* vfirst;
    bf16_t* proj;
    bf16_t* vt;
    unsigned char* rec;
    unsigned char* cb;
    bf16_t* g;
    float* y;
    bf16_t* hm;
    bf16_t* slab;
};

__device__ __forceinline__ int opaque(int x) { asm volatile("" : "+v"(x)); return x; }
__device__ __forceinline__ float dpp_add16(float x) {
    x += __builtin_bit_cast(float, __builtin_amdgcn_update_dpp(0, __builtin_bit_cast(int, x), 0xB1, 0xF, 0xF, true));
    x += __builtin_bit_cast(float, __builtin_amdgcn_update_dpp(0, __builtin_bit_cast(int, x), 0x4E, 0xF, 0xF, true));
    x += __builtin_bit_cast(float, __builtin_amdgcn_update_dpp(0, __builtin_bit_cast(int, x), 0x141, 0xF, 0xF, true));
    x += __builtin_bit_cast(float, __builtin_amdgcn_update_dpp(0, __builtin_bit_cast(int, x), 0x140, 0xF, 0xF, true));
    return x;
}
__device__ __forceinline__ float wave_sum(float v) {
    v = dpp_add16(v);
    const int vi = __builtin_bit_cast(int, v);
    return (__builtin_bit_cast(float, __builtin_amdgcn_readlane(vi, 0)) + __builtin_bit_cast(float, __builtin_amdgcn_readlane(vi, 16)))
         + (__builtin_bit_cast(float, __builtin_amdgcn_readlane(vi, 32)) + __builtin_bit_cast(float, __builtin_amdgcn_readlane(vi, 48)));
}
__device__ __forceinline__ unsigned pf_lines(const void* p, int nbytes, int lane) {
    unsigned acc = 0u;
    for (int off = lane * 128; off < nbytes; off += 8192) acc += *(const unsigned*)((const char*)p + off);
    return acc;
}
__device__ __forceinline__ void pf_done(unsigned v) { asm volatile("" :: "v"(v)); }
__device__ __forceinline__ float sigmoidf_(float x) { return 1.f / (1.f + __expf(-x)); }
__device__ __forceinline__ float softplusf_(float x) { return fmaxf(x, 0.f) + __logf(1.f + __expf(-fabsf(x))); }
__device__ __forceinline__ float siluf_(float x) { return x / (1.f + __expf(-x)); }
__device__ __forceinline__ unsigned f2bf(float f) { unsigned u = __builtin_bit_cast(unsigned, f); return (u + 0x7fffu + ((u >> 16) & 1u)) >> 16; }
__device__ __forceinline__ unsigned pk2(float lo, float hi) { return f2bf(lo) | (f2bf(hi) << 16); }
__device__ __forceinline__ float bf2f(bf16_t h) { return __builtin_bit_cast(float, (unsigned)h << 16); }
__device__ __forceinline__ float bflo(unsigned u) { return __builtin_bit_cast(float, u << 16); }
__device__ __forceinline__ float bfhi(unsigned u) { return __builtin_bit_cast(float, u & 0xffff0000u); }

namespace pg8 {
constexpr int BM = 256, BK = 64, HALF = 128, HTB = HALF * BK * 2, STAGE_BYTES = 8 * HTB;
__device__ __forceinline__ int lds_byte(int r, int c) { const int st = (r >> 4) * 2 + (c >> 5), rr = r & 15, cc = c & 31, ob = rr * 64 + cc * 2; return st * 1024 + (ob ^ (((ob >> 9) & 1) << 5)); }
__device__ __forceinline__ void stage_rc(int b, int& R, int& C) { const int st = b / 1024, sb = b % 1024, swz = sb ^ (((sb >> 9) & 1) << 5); R = (st >> 1) * 16 + swz / 64; C = (st & 1) * 32 + (swz % 64) / 2; }
__device__ __forceinline__ int perm32(int rho) { const int n = rho >> 4, i = rho & 15; return 8 * (i >> 2) + 4 * n + (i & 3); }

struct Unit { int pm, pn, e, mt; };

template <class Epi, class Sched, bool ALIGN_EPI, bool SP2>
__device__ __forceinline__ void gemm_phase(LAS unsigned char* lds, const int K, const Sched& S, const Epi& E) {
    const int tid = opaque(threadIdx.x), wid = __builtin_amdgcn_readfirstlane(tid >> 6), lane = tid & 63, wr = wid >> 2, wc = wid & 3, fr = lane & 15, fq = lane >> 4;
    const int nt = K / BK;
    unsigned voffA[2], voffB[2];
#pragma unroll
    for (int i = 0; i < 2; ++i) { int R, C; stage_rc(tid * 16 + i * 8192, R, C); const int Rb = Epi::PERM ? ((R & ~31) + perm32(R & 31)) : R;
        voffA[i] = Sched::GATHER ? (unsigned)(C * 2) : (unsigned)(R * K + C) * 2u; voffB[i] = (unsigned)(Rb * K + C) * 2u; }
    const size_t kstep = (size_t)(BK * 2);
    const size_t hstep = (size_t)HALF * K * 2;
    const unsigned ldsw = (unsigned)wid * 1024u;
    const int aoff = lds_byte(wr * 64 + fr, fq * 8), boff = lds_byte(wc * 32 + fr, fq * 8);
#define PG8_SA(b, h) (((b) * 2 + (h)) * HTB)
#define PG8_SB(b, h) ((4 + (b) * 2 + (h)) * HTB)
#define PG8_STAGE(bufoff, gbase, voff) do { _Pragma("unroll") for (int _i = 0; _i < 2; ++_i) \
        __builtin_amdgcn_global_load_lds((const unsigned*)((const char*)(gbase) + (voff)[_i]), (LAS unsigned*)(lds + (bufoff) + ldsw + _i * 8192), 16, 0, 0); } while (0)
#define PG8_LDA(dst, b, h) do { _Pragma("unroll") for (int m = 0; m < 4; ++m) _Pragma("unroll") for (int k = 0; k < 2; ++k) dst[m][k] = *(const LAS bf16x8*)(lds + PG8_SA(b, h) + aoff + m * 2048 + k * 1024); } while (0)
#define PG8_LDB(dst, b, h) do { _Pragma("unroll") for (int n = 0; n < 2; ++n) _Pragma("unroll") for (int k = 0; k < 2; ++k) dst[n][k] = *(const LAS bf16x8*)(lds + PG8_SB(b, h) + boff + n * 2048 + k * 1024); } while (0)
#define PG8_MMA(ai, bj, At, Bt) do { __builtin_amdgcn_s_setprio(1); _Pragma("unroll") for (int m = 0; m < 4; ++m) _Pragma("unroll") for (int n = 0; n < 2; ++n) _Pragma("unroll") for (int k = 0; k < 2; ++k) \
        acc[ai][bj][m][n] = __builtin_amdgcn_mfma_f32_16x16x32_bf16(Bt[n][k], At[m][k], acc[ai][bj][m][n], 0, 0, 0); __builtin_amdgcn_s_setprio(0); } while (0)
#define PG8_WAIT_V(n) asm volatile("s_waitcnt vmcnt(" #n ")" ::: "memory")
#define PG8_WAIT_L(n) asm volatile("s_waitcnt lgkmcnt(" #n ")" ::: "memory")
#define PG8_BAR __builtin_amdgcn_s_barrier()
#define PG8_SCHED __builtin_amdgcn_sched_barrier(0)
    Unit cur, nxt; int ui = 0;
    if (!S.next(0, cur)) return;
    f32x4 acc[2][2][4][2];
#pragma unroll
    for (int a = 0; a < 2; ++a)
#pragma unroll
        for (int b = 0; b < 2; ++b)
#pragma unroll
            for (int m = 0; m < 4; ++m)
#pragma unroll
                for (int n = 0; n < 2; ++n) acc[a][b][m][n] = (f32x4){0.f, 0.f, 0.f, 0.f};
    bf16x8 At[4][2], B0[2][2], B1[2][2];
    const char* cA = S.a_base(cur); const char* cB = S.b_base(cur);
    unsigned pk[2] = {0u, 0u}, npk[2] = {0u, 0u};
    if constexpr (Sched::GATHER) S.a_tok(cur, tid, pk);
    const unsigned k2 = (unsigned)K * 2u;
#define PG8_STAGE_A(bufoff, gbase, hh, PK) do { if constexpr (Sched::GATHER) { unsigned _v[2]; _v[0] = (((PK)[0] >> (16 * (hh))) & 0xffffu) * k2 + voffA[0]; _v[1] = (((PK)[1] >> (16 * (hh))) & 0xffffu) * k2 + voffA[1]; \
        PG8_STAGE(bufoff, gbase, _v); } else { PG8_STAGE(bufoff, (gbase) + (hh) * hstep, voffA); } } while (0)
    static_assert(SP2, "only the SP2 loop is kept");
    PG8_STAGE(PG8_SB(0, 0), cB, voffB); PG8_STAGE(PG8_SB(0, 1), cB + hstep, voffB); PG8_STAGE_A(PG8_SA(0, 0), cA, 0, pk); PG8_STAGE_A(PG8_SA(0, 1), cA, 1, pk);
    if (wr == 1) PG8_BAR;
    PG8_WAIT_V(2); PG8_BAR;
    PG8_STAGE(PG8_SB(1, 0), cB + kstep, voffB); PG8_STAGE_A(PG8_SA(1, 0), cA + kstep, 0, pk); PG8_STAGE(PG8_SB(1, 1), cB + hstep + kstep, voffB);
    PG8_WAIT_V(6); PG8_BAR;
    for (;;) {
        const bool has_next = S.next(ui + 1, nxt);
        const char* nA = has_next ? S.a_base(nxt) : cA; const char* nB = has_next ? S.b_base(nxt) : cB;
        if constexpr (Sched::GATHER) { if (has_next) S.a_tok(nxt, tid, npk); else { npk[0] = pk[0]; npk[1] = pk[1]; } }
#pragma unroll 1
        for (int t = 0; t < nt; t += 2) {
            const bool last = (t == nt - 2);
            const char* a1 = cA + (size_t)(t + 1) * kstep;
            const char* a2 = last ? nA : cA + (size_t)(t + 2) * kstep; const char* b2 = last ? nB : cB + (size_t)(t + 2) * kstep;
            const char* a3 = a2 + kstep; const char* b3 = b2 + kstep;
            unsigned sp[2]; sp[0] = last ? npk[0] : pk[0]; sp[1] = last ? npk[1] : pk[1];
            PG8_LDB(B0, 0, 0); PG8_LDB(B1, 0, 1); PG8_SCHED; PG8_LDA(At, 0, 0); PG8_STAGE_A(PG8_SA(1, 1), a1, 1, pk);
            PG8_WAIT_V(8); PG8_WAIT_L(0); PG8_BAR; PG8_MMA(0, 0, At, B0); PG8_MMA(0, 1, At, B1); PG8_BAR; PG8_SCHED;
            PG8_LDA(At, 0, 1); PG8_STAGE(PG8_SB(0, 0), b2, voffB); PG8_STAGE(PG8_SB(0, 1), b2 + hstep, voffB); PG8_STAGE_A(PG8_SA(0, 0), a2, 0, sp);
            PG8_WAIT_V(8); PG8_WAIT_L(0); PG8_BAR; PG8_MMA(1, 0, At, B0); PG8_MMA(1, 1, At, B1); PG8_BAR; PG8_SCHED;
            PG8_LDB(B0, 1, 0); PG8_LDB(B1, 1, 1); PG8_SCHED; PG8_LDA(At, 1, 0); PG8_STAGE_A(PG8_SA(0, 1), a2, 1, sp);
            PG8_WAIT_V(8); PG8_WAIT_L(0); PG8_BAR; PG8_MMA(0, 0, At, B0); PG8_MMA(0, 1, At, B1); PG8_BAR; PG8_SCHED;
            PG8_LDA(At, 1, 1); PG8_STAGE(PG8_SB(1, 0), b3, voffB); PG8_STAGE(PG8_SB(1, 1), b3 + hstep, voffB); PG8_STAGE_A(PG8_SA(1, 0), a3, 0, sp);
            PG8_WAIT_V(8); PG8_WAIT_L(0); PG8_BAR; PG8_MMA(1, 0, At, B0); PG8_MMA(1, 1, At, B1); PG8_BAR; PG8_SCHED;
        }
        if constexpr (ALIGN_EPI) { if (wr == 0) PG8_BAR; }
        { const int t2 = opaque(threadIdx.x), w2 = __builtin_amdgcn_readfirstlane(t2 >> 6), l2 = t2 & 63; E(acc, cur, w2 >> 2, w2 & 3, l2 & 15, l2 >> 4); }
        if (!has_next) break;
#pragma unroll
        for (int a = 0; a < 2; ++a)
#pragma unroll
            for (int b = 0; b < 2; ++b)
#pragma unroll
                for (int m = 0; m < 4; ++m)
#pragma unroll
                    for (int n = 0; n < 2; ++n) acc[a][b][m][n] = (f32x4){0.f, 0.f, 0.f, 0.f};
        cur = nxt; cA = nA; cB = nB; ++ui;
        pk[0] = npk[0]; pk[1] = npk[1];
        if constexpr (ALIGN_EPI) { if (wr == 1) PG8_BAR; }
    }
    PG8_WAIT_V(0);
    if constexpr (!ALIGN_EPI) { if (wr == 0) PG8_BAR; }
    PG8_BAR;
#undef PG8_SA
#undef PG8_SB
#undef PG8_STAGE
#undef PG8_STAGE_A
#undef PG8_LDA
#undef PG8_LDB
#undef PG8_MMA
#undef PG8_WAIT_V
#undef PG8_WAIT_L
#undef PG8_BAR
#undef PG8_SCHED
}

struct DenseOrder {
    const bf16_t* A; const bf16_t* Bt; int K; int nM, nN, nwg, G, c;
    __device__ __forceinline__ void init(const bf16_t* A_, const bf16_t* Bt_, int M, int N, int K_, int G_, int c_) { A = A_; Bt = Bt_; K = K_; nM = M / BM; nN = N / BM; nwg = nM * nN; G = G_; c = c_; }
    __device__ __forceinline__ bool next(int i, Unit& u) const {
        const long L = (long)i * G + c; if (L >= nwg) return false;
        int wgid = (int)L; { const int q = nwg / 8, r = nwg % 8, xcd = wgid % 8, off = wgid / 8; wgid = (xcd < r ? xcd * (q + 1) : r * (q + 1) + (xcd - r) * q) + off; }
        const int nig = 8 * nN, gid = wgid / nig, fm = gid * 8, gsz = (nM - fm) < 8 ? (nM - fm) : 8;
        u.pm = fm + ((wgid % nig) % gsz); u.pn = (wgid % nig) / gsz; u.e = 0; u.mt = 0; return true;
    }
    __device__ __forceinline__ const char* a_base(const Unit& u) const { return (const char*)A + (size_t)u.pm * BM * K * 2; }
    __device__ __forceinline__ const char* b_base(const Unit& u) const { return (const char*)Bt + (size_t)u.pn * BM * K * 2; }
    static constexpr bool GATHER = false;
    __device__ __forceinline__ void a_tok(const Unit&, int, unsigned (&)[2]) const {}
};

template <bool GATHER_>
struct MoeOrder {
    static constexpr bool GATHER = GATHER_;
    const LAS int* tstart;
    const LAS int* cnts;
    const int* list;
    const bf16_t* A;
    const bf16_t* Bt;
    int K, N, lognpn, G, c;
    __device__ __forceinline__ bool next(int i, Unit& u) const {
        const int L = i * G + c; const int total = __builtin_amdgcn_readfirstlane(tstart[65]) << lognpn; if (L >= total) return false;
        const int rt = L >> lognpn; u.pn = L & ((1 << lognpn) - 1); u.pm = rt;
        int e = 0;
        for (int j = 1; j < 65; ++j) e += (tstart[j] <= rt) ? 1 : 0;
        e = __builtin_amdgcn_readfirstlane(e);
        u.e = e; u.mt = rt - __builtin_amdgcn_readfirstlane(tstart[e]); return true;
    }
    __device__ __forceinline__ const char* a_base(const Unit& u) const { return GATHER ? (const char*)A : (const char*)A + (size_t)u.pm * BM * K * 2; }
    __device__ __forceinline__ const char* b_base(const Unit& u) const { return (const char*)Bt + ((size_t)u.e * N + (size_t)u.pn * BM) * K * 2; }
    __device__ __forceinline__ void a_tok(const Unit& u, int tid, unsigned (&pkv)[2]) const {
        const int ce = cnts[u.e];
#pragma unroll
        for (int i = 0; i < 2; ++i) {
            int R, C; stage_rc(tid * 16 + i * 8192, R, C); (void)C;
            unsigned v = 0u;
#pragma unroll
            for (int hh = 0; hh < 2; ++hh) {
                const int idx = u.mt * BM + hh * HALF + R;
                int tok = 0;
                if (idx < ce) tok = (u.e < NE) ? (list[(size_t)u.e * T + idx] / TOPK) : idx;
                v |= (unsigned)tok << (16 * hh);
            }
            pkv[i] = v;
        }
    }
};

struct EpiProj {
    static constexpr bool PERM = true;
    bf16_t* O; bf16_t* vt;
    __device__ __forceinline__ void operator()(const f32x4 (&acc)[2][2][4][2], const Unit& u, int wr, int wc, int fr, int fq) const {
        const int row0 = u.pm * BM + wr * 64 + fr, col0 = u.pn * BM + wc * 32 + 8 * fq;
#pragma unroll
        for (int bj = 0; bj < 2; ++bj) {
            const bool isv = (u.pn == 8) || (u.pn == 9 && bj == 0);
            if (!isv) {
#pragma unroll
                for (int ai = 0; ai < 2; ++ai)
#pragma unroll
                    for (int m = 0; m < 4; ++m) { bf16_t* rowp = O + (size_t)(row0 + ai * HALF + m * 16) * PJB + col0 + bj * HALF;
                        const f32x4 v0 = acc[ai][bj][m][0], v1 = acc[ai][bj][m][1];
                        u32x4 w; w.x = pk2(v0[0], v0[1]); w.y = pk2(v0[2], v0[3]); w.z = pk2(v1[0], v1[1]); w.w = pk2(v1[2], v1[3]);
                        *(u32x4*)rowp = w; }
            } else {
                const int vc0 = col0 + bj * HALF - 2048;
#pragma unroll
                for (int ai = 0; ai < 2; ++ai)
#pragma unroll
                    for (int m = 0; m < 4; ++m) { const int row = row0 + ai * HALF + m * 16; const int b = row / SEQ, s = row % SEQ;
                        bf16_t* base = vt + ((size_t)b * SBW + vc0) * SEQ + s;
#pragma unroll
                        for (int n = 0; n < 2; ++n)
#pragma unroll
                            for (int j = 0; j < 4; ++j) base[(size_t)(4 * n + j) * SEQ] = (bf16_t)f2bf(acc[ai][bj][m][n][j]); }
            }
        }
    }
};
struct EpiOut {
    static constexpr bool PERM = false;
    const float* xin; float* xo; const float* gt;
    __device__ __forceinline__ void operator()(const f32x4 (&acc)[2][2][4][2], const Unit& u, int wr, int wc, int fr, int fq) const {
        const int row0 = u.pm * BM + wr * 64 + fr, col0 = u.pn * BM + wc * 32 + 4 * fq;
#pragma unroll
        for (int ai = 0; ai < 2; ++ai)
#pragma unroll
            for (int m = 0; m < 4; ++m) { const int row = row0 + ai * HALF + m * 16; const float* gr = gt + (size_t)(row / SEQ) * 6144;
#pragma unroll
                for (int bj = 0; bj < 2; ++bj)
#pragma unroll
                    for (int n = 0; n < 2; ++n) { const int col = col0 + bj * HALF + 16 * n;
                        const f32x4 xi = *(const f32x4*)(xin + (size_t)row * D + col); const f32x4 gg = *(const f32x4*)(gr + col);
                        *(f32x4*)(xo + (size_t)row * D + col) = xi + gg * acc[ai][bj][m][n]; } }
    }
};
struct EpiExp1 {
    static constexpr bool PERM = true;
    bf16_t* hm;
    __device__ __forceinline__ void operator()(const f32x4 (&acc)[2][2][4][2], const Unit& u, int wr, int wc, int fr, int fq) const {
        const int row0 = u.pm * BM + wr * 64 + fr, col0 = u.pn * HALF + wc * 32 + 8 * fq;
#pragma unroll
        for (int ai = 0; ai < 2; ++ai)
#pragma unroll
            for (int m = 0; m < 4; ++m) { bf16_t* rowp = hm + (size_t)(row0 + ai * HALF + m * 16) * ED + col0;
                float o[8];
#pragma unroll
                for (int n = 0; n < 2; ++n)
#pragma unroll
                    for (int j = 0; j < 4; ++j) o[n * 4 + j] = siluf_(acc[ai][0][m][n][j]) * acc[ai][1][m][n][j];
                u32x4 w; w.x = pk2(o[0], o[1]); w.y = pk2(o[2], o[3]); w.z = pk2(o[4], o[5]); w.w = pk2(o[6], o[7]);
                *(u32x4*)rowp = w; }
    }
};
struct EpiExp2 {
    static constexpr bool PERM = true;
    bf16_t* slab; float* xb; const float* gt; const int* list; const float* topw; const LAS int* cnts; int skip_shared;
    __device__ __forceinline__ void operator()(const f32x4 (&acc)[2][2][4][2], const Unit& u, int wr, int wc, int fr, int fq) const {
        const int col0 = u.pn * BM + wc * 32 + 8 * fq; const int ce = cnts[u.e];
#pragma unroll
        for (int ai = 0; ai < 2; ++ai)
#pragma unroll
            for (int m = 0; m < 4; ++m) { const int idx = u.mt * BM + ai * HALF + wr * 64 + m * 16 + fr;
                if (idx < ce) {
                    if (u.e < NE) {
                        const int aid = list[(size_t)u.e * T + idx]; const float wgt = topw[aid]; bf16_t* rowp = slab + (size_t)aid * D + col0;
#pragma unroll
                        for (int bj = 0; bj < 2; ++bj) { const f32x4 v0 = acc[ai][bj][m][0] * wgt, v1 = acc[ai][bj][m][1] * wgt;
                            u32x4 w; w.x = pk2(v0[0], v0[1]); w.y = pk2(v0[2], v0[3]); w.z = pk2(v1[0], v1[1]); w.w = pk2(v1[2], v1[3]);
                            *(u32x4*)(rowp + bj * HALF) = w; }
                    } else if (!skip_shared) {
                        const int tok = idx; float* xr = xb + (size_t)tok * D + col0; const float* gr = gt + (size_t)(tok / SEQ) * 6144 + col0;
#pragma unroll
                        for (int bj = 0; bj < 2; ++bj)
#pragma unroll
                            for (int n = 0; n < 2; ++n) { const f32x4 xi = *(const f32x4*)(xr + bj * HALF + 4 * n); const f32x4 gg = *(const f32x4*)(gr + bj * HALF + 4 * n);
                                *(f32x4*)(xr + bj * HALF + 4 * n) = xi + gg * acc[ai][bj][m][n]; }
                    }
                } }
    }
};
}

__device__ __forceinline__ void st_mod(const P& p, int item, LAS float* L  ) {
    const int tid = opaque(threadIdx.x), wave = tid >> 6, lane = tid & 63;
    const int l = item / 96, j0 = (item % 96) * 64;
    for (int i = tid; i < 8 * 1024; i += NTHREADS) L[i] = siluf_(p.c[i]);
    __syncthreads();
    float acc[8];
#pragma unroll
    for (int b = 0; b < 8; ++b) acc[b] = 0.f;
    const float* w = p.w_ada + ((size_t)l * 1024 + wave * 128) * 6144 + j0 + lane;
#pragma unroll 8
    for (int i = 0; i < 128; ++i) {
        const float wv = w[(size_t)i * 6144];
#pragma unroll
        for (int b = 0; b < 8; ++b) acc[b] += L[b * 1024 + wave * 128 + i] * wv;
    }
    LAS float* red = L + 8 * 1024;
#pragma unroll
    for (int b = 0; b < 8; ++b) red[(wave * 8 + b) * 64 + lane] = acc[b];
    __syncthreads();
    {
        const int b = tid >> 6;
        float s = p.b_ada[l * 6144 + j0 + lane];
#pragma unroll
        for (int wv = 0; wv < 8; ++wv) s += red[(wv * 8 + b) * 64 + lane];
        p.mod[((size_t)l * 8 + b) * 6144 + j0 + lane] = s;
    }
    __syncthreads();
}

constexpr int REC_HB = 912, REC_TB = 6 * REC_HB;
constexpr int CB_PHI = 0, CB_RT = 8192, CB_PSI = 12288, CB_G = 16384, CB_V = 18432, CB_BYTES = 22528;
constexpr int PREP_TOK = 64;
__device__ __forceinline__ void st_prep(const P& p, int l, int vb0, int vbstride, LAS float* X  ) {
    const int tid = opaque(threadIdx.x);
    const int c = tid < RWW ? tid : 0, hh = c >> 6, lane = c & 63;
    for (int vb = vb0; vb < T / PREP_TOK; vb += vbstride) {
        const int t0 = vb * PREP_TOK, s0 = t0 % SEQ;
#pragma unroll 4
        for (int q = 0; q < PREP_TOK * 160 / NTHREADS; ++q) {
            const int it = tid + q * NTHREADS;
            const int tt = it / 160, i = it % 160;
            const int col = (i < 128) ? 1152 + i : INC + (i - 128);
            const float mu = (i < 128) ? p.mu_rw[l * RWC + col] : p.mu_vres[i - 128];
            const bf16_t* u = p.proj + (size_t)(t0 + tt) * PJB + col;
            const float uu = bf2f(u[0]), pv = (s0 + tt) > 0 ? bf2f(u[-PJB]) : 0.f;
            float x = uu + (pv - uu) * mu;
            if (i < 32) x = tanhf(x); else if (i >= 64 && i < 128) x = sigmoidf_(x);
            if (i >= 128 && l == 0) x = 0.f;
            X[it] = x;
        }
        __syncthreads();
        if (tid < RWW) {
            {
                float W2[32], A2[32], V2[32];
                const int cc = opaque(c);
                {
                    const float* w2 = p.rw_w2 + (size_t)l * 32 * RWW;
                    const float* a2 = p.rw_a2 + (size_t)l * 32 * RWW;
                    const float* v2 = p.rw_v2;
#pragma unroll
                    for (int i = 0; i < 32; ++i) { W2[i] = w2[i * RWW + cc]; A2[i] = a2[i * RWW + cc]; V2[i] = (l == 1) ? v2[i * RWW + cc] : 0.f; }
                }
                const float w0 = p.rw_w0[l * RWW + cc], a0 = p.rw_a0[l * RWW + cc], v0 = (l == 1) ? p.rw_v0[cc] : 0.f;
                const float kkc = p.rw_k_k[l * RWW + cc], kac = p.rw_k_a[l * RWW + cc], rkc = p.rw_r_k[l * RWW + cc];
                const float mur = p.mu_rw[l * RWC + cc], muk = p.mu_rw[l * RWC + 384 + cc], muv = p.mu_rw[l * RWC + 768 + cc];
                for (int grp = 0; grp < PREP_TOK / 4; ++grp) {
                    float pr[4], pk_[4], pv_[4], pvf[4];
#pragma unroll
                    for (int j = 0; j < 4; ++j) {
                        const int tt = grp * 4 + j; const bf16_t* u = p.proj + (size_t)(t0 + tt) * PJB + c; const bool hp = (s0 + tt) > 0;
                        float r = bf2f(u[0]), k = bf2f(u[384]), v = bf2f(u[768]);
                        const float rp = hp ? bf2f(u[-PJB]) : 0.f, kp = hp ? bf2f(u[384 - PJB]) : 0.f, vp = hp ? bf2f(u[768 - PJB]) : 0.f;
                        pr[j] = r + (rp - r) * mur; pk_[j] = k + (kp - k) * muk; pv_[j] = v + (vp - v) * muv;
                        pvf[j] = (l == 1) ? bf2f(p.vfirst[(size_t)(t0 + tt) * RWW + c]) : 0.f;
                    }
#pragma unroll
                    for (int j = 0; j < 4; ++j) {
                        const int tt = grp * 4 + j, t = t0 + tt;
                        const LAS float* xr = X + tt * 160;
                        float aw = w0, aa = a0, av = v0;
#pragma unroll
                        for (int i = 0; i < 32; i += 4) {
                            const f32x4 xw = *(const LAS f32x4*)(xr + i), xa = *(const LAS f32x4*)(xr + 32 + i), xv = *(const LAS f32x4*)(xr + 128 + i);
#pragma unroll
                            for (int q = 0; q < 4; ++q) { aw += xw[q] * W2[i + q]; aa += xa[q] * A2[i + q]; av += xv[q] * V2[i + q]; }
                        }
                        const float r = pr[j], k = pk_[j]; float v = pv_[j];
                        const float wlog = -softplusf_(-aw) - 0.5f;
                        const float decay = __expf(-__expf(wlog));
                        const float a = sigmoidf_(aa);
                        if (l == 1) { const float vg = sigmoidf_(av); v = v + (pvf[j] - v) * vg; }
                        else p.vfirst[(size_t)t * RWW + c] = (bf16_t)f2bf(v);
                        const float kkr = k * kkc;
                        const float ss = wave_sum(kkr * kkr);
                        const float kk = kkr / fmaxf(sqrtf(ss), 1e-12f);
                        unsigned char* rc = p.rec + (size_t)t * REC_TB + hh * REC_HB;
                        const float bq = kk * a, k2 = k * (1.f + (a - 1.f) * kac);
                        *(float*)(rc + lane * 4) = decay;
                        bf16_t* rb = (bf16_t*)(rc + 256) + lane;
                        rb[0] = (bf16_t)f2bf(-kk); rb[64] = (bf16_t)f2bf(bq); rb[128] = (bf16_t)f2bf(k2); rb[192] = (bf16_t)f2bf(decay * r); rb[256] = (bf16_t)f2bf(v);
                        const float rkb = wave_sum(r * k2 * rkc);
                        if (lane == 0) *(float*)(rc + 896) = rkb;
                    }
                }
            }
            {
                float G2[64];
                const float* g2 = p.rw_g2 + (size_t)l * 64 * RWW;
                const int cc = opaque(c);
#pragma unroll
                for (int i = 0; i < 64; ++i) G2[i] = g2[i * RWW + cc];
                for (int grp = 0; grp < PREP_TOK / 4; ++grp) {
#pragma unroll
                    for (int j = 0; j < 4; ++j) {
                        const int tt = grp * 4 + j;
                        const LAS float* xr = X + tt * 160 + 64;
                        float ag = 0.f;
#pragma unroll
                        for (int i = 0; i < 64; i += 4) {
                            const f32x4 xg = *(const LAS f32x4*)(xr + i);
#pragma unroll
                            for (int q = 0; q < 4; ++q) ag += xg[q] * G2[i + q];
                        }
                        p.g[(size_t)(t0 + tt) * RWW + c] = (bf16_t)f2bf(ag);
                    }
                }
            }
        }
        __syncthreads();
    }
}

typedef float f32x16 __attribute__((ext_vector_type(16)));
typedef __bf16 bf16x2_t __attribute__((ext_vector_type(2)));
__device__ __forceinline__ unsigned cvtpk(float lo, float hi) { const f32x2 v = {lo, hi}; const bf16x2_t b = __builtin_convertvector(v, bf16x2_t); return __builtin_bit_cast(unsigned, b); }
__device__ __forceinline__ bf16x8 mk8(unsigned a, unsigned b, unsigned c, unsigned d) { return __builtin_bit_cast(bf16x8, (u32x4){a, b, c, d}); }
__device__ __forceinline__ bf16x8 acc_frag(const f32x16& x, int ks) {
    return ks == 0 ? mk8(cvtpk(x[0], x[1]), cvtpk(x[2], x[3]), cvtpk(x[4], x[5]), cvtpk(x[6], x[7])) : mk8(cvtpk(x[8], x[9]), cvtpk(x[10], x[11]), cvtpk(x[12], x[13]), cvtpk(x[14], x[15]));
}
__device__ __forceinline__ bf16x8 lds_perm_frag(const LAS unsigned char* rowp, int ks, int hf) {
    const u32x2 g0 = *(const LAS u32x2*)(rowp + (16 * ks + 4 * hf) * 2), g1 = *(const LAS u32x2*)(rowp + (16 * ks + 4 * hf + 8) * 2);
    return mk8(g0.x, g0.y, g1.x, g1.y);
}
constexpr int CP_WAVES = 6, CP_LDS = 20736;
__device__ __forceinline__ void st_cpre(const P& p, int item, LAS unsigned char* L, int lane_) {
    const int lane = opaque(lane_);
    const int ch = item & 63, bh = item >> 6, b = bh / 6, hh = bh % 6;
    const int r = lane & 31, hf = lane >> 5;
    const unsigned char* rec0 = p.rec + ((size_t)(b * SEQ + ch * 32)) * REC_TB + hh * REC_HB;
    unsigned char* cbo = p.cb + (size_t)item * CB_BYTES;
    LAS unsigned char* AbarT = L; LAS unsigned char* RbarT = L + 4096; LAS unsigned char* Bbar = L + 8192; LAS unsigned char* Kbar = L + 12288; LAS unsigned char* BbarT = L + 16384;
    LAS float* PCv = (LAS float*)(L + 20480);
    float Y[32];
    {
        float Pc = 1.f;
        unsigned bt[16], vtw[16];
#pragma unroll
        for (int t8 = 0; t8 < 32; t8 += 8) {
            float wv[8]; bf16_t av[8], bv[8], kv[8], qv[8], vv[8];
#pragma unroll
            for (int j = 0; j < 8; ++j) {
                const unsigned char* rp = rec0 + (size_t)(t8 + j) * REC_TB;
                wv[j] = *(const float*)(rp + lane * 4);
                const bf16_t* hb = (const bf16_t*)(rp + 256) + lane;
                av[j] = hb[0]; bv[j] = hb[64]; kv[j] = hb[128]; qv[j] = hb[192]; vv[j] = hb[256];
            }
#pragma unroll
            for (int j = 0; j < 8; ++j) {
                const int t = t8 + j;
                const float Pm = Pc; Pc *= wv[j]; const float inv = 1.f / Pc;
                const float ab = bf2f(av[j]) * Pm, rb = bf2f(qv[j]) * Pm, bb = bf2f(bv[j]) * inv, kb = bf2f(kv[j]) * inv;
                Y[t] = ab;
                *(LAS bf16_t*)(AbarT + (t * 64 + lane) * 2) = (bf16_t)f2bf(ab);
                *(LAS bf16_t*)(RbarT + (t * 64 + lane) * 2) = (bf16_t)f2bf(rb);
                *(LAS bf16_t*)(Bbar + (t * 64 + lane) * 2) = (bf16_t)f2bf(bb);
                *(LAS bf16_t*)(Kbar + (t * 64 + lane) * 2) = (bf16_t)f2bf(kb);
                if (t & 1) { bt[t >> 1] |= f2bf(bb) << 16; vtw[t >> 1] |= (unsigned)vv[j] << 16; } else { bt[t >> 1] = f2bf(bb); vtw[t >> 1] = (unsigned)vv[j]; }
            }
            asm volatile("" ::: "memory");
        }
        PCv[lane] = Pc;
#pragma unroll
        for (int q = 0; q < 4; ++q) {
            *(LAS u32x4*)(BbarT + lane * 64 + q * 16) = (u32x4){bt[4 * q], bt[4 * q + 1], bt[4 * q + 2], bt[4 * q + 3]};
            *(u32x4*)(cbo + CB_V + lane * 64 + q * 16) = (u32x4){vtw[4 * q], vtw[4 * q + 1], vtw[4 * q + 2], vtw[4 * q + 3]};
        }
    }
    asm volatile("s_waitcnt lgkmcnt(0)" ::: "memory");
    f32x16 Lab, Lak, Mbr, Mkr;
#pragma unroll
    for (int i = 0; i < 16; ++i) { Lab[i] = 0.f; Lak[i] = 0.f; Mbr[i] = 0.f; Mkr[i] = 0.f; }
#pragma unroll
    for (int ks = 0; ks < 4; ++ks) {
        const int off = (r * 64 + 16 * ks + 8 * hf) * 2;
        const bf16x8 fb = *(const LAS bf16x8*)(Bbar + off), fk = *(const LAS bf16x8*)(Kbar + off), fa = *(const LAS bf16x8*)(AbarT + off), fr = *(const LAS bf16x8*)(RbarT + off);
        Lab = __builtin_amdgcn_mfma_f32_32x32x16_bf16(fb, fa, Lab, 0, 0, 0);
        Lak = __builtin_amdgcn_mfma_f32_32x32x16_bf16(fk, fa, Lak, 0, 0, 0);
        Mbr = __builtin_amdgcn_mfma_f32_32x32x16_bf16(fb, fr, Mbr, 0, 0, 0);
        Mkr = __builtin_amdgcn_mfma_f32_32x32x16_bf16(fk, fr, Mkr, 0, 0, 0);
    }
#pragma unroll
    for (int i = 0; i < 16; ++i) {
        const int s = (i & 3) + 8 * (i >> 2) + 4 * hf;
        if (!(s < r)) { Lab[i] = 0.f; Lak[i] = 0.f; }
        if (!(s <= r)) { Mbr[i] = 0.f; Mkr[i] = 0.f; }
    }
    asm volatile("s_waitcnt lgkmcnt(0)" ::: "memory");
    {
        LAS float* LabT = (LAS float*)AbarT; LAS float* LakM = (LAS float*)Bbar;
#pragma unroll
        for (int g = 0; g < 4; ++g) *(LAS f32x4*)(LabT + r * 32 + 8 * g + 4 * hf) = (f32x4){Lab[4 * g], Lab[4 * g + 1], Lab[4 * g + 2], Lab[4 * g + 3]};
#pragma unroll
        for (int i = 0; i < 16; ++i) LakM[((i & 3) + 8 * (i >> 2) + 4 * hf) * 32 + r] = Lak[i];
    }
    asm volatile("s_waitcnt lgkmcnt(0)" ::: "memory");
    unsigned W2p[16];
    {
        const LAS float* LabT = (const LAS float*)AbarT; const LAS float* LakM = (const LAS float*)Bbar;
        float X2[32];
#pragma unroll
        for (int t = 0; t < 32; t += 4) { const f32x4 q = *(const LAS f32x4*)(LakM + r * 32 + t); X2[t] = q[0]; X2[t + 1] = q[1]; X2[t + 2] = q[2]; X2[t + 3] = q[3]; }
        int zdep = 0;
#pragma unroll
        for (int t = 1; t < 32; ++t) {
            float x2 = X2[t];
            const LAS float* row = LabT + t * 32 + zdep;
#pragma unroll
            for (int s4 = 0; s4 < t; s4 += 4) {
                const f32x4 lq = *(const LAS f32x4*)(row + s4);
#pragma unroll
                for (int q = 0; q < 4; ++q) if (s4 + q < t) x2 = fmaf(X2[s4 + q], lq[q], x2);
            }
            X2[t] = x2;
            asm volatile("v_mov_b32 %0, 0" : "=v"(zdep) : "v"(x2));
        }
#pragma unroll
        for (int q = 0; q < 16; ++q) W2p[q] = pk2(X2[2 * q], X2[2 * q + 1]);
    }
    {
        const LAS float* LabT = (const LAS float*)AbarT;
        int zdep = 0;
#pragma unroll
        for (int t = 1; t < 32; ++t) {
            float x1 = Y[t];
            const LAS float* row = LabT + t * 32 + zdep;
#pragma unroll
            for (int s4 = 0; s4 < t; s4 += 4) {
                const f32x4 lq = *(const LAS f32x4*)(row + s4);
#pragma unroll
                for (int q = 0; q < 4; ++q) if (s4 + q < t) x1 = fmaf(Y[s4 + q], lq[q], x1);
            }
            Y[t] = x1;
            asm volatile("v_mov_b32 %0, 0" : "=v"(zdep) : "v"(x1));
        }
    }
    asm volatile("s_waitcnt lgkmcnt(0)" ::: "memory");
    LAS unsigned char* Atil = L;
    LAS unsigned char* Wv = L + 8192;
#pragma unroll
    for (int q = 0; q < 4; ++q) {
        *(LAS u32x4*)(Atil + lane * 64 + q * 16) = (u32x4){pk2(Y[8 * q], Y[8 * q + 1]), pk2(Y[8 * q + 2], Y[8 * q + 3]), pk2(Y[8 * q + 4], Y[8 * q + 5]), pk2(Y[8 * q + 6], Y[8 * q + 7])};
        if (lane < 32) *(LAS u32x4*)(Wv + lane * 64 + q * 16) = (u32x4){W2p[4 * q], W2p[4 * q + 1], W2p[4 * q + 2], W2p[4 * q + 3]};
    }
    asm volatile("s_waitcnt lgkmcnt(0)" ::: "memory");
    const bf16x8 mb0 = acc_frag(Mbr, 0), mb1 = acc_frag(Mbr, 1);
#pragma unroll
    for (int i = 0; i < 2; ++i) {
        f32x16 c;
#pragma unroll
        for (int g = 0; g < 4; ++g) { const u32x2 q = *(const LAS u32x2*)(RbarT + (r * 64 + 32 * i + 8 * g + 4 * hf) * 2); c[4 * g] = bflo(q.x); c[4 * g + 1] = bfhi(q.x); c[4 * g + 2] = bflo(q.y); c[4 * g + 3] = bfhi(q.y); }
        c = __builtin_amdgcn_mfma_f32_32x32x16_bf16(lds_perm_frag(Atil + (32 * i + r) * 64, 0, hf), mb0, c, 0, 0, 0);
        c = __builtin_amdgcn_mfma_f32_32x32x16_bf16(lds_perm_frag(Atil + (32 * i + r) * 64, 1, hf), mb1, c, 0, 0, 0);
#pragma unroll
        for (int g = 0; g < 4; ++g) *(u32x2*)(cbo + CB_RT + (r * 64 + 32 * i + 8 * g + 4 * hf) * 2) = (u32x2){cvtpk(c[4 * g], c[4 * g + 1]), cvtpk(c[4 * g + 2], c[4 * g + 3])};
    }
    {
        f32x16 c = Mkr;
        c = __builtin_amdgcn_mfma_f32_32x32x16_bf16(lds_perm_frag(Wv + r * 64, 0, hf), mb0, c, 0, 0, 0);
        c = __builtin_amdgcn_mfma_f32_32x32x16_bf16(lds_perm_frag(Wv + r * 64, 1, hf), mb1, c, 0, 0, 0);
#pragma unroll
        for (int g = 0; g < 4; ++g) *(u32x2*)(cbo + CB_G + (r * 32 + 8 * g + 4 * hf) * 2) = (u32x2){cvtpk(c[4 * g], c[4 * g + 1]), cvtpk(c[4 * g + 2], c[4 * g + 3])};
    }
#pragma unroll
    for (int jt = 0; jt < 2; ++jt) {
        const float pc = PCv[32 * jt + r];
        const bf16x8 fb0 = *(const LAS bf16x8*)(BbarT + (32 * jt + r) * 64 + (8 * hf) * 2), fb1 = *(const LAS bf16x8*)(BbarT + (32 * jt + r) * 64 + (16 + 8 * hf) * 2);
#pragma unroll
        for (int i = 0; i < 2; ++i) {
            f32x16 c;
#pragma unroll
            for (int q = 0; q < 16; ++q) c[q] = 0.f;
            c = __builtin_amdgcn_mfma_f32_32x32x16_bf16(*(const LAS bf16x8*)(Atil + (32 * i + r) * 64 + (8 * hf) * 2), fb0, c, 0, 0, 0);
            c = __builtin_amdgcn_mfma_f32_32x32x16_bf16(*(const LAS bf16x8*)(Atil + (32 * i + r) * 64 + (16 + 8 * hf) * 2), fb1, c, 0, 0, 0);
#pragma unroll
            for (int q = 0; q < 16; ++q) { const int kq = (q & 3) + 8 * (q >> 2) + 4 * hf; c[q] = (c[q] + ((i == jt && kq == r) ? 1.f : 0.f)) * pc; }
#pragma unroll
            for (int g = 0; g < 4; ++g) *(u32x2*)(cbo + CB_PHI + ((32 * jt + r) * 64 + 32 * i + 8 * g + 4 * hf) * 2) = (u32x2){cvtpk(c[4 * g], c[4 * g + 1]), cvtpk(c[4 * g + 2], c[4 * g + 3])};
        }
        {
            f32x16 c;
#pragma unroll
            for (int q = 0; q < 16; ++q) c[q] = bf2f(*(const LAS bf16_t*)(Kbar + (((q & 3) + 8 * (q >> 2) + 4 * hf) * 64 + 32 * jt + r) * 2));
            c = __builtin_amdgcn_mfma_f32_32x32x16_bf16(*(const LAS bf16x8*)(Wv + r * 64 + (8 * hf) * 2), fb0, c, 0, 0, 0);
            c = __builtin_amdgcn_mfma_f32_32x32x16_bf16(*(const LAS bf16x8*)(Wv + r * 64 + (16 + 8 * hf) * 2), fb1, c, 0, 0, 0);
#pragma unroll
            for (int g = 0; g < 4; ++g) *(u32x2*)(cbo + CB_PSI + ((32 * jt + r) * 32 + 8 * g + 4 * hf) * 2) = (u32x2){cvtpk(c[4 * g] * pc, c[4 * g + 1] * pc), cvtpk(c[4 * g + 2] * pc, c[4 * g + 3] * pc)};
        }
    }
    asm volatile("s_waitcnt lgkmcnt(0)" ::: "memory");
}

constexpr int CS_SLOTS = 4, CS_NP = CB_BYTES / 1024;
__device__ __forceinline__ void st_cscan(const P& p, int bh, LAS unsigned char* lds) {
    const int tid = opaque(threadIdx.x), wave = __builtin_amdgcn_readfirstlane(tid >> 6), lane = tid & 63;
    const int b = bh / 6, hh = bh % 6, r = lane & 31, hf = lane >> 5;
    const unsigned char* cb0 = p.cb + (size_t)bh * 64 * CB_BYTES;
    constexpr int NCH = SEQ / 32;
    const int lw = wave - 2;
#define CS_ISSUE(chunk) do { const int _c = (chunk) < NCH ? (chunk) : NCH - 1; const unsigned char* _g = cb0 + (size_t)_c * CB_BYTES + lane * 16; LAS unsigned char* _l = lds + ((chunk) & 3) * CB_BYTES; \
        _Pragma("unroll") for (int _j = 0; _j < 4; ++_j) if (lw + 6 * _j < CS_NP) __builtin_amdgcn_global_load_lds((const unsigned*)(_g + (lw + 6 * _j) * 1024), (LAS unsigned*)(_l + (lw + 6 * _j) * 1024), 16, 0, 0); } while (0)
    f32x16 X0, X1;
#pragma unroll
    for (int i = 0; i < 16; ++i) { X0[i] = 0.f; X1[i] = 0.f; }
    if (wave >= 2) { CS_ISSUE(0); CS_ISSUE(1); CS_ISSUE(2); }
    float* yb = p.y + (size_t)b * SEQ * RWW + hh * 64 + 32 * wave + r;
    for (int c = 0; c < NCH; ++c) {
        if (wave >= 2) { if (lw < 4) asm volatile("s_waitcnt vmcnt(8)" ::: "memory"); else asm volatile("s_waitcnt vmcnt(6)" ::: "memory"); }
        __builtin_amdgcn_s_barrier();
        if (wave >= 2) { CS_ISSUE(c + 3); }
        else {
            const LAS unsigned char* S = lds + (c & 3) * CB_BYTES;
            const int vr = 32 * wave + r;
            const bf16x8 vf0 = *(const LAS bf16x8*)(S + CB_V + vr * 64 + (8 * hf) * 2), vf1 = *(const LAS bf16x8*)(S + CB_V + vr * 64 + (16 + 8 * hf) * 2);
            const LAS unsigned char* rp = S + CB_RT + r * 128;
            const bf16x8 fr0 = lds_perm_frag(rp, 0, hf), fr1 = lds_perm_frag(rp, 1, hf), fr2 = lds_perm_frag(rp + 64, 0, hf), fr3 = lds_perm_frag(rp + 64, 1, hf);
            const bf16x8 fg0 = *(const LAS bf16x8*)(S + CB_G + r * 64 + (8 * hf) * 2), fg1 = *(const LAS bf16x8*)(S + CB_G + r * 64 + (16 + 8 * hf) * 2);
            const LAS unsigned char* p0 = S + CB_PHI + r * 128; const LAS unsigned char* p1 = S + CB_PHI + (32 + r) * 128;
            const bf16x8 fa0 = lds_perm_frag(p0, 0, hf), fa1 = lds_perm_frag(p0, 1, hf), fa2 = lds_perm_frag(p0 + 64, 0, hf), fa3 = lds_perm_frag(p0 + 64, 1, hf);
            const bf16x8 fb0 = lds_perm_frag(p1, 0, hf), fb1 = lds_perm_frag(p1, 1, hf), fb2 = lds_perm_frag(p1 + 64, 0, hf), fb3 = lds_perm_frag(p1 + 64, 1, hf);
            const LAS unsigned char* q0 = S + CB_PSI + r * 64; const LAS unsigned char* q1 = S + CB_PSI + (32 + r) * 64;
            const bf16x8 fp0 = *(const LAS bf16x8*)(q0 + (8 * hf) * 2), fp1 = *(const LAS bf16x8*)(q0 + (16 + 8 * hf) * 2), fp2 = *(const LAS bf16x8*)(q1 + (8 * hf) * 2), fp3 = *(const LAS bf16x8*)(q1 + (16 + 8 * hf) * 2);
            const bf16x8 x00 = acc_frag(X0, 0), x01 = acc_frag(X0, 1), x10 = acc_frag(X1, 0), x11 = acc_frag(X1, 1);
            asm volatile("s_waitcnt lgkmcnt(0)" ::: "memory");
            __builtin_amdgcn_sched_barrier(0);
            f32x16 yc, n0, n1;
#pragma unroll
            for (int i = 0; i < 16; ++i) { yc[i] = 0.f; n0[i] = 0.f; n1[i] = 0.f; }
            n0 = __builtin_amdgcn_mfma_f32_32x32x16_bf16(fa0, x00, n0, 0, 0, 0);
            n1 = __builtin_amdgcn_mfma_f32_32x32x16_bf16(fb0, x00, n1, 0, 0, 0);
            yc = __builtin_amdgcn_mfma_f32_32x32x16_bf16(fr0, x00, yc, 0, 0, 0);
            n0 = __builtin_amdgcn_mfma_f32_32x32x16_bf16(fa1, x01, n0, 0, 0, 0);
            n1 = __builtin_amdgcn_mfma_f32_32x32x16_bf16(fb1, x01, n1, 0, 0, 0);
            yc = __builtin_amdgcn_mfma_f32_32x32x16_bf16(fr1, x01, yc, 0, 0, 0);
            n0 = __builtin_amdgcn_mfma_f32_32x32x16_bf16(fa2, x10, n0, 0, 0, 0);
            n1 = __builtin_amdgcn_mfma_f32_32x32x16_bf16(fb2, x10, n1, 0, 0, 0);
            yc = __builtin_amdgcn_mfma_f32_32x32x16_bf16(fr2, x10, yc, 0, 0, 0);
            n0 = __builtin_amdgcn_mfma_f32_32x32x16_bf16(fa3, x11, n0, 0, 0, 0);
            n1 = __builtin_amdgcn_mfma_f32_32x32x16_bf16(fb3, x11, n1, 0, 0, 0);
            yc = __builtin_amdgcn_mfma_f32_32x32x16_bf16(fr3, x11, yc, 0, 0, 0);
            n0 = __builtin_amdgcn_mfma_f32_32x32x16_bf16(fp0, vf0, n0, 0, 0, 0);
            n1 = __builtin_amdgcn_mfma_f32_32x32x16_bf16(fp2, vf0, n1, 0, 0, 0);
            yc = __builtin_amdgcn_mfma_f32_32x32x16_bf16(fg0, vf0, yc, 0, 0, 0);
            n0 = __builtin_amdgcn_mfma_f32_32x32x16_bf16(fp1, vf1, n0, 0, 0, 0);
            n1 = __builtin_amdgcn_mfma_f32_32x32x16_bf16(fp3, vf1, n1, 0, 0, 0);
            yc = __builtin_amdgcn_mfma_f32_32x32x16_bf16(fg1, vf1, yc, 0, 0, 0);
            X0 = n0; X1 = n1;
#pragma unroll
            for (int i = 0; i < 16; ++i) yb[(size_t)(c * 32 + (i & 3) + 8 * (i >> 2) + 4 * hf) * RWW] = yc[i];
        }
    }
    asm volatile("s_waitcnt vmcnt(0)" ::: "memory");
    __builtin_amdgcn_s_barrier();
#undef CS_ISSUE
}

__device__ __forceinline__ void st_rwout(const P& p, int l, int t, int lane) {
    float y[6], vv[6], gg[6], rk[6];
#pragma unroll
    for (int hh = 0; hh < 6; ++hh) {
        y[hh] = p.y[(size_t)t * RWW + hh * 64 + lane]; vv[hh] = bf2f(*(const bf16_t*)(p.rec + (size_t)t * REC_TB + hh * REC_HB + 768 + lane * 2)); gg[hh] = bf2f(p.g[(size_t)t * RWW + hh * 64 + lane]);
        rk[hh] = *(const float*)(p.rec + (size_t)t * REC_TB + hh * REC_HB + 896);
    }
#pragma unroll
    for (int hh = 0; hh < 6; ++hh) {
        const int c = hh * 64 + lane;
        const float mean = wave_sum(y[hh]) * (1.f / 64.f);
        const float d = y[hh] - mean;
        const float var = wave_sum(d * d) * (1.f / 64.f);
        const float yn = d * rsqrtf(var + 64e-5f) * p.rw_ln_g[l * RWW + c] + p.rw_ln_b[l * RWW + c];
        p.h[(size_t)t * D + c] = (bf16_t)f2bf((yn + rk[hh] * vv[hh]) * gg[hh]);
    }
}

typedef float f32x16 __attribute__((ext_vector_type(16)));
constexpr float ATT_EXIT = -60.f;
__device__ __forceinline__ float xhalf(float x, int lane) { return __builtin_bit_cast(float, __builtin_amdgcn_ds_bpermute((lane ^ 32) << 2, __builtin_bit_cast(int, x))); }
__device__ __forceinline__ void st_attn(const P& p, int l, int item) {
    const int lane = opaque(threadIdx.x) & 63;
    const int qt = item % (SEQ / 32), bh = item / (SEQ / 32), b = bh / 6, hh = bh % 6;
    const int r = lane & 31, hf = lane >> 5;
    const bf16_t* qkb = p.proj + (size_t)b * SEQ * PJB + RWC + hh * 64 + 8 * hf;
    const bf16_t* vtb = p.vt + ((size_t)(b * 6 + hh) * 64 + r) * SEQ + 4 * hf;
    bf16x8 qf[4];
    {
        const bf16_t* qp = qkb + (size_t)(qt * 32 + r) * PJB;
#pragma unroll
        for (int s = 0; s < 4; ++s) {
            u32x4 t4 = *(const u32x4*)(qp + 16 * s);
            unsigned w[4] = {t4.x, t4.y, t4.z, t4.w};
#pragma unroll
            for (int q = 0; q < 4; ++q) { const float lo = bflo(w[q]) * 0.125f, hi = bfhi(w[q]) * 0.125f; w[q] = (__builtin_bit_cast(unsigned, lo) >> 16) | (__builtin_bit_cast(unsigned, hi) & 0xffff0000u); }
            t4.x = w[0]; t4.y = w[1]; t4.z = w[2]; t4.w = w[3];
            qf[s] = __builtin_bit_cast(bf16x8, t4);
        }
    }
    f32x16 o0, o1;
#pragma unroll
    for (int i = 0; i < 16; ++i) { o0[i] = 0.f; o1[i] = 0.f; }
    float R = 0.f;
    bf16x8 kfn[4]; u32x2 vfn[2][2][2];
#define ATT_LOAD(KT) do { const int _k0 = (KT) * 32; const bf16_t* kp = qkb + SBW + (size_t)(_k0 + r) * PJB; \
        _Pragma("unroll") for (int s = 0; s < 4; ++s) kfn[s] = *(const bf16x8*)(kp + 16 * s); \
        _Pragma("unroll") for (int dt = 0; dt < 2; ++dt) _Pragma("unroll") for (int s = 0; s < 2; ++s) { const bf16_t* vp = vtb + (size_t)dt * 32 * SEQ + _k0 + 16 * s; vfn[dt][s][0] = *(const u32x2*)vp; vfn[dt][s][1] = *(const u32x2*)(vp + 8); } } while (0)
    ATT_LOAD(qt);
    for (int kt = qt; kt >= 0; --kt) {
        const int key0 = kt * 32; (void)key0;
        bf16x8 kf[4]; u32x2 vf[2][2][2];
#pragma unroll
        for (int s = 0; s < 4; ++s) kf[s] = kfn[s];
#pragma unroll
        for (int dt = 0; dt < 2; ++dt)
#pragma unroll
            for (int s = 0; s < 2; ++s) { vf[dt][s][0] = vfn[dt][s][0]; vf[dt][s][1] = vfn[dt][s][1]; }
        if (kt > 0) ATT_LOAD(kt - 1);
        f32x16 z;
#pragma unroll
        for (int i = 0; i < 16; ++i) z[i] = 0.f;
#pragma unroll
        for (int s = 0; s < 4; ++s) z = __builtin_amdgcn_mfma_f32_32x32x16_bf16(kf[s], qf[s], z, 0, 0, 0);
        const bool diag = (kt == qt);
        float c[16], gs[4];
#pragma unroll
        for (int gi = 0; gi < 4; ++gi) {
            float run = 0.f;
#pragma unroll
            for (int e = 3; e >= 0; --e) {
                const int reg = gi * 4 + e;
                const float zz = z[reg];
                float L = -(fmaxf(zz, 0.f) + __logf(1.f + __expf(-fabsf(zz))));
                if (diag && !(r > e + 8 * gi + 4 * hf)) L = 0.f;
                run += L; c[reg] = run;
            }
            gs[gi] = run;
        }
        float go[4], pp[4], ob[4], off[4];
#pragma unroll
        for (int gi = 0; gi < 4; ++gi) { go[gi] = xhalf(gs[gi], lane); pp[gi] = gs[gi] + go[gi]; }
        ob[3] = 0.f; ob[2] = pp[3]; ob[1] = pp[3] + pp[2]; ob[0] = ob[1] + pp[1];
#pragma unroll
        for (int gi = 0; gi < 4; ++gi) off[gi] = ob[gi] + (hf == 0 ? go[gi] : 0.f) + R;
        const float total = ob[0] + pp[0];
        unsigned af[8];
#pragma unroll
        for (int i = 0; i < 8; ++i) {
            float a2[2];
#pragma unroll
            for (int q = 0; q < 2; ++q) {
                const int reg = 2 * i + q, gi = reg >> 2, e = reg & 3;
                float a = __expf(z[reg] + c[reg] + off[gi]);
                if (diag && !(r > e + 8 * gi + 4 * hf)) a = 0.f;
                a2[q] = a;
            }
            af[i] = pk2(a2[0], a2[1]);
        }
        R += total;
        const bf16x8 a0 = __builtin_bit_cast(bf16x8, (u32x4){af[0], af[1], af[2], af[3]});
        const bf16x8 a1 = __builtin_bit_cast(bf16x8, (u32x4){af[4], af[5], af[6], af[7]});
        o0 = __builtin_amdgcn_mfma_f32_32x32x16_bf16(__builtin_bit_cast(bf16x8, (u32x4){vf[0][0][0].x, vf[0][0][0].y, vf[0][0][1].x, vf[0][0][1].y}), a0, o0, 0, 0, 0);
        o0 = __builtin_amdgcn_mfma_f32_32x32x16_bf16(__builtin_bit_cast(bf16x8, (u32x4){vf[0][1][0].x, vf[0][1][0].y, vf[0][1][1].x, vf[0][1][1].y}), a1, o0, 0, 0, 0);
        o1 = __builtin_amdgcn_mfma_f32_32x32x16_bf16(__builtin_bit_cast(bf16x8, (u32x4){vf[1][0][0].x, vf[1][0][0].y, vf[1][0][1].x, vf[1][0][1].y}), a0, o1, 0, 0, 0);
        o1 = __builtin_amdgcn_mfma_f32_32x32x16_bf16(__builtin_bit_cast(bf16x8, (u32x4){vf[1][1][0].x, vf[1][1][0].y, vf[1][1][1].x, vf[1][1][1].y}), a1, o1, 0, 0, 0);
        if (__all(R < ATT_EXIT)) break;
    }
#undef ATT_LOAD
    float ss = 0.f;
#pragma unroll
    for (int i = 0; i < 16; ++i) ss += o0[i] * o0[i] + o1[i] * o1[i];
    ss += xhalf(ss, lane);
    const float rs = rsqrtf(ss * (1.f / 64.f) + 1e-6f);
    bf16_t* op = p.h + ((size_t)b * SEQ + qt * 32 + r) * D + RWW + hh * 64 + 4 * hf;
    const float* gn = p.sb_norm_g + l * SBW + hh * 64 + 4 * hf;
#pragma unroll
    for (int gi = 0; gi < 4; ++gi) {
        const f32x4 g0 = *(const f32x4*)(gn + 8 * gi), g1 = *(const f32x4*)(gn + 32 + 8 * gi);
        u32x2 w0, w1;
        w0.x = pk2(o0[4 * gi] * rs * g0[0], o0[4 * gi + 1] * rs * g0[1]); w0.y = pk2(o0[4 * gi + 2] * rs * g0[2], o0[4 * gi + 3] * rs * g0[3]);
        w1.x = pk2(o1[4 * gi] * rs * g1[0], o1[4 * gi + 1] * rs * g1[1]); w1.y = pk2(o1[4 * gi + 2] * rs * g1[2], o1[4 * gi + 3] * rs * g1[3]);
        *(u32x2*)(op + 8 * gi) = w0; *(u32x2*)(op + 32 + 8 * gi) = w1;
    }
}

__device__ __forceinline__ void st_pool(const P& p, int l, int vb, LAS float* PL  ) {
    const int tid = opaque(threadIdx.x);
    const int t0 = vb * 32, s0 = t0 % SEQ;
    {
        const int col = tid & 255, th = tid >> 8, g = col >> 6, win = 2 << g;
        const int sA = s0 + th * 16;
        const bf16_t* u = p.proj + (size_t)(t0 + th * 16) * PJB + RWC + SBC + col;
        float xv[31];
#pragma unroll
        for (int i = 0; i < 31; ++i) { const int s = sA - 15 + i; xv[i] = (s >= 0 && (i >= 15 || 15 - i < win)) ? bf2f(u[(ptrdiff_t)(i - 15) * PJB]) : 0.f; }
        float run = 0.f;
#pragma unroll
        for (int i = 0; i < 15; ++i) run += (15 - i < win) ? xv[i] : 0.f;
#pragma unroll
        for (int j = 0; j < 16; ++j) {
            run += xv[15 + j];
            const int s = sA + j, n = min(s + 1, win);
            PL[(th * 16 + j) * 256 + col] = run / (float)n - xv[15 + j];
            float drop = 0.f;
#pragma unroll
            for (int q = 1; q <= 4; ++q) if (win == (1 << q)) drop = xv[15 + j - (1 << q) + 1];
            run -= drop;
        }
    }
    __syncthreads();
    {
        const int wave = tid >> 6, lane = tid & 63, g = wave & 3, th = wave >> 2;
        float acc[16];
#pragma unroll
        for (int j = 0; j < 16; ++j) acc[j] = 0.f;
        const float* pw = p.pool_w + ((size_t)l * 4 + g) * 64 * 64 + lane;
        for (int c = 0; c < 64; c += 4) {
            const float w0 = pw[c * 64], w1 = pw[(c + 1) * 64], w2 = pw[(c + 2) * 64], w3 = pw[(c + 3) * 64];
#pragma unroll
            for (int j = 0; j < 16; ++j) { const f32x4 x = *(const LAS f32x4*)(PL + (th * 16 + j) * 256 + g * 64 + c); acc[j] += x[0] * w0 + x[1] * w1 + x[2] * w2 + x[3] * w3; }
        }
        const float sc = p.pool_scale[l * PLW + g * 64 + lane];
#pragma unroll
        for (int j = 0; j < 16; ++j) p.h[(size_t)(t0 + th * 16 + j) * D + 768 + g * 64 + lane] = (bf16_t)f2bf(acc[j] * sc);
    }
    __syncthreads();
}

template <bool TOLDS>
__device__ __forceinline__ void norm_row(const float* xr, const float* md  , bf16_t* hrow, LAS float* hl, int lane) {
    f32x4 v[4]; float ss = 0.f;
#pragma unroll
    for (int i = 0; i < 4; ++i) { v[i] = *(const f32x4*)(xr + i * 256 + lane * 4); ss += v[i][0] * v[i][0] + v[i][1] * v[i][1] + v[i][2] * v[i][2] + v[i][3] * v[i][3]; }
    ss = wave_sum(ss);
    const float rs = rsqrtf(ss * (1.f / D) + 1e-6f);
#pragma unroll
    for (int i = 0; i < 4; ++i) {
        const int cidx = i * 256 + lane * 4;
        const f32x4 sh = *(const f32x4*)(md + cidx), sc = *(const f32x4*)(md + 1024 + cidx);
        const f32x4 o = v[i] * rs * (sc + 1.f) + sh;
        u32x2 w; w.x = pk2(o[0], o[1]); w.y = pk2(o[2], o[3]);
        *(u32x2*)(hrow + cidx) = w;
        if constexpr (TOLDS) *(LAS f32x4*)(hl + cidx) = o;
    }
}

__device__ __forceinline__ void st_normrouter(const P& p, int l, int vb0, int vbstride, LAS float* L  ) {
    const int tid = opaque(threadIdx.x), wave = tid >> 6, lane = tid & 63;
    LAS float* H = L; LAS float* PART = L + 16 * 1024; LAS float* SEL = PART + 8 * 16 * 64; LAS int* lcnt = (LAS int*)(SEL + 16 * 72);
    float WR[128];
    {
        const float* wr = p.w_router + ((size_t)l * D + wave * 128) * NE;
        const int ll = opaque(lane);
#pragma unroll
        for (int k = 0; k < 128; ++k) WR[k] = wr[k * NE + ll];
    }
    const float brt = p.b_router[l * NE + lane];
    for (int vb = vb0; vb < T / 16; vb += vbstride) {
        const int t0 = vb * 16, b = t0 / SEQ;
        const float* md = p.mod + ((size_t)l * 8 + b) * 6144 + 3072;
        if (tid < 64) lcnt[tid] = 0;
        unsigned pfv = 0u;
        if (vb + vbstride < T / 16) pfv = pf_lines(p.xb + (size_t)((vb + vbstride) * 16 + wave * 2) * D, 2 * D * 4, lane);
#pragma unroll
        for (int q = 0; q < 2; ++q) { const int tt = wave * 2 + q; norm_row<true>(p.xb + (size_t)(t0 + tt) * D, md, p.h + (size_t)(t0 + tt) * D, H + tt * 1024, lane); }
        __syncthreads();
        {
            float acc[16];
#pragma unroll
            for (int j = 0; j < 16; ++j) acc[j] = 0.f;
#pragma unroll
            for (int k = 0; k < 128; k += 4) {
#pragma unroll
                for (int j = 0; j < 16; ++j) { const f32x4 x = *(const LAS f32x4*)(H + j * 1024 + wave * 128 + k); acc[j] += x[0] * WR[k] + x[1] * WR[k + 1] + x[2] * WR[k + 2] + x[3] * WR[k + 3]; }
            }
#pragma unroll
            for (int j = 0; j < 16; ++j) PART[(wave * 16 + j) * 64 + lane] = acc[j];
        }
        __syncthreads();
#pragma unroll
        for (int q = 0; q < 2; ++q) {
            const int tt = wave * 2 + q, t = t0 + tt;
            float logit = 0.f;
#pragma unroll
            for (int w = 0; w < 8; ++w) logit += PART[(w * 16 + tt) * 64 + lane];
            float score = sigmoidf_(logit);
            score = (score == score) ? score : 0.f;
            const float sl = score + brt;
            LAS float* sel = SEL + (wave * 2 + q) * 72; LAS float* gs = sel + 64;
            sel[lane] = sl;
            if (lane < 8) {
                float m1 = -INFINITY, m2 = -INFINITY;
                for (int i = 0; i < 8; ++i) { const float v = sel[lane * 8 + i]; if (v > m1) { m2 = m1; m1 = v; } else if (v > m2) m2 = v; }
                gs[lane] = m1 + m2;
            }
            const int gI = lane >> 3;
            int grank = 0;
            for (int i = 0; i < 8; ++i) { const float v = gs[i]; grank += (v > gs[gI] || (v == gs[gI] && i < gI)) ? 1 : 0; }
            const float msk = (grank < 4) ? sl : -INFINITY;
            sel[lane] = msk;
            int rank = 0;
            for (int i = 0; i < 64; ++i) { const float v = sel[i]; rank += (v > msk || (v == msk && i < lane)) ? 1 : 0; }
            const bool chosen = rank < TOPK;
            const float wsum = wave_sum(chosen ? score : 0.f);
            if (chosen) {
                const int pos = __hip_atomic_fetch_add(&lcnt[lane], 1, __ATOMIC_RELAXED, __HIP_MEMORY_SCOPE_WORKGROUP);
                p.seg[((size_t)lane * 1024 + vb) * 16 + pos] = t * TOPK + rank;
                p.topw[(size_t)t * TOPK + rank] = score / (wsum + 1e-20f) * 2.5f;
            }
        }
        __syncthreads();
        if (tid < 64) p.cnt2[tid * 1024 + vb] = lcnt[tid];
        pf_done(pfv);
        __syncthreads();
    }
}

__device__ __forceinline__ void st_compact(const P& p, int e, LAS int* wt  ) {
    const int tid = opaque(threadIdx.x), wave = tid >> 6, lane = tid & 63;
    const int c0 = p.cnt2[e * 1024 + 2 * tid], c1 = p.cnt2[e * 1024 + 2 * tid + 1], s = c0 + c1;
    int incl = s;
#pragma unroll
    for (int o = 1; o < 64; o <<= 1) { const int v = __builtin_amdgcn_ds_bpermute(((lane - o) & 63) << 2, incl); if (lane >= o) incl += v; }
    if (lane == 63) wt[wave] = incl;
    __syncthreads();
    int base = 0;
    for (int w = 0; w < wave; ++w) base += wt[w];
    const int excl = base + incl - s;
    int* dst = p.list + (size_t)e * T + excl;
    const int* s0 = p.seg + ((size_t)e * 1024 + 2 * tid) * 16;
    for (int j = 0; j < c0; ++j) dst[j] = s0[j];
    for (int j = 0; j < c1; ++j) dst[c0 + j] = s0[16 + j];
    if (tid == NTHREADS - 1) p.cnt[e] = base + incl;
    __syncthreads();
}

__device__ __forceinline__ void st_combine(const P& p, int l, int t, int lane) {
    const int b = t / SEQ;
    const float* gt = p.mod + ((size_t)l * 8 + b) * 6144 + 5120;
    const bf16_t* sl = p.slab + (size_t)t * TOPK * D;
    float* xr = p.xb + (size_t)t * D;
    float xv[16]; float ss = 0.f;
#pragma unroll
    for (int i = 0; i < 2; ++i) {
        const int cidx = i * 512 + lane * 8;
        float f[8];
#pragma unroll
        for (int j = 0; j < 8; ++j) f[j] = 0.f;
#pragma unroll
        for (int s = 0; s < TOPK; ++s) {
            const u32x4 q = *(const u32x4*)(sl + (size_t)s * D + cidx);
            f[0] += bflo(q.x); f[1] += bfhi(q.x); f[2] += bflo(q.y); f[3] += bfhi(q.y); f[4] += bflo(q.z); f[5] += bfhi(q.z); f[6] += bflo(q.w); f[7] += bfhi(q.w);
        }
        const f32x4 x0 = *(const f32x4*)(xr + cidx), x1 = *(const f32x4*)(xr + cidx + 4);
        const f32x4 g0 = *(const f32x4*)(gt + cidx), g1 = *(const f32x4*)(gt + cidx + 4);
#pragma unroll
        for (int j = 0; j < 4; ++j) { xv[i * 8 + j] = x0[j] + g0[j] * f[j]; xv[i * 8 + 4 + j] = x1[j] + g1[j] * f[4 + j]; }
#pragma unroll
        for (int j = 0; j < 8; ++j) ss += xv[i * 8 + j] * xv[i * 8 + j];
    }
    ss = wave_sum(ss);
    const float rs = rsqrtf(ss * (1.f / D) + 1e-6f);
    if (l + 1 < NL) {
        const float* md = p.mod + ((size_t)(l + 1) * 8 + b) * 6144;
#pragma unroll
        for (int i = 0; i < 2; ++i) {
            const int cidx = i * 512 + lane * 8;
            *(f32x4*)(xr + cidx) = (f32x4){xv[i * 8], xv[i * 8 + 1], xv[i * 8 + 2], xv[i * 8 + 3]};
            *(f32x4*)(xr + cidx + 4) = (f32x4){xv[i * 8 + 4], xv[i * 8 + 5], xv[i * 8 + 6], xv[i * 8 + 7]};
            float o[8];
#pragma unroll
            for (int j = 0; j < 8; ++j) o[j] = xv[i * 8 + j] * rs * (1.f + md[1024 + cidx + j]) + md[cidx + j];
            u32x4 w; w.x = pk2(o[0], o[1]); w.y = pk2(o[2], o[3]); w.z = pk2(o[4], o[5]); w.w = pk2(o[6], o[7]);
            *(u32x4*)(p.h + (size_t)t * D + cidx) = w;
        }
    } else {
#pragma unroll
        for (int i = 0; i < 2; ++i) {
            const int cidx = i * 512 + lane * 8;
            const f32x4 g0 = *(const f32x4*)(p.g_final + cidx), g1 = *(const f32x4*)(p.g_final + cidx + 4);
            *(f32x4*)(p.out + (size_t)t * D + cidx) = (f32x4){xv[i * 8] * rs * g0[0], xv[i * 8 + 1] * rs * g0[1], xv[i * 8 + 2] * rs * g0[2], xv[i * 8 + 3] * rs * g0[3]};
            *(f32x4*)(p.out + (size_t)t * D + cidx + 4) = (f32x4){xv[i * 8 + 4] * rs * g1[0], xv[i * 8 + 5] * rs * g1[1], xv[i * 8 + 6] * rs * g1[2], xv[i * 8 + 7] * rs * g1[3]};
        }
    }
}

struct CvtJob { const float* W; bf16_t* WT; int K, N, k0, n0, dst_row0; };
__device__ __forceinline__ void cvt_load(const CvtJob& j, float (&wv)[32], int lane) {
#pragma unroll
    for (int i = 0; i < 32; ++i) wv[i] = j.W[(size_t)(j.k0 + 2 * i + (lane >> 5)) * j.N + j.n0 + (lane & 31)];
}
__device__ __forceinline__ void cvt_store(const CvtJob& j, const float (&wv)[32], LAS float* scr, int lane) {
#pragma unroll
    for (int i = 0; i < 32; ++i) scr[(2 * i + (lane >> 5)) * 33 + (lane & 31)] = wv[i];
    asm volatile("s_waitcnt lgkmcnt(0)" ::: "memory");
    const int c = lane & 7;
#pragma unroll
    for (int q = 0; q < 4; ++q) { const int n = (lane >> 3) + 8 * q; const LAS float* sp = scr + (8 * c) * 33 + n;
        u32x4 o; o.x = pk2(sp[0 * 33], sp[1 * 33]); o.y = pk2(sp[2 * 33], sp[3 * 33]); o.z = pk2(sp[4 * 33], sp[5 * 33]); o.w = pk2(sp[6 * 33], sp[7 * 33]);
        *(u32x4*)(j.WT + (size_t)(j.dst_row0 + n) * j.K + j.k0 + 8 * c) = o; }
    asm volatile("s_waitcnt lgkmcnt(0)" ::: "memory");
}
__device__ __forceinline__ void cvt_item(const float* W, int K, int N, int k0, int n0, bf16_t* WT, int dst_row0, LAS float* scr, int lane) {
    const CvtJob j{W, WT, K, N, k0, n0, dst_row0};
    float wv[32];
    cvt_load(j, wv, lane);
    cvt_store(j, wv, scr, lane);
}
constexpr int CV_IN = 16 * 84, CV_VR = 16, CV_OUT = 16 * 32, CV_DENSE_L = CV_IN + CV_VR + CV_OUT, CV_DENSE = NL * CV_DENSE_L;
__device__ __forceinline__ void cvt_dense_item(const P& p, int it, LAS float* scr, int lane) {
    const int l = it / CV_DENSE_L; int r = it % CV_DENSE_L;
    bf16_t* wti = p.wt_in + (size_t)l * PJB * D;
    if (r < CV_IN) { const int kb = r / 84, nb = r % 84; cvt_item(p.w_in + (size_t)l * D * INC, D, INC, kb * 64, nb * 32, wti, nb * 32, scr, lane); return; }
    r -= CV_IN;
    if (r < CV_VR) {
        if (l == 1) cvt_item(p.w_vres, D, 32, r * 64, 0, wti, INC, scr, lane);
        const int rz0 = (l == 1) ? INC + 32 : INC;
        for (int row = rz0 + (lane >> 3); row < PJB; row += 8) *(u32x4*)(wti + (size_t)row * D + r * 64 + (lane & 7) * 8) = (u32x4){0u, 0u, 0u, 0u};
        return;
    }
    r -= CV_VR;
    { const int kb = r / 32, nb = r % 32; cvt_item(p.w_out + (size_t)l * D * D, D, D, kb * 64, nb * 32, p.wt_out + (size_t)l * D * D, nb * 32, scr, lane); }
}
constexpr int CV_EXP_E = 128 + 128 + 128, CV_EXP = 65 * CV_EXP_E;
__device__ __forceinline__ CvtJob cvt_exp_job(const P& p, int l, int it) {
    const int e = it / CV_EXP_E; int r = it % CV_EXP_E;
    if (r < 256) {
        const int which = r >> 7; r &= 127; const int kb = r >> 3, nb = r & 7;
        const float* W = e < NE ? (which ? p.w_eu : p.w_eg) + ((size_t)l * NE + e) * D * ED : (which ? p.w_su : p.w_sg) + (size_t)l * D * ED;
        const int n0 = nb * 32, pn = n0 >> 7;
        return CvtJob{W, p.wt1 + (size_t)e * 512 * D, D, ED, kb * 64, n0, pn * 256 + which * 128 + (n0 & 127)};
    } else {
        r -= 256; const int kb = r >> 5, nb = r & 31;
        const float* W = e < NE ? p.w_ed + ((size_t)l * NE + e) * ED * D : p.w_sd + (size_t)l * ED * D;
        return CvtJob{W, p.wt2 + (size_t)e * D * ED, ED, D, kb * 64, nb * 32, nb * 32};
    }
}
__device__ __forceinline__ void cvt_exp_stream(const P& p, int l, int first, int stride, LAS float* scr, int lane) {
    if (first >= CV_EXP) return;
    float wa[32], wb[32];
    CvtJob ja = cvt_exp_job(p, l, first), jb = ja;
    cvt_load(ja, wa, lane);
    for (int it = first; it < CV_EXP; it += 2 * stride) {
        const bool hb = it + stride < CV_EXP;
        if (hb) { jb = cvt_exp_job(p, l, it + stride); cvt_load(jb, wb, lane); }
        cvt_store(ja, wa, scr, lane);
        if (!hb) break;
        const bool ha = it + 2 * stride < CV_EXP;
        if (ha) { ja = cvt_exp_job(p, l, it + 2 * stride); cvt_load(ja, wa, lane); }
        cvt_store(jb, wb, scr, lane);
        if (!ha) break;
    }
}

#define XB_TMO      128
#define XB_XCNT(j)  (256  + 64 * (j))
#define XB_XSUB(j)  (1280 + 64 * (j))
#define XB_XGEN(j)  (2304 + 64 * (j))
#define XB_TOP      3328
#define XB_TOPGEN   3392
#define XCD_BAR_WORDS 3456
#define XB_SPIN_CAP (1u << 22)
__device__ __forceinline__ unsigned xb_ld(unsigned* p)              { return __hip_atomic_load(p, __ATOMIC_RELAXED, __HIP_MEMORY_SCOPE_AGENT); }
__device__ __forceinline__ unsigned xb_add(unsigned* p, unsigned v) { return __hip_atomic_fetch_add(p, v, __ATOMIC_RELAXED, __HIP_MEMORY_SCOPE_AGENT); }
__device__ __forceinline__ unsigned xb_xcc_id() { return (unsigned)__builtin_amdgcn_s_getreg((3 << 11) | 20) & 0xFu; }
#define XB_SPIN(cond, bar) do { unsigned _sp = 0; while (cond) { __builtin_amdgcn_s_sleep(1); \
    if ((++_sp & 255u) == 0u) { if (xb_ld(&(bar)[XB_TMO])) break; if (_sp > XB_SPIN_CAP) { atomicAdd(&(bar)[XB_TMO], 1u); break; } } } } while (0)
struct XcdBarrier { unsigned* bar; unsigned x; volatile LAS unsigned* st; };
__device__ __forceinline__ XcdBarrier xcd_barrier_post(unsigned* bar, volatile LAS unsigned* st) {
    XcdBarrier b; b.bar = bar; b.x = xb_xcc_id(); b.st = st;
    if (threadIdx.x == 0) (void)xb_add(&bar[XB_XCNT(b.x)], 1u);
    return b;
}
__device__ __forceinline__ void xcd_barrier_complete(unsigned* bar, unsigned x, unsigned& nloc, unsigned& nx) {
    const unsigned G = gridDim.x * gridDim.y * gridDim.z;
    unsigned sum, cnt, mine, sp = 0u;
    for (;;) {
        sum = 0u; cnt = 0u; mine = 0u;
#pragma unroll
        for (unsigned j = 0; j < 16; ++j) { const unsigned c = xb_ld(&bar[XB_XCNT(j)]); sum += c; cnt += (c > 0u) ? 1u : 0u; mine = (j == x) ? c : mine; }
        if (sum == G) break;
        __builtin_amdgcn_s_sleep(1);
        if ((++sp & 255u) == 0u) { if (xb_ld(&bar[XB_TMO])) break; if (sp > XB_SPIN_CAP) { atomicAdd(&bar[XB_TMO], 1u); break; } }
    }
    nloc = mine > 0u ? mine : 1u; nx = cnt > 0u ? cnt : 1u;
}
__device__ __forceinline__ void xcd_barrier(const XcdBarrier& b0) {
    XcdBarrier b = b0; { unsigned xx = b0.x; asm volatile("" : "+s"(xx)); b.x = xx; }
    asm volatile("s_waitcnt vmcnt(0)" ::: "memory");
    __syncthreads();
    if (threadIdx.x == 0) {
        unsigned* bar = b.bar;
        __builtin_amdgcn_s_waitcnt(0);
        unsigned nloc = b.st[0], nx = b.st[1];
        if (nloc == 0u) { xcd_barrier_complete(bar, b.x, nloc, nx); b.st[0] = nloc; b.st[1] = nx; }
        const unsigned old = xb_add(&bar[XB_XSUB(b.x)], 1u);
        const unsigned gen = old / nloc;
        if (old + 1u == (gen + 1u) * nloc) {
            __builtin_amdgcn_fence(__ATOMIC_RELEASE, "agent");
            asm volatile("s_waitcnt vmcnt(0)" ::: "memory");
            const unsigned og = xb_add(&bar[XB_TOP], 1u);
            const unsigned tg = og / nx;
            if (og + 1u == (tg + 1u) * nx) xb_add(&bar[XB_TOPGEN], 1u);
            else XB_SPIN(xb_ld(&bar[XB_TOPGEN]) == tg, bar);
            __builtin_amdgcn_fence(__ATOMIC_ACQUIRE, "agent");
            xb_add(&bar[XB_XGEN(b.x)], 1u);
            asm volatile("s_waitcnt vmcnt(0)" ::: "memory");
        } else {
            XB_SPIN(xb_ld(&bar[XB_XGEN(b.x)]) == gen, bar);
            __builtin_amdgcn_fence(__ATOMIC_ACQUIRE, "agent");
            asm volatile("s_waitcnt vmcnt(0)" ::: "memory");
        }
    }
    __syncthreads();
}

__device__ __forceinline__ P load_args() {
    P q{};
#if defined(__HIP_DEVICE_COMPILE__)
    const __attribute__((address_space(4))) unsigned long long* k = (const __attribute__((address_space(4))) unsigned long long*)__builtin_amdgcn_kernarg_segment_ptr();
    asm volatile("" : "+s"(k));
    unsigned long long w[sizeof(P) / 8];
#pragma unroll
    for (unsigned i = 0; i < sizeof(P) / 8; ++i) w[i] = k[i];
    __builtin_memcpy(&q, w, sizeof(P));
#endif
    return q;
}
enum Ph { PH_NORM1 = 0, PH_INPROJ, PH_PREP, PH_CPRE, PH_MIX, PH_RWOUT, PH_OUTPROJ, PH_ROUTER, PH_COMPACT, PH_EXP1, PH_EXP2, PH_COMBINE, PH_PER_LAYER };

__global__ void __launch_bounds__(NTHREADS, 2) k_fused(P p_arg) {
    (void)p_arg;
#define KARGS() load_args()
    extern __shared__ __attribute__((aligned(16))) unsigned char lds_raw[];
    LAS unsigned char* lds = (LAS unsigned char*)lds_raw;
    LAS int* tstart = (LAS int*)(lds + LDS_STAGE);
    LAS int* cnts = (LAS int*)(lds + LDS_STAGE + 272);
    volatile LAS unsigned* bst = (volatile LAS unsigned*)(lds + LDS_STAGE + 1008);
    if (threadIdx.x < 4) bst[threadIdx.x] = 0u;
    __syncthreads();
    XcdBarrier xb = xcd_barrier_post(load_args().bar, bst);
#define PHASE_COORDS() int G = gridDim.x, bx = blockIdx.x; asm volatile("" : "+s"(G), "+s"(bx)); const int vcu = (G % 8 == 0) ? (bx % 8) * (G / 8) + bx / 8 : bx; (void)vcu; \
    const int tid = opaque(threadIdx.x), half = tid >> 8, lane = tid & 63, wave = __builtin_amdgcn_readfirstlane(tid >> 6); \
    float* smem = (float*)lds_raw + half * 8192; LAS float* scr = (LAS float*)(lds + wave * 16384); (void)lane; (void)smem; (void)scr; (void)tid

    for (int rep = 0; rep < (REP_PH == -1 ? REP_N : 1); ++rep) {
        const P p = KARGS();
        PHASE_COORDS();
        for (int it = bx; it < NL * 96; it += G) st_mod(p, it, (LAS float*)lds);
        __syncthreads();
        for (int it = (bx * 8 + wave); it < CV_DENSE; it += G * 8) cvt_dense_item(p, it, scr, lane);
        xcd_barrier(xb);
    }

    constexpr int NPH2 = NL * PH_PER_LAYER + ((REP_PH >= 0) ? REP_N - 1 : 0);
    for (int ph2 = 0; ph2 < NPH2; ++ph2) {
      {
        const int ph = (REP_PH < 0 || ph2 <= REP_PH) ? ph2 : (ph2 < REP_PH + REP_N ? REP_PH : ph2 - (REP_N - 1));
        const int rep = (REP_PH >= 0 && ph2 > REP_PH && ph2 < REP_PH + REP_N) ? 1 : 0; (void)rep;
        const int l = ph / PH_PER_LAYER, st = ph % PH_PER_LAYER;
        const P p = KARGS();
        PHASE_COORDS();
        if (st == PH_NORM1) {
            if (l == 0) {
                for (int t = bx * 8 + wave; t < T; t += G * 8) {
                    const int tn = t + G * 8; unsigned pfv = 0u;
                    if (tn < T) pfv = pf_lines(p.x + (size_t)tn * D, D * 4, lane);
                    norm_row<false>(p.x + (size_t)t * D, p.mod + (size_t)(t / SEQ) * 6144, p.h + (size_t)t * D, (LAS float*)lds, lane);
                    pf_done(pfv);
                }
            }
        } else if (st == PH_INPROJ) {
            pg8::DenseOrder S; S.init(p.h, p.wt_in + (size_t)l * PJB * D, T, PJB, D, G, bx);
            pg8::EpiProj E{p.proj, p.vt};
            pg8::gemm_phase<pg8::EpiProj, pg8::DenseOrder, true, true>(lds, D, S, E);
        } else if (st == PH_PREP) {
            st_prep(p, l, bx, G, (LAS float*)lds);
        } else if (st == PH_CPRE) {
            if (wave < CP_WAVES) for (int it = bx * CP_WAVES + wave; it < NBATCH * 6 * (SEQ / 32); it += G * CP_WAVES) st_cpre(p, it, lds + wave * CP_LDS, lane);
        } else if (st == PH_MIX) {
            constexpr int N1 = NBATCH * 6, N2 = NBATCH * 6 * (SEQ / 32) / 8, N3 = T / 32, N4 = (CV_EXP + 7) / 8;
            const int sel = (rep == 0) ? 15 : REP_SEL;
            if (sel & 1) for (int wb = bx; wb < N1; wb += G) st_cscan(p, wb, lds);
            __syncthreads();
            for (int wb = bx; wb < N2 + N3; wb += G) {
                if (wb < N2) { if (sel & 2) st_attn(p, l, wb * 8 + wave); }
                else if (sel & 4) st_pool(p, l, wb - N2, (LAS float*)lds);
            }
            (void)N4;
            if (sel & 8) cvt_exp_stream(p, l, bx * 8 + wave, G * 8, scr, lane);
        } else if (st == PH_RWOUT) {
            for (int t = bx * 8 + wave; t < T; t += G * 8) {
                const int tn = t + G * 8; unsigned pfv = 0u;
                if (tn < T) pfv = pf_lines(p.y + (size_t)tn * RWW, RWW * 4, lane) + pf_lines(p.rec + (size_t)tn * REC_TB, REC_TB, lane) + pf_lines(p.g + (size_t)tn * RWW, RWW * 2, lane);
                st_rwout(p, l, t, lane);
                pf_done(pfv);
            }
        } else if (st == PH_OUTPROJ) {
            pg8::DenseOrder S; S.init(p.h, p.wt_out + (size_t)l * D * D, T, D, D, G, bx);
            pg8::EpiOut E{l == 0 ? p.x : p.xb, p.xb, p.mod + (size_t)l * 8 * 6144 + 2048};
            pg8::gemm_phase<pg8::EpiOut, pg8::DenseOrder, true, true>(lds, D, S, E);
        } else if (st == PH_ROUTER) {
            st_normrouter(p, l, bx, G, (LAS float*)lds);
        } else if (st == PH_COMPACT) {
            if (bx < NE) st_compact(p, bx, (LAS int*)lds);
        } else if (st == PH_EXP1 || st == PH_EXP2) {
            __syncthreads();
            if (tid == 0) {
                int acc = 0;
                for (int e = 0; e < 65; ++e) { const int c = e < NE ? p.cnt[e] : T; cnts[e] = c; tstart[e] = acc; acc += (c + 255) >> 8; }
                tstart[65] = acc;
            }
            __syncthreads();
            if (st == PH_EXP1) {
                pg8::MoeOrder<true> S{tstart, cnts, p.list, p.h, p.wt1, D, 512, 1, G, vcu};
                pg8::EpiExp1 E{p.hm};
                pg8::gemm_phase<pg8::EpiExp1, pg8::MoeOrder<true>, true, true>(lds, D, S, E);
            } else {
                pg8::MoeOrder<false> S{tstart, cnts, p.list, p.hm, p.wt2, ED, D, 2, G, vcu};
                pg8::EpiExp2 E{p.slab, p.xb, p.mod + (size_t)l * 8 * 6144 + 5120, p.list, p.topw, cnts, rep};
                pg8::gemm_phase<pg8::EpiExp2, pg8::MoeOrder<false>, true, true>(lds, ED, S, E);
            }
        } else {
            for (int t = bx * 8 + wave; t < T; t += G * 8) {
                const int tn = t + G * 8; unsigned pfv = 0u;
                if (tn < T) pfv = pf_lines(p.slab + (size_t)tn * TOPK * D, TOPK * D * 2, lane) + pf_lines(p.xb + (size_t)tn * D, D * 4, lane);
                st_combine(p, l, t, lane);
                pf_done(pfv);
            }
        }
        if (!(ph2 == NPH2 - 1)) { if (!(st == PH_NORM1 && l > 0)) xcd_barrier(xb); }
      }
    }
#undef PHASE_COORDS
#undef KARGS
}

}

extern "C" void kernel_launch(void* const* d_in, const int* in_sizes, int n_in, void* d_out, int out_size, void* d_ws, size_t ws_size,
                              hipStream_t stream) {
    P p{};
    const float** fp = (const float**)&p;
    for (int i = 0; i < 33; ++i) fp[i] = (const float*)d_in[i];
    p.out = (float*)d_out;
    char* ws = (char*)d_ws;
    size_t off = 0;
    auto take = [&](size_t bytes) { char* r = ws + off; off += (bytes + 255) & ~(size_t)255; return r; };
    p.bar = (unsigned*)take(16384);
    p.cnt = (int*)take(256);
    p.mod = (float*)take((size_t)NL * 8 * 6144 * 4);
    p.list = (int*)take((size_t)NE * T * 4);
    p.cnt2 = (int*)take((size_t)NE * 1024 * 4);
    p.seg = (int*)take((size_t)NE * 1024 * 16 * 4);
    p.topw = (float*)take((size_t)T * TOPK * 4);
    p.wt_in = (bf16_t*)take((size_t)NL * PJB * D * 2);
    p.wt_out = (bf16_t*)take((size_t)NL * D * D * 2);
    p.wt1 = (bf16_t*)take((size_t)65 * 512 * D * 2);
    p.wt2 = (bf16_t*)take((size_t)65 * D * ED * 2);
    p.xb = (float*)take((size_t)T * D * 4);
    p.h = (bf16_t*)take((size_t)T * D * 2);
    p.vfirst = (bf16_t*)take((size_t)T * RWW * 2);
    const size_t ov = off;
    p.proj = (bf16_t*)take((size_t)T * PJB * 2);
    p.vt = (bf16_t*)take((size_t)T * SBW * 2);
    p.rec = (unsigned char*)take((size_t)T * REC_TB);
    p.g = (bf16_t*)take((size_t)T * RWW * 2);
    p.y = (float*)take((size_t)T * RWW * 4);
    p.cb = (unsigned char*)take((size_t)NBATCH * 6 * (SEQ / 32) * CB_BYTES);
    p.hm = (bf16_t*)(ws + ov);
    p.slab = (bf16_t*)(ws + ov + (size_t)MAXRT * 256 * ED * 2);
    const size_t end_moe = ov + (size_t)MAXRT * 256 * ED * 2 + (size_t)T * TOPK * D * 2;
    if (end_moe > off) off = end_moe;
    if (off > ws_size) { fprintf(stderr, "kernel_launch: workspace too small: need %zu, have %zu\n", off, ws_size); return; }

    static int cus = 0;
    if (cus == 0) {
        int dev = 0, n = 0;
        if (hipGetDevice(&dev) != hipSuccess || hipDeviceGetAttribute(&n, hipDeviceAttributeMultiprocessorCount, dev) != hipSuccess || n <= 0) n = 256;
        (void)hipFuncSetAttribute((const void*)k_fused, hipFuncAttributeMaxDynamicSharedMemorySize, LDS_BYTES);
        cus = n;
    }
    (void)hipMemsetAsync(p.bar, 0, 16384 + 256, stream);
    void* args[] = {(void*)&p};
    (void)hipLaunchCooperativeKernel((const void*)k_fused, dim3(cus), dim3(NTHREADS), args, LDS_BYTES, stream);
}
```

```cpp
#include <hip/hip_runtime.h>
#include <stdint.h>
#include <stdio.h>

#define REP_PH -2
#define REP_N 1
#define REP_SEL 15

namespace {

typedef unsigned short bf16_t;
typedef short bf16x8 __attribute__((ext_vector_type(8)));
typedef float f32x4 __attribute__((ext_vector_type(4)));
typedef float f32x2 __attribute__((ext_vector_type(2)));
typedef unsigned u32x4 __attribute__((ext_vector_type(4)));
typedef unsigned u32x2 __attribute__((ext_vector_type(2)));
#define LAS __attribute__((address_space(3)))

constexpr int D = 1024, NBATCH = 8, SEQ = 2048, T = NBATCH * SEQ, NL = 2;
constexpr int RWW = 384, SBW = 384, PLW = 256;
constexpr int RWC = 1280, SBC = 1152, INC = 2688;
constexpr int PJB = 2816;
constexpr int NE = 64, TOPK = 6, ED = 256;
constexpr int MAXRT = 512;
constexpr int NTHREADS = 512;
constexpr int LDS_STAGE = 131072, LDS_CTL = 1024, LDS_BYTES = LDS_STAGE + LDS_CTL;

struct P {
    const float *x, *c, *w_ada, *b_ada, *w_in, *w_vres, *mu_rw, *mu_vres, *rw_w0, *rw_w2, *rw_a0, *rw_a2,
        *rw_v0, *rw_v2, *rw_g2, *rw_k_k, *rw_k_a, *rw_r_k, *rw_ln_g, *rw_ln_b, *sb_norm_g, *pool_w, *pool_scale,
        *w_out, *w_router, *b_router, *w_eg, *w_eu, *w_ed, *w_sg, *w_su, *w_sd, *g_final;
    float* out;
    unsigned* bar;
    float* mod;
    int* cnt;
    int* list;
    int* cnt2;
    int* seg;
    float* topw;
    bf16_t* wt_in;
    bf16_t* wt_out;
    bf16_t* wt1;
    bf16_t* wt2;
    float* xb;
    bf16_t* h;
    bf16_t* vfirst;
    bf16_t* proj;
    bf16_t* vt;
    unsigned char* rec;
    unsigned char* cb;
    bf16_t* g;
    float* y;
    bf16_t* hm;
    bf16_t* slab;
};

__device__ __forceinline__ int opaque(int x) { asm volatile("" : "+v"(x)); return x; }
__device__ __forceinline__ float dpp_add16(float x) {
    x += __builtin_bit_cast(float, __builtin_amdgcn_update_dpp(0, __builtin_bit_cast(int, x), 0xB1, 0xF, 0xF, true));
    x += __builtin_bit_cast(float, __builtin_amdgcn_update_dpp(0, __builtin_bit_cast(int, x), 0x4E, 0xF, 0xF, true));
    x += __builtin_bit_cast(float, __builtin_amdgcn_update_dpp(0, __builtin_bit_cast(int, x), 0x141, 0xF, 0xF, true));
    x += __builtin_bit_cast(float, __builtin_amdgcn_update_dpp(0, __builtin_bit_cast(int, x), 0x140, 0xF, 0xF, true));
    return x;
}
__device__ __forceinline__ float wave_sum(float v) {
    v = dpp_add16(v);
    const int vi = __builtin_bit_cast(int, v);
    return (__builtin_bit_cast(float, __builtin_amdgcn_readlane(vi, 0)) + __builtin_bit_cast(float, __builtin_amdgcn_readlane(vi, 16)))
         + (__builtin_bit_cast(float, __builtin_amdgcn_readlane(vi, 32)) + __builtin_bit_cast(float, __builtin_amdgcn_readlane(vi, 48)));
}
typedef __bf16 bf16x2_t __attribute__((ext_vector_type(2)));
__device__ __forceinline__ unsigned cvtpk(float lo, float hi) { const f32x2 v = {lo, hi}; const bf16x2_t b = __builtin_convertvector(v, bf16x2_t); return __builtin_bit_cast(unsigned, b); }
__device__ __forceinline__ bf16x8 mk8(unsigned a, unsigned b, unsigned c, unsigned d) { return __builtin_bit_cast(bf16x8, (u32x4){a, b, c, d}); }
__device__ __forceinline__ unsigned pf_lines(const void* p, int nbytes, int lane) {
    unsigned acc = 0u;
    for (int off = lane * 128; off < nbytes; off += 8192) acc += *(const unsigned*)((const char*)p + off);
    return acc;
}
__device__ __forceinline__ void pf_done(unsigned v) { asm volatile("" :: "v"(v)); }
__device__ __forceinline__ float sigmoidf_(float x) { return 1.f / (1.f + __expf(-x)); }
__device__ __forceinline__ float softplusf_(float x) { return fmaxf(x, 0.f) + __logf(1.f + __expf(-fabsf(x))); }
__device__ __forceinline__ float siluf_(float x) { return x / (1.f + __expf(-x)); }
__device__ __forceinline__ unsigned f2bf(float f) { unsigned u = __builtin_bit_cast(unsigned, f); return (u + 0x7fffu + ((u >> 16) & 1u)) >> 16; }
__device__ __forceinline__ unsigned pk2(float lo, float hi) { return f2bf(lo) | (f2bf(hi) << 16); }
__device__ __forceinline__ float bf2f(bf16_t h) { return __builtin_bit_cast(float, (unsigned)h << 16); }
__device__ __forceinline__ float bflo(unsigned u) { return __builtin_bit_cast(float, u << 16); }
__device__ __forceinline__ float bfhi(unsigned u) { return __builtin_bit_cast(float, u & 0xffff0000u); }

namespace pg8 {
constexpr int BM = 256, BK = 64, HALF = 128, HTB = HALF * BK * 2, STAGE_BYTES = 8 * HTB;
__device__ __forceinline__ int lds_byte(int r, int c) { const int st = (r >> 4) * 2 + (c >> 5), rr = r & 15, cc = c & 31, ob = rr * 64 + cc * 2; return st * 1024 + (ob ^ (((ob >> 9) & 1) << 5)); }
__device__ __forceinline__ void stage_rc(int b, int& R, int& C) { const int st = b / 1024, sb = b % 1024, swz = sb ^ (((sb >> 9) & 1) << 5); R = (st >> 1) * 16 + swz / 64; C = (st & 1) * 32 + (swz % 64) / 2; }
__device__ __forceinline__ int perm32(int rho) { const int n = rho >> 4, i = rho & 15; return 8 * (i >> 2) + 4 * n + (i & 3); }

struct Unit { int pm, pn, e, mt; };

template <class Epi, class Sched, bool ALIGN_EPI, bool SP2>
__device__ __forceinline__ void gemm_phase(LAS unsigned char* lds, const int K, const Sched& S, const Epi& E) {
    const int tid = opaque(threadIdx.x), wid = __builtin_amdgcn_readfirstlane(tid >> 6), lane = tid & 63, wr = wid >> 2, wc = wid & 3, fr = lane & 15, fq = lane >> 4;
    const int nt = K / BK;
    unsigned voffA[2], voffB[2];
#pragma unroll
    for (int i = 0; i < 2; ++i) { int R, C; stage_rc(tid * 16 + i * 8192, R, C); const int Rb = Epi::PERM ? ((R & ~31) + perm32(R & 31)) : R;
        voffA[i] = Sched::GATHER ? (unsigned)(C * 2) : (unsigned)(R * K + C) * 2u; voffB[i] = (unsigned)(Rb * K + C) * 2u; }
    const size_t kstep = (size_t)(BK * 2);
    const size_t hstep = (size_t)HALF * K * 2;
    const unsigned ldsw = (unsigned)wid * 1024u;
    const int aoff = lds_byte(wr * 64 + fr, fq * 8), boff = lds_byte(wc * 32 + fr, fq * 8);
#define PG8_SA(b, h) (((b) * 2 + (h)) * HTB)
#define PG8_SB(b, h) ((4 + (b) * 2 + (h)) * HTB)
#define PG8_STAGE(bufoff, gbase, voff) do { _Pragma("unroll") for (int _i = 0; _i < 2; ++_i) \
        __builtin_amdgcn_global_load_lds((const unsigned*)((const char*)(gbase) + (voff)[_i]), (LAS unsigned*)(lds + (bufoff) + ldsw + _i * 8192), 16, 0, 0); } while (0)
#define PG8_LDA(dst, b, h) do { _Pragma("unroll") for (int m = 0; m < 4; ++m) _Pragma("unroll") for (int k = 0; k < 2; ++k) dst[m][k] = *(const LAS bf16x8*)(lds + PG8_SA(b, h) + aoff + m * 2048 + k * 1024); } while (0)
#define PG8_LDB(dst, b, h) do { _Pragma("unroll") for (int n = 0; n < 2; ++n) _Pragma("unroll") for (int k = 0; k < 2; ++k) dst[n][k] = *(const LAS bf16x8*)(lds + PG8_SB(b, h) + boff + n * 2048 + k * 1024); } while (0)
#define PG8_MMA(ai, bj, At, Bt) do { __builtin_amdgcn_s_setprio(1); _Pragma("unroll") for (int m = 0; m < 4; ++m) _Pragma("unroll") for (int n = 0; n < 2; ++n) _Pragma("unroll") for (int k = 0; k < 2; ++k) \
        acc[ai][bj][m][n] = __builtin_amdgcn_mfma_f32_16x16x32_bf16(Bt[n][k], At[m][k], acc[ai][bj][m][n], 0, 0, 0); __builtin_amdgcn_s_setprio(0); } while (0)
#define PG8_WAIT_V(n) asm volatile("s_waitcnt vmcnt(" #n ")" ::: "memory")
#define PG8_WAIT_L(n) asm volatile("s_waitcnt lgkmcnt(" #n ")" ::: "memory")
#define PG8_BAR __builtin_amdgcn_s_barrier()
#define PG8_SCHED __builtin_amdgcn_sched_barrier(0)
    Unit cur, nxt; int ui = 0;
    if (!S.next(0, cur)) return;
    f32x4 acc[2][2][4][2];
#pragma unroll
    for (int a = 0; a < 2; ++a)
#pragma unroll
        for (int b = 0; b < 2; ++b)
#pragma unroll
            for (int m = 0; m < 4; ++m)
#pragma unroll
                for (int n = 0; n < 2; ++n) acc[a][b][m][n] = (f32x4){0.f, 0.f, 0.f, 0.f};
    bf16x8 At[4][2], B0[2][2], B1[2][2];
    const char* cA = S.a_base(cur); const char* cB = S.b_base(cur);
    unsigned pk[2] = {0u, 0u}, npk[2] = {0u, 0u};
    if constexpr (Sched::GATHER) S.a_tok(cur, tid, pk);
    const unsigned k2 = (unsigned)K * 2u;
#define PG8_STAGE_A(bufoff, gbase, hh, PK) do { if constexpr (Sched::GATHER) { unsigned _v[2]; _v[0] = (((PK)[0] >> (16 * (hh))) & 0xffffu) * k2 + voffA[0]; _v[1] = (((PK)[1] >> (16 * (hh))) & 0xffffu) * k2 + voffA[1]; \
        PG8_STAGE(bufoff, gbase, _v); } else { PG8_STAGE(bufoff, (gbase) + (hh) * hstep, voffA); } } while (0)
    static_assert(SP2, "only the SP2 loop is kept");
    PG8_STAGE(PG8_SB(0, 0), cB, voffB); PG8_STAGE(PG8_SB(0, 1), cB + hstep, voffB); PG8_STAGE_A(PG8_SA(0, 0), cA, 0, pk); PG8_STAGE_A(PG8_SA(0, 1), cA, 1, pk);
    if (wr == 1) PG8_BAR;
    PG8_WAIT_V(2); PG8_BAR;
    PG8_STAGE(PG8_SB(1, 0), cB + kstep, voffB); PG8_STAGE_A(PG8_SA(1, 0), cA + kstep, 0, pk); PG8_STAGE(PG8_SB(1, 1), cB + hstep + kstep, voffB);
    PG8_WAIT_V(6); PG8_BAR;
    for (;;) {
        const bool has_next = S.next(ui + 1, nxt);
        const char* nA = has_next ? S.a_base(nxt) : cA; const char* nB = has_next ? S.b_base(nxt) : cB;
        if constexpr (Sched::GATHER) { if (has_next) S.a_tok(nxt, tid, npk); else { npk[0] = pk[0]; npk[1] = pk[1]; } }
#pragma unroll 1
        for (int t = 0; t < nt; t += 2) {
            const bool last = (t == nt - 2);
            const char* a1 = cA + (size_t)(t + 1) * kstep;
            const char* a2 = last ? nA : cA + (size_t)(t + 2) * kstep; const char* b2 = last ? nB : cB + (size_t)(t + 2) * kstep;
            const char* a3 = a2 + kstep; const char* b3 = b2 + kstep;
            unsigned sp[2]; sp[0] = last ? npk[0] : pk[0]; sp[1] = last ? npk[1] : pk[1];
            PG8_LDB(B0, 0, 0); PG8_LDB(B1, 0, 1); PG8_SCHED; PG8_LDA(At, 0, 0); PG8_STAGE_A(PG8_SA(1, 1), a1, 1, pk);
            PG8_WAIT_V(8); PG8_WAIT_L(0); PG8_BAR; PG8_MMA(0, 0, At, B0); PG8_MMA(0, 1, At, B1); PG8_BAR; PG8_SCHED;
            PG8_LDA(At, 0, 1); PG8_STAGE(PG8_SB(0, 0), b2, voffB); PG8_STAGE(PG8_SB(0, 1), b2 + hstep, voffB); PG8_STAGE_A(PG8_SA(0, 0), a2, 0, sp);
            PG8_WAIT_V(8); PG8_WAIT_L(0); PG8_BAR; PG8_MMA(1, 0, At, B0); PG8_MMA(1, 1, At, B1); PG8_BAR; PG8_SCHED;
            PG8_LDB(B0, 1, 0); PG8_LDB(B1, 1, 1); PG8_SCHED; PG8_LDA(At, 1, 0); PG8_STAGE_A(PG8_SA(0, 1), a2, 1, sp);
            PG8_WAIT_V(8); PG8_WAIT_L(0); PG8_BAR; PG8_MMA(0, 0, At, B0); PG8_MMA(0, 1, At, B1); PG8_BAR; PG8_SCHED;
            PG8_LDA(At, 1, 1); PG8_STAGE(PG8_SB(1, 0), b3, voffB); PG8_STAGE(PG8_SB(1, 1), b3 + hstep, voffB); PG8_STAGE_A(PG8_SA(1, 0), a3, 0, sp);
            PG8_WAIT_V(8); PG8_WAIT_L(0); PG8_BAR; PG8_MMA(1, 0, At, B0); PG8_MMA(1, 1, At, B1); PG8_BAR; PG8_SCHED;
        }
        if constexpr (ALIGN_EPI) { if (wr == 0) PG8_BAR; }
        { const int t2 = opaque(threadIdx.x), w2 = __builtin_amdgcn_readfirstlane(t2 >> 6), l2 = t2 & 63; E(acc, cur, w2 >> 2, w2 & 3, l2 & 15, l2 >> 4); }
        if (!has_next) break;
#pragma unroll
        for (int a = 0; a < 2; ++a)
#pragma unroll
            for (int b = 0; b < 2; ++b)
#pragma unroll
                for (int m = 0; m < 4; ++m)
#pragma unroll
                    for (int n = 0; n < 2; ++n) acc[a][b][m][n] = (f32x4){0.f, 0.f, 0.f, 0.f};
        cur = nxt; cA = nA; cB = nB; ++ui;
        pk[0] = npk[0]; pk[1] = npk[1];
        if constexpr (ALIGN_EPI) { if (wr == 1) PG8_BAR; }
    }
    PG8_WAIT_V(0);
    if constexpr (!ALIGN_EPI) { if (wr == 0) PG8_BAR; }
    PG8_BAR;
#undef PG8_SA
#undef PG8_SB
#undef PG8_STAGE
#undef PG8_STAGE_A
#undef PG8_LDA
#undef PG8_LDB
#undef PG8_MMA
#undef PG8_WAIT_V
#undef PG8_WAIT_L
#undef PG8_BAR
#undef PG8_SCHED
}

struct DenseOrder {
    const bf16_t* A; const bf16_t* Bt; int K; int nM, nN, nwg, G, c;
    __device__ __forceinline__ void init(const bf16_t* A_, const bf16_t* Bt_, int M, int N, int K_, int G_, int c_) { A = A_; Bt = Bt_; K = K_; nM = M / BM; nN = N / BM; nwg = nM * nN; G = G_; c = c_; }
    __device__ __forceinline__ bool next(int i, Unit& u) const {
        const long L = (long)i * G + c; if (L >= nwg) return false;
        int wgid = (int)L; { const int q = nwg / 8, r = nwg % 8, xcd = wgid % 8, off = wgid / 8; wgid = (xcd < r ? xcd * (q + 1) : r * (q + 1) + (xcd - r) * q) + off; }
        const int nig = 8 * nN, gid = wgid / nig, fm = gid * 8, gsz = (nM - fm) < 8 ? (nM - fm) : 8;
        u.pm = fm + ((wgid % nig) % gsz); u.pn = (wgid % nig) / gsz; u.e = 0; u.mt = 0; return true;
    }
    __device__ __forceinline__ const char* a_base(const Unit& u) const { return (const char*)A + (size_t)u.pm * BM * K * 2; }
    __device__ __forceinline__ const char* b_base(const Unit& u) const { return (const char*)Bt + (size_t)u.pn * BM * K * 2; }
    static constexpr bool GATHER = false;
    __device__ __forceinline__ void a_tok(const Unit&, int, unsigned (&)[2]) const {}
};

template <bool GATHER_>
struct MoeOrder {
    static constexpr bool GATHER = GATHER_;
    const LAS int* tstart;
    const LAS int* cnts;
    const int* list;
    const bf16_t* A;
    const bf16_t* Bt;
    int K, N, lognpn, G, c;
    __device__ __forceinline__ bool next(int i, Unit& u) const {
        const int L = i * G + c; const int total = __builtin_amdgcn_readfirstlane(tstart[65]) << lognpn; if (L >= total) return false;
        const int rt = L >> lognpn; u.pn = L & ((1 << lognpn) - 1); u.pm = rt;
        int e = 0;
        for (int j = 1; j < 65; ++j) e += (tstart[j] <= rt) ? 1 : 0;
        e = __builtin_amdgcn_readfirstlane(e);
        u.e = e; u.mt = rt - __builtin_amdgcn_readfirstlane(tstart[e]); return true;
    }
    __device__ __forceinline__ const char* a_base(const Unit& u) const { return GATHER ? (const char*)A : (const char*)A + (size_t)u.pm * BM * K * 2; }
    __device__ __forceinline__ const char* b_base(const Unit& u) const { return (const char*)Bt + ((size_t)u.e * N + (size_t)u.pn * BM) * K * 2; }
    __device__ __forceinline__ void a_tok(const Unit& u, int tid, unsigned (&pkv)[2]) const {
        const int ce = cnts[u.e];
#pragma unroll
        for (int i = 0; i < 2; ++i) {
            int R, C; stage_rc(tid * 16 + i * 8192, R, C); (void)C;
            unsigned v = 0u;
#pragma unroll
            for (int hh = 0; hh < 2; ++hh) {
                const int idx = u.mt * BM + hh * HALF + R;
                int tok = 0;
                if (idx < ce) tok = (u.e < NE) ? (list[(size_t)u.e * T + idx] / TOPK) : idx;
                v |= (unsigned)tok << (16 * hh);
            }
            pkv[i] = v;
        }
    }
};

struct EpiProj {
    static constexpr bool PERM = true;
    bf16_t* O; bf16_t* vt;
    __device__ __forceinline__ void operator()(const f32x4 (&acc)[2][2][4][2], const Unit& u, int wr, int wc, int fr, int fq) const {
        const int row0 = u.pm * BM + wr * 64 + fr, col0 = u.pn * BM + wc * 32 + 8 * fq;
#pragma unroll
        for (int bj = 0; bj < 2; ++bj) {
            const bool isv = (u.pn == 8) || (u.pn == 9 && bj == 0);
            if (!isv) {
#pragma unroll
                for (int ai = 0; ai < 2; ++ai)
#pragma unroll
                    for (int m = 0; m < 4; ++m) { bf16_t* rowp = O + (size_t)(row0 + ai * HALF + m * 16) * PJB + col0 + bj * HALF;
                        const f32x4 v0 = acc[ai][bj][m][0], v1 = acc[ai][bj][m][1];
                        u32x4 w; w.x = pk2(v0[0], v0[1]); w.y = pk2(v0[2], v0[3]); w.z = pk2(v1[0], v1[1]); w.w = pk2(v1[2], v1[3]);
                        *(u32x4*)rowp = w; }
            } else {
                const int vc0 = col0 + bj * HALF - 2048;
#pragma unroll
                for (int ai = 0; ai < 2; ++ai)
#pragma unroll
                    for (int m = 0; m < 4; ++m) { const int row = row0 + ai * HALF + m * 16; const int b = row / SEQ, s = row % SEQ;
                        bf16_t* base = vt + ((size_t)b * SBW + vc0) * SEQ + s;
#pragma unroll
                        for (int n = 0; n < 2; ++n)
#pragma unroll
                            for (int j = 0; j < 4; ++j) base[(size_t)(4 * n + j) * SEQ] = (bf16_t)f2bf(acc[ai][bj][m][n][j]); }
            }
        }
    }
};
struct EpiOut {
    static constexpr bool PERM = false;
    const float* xin; float* xo; const float* gt;
    __device__ __forceinline__ void operator()(const f32x4 (&acc)[2][2][4][2], const Unit& u, int wr, int wc, int fr, int fq) const {
        const int row0 = u.pm * BM + wr * 64 + fr, col0 = u.pn * BM + wc * 32 + 4 * fq;
#pragma unroll
        for (int ai = 0; ai < 2; ++ai)
#pragma unroll
            for (int m = 0; m < 4; ++m) { const int row = row0 + ai * HALF + m * 16; const float* gr = gt + (size_t)(row / SEQ) * 6144;
#pragma unroll
                for (int bj = 0; bj < 2; ++bj)
#pragma unroll
                    for (int n = 0; n < 2; ++n) { const int col = col0 + bj * HALF + 16 * n;
                        const f32x4 xi = *(const f32x4*)(xin + (size_t)row * D + col); const f32x4 gg = *(const f32x4*)(gr + col);
                        *(f32x4*)(xo + (size_t)row * D + col) = xi + gg * acc[ai][bj][m][n]; } }
    }
};
struct EpiExp1 {
    static constexpr bool PERM = true;
    bf16_t* hm;
    __device__ __forceinline__ void operator()(const f32x4 (&acc)[2][2][4][2], const Unit& u, int wr, int wc, int fr, int fq) const {
        const int row0 = u.pm * BM + wr * 64 + fr, col0 = u.pn * HALF + wc * 32 + 8 * fq;
#pragma unroll
        for (int ai = 0; ai < 2; ++ai)
#pragma unroll
            for (int m = 0; m < 4; ++m) { bf16_t* rowp = hm + (size_t)(row0 + ai * HALF + m * 16) * ED + col0;
                float o[8];
#pragma unroll
                for (int n = 0; n < 2; ++n)
#pragma unroll
                    for (int j = 0; j < 4; ++j) o[n * 4 + j] = siluf_(acc[ai][0][m][n][j]) * acc[ai][1][m][n][j];
                u32x4 w; w.x = pk2(o[0], o[1]); w.y = pk2(o[2], o[3]); w.z = pk2(o[4], o[5]); w.w = pk2(o[6], o[7]);
                *(u32x4*)rowp = w; }
    }
};
struct EpiExp2 {
    static constexpr bool PERM = true;
    bf16_t* slab; float* xb; const float* gt; const int* list; const float* topw; const LAS int* cnts; int skip_shared;
    __device__ __forceinline__ void operator()(const f32x4 (&acc)[2][2][4][2], const Unit& u, int wr, int wc, int fr, int fq) const {
        const int col0 = u.pn * BM + wc * 32 + 8 * fq; const int ce = cnts[u.e];
#pragma unroll
        for (int ai = 0; ai < 2; ++ai)
#pragma unroll
            for (int m = 0; m < 4; ++m) { const int idx = u.mt * BM + ai * HALF + wr * 64 + m * 16 + fr;
                if (idx < ce) {
                    if (u.e < NE) {
                        const int aid = list[(size_t)u.e * T + idx]; const float wgt = topw[aid]; bf16_t* rowp = slab + (size_t)aid * D + col0;
#pragma unroll
                        for (int bj = 0; bj < 2; ++bj) { const f32x4 v0 = acc[ai][bj][m][0] * wgt, v1 = acc[ai][bj][m][1] * wgt;
                            u32x4 w; w.x = pk2(v0[0], v0[1]); w.y = pk2(v0[2], v0[3]); w.z = pk2(v1[0], v1[1]); w.w = pk2(v1[2], v1[3]);
                            *(u32x4*)(rowp + bj * HALF) = w; }
                    } else if (!skip_shared) {
                        const int tok = idx; float* xr = xb + (size_t)tok * D + col0; const float* gr = gt + (size_t)(tok / SEQ) * 6144 + col0;
#pragma unroll
                        for (int bj = 0; bj < 2; ++bj)
#pragma unroll
                            for (int n = 0; n < 2; ++n) { const f32x4 xi = *(const f32x4*)(xr + bj * HALF + 4 * n); const f32x4 gg = *(const f32x4*)(gr + bj * HALF + 4 * n);
                                *(f32x4*)(xr + bj * HALF + 4 * n) = xi + gg * acc[ai][bj][m][n]; }
                    }
                } }
    }
};
}

__device__ __forceinline__ void st_mod(const P& p, int item, LAS float* L  ) {
    const int tid = opaque(threadIdx.x), wave = tid >> 6, lane = tid & 63;
    const int l = item / 96, j0 = (item % 96) * 64;
    for (int i = tid; i < 8 * 1024; i += NTHREADS) L[i] = siluf_(p.c[i]);
    __syncthreads();
    float acc[8];
#pragma unroll
    for (int b = 0; b < 8; ++b) acc[b] = 0.f;
    const float* w = p.w_ada + ((size_t)l * 1024 + wave * 128) * 6144 + j0 + lane;
#pragma unroll 8
    for (int i = 0; i < 128; ++i) {
        const float wv = w[(size_t)i * 6144];
#pragma unroll
        for (int b = 0; b < 8; ++b) acc[b] += L[b * 1024 + wave * 128 + i] * wv;
    }
    LAS float* red = L + 8 * 1024;
#pragma unroll
    for (int b = 0; b < 8; ++b) red[(wave * 8 + b) * 64 + lane] = acc[b];
    __syncthreads();
    {
        const int b = tid >> 6;
        float s = p.b_ada[l * 6144 + j0 + lane];
#pragma unroll
        for (int wv = 0; wv < 8; ++wv) s += red[(wv * 8 + b) * 64 + lane];
        p.mod[((size_t)l * 8 + b) * 6144 + j0 + lane] = s;
    }
    __syncthreads();
}

constexpr int REC_HB = 912, REC_TB = 6 * REC_HB;
constexpr int CB_PHI = 0, CB_RT = 8192, CB_PSI = 12288, CB_G = 16384, CB_V = 18432, CB_BYTES = 22528;
constexpr int PREP_TOK = 64;
__device__ __forceinline__ void st_prep(const P& p, int l, int vb0, int vbstride, LAS float* X  ) {
    const int tid = opaque(threadIdx.x);
    const int c = tid < RWW ? tid : 0, hh = c >> 6, lane = c & 63;
    for (int vb = vb0; vb < T / PREP_TOK; vb += vbstride) {
        const int t0 = vb * PREP_TOK, s0 = t0 % SEQ;
#pragma unroll 4
        for (int q = 0; q < PREP_TOK * 160 / NTHREADS; ++q) {
            const int it = tid + q * NTHREADS;
            const int tt = it / 160, i = it % 160;
            const int col = (i < 128) ? 1152 + i : INC + (i - 128);
            const float mu = (i < 128) ? p.mu_rw[l * RWC + col] : p.mu_vres[i - 128];
            const bf16_t* u = p.proj + (size_t)(t0 + tt) * PJB + col;
            const float uu = bf2f(u[0]), pv = (s0 + tt) > 0 ? bf2f(u[-PJB]) : 0.f;
            float x = uu + (pv - uu) * mu;
            if (i < 32) x = tanhf(x); else if (i >= 64 && i < 128) x = sigmoidf_(x);
            if (i >= 128 && l == 0) x = 0.f;
            X[it] = x;
        }
        __syncthreads();
        if (tid < RWW) {
            {
                float W2[32], A2[32], V2[32];
                const int cc = opaque(c);
                {
                    const float* w2 = p.rw_w2 + (size_t)l * 32 * RWW;
                    const float* a2 = p.rw_a2 + (size_t)l * 32 * RWW;
                    const float* v2 = p.rw_v2;
#pragma unroll
                    for (int i = 0; i < 32; ++i) { W2[i] = w2[i * RWW + cc]; A2[i] = a2[i * RWW + cc]; V2[i] = (l == 1) ? v2[i * RWW + cc] : 0.f; }
                }
                const float w0 = p.rw_w0[l * RWW + cc], a0 = p.rw_a0[l * RWW + cc], v0 = (l == 1) ? p.rw_v0[cc] : 0.f;
                const float kkc = p.rw_k_k[l * RWW + cc], kac = p.rw_k_a[l * RWW + cc], rkc = p.rw_r_k[l * RWW + cc];
                const float mur = p.mu_rw[l * RWC + cc], muk = p.mu_rw[l * RWC + 384 + cc], muv = p.mu_rw[l * RWC + 768 + cc];
                for (int grp = 0; grp < PREP_TOK / 4; ++grp) {
                    float pr[4], pk_[4], pv_[4], pvf[4];
#pragma unroll
                    for (int j = 0; j < 4; ++j) {
                        const int tt = grp * 4 + j; const bf16_t* u = p.proj + (size_t)(t0 + tt) * PJB + c; const bool hp = (s0 + tt) > 0;
                        float r = bf2f(u[0]), k = bf2f(u[384]), v = bf2f(u[768]);
                        const float rp = hp ? bf2f(u[-PJB]) : 0.f, kp = hp ? bf2f(u[384 - PJB]) : 0.f, vp = hp ? bf2f(u[768 - PJB]) : 0.f;
                        pr[j] = r + (rp - r) * mur; pk_[j] = k + (kp - k) * muk; pv_[j] = v + (vp - v) * muv;
                        pvf[j] = (l == 1) ? bf2f(p.vfirst[(size_t)(t0 + tt) * RWW + c]) : 0.f;
                    }
#pragma unroll
                    for (int j = 0; j < 4; ++j) {
                        const int tt = grp * 4 + j, t = t0 + tt;
                        const LAS float* xr = X + tt * 160;
                        float aw = w0, aa = a0, av = v0;
#pragma unroll
                        for (int i = 0; i < 32; i += 4) {
                            const f32x4 xw = *(const LAS f32x4*)(xr + i), xa = *(const LAS f32x4*)(xr + 32 + i), xv = *(const LAS f32x4*)(xr + 128 + i);
#pragma unroll
                            for (int q = 0; q < 4; ++q) { aw += xw[q] * W2[i + q]; aa += xa[q] * A2[i + q]; av += xv[q] * V2[i + q]; }
                        }
                        const float r = pr[j], k = pk_[j]; float v = pv_[j];
                        const float wlog = -softplusf_(-aw) - 0.5f;
                        const float decay = __expf(-__expf(wlog));
                        const float a = sigmoidf_(aa);
                        if (l == 1) { const float vg = sigmoidf_(av); v = v + (pvf[j] - v) * vg; }
                        else p.vfirst[(size_t)t * RWW + c] = (bf16_t)f2bf(v);
                        const float kkr = k * kkc;
                        const float ss = wave_sum(kkr * kkr);
                        const float kk = kkr / fmaxf(sqrtf(ss), 1e-12f);
                        unsigned char* rc = p.rec + (size_t)t * REC_TB + hh * REC_HB;
                        const float bq = kk * a, k2 = k * (1.f + (a - 1.f) * kac);
                        *(float*)(rc + lane * 4) = decay;
                        bf16_t* rb = (bf16_t*)(rc + 256) + lane;
                        rb[0] = (bf16_t)f2bf(-kk); rb[64] = (bf16_t)f2bf(bq); rb[128] = (bf16_t)f2bf(k2); rb[192] = (bf16_t)f2bf(decay * r); rb[256] = (bf16_t)f2bf(v);
                        const float rkb = wave_sum(r * k2 * rkc);
                        if (lane == 0) *(float*)(rc + 896) = rkb;
                    }
                }
            }
            {
                float G2[64];
                const float* g2 = p.rw_g2 + (size_t)l * 64 * RWW;
                const int cc = opaque(c);
#pragma unroll
                for (int i = 0; i < 64; ++i) G2[i] = g2[i * RWW + cc];
                for (int grp = 0; grp < PREP_TOK / 4; ++grp) {
#pragma unroll
                    for (int j = 0; j < 4; ++j) {
                        const int tt = grp * 4 + j;
                        const LAS float* xr = X + tt * 160 + 64;
                        float ag = 0.f;
#pragma unroll
                        for (int i = 0; i < 64; i += 4) {
                            const f32x4 xg = *(const LAS f32x4*)(xr + i);
#pragma unroll
                            for (int q = 0; q < 4; ++q) ag += xg[q] * G2[i + q];
                        }
                        p.g[(size_t)(t0 + tt) * RWW + c] = (bf16_t)f2bf(ag);
                    }
                }
            }
        }
        __syncthreads();
    }
}

typedef float f32x16 __attribute__((ext_vector_type(16)));
__device__ __forceinline__ bf16x8 acc_frag(const f32x16& x, int ks) {
    return ks == 0 ? mk8(cvtpk(x[0], x[1]), cvtpk(x[2], x[3]), cvtpk(x[4], x[5]), cvtpk(x[6], x[7])) : mk8(cvtpk(x[8], x[9]), cvtpk(x[10], x[11]), cvtpk(x[12], x[13]), cvtpk(x[14], x[15]));
}
__device__ __forceinline__ bf16x8 lds_perm_frag(const LAS unsigned char* rowp, int ks, int hf) {
    const u32x2 g0 = *(const LAS u32x2*)(rowp + (16 * ks + 4 * hf) * 2), g1 = *(const LAS u32x2*)(rowp + (16 * ks + 4 * hf + 8) * 2);
    return mk8(g0.x, g0.y, g1.x, g1.y);
}
constexpr int CP_WAVES = 6, CP_LDS = 20736;
__device__ __forceinline__ void st_cpre(const P& p, int item, LAS unsigned char* L, int lane_) {
    const int lane = opaque(lane_);
    const int ch = item & 63, bh = item >> 6, b = bh / 6, hh = bh % 6;
    const int r = lane & 31, hf = lane >> 5;
    const unsigned char* rec0 = p.rec + ((size_t)(b * SEQ + ch * 32)) * REC_TB + hh * REC_HB;
    unsigned char* cbo = p.cb + (size_t)item * CB_BYTES;
    LAS unsigned char* AbarT = L; LAS unsigned char* RbarT = L + 4096; LAS unsigned char* Bbar = L + 8192; LAS unsigned char* Kbar = L + 12288; LAS unsigned char* BbarT = L + 16384;
    LAS float* PCv = (LAS float*)(L + 20480);
    float Y[32];
    {
        float Pc = 1.f;
        unsigned bt[16], vtw[16];
#pragma unroll
        for (int t8 = 0; t8 < 32; t8 += 8) {
            float wv[8]; bf16_t av[8], bv[8], kv[8], qv[8], vv[8];
#pragma unroll
            for (int j = 0; j < 8; ++j) {
                const unsigned char* rp = rec0 + (size_t)(t8 + j) * REC_TB;
                wv[j] = *(const float*)(rp + lane * 4);
                const bf16_t* hb = (const bf16_t*)(rp + 256) + lane;
                av[j] = hb[0]; bv[j] = hb[64]; kv[j] = hb[128]; qv[j] = hb[192]; vv[j] = hb[256];
            }
#pragma unroll
            for (int j = 0; j < 8; ++j) {
                const int t = t8 + j;
                const float Pm = Pc; Pc *= wv[j]; const float inv = 1.f / Pc;
                const float ab = bf2f(av[j]) * Pm, rb = bf2f(qv[j]) * Pm, bb = bf2f(bv[j]) * inv, kb = bf2f(kv[j]) * inv;
                Y[t] = ab;
                *(LAS bf16_t*)(AbarT + (t * 64 + lane) * 2) = (bf16_t)f2bf(ab);
                *(LAS bf16_t*)(RbarT + (t * 64 + lane) * 2) = (bf16_t)f2bf(rb);
                *(LAS bf16_t*)(Bbar + (t * 64 + lane) * 2) = (bf16_t)f2bf(bb);
                *(LAS bf16_t*)(Kbar + (t * 64 + lane) * 2) = (bf16_t)f2bf(kb);
                if (t & 1) { bt[t >> 1] |= f2bf(bb) << 16; vtw[t >> 1] |= (unsigned)vv[j] << 16; } else { bt[t >> 1] = f2bf(bb); vtw[t >> 1] = (unsigned)vv[j]; }
            }
            asm volatile("" ::: "memory");
        }
        PCv[lane] = Pc;
#pragma unroll
        for (int q = 0; q < 4; ++q) {
            *(LAS u32x4*)(BbarT + lane * 64 + q * 16) = (u32x4){bt[4 * q], bt[4 * q + 1], bt[4 * q + 2], bt[4 * q + 3]};
            *(u32x4*)(cbo + CB_V + lane * 64 + q * 16) = (u32x4){vtw[4 * q], vtw[4 * q + 1], vtw[4 * q + 2], vtw[4 * q + 3]};
        }
    }
    asm volatile("s_waitcnt lgkmcnt(0)" ::: "memory");
    f32x16 Lab, Lak, Mbr, Mkr;
#pragma unroll
    for (int i = 0; i < 16; ++i) { Lab[i] = 0.f; Lak[i] = 0.f; Mbr[i] = 0.f; Mkr[i] = 0.f; }
#pragma unroll
    for (int ks = 0; ks < 4; ++ks) {
        const int off = (r * 64 + 16 * ks + 8 * hf) * 2;
        const bf16x8 fb = *(const LAS bf16x8*)(Bbar + off), fk = *(const LAS bf16x8*)(Kbar + off), fa = *(const LAS bf16x8*)(AbarT + off), fr = *(const LAS bf16x8*)(RbarT + off);
        Lab = __builtin_amdgcn_mfma_f32_32x32x16_bf16(fb, fa, Lab, 0, 0, 0);
        Lak = __builtin_amdgcn_mfma_f32_32x32x16_bf16(fk, fa, Lak, 0, 0, 0);
        Mbr = __builtin_amdgcn_mfma_f32_32x32x16_bf16(fb, fr, Mbr, 0, 0, 0);
        Mkr = __builtin_amdgcn_mfma_f32_32x32x16_bf16(fk, fr, Mkr, 0, 0, 0);
    }
#pragma unroll
    for (int i = 0; i < 16; ++i) {
        const int s = (i & 3) + 8 * (i >> 2) + 4 * hf;
        if (!(s < r)) { Lab[i] = 0.f; Lak[i] = 0.f; }
        if (!(s <= r)) { Mbr[i] = 0.f; Mkr[i] = 0.f; }
    }
    asm volatile("s_waitcnt lgkmcnt(0)" ::: "memory");
    {
        LAS float* LabT = (LAS float*)AbarT; LAS float* LakM = (LAS float*)Bbar;
#pragma unroll
        for (int g = 0; g < 4; ++g) *(LAS f32x4*)(LabT + r * 32 + 8 * g + 4 * hf) = (f32x4){Lab[4 * g], Lab[4 * g + 1], Lab[4 * g + 2], Lab[4 * g + 3]};
#pragma unroll
        for (int i = 0; i < 16; ++i) LakM[((i & 3) + 8 * (i >> 2) + 4 * hf) * 32 + r] = Lak[i];
    }
    asm volatile("s_waitcnt lgkmcnt(0)" ::: "memory");
    unsigned W2p[16];
    {
        const LAS float* LabT = (const LAS float*)AbarT; const LAS float* LakM = (const LAS float*)Bbar;
        float X2[32];
#pragma unroll
        for (int t = 0; t < 32; t += 4) { const f32x4 q = *(const LAS f32x4*)(LakM + r * 32 + t); X2[t] = q[0]; X2[t + 1] = q[1]; X2[t + 2] = q[2]; X2[t + 3] = q[3]; }
        int zdep = 0;
#pragma unroll
        for (int t = 1; t < 32; ++t) {
            float x2 = X2[t];
            const LAS float* row = LabT + t * 32 + zdep;
#pragma unroll
            for (int s4 = 0; s4 < t; s4 += 4) {
                const f32x4 lq = *(const LAS f32x4*)(row + s4);
#pragma unroll
                for (int q = 0; q < 4; ++q) if (s4 + q < t) x2 = fmaf(X2[s4 + q], lq[q], x2);
            }
            X2[t] = x2;
            asm volatile("v_mov_b32 %0, 0" : "=v"(zdep) : "v"(x2));
        }
#pragma unroll
        for (int q = 0; q < 16; ++q) W2p[q] = pk2(X2[2 * q], X2[2 * q + 1]);
    }
    {
        const LAS float* LabT = (const LAS float*)AbarT;
        int zdep = 0;
#pragma unroll
        for (int t = 1; t < 32; ++t) {
            float x1 = Y[t];
            const LAS float* row = LabT + t * 32 + zdep;
#pragma unroll
            for (int s4 = 0; s4 < t; s4 += 4) {
                const f32x4 lq = *(const LAS f32x4*)(row + s4);
#pragma unroll
                for (int q = 0; q < 4; ++q) if (s4 + q < t) x1 = fmaf(Y[s4 + q], lq[q], x1);
            }
            Y[t] = x1;
            asm volatile("v_mov_b32 %0, 0" : "=v"(zdep) : "v"(x1));
        }
    }
    asm volatile("s_waitcnt lgkmcnt(0)" ::: "memory");
    LAS unsigned char* Atil = L;
    LAS unsigned char* Wv = L + 8192;
#pragma unroll
    for (int q = 0; q < 4; ++q) {
        *(LAS u32x4*)(Atil + lane * 64 + q * 16) = (u32x4){pk2(Y[8 * q], Y[8 * q + 1]), pk2(Y[8 * q + 2], Y[8 * q + 3]), pk2(Y[8 * q + 4], Y[8 * q + 5]), pk2(Y[8 * q + 6], Y[8 * q + 7])};
        if (lane < 32) *(LAS u32x4*)(Wv + lane * 64 + q * 16) = (u32x4){W2p[4 * q], W2p[4 * q + 1], W2p[4 * q + 2], W2p[4 * q + 3]};
    }
    asm volatile("s_waitcnt lgkmcnt(0)" ::: "memory");
    const bf16x8 mb0 = acc_frag(Mbr, 0), mb1 = acc_frag(Mbr, 1);
#pragma unroll
    for (int i = 0; i < 2; ++i) {
        f32x16 c;
#pragma unroll
        for (int g = 0; g < 4; ++g) { const u32x2 q = *(const LAS u32x2*)(RbarT + (r * 64 + 32 * i + 8 * g + 4 * hf) * 2); c[4 * g] = bflo(q.x); c[4 * g + 1] = bfhi(q.x); c[4 * g + 2] = bflo(q.y); c[4 * g + 3] = bfhi(q.y); }
        c = __builtin_amdgcn_mfma_f32_32x32x16_bf16(lds_perm_frag(Atil + (32 * i + r) * 64, 0, hf), mb0, c, 0, 0, 0);
        c = __builtin_amdgcn_mfma_f32_32x32x16_bf16(lds_perm_frag(Atil + (32 * i + r) * 64, 1, hf), mb1, c, 0, 0, 0);
#pragma unroll
        for (int g = 0; g < 4; ++g) *(u32x2*)(cbo + CB_RT + (r * 64 + 32 * i + 8 * g + 4 * hf) * 2) = (u32x2){cvtpk(c[4 * g], c[4 * g + 1]), cvtpk(c[4 * g + 2], c[4 * g + 3])};
    }
    {
        f32x16 c = Mkr;
        c = __builtin_amdgcn_mfma_f32_32x32x16_bf16(lds_perm_frag(Wv + r * 64, 0, hf), mb0, c, 0, 0, 0);
        c = __builtin_amdgcn_mfma_f32_32x32x16_bf16(lds_perm_frag(Wv + r * 64, 1, hf), mb1, c, 0, 0, 0);
#pragma unroll
        for (int g = 0; g < 4; ++g) *(u32x2*)(cbo + CB_G + (r * 32 + 8 * g + 4 * hf) * 2) = (u32x2){cvtpk(c[4 * g], c[4 * g + 1]), cvtpk(c[4 * g + 2], c[4 * g + 3])};
    }
#pragma unroll
    for (int jt = 0; jt < 2; ++jt) {
        const float pc = PCv[32 * jt + r];
        const bf16x8 fb0 = *(const LAS bf16x8*)(BbarT + (32 * jt + r) * 64 + (8 * hf) * 2), fb1 = *(const LAS bf16x8*)(BbarT + (32 * jt + r) * 64 + (16 + 8 * hf) * 2);
#pragma unroll
        for (int i = 0; i < 2; ++i) {
            f32x16 c;
#pragma unroll
            for (int q = 0; q < 16; ++q) c[q] = 0.f;
            c = __builtin_amdgcn_mfma_f32_32x32x16_bf16(*(const LAS bf16x8*)(Atil + (32 * i + r) * 64 + (8 * hf) * 2), fb0, c, 0, 0, 0);
            c = __builtin_amdgcn_mfma_f32_32x32x16_bf16(*(const LAS bf16x8*)(Atil + (32 * i + r) * 64 + (16 + 8 * hf) * 2), fb1, c, 0, 0, 0);
#pragma unroll
            for (int q = 0; q < 16; ++q) { const int kq = (q & 3) + 8 * (q >> 2) + 4 * hf; c[q] = (c[q] + ((i == jt && kq == r) ? 1.f : 0.f)) * pc; }
#pragma unroll
            for (int g = 0; g < 4; ++g) *(u32x2*)(cbo + CB_PHI + ((32 * jt + r) * 64 + 32 * i + 8 * g + 4 * hf) * 2) = (u32x2){cvtpk(c[4 * g], c[4 * g + 1]), cvtpk(c[4 * g + 2], c[4 * g + 3])};
        }
        {
            f32x16 c;
#pragma unroll
            for (int q = 0; q < 16; ++q) c[q] = bf2f(*(const LAS bf16_t*)(Kbar + (((q & 3) + 8 * (q >> 2) + 4 * hf) * 64 + 32 * jt + r) * 2));
            c = __builtin_amdgcn_mfma_f32_32x32x16_bf16(*(const LAS bf16x8*)(Wv + r * 64 + (8 * hf) * 2), fb0, c, 0, 0, 0);
            c = __builtin_amdgcn_mfma_f32_32x32x16_bf16(*(const LAS bf16x8*)(Wv + r * 64 + (16 + 8 * hf) * 2), fb1, c, 0, 0, 0);
#pragma unroll
            for (int g = 0; g < 4; ++g) *(u32x2*)(cbo + CB_PSI + ((32 * jt + r) * 32 + 8 * g + 4 * hf) * 2) = (u32x2){cvtpk(c[4 * g] * pc, c[4 * g + 1] * pc), cvtpk(c[4 * g + 2] * pc, c[4 * g + 3] * pc)};
        }
    }
    asm volatile("s_waitcnt lgkmcnt(0)" ::: "memory");
}

constexpr int CS_SLOTS = 4, CS_NP = CB_BYTES / 1024;
__device__ __forceinline__ void st_cscan(const P& p, int bh, LAS unsigned char* lds) {
    const int tid = opaque(threadIdx.x), wave = __builtin_amdgcn_readfirstlane(tid >> 6), lane = tid & 63;
    const int b = bh / 6, hh = bh % 6, r = lane & 31, hf = lane >> 5;
    const unsigned char* cb0 = p.cb + (size_t)bh * 64 * CB_BYTES;
    constexpr int NCH = SEQ / 32;
    const int lw = wave - 2;
#define CS_ISSUE(chunk) do { const int _c = (chunk) < NCH ? (chunk) : NCH - 1; const unsigned char* _g = cb0 + (size_t)_c * CB_BYTES + lane * 16; LAS unsigned char* _l = lds + ((chunk) & 3) * CB_BYTES; \
        _Pragma("unroll") for (int _j = 0; _j < 4; ++_j) if (lw + 6 * _j < CS_NP) __builtin_amdgcn_global_load_lds((const unsigned*)(_g + (lw + 6 * _j) * 1024), (LAS unsigned*)(_l + (lw + 6 * _j) * 1024), 16, 0, 0); } while (0)
    f32x16 X0, X1;
#pragma unroll
    for (int i = 0; i < 16; ++i) { X0[i] = 0.f; X1[i] = 0.f; }
    if (wave >= 2) { CS_ISSUE(0); CS_ISSUE(1); CS_ISSUE(2); }
    float* yb = p.y + (size_t)b * SEQ * RWW + hh * 64 + 32 * wave + r;
    for (int c = 0; c < NCH; ++c) {
        if (wave >= 2) { if (lw < 4) asm volatile("s_waitcnt vmcnt(8)" ::: "memory"); else asm volatile("s_waitcnt vmcnt(6)" ::: "memory"); }
        __builtin_amdgcn_s_barrier();
        if (wave >= 2) { CS_ISSUE(c + 3); }
        else {
            const LAS unsigned char* S = lds + (c & 3) * CB_BYTES;
            const int vr = 32 * wave + r;
            const bf16x8 vf0 = *(const LAS bf16x8*)(S + CB_V + vr * 64 + (8 * hf) * 2), vf1 = *(const LAS bf16x8*)(S + CB_V + vr * 64 + (16 + 8 * hf) * 2);
            const LAS unsigned char* rp = S + CB_RT + r * 128;
            const bf16x8 fr0 = lds_perm_frag(rp, 0, hf), fr1 = lds_perm_frag(rp, 1, hf), fr2 = lds_perm_frag(rp + 64, 0, hf), fr3 = lds_perm_frag(rp + 64, 1, hf);
            const bf16x8 fg0 = *(const LAS bf16x8*)(S + CB_G + r * 64 + (8 * hf) * 2), fg1 = *(const LAS bf16x8*)(S + CB_G + r * 64 + (16 + 8 * hf) * 2);
            const LAS unsigned char* p0 = S + CB_PHI + r * 128; const LAS unsigned char* p1 = S + CB_PHI + (32 + r) * 128;
            const bf16x8 fa0 = lds_perm_frag(p0, 0, hf), fa1 = lds_perm_frag(p0, 1, hf), fa2 = lds_perm_frag(p0 + 64, 0, hf), fa3 = lds_perm_frag(p0 + 64, 1, hf);
            const bf16x8 fb0 = lds_perm_frag(p1, 0, hf), fb1 = lds_perm_frag(p1, 1, hf), fb2 = lds_perm_frag(p1 + 64, 0, hf), fb3 = lds_perm_frag(p1 + 64, 1, hf);
            const LAS unsigned char* q0 = S + CB_PSI + r * 64; const LAS unsigned char* q1 = S + CB_PSI + (32 + r) * 64;
            const bf16x8 fp0 = *(const LAS bf16x8*)(q0 + (8 * hf) * 2), fp1 = *(const LAS bf16x8*)(q0 + (16 + 8 * hf) * 2), fp2 = *(const LAS bf16x8*)(q1 + (8 * hf) * 2), fp3 = *(const LAS bf16x8*)(q1 + (16 + 8 * hf) * 2);
            const bf16x8 x00 = acc_frag(X0, 0), x01 = acc_frag(X0, 1), x10 = acc_frag(X1, 0), x11 = acc_frag(X1, 1);
            asm volatile("s_waitcnt lgkmcnt(0)" ::: "memory");
            __builtin_amdgcn_sched_barrier(0);
            f32x16 yc, n0, n1;
#pragma unroll
            for (int i = 0; i < 16; ++i) { yc[i] = 0.f; n0[i] = 0.f; n1[i] = 0.f; }
            n0 = __builtin_amdgcn_mfma_f32_32x32x16_bf16(fa0, x00, n0, 0, 0, 0);
            n1 = __builtin_amdgcn_mfma_f32_32x32x16_bf16(fb0, x00, n1, 0, 0, 0);
            yc = __builtin_amdgcn_mfma_f32_32x32x16_bf16(fr0, x00, yc, 0, 0, 0);
            n0 = __builtin_amdgcn_mfma_f32_32x32x16_bf16(fa1, x01, n0, 0, 0, 0);
            n1 = __builtin_amdgcn_mfma_f32_32x32x16_bf16(fb1, x01, n1, 0, 0, 0);
            yc = __builtin_amdgcn_mfma_f32_32x32x16_bf16(fr1, x01, yc, 0, 0, 0);
            n0 = __builtin_amdgcn_mfma_f32_32x32x16_bf16(fa2, x10, n0, 0, 0, 0);
            n1 = __builtin_amdgcn_mfma_f32_32x32x16_bf16(fb2, x10, n1, 0, 0, 0);
            yc = __builtin_amdgcn_mfma_f32_32x32x16_bf16(fr2, x10, yc, 0, 0, 0);
            n0 = __builtin_amdgcn_mfma_f32_32x32x16_bf16(fa3, x11, n0, 0, 0, 0);
            n1 = __builtin_amdgcn_mfma_f32_32x32x16_bf16(fb3, x11, n1, 0, 0, 0);
            yc = __builtin_amdgcn_mfma_f32_32x32x16_bf16(fr3, x11, yc, 0, 0, 0);
            n0 = __builtin_amdgcn_mfma_f32_32x32x16_bf16(fp0, vf0, n0, 0, 0, 0);
            n1 = __builtin_amdgcn_mfma_f32_32x32x16_bf16(fp2, vf0, n1, 0, 0, 0);
            yc = __builtin_amdgcn_mfma_f32_32x32x16_bf16(fg0, vf0, yc, 0, 0, 0);
            n0 = __builtin_amdgcn_mfma_f32_32x32x16_bf16(fp1, vf1, n0, 0, 0, 0);
            n1 = __builtin_amdgcn_mfma_f32_32x32x16_bf16(fp3, vf1, n1, 0, 0, 0);
            yc = __builtin_amdgcn_mfma_f32_32x32x16_bf16(fg1, vf1, yc, 0, 0, 0);
            X0 = n0; X1 = n1;
#pragma unroll
            for (int i = 0; i < 16; ++i) yb[(size_t)(c * 32 + (i & 3) + 8 * (i >> 2) + 4 * hf) * RWW] = yc[i];
        }
    }
    asm volatile("s_waitcnt vmcnt(0)" ::: "memory");
    __builtin_amdgcn_s_barrier();
#undef CS_ISSUE
}

__device__ __forceinline__ void st_rwout(const P& p, int l, int t, int lane) {
    float y[6], vv[6], gg[6], rk[6];
#pragma unroll
    for (int hh = 0; hh < 6; ++hh) {
        y[hh] = p.y[(size_t)t * RWW + hh * 64 + lane]; vv[hh] = bf2f(*(const bf16_t*)(p.rec + (size_t)t * REC_TB + hh * REC_HB + 768 + lane * 2)); gg[hh] = bf2f(p.g[(size_t)t * RWW + hh * 64 + lane]);
        rk[hh] = *(const float*)(p.rec + (size_t)t * REC_TB + hh * REC_HB + 896);
    }
#pragma unroll
    for (int hh = 0; hh < 6; ++hh) {
        const int c = hh * 64 + lane;
        const float mean = wave_sum(y[hh]) * (1.f / 64.f);
        const float d = y[hh] - mean;
        const float var = wave_sum(d * d) * (1.f / 64.f);
        const float yn = d * rsqrtf(var + 64e-5f) * p.rw_ln_g[l * RWW + c] + p.rw_ln_b[l * RWW + c];
        p.h[(size_t)t * D + c] = (bf16_t)f2bf((yn + rk[hh] * vv[hh]) * gg[hh]);
    }
}

typedef float f32x16 __attribute__((ext_vector_type(16)));
constexpr float ATT_EXIT = -60.f;
__device__ __forceinline__ float xhalf(float x, int lane) { return __builtin_bit_cast(float, __builtin_amdgcn_ds_bpermute((lane ^ 32) << 2, __builtin_bit_cast(int, x))); }
__device__ __forceinline__ void st_attn(const P& p, int l, int item) {
    const int lane = opaque(threadIdx.x) & 63;
    const int qt = item % (SEQ / 32), bh = item / (SEQ / 32), b = bh / 6, hh = bh % 6;
    const int r = lane & 31, hf = lane >> 5;
    const bf16_t* qkb = p.proj + (size_t)b * SEQ * PJB + RWC + hh * 64 + 8 * hf;
    const bf16_t* vtb = p.vt + ((size_t)(b * 6 + hh) * 64 + r) * SEQ + 4 * hf;
    bf16x8 qf[4];
    {
        const bf16_t* qp = qkb + (size_t)(qt * 32 + r) * PJB;
#pragma unroll
        for (int s = 0; s < 4; ++s) {
            u32x4 t4 = *(const u32x4*)(qp + 16 * s);
            unsigned w[4] = {t4.x, t4.y, t4.z, t4.w};
#pragma unroll
            for (int q = 0; q < 4; ++q) { const float lo = bflo(w[q]) * 0.125f, hi = bfhi(w[q]) * 0.125f; w[q] = (__builtin_bit_cast(unsigned, lo) >> 16) | (__builtin_bit_cast(unsigned, hi) & 0xffff0000u); }
            t4.x = w[0]; t4.y = w[1]; t4.z = w[2]; t4.w = w[3];
            qf[s] = __builtin_bit_cast(bf16x8, t4);
        }
    }
    f32x16 o0, o1;
#pragma unroll
    for (int i = 0; i < 16; ++i) { o0[i] = 0.f; o1[i] = 0.f; }
    float R = 0.f;
    bf16x8 kfn[4]; u32x2 vfn[2][2][2];
#define ATT_LOAD(KT) do { const int _k0 = (KT) * 32; const bf16_t* kp = qkb + SBW + (size_t)(_k0 + r) * PJB; \
        _Pragma("unroll") for (int s = 0; s < 4; ++s) kfn[s] = *(const bf16x8*)(kp + 16 * s); \
        _Pragma("unroll") for (int dt = 0; dt < 2; ++dt) _Pragma("unroll") for (int s = 0; s < 2; ++s) { const bf16_t* vp = vtb + (size_t)dt * 32 * SEQ + _k0 + 16 * s; vfn[dt][s][0] = *(const u32x2*)vp; vfn[dt][s][1] = *(const u32x2*)(vp + 8); } } while (0)
    ATT_LOAD(qt);
    for (int kt = qt; kt >= 0; --kt) {
        const int key0 = kt * 32; (void)key0;
        bf16x8 kf[4]; u32x2 vf[2][2][2];
#pragma unroll
        for (int s = 0; s < 4; ++s) kf[s] = kfn[s];
#pragma unroll
        for (int dt = 0; dt < 2; ++dt)
#pragma unroll
            for (int s = 0; s < 2; ++s) { vf[dt][s][0] = vfn[dt][s][0]; vf[dt][s][1] = vfn[dt][s][1]; }
        if (kt > 0) ATT_LOAD(kt - 1);
        f32x16 z;
#pragma unroll
        for (int i = 0; i < 16; ++i) z[i] = 0.f;
#pragma unroll
        for (int s = 0; s < 4; ++s) z = __builtin_amdgcn_mfma_f32_32x32x16_bf16(kf[s], qf[s], z, 0, 0, 0);
        const bool diag = (kt == qt);
        float c[16], gs[4];
#pragma unroll
        for (int gi = 0; gi < 4; ++gi) {
            float run = 0.f;
#pragma unroll
            for (int e = 3; e >= 0; --e) {
                const int reg = gi * 4 + e;
                const float zz = z[reg];
                float L = -(fmaxf(zz, 0.f) + __logf(1.f + __expf(-fabsf(zz))));
                if (diag && !(r > e + 8 * gi + 4 * hf)) L = 0.f;
                run += L; c[reg] = run;
            }
            gs[gi] = run;
        }
        float go[4], pp[4], ob[4], off[4];
#pragma unroll
        for (int gi = 0; gi < 4; ++gi) { go[gi] = xhalf(gs[gi], lane); pp[gi] = gs[gi] + go[gi]; }
        ob[3] = 0.f; ob[2] = pp[3]; ob[1] = pp[3] + pp[2]; ob[0] = ob[1] + pp[1];
#pragma unroll
        for (int gi = 0; gi < 4; ++gi) off[gi] = ob[gi] + (hf == 0 ? go[gi] : 0.f) + R;
        const float total = ob[0] + pp[0];
        unsigned af[8];
#pragma unroll
        for (int i = 0; i < 8; ++i) {
            float a2[2];
#pragma unroll
            for (int q = 0; q < 2; ++q) {
                const int reg = 2 * i + q, gi = reg >> 2, e = reg & 3;
                float a = __expf(z[reg] + c[reg] + off[gi]);
                if (diag && !(r > e + 8 * gi + 4 * hf)) a = 0.f;
                a2[q] = a;
            }
            af[i] = pk2(a2[0], a2[1]);
        }
        R += total;
        const bf16x8 a0 = __builtin_bit_cast(bf16x8, (u32x4){af[0], af[1], af[2], af[3]});
        const bf16x8 a1 = __builtin_bit_cast(bf16x8, (u32x4){af[4], af[5], af[6], af[7]});
        o0 = __builtin_amdgcn_mfma_f32_32x32x16_bf16(__builtin_bit_cast(bf16x8, (u32x4){vf[0][0][0].x, vf[0][0][0].y, vf[0][0][1].x, vf[0][0][1].y}), a0, o0, 0, 0, 0);
        o0 = __builtin_amdgcn_mfma_f32_32x32x16_bf16(__builtin_bit_cast(bf16x8, (u32x4){vf[0][1][0].x, vf[0][1][0].y, vf[0][1][1].x, vf[0][1][1].y}), a1, o0, 0, 0, 0);
        o1 = __builtin_amdgcn_mfma_f32_32x32x16_bf16(__builtin_bit_cast(bf16x8, (u32x4){vf[1][0][0].x, vf[1][0][0].y, vf[1][0][1].x, vf[1][0][1].y}), a0, o1, 0, 0, 0);
        o1 = __builtin_amdgcn_mfma_f32_32x32x16_bf16(__builtin_bit_cast(bf16x8, (u32x4){vf[1][1][0].x, vf[1][1][0].y, vf[1][1][1].x, vf[1][1][1].y}), a1, o1, 0, 0, 0);
        if (__all(R < ATT_EXIT)) break;
    }
#undef ATT_LOAD
    float ss = 0.f;
#pragma unroll
    for (int i = 0; i < 16; ++i) ss += o0[i] * o0[i] + o1[i] * o1[i];
    ss += xhalf(ss, lane);
    const float rs = rsqrtf(ss * (1.f / 64.f) + 1e-6f);
    bf16_t* op = p.h + ((size_t)b * SEQ + qt * 32 + r) * D + RWW + hh * 64 + 4 * hf;
    const float* gn = p.sb_norm_g + l * SBW + hh * 64 + 4 * hf;
#pragma unroll
    for (int gi = 0; gi < 4; ++gi) {
        const f32x4 g0 = *(const f32x4*)(gn + 8 * gi), g1 = *(const f32x4*)(gn + 32 + 8 * gi);
        u32x2 w0, w1;
        w0.x = pk2(o0[4 * gi] * rs * g0[0], o0[4 * gi + 1] * rs * g0[1]); w0.y = pk2(o0[4 * gi + 2] * rs * g0[2], o0[4 * gi + 3] * rs * g0[3]);
        w1.x = pk2(o1[4 * gi] * rs * g1[0], o1[4 * gi + 1] * rs * g1[1]); w1.y = pk2(o1[4 * gi + 2] * rs * g1[2], o1[4 * gi + 3] * rs * g1[3]);
        *(u32x2*)(op + 8 * gi) = w0; *(u32x2*)(op + 32 + 8 * gi) = w1;
    }
}

__device__ __forceinline__ void st_pool(const P& p, int l, int vb, LAS float* PL  ) {
    const int tid = opaque(threadIdx.x);
    const int t0 = vb * 32, s0 = t0 % SEQ;
    {
        const int col = tid & 255, th = tid >> 8, g = col >> 6, win = 2 << g;
        const int sA = s0 + th * 16;
        const bf16_t* u = p.proj + (size_t)(t0 + th * 16) * PJB + RWC + SBC + col;
        float xv[31];
#pragma unroll
        for (int i = 0; i < 31; ++i) { const int s = sA - 15 + i; xv[i] = (s >= 0 && (i >= 15 || 15 - i < win)) ? bf2f(u[(ptrdiff_t)(i - 15) * PJB]) : 0.f; }
        float run = 0.f;
#pragma unroll
        for (int i = 0; i < 15; ++i) run += (15 - i < win) ? xv[i] : 0.f;
#pragma unroll
        for (int j = 0; j < 16; ++j) {
            run += xv[15 + j];
            const int s = sA + j, n = min(s + 1, win);
            PL[(th * 16 + j) * 256 + col] = run / (float)n - xv[15 + j];
            float drop = 0.f;
#pragma unroll
            for (int q = 1; q <= 4; ++q) if (win == (1 << q)) drop = xv[15 + j - (1 << q) + 1];
            run -= drop;
        }
    }
    __syncthreads();
    {
        const int wave = tid >> 6, lane = tid & 63, g = wave & 3, th = wave >> 2;
        float acc[16];
#pragma unroll
        for (int j = 0; j < 16; ++j) acc[j] = 0.f;
        const float* pw = p.pool_w + ((size_t)l * 4 + g) * 64 * 64 + lane;
        for (int c = 0; c < 64; c += 4) {
            const float w0 = pw[c * 64], w1 = pw[(c + 1) * 64], w2 = pw[(c + 2) * 64], w3 = pw[(c + 3) * 64];
#pragma unroll
            for (int j = 0; j < 16; ++j) { const f32x4 x = *(const LAS f32x4*)(PL + (th * 16 + j) * 256 + g * 64 + c); acc[j] += x[0] * w0 + x[1] * w1 + x[2] * w2 + x[3] * w3; }
        }
        const float sc = p.pool_scale[l * PLW + g * 64 + lane];
#pragma unroll
        for (int j = 0; j < 16; ++j) p.h[(size_t)(t0 + th * 16 + j) * D + 768 + g * 64 + lane] = (bf16_t)f2bf(acc[j] * sc);
    }
    __syncthreads();
}

template <bool TOLDS>
__device__ __forceinline__ void norm_row(const float* xr, const float* md  , bf16_t* hrow, LAS float* hl, int lane) {
    f32x4 v[4]; float ss = 0.f;
#pragma unroll
    for (int i = 0; i < 4; ++i) { v[i] = *(const f32x4*)(xr + i * 256 + lane * 4); ss += v[i][0] * v[i][0] + v[i][1] * v[i][1] + v[i][2] * v[i][2] + v[i][3] * v[i][3]; }
    ss = wave_sum(ss);
    const float rs = rsqrtf(ss * (1.f / D) + 1e-6f);
#pragma unroll
    for (int i = 0; i < 4; ++i) {
        const int cidx = i * 256 + lane * 4;
        const f32x4 sh = *(const f32x4*)(md + cidx), sc = *(const f32x4*)(md + 1024 + cidx);
        const f32x4 o = v[i] * rs * (sc + 1.f) + sh;
        u32x2 w; w.x = pk2(o[0], o[1]); w.y = pk2(o[2], o[3]);
        *(u32x2*)(hrow + cidx) = w;
        if constexpr (TOLDS) *(LAS f32x4*)(hl + cidx) = o;
    }
}

__device__ __forceinline__ void split_bf16(const float (&x)[8], bf16x8& hi, bf16x8& lo) {
    unsigned h[4], l[4];
#pragma unroll
    for (int q = 0; q < 4; ++q) {
        const unsigned ph = cvtpk(x[2 * q], x[2 * q + 1]);
        const float r0 = x[2 * q] - bflo(ph), r1 = x[2 * q + 1] - bfhi(ph);
        h[q] = ph; l[q] = cvtpk(r0, r1);
    }
    hi = mk8(h[0], h[1], h[2], h[3]); lo = mk8(l[0], l[1], l[2], l[3]);
}
__device__ __forceinline__ void st_normrouter(const P& p, int l, int vb0, int vbstride, LAS float* L  ) {
    const int tid = opaque(threadIdx.x), wave = tid >> 6, lane = tid & 63;
    const int fr = lane & 15, fq = lane >> 4;
    LAS float* H = L; LAS float* PART = L + 16 * 1024; LAS float* SEL = PART + 8 * 16 * 64; LAS int* lcnt = (LAS int*)(SEL + 16 * 72);
    bf16x8 Bh[4][4], Bl[4][4];
    {
        const float* wr = p.w_router + ((size_t)l * D + wave * 128) * NE;
        const int ll = opaque(lane), fr2 = ll & 15, fq2 = ll >> 4;
#pragma unroll
        for (int ks = 0; ks < 4; ++ks)
#pragma unroll
            for (int nt = 0; nt < 4; ++nt) {
                float x[8];
#pragma unroll
                for (int j = 0; j < 8; ++j) x[j] = wr[(32 * ks + 8 * fq2 + j) * NE + 16 * nt + fr2];
                split_bf16(x, Bh[ks][nt], Bl[ks][nt]);
            }
    }
    const float brt = p.b_router[l * NE + lane];
    for (int vb = vb0; vb < T / 16; vb += vbstride) {
        const int t0 = vb * 16, b = t0 / SEQ;
        const float* md = p.mod + ((size_t)l * 8 + b) * 6144 + 3072;
        if (tid < 64) lcnt[tid] = 0;
        unsigned pfv = 0u;
        if (vb + vbstride < T / 16) pfv = pf_lines(p.xb + (size_t)((vb + vbstride) * 16 + wave * 2) * D, 2 * D * 4, lane);
#pragma unroll
        for (int q = 0; q < 2; ++q) { const int tt = wave * 2 + q; norm_row<true>(p.xb + (size_t)(t0 + tt) * D, md, p.h + (size_t)(t0 + tt) * D, H + tt * 1024, lane); }
        __syncthreads();
        {
            f32x4 acc[4];
#pragma unroll
            for (int nt = 0; nt < 4; ++nt) acc[nt] = (f32x4){0.f, 0.f, 0.f, 0.f};
#pragma unroll
            for (int ks = 0; ks < 4; ++ks) {
                const LAS float* hp = H + fr * 1024 + wave * 128 + 32 * ks + 8 * fq;
                const f32x4 h0 = *(const LAS f32x4*)hp, h1 = *(const LAS f32x4*)(hp + 4);
                const float x[8] = {h0[0], h0[1], h0[2], h0[3], h1[0], h1[1], h1[2], h1[3]};
                bf16x8 ah, al; split_bf16(x, ah, al);
#pragma unroll
                for (int nt = 0; nt < 4; ++nt) {
                    acc[nt] = __builtin_amdgcn_mfma_f32_16x16x32_bf16(ah, Bh[ks][nt], acc[nt], 0, 0, 0);
                    acc[nt] = __builtin_amdgcn_mfma_f32_16x16x32_bf16(ah, Bl[ks][nt], acc[nt], 0, 0, 0);
                    acc[nt] = __builtin_amdgcn_mfma_f32_16x16x32_bf16(al, Bh[ks][nt], acc[nt], 0, 0, 0);
                }
            }
#pragma unroll
            for (int nt = 0; nt < 4; ++nt)
#pragma unroll
                for (int rg = 0; rg < 4; ++rg) PART[(wave * 16 + 4 * fq + rg) * 64 + 16 * nt + fr] = acc[nt][rg];
        }
        __syncthreads();
#pragma unroll
        for (int q = 0; q < 2; ++q) {
            const int tt = wave * 2 + q, t = t0 + tt;
            float logit = 0.f;
#pragma unroll
            for (int w = 0; w < 8; ++w) logit += PART[(w * 16 + tt) * 64 + lane];
            float score = sigmoidf_(logit);
            score = (score == score) ? score : 0.f;
            const float sl = score + brt;
            LAS float* sel = SEL + (wave * 2 + q) * 72; LAS float* gs = sel + 64;
            sel[lane] = sl;
            if (lane < 8) {
                float m1 = -INFINITY, m2 = -INFINITY;
                for (int i = 0; i < 8; ++i) { const float v = sel[lane * 8 + i]; if (v > m1) { m2 = m1; m1 = v; } else if (v > m2) m2 = v; }
                gs[lane] = m1 + m2;
            }
            const int gI = lane >> 3;
            int grank = 0;
            for (int i = 0; i < 8; ++i) { const float v = gs[i]; grank += (v > gs[gI] || (v == gs[gI] && i < gI)) ? 1 : 0; }
            const float msk = (grank < 4) ? sl : -INFINITY;
            sel[lane] = msk;
            int rank = 0;
            for (int i = 0; i < 64; ++i) { const float v = sel[i]; rank += (v > msk || (v == msk && i < lane)) ? 1 : 0; }
            const bool chosen = rank < TOPK;
            const float wsum = wave_sum(chosen ? score : 0.f);
            if (chosen) {
                const int pos = __hip_atomic_fetch_add(&lcnt[lane], 1, __ATOMIC_RELAXED, __HIP_MEMORY_SCOPE_WORKGROUP);
                p.seg[((size_t)lane * 1024 + vb) * 16 + pos] = t * TOPK + rank;
                p.topw[(size_t)t * TOPK + rank] = score / (wsum + 1e-20f) * 2.5f;
            }
        }
        __syncthreads();
        if (tid < 64) p.cnt2[tid * 1024 + vb] = lcnt[tid];
        pf_done(pfv);
        __syncthreads();
    }
}

__device__ __forceinline__ void st_compact(const P& p, int e, LAS int* wt  ) {
    const int tid = opaque(threadIdx.x), wave = tid >> 6, lane = tid & 63;
    const int c0 = p.cnt2[e * 1024 + 2 * tid], c1 = p.cnt2[e * 1024 + 2 * tid + 1], s = c0 + c1;
    int incl = s;
#pragma unroll
    for (int o = 1; o < 64; o <<= 1) { const int v = __builtin_amdgcn_ds_bpermute(((lane - o) & 63) << 2, incl); if (lane >= o) incl += v; }
    if (lane == 63) wt[wave] = incl;
    __syncthreads();
    int base = 0;
    for (int w = 0; w < wave; ++w) base += wt[w];
    const int excl = base + incl - s;
    int* dst = p.list + (size_t)e * T + excl;
    const int* s0 = p.seg + ((size_t)e * 1024 + 2 * tid) * 16;
    for (int j = 0; j < c0; ++j) dst[j] = s0[j];
    for (int j = 0; j < c1; ++j) dst[c0 + j] = s0[16 + j];
    if (tid == NTHREADS - 1) p.cnt[e] = base + incl;
    __syncthreads();
}

__device__ __forceinline__ void st_combine(const P& p, int l, int t, int lane) {
    const int b = t / SEQ;
    const float* gt = p.mod + ((size_t)l * 8 + b) * 6144 + 5120;
    const bf16_t* sl = p.slab + (size_t)t * TOPK * D;
    float* xr = p.xb + (size_t)t * D;
    float xv[16]; float ss = 0.f;
#pragma unroll
    for (int i = 0; i < 2; ++i) {
        const int cidx = i * 512 + lane * 8;
        float f[8];
#pragma unroll
        for (int j = 0; j < 8; ++j) f[j] = 0.f;
#pragma unroll
        for (int s = 0; s < TOPK; ++s) {
            const u32x4 q = *(const u32x4*)(sl + (size_t)s * D + cidx);
            f[0] += bflo(q.x); f[1] += bfhi(q.x); f[2] += bflo(q.y); f[3] += bfhi(q.y); f[4] += bflo(q.z); f[5] += bfhi(q.z); f[6] += bflo(q.w); f[7] += bfhi(q.w);
        }
        const f32x4 x0 = *(const f32x4*)(xr + cidx), x1 = *(const f32x4*)(xr + cidx + 4);
        const f32x4 g0 = *(const f32x4*)(gt + cidx), g1 = *(const f32x4*)(gt + cidx + 4);
#pragma unroll
        for (int j = 0; j < 4; ++j) { xv[i * 8 + j] = x0[j] + g0[j] * f[j]; xv[i * 8 + 4 + j] = x1[j] + g1[j] * f[4 + j]; }
#pragma unroll
        for (int j = 0; j < 8; ++j) ss += xv[i * 8 + j] * xv[i * 8 + j];
    }
    ss = wave_sum(ss);
    const float rs = rsqrtf(ss * (1.f / D) + 1e-6f);
    if (l + 1 < NL) {
        const float* md = p.mod + ((size_t)(l + 1) * 8 + b) * 6144;
#pragma unroll
        for (int i = 0; i < 2; ++i) {
            const int cidx = i * 512 + lane * 8;
            *(f32x4*)(xr + cidx) = (f32x4){xv[i * 8], xv[i * 8 + 1], xv[i * 8 + 2], xv[i * 8 + 3]};
            *(f32x4*)(xr + cidx + 4) = (f32x4){xv[i * 8 + 4], xv[i * 8 + 5], xv[i * 8 + 6], xv[i * 8 + 7]};
            float o[8];
#pragma unroll
            for (int j = 0; j < 8; ++j) o[j] = xv[i * 8 + j] * rs * (1.f + md[1024 + cidx + j]) + md[cidx + j];
            u32x4 w; w.x = pk2(o[0], o[1]); w.y = pk2(o[2], o[3]); w.z = pk2(o[4], o[5]); w.w = pk2(o[6], o[7]);
            *(u32x4*)(p.h + (size_t)t * D + cidx) = w;
        }
    } else {
#pragma unroll
        for (int i = 0; i < 2; ++i) {
            const int cidx = i * 512 + lane * 8;
            const f32x4 g0 = *(const f32x4*)(p.g_final + cidx), g1 = *(const f32x4*)(p.g_final + cidx + 4);
            *(f32x4*)(p.out + (size_t)t * D + cidx) = (f32x4){xv[i * 8] * rs * g0[0], xv[i * 8 + 1] * rs * g0[1], xv[i * 8 + 2] * rs * g0[2], xv[i * 8 + 3] * rs * g0[3]};
            *(f32x4*)(p.out + (size_t)t * D + cidx + 4) = (f32x4){xv[i * 8 + 4] * rs * g1[0], xv[i * 8 + 5] * rs * g1[1], xv[i * 8 + 6] * rs * g1[2], xv[i * 8 + 7] * rs * g1[3]};
        }
    }
}

struct CvtJob { const float* W; bf16_t* WT; int K, N, k0, n0, dst_row0; };
__device__ __forceinline__ void cvt_load(const CvtJob& j, float (&wv)[32], int lane) {
#pragma unroll
    for (int i = 0; i < 32; ++i) wv[i] = j.W[(size_t)(j.k0 + 2 * i + (lane >> 5)) * j.N + j.n0 + (lane & 31)];
}
__device__ __forceinline__ void cvt_store(const CvtJob& j, const float (&wv)[32], LAS float* scr, int lane) {
#pragma unroll
    for (int i = 0; i < 32; ++i) scr[(2 * i + (lane >> 5)) * 33 + (lane & 31)] = wv[i];
    asm volatile("s_waitcnt lgkmcnt(0)" ::: "memory");
    const int c = lane & 7;
#pragma unroll
    for (int q = 0; q < 4; ++q) { const int n = (lane >> 3) + 8 * q; const LAS float* sp = scr + (8 * c) * 33 + n;
        u32x4 o; o.x = pk2(sp[0 * 33], sp[1 * 33]); o.y = pk2(sp[2 * 33], sp[3 * 33]); o.z = pk2(sp[4 * 33], sp[5 * 33]); o.w = pk2(sp[6 * 33], sp[7 * 33]);
        *(u32x4*)(j.WT + (size_t)(j.dst_row0 + n) * j.K + j.k0 + 8 * c) = o; }
    asm volatile("s_waitcnt lgkmcnt(0)" ::: "memory");
}
__device__ __forceinline__ void cvt_item(const float* W, int K, int N, int k0, int n0, bf16_t* WT, int dst_row0, LAS float* scr, int lane) {
    const CvtJob j{W, WT, K, N, k0, n0, dst_row0};
    float wv[32];
    cvt_load(j, wv, lane);
    cvt_store(j, wv, scr, lane);
}
constexpr int CV_IN = 16 * 84, CV_VR = 16, CV_OUT = 16 * 32, CV_DENSE_L = CV_IN + CV_VR + CV_OUT, CV_DENSE = NL * CV_DENSE_L;
__device__ __forceinline__ void cvt_dense_item(const P& p, int it, LAS float* scr, int lane) {
    const int l = it / CV_DENSE_L; int r = it % CV_DENSE_L;
    bf16_t* wti = p.wt_in + (size_t)l * PJB * D;
    if (r < CV_IN) { const int kb = r / 84, nb = r % 84; cvt_item(p.w_in + (size_t)l * D * INC, D, INC, kb * 64, nb * 32, wti, nb * 32, scr, lane); return; }
    r -= CV_IN;
    if (r < CV_VR) {
        if (l == 1) cvt_item(p.w_vres, D, 32, r * 64, 0, wti, INC, scr, lane);
        const int rz0 = (l == 1) ? INC + 32 : INC;
        for (int row = rz0 + (lane >> 3); row < PJB; row += 8) *(u32x4*)(wti + (size_t)row * D + r * 64 + (lane & 7) * 8) = (u32x4){0u, 0u, 0u, 0u};
        return;
    }
    r -= CV_VR;
    { const int kb = r / 32, nb = r % 32; cvt_item(p.w_out + (size_t)l * D * D, D, D, kb * 64, nb * 32, p.wt_out + (size_t)l * D * D, nb * 32, scr, lane); }
}
constexpr int CV_EXP_E = 128 + 128 + 128, CV_EXP = 65 * CV_EXP_E;
__device__ __forceinline__ CvtJob cvt_exp_job(const P& p, int l, int it) {
    const int e = it / CV_EXP_E; int r = it % CV_EXP_E;
    if (r < 256) {
        const int which = r >> 7; r &= 127; const int kb = r >> 3, nb = r & 7;
        const float* W = e < NE ? (which ? p.w_eu : p.w_eg) + ((size_t)l * NE + e) * D * ED : (which ? p.w_su : p.w_sg) + (size_t)l * D * ED;
        const int n0 = nb * 32, pn = n0 >> 7;
        return CvtJob{W, p.wt1 + (size_t)e * 512 * D, D, ED, kb * 64, n0, pn * 256 + which * 128 + (n0 & 127)};
    } else {
        r -= 256; const int kb = r >> 5, nb = r & 31;
        const float* W = e < NE ? p.w_ed + ((size_t)l * NE + e) * ED * D : p.w_sd + (size_t)l * ED * D;
        return CvtJob{W, p.wt2 + (size_t)e * D * ED, ED, D, kb * 64, nb * 32, nb * 32};
    }
}
__device__ __forceinline__ void cvt_exp_stream(const P& p, int l, int first, int stride, LAS float* scr, int lane) {
    if (first >= CV_EXP) return;
    float wa[32], wb[32];
    CvtJob ja = cvt_exp_job(p, l, first), jb = ja;
    cvt_load(ja, wa, lane);
    for (int it = first; it < CV_EXP; it += 2 * stride) {
        const bool hb = it + stride < CV_EXP;
        if (hb) { jb = cvt_exp_job(p, l, it + stride); cvt_load(jb, wb, lane); }
        cvt_store(ja, wa, scr, lane);
        if (!hb) break;
        const bool ha = it + 2 * stride < CV_EXP;
        if (ha) { ja = cvt_exp_job(p, l, it + 2 * stride); cvt_load(ja, wa, lane); }
        cvt_store(jb, wb, scr, lane);
        if (!ha) break;
    }
}

#define XB_TMO      128
#define XB_XCNT(j)  (256  + 64 * (j))
#define XB_XSUB(j)  (1280 + 64 * (j))
#define XB_XGEN(j)  (2304 + 64 * (j))
#define XB_TOP      3328
#define XB_TOPGEN   3392
#define XCD_BAR_WORDS 3456
#define XB_SPIN_CAP (1u << 22)
__device__ __forceinline__ unsigned xb_ld(unsigned* p)              { return __hip_atomic_load(p, __ATOMIC_RELAXED, __HIP_MEMORY_SCOPE_AGENT); }
__device__ __forceinline__ unsigned xb_add(unsigned* p, unsigned v) { return __hip_atomic_fetch_add(p, v, __ATOMIC_RELAXED, __HIP_MEMORY_SCOPE_AGENT); }
__device__ __forceinline__ unsigned xb_xcc_id() { return (unsigned)__builtin_amdgcn_s_getreg((3 << 11) | 20) & 0xFu; }
#define XB_SPIN(cond, bar) do { unsigned _sp = 0; while (cond) { __builtin_amdgcn_s_sleep(1); \
    if ((++_sp & 255u) == 0u) { if (xb_ld(&(bar)[XB_TMO])) break; if (_sp > XB_SPIN_CAP) { atomicAdd(&(bar)[XB_TMO], 1u); break; } } } } while (0)
struct XcdBarrier { unsigned* bar; unsigned x; volatile LAS unsigned* st; };
__device__ __forceinline__ XcdBarrier xcd_barrier_post(unsigned* bar, volatile LAS unsigned* st) {
    XcdBarrier b; b.bar = bar; b.x = xb_xcc_id(); b.st = st;
    if (threadIdx.x == 0) (void)xb_add(&bar[XB_XCNT(b.x)], 1u);
    return b;
}
__device__ __forceinline__ void xcd_barrier_complete(unsigned* bar, unsigned x, unsigned& nloc, unsigned& nx) {
    const unsigned G = gridDim.x * gridDim.y * gridDim.z;
    unsigned sum, cnt, mine, sp = 0u;
    for (;;) {
        sum = 0u; cnt = 0u; mine = 0u;
#pragma unroll
        for (unsigned j = 0; j < 16; ++j) { const unsigned c = xb_ld(&bar[XB_XCNT(j)]); sum += c; cnt += (c > 0u) ? 1u : 0u; mine = (j == x) ? c : mine; }
        if (sum == G) break;
        __builtin_amdgcn_s_sleep(1);
        if ((++sp & 255u) == 0u) { if (xb_ld(&bar[XB_TMO])) break; if (sp > XB_SPIN_CAP) { atomicAdd(&bar[XB_TMO], 1u); break; } }
    }
    nloc = mine > 0u ? mine : 1u; nx = cnt > 0u ? cnt : 1u;
}
__device__ __forceinline__ void xcd_barrier(const XcdBarrier& b0) {
    XcdBarrier b = b0; { unsigned xx = b0.x; asm volatile("" : "+s"(xx)); b.x = xx; }
    asm volatile("s_waitcnt vmcnt(0)" ::: "memory");
    __syncthreads();
    if (threadIdx.x == 0) {
        unsigned* bar = b.bar;
        __builtin_amdgcn_s_waitcnt(0);
        unsigned nloc = b.st[0], nx = b.st[1];
        if (nloc == 0u) { xcd_barrier_complete(bar, b.x, nloc, nx); b.st[0] = nloc; b.st[1] = nx; }
        const unsigned old = xb_add(&bar[XB_XSUB(b.x)], 1u);
        const unsigned gen = old / nloc;
        if (old + 1u == (gen + 1u) * nloc) {
            __builtin_amdgcn_fence(__ATOMIC_RELEASE, "agent");
            asm volatile("s_waitcnt vmcnt(0)" ::: "memory");
            const unsigned og = xb_add(&bar[XB_TOP], 1u);
            const unsigned tg = og / nx;
            if (og + 1u == (tg + 1u) * nx) xb_add(&bar[XB_TOPGEN], 1u);
            else XB_SPIN(xb_ld(&bar[XB_TOPGEN]) == tg, bar);
            __builtin_amdgcn_fence(__ATOMIC_ACQUIRE, "agent");
            xb_add(&bar[XB_XGEN(b.x)], 1u);
            asm volatile("s_waitcnt vmcnt(0)" ::: "memory");
        } else {
            XB_SPIN(xb_ld(&bar[XB_XGEN(b.x)]) == gen, bar);
            __builtin_amdgcn_fence(__ATOMIC_ACQUIRE, "agent");
            asm volatile("s_waitcnt vmcnt(0)" ::: "memory");
        }
    }
    __syncthreads();
}

__device__ __forceinline__ P load_args() {
    P q{};
#if defined(__HIP_DEVICE_COMPILE__)
    const __attribute__((address_space(4))) unsigned long long* k = (const __attribute__((address_space(4))) unsigned long long*)__builtin_amdgcn_kernarg_segment_ptr();
    asm volatile("" : "+s"(k));
    unsigned long long w[sizeof(P) / 8];
#pragma unroll
    for (unsigned i = 0; i < sizeof(P) / 8; ++i) w[i] = k[i];
    __builtin_memcpy(&q, w, sizeof(P));
#endif
    return q;
}
enum Ph { PH_NORM1 = 0, PH_INPROJ, PH_PREP, PH_CPRE, PH_MIX, PH_RWOUT, PH_OUTPROJ, PH_ROUTER, PH_COMPACT, PH_EXP1, PH_EXP2, PH_COMBINE, PH_PER_LAYER };

__global__ void __launch_bounds__(NTHREADS, 2) k_fused(P p_arg) {
    (void)p_arg;
#define KARGS() load_args()
    extern __shared__ __attribute__((aligned(16))) unsigned char lds_raw[];
    LAS unsigned char* lds = (LAS unsigned char*)lds_raw;
    LAS int* tstart = (LAS int*)(lds + LDS_STAGE);
    LAS int* cnts = (LAS int*)(lds + LDS_STAGE + 272);
    volatile LAS unsigned* bst = (volatile LAS unsigned*)(lds + LDS_STAGE + 1008);
    if (threadIdx.x < 4) bst[threadIdx.x] = 0u;
    __syncthreads();
    XcdBarrier xb = xcd_barrier_post(load_args().bar, bst);
#define PHASE_COORDS() int G = gridDim.x, bx = blockIdx.x; asm volatile("" : "+s"(G), "+s"(bx)); const int vcu = (G % 8 == 0) ? (bx % 8) * (G / 8) + bx / 8 : bx; (void)vcu; \
    const int tid = opaque(threadIdx.x), half = tid >> 8, lane = tid & 63, wave = __builtin_amdgcn_readfirstlane(tid >> 6); \
    float* smem = (float*)lds_raw + half * 8192; LAS float* scr = (LAS float*)(lds + wave * 16384); (void)lane; (void)smem; (void)scr; (void)tid

    for (int rep = 0; rep < (REP_PH == -1 ? REP_N : 1); ++rep) {
        const P p = KARGS();
        PHASE_COORDS();
        for (int it = bx; it < NL * 96; it += G) st_mod(p, it, (LAS float*)lds);
        __syncthreads();
        for (int it = (bx * 8 + wave); it < CV_DENSE; it += G * 8) cvt_dense_item(p, it, scr, lane);
        xcd_barrier(xb);
    }

    constexpr int NPH2 = NL * PH_PER_LAYER + ((REP_PH >= 0) ? REP_N - 1 : 0);
    for (int ph2 = 0; ph2 < NPH2; ++ph2) {
      {
        const int ph = (REP_PH < 0 || ph2 <= REP_PH) ? ph2 : (ph2 < REP_PH + REP_N ? REP_PH : ph2 - (REP_N - 1));
        const int rep = (REP_PH >= 0 && ph2 > REP_PH && ph2 < REP_PH + REP_N) ? 1 : 0; (void)rep;
        const int l = ph / PH_PER_LAYER, st = ph % PH_PER_LAYER;
        const P p = KARGS();
        PHASE_COORDS();
        if (st == PH_NORM1) {
            if (l == 0) {
                for (int t = bx * 8 + wave; t < T; t += G * 8) {
                    const int tn = t + G * 8; unsigned pfv = 0u;
                    if (tn < T) pfv = pf_lines(p.x + (size_t)tn * D, D * 4, lane);
                    norm_row<false>(p.x + (size_t)t * D, p.mod + (size_t)(t / SEQ) * 6144, p.h + (size_t)t * D, (LAS float*)lds, lane);
                    pf_done(pfv);
                }
            }
        } else if (st == PH_INPROJ) {
            pg8::DenseOrder S; S.init(p.h, p.wt_in + (size_t)l * PJB * D, T, PJB, D, G, bx);
            pg8::EpiProj E{p.proj, p.vt};
            pg8::gemm_phase<pg8::EpiProj, pg8::DenseOrder, true, true>(lds, D, S, E);
        } else if (st == PH_PREP) {
            st_prep(p, l, bx, G, (LAS float*)lds);
        } else if (st == PH_CPRE) {
            if (wave < CP_WAVES) for (int it = bx * CP_WAVES + wave; it < NBATCH * 6 * (SEQ / 32); it += G * CP_WAVES) st_cpre(p, it, lds + wave * CP_LDS, lane);
        } else if (st == PH_MIX) {
            constexpr int N1 = NBATCH * 6, N2 = NBATCH * 6 * (SEQ / 32) / 8, N3 = T / 32, N4 = (CV_EXP + 7) / 8;
            const int sel = (rep == 0) ? 15 : REP_SEL;
            if (sel & 1) for (int wb = bx; wb < N1; wb += G) st_cscan(p, wb, lds);
            __syncthreads();
            for (int wb = bx; wb < N2 + N3; wb += G) {
                if (wb < N2) { if (sel & 2) st_attn(p, l, wb * 8 + wave); }
                else if (sel & 4) st_pool(p, l, wb - N2, (LAS float*)lds);
            }
            (void)N4;
            if (sel & 8) cvt_exp_stream(p, l, bx * 8 + wave, G * 8, scr, lane);
        } else if (st == PH_RWOUT) {
            for (int t = bx * 8 + wave; t < T; t += G * 8) {
                const int tn = t + G * 8; unsigned pfv = 0u;
                if (tn < T) pfv = pf_lines(p.y + (size_t)tn * RWW, RWW * 4, lane) + pf_lines(p.rec + (size_t)tn * REC_TB, REC_TB, lane) + pf_lines(p.g + (size_t)tn * RWW, RWW * 2, lane);
                st_rwout(p, l, t, lane);
                pf_done(pfv);
            }
        } else if (st == PH_OUTPROJ) {
            pg8::DenseOrder S; S.init(p.h, p.wt_out + (size_t)l * D * D, T, D, D, G, bx);
            pg8::EpiOut E{l == 0 ? p.x : p.xb, p.xb, p.mod + (size_t)l * 8 * 6144 + 2048};
            pg8::gemm_phase<pg8::EpiOut, pg8::DenseOrder, true, true>(lds, D, S, E);
        } else if (st == PH_ROUTER) {
            st_normrouter(p, l, bx, G, (LAS float*)lds);
        } else if (st == PH_COMPACT) {
            if (bx < NE) st_compact(p, bx, (LAS int*)lds);
        } else if (st == PH_EXP1 || st == PH_EXP2) {
            __syncthreads();
            if (tid == 0) {
                int acc = 0;
                for (int e = 0; e < 65; ++e) { const int c = e < NE ? p.cnt[e] : T; cnts[e] = c; tstart[e] = acc; acc += (c + 255) >> 8; }
                tstart[65] = acc;
            }
            __syncthreads();
            if (st == PH_EXP1) {
                pg8::MoeOrder<true> S{tstart, cnts, p.list, p.h, p.wt1, D, 512, 1, G, vcu};
                pg8::EpiExp1 E{p.hm};
                pg8::gemm_phase<pg8::EpiExp1, pg8::MoeOrder<true>, true, true>(lds, D, S, E);
            } else {
                pg8::MoeOrder<false> S{tstart, cnts, p.list, p.hm, p.wt2, ED, D, 2, G, vcu};
                pg8::EpiExp2 E{p.slab, p.xb, p.mod + (size_t)l * 8 * 6144 + 5120, p.list, p.topw, cnts, rep};
                pg8::gemm_phase<pg8::EpiExp2, pg8::MoeOrder<false>, true, true>(lds, ED, S, E);
            }
        } else {
            for (int t = bx * 8 + wave; t < T; t += G * 8) {
                const int tn = t + G * 8; unsigned pfv = 0u;
                if (tn < T) pfv = pf_lines(p.slab + (size_t)tn * TOPK * D, TOPK * D * 2, lane) + pf_lines(p.xb + (size_t)tn * D, D * 4, lane);
                st_combine(p, l, t, lane);
                pf_done(pfv);
            }
        }
        if (!(ph2 == NPH2 - 1)) { if (!(st == PH_NORM1 && l > 0)) xcd_barrier(xb); }
      }
    }
#undef PHASE_COORDS
#undef KARGS
}

}

extern "C" void kernel_launch(void* const* d_in, const int* in_sizes, int n_in, void* d_out, int out_size, void* d_ws, size_t ws_size,
                              hipStream_t stream) {
    P p{};
    const float** fp = (const float**)&p;
    for (int i = 0; i < 33; ++i) fp[i] = (const float*)d_in[i];
    p.out = (float*)d_out;
    char* ws = (char*)d_ws;
    size_t off = 0;
    auto take = [&](size_t bytes) { char* r = ws + off; off += (bytes + 255) & ~(size_t)255; return r; };
    p.bar = (unsigned*)take(16384);
    p.cnt = (int*)take(256);
    p.mod = (float*)take((size_t)NL * 8 * 6144 * 4);
    p.list = (int*)take((size_t)NE * T * 4);
    p.cnt2 = (int*)take((size_t)NE * 1024 * 4);
    p.seg = (int*)take((size_t)NE * 1024 * 16 * 4);
    p.topw = (float*)take((size_t)T * TOPK * 4);
    p.wt_in = (bf16_t*)take((size_t)NL * PJB * D * 2);
    p.wt_out = (bf16_t*)take((size_t)NL * D * D * 2);
    p.wt1 = (bf16_t*)take((size_t)65 * 512 * D * 2);
    p.wt2 = (bf16_t*)take((size_t)65 * D * ED * 2);
    p.xb = (float*)take((size_t)T * D * 4);
    p.h = (bf16_t*)take((size_t)T * D * 2);
    p.vfirst = (bf16_t*)take((size_t)T * RWW * 2);
    const size_t ov = off;
    p.proj = (bf16_t*)take((size_t)T * PJB * 2);
    p.vt = (bf16_t*)take((size_t)T * SBW * 2);
    p.rec = (unsigned char*)take((size_t)T * REC_TB);
    p.g = (bf16_t*)take((size_t)T * RWW * 2);
    p.y = (float*)take((size_t)T * RWW * 4);
    p.cb = (unsigned char*)take((size_t)NBATCH * 6 * (SEQ / 32) * CB_BYTES);
    p.hm = (bf16_t*)(ws + ov);
    p.slab = (bf16_t*)(ws + ov + (size_t)MAXRT * 256 * ED * 2);
    const size_t end_moe = ov + (size_t)MAXRT * 256 * ED * 2 + (size_t)T * TOPK * D * 2;
    if (end_moe > off) off = end_moe;
    if (off > ws_size) { fprintf(stderr, "kernel_launch: workspace too small: need %zu, have %zu\n", off, ws_size); return; }

    static int cus = 0;
    if (cus == 0) {
        int dev = 0, n = 0;
        if (hipGetDevice(&dev) != hipSuccess || hipDeviceGetAttribute(&n, hipDeviceAttributeMultiprocessorCount, dev) != hipSuccess || n <= 0) n = 256;
        (void)hipFuncSetAttribute((const void*)k_fused, hipFuncAttributeMaxDynamicSharedMemorySize, LDS_BYTES);
        cus = n;
    }
    (void)hipMemsetAsync(p.bar, 0, 16384 + 256, stream);
    void* args[] = {(void*)&p};
    (void)hipLaunchCooperativeKernel((const void*)k_fused, dim3(cus), dim3(NTHREADS), args, LDS_BYTES, stream);
}
```

```cpp
#include <hip/hip_runtime.h>
#include <stdint.h>
#include <stdio.h>

#define REP_PH -2
#define REP_N 1
#define REP_SEL 15

namespace {

typedef unsigned short bf16_t;
typedef short bf16x8 __attribute__((ext_vector_type(8)));
typedef float f32x4 __attribute__((ext_vector_type(4)));
typedef float f32x2 __attribute__((ext_vector_type(2)));
typedef unsigned u32x4 __attribute__((ext_vector_type(4)));
typedef unsigned u32x2 __attribute__((ext_vector_type(2)));
#define LAS __attribute__((address_space(3)))

constexpr int D = 1024, NBATCH = 8, SEQ = 2048, T = NBATCH * SEQ, NL = 2;
constexpr int RWW = 384, SBW = 384, PLW = 256;
constexpr int RWC = 1280, SBC = 1152, INC = 2688;
constexpr int PJB = 2816;
constexpr int NE = 64, TOPK = 6, ED = 256;
constexpr int MAXRT = 512;
constexpr int NTHREADS = 512;
constexpr int LDS_STAGE = 131072, LDS_CTL = 1024, LDS_BYTES = LDS_STAGE + LDS_CTL;

struct P {
    const float *x, *c, *w_ada, *b_ada, *w_in, *w_vres, *mu_rw, *mu_vres, *rw_w0, *rw_w2, *rw_a0, *rw_a2,
        *rw_v0, *rw_v2, *rw_g2, *rw_k_k, *rw_k_a, *rw_r_k, *rw_ln_g, *rw_ln_b, *sb_norm_g, *pool_w, *pool_scale,
        *w_out, *w_router, *b_router, *w_eg, *w_eu, *w_ed, *w_sg, *w_su, *w_sd, *g_final;
    float* out;
    unsigned* bar;
    float* mod;
    int* cnt;
    int* list;
    int* cnt2;
    int* seg;
    float* topw;
    bf16_t* wt_in;
    bf16_t* wt_out;
    bf16_t* lwt;
    bf16_t* wt1;
    bf16_t* wt2;
    float* xb;
    bf16_t* h;
    bf16_t* vfirst;
    bf16_t* proj;
    bf16_t* vt;
    unsigned char* rec;
    unsigned char* cb;
    bf16_t* g;
    float* y;
    bf16_t* hm;
    bf16_t* slab;
};

__device__ __forceinline__ int opaque(int x) { asm volatile("" : "+v"(x)); return x; }
__device__ __forceinline__ float dpp_add16(float x) {
    x += __builtin_bit_cast(float, __builtin_amdgcn_update_dpp(0, __builtin_bit_cast(int, x), 0xB1, 0xF, 0xF, true));
    x += __builtin_bit_cast(float, __builtin_amdgcn_update_dpp(0, __builtin_bit_cast(int, x), 0x4E, 0xF, 0xF, true));
    x += __builtin_bit_cast(float, __builtin_amdgcn_update_dpp(0, __builtin_bit_cast(int, x), 0x141, 0xF, 0xF, true));
    x += __builtin_bit_cast(float, __builtin_amdgcn_update_dpp(0, __builtin_bit_cast(int, x), 0x140, 0xF, 0xF, true));
    return x;
}
__device__ __forceinline__ float wave_sum(float v) {
    v = dpp_add16(v);
    const int vi = __builtin_bit_cast(int, v);
    return (__builtin_bit_cast(float, __builtin_amdgcn_readlane(vi, 0)) + __builtin_bit_cast(float, __builtin_amdgcn_readlane(vi, 16)))
         + (__builtin_bit_cast(float, __builtin_amdgcn_readlane(vi, 32)) + __builtin_bit_cast(float, __builtin_amdgcn_readlane(vi, 48)));
}
typedef __bf16 bf16x2_t __attribute__((ext_vector_type(2)));
__device__ __forceinline__ unsigned cvtpk(float lo, float hi) { const f32x2 v = {lo, hi}; const bf16x2_t b = __builtin_convertvector(v, bf16x2_t); return __builtin_bit_cast(unsigned, b); }
__device__ __forceinline__ bf16x8 mk8(unsigned a, unsigned b, unsigned c, unsigned d) { return __builtin_bit_cast(bf16x8, (u32x4){a, b, c, d}); }
__device__ __forceinline__ unsigned pf_lines(const void* p, int nbytes, int lane) {
    unsigned acc = 0u;
    for (int off = lane * 128; off < nbytes; off += 8192) acc += *(const unsigned*)((const char*)p + off);
    return acc;
}
__device__ __forceinline__ void pf_done(unsigned v) { asm volatile("" :: "v"(v)); }
__device__ __forceinline__ float sigmoidf_(float x) { return 1.f / (1.f + __expf(-x)); }
__device__ __forceinline__ float softplusf_(float x) { return fmaxf(x, 0.f) + __logf(1.f + __expf(-fabsf(x))); }
__device__ __forceinline__ float siluf_(float x) { return x / (1.f + __expf(-x)); }
__device__ __forceinline__ unsigned f2bf(float f) { unsigned u = __builtin_bit_cast(unsigned, f); return (u + 0x7fffu + ((u >> 16) & 1u)) >> 16; }
__device__ __forceinline__ unsigned pk2(float lo, float hi) { return f2bf(lo) | (f2bf(hi) << 16); }
__device__ __forceinline__ float bf2f(bf16_t h) { return __builtin_bit_cast(float, (unsigned)h << 16); }
__device__ __forceinline__ float bflo(unsigned u) { return __builtin_bit_cast(float, u << 16); }
__device__ __forceinline__ float bfhi(unsigned u) { return __builtin_bit_cast(float, u & 0xffff0000u); }

namespace pg8 {
constexpr int BM = 256, BK = 64, HALF = 128, HTB = HALF * BK * 2, STAGE_BYTES = 8 * HTB;
__device__ __forceinline__ int lds_byte(int r, int c) { const int st = (r >> 4) * 2 + (c >> 5), rr = r & 15, cc = c & 31, ob = rr * 64 + cc * 2; return st * 1024 + (ob ^ (((ob >> 9) & 1) << 5)); }
__device__ __forceinline__ void stage_rc(int b, int& R, int& C) { const int st = b / 1024, sb = b % 1024, swz = sb ^ (((sb >> 9) & 1) << 5); R = (st >> 1) * 16 + swz / 64; C = (st & 1) * 32 + (swz % 64) / 2; }
__device__ __forceinline__ int perm32(int rho) { const int n = rho >> 4, i = rho & 15; return 8 * (i >> 2) + 4 * n + (i & 3); }

struct Unit { int pm, pn, e, mt; };

template <class Epi, class Sched, bool ALIGN_EPI, bool SP2>
__device__ __forceinline__ void gemm_phase(LAS unsigned char* lds, const int K, const Sched& S, const Epi& E) {
    const int tid = opaque(threadIdx.x), wid = __builtin_amdgcn_readfirstlane(tid >> 6), lane = tid & 63, wr = wid >> 2, wc = wid & 3, fr = lane & 15, fq = lane >> 4;
    const int nt = K / BK;
    unsigned voffA[2], voffB[2];
#pragma unroll
    for (int i = 0; i < 2; ++i) { int R, C; stage_rc(tid * 16 + i * 8192, R, C); const int Rb = Epi::PERM ? ((R & ~31) + perm32(R & 31)) : R;
        voffA[i] = Sched::GATHER ? (unsigned)(C * 2) : (unsigned)(R * K + C) * 2u; voffB[i] = (unsigned)(Rb * K + C) * 2u; }
    const size_t kstep = (size_t)(BK * 2);
    const size_t hstep = (size_t)HALF * K * 2;
    const unsigned ldsw = (unsigned)wid * 1024u;
    const int aoff = lds_byte(wr * 64 + fr, fq * 8), boff = lds_byte(wc * 32 + fr, fq * 8);
#define PG8_SA(b, h) (((b) * 2 + (h)) * HTB)
#define PG8_SB(b, h) ((4 + (b) * 2 + (h)) * HTB)
#define PG8_STAGE(bufoff, gbase, voff) do { _Pragma("unroll") for (int _i = 0; _i < 2; ++_i) \
        __builtin_amdgcn_global_load_lds((const unsigned*)((const char*)(gbase) + (voff)[_i]), (LAS unsigned*)(lds + (bufoff) + ldsw + _i * 8192), 16, 0, 0); } while (0)
#define PG8_LDA(dst, b, h) do { _Pragma("unroll") for (int m = 0; m < 4; ++m) _Pragma("unroll") for (int k = 0; k < 2; ++k) dst[m][k] = *(const LAS bf16x8*)(lds + PG8_SA(b, h) + aoff + m * 2048 + k * 1024); } while (0)
#define PG8_LDB(dst, b, h) do { _Pragma("unroll") for (int n = 0; n < 2; ++n) _Pragma("unroll") for (int k = 0; k < 2; ++k) dst[n][k] = *(const LAS bf16x8*)(lds + PG8_SB(b, h) + boff + n * 2048 + k * 1024); } while (0)
#define PG8_MMA(ai, bj, At, Bt) do { __builtin_amdgcn_s_setprio(1); _Pragma("unroll") for (int m = 0; m < 4; ++m) _Pragma("unroll") for (int n = 0; n < 2; ++n) _Pragma("unroll") for (int k = 0; k < 2; ++k) \
        acc[ai][bj][m][n] = __builtin_amdgcn_mfma_f32_16x16x32_bf16(Bt[n][k], At[m][k], acc[ai][bj][m][n], 0, 0, 0); __builtin_amdgcn_s_setprio(0); } while (0)
#define PG8_WAIT_V(n) asm volatile("s_waitcnt vmcnt(" #n ")" ::: "memory")
#define PG8_WAIT_L(n) asm volatile("s_waitcnt lgkmcnt(" #n ")" ::: "memory")
#define PG8_BAR __builtin_amdgcn_s_barrier()
#define PG8_SCHED __builtin_amdgcn_sched_barrier(0)
    Unit cur, nxt; int ui = 0;
    if (!S.next(0, cur)) return;
    f32x4 acc[2][2][4][2];
#pragma unroll
    for (int a = 0; a < 2; ++a)
#pragma unroll
        for (int b = 0; b < 2; ++b)
#pragma unroll
            for (int m = 0; m < 4; ++m)
#pragma unroll
                for (int n = 0; n < 2; ++n) acc[a][b][m][n] = (f32x4){0.f, 0.f, 0.f, 0.f};
    bf16x8 At[4][2], B0[2][2], B1[2][2];
    const char* cA = S.a_base(cur); const char* cB = S.b_base(cur);
    unsigned pk[2] = {0u, 0u}, npk[2] = {0u, 0u};
    if constexpr (Sched::GATHER) S.a_tok(cur, tid, pk);
    const unsigned k2 = (unsigned)K * 2u;
#define PG8_STAGE_A(bufoff, gbase, hh, PK) do { if constexpr (Sched::GATHER) { unsigned _v[2]; _v[0] = (((PK)[0] >> (16 * (hh))) & 0xffffu) * k2 + voffA[0]; _v[1] = (((PK)[1] >> (16 * (hh))) & 0xffffu) * k2 + voffA[1]; \
        PG8_STAGE(bufoff, gbase, _v); } else { PG8_STAGE(bufoff, (gbase) + (hh) * hstep, voffA); } } while (0)
    static_assert(SP2, "only the SP2 loop is kept");
    PG8_STAGE(PG8_SB(0, 0), cB, voffB); PG8_STAGE(PG8_SB(0, 1), cB + hstep, voffB); PG8_STAGE_A(PG8_SA(0, 0), cA, 0, pk); PG8_STAGE_A(PG8_SA(0, 1), cA, 1, pk);
    if (wr == 1) PG8_BAR;
    PG8_WAIT_V(2); PG8_BAR;
    PG8_STAGE(PG8_SB(1, 0), cB + kstep, voffB); PG8_STAGE_A(PG8_SA(1, 0), cA + kstep, 0, pk); PG8_STAGE(PG8_SB(1, 1), cB + hstep + kstep, voffB);
    PG8_WAIT_V(6); PG8_BAR;
    for (;;) {
        const bool has_next = S.next(ui + 1, nxt);
        const char* nA = has_next ? S.a_base(nxt) : cA; const char* nB = has_next ? S.b_base(nxt) : cB;
        if constexpr (Sched::GATHER) { if (has_next) S.a_tok(nxt, tid, npk); else { npk[0] = pk[0]; npk[1] = pk[1]; } }
#pragma unroll 1
        for (int t = 0; t < nt; t += 2) {
            const bool last = (t == nt - 2);
            const char* a1 = cA + (size_t)(t + 1) * kstep;
            const char* a2 = last ? nA : cA + (size_t)(t + 2) * kstep; const char* b2 = last ? nB : cB + (size_t)(t + 2) * kstep;
            const char* a3 = a2 + kstep; const char* b3 = b2 + kstep;
            unsigned sp[2]; sp[0] = last ? npk[0] : pk[0]; sp[1] = last ? npk[1] : pk[1];
            PG8_LDB(B0, 0, 0); PG8_LDB(B1, 0, 1); PG8_SCHED; PG8_LDA(At, 0, 0); PG8_STAGE_A(PG8_SA(1, 1), a1, 1, pk);
            PG8_WAIT_V(8); PG8_WAIT_L(0); PG8_BAR; PG8_MMA(0, 0, At, B0); PG8_MMA(0, 1, At, B1); PG8_BAR; PG8_SCHED;
            PG8_LDA(At, 0, 1); PG8_STAGE(PG8_SB(0, 0), b2, voffB); PG8_STAGE(PG8_SB(0, 1), b2 + hstep, voffB); PG8_STAGE_A(PG8_SA(0, 0), a2, 0, sp);
            PG8_WAIT_V(8); PG8_WAIT_L(0); PG8_BAR; PG8_MMA(1, 0, At, B0); PG8_MMA(1, 1, At, B1); PG8_BAR; PG8_SCHED;
            PG8_LDB(B0, 1, 0); PG8_LDB(B1, 1, 1); PG8_SCHED; PG8_LDA(At, 1, 0); PG8_STAGE_A(PG8_SA(0, 1), a2, 1, sp);
            PG8_WAIT_V(8); PG8_WAIT_L(0); PG8_BAR; PG8_MMA(0, 0, At, B0); PG8_MMA(0, 1, At, B1); PG8_BAR; PG8_SCHED;
            PG8_LDA(At, 1, 1); PG8_STAGE(PG8_SB(1, 0), b3, voffB); PG8_STAGE(PG8_SB(1, 1), b3 + hstep, voffB); PG8_STAGE_A(PG8_SA(1, 0), a3, 0, sp);
            PG8_WAIT_V(8); PG8_WAIT_L(0); PG8_BAR; PG8_MMA(1, 0, At, B0); PG8_MMA(1, 1, At, B1); PG8_BAR; PG8_SCHED;
        }
        if constexpr (ALIGN_EPI) { if (wr == 0) PG8_BAR; }
        { const int t2 = opaque(threadIdx.x), w2 = __builtin_amdgcn_readfirstlane(t2 >> 6), l2 = t2 & 63; E(acc, cur, w2 >> 2, w2 & 3, l2 & 15, l2 >> 4); }
        if (!has_next) break;
#pragma unroll
        for (int a = 0; a < 2; ++a)
#pragma unroll
            for (int b = 0; b < 2; ++b)
#pragma unroll
                for (int m = 0; m < 4; ++m)
#pragma unroll
                    for (int n = 0; n < 2; ++n) acc[a][b][m][n] = (f32x4){0.f, 0.f, 0.f, 0.f};
        cur = nxt; cA = nA; cB = nB; ++ui;
        pk[0] = npk[0]; pk[1] = npk[1];
        if constexpr (ALIGN_EPI) { if (wr == 1) PG8_BAR; }
    }
    PG8_WAIT_V(0);
    if constexpr (!ALIGN_EPI) { if (wr == 0) PG8_BAR; }
    PG8_BAR;
#undef PG8_SA
#undef PG8_SB
#undef PG8_STAGE
#undef PG8_STAGE_A
#undef PG8_LDA
#undef PG8_LDB
#undef PG8_MMA
#undef PG8_WAIT_V
#undef PG8_WAIT_L
#undef PG8_BAR
#undef PG8_SCHED
}

struct DenseOrder {
    const bf16_t* A; const bf16_t* Bt; int K; int nM, nN, nwg, G, c;
    __device__ __forceinline__ void init(const bf16_t* A_, const bf16_t* Bt_, int M, int N, int K_, int G_, int c_) { A = A_; Bt = Bt_; K = K_; nM = M / BM; nN = N / BM; nwg = nM * nN; G = G_; c = c_; }
    __device__ __forceinline__ bool next(int i, Unit& u) const {
        const long L = (long)i * G + c; if (L >= nwg) return false;
        int wgid = (int)L; { const int q = nwg / 8, r = nwg % 8, xcd = wgid % 8, off = wgid / 8; wgid = (xcd < r ? xcd * (q + 1) : r * (q + 1) + (xcd - r) * q) + off; }
        const int nig = 8 * nN, gid = wgid / nig, fm = gid * 8, gsz = (nM - fm) < 8 ? (nM - fm) : 8;
        u.pm = fm + ((wgid % nig) % gsz); u.pn = (wgid % nig) / gsz; u.e = 0; u.mt = 0; return true;
    }
    __device__ __forceinline__ const char* a_base(const Unit& u) const { return (const char*)A + (size_t)u.pm * BM * K * 2; }
    __device__ __forceinline__ const char* b_base(const Unit& u) const { return (const char*)Bt + (size_t)u.pn * BM * K * 2; }
    static constexpr bool GATHER = false;
    __device__ __forceinline__ void a_tok(const Unit&, int, unsigned (&)[2]) const {}
};

template <bool GATHER_>
struct MoeOrder {
    static constexpr bool GATHER = GATHER_;
    const LAS int* tstart;
    const LAS int* cnts;
    const int* list;
    const bf16_t* A;
    const bf16_t* Bt;
    int K, N, lognpn, G, c;
    __device__ __forceinline__ bool next(int i, Unit& u) const {
        const int L = i * G + c; const int total = __builtin_amdgcn_readfirstlane(tstart[65]) << lognpn; if (L >= total) return false;
        const int rt = L >> lognpn; u.pn = L & ((1 << lognpn) - 1); u.pm = rt;
        int e = 0;
        for (int j = 1; j < 65; ++j) e += (tstart[j] <= rt) ? 1 : 0;
        e = __builtin_amdgcn_readfirstlane(e);
        u.e = e; u.mt = rt - __builtin_amdgcn_readfirstlane(tstart[e]); return true;
    }
    __device__ __forceinline__ const char* a_base(const Unit& u) const { return GATHER ? (const char*)A : (const char*)A + (size_t)u.pm * BM * K * 2; }
    __device__ __forceinline__ const char* b_base(const Unit& u) const { return (const char*)Bt + ((size_t)u.e * N + (size_t)u.pn * BM) * K * 2; }
    __device__ __forceinline__ void a_tok(const Unit& u, int tid, unsigned (&pkv)[2]) const {
        const int ce = cnts[u.e];
#pragma unroll
        for (int i = 0; i < 2; ++i) {
            int R, C; stage_rc(tid * 16 + i * 8192, R, C); (void)C;
            unsigned v = 0u;
#pragma unroll
            for (int hh = 0; hh < 2; ++hh) {
                const int idx = u.mt * BM + hh * HALF + R;
                int tok = 0;
                if (idx < ce) tok = (u.e < NE) ? (list[(size_t)u.e * T + idx] / TOPK) : idx;
                v |= (unsigned)tok << (16 * hh);
            }
            pkv[i] = v;
        }
    }
};

struct EpiProj {
    static constexpr bool PERM = true;
    bf16_t* O; bf16_t* vt;
    __device__ __forceinline__ void operator()(const f32x4 (&acc)[2][2][4][2], const Unit& u, int wr, int wc, int fr, int fq) const {
        const int row0 = u.pm * BM + wr * 64 + fr, col0 = u.pn * BM + wc * 32 + 8 * fq;
#pragma unroll
        for (int bj = 0; bj < 2; ++bj) {
            const bool isv = (u.pn == 8) || (u.pn == 9 && bj == 0);
            if (!isv) {
#pragma unroll
                for (int ai = 0; ai < 2; ++ai)
#pragma unroll
                    for (int m = 0; m < 4; ++m) { bf16_t* rowp = O + (size_t)(row0 + ai * HALF + m * 16) * PJB + col0 + bj * HALF;
                        const f32x4 v0 = acc[ai][bj][m][0], v1 = acc[ai][bj][m][1];
                        u32x4 w; w.x = pk2(v0[0], v0[1]); w.y = pk2(v0[2], v0[3]); w.z = pk2(v1[0], v1[1]); w.w = pk2(v1[2], v1[3]);
                        *(u32x4*)rowp = w; }
            } else {
                const int vc0 = col0 + bj * HALF - 2048;
#pragma unroll
                for (int ai = 0; ai < 2; ++ai)
#pragma unroll
                    for (int m = 0; m < 4; ++m) { const int row = row0 + ai * HALF + m * 16; const int b = row / SEQ, s = row % SEQ;
                        bf16_t* base = vt + ((size_t)b * SBW + vc0) * SEQ + s;
#pragma unroll
                        for (int n = 0; n < 2; ++n)
#pragma unroll
                            for (int j = 0; j < 4; ++j) base[(size_t)(4 * n + j) * SEQ] = (bf16_t)f2bf(acc[ai][bj][m][n][j]); }
            }
        }
    }
};
struct EpiOut {
    static constexpr bool PERM = false;
    const float* xin; float* xo; const float* gt;
    __device__ __forceinline__ void operator()(const f32x4 (&acc)[2][2][4][2], const Unit& u, int wr, int wc, int fr, int fq) const {
        const int row0 = u.pm * BM + wr * 64 + fr, col0 = u.pn * BM + wc * 32 + 4 * fq;
#pragma unroll
        for (int ai = 0; ai < 2; ++ai)
#pragma unroll
            for (int m = 0; m < 4; ++m) { const int row = row0 + ai * HALF + m * 16; const float* gr = gt + (size_t)(row / SEQ) * 6144;
#pragma unroll
                for (int bj = 0; bj < 2; ++bj)
#pragma unroll
                    for (int n = 0; n < 2; ++n) { const int col = col0 + bj * HALF + 16 * n;
                        const f32x4 xi = *(const f32x4*)(xin + (size_t)row * D + col); const f32x4 gg = *(const f32x4*)(gr + col);
                        *(f32x4*)(xo + (size_t)row * D + col) = xi + gg * acc[ai][bj][m][n]; } }
    }
};
struct EpiExp1 {
    static constexpr bool PERM = true;
    bf16_t* hm;
    __device__ __forceinline__ void operator()(const f32x4 (&acc)[2][2][4][2], const Unit& u, int wr, int wc, int fr, int fq) const {
        const int row0 = u.pm * BM + wr * 64 + fr, col0 = u.pn * HALF + wc * 32 + 8 * fq;
#pragma unroll
        for (int ai = 0; ai < 2; ++ai)
#pragma unroll
            for (int m = 0; m < 4; ++m) { bf16_t* rowp = hm + (size_t)(row0 + ai * HALF + m * 16) * ED + col0;
                float o[8];
#pragma unroll
                for (int n = 0; n < 2; ++n)
#pragma unroll
                    for (int j = 0; j < 4; ++j) o[n * 4 + j] = siluf_(acc[ai][0][m][n][j]) * acc[ai][1][m][n][j];
                u32x4 w; w.x = pk2(o[0], o[1]); w.y = pk2(o[2], o[3]); w.z = pk2(o[4], o[5]); w.w = pk2(o[6], o[7]);
                *(u32x4*)rowp = w; }
    }
};
struct EpiExp2 {
    static constexpr bool PERM = true;
    bf16_t* slab; float* xb; const float* gt; const int* list; const float* topw; const LAS int* cnts; int skip_shared;
    __device__ __forceinline__ void operator()(const f32x4 (&acc)[2][2][4][2], const Unit& u, int wr, int wc, int fr, int fq) const {
        const int col0 = u.pn * BM + wc * 32 + 8 * fq; const int ce = cnts[u.e];
#pragma unroll
        for (int ai = 0; ai < 2; ++ai)
#pragma unroll
            for (int m = 0; m < 4; ++m) { const int idx = u.mt * BM + ai * HALF + wr * 64 + m * 16 + fr;
                if (idx < ce) {
                    if (u.e < NE) {
                        const int aid = list[(size_t)u.e * T + idx]; const float wgt = topw[aid]; bf16_t* rowp = slab + (size_t)aid * D + col0;
#pragma unroll
                        for (int bj = 0; bj < 2; ++bj) { const f32x4 v0 = acc[ai][bj][m][0] * wgt, v1 = acc[ai][bj][m][1] * wgt;
                            u32x4 w; w.x = pk2(v0[0], v0[1]); w.y = pk2(v0[2], v0[3]); w.z = pk2(v1[0], v1[1]); w.w = pk2(v1[2], v1[3]);
                            *(u32x4*)(rowp + bj * HALF) = w; }
                    } else if (!skip_shared) {
                        const int tok = idx; float* xr = xb + (size_t)tok * D + col0; const float* gr = gt + (size_t)(tok / SEQ) * 6144 + col0;
#pragma unroll
                        for (int bj = 0; bj < 2; ++bj)
#pragma unroll
                            for (int n = 0; n < 2; ++n) { const f32x4 xi = *(const f32x4*)(xr + bj * HALF + 4 * n); const f32x4 gg = *(const f32x4*)(gr + bj * HALF + 4 * n);
                                *(f32x4*)(xr + bj * HALF + 4 * n) = xi + gg * acc[ai][bj][m][n]; }
                    }
                } }
    }
};
}

__device__ __forceinline__ void st_mod(const P& p, int item, LAS float* L  ) {
    const int tid = opaque(threadIdx.x), wave = tid >> 6, lane = tid & 63;
    const int l = item / 96, j0 = (item % 96) * 64;
    for (int i = tid; i < 8 * 1024; i += NTHREADS) L[i] = siluf_(p.c[i]);
    __syncthreads();
    float acc[8];
#pragma unroll
    for (int b = 0; b < 8; ++b) acc[b] = 0.f;
    const float* w = p.w_ada + ((size_t)l * 1024 + wave * 128) * 6144 + j0 + lane;
#pragma unroll 8
    for (int i = 0; i < 128; ++i) {
        const float wv = w[(size_t)i * 6144];
#pragma unroll
        for (int b = 0; b < 8; ++b) acc[b] += L[b * 1024 + wave * 128 + i] * wv;
    }
    LAS float* red = L + 8 * 1024;
#pragma unroll
    for (int b = 0; b < 8; ++b) red[(wave * 8 + b) * 64 + lane] = acc[b];
    __syncthreads();
    {
        const int b = tid >> 6;
        float s = p.b_ada[l * 6144 + j0 + lane];
#pragma unroll
        for (int wv = 0; wv < 8; ++wv) s += red[(wv * 8 + b) * 64 + lane];
        p.mod[((size_t)l * 8 + b) * 6144 + j0 + lane] = s;
    }
    __syncthreads();
}

constexpr int REC_HB = 912, REC_TB = 6 * REC_HB;
constexpr int CB_PHI = 0, CB_RT = 8192, CB_PSI = 12288, CB_G = 16384, CB_V = 18432, CB_BYTES = 22528;
constexpr int PREP_TOK = 64, PREP_XS = 168;
__device__ __forceinline__ void st_prep(const P& p, int l, int vb0, int vbstride, LAS unsigned char* L) {
    const int tid = opaque(threadIdx.x), wave = __builtin_amdgcn_readfirstlane(tid >> 6), lane = tid & 63, fr = lane & 15, fq = lane >> 4;
    LAS bf16_t* X = (LAS bf16_t*)L;
    for (int vb = vb0; vb < T / PREP_TOK; vb += vbstride) {
        const int t0 = vb * PREP_TOK, s0 = t0 % SEQ;
#pragma unroll 4
        for (int q = 0; q < PREP_TOK * 160 / NTHREADS; ++q) {
            const int it = tid + q * NTHREADS;
            const int tt = it / 160, i = it % 160;
            const int col = (i < 128) ? 1152 + i : INC + (i - 128);
            const float mu = (i < 128) ? p.mu_rw[l * RWC + col] : p.mu_vres[i - 128];
            const bf16_t* u = p.proj + (size_t)(t0 + tt) * PJB + col;
            const float uu = bf2f(u[0]), pv = (s0 + tt) > 0 ? bf2f(u[-PJB]) : 0.f;
            float x = uu + (pv - uu) * mu;
            if (i < 32) x = tanhf(x); else if (i >= 64 && i < 128) x = sigmoidf_(x);
            if (i >= 128 && l == 0) x = 0.f;
            X[tt * PREP_XS + i] = (bf16_t)f2bf(x);
        }
        __syncthreads();
        if (wave < 6) {
            const int hh = wave;
            const int ll = opaque(lane), fr2 = ll & 15, fq2 = ll >> 4;
            const bf16_t* lw = p.lwt + ((size_t)l * RWW + hh * 64) * 160;
#pragma unroll 1
            for (int mt = 0; mt < 4; ++mt) {
                const int tb = t0 + 16 * mt + 4 * fq2, sb = s0 + 16 * mt + 4 * fq2;
                bf16_t rr[4][5], kr[4][5], vr[4][5], vf[4][4];
#pragma unroll
                for (int nt = 0; nt < 4; ++nt) {
                    const bf16_t* u = p.proj + (size_t)tb * PJB + hh * 64 + 16 * nt + fr2;
#pragma unroll
                    for (int rw = 0; rw < 5; ++rw) {
                        const bool ok = (rw > 0) || (sb > 0);
                        rr[nt][rw] = ok ? u[(ptrdiff_t)(rw - 1) * PJB] : (bf16_t)0; kr[nt][rw] = ok ? u[(ptrdiff_t)(rw - 1) * PJB + 384] : (bf16_t)0; vr[nt][rw] = ok ? u[(ptrdiff_t)(rw - 1) * PJB + 768] : (bf16_t)0;
                    }
#pragma unroll
                    for (int rg = 0; rg < 4; ++rg) vf[nt][rg] = (l == 1) ? p.vfirst[(size_t)(tb + rg) * RWW + hh * 64 + 16 * nt + fr2] : (bf16_t)0;
                }
                const LAS bf16_t* xa = X + (16 * mt + fr2) * PREP_XS + 8 * fq2;
                const bf16x8 Aw = *(const LAS bf16x8*)xa, Aa = *(const LAS bf16x8*)(xa + 32), Av = *(const LAS bf16x8*)(xa + 128);
                f32x4 aw[4], aa[4], av[4];
#pragma unroll
                for (int nt = 0; nt < 4; ++nt) {
                    const bf16_t* q = lw + (16 * nt + fr2) * 160 + 8 * fq2;
                    aw[nt] = __builtin_amdgcn_mfma_f32_16x16x32_bf16(Aw, *(const bf16x8*)q, (f32x4){0.f, 0.f, 0.f, 0.f}, 0, 0, 0);
                    aa[nt] = __builtin_amdgcn_mfma_f32_16x16x32_bf16(Aa, *(const bf16x8*)(q + 32), (f32x4){0.f, 0.f, 0.f, 0.f}, 0, 0, 0);
                    av[nt] = __builtin_amdgcn_mfma_f32_16x16x32_bf16(Av, *(const bf16x8*)(q + 128), (f32x4){0.f, 0.f, 0.f, 0.f}, 0, 0, 0);
                }
                float ksh[4][4], ss[4] = {0.f, 0.f, 0.f, 0.f};
#pragma unroll
                for (int nt = 0; nt < 4; ++nt) {
                    const int c = hh * 64 + 16 * nt + fr2;
                    const float muk = p.mu_rw[l * RWC + 384 + c], kkc = p.rw_k_k[l * RWW + c];
#pragma unroll
                    for (int rg = 0; rg < 4; ++rg) {
                        const float kc = bf2f(kr[nt][rg + 1]), kp = bf2f(kr[nt][rg]);
                        const float k = kc + (kp - kc) * muk;
                        ksh[nt][rg] = k; ss[rg] += (k * kkc) * (k * kkc);
                    }
                }
                float inrm[4], rkp[4] = {0.f, 0.f, 0.f, 0.f};
#pragma unroll
                for (int rg = 0; rg < 4; ++rg) inrm[rg] = 1.f / fmaxf(sqrtf(dpp_add16(ss[rg])), 1e-12f);
#pragma unroll
                for (int nt = 0; nt < 4; ++nt) {
                    const int c = hh * 64 + 16 * nt + fr2;
                    const float w0 = p.rw_w0[l * RWW + c], a0 = p.rw_a0[l * RWW + c], v0 = (l == 1) ? p.rw_v0[c] : 0.f;
                    const float kkc = p.rw_k_k[l * RWW + c], kac = p.rw_k_a[l * RWW + c], rkc = p.rw_r_k[l * RWW + c];
                    const float mur = p.mu_rw[l * RWC + c], muv = p.mu_rw[l * RWC + 768 + c];
#pragma unroll
                    for (int rg = 0; rg < 4; ++rg) {
                        const int t = tb + rg;
                        const float rc_ = bf2f(rr[nt][rg + 1]), rp = bf2f(rr[nt][rg]), vc = bf2f(vr[nt][rg + 1]), vp = bf2f(vr[nt][rg]);
                        const float r = rc_ + (rp - rc_) * mur; float v = vc + (vp - vc) * muv; const float k = ksh[nt][rg];
                        const float wlog = -softplusf_(-(aw[nt][rg] + w0)) - 0.5f;
                        const float decay = __expf(-__expf(wlog));
                        const float a = sigmoidf_(aa[nt][rg] + a0);
                        if (l == 1) { const float vg = sigmoidf_(av[nt][rg] + v0); v = v + (bf2f(vf[nt][rg]) - v) * vg; }
                        else p.vfirst[(size_t)t * RWW + c] = (bf16_t)f2bf(v);
                        const float kk = k * kkc * inrm[rg];
                        const float bq = kk * a, k2 = k * (1.f + (a - 1.f) * kac);
                        unsigned char* rc = p.rec + (size_t)t * REC_TB + hh * REC_HB;
                        *(float*)(rc + (16 * nt + fr2) * 4) = decay;
                        bf16_t* rb = (bf16_t*)(rc + 256) + 16 * nt + fr2;
                        rb[0] = (bf16_t)f2bf(-kk); rb[64] = (bf16_t)f2bf(bq); rb[128] = (bf16_t)f2bf(k2); rb[192] = (bf16_t)f2bf(decay * r); rb[256] = (bf16_t)f2bf(v);
                        rkp[rg] += r * k2 * rkc;
                    }
                }
#pragma unroll
                for (int rg = 0; rg < 4; ++rg) { const float rk = dpp_add16(rkp[rg]); if (fr2 == 0) *(float*)(p.rec + (size_t)(tb + rg) * REC_TB + hh * REC_HB + 896) = rk; }
                {
                    const bf16x8 Ag0 = *(const LAS bf16x8*)(xa + 64), Ag1 = *(const LAS bf16x8*)(xa + 96);
#pragma unroll
                    for (int nt = 0; nt < 4; ++nt) {
                        const bf16_t* q = lw + (16 * nt + fr2) * 160 + 64 + 8 * fq2;
                        f32x4 ag = __builtin_amdgcn_mfma_f32_16x16x32_bf16(Ag0, *(const bf16x8*)q, (f32x4){0.f, 0.f, 0.f, 0.f}, 0, 0, 0);
                        ag = __builtin_amdgcn_mfma_f32_16x16x32_bf16(Ag1, *(const bf16x8*)(q + 32), ag, 0, 0, 0);
#pragma unroll
                        for (int rg = 0; rg < 4; ++rg) p.g[(size_t)(tb + rg) * RWW + hh * 64 + 16 * nt + fr2] = (bf16_t)f2bf(ag[rg]);
                    }
                }
            }
        }
        __syncthreads();
    }
}

typedef float f32x16 __attribute__((ext_vector_type(16)));
__device__ __forceinline__ bf16x8 acc_frag(const f32x16& x, int ks) {
    return ks == 0 ? mk8(cvtpk(x[0], x[1]), cvtpk(x[2], x[3]), cvtpk(x[4], x[5]), cvtpk(x[6], x[7])) : mk8(cvtpk(x[8], x[9]), cvtpk(x[10], x[11]), cvtpk(x[12], x[13]), cvtpk(x[14], x[15]));
}
__device__ __forceinline__ bf16x8 lds_perm_frag(const LAS unsigned char* rowp, int ks, int hf) {
    const u32x2 g0 = *(const LAS u32x2*)(rowp + (16 * ks + 4 * hf) * 2), g1 = *(const LAS u32x2*)(rowp + (16 * ks + 4 * hf + 8) * 2);
    return mk8(g0.x, g0.y, g1.x, g1.y);
}
constexpr int CP_WAVES = 6, CP_LDS = 20736;
__device__ __forceinline__ void st_cpre(const P& p, int item, LAS unsigned char* L, int lane_) {
    const int lane = opaque(lane_);
    const int ch = item & 63, bh = item >> 6, b = bh / 6, hh = bh % 6;
    const int r = lane & 31, hf = lane >> 5;
    const unsigned char* rec0 = p.rec + ((size_t)(b * SEQ + ch * 32)) * REC_TB + hh * REC_HB;
    unsigned char* cbo = p.cb + (size_t)item * CB_BYTES;
    LAS unsigned char* AbarT = L; LAS unsigned char* RbarT = L + 4096; LAS unsigned char* Bbar = L + 8192; LAS unsigned char* Kbar = L + 12288; LAS unsigned char* BbarT = L + 16384;
    LAS float* PCv = (LAS float*)(L + 20480);
    float Y[32];
    {
        float Pc = 1.f;
        unsigned bt[16], vtw[16];
#pragma unroll
        for (int t8 = 0; t8 < 32; t8 += 8) {
            float wv[8]; bf16_t av[8], bv[8], kv[8], qv[8], vv[8];
#pragma unroll
            for (int j = 0; j < 8; ++j) {
                const unsigned char* rp = rec0 + (size_t)(t8 + j) * REC_TB;
                wv[j] = *(const float*)(rp + lane * 4);
                const bf16_t* hb = (const bf16_t*)(rp + 256) + lane;
                av[j] = hb[0]; bv[j] = hb[64]; kv[j] = hb[128]; qv[j] = hb[192]; vv[j] = hb[256];
            }
#pragma unroll
            for (int j = 0; j < 8; ++j) {
                const int t = t8 + j;
                const float Pm = Pc; Pc *= wv[j]; const float inv = 1.f / Pc;
                const float ab = bf2f(av[j]) * Pm, rb = bf2f(qv[j]) * Pm, bb = bf2f(bv[j]) * inv, kb = bf2f(kv[j]) * inv;
                Y[t] = ab;
                *(LAS bf16_t*)(AbarT + (t * 64 + lane) * 2) = (bf16_t)f2bf(ab);
                *(LAS bf16_t*)(RbarT + (t * 64 + lane) * 2) = (bf16_t)f2bf(rb);
                *(LAS bf16_t*)(Bbar + (t * 64 + lane) * 2) = (bf16_t)f2bf(bb);
                *(LAS bf16_t*)(Kbar + (t * 64 + lane) * 2) = (bf16_t)f2bf(kb);
                if (t & 1) { bt[t >> 1] |= f2bf(bb) << 16; vtw[t >> 1] |= (unsigned)vv[j] << 16; } else { bt[t >> 1] = f2bf(bb); vtw[t >> 1] = (unsigned)vv[j]; }
            }
            asm volatile("" ::: "memory");
        }
        PCv[lane] = Pc;
#pragma unroll
        for (int q = 0; q < 4; ++q) {
            *(LAS u32x4*)(BbarT + lane * 64 + q * 16) = (u32x4){bt[4 * q], bt[4 * q + 1], bt[4 * q + 2], bt[4 * q + 3]};
            *(u32x4*)(cbo + CB_V + lane * 64 + q * 16) = (u32x4){vtw[4 * q], vtw[4 * q + 1], vtw[4 * q + 2], vtw[4 * q + 3]};
        }
    }
    asm volatile("s_waitcnt lgkmcnt(0)" ::: "memory");
    f32x16 Lab, Lak, Mbr, Mkr;
#pragma unroll
    for (int i = 0; i < 16; ++i) { Lab[i] = 0.f; Lak[i] = 0.f; Mbr[i] = 0.f; Mkr[i] = 0.f; }
#pragma unroll
    for (int ks = 0; ks < 4; ++ks) {
        const int off = (r * 64 + 16 * ks + 8 * hf) * 2;
        const bf16x8 fb = *(const LAS bf16x8*)(Bbar + off), fk = *(const LAS bf16x8*)(Kbar + off), fa = *(const LAS bf16x8*)(AbarT + off), fr = *(const LAS bf16x8*)(RbarT + off);
        Lab = __builtin_amdgcn_mfma_f32_32x32x16_bf16(fb, fa, Lab, 0, 0, 0);
        Lak = __builtin_amdgcn_mfma_f32_32x32x16_bf16(fk, fa, Lak, 0, 0, 0);
        Mbr = __builtin_amdgcn_mfma_f32_32x32x16_bf16(fb, fr, Mbr, 0, 0, 0);
        Mkr = __builtin_amdgcn_mfma_f32_32x32x16_bf16(fk, fr, Mkr, 0, 0, 0);
    }
#pragma unroll
    for (int i = 0; i < 16; ++i) {
        const int s = (i & 3) + 8 * (i >> 2) + 4 * hf;
        if (!(s < r)) { Lab[i] = 0.f; Lak[i] = 0.f; }
        if (!(s <= r)) { Mbr[i] = 0.f; Mkr[i] = 0.f; }
    }
    asm volatile("s_waitcnt lgkmcnt(0)" ::: "memory");
    {
        LAS float* LabT = (LAS float*)AbarT; LAS float* LakM = (LAS float*)Bbar;
#pragma unroll
        for (int g = 0; g < 4; ++g) *(LAS f32x4*)(LabT + r * 32 + 8 * g + 4 * hf) = (f32x4){Lab[4 * g], Lab[4 * g + 1], Lab[4 * g + 2], Lab[4 * g + 3]};
#pragma unroll
        for (int i = 0; i < 16; ++i) LakM[((i & 3) + 8 * (i >> 2) + 4 * hf) * 32 + r] = Lak[i];
    }
    asm volatile("s_waitcnt lgkmcnt(0)" ::: "memory");
    unsigned W2p[16];
    {
        const LAS float* LabT = (const LAS float*)AbarT; const LAS float* LakM = (const LAS float*)Bbar;
        float X2[32];
#pragma unroll
        for (int t = 0; t < 32; t += 4) { const f32x4 q = *(const LAS f32x4*)(LakM + r * 32 + t); X2[t] = q[0]; X2[t + 1] = q[1]; X2[t + 2] = q[2]; X2[t + 3] = q[3]; }
        int zdep = 0;
#pragma unroll
        for (int t = 1; t < 32; ++t) {
            float x2 = X2[t];
            const LAS float* row = LabT + t * 32 + zdep;
#pragma unroll
            for (int s4 = 0; s4 < t; s4 += 4) {
                const f32x4 lq = *(const LAS f32x4*)(row + s4);
#pragma unroll
                for (int q = 0; q < 4; ++q) if (s4 + q < t) x2 = fmaf(X2[s4 + q], lq[q], x2);
            }
            X2[t] = x2;
            asm volatile("v_mov_b32 %0, 0" : "=v"(zdep) : "v"(x2));
        }
#pragma unroll
        for (int q = 0; q < 16; ++q) W2p[q] = pk2(X2[2 * q], X2[2 * q + 1]);
    }
    {
        const LAS float* LabT = (const LAS float*)AbarT;
        int zdep = 0;
#pragma unroll
        for (int t = 1; t < 32; ++t) {
            float x1 = Y[t];
            const LAS float* row = LabT + t * 32 + zdep;
#pragma unroll
            for (int s4 = 0; s4 < t; s4 += 4) {
                const f32x4 lq = *(const LAS f32x4*)(row + s4);
#pragma unroll
                for (int q = 0; q < 4; ++q) if (s4 + q < t) x1 = fmaf(Y[s4 + q], lq[q], x1);
            }
            Y[t] = x1;
            asm volatile("v_mov_b32 %0, 0" : "=v"(zdep) : "v"(x1));
        }
    }
    asm volatile("s_waitcnt lgkmcnt(0)" ::: "memory");
    LAS unsigned char* Atil = L;
    LAS unsigned char* Wv = L + 8192;
#pragma unroll
    for (int q = 0; q < 4; ++q) {
        *(LAS u32x4*)(Atil + lane * 64 + q * 16) = (u32x4){pk2(Y[8 * q], Y[8 * q + 1]), pk2(Y[8 * q + 2], Y[8 * q + 3]), pk2(Y[8 * q + 4], Y[8 * q + 5]), pk2(Y[8 * q + 6], Y[8 * q + 7])};
        if (lane < 32) *(LAS u32x4*)(Wv + lane * 64 + q * 16) = (u32x4){W2p[4 * q], W2p[4 * q + 1], W2p[4 * q + 2], W2p[4 * q + 3]};
    }
    asm volatile("s_waitcnt lgkmcnt(0)" ::: "memory");
    const bf16x8 mb0 = acc_frag(Mbr, 0), mb1 = acc_frag(Mbr, 1);
#pragma unroll
    for (int i = 0; i < 2; ++i) {
        f32x16 c;
#pragma unroll
        for (int g = 0; g < 4; ++g) { const u32x2 q = *(const LAS u32x2*)(RbarT + (r * 64 + 32 * i + 8 * g + 4 * hf) * 2); c[4 * g] = bflo(q.x); c[4 * g + 1] = bfhi(q.x); c[4 * g + 2] = bflo(q.y); c[4 * g + 3] = bfhi(q.y); }
        c = __builtin_amdgcn_mfma_f32_32x32x16_bf16(lds_perm_frag(Atil + (32 * i + r) * 64, 0, hf), mb0, c, 0, 0, 0);
        c = __builtin_amdgcn_mfma_f32_32x32x16_bf16(lds_perm_frag(Atil + (32 * i + r) * 64, 1, hf), mb1, c, 0, 0, 0);
#pragma unroll
        for (int g = 0; g < 4; ++g) *(u32x2*)(cbo + CB_RT + (r * 64 + 32 * i + 8 * g + 4 * hf) * 2) = (u32x2){cvtpk(c[4 * g], c[4 * g + 1]), cvtpk(c[4 * g + 2], c[4 * g + 3])};
    }
    {
        f32x16 c = Mkr;
        c = __builtin_amdgcn_mfma_f32_32x32x16_bf16(lds_perm_frag(Wv + r * 64, 0, hf), mb0, c, 0, 0, 0);
        c = __builtin_amdgcn_mfma_f32_32x32x16_bf16(lds_perm_frag(Wv + r * 64, 1, hf), mb1, c, 0, 0, 0);
#pragma unroll
        for (int g = 0; g < 4; ++g) *(u32x2*)(cbo + CB_G + (r * 32 + 8 * g + 4 * hf) * 2) = (u32x2){cvtpk(c[4 * g], c[4 * g + 1]), cvtpk(c[4 * g + 2], c[4 * g + 3])};
    }
#pragma unroll
    for (int jt = 0; jt < 2; ++jt) {
        const float pc = PCv[32 * jt + r];
        const bf16x8 fb0 = *(const LAS bf16x8*)(BbarT + (32 * jt + r) * 64 + (8 * hf) * 2), fb1 = *(const LAS bf16x8*)(BbarT + (32 * jt + r) * 64 + (16 + 8 * hf) * 2);
#pragma unroll
        for (int i = 0; i < 2; ++i) {
            f32x16 c;
#pragma unroll
            for (int q = 0; q < 16; ++q) c[q] = 0.f;
            c = __builtin_amdgcn_mfma_f32_32x32x16_bf16(*(const LAS bf16x8*)(Atil + (32 * i + r) * 64 + (8 * hf) * 2), fb0, c, 0, 0, 0);
            c = __builtin_amdgcn_mfma_f32_32x32x16_bf16(*(const LAS bf16x8*)(Atil + (32 * i + r) * 64 + (16 + 8 * hf) * 2), fb1, c, 0, 0, 0);
#pragma unroll
            for (int q = 0; q < 16; ++q) { const int kq = (q & 3) + 8 * (q >> 2) + 4 * hf; c[q] = (c[q] + ((i == jt && kq == r) ? 1.f : 0.f)) * pc; }
#pragma unroll
            for (int g = 0; g < 4; ++g) *(u32x2*)(cbo + CB_PHI + ((32 * jt + r) * 64 + 32 * i + 8 * g + 4 * hf) * 2) = (u32x2){cvtpk(c[4 * g], c[4 * g + 1]), cvtpk(c[4 * g + 2], c[4 * g + 3])};
        }
        {
            f32x16 c;
#pragma unroll
            for (int q = 0; q < 16; ++q) c[q] = bf2f(*(const LAS bf16_t*)(Kbar + (((q & 3) + 8 * (q >> 2) + 4 * hf) * 64 + 32 * jt + r) * 2));
            c = __builtin_amdgcn_mfma_f32_32x32x16_bf16(*(const LAS bf16x8*)(Wv + r * 64 + (8 * hf) * 2), fb0, c, 0, 0, 0);
            c = __builtin_amdgcn_mfma_f32_32x32x16_bf16(*(const LAS bf16x8*)(Wv + r * 64 + (16 + 8 * hf) * 2), fb1, c, 0, 0, 0);
#pragma unroll
            for (int g = 0; g < 4; ++g) *(u32x2*)(cbo + CB_PSI + ((32 * jt + r) * 32 + 8 * g + 4 * hf) * 2) = (u32x2){cvtpk(c[4 * g] * pc, c[4 * g + 1] * pc), cvtpk(c[4 * g + 2] * pc, c[4 * g + 3] * pc)};
        }
    }
    asm volatile("s_waitcnt lgkmcnt(0)" ::: "memory");
}

constexpr int CS_SLOTS = 4, CS_NP = CB_BYTES / 1024;
__device__ __forceinline__ void st_cscan(const P& p, int bh, LAS unsigned char* lds) {
    const int tid = opaque(threadIdx.x), wave = __builtin_amdgcn_readfirstlane(tid >> 6), lane = tid & 63;
    const int b = bh / 6, hh = bh % 6, r = lane & 31, hf = lane >> 5;
    const unsigned char* cb0 = p.cb + (size_t)bh * 64 * CB_BYTES;
    constexpr int NCH = SEQ / 32;
    const int lw = wave - 2;
#define CS_ISSUE(chunk) do { const int _c = (chunk) < NCH ? (chunk) : NCH - 1; const unsigned char* _g = cb0 + (size_t)_c * CB_BYTES + lane * 16; LAS unsigned char* _l = lds + ((chunk) & 3) * CB_BYTES; \
        _Pragma("unroll") for (int _j = 0; _j < 4; ++_j) if (lw + 6 * _j < CS_NP) __builtin_amdgcn_global_load_lds((const unsigned*)(_g + (lw + 6 * _j) * 1024), (LAS unsigned*)(_l + (lw + 6 * _j) * 1024), 16, 0, 0); } while (0)
    f32x16 X0, X1;
#pragma unroll
    for (int i = 0; i < 16; ++i) { X0[i] = 0.f; X1[i] = 0.f; }
    if (wave >= 2) { CS_ISSUE(0); CS_ISSUE(1); CS_ISSUE(2); }
    float* yb = p.y + (size_t)b * SEQ * RWW + hh * 64 + 32 * wave + r;
    for (int c = 0; c < NCH; ++c) {
        if (wave >= 2) { if (lw < 4) asm volatile("s_waitcnt vmcnt(8)" ::: "memory"); else asm volatile("s_waitcnt vmcnt(6)" ::: "memory"); }
        __builtin_amdgcn_s_barrier();
        if (wave >= 2) { CS_ISSUE(c + 3); }
        else {
            const LAS unsigned char* S = lds + (c & 3) * CB_BYTES;
            const int vr = 32 * wave + r;
            const bf16x8 vf0 = *(const LAS bf16x8*)(S + CB_V + vr * 64 + (8 * hf) * 2), vf1 = *(const LAS bf16x8*)(S + CB_V + vr * 64 + (16 + 8 * hf) * 2);
            const LAS unsigned char* rp = S + CB_RT + r * 128;
            const bf16x8 fr0 = lds_perm_frag(rp, 0, hf), fr1 = lds_perm_frag(rp, 1, hf), fr2 = lds_perm_frag(rp + 64, 0, hf), fr3 = lds_perm_frag(rp + 64, 1, hf);
            const bf16x8 fg0 = *(const LAS bf16x8*)(S + CB_G + r * 64 + (8 * hf) * 2), fg1 = *(const LAS bf16x8*)(S + CB_G + r * 64 + (16 + 8 * hf) * 2);
            const LAS unsigned char* p0 = S + CB_PHI + r * 128; const LAS unsigned char* p1 = S + CB_PHI + (32 + r) * 128;
            const bf16x8 fa0 = lds_perm_frag(p0, 0, hf), fa1 = lds_perm_frag(p0, 1, hf), fa2 = lds_perm_frag(p0 + 64, 0, hf), fa3 = lds_perm_frag(p0 + 64, 1, hf);
            const bf16x8 fb0 = lds_perm_frag(p1, 0, hf), fb1 = lds_perm_frag(p1, 1, hf), fb2 = lds_perm_frag(p1 + 64, 0, hf), fb3 = lds_perm_frag(p1 + 64, 1, hf);
            const LAS unsigned char* q0 = S + CB_PSI + r * 64; const LAS unsigned char* q1 = S + CB_PSI + (32 + r) * 64;
            const bf16x8 fp0 = *(const LAS bf16x8*)(q0 + (8 * hf) * 2), fp1 = *(const LAS bf16x8*)(q0 + (16 + 8 * hf) * 2), fp2 = *(const LAS bf16x8*)(q1 + (8 * hf) * 2), fp3 = *(const LAS bf16x8*)(q1 + (16 + 8 * hf) * 2);
            const bf16x8 x00 = acc_frag(X0, 0), x01 = acc_frag(X0, 1), x10 = acc_frag(X1, 0), x11 = acc_frag(X1, 1);
            asm volatile("s_waitcnt lgkmcnt(0)" ::: "memory");
            __builtin_amdgcn_sched_barrier(0);
            f32x16 yc, n0, n1;
#pragma unroll
            for (int i = 0; i < 16; ++i) { yc[i] = 0.f; n0[i] = 0.f; n1[i] = 0.f; }
            n0 = __builtin_amdgcn_mfma_f32_32x32x16_bf16(fa0, x00, n0, 0, 0, 0);
            n1 = __builtin_amdgcn_mfma_f32_32x32x16_bf16(fb0, x00, n1, 0, 0, 0);
            yc = __builtin_amdgcn_mfma_f32_32x32x16_bf16(fr0, x00, yc, 0, 0, 0);
            n0 = __builtin_amdgcn_mfma_f32_32x32x16_bf16(fa1, x01, n0, 0, 0, 0);
            n1 = __builtin_amdgcn_mfma_f32_32x32x16_bf16(fb1, x01, n1, 0, 0, 0);
            yc = __builtin_amdgcn_mfma_f32_32x32x16_bf16(fr1, x01, yc, 0, 0, 0);
            n0 = __builtin_amdgcn_mfma_f32_32x32x16_bf16(fa2, x10, n0, 0, 0, 0);
            n1 = __builtin_amdgcn_mfma_f32_32x32x16_bf16(fb2, x10, n1, 0, 0, 0);
            yc = __builtin_amdgcn_mfma_f32_32x32x16_bf16(fr2, x10, yc, 0, 0, 0);
            n0 = __builtin_amdgcn_mfma_f32_32x32x16_bf16(fa3, x11, n0, 0, 0, 0);
            n1 = __builtin_amdgcn_mfma_f32_32x32x16_bf16(fb3, x11, n1, 0, 0, 0);
            yc = __builtin_amdgcn_mfma_f32_32x32x16_bf16(fr3, x11, yc, 0, 0, 0);
            n0 = __builtin_amdgcn_mfma_f32_32x32x16_bf16(fp0, vf0, n0, 0, 0, 0);
            n1 = __builtin_amdgcn_mfma_f32_32x32x16_bf16(fp2, vf0, n1, 0, 0, 0);
            yc = __builtin_amdgcn_mfma_f32_32x32x16_bf16(fg0, vf0, yc, 0, 0, 0);
            n0 = __builtin_amdgcn_mfma_f32_32x32x16_bf16(fp1, vf1, n0, 0, 0, 0);
            n1 = __builtin_amdgcn_mfma_f32_32x32x16_bf16(fp3, vf1, n1, 0, 0, 0);
            yc = __builtin_amdgcn_mfma_f32_32x32x16_bf16(fg1, vf1, yc, 0, 0, 0);
            X0 = n0; X1 = n1;
#pragma unroll
            for (int i = 0; i < 16; ++i) yb[(size_t)(c * 32 + (i & 3) + 8 * (i >> 2) + 4 * hf) * RWW] = yc[i];
        }
    }
    asm volatile("s_waitcnt vmcnt(0)" ::: "memory");
    __builtin_amdgcn_s_barrier();
#undef CS_ISSUE
}

__device__ __forceinline__ void st_rwout(const P& p, int l, int t, int lane) {
    float y[6], vv[6], gg[6], rk[6];
#pragma unroll
    for (int hh = 0; hh < 6; ++hh) {
        y[hh] = p.y[(size_t)t * RWW + hh * 64 + lane]; vv[hh] = bf2f(*(const bf16_t*)(p.rec + (size_t)t * REC_TB + hh * REC_HB + 768 + lane * 2)); gg[hh] = bf2f(p.g[(size_t)t * RWW + hh * 64 + lane]);
        rk[hh] = *(const float*)(p.rec + (size_t)t * REC_TB + hh * REC_HB + 896);
    }
#pragma unroll
    for (int hh = 0; hh < 6; ++hh) {
        const int c = hh * 64 + lane;
        const float mean = wave_sum(y[hh]) * (1.f / 64.f);
        const float d = y[hh] - mean;
        const float var = wave_sum(d * d) * (1.f / 64.f);
        const float yn = d * rsqrtf(var + 64e-5f) * p.rw_ln_g[l * RWW + c] + p.rw_ln_b[l * RWW + c];
        p.h[(size_t)t * D + c] = (bf16_t)f2bf((yn + rk[hh] * vv[hh]) * gg[hh]);
    }
}

typedef float f32x16 __attribute__((ext_vector_type(16)));
constexpr float ATT_EXIT = -60.f;
__device__ __forceinline__ float xhalf(float x, int lane) { return __builtin_bit_cast(float, __builtin_amdgcn_ds_bpermute((lane ^ 32) << 2, __builtin_bit_cast(int, x))); }
__device__ __forceinline__ void st_attn(const P& p, int l, int item) {
    const int lane = opaque(threadIdx.x) & 63;
    const int qt = item % (SEQ / 32), bh = item / (SEQ / 32), b = bh / 6, hh = bh % 6;
    const int r = lane & 31, hf = lane >> 5;
    const bf16_t* qkb = p.proj + (size_t)b * SEQ * PJB + RWC + hh * 64 + 8 * hf;
    const bf16_t* vtb = p.vt + ((size_t)(b * 6 + hh) * 64 + r) * SEQ + 4 * hf;
    bf16x8 qf[4];
    {
        const bf16_t* qp = qkb + (size_t)(qt * 32 + r) * PJB;
#pragma unroll
        for (int s = 0; s < 4; ++s) {
            u32x4 t4 = *(const u32x4*)(qp + 16 * s);
            unsigned w[4] = {t4.x, t4.y, t4.z, t4.w};
#pragma unroll
            for (int q = 0; q < 4; ++q) { const float lo = bflo(w[q]) * 0.125f, hi = bfhi(w[q]) * 0.125f; w[q] = (__builtin_bit_cast(unsigned, lo) >> 16) | (__builtin_bit_cast(unsigned, hi) & 0xffff0000u); }
            t4.x = w[0]; t4.y = w[1]; t4.z = w[2]; t4.w = w[3];
            qf[s] = __builtin_bit_cast(bf16x8, t4);
        }
    }
    f32x16 o0, o1;
#pragma unroll
    for (int i = 0; i < 16; ++i) { o0[i] = 0.f; o1[i] = 0.f; }
    float R = 0.f;
    bf16x8 kfn[4]; u32x2 vfn[2][2][2];
#define ATT_LOAD(KT) do { const int _k0 = (KT) * 32; const bf16_t* kp = qkb + SBW + (size_t)(_k0 + r) * PJB; \
        _Pragma("unroll") for (int s = 0; s < 4; ++s) kfn[s] = *(const bf16x8*)(kp + 16 * s); \
        _Pragma("unroll") for (int dt = 0; dt < 2; ++dt) _Pragma("unroll") for (int s = 0; s < 2; ++s) { const bf16_t* vp = vtb + (size_t)dt * 32 * SEQ + _k0 + 16 * s; vfn[dt][s][0] = *(const u32x2*)vp; vfn[dt][s][1] = *(const u32x2*)(vp + 8); } } while (0)
    ATT_LOAD(qt);
    for (int kt = qt; kt >= 0; --kt) {
        const int key0 = kt * 32; (void)key0;
        bf16x8 kf[4]; u32x2 vf[2][2][2];
#pragma unroll
        for (int s = 0; s < 4; ++s) kf[s] = kfn[s];
#pragma unroll
        for (int dt = 0; dt < 2; ++dt)
#pragma unroll
            for (int s = 0; s < 2; ++s) { vf[dt][s][0] = vfn[dt][s][0]; vf[dt][s][1] = vfn[dt][s][1]; }
        if (kt > 0) ATT_LOAD(kt - 1);
        f32x16 z;
#pragma unroll
        for (int i = 0; i < 16; ++i) z[i] = 0.f;
#pragma unroll
        for (int s = 0; s < 4; ++s) z = __builtin_amdgcn_mfma_f32_32x32x16_bf16(kf[s], qf[s], z, 0, 0, 0);
        const bool diag = (kt == qt);
        float c[16], gs[4];
#pragma unroll
        for (int gi = 0; gi < 4; ++gi) {
            float run = 0.f;
#pragma unroll
            for (int e = 3; e >= 0; --e) {
                const int reg = gi * 4 + e;
                const float zz = z[reg];
                float L = -(fmaxf(zz, 0.f) + __logf(1.f + __expf(-fabsf(zz))));
                if (diag && !(r > e + 8 * gi + 4 * hf)) L = 0.f;
                run += L; c[reg] = run;
            }
            gs[gi] = run;
        }
        float go[4], pp[4], ob[4], off[4];
#pragma unroll
        for (int gi = 0; gi < 4; ++gi) { go[gi] = xhalf(gs[gi], lane); pp[gi] = gs[gi] + go[gi]; }
        ob[3] = 0.f; ob[2] = pp[3]; ob[1] = pp[3] + pp[2]; ob[0] = ob[1] + pp[1];
#pragma unroll
        for (int gi = 0; gi < 4; ++gi) off[gi] = ob[gi] + (hf == 0 ? go[gi] : 0.f) + R;
        const float total = ob[0] + pp[0];
        unsigned af[8];
#pragma unroll
        for (int i = 0; i < 8; ++i) {
            float a2[2];
#pragma unroll
            for (int q = 0; q < 2; ++q) {
                const int reg = 2 * i + q, gi = reg >> 2, e = reg & 3;
                float a = __expf(z[reg] + c[reg] + off[gi]);
                if (diag && !(r > e + 8 * gi + 4 * hf)) a = 0.f;
                a2[q] = a;
            }
            af[i] = pk2(a2[0], a2[1]);
        }
        R += total;
        const bf16x8 a0 = __builtin_bit_cast(bf16x8, (u32x4){af[0], af[1], af[2], af[3]});
        const bf16x8 a1 = __builtin_bit_cast(bf16x8, (u32x4){af[4], af[5], af[6], af[7]});
        o0 = __builtin_amdgcn_mfma_f32_32x32x16_bf16(__builtin_bit_cast(bf16x8, (u32x4){vf[0][0][0].x, vf[0][0][0].y, vf[0][0][1].x, vf[0][0][1].y}), a0, o0, 0, 0, 0);
        o0 = __builtin_amdgcn_mfma_f32_32x32x16_bf16(__builtin_bit_cast(bf16x8, (u32x4){vf[0][1][0].x, vf[0][1][0].y, vf[0][1][1].x, vf[0][1][1].y}), a1, o0, 0, 0, 0);
        o1 = __builtin_amdgcn_mfma_f32_32x32x16_bf16(__builtin_bit_cast(bf16x8, (u32x4){vf[1][0][0].x, vf[1][0][0].y, vf[1][0][1].x, vf[1][0][1].y}), a0, o1, 0, 0, 0);
        o1 = __builtin_amdgcn_mfma_f32_32x32x16_bf16(__builtin_bit_cast(bf16x8, (u32x4){vf[1][1][0].x, vf[1][1][0].y, vf[1][1][1].x, vf[1][1][1].y}), a1, o1, 0, 0, 0);
        if (__all(R < ATT_EXIT)) break;
    }
#undef ATT_LOAD
    float ss = 0.f;
#pragma unroll
    for (int i = 0; i < 16; ++i) ss += o0[i] * o0[i] + o1[i] * o1[i];
    ss += xhalf(ss, lane);
    const float rs = rsqrtf(ss * (1.f / 64.f) + 1e-6f);
    bf16_t* op = p.h + ((size_t)b * SEQ + qt * 32 + r) * D + RWW + hh * 64 + 4 * hf;
    const float* gn = p.sb_norm_g + l * SBW + hh * 64 + 4 * hf;
#pragma unroll
    for (int gi = 0; gi < 4; ++gi) {
        const f32x4 g0 = *(const f32x4*)(gn + 8 * gi), g1 = *(const f32x4*)(gn + 32 + 8 * gi);
        u32x2 w0, w1;
        w0.x = pk2(o0[4 * gi] * rs * g0[0], o0[4 * gi + 1] * rs * g0[1]); w0.y = pk2(o0[4 * gi + 2] * rs * g0[2], o0[4 * gi + 3] * rs * g0[3]);
        w1.x = pk2(o1[4 * gi] * rs * g1[0], o1[4 * gi + 1] * rs * g1[1]); w1.y = pk2(o1[4 * gi + 2] * rs * g1[2], o1[4 * gi + 3] * rs * g1[3]);
        *(u32x2*)(op + 8 * gi) = w0; *(u32x2*)(op + 32 + 8 * gi) = w1;
    }
}

__device__ __forceinline__ void st_pool(const P& p, int l, int vb, LAS float* PL  ) {
    const int tid = opaque(threadIdx.x);
    const int t0 = vb * 32, s0 = t0 % SEQ;
    {
        const int col = tid & 255, th = tid >> 8, g = col >> 6, win = 2 << g;
        const int sA = s0 + th * 16;
        const bf16_t* u = p.proj + (size_t)(t0 + th * 16) * PJB + RWC + SBC + col;
        float xv[31];
#pragma unroll
        for (int i = 0; i < 31; ++i) { const int s = sA - 15 + i; xv[i] = (s >= 0 && (i >= 15 || 15 - i < win)) ? bf2f(u[(ptrdiff_t)(i - 15) * PJB]) : 0.f; }
        float run = 0.f;
#pragma unroll
        for (int i = 0; i < 15; ++i) run += (15 - i < win) ? xv[i] : 0.f;
#pragma unroll
        for (int j = 0; j < 16; ++j) {
            run += xv[15 + j];
            const int s = sA + j, n = min(s + 1, win);
            PL[(th * 16 + j) * 256 + col] = run / (float)n - xv[15 + j];
            float drop = 0.f;
#pragma unroll
            for (int q = 1; q <= 4; ++q) if (win == (1 << q)) drop = xv[15 + j - (1 << q) + 1];
            run -= drop;
        }
    }
    __syncthreads();
    {
        const int wave = tid >> 6, lane = tid & 63, g = wave & 3, th = wave >> 2;
        float acc[16];
#pragma unroll
        for (int j = 0; j < 16; ++j) acc[j] = 0.f;
        const float* pw = p.pool_w + ((size_t)l * 4 + g) * 64 * 64 + lane;
        for (int c = 0; c < 64; c += 4) {
            const float w0 = pw[c * 64], w1 = pw[(c + 1) * 64], w2 = pw[(c + 2) * 64], w3 = pw[(c + 3) * 64];
#pragma unroll
            for (int j = 0; j < 16; ++j) { const f32x4 x = *(const LAS f32x4*)(PL + (th * 16 + j) * 256 + g * 64 + c); acc[j] += x[0] * w0 + x[1] * w1 + x[2] * w2 + x[3] * w3; }
        }
        const float sc = p.pool_scale[l * PLW + g * 64 + lane];
#pragma unroll
        for (int j = 0; j < 16; ++j) p.h[(size_t)(t0 + th * 16 + j) * D + 768 + g * 64 + lane] = (bf16_t)f2bf(acc[j] * sc);
    }
    __syncthreads();
}

template <bool TOLDS>
__device__ __forceinline__ void norm_row(const float* xr, const float* md  , bf16_t* hrow, LAS float* hl, int lane) {
    f32x4 v[4]; float ss = 0.f;
#pragma unroll
    for (int i = 0; i < 4; ++i) { v[i] = *(const f32x4*)(xr + i * 256 + lane * 4); ss += v[i][0] * v[i][0] + v[i][1] * v[i][1] + v[i][2] * v[i][2] + v[i][3] * v[i][3]; }
    ss = wave_sum(ss);
    const float rs = rsqrtf(ss * (1.f / D) + 1e-6f);
#pragma unroll
    for (int i = 0; i < 4; ++i) {
        const int cidx = i * 256 + lane * 4;
        const f32x4 sh = *(const f32x4*)(md + cidx), sc = *(const f32x4*)(md + 1024 + cidx);
        const f32x4 o = v[i] * rs * (sc + 1.f) + sh;
        u32x2 w; w.x = pk2(o[0], o[1]); w.y = pk2(o[2], o[3]);
        *(u32x2*)(hrow + cidx) = w;
        if constexpr (TOLDS) *(LAS f32x4*)(hl + cidx) = o;
    }
}

__device__ __forceinline__ void split_bf16(const float (&x)[8], bf16x8& hi, bf16x8& lo) {
    unsigned h[4], l[4];
#pragma unroll
    for (int q = 0; q < 4; ++q) {
        const unsigned ph = cvtpk(x[2 * q], x[2 * q + 1]);
        const float r0 = x[2 * q] - bflo(ph), r1 = x[2 * q + 1] - bfhi(ph);
        h[q] = ph; l[q] = cvtpk(r0, r1);
    }
    hi = mk8(h[0], h[1], h[2], h[3]); lo = mk8(l[0], l[1], l[2], l[3]);
}
__device__ __forceinline__ void st_normrouter(const P& p, int l, int vb0, int vbstride, LAS float* L  ) {
    const int tid = opaque(threadIdx.x), wave = tid >> 6, lane = tid & 63;
    const int fr = lane & 15, fq = lane >> 4;
    LAS float* H = L; LAS float* PART = L + 16 * 1024; LAS float* SEL = PART + 8 * 16 * 64; LAS int* lcnt = (LAS int*)(SEL + 16 * 72);
    bf16x8 Bh[4][4], Bl[4][4];
    {
        const float* wr = p.w_router + ((size_t)l * D + wave * 128) * NE;
        const int ll = opaque(lane), fr2 = ll & 15, fq2 = ll >> 4;
#pragma unroll
        for (int ks = 0; ks < 4; ++ks)
#pragma unroll
            for (int nt = 0; nt < 4; ++nt) {
                float x[8];
#pragma unroll
                for (int j = 0; j < 8; ++j) x[j] = wr[(32 * ks + 8 * fq2 + j) * NE + 16 * nt + fr2];
                split_bf16(x, Bh[ks][nt], Bl[ks][nt]);
            }
    }
    const float brt = p.b_router[l * NE + lane];
    for (int vb = vb0; vb < T / 16; vb += vbstride) {
        const int t0 = vb * 16, b = t0 / SEQ;
        const float* md = p.mod + ((size_t)l * 8 + b) * 6144 + 3072;
        if (tid < 64) lcnt[tid] = 0;
        unsigned pfv = 0u;
        if (vb + vbstride < T / 16) pfv = pf_lines(p.xb + (size_t)((vb + vbstride) * 16 + wave * 2) * D, 2 * D * 4, lane);
#pragma unroll
        for (int q = 0; q < 2; ++q) { const int tt = wave * 2 + q; norm_row<true>(p.xb + (size_t)(t0 + tt) * D, md, p.h + (size_t)(t0 + tt) * D, H + tt * 1024, lane); }
        __syncthreads();
        {
            f32x4 acc[4];
#pragma unroll
            for (int nt = 0; nt < 4; ++nt) acc[nt] = (f32x4){0.f, 0.f, 0.f, 0.f};
#pragma unroll
            for (int ks = 0; ks < 4; ++ks) {
                const LAS float* hp = H + fr * 1024 + wave * 128 + 32 * ks + 8 * fq;
                const f32x4 h0 = *(const LAS f32x4*)hp, h1 = *(const LAS f32x4*)(hp + 4);
                const float x[8] = {h0[0], h0[1], h0[2], h0[3], h1[0], h1[1], h1[2], h1[3]};
                bf16x8 ah, al; split_bf16(x, ah, al);
#pragma unroll
                for (int nt = 0; nt < 4; ++nt) {
                    acc[nt] = __builtin_amdgcn_mfma_f32_16x16x32_bf16(ah, Bh[ks][nt], acc[nt], 0, 0, 0);
                    acc[nt] = __builtin_amdgcn_mfma_f32_16x16x32_bf16(ah, Bl[ks][nt], acc[nt], 0, 0, 0);
                    acc[nt] = __builtin_amdgcn_mfma_f32_16x16x32_bf16(al, Bh[ks][nt], acc[nt], 0, 0, 0);
                }
            }
#pragma unroll
            for (int nt = 0; nt < 4; ++nt)
#pragma unroll
                for (int rg = 0; rg < 4; ++rg) PART[(wave * 16 + 4 * fq + rg) * 64 + 16 * nt + fr] = acc[nt][rg];
        }
        __syncthreads();
#pragma unroll
        for (int q = 0; q < 2; ++q) {
            const int tt = wave * 2 + q, t = t0 + tt;
            float logit = 0.f;
#pragma unroll
            for (int w = 0; w < 8; ++w) logit += PART[(w * 16 + tt) * 64 + lane];
            float score = sigmoidf_(logit);
            score = (score == score) ? score : 0.f;
            const float sl = score + brt;
            LAS float* sel = SEL + (wave * 2 + q) * 72; LAS float* gs = sel + 64;
            sel[lane] = sl;
            if (lane < 8) {
                float m1 = -INFINITY, m2 = -INFINITY;
                for (int i = 0; i < 8; ++i) { const float v = sel[lane * 8 + i]; if (v > m1) { m2 = m1; m1 = v; } else if (v > m2) m2 = v; }
                gs[lane] = m1 + m2;
            }
            const int gI = lane >> 3;
            int grank = 0;
            for (int i = 0; i < 8; ++i) { const float v = gs[i]; grank += (v > gs[gI] || (v == gs[gI] && i < gI)) ? 1 : 0; }
            const float msk = (grank < 4) ? sl : -INFINITY;
            sel[lane] = msk;
            int rank = 0;
            for (int i = 0; i < 64; ++i) { const float v = sel[i]; rank += (v > msk || (v == msk && i < lane)) ? 1 : 0; }
            const bool chosen = rank < TOPK;
            const float wsum = wave_sum(chosen ? score : 0.f);
            if (chosen) {
                const int pos = __hip_atomic_fetch_add(&lcnt[lane], 1, __ATOMIC_RELAXED, __HIP_MEMORY_SCOPE_WORKGROUP);
                p.seg[((size_t)lane * 1024 + vb) * 16 + pos] = t * TOPK + rank;
                p.topw[(size_t)t * TOPK + rank] = score / (wsum + 1e-20f) * 2.5f;
            }
        }
        __syncthreads();
        if (tid < 64) p.cnt2[tid * 1024 + vb] = lcnt[tid];
        pf_done(pfv);
        __syncthreads();
    }
}

__device__ __forceinline__ void st_compact(const P& p, int e, LAS int* wt  ) {
    const int tid = opaque(threadIdx.x), wave = tid >> 6, lane = tid & 63;
    const int c0 = p.cnt2[e * 1024 + 2 * tid], c1 = p.cnt2[e * 1024 + 2 * tid + 1], s = c0 + c1;
    int incl = s;
#pragma unroll
    for (int o = 1; o < 64; o <<= 1) { const int v = __builtin_amdgcn_ds_bpermute(((lane - o) & 63) << 2, incl); if (lane >= o) incl += v; }
    if (lane == 63) wt[wave] = incl;
    __syncthreads();
    int base = 0;
    for (int w = 0; w < wave; ++w) base += wt[w];
    const int excl = base + incl - s;
    int* dst = p.list + (size_t)e * T + excl;
    const int* s0 = p.seg + ((size_t)e * 1024 + 2 * tid) * 16;
    for (int j = 0; j < c0; ++j) dst[j] = s0[j];
    for (int j = 0; j < c1; ++j) dst[c0 + j] = s0[16 + j];
    if (tid == NTHREADS - 1) p.cnt[e] = base + incl;
    __syncthreads();
}

__device__ __forceinline__ void st_combine(const P& p, int l, int t, int lane) {
    const int b = t / SEQ;
    const float* gt = p.mod + ((size_t)l * 8 + b) * 6144 + 5120;
    const bf16_t* sl = p.slab + (size_t)t * TOPK * D;
    float* xr = p.xb + (size_t)t * D;
    float xv[16]; float ss = 0.f;
#pragma unroll
    for (int i = 0; i < 2; ++i) {
        const int cidx = i * 512 + lane * 8;
        float f[8];
#pragma unroll
        for (int j = 0; j < 8; ++j) f[j] = 0.f;
#pragma unroll
        for (int s = 0; s < TOPK; ++s) {
            const u32x4 q = *(const u32x4*)(sl + (size_t)s * D + cidx);
            f[0] += bflo(q.x); f[1] += bfhi(q.x); f[2] += bflo(q.y); f[3] += bfhi(q.y); f[4] += bflo(q.z); f[5] += bfhi(q.z); f[6] += bflo(q.w); f[7] += bfhi(q.w);
        }
        const f32x4 x0 = *(const f32x4*)(xr + cidx), x1 = *(const f32x4*)(xr + cidx + 4);
        const f32x4 g0 = *(const f32x4*)(gt + cidx), g1 = *(const f32x4*)(gt + cidx + 4);
#pragma unroll
        for (int j = 0; j < 4; ++j) { xv[i * 8 + j] = x0[j] + g0[j] * f[j]; xv[i * 8 + 4 + j] = x1[j] + g1[j] * f[4 + j]; }
#pragma unroll
        for (int j = 0; j < 8; ++j) ss += xv[i * 8 + j] * xv[i * 8 + j];
    }
    ss = wave_sum(ss);
    const float rs = rsqrtf(ss * (1.f / D) + 1e-6f);
    if (l + 1 < NL) {
        const float* md = p.mod + ((size_t)(l + 1) * 8 + b) * 6144;
#pragma unroll
        for (int i = 0; i < 2; ++i) {
            const int cidx = i * 512 + lane * 8;
            *(f32x4*)(xr + cidx) = (f32x4){xv[i * 8], xv[i * 8 + 1], xv[i * 8 + 2], xv[i * 8 + 3]};
            *(f32x4*)(xr + cidx + 4) = (f32x4){xv[i * 8 + 4], xv[i * 8 + 5], xv[i * 8 + 6], xv[i * 8 + 7]};
            float o[8];
#pragma unroll
            for (int j = 0; j < 8; ++j) o[j] = xv[i * 8 + j] * rs * (1.f + md[1024 + cidx + j]) + md[cidx + j];
            u32x4 w; w.x = pk2(o[0], o[1]); w.y = pk2(o[2], o[3]); w.z = pk2(o[4], o[5]); w.w = pk2(o[6], o[7]);
            *(u32x4*)(p.h + (size_t)t * D + cidx) = w;
        }
    } else {
#pragma unroll
        for (int i = 0; i < 2; ++i) {
            const int cidx = i * 512 + lane * 8;
            const f32x4 g0 = *(const f32x4*)(p.g_final + cidx), g1 = *(const f32x4*)(p.g_final + cidx + 4);
            *(f32x4*)(p.out + (size_t)t * D + cidx) = (f32x4){xv[i * 8] * rs * g0[0], xv[i * 8 + 1] * rs * g0[1], xv[i * 8 + 2] * rs * g0[2], xv[i * 8 + 3] * rs * g0[3]};
            *(f32x4*)(p.out + (size_t)t * D + cidx + 4) = (f32x4){xv[i * 8 + 4] * rs * g1[0], xv[i * 8 + 5] * rs * g1[1], xv[i * 8 + 6] * rs * g1[2], xv[i * 8 + 7] * rs * g1[3]};
        }
    }
}

struct CvtJob { const float* W; bf16_t* WT; int K, N, k0, n0, dst_row0; };
__device__ __forceinline__ void cvt_load(const CvtJob& j, float (&wv)[32], int lane) {
#pragma unroll
    for (int i = 0; i < 32; ++i) wv[i] = j.W[(size_t)(j.k0 + 2 * i + (lane >> 5)) * j.N + j.n0 + (lane & 31)];
}
__device__ __forceinline__ void cvt_store(const CvtJob& j, const float (&wv)[32], LAS float* scr, int lane) {
#pragma unroll
    for (int i = 0; i < 32; ++i) scr[(2 * i + (lane >> 5)) * 33 + (lane & 31)] = wv[i];
    asm volatile("s_waitcnt lgkmcnt(0)" ::: "memory");
    const int c = lane & 7;
#pragma unroll
    for (int q = 0; q < 4; ++q) { const int n = (lane >> 3) + 8 * q; const LAS float* sp = scr + (8 * c) * 33 + n;
        u32x4 o; o.x = pk2(sp[0 * 33], sp[1 * 33]); o.y = pk2(sp[2 * 33], sp[3 * 33]); o.z = pk2(sp[4 * 33], sp[5 * 33]); o.w = pk2(sp[6 * 33], sp[7 * 33]);
        *(u32x4*)(j.WT + (size_t)(j.dst_row0 + n) * j.K + j.k0 + 8 * c) = o; }
    asm volatile("s_waitcnt lgkmcnt(0)" ::: "memory");
}
__device__ __forceinline__ void cvt_item(const float* W, int K, int N, int k0, int n0, bf16_t* WT, int dst_row0, LAS float* scr, int lane) {
    const CvtJob j{W, WT, K, N, k0, n0, dst_row0};
    float wv[32];
    cvt_load(j, wv, lane);
    cvt_store(j, wv, scr, lane);
}
constexpr int CV_IN = 16 * 84, CV_VR = 16, CV_OUT = 16 * 32, CV_DENSE_L = CV_IN + CV_VR + CV_OUT, CV_DENSE = NL * CV_DENSE_L;
__device__ __forceinline__ void cvt_dense_item(const P& p, int it, LAS float* scr, int lane) {
    const int l = it / CV_DENSE_L; int r = it % CV_DENSE_L;
    bf16_t* wti = p.wt_in + (size_t)l * PJB * D;
    if (r < CV_IN) { const int kb = r / 84, nb = r % 84; cvt_item(p.w_in + (size_t)l * D * INC, D, INC, kb * 64, nb * 32, wti, nb * 32, scr, lane); return; }
    r -= CV_IN;
    if (r < CV_VR) {
        if (l == 1) cvt_item(p.w_vres, D, 32, r * 64, 0, wti, INC, scr, lane);
        const int rz0 = (l == 1) ? INC + 32 : INC;
        for (int row = rz0 + (lane >> 3); row < PJB; row += 8) *(u32x4*)(wti + (size_t)row * D + r * 64 + (lane & 7) * 8) = (u32x4){0u, 0u, 0u, 0u};
        return;
    }
    r -= CV_VR;
    { const int kb = r / 32, nb = r % 32; cvt_item(p.w_out + (size_t)l * D * D, D, D, kb * 64, nb * 32, p.wt_out + (size_t)l * D * D, nb * 32, scr, lane); }
}
constexpr int CV_EXP_E = 128 + 128 + 128, CV_EXP = 65 * CV_EXP_E;
__device__ __forceinline__ CvtJob cvt_exp_job(const P& p, int l, int it) {
    const int e = it / CV_EXP_E; int r = it % CV_EXP_E;
    if (r < 256) {
        const int which = r >> 7; r &= 127; const int kb = r >> 3, nb = r & 7;
        const float* W = e < NE ? (which ? p.w_eu : p.w_eg) + ((size_t)l * NE + e) * D * ED : (which ? p.w_su : p.w_sg) + (size_t)l * D * ED;
        const int n0 = nb * 32, pn = n0 >> 7;
        return CvtJob{W, p.wt1 + (size_t)e * 512 * D, D, ED, kb * 64, n0, pn * 256 + which * 128 + (n0 & 127)};
    } else {
        r -= 256; const int kb = r >> 5, nb = r & 31;
        const float* W = e < NE ? p.w_ed + ((size_t)l * NE + e) * ED * D : p.w_sd + (size_t)l * ED * D;
        return CvtJob{W, p.wt2 + (size_t)e * D * ED, ED, D, kb * 64, nb * 32, nb * 32};
    }
}
__device__ __forceinline__ void cvt_exp_stream(const P& p, int l, int first, int stride, LAS float* scr, int lane) {
    if (first >= CV_EXP) return;
    float wa[32], wb[32];
    CvtJob ja = cvt_exp_job(p, l, first), jb = ja;
    cvt_load(ja, wa, lane);
    for (int it = first; it < CV_EXP; it += 2 * stride) {
        const bool hb = it + stride < CV_EXP;
        if (hb) { jb = cvt_exp_job(p, l, it + stride); cvt_load(jb, wb, lane); }
        cvt_store(ja, wa, scr, lane);
        if (!hb) break;
        const bool ha = it + 2 * stride < CV_EXP;
        if (ha) { ja = cvt_exp_job(p, l, it + 2 * stride); cvt_load(ja, wa, lane); }
        cvt_store(jb, wb, scr, lane);
        if (!ha) break;
    }
}

#define XB_TMO      128
#define XB_XCNT(j)  (256  + 64 * (j))
#define XB_XSUB(j)  (1280 + 64 * (j))
#define XB_XGEN(j)  (2304 + 64 * (j))
#define XB_TOP      3328
#define XB_TOPGEN   3392
#define XCD_BAR_WORDS 3456
#define XB_SPIN_CAP (1u << 22)
__device__ __forceinline__ unsigned xb_ld(unsigned* p)              { return __hip_atomic_load(p, __ATOMIC_RELAXED, __HIP_MEMORY_SCOPE_AGENT); }
__device__ __forceinline__ unsigned xb_add(unsigned* p, unsigned v) { return __hip_atomic_fetch_add(p, v, __ATOMIC_RELAXED, __HIP_MEMORY_SCOPE_AGENT); }
__device__ __forceinline__ unsigned xb_xcc_id() { return (unsigned)__builtin_amdgcn_s_getreg((3 << 11) | 20) & 0xFu; }
#define XB_SPIN(cond, bar) do { unsigned _sp = 0; while (cond) { __builtin_amdgcn_s_sleep(1); \
    if ((++_sp & 255u) == 0u) { if (xb_ld(&(bar)[XB_TMO])) break; if (_sp > XB_SPIN_CAP) { atomicAdd(&(bar)[XB_TMO], 1u); break; } } } } while (0)
struct XcdBarrier { unsigned* bar; unsigned x; volatile LAS unsigned* st; };
__device__ __forceinline__ XcdBarrier xcd_barrier_post(unsigned* bar, volatile LAS unsigned* st) {
    XcdBarrier b; b.bar = bar; b.x = xb_xcc_id(); b.st = st;
    if (threadIdx.x == 0) (void)xb_add(&bar[XB_XCNT(b.x)], 1u);
    return b;
}
__device__ __forceinline__ void xcd_barrier_complete(unsigned* bar, unsigned x, unsigned& nloc, unsigned& nx) {
    const unsigned G = gridDim.x * gridDim.y * gridDim.z;
    unsigned sum, cnt, mine, sp = 0u;
    for (;;) {
        sum = 0u; cnt = 0u; mine = 0u;
#pragma unroll
        for (unsigned j = 0; j < 16; ++j) { const unsigned c = xb_ld(&bar[XB_XCNT(j)]); sum += c; cnt += (c > 0u) ? 1u : 0u; mine = (j == x) ? c : mine; }
        if (sum == G) break;
        __builtin_amdgcn_s_sleep(1);
        if ((++sp & 255u) == 0u) { if (xb_ld(&bar[XB_TMO])) break; if (sp > XB_SPIN_CAP) { atomicAdd(&bar[XB_TMO], 1u); break; } }
    }
    nloc = mine > 0u ? mine : 1u; nx = cnt > 0u ? cnt : 1u;
}
__device__ __forceinline__ void xcd_barrier(const XcdBarrier& b0) {
    XcdBarrier b = b0; { unsigned xx = b0.x; asm volatile("" : "+s"(xx)); b.x = xx; }
    asm volatile("s_waitcnt vmcnt(0)" ::: "memory");
    __syncthreads();
    if (threadIdx.x == 0) {
        unsigned* bar = b.bar;
        __builtin_amdgcn_s_waitcnt(0);
        unsigned nloc = b.st[0], nx = b.st[1];
        if (nloc == 0u) { xcd_barrier_complete(bar, b.x, nloc, nx); b.st[0] = nloc; b.st[1] = nx; }
        const unsigned old = xb_add(&bar[XB_XSUB(b.x)], 1u);
        const unsigned gen = old / nloc;
        if (old + 1u == (gen + 1u) * nloc) {
            __builtin_amdgcn_fence(__ATOMIC_RELEASE, "agent");
            asm volatile("s_waitcnt vmcnt(0)" ::: "memory");
            const unsigned og = xb_add(&bar[XB_TOP], 1u);
            const unsigned tg = og / nx;
            if (og + 1u == (tg + 1u) * nx) xb_add(&bar[XB_TOPGEN], 1u);
            else XB_SPIN(xb_ld(&bar[XB_TOPGEN]) == tg, bar);
            __builtin_amdgcn_fence(__ATOMIC_ACQUIRE, "agent");
            xb_add(&bar[XB_XGEN(b.x)], 1u);
            asm volatile("s_waitcnt vmcnt(0)" ::: "memory");
        } else {
            XB_SPIN(xb_ld(&bar[XB_XGEN(b.x)]) == gen, bar);
            __builtin_amdgcn_fence(__ATOMIC_ACQUIRE, "agent");
            asm volatile("s_waitcnt vmcnt(0)" ::: "memory");
        }
    }
    __syncthreads();
}

__device__ __forceinline__ P load_args() {
    P q{};
#if defined(__HIP_DEVICE_COMPILE__)
    const __attribute__((address_space(4))) unsigned long long* k = (const __attribute__((address_space(4))) unsigned long long*)__builtin_amdgcn_kernarg_segment_ptr();
    asm volatile("" : "+s"(k));
    unsigned long long w[sizeof(P) / 8];
#pragma unroll
    for (unsigned i = 0; i < sizeof(P) / 8; ++i) w[i] = k[i];
    __builtin_memcpy(&q, w, sizeof(P));
#endif
    return q;
}
enum Ph { PH_NORM1 = 0, PH_INPROJ, PH_PREP, PH_CPRE, PH_MIX, PH_RWOUT, PH_OUTPROJ, PH_ROUTER, PH_COMPACT, PH_EXP1, PH_EXP2, PH_COMBINE, PH_PER_LAYER };

__global__ void __launch_bounds__(NTHREADS, 2) k_fused(P p_arg) {
    (void)p_arg;
#define KARGS() load_args()
    extern __shared__ __attribute__((aligned(16))) unsigned char lds_raw[];
    LAS unsigned char* lds = (LAS unsigned char*)lds_raw;
    LAS int* tstart = (LAS int*)(lds + LDS_STAGE);
    LAS int* cnts = (LAS int*)(lds + LDS_STAGE + 272);
    volatile LAS unsigned* bst = (volatile LAS unsigned*)(lds + LDS_STAGE + 1008);
    if (threadIdx.x < 4) bst[threadIdx.x] = 0u;
    __syncthreads();
    XcdBarrier xb = xcd_barrier_post(load_args().bar, bst);
#define PHASE_COORDS() int G = gridDim.x, bx = blockIdx.x; asm volatile("" : "+s"(G), "+s"(bx)); const int vcu = (G % 8 == 0) ? (bx % 8) * (G / 8) + bx / 8 : bx; (void)vcu; \
    const int tid = opaque(threadIdx.x), half = tid >> 8, lane = tid & 63, wave = __builtin_amdgcn_readfirstlane(tid >> 6); \
    float* smem = (float*)lds_raw + half * 8192; LAS float* scr = (LAS float*)(lds + wave * 16384); (void)lane; (void)smem; (void)scr; (void)tid

    for (int rep = 0; rep < (REP_PH == -1 ? REP_N : 1); ++rep) {
        const P p = KARGS();
        PHASE_COORDS();
        for (int it = bx; it < NL * 96; it += G) st_mod(p, it, (LAS float*)lds);
        __syncthreads();
        for (int it = (bx * 8 + wave); it < CV_DENSE; it += G * 8) cvt_dense_item(p, it, scr, lane);
        for (int idx = bx * NTHREADS + tid; idx < NL * RWW * 160; idx += G * NTHREADS) {
            const int k = idx % 160, c = (idx / 160) % RWW, ly = idx / (160 * RWW);
            float v;
            if (k < 32) v = p.rw_w2[((size_t)ly * 32 + k) * RWW + c];
            else if (k < 64) v = p.rw_a2[((size_t)ly * 32 + (k - 32)) * RWW + c];
            else if (k < 128) v = p.rw_g2[((size_t)ly * 64 + (k - 64)) * RWW + c];
            else v = (ly == 1) ? p.rw_v2[(size_t)(k - 128) * RWW + c] : 0.f;
            p.lwt[idx] = (bf16_t)f2bf(v);
        }
        xcd_barrier(xb);
    }

    constexpr int NPH2 = NL * PH_PER_LAYER + ((REP_PH >= 0) ? REP_N - 1 : 0);
    for (int ph2 = 0; ph2 < NPH2; ++ph2) {
      {
        const int ph = (REP_PH < 0 || ph2 <= REP_PH) ? ph2 : (ph2 < REP_PH + REP_N ? REP_PH : ph2 - (REP_N - 1));
        const int rep = (REP_PH >= 0 && ph2 > REP_PH && ph2 < REP_PH + REP_N) ? 1 : 0; (void)rep;
        const int l = ph / PH_PER_LAYER, st = ph % PH_PER_LAYER;
        const P p = KARGS();
        PHASE_COORDS();
        if (st == PH_NORM1) {
            if (l == 0) {
                for (int t = bx * 8 + wave; t < T; t += G * 8) {
                    const int tn = t + G * 8; unsigned pfv = 0u;
                    if (tn < T) pfv = pf_lines(p.x + (size_t)tn * D, D * 4, lane);
                    norm_row<false>(p.x + (size_t)t * D, p.mod + (size_t)(t / SEQ) * 6144, p.h + (size_t)t * D, (LAS float*)lds, lane);
                    pf_done(pfv);
                }
            }
        } else if (st == PH_INPROJ) {
            pg8::DenseOrder S; S.init(p.h, p.wt_in + (size_t)l * PJB * D, T, PJB, D, G, bx);
            pg8::EpiProj E{p.proj, p.vt};
            pg8::gemm_phase<pg8::EpiProj, pg8::DenseOrder, true, true>(lds, D, S, E);
        } else if (st == PH_PREP) {
            st_prep(p, l, bx, G, lds);
        } else if (st == PH_CPRE) {
            if (wave < CP_WAVES) for (int it = bx * CP_WAVES + wave; it < NBATCH * 6 * (SEQ / 32); it += G * CP_WAVES) st_cpre(p, it, lds + wave * CP_LDS, lane);
        } else if (st == PH_MIX) {
            constexpr int N1 = NBATCH * 6, N2 = NBATCH * 6 * (SEQ / 32) / 8, N3 = T / 32, N4 = (CV_EXP + 7) / 8;
            const int sel = (rep == 0) ? 15 : REP_SEL;
            if (sel & 1) for (int wb = bx; wb < N1; wb += G) st_cscan(p, wb, lds);
            __syncthreads();
            for (int wb = bx; wb < N2 + N3; wb += G) {
                if (wb < N2) { if (sel & 2) st_attn(p, l, wb * 8 + wave); }
                else if (sel & 4) st_pool(p, l, wb - N2, (LAS float*)lds);
            }
            (void)N4;
            if (sel & 8) cvt_exp_stream(p, l, bx * 8 + wave, G * 8, scr, lane);
        } else if (st == PH_RWOUT) {
            for (int t = bx * 8 + wave; t < T; t += G * 8) {
                const int tn = t + G * 8; unsigned pfv = 0u;
                if (tn < T) pfv = pf_lines(p.y + (size_t)tn * RWW, RWW * 4, lane) + pf_lines(p.rec + (size_t)tn * REC_TB, REC_TB, lane) + pf_lines(p.g + (size_t)tn * RWW, RWW * 2, lane);
                st_rwout(p, l, t, lane);
                pf_done(pfv);
            }
        } else if (st == PH_OUTPROJ) {
            pg8::DenseOrder S; S.init(p.h, p.wt_out + (size_t)l * D * D, T, D, D, G, bx);
            pg8::EpiOut E{l == 0 ? p.x : p.xb, p.xb, p.mod + (size_t)l * 8 * 6144 + 2048};
            pg8::gemm_phase<pg8::EpiOut, pg8::DenseOrder, true, true>(lds, D, S, E);
        } else if (st == PH_ROUTER) {
            st_normrouter(p, l, bx, G, (LAS float*)lds);
        } else if (st == PH_COMPACT) {
            if (bx < NE) st_compact(p, bx, (LAS int*)lds);
        } else if (st == PH_EXP1 || st == PH_EXP2) {
            __syncthreads();
            if (tid == 0) {
                int acc = 0;
                for (int e = 0; e < 65; ++e) { const int c = e < NE ? p.cnt[e] : T; cnts[e] = c; tstart[e] = acc; acc += (c + 255) >> 8; }
                tstart[65] = acc;
            }
            __syncthreads();
            if (st == PH_EXP1) {
                pg8::MoeOrder<true> S{tstart, cnts, p.list, p.h, p.wt1, D, 512, 1, G, vcu};
                pg8::EpiExp1 E{p.hm};
                pg8::gemm_phase<pg8::EpiExp1, pg8::MoeOrder<true>, true, true>(lds, D, S, E);
            } else {
                pg8::MoeOrder<false> S{tstart, cnts, p.list, p.hm, p.wt2, ED, D, 2, G, vcu};
                pg8::EpiExp2 E{p.slab, p.xb, p.mod + (size_t)l * 8 * 6144 + 5120, p.list, p.topw, cnts, rep};
                pg8::gemm_phase<pg8::EpiExp2, pg8::MoeOrder<false>, true, true>(lds, ED, S, E);
            }
        } else {
            for (int t = bx * 8 + wave; t < T; t += G * 8) {
                const int tn = t + G * 8; unsigned pfv = 0u;
                if (tn < T) pfv = pf_lines(p.slab + (size_t)tn * TOPK * D, TOPK * D * 2, lane) + pf_lines(p.xb + (size_t)tn * D, D * 4, lane);
                st_combine(p, l, t, lane);
                pf_done(pfv);
            }
        }
        if (!(ph2 == NPH2 - 1)) { if (!(st == PH_NORM1 && l > 0)) xcd_barrier(xb); }
      }
    }
#undef PHASE_COORDS
#undef KARGS
}

}

extern "C" void kernel_launch(void* const* d_in, const int* in_sizes, int n_in, void* d_out, int out_size, void* d_ws, size_t ws_size,
                              hipStream_t stream) {
    P p{};
    const float** fp = (const float**)&p;
    for (int i = 0; i < 33; ++i) fp[i] = (const float*)d_in[i];
    p.out = (float*)d_out;
    char* ws = (char*)d_ws;
    size_t off = 0;
    auto take = [&](size_t bytes) { char* r = ws + off; off += (bytes + 255) & ~(size_t)255; return r; };
    p.bar = (unsigned*)take(16384);
    p.cnt = (int*)take(256);
    p.mod = (float*)take((size_t)NL * 8 * 6144 * 4);
    p.list = (int*)take((size_t)NE * T * 4);
    p.cnt2 = (int*)take((size_t)NE * 1024 * 4);
    p.seg = (int*)take((size_t)NE * 1024 * 16 * 4);
    p.topw = (float*)take((size_t)T * TOPK * 4);
    p.wt_in = (bf16_t*)take((size_t)NL * PJB * D * 2);
    p.wt_out = (bf16_t*)take((size_t)NL * D * D * 2);
    p.lwt = (bf16_t*)take((size_t)NL * RWW * 160 * 2);
    p.wt1 = (bf16_t*)take((size_t)65 * 512 * D * 2);
    p.wt2 = (bf16_t*)take((size_t)65 * D * ED * 2);
    p.xb = (float*)take((size_t)T * D * 4);
    p.h = (bf16_t*)take((size_t)T * D * 2);
    p.vfirst = (bf16_t*)take((size_t)T * RWW * 2);
    const size_t ov = off;
    p.proj = (bf16_t*)take((size_t)T * PJB * 2);
    p.vt = (bf16_t*)take((size_t)T * SBW * 2);
    p.rec = (unsigned char*)take((size_t)T * REC_TB);
    p.g = (bf16_t*)take((size_t)T * RWW * 2);
    p.y = (float*)take((size_t)T * RWW * 4);
    p.cb = (unsigned char*)take((size_t)NBATCH * 6 * (SEQ / 32) * CB_BYTES);
    p.hm = (bf16_t*)(ws + ov);
    p.slab = (bf16_t*)(ws + ov + (size_t)MAXRT * 256 * ED * 2);
    const size_t end_moe = ov + (size_t)MAXRT * 256 * ED * 2 + (size_t)T * TOPK * D * 2;
    if (end_moe > off) off = end_moe;
    if (off > ws_size) { fprintf(stderr, "kernel_launch: workspace too small: need %zu, have %zu\n", off, ws_size); return; }

    static int cus = 0;
    if (cus == 0) {
        int dev = 0, n = 0;
        if (hipGetDevice(&dev) != hipSuccess || hipDeviceGetAttribute(&n, hipDeviceAttributeMultiprocessorCount, dev) != hipSuccess || n <= 0) n = 256;
        (void)hipFuncSetAttribute((const void*)k_fused, hipFuncAttributeMaxDynamicSharedMemorySize, LDS_BYTES);
        cus = n;
    }
    (void)hipMemsetAsync(p.bar, 0, 16384 + 256, stream);
    void* args[] = {(void*)&p};
    (void)hipLaunchCooperativeKernel((const void*)k_fused, dim3(cus), dim3(NTHREADS), args, LDS_BYTES, stream);
}
```

```cpp
#include <hip/hip_runtime.h>
#include <stdint.h>
#include <stdio.h>

#define REP_PH -2
#define REP_N 1
#define REP_SEL 15

namespace {

typedef unsigned short bf16_t;
typedef short bf16x8 __attribute__((ext_vector_type(8)));
typedef float f32x4 __attribute__((ext_vector_type(4)));
typedef float f32x2 __attribute__((ext_vector_type(2)));
typedef unsigned u32x4 __attribute__((ext_vector_type(4)));
typedef unsigned u32x2 __attribute__((ext_vector_type(2)));
#define LAS __attribute__((address_space(3)))

constexpr int D = 1024, NBATCH = 8, SEQ = 2048, T = NBATCH * SEQ, NL = 2;
constexpr int RWW = 384, SBW = 384, PLW = 256;
constexpr int RWC = 1280, SBC = 1152, INC = 2688;
constexpr int PJB = 2816;
constexpr int NE = 64, TOPK = 6, ED = 256;
constexpr int MAXRT = 512;
constexpr int NTHREADS = 512;
constexpr int LDS_STAGE = 131072, LDS_CTL = 1024, LDS_BYTES = LDS_STAGE + LDS_CTL;

struct P {
    const float *x, *c, *w_ada, *b_ada, *w_in, *w_vres, *mu_rw, *mu_vres, *rw_w0, *rw_w2, *rw_a0, *rw_a2,
        *rw_v0, *rw_v2, *rw_g2, *rw_k_k, *rw_k_a, *rw_r_k, *rw_ln_g, *rw_ln_b, *sb_norm_g, *pool_w, *pool_scale,
        *w_out, *w_router, *b_router, *w_eg, *w_eu, *w_ed, *w_sg, *w_su, *w_sd, *g_final;
    float* out;
    unsigned* bar;
    float* mod;
    int* cnt;
    int* list;
    int* cnt2;
    int* seg;
    float* topw;
    bf16_t* wt_in;
    bf16_t* wt_out;
    bf16_t* lwt;
    bf16_t* wt1;
    bf16_t* wt2;
    float* xb;
    bf16_t* h;
    bf16_t* vfirst;
    bf16_t* proj;
    bf16_t* vt;
    unsigned char* rec;
    unsigned char* cb;
    bf16_t* g;
    float* y;
    bf16_t* hm;
    bf16_t* slab;
};

__device__ __forceinline__ int opaque(int x) { asm volatile("" : "+v"(x)); return x; }
__device__ __forceinline__ float dpp_add16(float x) {
    x += __builtin_bit_cast(float, __builtin_amdgcn_update_dpp(0, __builtin_bit_cast(int, x), 0xB1, 0xF, 0xF, true));
    x += __builtin_bit_cast(float, __builtin_amdgcn_update_dpp(0, __builtin_bit_cast(int, x), 0x4E, 0xF, 0xF, true));
    x += __builtin_bit_cast(float, __builtin_amdgcn_update_dpp(0, __builtin_bit_cast(int, x), 0x141, 0xF, 0xF, true));
    x += __builtin_bit_cast(float, __builtin_amdgcn_update_dpp(0, __builtin_bit_cast(int, x), 0x140, 0xF, 0xF, true));
    return x;
}
__device__ __forceinline__ float wave_sum(float v) {
    v = dpp_add16(v);
    const int vi = __builtin_bit_cast(int, v);
    return (__builtin_bit_cast(float, __builtin_amdgcn_readlane(vi, 0)) + __builtin_bit_cast(float, __builtin_amdgcn_readlane(vi, 16)))
         + (__builtin_bit_cast(float, __builtin_amdgcn_readlane(vi, 32)) + __builtin_bit_cast(float, __builtin_amdgcn_readlane(vi, 48)));
}
typedef __bf16 bf16x2_t __attribute__((ext_vector_type(2)));
__device__ __forceinline__ unsigned cvtpk(float lo, float hi) { const f32x2 v = {lo, hi}; const bf16x2_t b = __builtin_convertvector(v, bf16x2_t); return __builtin_bit_cast(unsigned, b); }
__device__ __forceinline__ bf16x8 mk8(unsigned a, unsigned b, unsigned c, unsigned d) { return __builtin_bit_cast(bf16x8, (u32x4){a, b, c, d}); }
__device__ __forceinline__ unsigned pf_lines(const void* p, int nbytes, int lane) {
    unsigned acc = 0u;
    for (int off = lane * 128; off < nbytes; off += 8192) acc += *(const unsigned*)((const char*)p + off);
    return acc;
}
__device__ __forceinline__ void pf_done(unsigned v) { asm volatile("" :: "v"(v)); }
__device__ __forceinline__ float sigmoidf_(float x) { return 1.f / (1.f + __expf(-x)); }
__device__ __forceinline__ float softplusf_(float x) { return fmaxf(x, 0.f) + __logf(1.f + __expf(-fabsf(x))); }
__device__ __forceinline__ float siluf_(float x) { return x / (1.f + __expf(-x)); }
__device__ __forceinline__ unsigned f2bf(float f) { unsigned u = __builtin_bit_cast(unsigned, f); return (u + 0x7fffu + ((u >> 16) & 1u)) >> 16; }
__device__ __forceinline__ unsigned pk2(float lo, float hi) { return f2bf(lo) | (f2bf(hi) << 16); }
__device__ __forceinline__ float bf2f(bf16_t h) { return __builtin_bit_cast(float, (unsigned)h << 16); }
__device__ __forceinline__ float bflo(unsigned u) { return __builtin_bit_cast(float, u << 16); }
__device__ __forceinline__ float bfhi(unsigned u) { return __builtin_bit_cast(float, u & 0xffff0000u); }

namespace pg8 {
constexpr int BM = 256, BK = 64, HALF = 128, HTB = HALF * BK * 2, STAGE_BYTES = 8 * HTB;
__device__ __forceinline__ int lds_byte(int r, int c) { const int st = (r >> 4) * 2 + (c >> 5), rr = r & 15, cc = c & 31, ob = rr * 64 + cc * 2; return st * 1024 + (ob ^ (((ob >> 9) & 1) << 5)); }
__device__ __forceinline__ void stage_rc(int b, int& R, int& C) { const int st = b / 1024, sb = b % 1024, swz = sb ^ (((sb >> 9) & 1) << 5); R = (st >> 1) * 16 + swz / 64; C = (st & 1) * 32 + (swz % 64) / 2; }
__device__ __forceinline__ int perm32(int rho) { const int n = rho >> 4, i = rho & 15; return 8 * (i >> 2) + 4 * n + (i & 3); }

struct Unit { int pm, pn, e, mt; };

template <class Epi, class Sched, bool ALIGN_EPI, bool SP2>
__device__ __forceinline__ void gemm_phase(LAS unsigned char* lds, const int K, const Sched& S, const Epi& E) {
    const int tid = opaque(threadIdx.x), wid = __builtin_amdgcn_readfirstlane(tid >> 6), lane = tid & 63, wr = wid >> 2, wc = wid & 3, fr = lane & 15, fq = lane >> 4;
    const int nt = K / BK;
    unsigned voffA[2], voffB[2];
#pragma unroll
    for (int i = 0; i < 2; ++i) { int R, C; stage_rc(tid * 16 + i * 8192, R, C); const int Rb = Epi::PERM ? ((R & ~31) + perm32(R & 31)) : R;
        voffA[i] = Sched::GATHER ? (unsigned)(C * 2) : (unsigned)(R * K + C) * 2u; voffB[i] = (unsigned)(Rb * K + C) * 2u; }
    const size_t kstep = (size_t)(BK * 2);
    const size_t hstep = (size_t)HALF * K * 2;
    const unsigned ldsw = (unsigned)wid * 1024u;
    const int aoff = lds_byte(wr * 64 + fr, fq * 8), boff = lds_byte(wc * 32 + fr, fq * 8);
#define PG8_SA(b, h) (((b) * 2 + (h)) * HTB)
#define PG8_SB(b, h) ((4 + (b) * 2 + (h)) * HTB)
#define PG8_STAGE(bufoff, gbase, voff) do { _Pragma("unroll") for (int _i = 0; _i < 2; ++_i) \
        __builtin_amdgcn_global_load_lds((const unsigned*)((const char*)(gbase) + (voff)[_i]), (LAS unsigned*)(lds + (bufoff) + ldsw + _i * 8192), 16, 0, 0); } while (0)
#define PG8_LDA(dst, b, h) do { _Pragma("unroll") for (int m = 0; m < 4; ++m) _Pragma("unroll") for (int k = 0; k < 2; ++k) dst[m][k] = *(const LAS bf16x8*)(lds + PG8_SA(b, h) + aoff + m * 2048 + k * 1024); } while (0)
#define PG8_LDB(dst, b, h) do { _Pragma("unroll") for (int n = 0; n < 2; ++n) _Pragma("unroll") for (int k = 0; k < 2; ++k) dst[n][k] = *(const LAS bf16x8*)(lds + PG8_SB(b, h) + boff + n * 2048 + k * 1024); } while (0)
#define PG8_MMA(ai, bj, At, Bt) do { __builtin_amdgcn_s_setprio(1); _Pragma("unroll") for (int m = 0; m < 4; ++m) _Pragma("unroll") for (int n = 0; n < 2; ++n) _Pragma("unroll") for (int k = 0; k < 2; ++k) \
        acc[ai][bj][m][n] = __builtin_amdgcn_mfma_f32_16x16x32_bf16(Bt[n][k], At[m][k], acc[ai][bj][m][n], 0, 0, 0); __builtin_amdgcn_s_setprio(0); } while (0)
#define PG8_WAIT_V(n) asm volatile("s_waitcnt vmcnt(" #n ")" ::: "memory")
#define PG8_WAIT_L(n) asm volatile("s_waitcnt lgkmcnt(" #n ")" ::: "memory")
#define PG8_BAR __builtin_amdgcn_s_barrier()
#define PG8_SCHED __builtin_amdgcn_sched_barrier(0)
    Unit cur, nxt; int ui = 0;
    if (!S.next(0, cur)) return;
    f32x4 acc[2][2][4][2];
#pragma unroll
    for (int a = 0; a < 2; ++a)
#pragma unroll
        for (int b = 0; b < 2; ++b)
#pragma unroll
            for (int m = 0; m < 4; ++m)
#pragma unroll
                for (int n = 0; n < 2; ++n) acc[a][b][m][n] = (f32x4){0.f, 0.f, 0.f, 0.f};
    bf16x8 At[4][2], B0[2][2], B1[2][2];
    const char* cA = S.a_base(cur); const char* cB = S.b_base(cur);
    unsigned pk[2] = {0u, 0u}, npk[2] = {0u, 0u};
    if constexpr (Sched::GATHER) S.a_tok(cur, tid, pk);
    const unsigned k2 = (unsigned)K * 2u;
#define PG8_STAGE_A(bufoff, gbase, hh, PK) do { if constexpr (Sched::GATHER) { unsigned _v[2]; _v[0] = (((PK)[0] >> (16 * (hh))) & 0xffffu) * k2 + voffA[0]; _v[1] = (((PK)[1] >> (16 * (hh))) & 0xffffu) * k2 + voffA[1]; \
        PG8_STAGE(bufoff, gbase, _v); } else { PG8_STAGE(bufoff, (gbase) + (hh) * hstep, voffA); } } while (0)
    static_assert(SP2, "only the SP2 loop is kept");
    PG8_STAGE(PG8_SB(0, 0), cB, voffB); PG8_STAGE(PG8_SB(0, 1), cB + hstep, voffB); PG8_STAGE_A(PG8_SA(0, 0), cA, 0, pk); PG8_STAGE_A(PG8_SA(0, 1), cA, 1, pk);
    if (wr == 1) PG8_BAR;
    PG8_WAIT_V(2); PG8_BAR;
    PG8_STAGE(PG8_SB(1, 0), cB + kstep, voffB); PG8_STAGE_A(PG8_SA(1, 0), cA + kstep, 0, pk); PG8_STAGE(PG8_SB(1, 1), cB + hstep + kstep, voffB);
    PG8_WAIT_V(6); PG8_BAR;
    for (;;) {
        const bool has_next = S.next(ui + 1, nxt);
        const char* nA = has_next ? S.a_base(nxt) : cA; const char* nB = has_next ? S.b_base(nxt) : cB;
        if constexpr (Sched::GATHER) { if (has_next) S.a_tok(nxt, tid, npk); else { npk[0] = pk[0]; npk[1] = pk[1]; } }
#pragma unroll 1
        for (int t = 0; t < nt; t += 2) {
            const bool last = (t == nt - 2);
            const char* a1 = cA + (size_t)(t + 1) * kstep;
            const char* a2 = last ? nA : cA + (size_t)(t + 2) * kstep; const char* b2 = last ? nB : cB + (size_t)(t + 2) * kstep;
            const char* a3 = a2 + kstep; const char* b3 = b2 + kstep;
            unsigned sp[2]; sp[0] = last ? npk[0] : pk[0]; sp[1] = last ? npk[1] : pk[1];
            PG8_LDB(B0, 0, 0); PG8_LDB(B1, 0, 1); PG8_SCHED; PG8_LDA(At, 0, 0); PG8_STAGE_A(PG8_SA(1, 1), a1, 1, pk);
            PG8_WAIT_V(8); PG8_WAIT_L(0); PG8_BAR; PG8_MMA(0, 0, At, B0); PG8_MMA(0, 1, At, B1); PG8_BAR; PG8_SCHED;
            PG8_LDA(At, 0, 1); PG8_STAGE(PG8_SB(0, 0), b2, voffB); PG8_STAGE(PG8_SB(0, 1), b2 + hstep, voffB); PG8_STAGE_A(PG8_SA(0, 0), a2, 0, sp);
            PG8_WAIT_V(8); PG8_WAIT_L(0); PG8_BAR; PG8_MMA(1, 0, At, B0); PG8_MMA(1, 1, At, B1); PG8_BAR; PG8_SCHED;
            PG8_LDB(B0, 1, 0); PG8_LDB(B1, 1, 1); PG8_SCHED; PG8_LDA(At, 1, 0); PG8_STAGE_A(PG8_SA(0, 1), a2, 1, sp);
            PG8_WAIT_V(8); PG8_WAIT_L(0); PG8_BAR; PG8_MMA(0, 0, At, B0); PG8_MMA(0, 1, At, B1); PG8_BAR; PG8_SCHED;
            PG8_LDA(At, 1, 1); PG8_STAGE(PG8_SB(1, 0), b3, voffB); PG8_STAGE(PG8_SB(1, 1), b3 + hstep, voffB); PG8_STAGE_A(PG8_SA(1, 0), a3, 0, sp);
            PG8_WAIT_V(8); PG8_WAIT_L(0); PG8_BAR; PG8_MMA(1, 0, At, B0); PG8_MMA(1, 1, At, B1); PG8_BAR; PG8_SCHED;
        }
        if constexpr (ALIGN_EPI) { if (wr == 0) PG8_BAR; }
        { const int t2 = opaque(threadIdx.x), w2 = __builtin_amdgcn_readfirstlane(t2 >> 6), l2 = t2 & 63; E(acc, cur, w2 >> 2, w2 & 3, l2 & 15, l2 >> 4); }
        if (!has_next) break;
#pragma unroll
        for (int a = 0; a < 2; ++a)
#pragma unroll
            for (int b = 0; b < 2; ++b)
#pragma unroll
                for (int m = 0; m < 4; ++m)
#pragma unroll
                    for (int n = 0; n < 2; ++n) acc[a][b][m][n] = (f32x4){0.f, 0.f, 0.f, 0.f};
        cur = nxt; cA = nA; cB = nB; ++ui;
        pk[0] = npk[0]; pk[1] = npk[1];
        if constexpr (ALIGN_EPI) { if (wr == 1) PG8_BAR; }
    }
    PG8_WAIT_V(0);
    if constexpr (!ALIGN_EPI) { if (wr == 0) PG8_BAR; }
    PG8_BAR;
#undef PG8_SA
#undef PG8_SB
#undef PG8_STAGE
#undef PG8_STAGE_A
#undef PG8_LDA
#undef PG8_LDB
#undef PG8_MMA
#undef PG8_WAIT_V
#undef PG8_WAIT_L
#undef PG8_BAR
#undef PG8_SCHED
}

struct DenseOrder {
    const bf16_t* A; const bf16_t* Bt; int K; int nM, nN, nwg, G, c;
    __device__ __forceinline__ void init(const bf16_t* A_, const bf16_t* Bt_, int M, int N, int K_, int G_, int c_) { A = A_; Bt = Bt_; K = K_; nM = M / BM; nN = N / BM; nwg = nM * nN; G = G_; c = c_; }
    __device__ __forceinline__ bool next(int i, Unit& u) const {
        const long L = (long)i * G + c; if (L >= nwg) return false;
        int wgid = (int)L; { const int q = nwg / 8, r = nwg % 8, xcd = wgid % 8, off = wgid / 8; wgid = (xcd < r ? xcd * (q + 1) : r * (q + 1) + (xcd - r) * q) + off; }
        const int nig = 8 * nN, gid = wgid / nig, fm = gid * 8, gsz = (nM - fm) < 8 ? (nM - fm) : 8;
        u.pm = fm + ((wgid % nig) % gsz); u.pn = (wgid % nig) / gsz; u.e = 0; u.mt = 0; return true;
    }
    __device__ __forceinline__ const char* a_base(const Unit& u) const { return (const char*)A + (size_t)u.pm * BM * K * 2; }
    __device__ __forceinline__ const char* b_base(const Unit& u) const { return (const char*)Bt + (size_t)u.pn * BM * K * 2; }
    static constexpr bool GATHER = false;
    __device__ __forceinline__ void a_tok(const Unit&, int, unsigned (&)[2]) const {}
};

template <bool GATHER_>
struct MoeOrder {
    static constexpr bool GATHER = GATHER_;
    const LAS int* tstart;
    const LAS int* cnts;
    const int* list;
    const bf16_t* A;
    const bf16_t* Bt;
    int K, N, lognpn, G, c;
    __device__ __forceinline__ bool next(int i, Unit& u) const {
        const int L = i * G + c; const int total = __builtin_amdgcn_readfirstlane(tstart[65]) << lognpn; if (L >= total) return false;
        const int rt = L >> lognpn; u.pn = L & ((1 << lognpn) - 1); u.pm = rt;
        int e = 0;
        for (int j = 1; j < 65; ++j) e += (tstart[j] <= rt) ? 1 : 0;
        e = __builtin_amdgcn_readfirstlane(e);
        u.e = e; u.mt = rt - __builtin_amdgcn_readfirstlane(tstart[e]); return true;
    }
    __device__ __forceinline__ const char* a_base(const Unit& u) const { return GATHER ? (const char*)A : (const char*)A + (size_t)u.pm * BM * K * 2; }
    __device__ __forceinline__ const char* b_base(const Unit& u) const { return (const char*)Bt + ((size_t)u.e * N + (size_t)u.pn * BM) * K * 2; }
    __device__ __forceinline__ void a_tok(const Unit& u, int tid, unsigned (&pkv)[2]) const {
        const int ce = cnts[u.e];
#pragma unroll
        for (int i = 0; i < 2; ++i) {
            int R, C; stage_rc(tid * 16 + i * 8192, R, C); (void)C;
            unsigned v = 0u;
#pragma unroll
            for (int hh = 0; hh < 2; ++hh) {
                const int idx = u.mt * BM + hh * HALF + R;
                int tok = 0;
                if (idx < ce) tok = (u.e < NE) ? (list[(size_t)u.e * T + idx] / TOPK) : idx;
                v |= (unsigned)tok << (16 * hh);
            }
            pkv[i] = v;
        }
    }
};

struct EpiProj {
    static constexpr bool PERM = true;
    bf16_t* O; bf16_t* vt;
    __device__ __forceinline__ void operator()(const f32x4 (&acc)[2][2][4][2], const Unit& u, int wr, int wc, int fr, int fq) const {
        const int row0 = u.pm * BM + wr * 64 + fr, col0 = u.pn * BM + wc * 32 + 8 * fq;
#pragma unroll
        for (int bj = 0; bj < 2; ++bj) {
            const bool isv = (u.pn == 8) || (u.pn == 9 && bj == 0);
            if (!isv) {
#pragma unroll
                for (int ai = 0; ai < 2; ++ai)
#pragma unroll
                    for (int m = 0; m < 4; ++m) { bf16_t* rowp = O + (size_t)(row0 + ai * HALF + m * 16) * PJB + col0 + bj * HALF;
                        const f32x4 v0 = acc[ai][bj][m][0], v1 = acc[ai][bj][m][1];
                        u32x4 w; w.x = pk2(v0[0], v0[1]); w.y = pk2(v0[2], v0[3]); w.z = pk2(v1[0], v1[1]); w.w = pk2(v1[2], v1[3]);
                        *(u32x4*)rowp = w; }
            } else {
                const int vc0 = col0 + bj * HALF - 2048;
#pragma unroll
                for (int ai = 0; ai < 2; ++ai)
#pragma unroll
                    for (int m = 0; m < 4; ++m) { const int row = row0 + ai * HALF + m * 16; const int b = row / SEQ, s = row % SEQ;
                        bf16_t* base = vt + ((size_t)b * SBW + vc0) * SEQ + s;
#pragma unroll
                        for (int n = 0; n < 2; ++n)
#pragma unroll
                            for (int j = 0; j < 4; ++j) base[(size_t)(4 * n + j) * SEQ] = (bf16_t)f2bf(acc[ai][bj][m][n][j]); }
            }
        }
    }
};
struct EpiOut {
    static constexpr bool PERM = false;
    const float* xin; float* xo; const float* gt;
    __device__ __forceinline__ void operator()(const f32x4 (&acc)[2][2][4][2], const Unit& u, int wr, int wc, int fr, int fq) const {
        const int row0 = u.pm * BM + wr * 64 + fr, col0 = u.pn * BM + wc * 32 + 4 * fq;
#pragma unroll
        for (int ai = 0; ai < 2; ++ai)
#pragma unroll
            for (int m = 0; m < 4; ++m) { const int row = row0 + ai * HALF + m * 16; const float* gr = gt + (size_t)(row / SEQ) * 6144;
#pragma unroll
                for (int bj = 0; bj < 2; ++bj)
#pragma unroll
                    for (int n = 0; n < 2; ++n) { const int col = col0 + bj * HALF + 16 * n;
                        const f32x4 xi = *(const f32x4*)(xin + (size_t)row * D + col); const f32x4 gg = *(const f32x4*)(gr + col);
                        *(f32x4*)(xo + (size_t)row * D + col) = xi + gg * acc[ai][bj][m][n]; } }
    }
};
struct EpiExp1 {
    static constexpr bool PERM = true;
    bf16_t* hm;
    __device__ __forceinline__ void operator()(const f32x4 (&acc)[2][2][4][2], const Unit& u, int wr, int wc, int fr, int fq) const {
        const int row0 = u.pm * BM + wr * 64 + fr, col0 = u.pn * HALF + wc * 32 + 8 * fq;
#pragma unroll
        for (int ai = 0; ai < 2; ++ai)
#pragma unroll
            for (int m = 0; m < 4; ++m) { bf16_t* rowp = hm + (size_t)(row0 + ai * HALF + m * 16) * ED + col0;
                float o[8];
#pragma unroll
                for (int n = 0; n < 2; ++n)
#pragma unroll
                    for (int j = 0; j < 4; ++j) o[n * 4 + j] = siluf_(acc[ai][0][m][n][j]) * acc[ai][1][m][n][j];
                u32x4 w; w.x = pk2(o[0], o[1]); w.y = pk2(o[2], o[3]); w.z = pk2(o[4], o[5]); w.w = pk2(o[6], o[7]);
                *(u32x4*)rowp = w; }
    }
};
struct EpiExp2 {
    static constexpr bool PERM = true;
    bf16_t* slab; const int* list; const float* topw; const LAS int* cnts;
    __device__ __forceinline__ void operator()(const f32x4 (&acc)[2][2][4][2], const Unit& u, int wr, int wc, int fr, int fq) const {
        const int col0 = u.pn * BM + wc * 32 + 8 * fq; const int ce = cnts[u.e];
#pragma unroll
        for (int ai = 0; ai < 2; ++ai)
#pragma unroll
            for (int m = 0; m < 4; ++m) { const int idx = u.mt * BM + ai * HALF + wr * 64 + m * 16 + fr;
                if (idx < ce) {
                    if (u.e < NE) {
                        const int aid = list[(size_t)u.e * T + idx]; const float wgt = topw[aid]; bf16_t* rowp = slab + (size_t)aid * D + col0;
#pragma unroll
                        for (int bj = 0; bj < 2; ++bj) { const f32x4 v0 = acc[ai][bj][m][0] * wgt, v1 = acc[ai][bj][m][1] * wgt;
                            u32x4 w; w.x = pk2(v0[0], v0[1]); w.y = pk2(v0[2], v0[3]); w.z = pk2(v1[0], v1[1]); w.w = pk2(v1[2], v1[3]);
                            *(u32x4*)(rowp + bj * HALF) = w; }
                    } else {
                        bf16_t* rowp = slab + ((size_t)T * TOPK + idx) * D + col0;
#pragma unroll
                        for (int bj = 0; bj < 2; ++bj) { const f32x4 v0 = acc[ai][bj][m][0], v1 = acc[ai][bj][m][1];
                            u32x4 w; w.x = pk2(v0[0], v0[1]); w.y = pk2(v0[2], v0[3]); w.z = pk2(v1[0], v1[1]); w.w = pk2(v1[2], v1[3]);
                            *(u32x4*)(rowp + bj * HALF) = w; }
                    }
                } }
    }
};
}

__device__ __forceinline__ void st_mod(const P& p, int item, LAS float* L  ) {
    const int tid = opaque(threadIdx.x), wave = tid >> 6, lane = tid & 63;
    const int l = item / 96, j0 = (item % 96) * 64;
    for (int i = tid; i < 8 * 1024; i += NTHREADS) L[i] = siluf_(p.c[i]);
    __syncthreads();
    float acc[8];
#pragma unroll
    for (int b = 0; b < 8; ++b) acc[b] = 0.f;
    const float* w = p.w_ada + ((size_t)l * 1024 + wave * 128) * 6144 + j0 + lane;
#pragma unroll 8
    for (int i = 0; i < 128; ++i) {
        const float wv = w[(size_t)i * 6144];
#pragma unroll
        for (int b = 0; b < 8; ++b) acc[b] += L[b * 1024 + wave * 128 + i] * wv;
    }
    LAS float* red = L + 8 * 1024;
#pragma unroll
    for (int b = 0; b < 8; ++b) red[(wave * 8 + b) * 64 + lane] = acc[b];
    __syncthreads();
    {
        const int b = tid >> 6;
        float s = p.b_ada[l * 6144 + j0 + lane];
#pragma unroll
        for (int wv = 0; wv < 8; ++wv) s += red[(wv * 8 + b) * 64 + lane];
        p.mod[((size_t)l * 8 + b) * 6144 + j0 + lane] = s;
    }
    __syncthreads();
}

constexpr int REC_HB = 912, REC_TB = 6 * REC_HB;
constexpr int CB_PHI = 0, CB_RT = 8192, CB_PSI = 12288, CB_G = 16384, CB_V = 18432, CB_BYTES = 22528;
constexpr int PREP_TOK = 64, PREP_XS = 168;
__device__ __forceinline__ void st_prep(const P& p, int l, int vb0, int vbstride, LAS unsigned char* L) {
    const int tid = opaque(threadIdx.x), wave = __builtin_amdgcn_readfirstlane(tid >> 6), lane = tid & 63, fr = lane & 15, fq = lane >> 4;
    LAS bf16_t* X = (LAS bf16_t*)L;
    for (int vb = vb0; vb < T / PREP_TOK; vb += vbstride) {
        const int t0 = vb * PREP_TOK, s0 = t0 % SEQ;
#pragma unroll 4
        for (int q = 0; q < PREP_TOK * 160 / NTHREADS; ++q) {
            const int it = tid + q * NTHREADS;
            const int tt = it / 160, i = it % 160;
            const int col = (i < 128) ? 1152 + i : INC + (i - 128);
            const float mu = (i < 128) ? p.mu_rw[l * RWC + col] : p.mu_vres[i - 128];
            const bf16_t* u = p.proj + (size_t)(t0 + tt) * PJB + col;
            const float uu = bf2f(u[0]), pv = (s0 + tt) > 0 ? bf2f(u[-PJB]) : 0.f;
            float x = uu + (pv - uu) * mu;
            if (i < 32) x = 1.f - 2.f / (__expf(2.f * x) + 1.f); else if (i >= 64 && i < 128) x = sigmoidf_(x);
            if (i >= 128 && l == 0) x = 0.f;
            X[tt * PREP_XS + i] = (bf16_t)f2bf(x);
        }
        __syncthreads();
        if (wave < 6) {
            const int hh = wave;
            const int ll = opaque(lane), fr2 = ll & 15, fq2 = ll >> 4;
            const bf16_t* lw = p.lwt + ((size_t)l * RWW + hh * 64) * 160;
#pragma unroll 1
            for (int mt = 0; mt < 4; ++mt) {
                const int tb = t0 + 16 * mt + 4 * fq2, sb = s0 + 16 * mt + 4 * fq2;
                bf16_t rr[4][5], kr[4][5], vr[4][5], vf[4][4];
#pragma unroll
                for (int nt = 0; nt < 4; ++nt) {
                    const bf16_t* u = p.proj + (size_t)tb * PJB + hh * 64 + 16 * nt + fr2;
#pragma unroll
                    for (int rw = 0; rw < 5; ++rw) {
                        const bool ok = (rw > 0) || (sb > 0);
                        rr[nt][rw] = ok ? u[(ptrdiff_t)(rw - 1) * PJB] : (bf16_t)0; kr[nt][rw] = ok ? u[(ptrdiff_t)(rw - 1) * PJB + 384] : (bf16_t)0; vr[nt][rw] = ok ? u[(ptrdiff_t)(rw - 1) * PJB + 768] : (bf16_t)0;
                    }
#pragma unroll
                    for (int rg = 0; rg < 4; ++rg) vf[nt][rg] = (l == 1) ? p.vfirst[(size_t)(tb + rg) * RWW + hh * 64 + 16 * nt + fr2] : (bf16_t)0;
                }
                const LAS bf16_t* xa = X + (16 * mt + fr2) * PREP_XS + 8 * fq2;
                const bf16x8 Aw = *(const LAS bf16x8*)xa, Aa = *(const LAS bf16x8*)(xa + 32), Av = *(const LAS bf16x8*)(xa + 128);
                f32x4 aw[4], aa[4], av[4];
#pragma unroll
                for (int nt = 0; nt < 4; ++nt) {
                    const bf16_t* q = lw + (16 * nt + fr2) * 160 + 8 * fq2;
                    aw[nt] = __builtin_amdgcn_mfma_f32_16x16x32_bf16(Aw, *(const bf16x8*)q, (f32x4){0.f, 0.f, 0.f, 0.f}, 0, 0, 0);
                    aa[nt] = __builtin_amdgcn_mfma_f32_16x16x32_bf16(Aa, *(const bf16x8*)(q + 32), (f32x4){0.f, 0.f, 0.f, 0.f}, 0, 0, 0);
                    av[nt] = __builtin_amdgcn_mfma_f32_16x16x32_bf16(Av, *(const bf16x8*)(q + 128), (f32x4){0.f, 0.f, 0.f, 0.f}, 0, 0, 0);
                }
                float ksh[4][4], ss[4] = {0.f, 0.f, 0.f, 0.f};
#pragma unroll
                for (int nt = 0; nt < 4; ++nt) {
                    const int c = hh * 64 + 16 * nt + fr2;
                    const float muk = p.mu_rw[l * RWC + 384 + c], kkc = p.rw_k_k[l * RWW + c];
#pragma unroll
                    for (int rg = 0; rg < 4; ++rg) {
                        const float kc = bf2f(kr[nt][rg + 1]), kp = bf2f(kr[nt][rg]);
                        const float k = kc + (kp - kc) * muk;
                        ksh[nt][rg] = k; ss[rg] += (k * kkc) * (k * kkc);
                    }
                }
                float inrm[4], rkp[4] = {0.f, 0.f, 0.f, 0.f};
#pragma unroll
                for (int rg = 0; rg < 4; ++rg) inrm[rg] = 1.f / fmaxf(sqrtf(dpp_add16(ss[rg])), 1e-12f);
#pragma unroll
                for (int nt = 0; nt < 4; ++nt) {
                    const int c = hh * 64 + 16 * nt + fr2;
                    const float w0 = p.rw_w0[l * RWW + c], a0 = p.rw_a0[l * RWW + c], v0 = (l == 1) ? p.rw_v0[c] : 0.f;
                    const float kkc = p.rw_k_k[l * RWW + c], kac = p.rw_k_a[l * RWW + c], rkc = p.rw_r_k[l * RWW + c];
                    const float mur = p.mu_rw[l * RWC + c], muv = p.mu_rw[l * RWC + 768 + c];
#pragma unroll
                    for (int rg = 0; rg < 4; ++rg) {
                        const int t = tb + rg;
                        const float rc_ = bf2f(rr[nt][rg + 1]), rp = bf2f(rr[nt][rg]), vc = bf2f(vr[nt][rg + 1]), vp = bf2f(vr[nt][rg]);
                        const float r = rc_ + (rp - rc_) * mur; float v = vc + (vp - vc) * muv; const float k = ksh[nt][rg];
                        const float wlog = -softplusf_(-(aw[nt][rg] + w0)) - 0.5f;
                        const float decay = __expf(-__expf(wlog));
                        const float a = sigmoidf_(aa[nt][rg] + a0);
                        if (l == 1) { const float vg = sigmoidf_(av[nt][rg] + v0); v = v + (bf2f(vf[nt][rg]) - v) * vg; }
                        else p.vfirst[(size_t)t * RWW + c] = (bf16_t)f2bf(v);
                        const float kk = k * kkc * inrm[rg];
                        const float bq = kk * a, k2 = k * (1.f + (a - 1.f) * kac);
                        unsigned char* rc = p.rec + (size_t)t * REC_TB + hh * REC_HB;
                        *(float*)(rc + (16 * nt + fr2) * 4) = decay;
                        bf16_t* rb = (bf16_t*)(rc + 256) + 16 * nt + fr2;
                        rb[0] = (bf16_t)f2bf(-kk); rb[64] = (bf16_t)f2bf(bq); rb[128] = (bf16_t)f2bf(k2); rb[192] = (bf16_t)f2bf(decay * r); rb[256] = (bf16_t)f2bf(v);
                        rkp[rg] += r * k2 * rkc;
                    }
                }
#pragma unroll
                for (int rg = 0; rg < 4; ++rg) { const float rk = dpp_add16(rkp[rg]); if (fr2 == 0) *(float*)(p.rec + (size_t)(tb + rg) * REC_TB + hh * REC_HB + 896) = rk; }
                {
                    const bf16x8 Ag0 = *(const LAS bf16x8*)(xa + 64), Ag1 = *(const LAS bf16x8*)(xa + 96);
#pragma unroll
                    for (int nt = 0; nt < 4; ++nt) {
                        const bf16_t* q = lw + (16 * nt + fr2) * 160 + 64 + 8 * fq2;
                        f32x4 ag = __builtin_amdgcn_mfma_f32_16x16x32_bf16(Ag0, *(const bf16x8*)q, (f32x4){0.f, 0.f, 0.f, 0.f}, 0, 0, 0);
                        ag = __builtin_amdgcn_mfma_f32_16x16x32_bf16(Ag1, *(const bf16x8*)(q + 32), ag, 0, 0, 0);
#pragma unroll
                        for (int rg = 0; rg < 4; ++rg) p.g[(size_t)(tb + rg) * RWW + hh * 64 + 16 * nt + fr2] = (bf16_t)f2bf(ag[rg]);
                    }
                }
            }
        }
        __syncthreads();
    }
}

typedef float f32x16 __attribute__((ext_vector_type(16)));
__device__ __forceinline__ bf16x8 acc_frag(const f32x16& x, int ks) {
    return ks == 0 ? mk8(cvtpk(x[0], x[1]), cvtpk(x[2], x[3]), cvtpk(x[4], x[5]), cvtpk(x[6], x[7])) : mk8(cvtpk(x[8], x[9]), cvtpk(x[10], x[11]), cvtpk(x[12], x[13]), cvtpk(x[14], x[15]));
}
__device__ __forceinline__ bf16x8 lds_perm_frag(const LAS unsigned char* rowp, int ks, int hf) {
    const u32x2 g0 = *(const LAS u32x2*)(rowp + (16 * ks + 4 * hf) * 2), g1 = *(const LAS u32x2*)(rowp + (16 * ks + 4 * hf + 8) * 2);
    return mk8(g0.x, g0.y, g1.x, g1.y);
}
constexpr int CP_WAVES = 6, CP_LDS = 20736;
__device__ __forceinline__ void st_cpre(const P& p, int item, LAS unsigned char* L, int lane_) {
    const int lane = opaque(lane_);
    const int ch = item & 63, bh = item >> 6, b = bh / 6, hh = bh % 6;
    const int r = lane & 31, hf = lane >> 5;
    const unsigned char* rec0 = p.rec + ((size_t)(b * SEQ + ch * 32)) * REC_TB + hh * REC_HB;
    unsigned char* cbo = p.cb + (size_t)item * CB_BYTES;
    LAS unsigned char* AbarT = L; LAS unsigned char* RbarT = L + 4096; LAS unsigned char* Bbar = L + 8192; LAS unsigned char* Kbar = L + 12288; LAS unsigned char* BbarT = L + 16384;
    LAS float* PCv = (LAS float*)(L + 20480);
    float Y[32];
    {
        float Pc = 1.f;
        unsigned bt[16], vtw[16];
#pragma unroll
        for (int t8 = 0; t8 < 32; t8 += 16) {
            float wv[16]; bf16_t av[16], bv[16], kv[16], qv[16], vv[16];
#pragma unroll
            for (int j = 0; j < 16; ++j) {
                const unsigned char* rp = rec0 + (size_t)(t8 + j) * REC_TB;
                wv[j] = *(const float*)(rp + lane * 4);
                const bf16_t* hb = (const bf16_t*)(rp + 256) + lane;
                av[j] = hb[0]; bv[j] = hb[64]; kv[j] = hb[128]; qv[j] = hb[192]; vv[j] = hb[256];
            }
#pragma unroll
            for (int j = 0; j < 16; ++j) {
                const int t = t8 + j;
                const float Pm = Pc; Pc *= wv[j]; const float inv = 1.f / Pc;
                const float ab = bf2f(av[j]) * Pm, rb = bf2f(qv[j]) * Pm, bb = bf2f(bv[j]) * inv, kb = bf2f(kv[j]) * inv;
                Y[t] = ab;
                *(LAS bf16_t*)(AbarT + (t * 64 + lane) * 2) = (bf16_t)f2bf(ab);
                *(LAS bf16_t*)(RbarT + (t * 64 + lane) * 2) = (bf16_t)f2bf(rb);
                *(LAS bf16_t*)(Bbar + (t * 64 + lane) * 2) = (bf16_t)f2bf(bb);
                *(LAS bf16_t*)(Kbar + (t * 64 + lane) * 2) = (bf16_t)f2bf(kb);
                if (t & 1) { bt[t >> 1] |= f2bf(bb) << 16; vtw[t >> 1] |= (unsigned)vv[j] << 16; } else { bt[t >> 1] = f2bf(bb); vtw[t >> 1] = (unsigned)vv[j]; }
            }
            asm volatile("" ::: "memory");
        }
        PCv[lane] = Pc;
#pragma unroll
        for (int q = 0; q < 4; ++q) {
            *(LAS u32x4*)(BbarT + lane * 64 + q * 16) = (u32x4){bt[4 * q], bt[4 * q + 1], bt[4 * q + 2], bt[4 * q + 3]};
            *(u32x4*)(cbo + CB_V + lane * 64 + q * 16) = (u32x4){vtw[4 * q], vtw[4 * q + 1], vtw[4 * q + 2], vtw[4 * q + 3]};
        }
    }
    asm volatile("s_waitcnt lgkmcnt(0)" ::: "memory");
    f32x16 Lab, Lak, Mbr, Mkr;
#pragma unroll
    for (int i = 0; i < 16; ++i) { Lab[i] = 0.f; Lak[i] = 0.f; Mbr[i] = 0.f; Mkr[i] = 0.f; }
#pragma unroll
    for (int ks = 0; ks < 4; ++ks) {
        const int off = (r * 64 + 16 * ks + 8 * hf) * 2;
        const bf16x8 fb = *(const LAS bf16x8*)(Bbar + off), fk = *(const LAS bf16x8*)(Kbar + off), fa = *(const LAS bf16x8*)(AbarT + off), fr = *(const LAS bf16x8*)(RbarT + off);
        Lab = __builtin_amdgcn_mfma_f32_32x32x16_bf16(fb, fa, Lab, 0, 0, 0);
        Lak = __builtin_amdgcn_mfma_f32_32x32x16_bf16(fk, fa, Lak, 0, 0, 0);
        Mbr = __builtin_amdgcn_mfma_f32_32x32x16_bf16(fb, fr, Mbr, 0, 0, 0);
        Mkr = __builtin_amdgcn_mfma_f32_32x32x16_bf16(fk, fr, Mkr, 0, 0, 0);
    }
#pragma unroll
    for (int i = 0; i < 16; ++i) {
        const int s = (i & 3) + 8 * (i >> 2) + 4 * hf;
        if (!(s < r)) { Lab[i] = 0.f; Lak[i] = 0.f; }
        if (!(s <= r)) { Mbr[i] = 0.f; Mkr[i] = 0.f; }
    }
    asm volatile("s_waitcnt lgkmcnt(0)" ::: "memory");
    {
        LAS float* LabT = (LAS float*)AbarT; LAS float* LakM = (LAS float*)Bbar;
#pragma unroll
        for (int g = 0; g < 4; ++g) *(LAS f32x4*)(LabT + r * 32 + 8 * g + 4 * hf) = (f32x4){Lab[4 * g], Lab[4 * g + 1], Lab[4 * g + 2], Lab[4 * g + 3]};
#pragma unroll
        for (int i = 0; i < 16; ++i) LakM[((i & 3) + 8 * (i >> 2) + 4 * hf) * 32 + r] = Lak[i];
    }
    asm volatile("s_waitcnt lgkmcnt(0)" ::: "memory");
    unsigned W2p[16];
    {
        const LAS float* LabT = (const LAS float*)AbarT; const LAS float* LakM = (const LAS float*)Bbar;
        float X2[32];
#pragma unroll
        for (int t = 0; t < 32; t += 4) { const f32x4 q = *(const LAS f32x4*)(LakM + r * 32 + t); X2[t] = q[0]; X2[t + 1] = q[1]; X2[t + 2] = q[2]; X2[t + 3] = q[3]; }
        int zdep = 0;
#pragma unroll
        for (int t = 1; t < 32; ++t) {
            float x1 = Y[t], x2 = X2[t];
            const LAS float* row = LabT + t * 32 + zdep;
#pragma unroll
            for (int s4 = 0; s4 < t; s4 += 4) {
                const f32x4 lq = *(const LAS f32x4*)(row + s4);
#pragma unroll
                for (int q = 0; q < 4; ++q) if (s4 + q < t) { x1 = fmaf(Y[s4 + q], lq[q], x1); x2 = fmaf(X2[s4 + q], lq[q], x2); }
            }
            Y[t] = x1; X2[t] = x2;
            asm volatile("v_mov_b32 %0, 0" : "=v"(zdep) : "v"(x1), "v"(x2));
        }
#pragma unroll
        for (int q = 0; q < 16; ++q) W2p[q] = pk2(X2[2 * q], X2[2 * q + 1]);
    }
    asm volatile("s_waitcnt lgkmcnt(0)" ::: "memory");
    LAS unsigned char* Atil = L;
    LAS unsigned char* Wv = L + 8192;
#pragma unroll
    for (int q = 0; q < 4; ++q) {
        *(LAS u32x4*)(Atil + lane * 64 + q * 16) = (u32x4){pk2(Y[8 * q], Y[8 * q + 1]), pk2(Y[8 * q + 2], Y[8 * q + 3]), pk2(Y[8 * q + 4], Y[8 * q + 5]), pk2(Y[8 * q + 6], Y[8 * q + 7])};
        if (lane < 32) *(LAS u32x4*)(Wv + lane * 64 + q * 16) = (u32x4){W2p[4 * q], W2p[4 * q + 1], W2p[4 * q + 2], W2p[4 * q + 3]};
    }
    asm volatile("s_waitcnt lgkmcnt(0)" ::: "memory");
    const bf16x8 mb0 = acc_frag(Mbr, 0), mb1 = acc_frag(Mbr, 1);
#pragma unroll
    for (int i = 0; i < 2; ++i) {
        f32x16 c;
#pragma unroll
        for (int g = 0; g < 4; ++g) { const u32x2 q = *(const LAS u32x2*)(RbarT + (r * 64 + 32 * i + 8 * g + 4 * hf) * 2); c[4 * g] = bflo(q.x); c[4 * g + 1] = bfhi(q.x); c[4 * g + 2] = bflo(q.y); c[4 * g + 3] = bfhi(q.y); }
        c = __builtin_amdgcn_mfma_f32_32x32x16_bf16(lds_perm_frag(Atil + (32 * i + r) * 64, 0, hf), mb0, c, 0, 0, 0);
        c = __builtin_amdgcn_mfma_f32_32x32x16_bf16(lds_perm_frag(Atil + (32 * i + r) * 64, 1, hf), mb1, c, 0, 0, 0);
#pragma unroll
        for (int g = 0; g < 4; ++g) *(u32x2*)(cbo + CB_RT + (r * 64 + 32 * i + 8 * g + 4 * hf) * 2) = (u32x2){cvtpk(c[4 * g], c[4 * g + 1]), cvtpk(c[4 * g + 2], c[4 * g + 3])};
    }
    {
        f32x16 c = Mkr;
        c = __builtin_amdgcn_mfma_f32_32x32x16_bf16(lds_perm_frag(Wv + r * 64, 0, hf), mb0, c, 0, 0, 0);
        c = __builtin_amdgcn_mfma_f32_32x32x16_bf16(lds_perm_frag(Wv + r * 64, 1, hf), mb1, c, 0, 0, 0);
#pragma unroll
        for (int g = 0; g < 4; ++g) *(u32x2*)(cbo + CB_G + (r * 32 + 8 * g + 4 * hf) * 2) = (u32x2){cvtpk(c[4 * g], c[4 * g + 1]), cvtpk(c[4 * g + 2], c[4 * g + 3])};
    }
#pragma unroll
    for (int jt = 0; jt < 2; ++jt) {
        const float pc = PCv[32 * jt + r];
        const bf16x8 fb0 = *(const LAS bf16x8*)(BbarT + (32 * jt + r) * 64 + (8 * hf) * 2), fb1 = *(const LAS bf16x8*)(BbarT + (32 * jt + r) * 64 + (16 + 8 * hf) * 2);
#pragma unroll
        for (int i = 0; i < 2; ++i) {
            f32x16 c;
#pragma unroll
            for (int q = 0; q < 16; ++q) c[q] = 0.f;
            c = __builtin_amdgcn_mfma_f32_32x32x16_bf16(*(const LAS bf16x8*)(Atil + (32 * i + r) * 64 + (8 * hf) * 2), fb0, c, 0, 0, 0);
            c = __builtin_amdgcn_mfma_f32_32x32x16_bf16(*(const LAS bf16x8*)(Atil + (32 * i + r) * 64 + (16 + 8 * hf) * 2), fb1, c, 0, 0, 0);
#pragma unroll
            for (int q = 0; q < 16; ++q) { const int kq = (q & 3) + 8 * (q >> 2) + 4 * hf; c[q] = (c[q] + ((i == jt && kq == r) ? 1.f : 0.f)) * pc; }
#pragma unroll
            for (int g = 0; g < 4; ++g) *(u32x2*)(cbo + CB_PHI + ((32 * jt + r) * 64 + 32 * i + 8 * g + 4 * hf) * 2) = (u32x2){cvtpk(c[4 * g], c[4 * g + 1]), cvtpk(c[4 * g + 2], c[4 * g + 3])};
        }
        {
            f32x16 c;
#pragma unroll
            for (int q = 0; q < 16; ++q) c[q] = bf2f(*(const LAS bf16_t*)(Kbar + (((q & 3) + 8 * (q >> 2) + 4 * hf) * 64 + 32 * jt + r) * 2));
            c = __builtin_amdgcn_mfma_f32_32x32x16_bf16(*(const LAS bf16x8*)(Wv + r * 64 + (8 * hf) * 2), fb0, c, 0, 0, 0);
            c = __builtin_amdgcn_mfma_f32_32x32x16_bf16(*(const LAS bf16x8*)(Wv + r * 64 + (16 + 8 * hf) * 2), fb1, c, 0, 0, 0);
#pragma unroll
            for (int g = 0; g < 4; ++g) *(u32x2*)(cbo + CB_PSI + ((32 * jt + r) * 32 + 8 * g + 4 * hf) * 2) = (u32x2){cvtpk(c[4 * g] * pc, c[4 * g + 1] * pc), cvtpk(c[4 * g + 2] * pc, c[4 * g + 3] * pc)};
        }
    }
    asm volatile("s_waitcnt lgkmcnt(0)" ::: "memory");
}

constexpr int CS_SLOTS = 4, CS_NP = CB_BYTES / 1024;
__device__ __forceinline__ void st_cscan(const P& p, int bh, LAS unsigned char* lds) {
    const int tid = opaque(threadIdx.x), wave = __builtin_amdgcn_readfirstlane(tid >> 6), lane = tid & 63;
    const int b = bh / 6, hh = bh % 6, r = lane & 31, hf = lane >> 5;
    const unsigned char* cb0 = p.cb + (size_t)bh * 64 * CB_BYTES;
    constexpr int NCH = SEQ / 32;
    const int lw = wave - 2;
#define CS_ISSUE(chunk) do { const int _c = (chunk) < NCH ? (chunk) : NCH - 1; const unsigned char* _g = cb0 + (size_t)_c * CB_BYTES + lane * 16; LAS unsigned char* _l = lds + ((chunk) & 3) * CB_BYTES; \
        _Pragma("unroll") for (int _j = 0; _j < 4; ++_j) if (lw + 6 * _j < CS_NP) __builtin_amdgcn_global_load_lds((const unsigned*)(_g + (lw + 6 * _j) * 1024), (LAS unsigned*)(_l + (lw + 6 * _j) * 1024), 16, 0, 0); } while (0)
    f32x16 X0, X1;
#pragma unroll
    for (int i = 0; i < 16; ++i) { X0[i] = 0.f; X1[i] = 0.f; }
    if (wave >= 2) { CS_ISSUE(0); CS_ISSUE(1); CS_ISSUE(2); }
    float* yb = p.y + (size_t)b * SEQ * RWW + hh * 64 + 32 * wave + r;
    for (int c = 0; c < NCH; ++c) {
        if (wave >= 2) { if (lw < 4) asm volatile("s_waitcnt vmcnt(8)" ::: "memory"); else asm volatile("s_waitcnt vmcnt(6)" ::: "memory"); }
        __builtin_amdgcn_s_barrier();
        if (wave >= 2) { CS_ISSUE(c + 3); }
        else {
            const LAS unsigned char* S = lds + (c & 3) * CB_BYTES;
            const int vr = 32 * wave + r;
            const bf16x8 vf0 = *(const LAS bf16x8*)(S + CB_V + vr * 64 + (8 * hf) * 2), vf1 = *(const LAS bf16x8*)(S + CB_V + vr * 64 + (16 + 8 * hf) * 2);
            const LAS unsigned char* rp = S + CB_RT + r * 128;
            const bf16x8 fr0 = lds_perm_frag(rp, 0, hf), fr1 = lds_perm_frag(rp, 1, hf), fr2 = lds_perm_frag(rp + 64, 0, hf), fr3 = lds_perm_frag(rp + 64, 1, hf);
            const bf16x8 fg0 = *(const LAS bf16x8*)(S + CB_G + r * 64 + (8 * hf) * 2), fg1 = *(const LAS bf16x8*)(S + CB_G + r * 64 + (16 + 8 * hf) * 2);
            const LAS unsigned char* p0 = S + CB_PHI + r * 128; const LAS unsigned char* p1 = S + CB_PHI + (32 + r) * 128;
            const bf16x8 fa0 = lds_perm_frag(p0, 0, hf), fa1 = lds_perm_frag(p0, 1, hf), fa2 = lds_perm_frag(p0 + 64, 0, hf), fa3 = lds_perm_frag(p0 + 64, 1, hf);
            const bf16x8 fb0 = lds_perm_frag(p1, 0, hf), fb1 = lds_perm_frag(p1, 1, hf), fb2 = lds_perm_frag(p1 + 64, 0, hf), fb3 = lds_perm_frag(p1 + 64, 1, hf);
            const LAS unsigned char* q0 = S + CB_PSI + r * 64; const LAS unsigned char* q1 = S + CB_PSI + (32 + r) * 64;
            const bf16x8 fp0 = *(const LAS bf16x8*)(q0 + (8 * hf) * 2), fp1 = *(const LAS bf16x8*)(q0 + (16 + 8 * hf) * 2), fp2 = *(const LAS bf16x8*)(q1 + (8 * hf) * 2), fp3 = *(const LAS bf16x8*)(q1 + (16 + 8 * hf) * 2);
            const bf16x8 x00 = acc_frag(X0, 0), x01 = acc_frag(X0, 1), x10 = acc_frag(X1, 0), x11 = acc_frag(X1, 1);
            asm volatile("s_waitcnt lgkmcnt(0)" ::: "memory");
            __builtin_amdgcn_sched_barrier(0);
            f32x16 yc, n0, n1;
#pragma unroll
            for (int i = 0; i < 16; ++i) { yc[i] = 0.f; n0[i] = 0.f; n1[i] = 0.f; }
            n0 = __builtin_amdgcn_mfma_f32_32x32x16_bf16(fa0, x00, n0, 0, 0, 0);
            n1 = __builtin_amdgcn_mfma_f32_32x32x16_bf16(fb0, x00, n1, 0, 0, 0);
            yc = __builtin_amdgcn_mfma_f32_32x32x16_bf16(fr0, x00, yc, 0, 0, 0);
            n0 = __builtin_amdgcn_mfma_f32_32x32x16_bf16(fa1, x01, n0, 0, 0, 0);
            n1 = __builtin_amdgcn_mfma_f32_32x32x16_bf16(fb1, x01, n1, 0, 0, 0);
            yc = __builtin_amdgcn_mfma_f32_32x32x16_bf16(fr1, x01, yc, 0, 0, 0);
            n0 = __builtin_amdgcn_mfma_f32_32x32x16_bf16(fa2, x10, n0, 0, 0, 0);
            n1 = __builtin_amdgcn_mfma_f32_32x32x16_bf16(fb2, x10, n1, 0, 0, 0);
            yc = __builtin_amdgcn_mfma_f32_32x32x16_bf16(fr2, x10, yc, 0, 0, 0);
            n0 = __builtin_amdgcn_mfma_f32_32x32x16_bf16(fa3, x11, n0, 0, 0, 0);
            n1 = __builtin_amdgcn_mfma_f32_32x32x16_bf16(fb3, x11, n1, 0, 0, 0);
            yc = __builtin_amdgcn_mfma_f32_32x32x16_bf16(fr3, x11, yc, 0, 0, 0);
            n0 = __builtin_amdgcn_mfma_f32_32x32x16_bf16(fp0, vf0, n0, 0, 0, 0);
            n1 = __builtin_amdgcn_mfma_f32_32x32x16_bf16(fp2, vf0, n1, 0, 0, 0);
            yc = __builtin_amdgcn_mfma_f32_32x32x16_bf16(fg0, vf0, yc, 0, 0, 0);
            n0 = __builtin_amdgcn_mfma_f32_32x32x16_bf16(fp1, vf1, n0, 0, 0, 0);
            n1 = __builtin_amdgcn_mfma_f32_32x32x16_bf16(fp3, vf1, n1, 0, 0, 0);
            yc = __builtin_amdgcn_mfma_f32_32x32x16_bf16(fg1, vf1, yc, 0, 0, 0);
            X0 = n0; X1 = n1;
#pragma unroll
            for (int i = 0; i < 16; ++i) yb[(size_t)(c * 32 + (i & 3) + 8 * (i >> 2) + 4 * hf) * RWW] = yc[i];
        }
    }
    asm volatile("s_waitcnt vmcnt(0)" ::: "memory");
    __builtin_amdgcn_s_barrier();
#undef CS_ISSUE
}

__device__ __forceinline__ void st_rwout(const P& p, int l, int t, int lane) {
    float y[6], vv[6], gg[6], rk[6];
#pragma unroll
    for (int hh = 0; hh < 6; ++hh) {
        y[hh] = p.y[(size_t)t * RWW + hh * 64 + lane]; vv[hh] = bf2f(*(const bf16_t*)(p.rec + (size_t)t * REC_TB + hh * REC_HB + 768 + lane * 2)); gg[hh] = bf2f(p.g[(size_t)t * RWW + hh * 64 + lane]);
        rk[hh] = *(const float*)(p.rec + (size_t)t * REC_TB + hh * REC_HB + 896);
    }
#pragma unroll
    for (int hh = 0; hh < 6; ++hh) {
        const int c = hh * 64 + lane;
        const float mean = wave_sum(y[hh]) * (1.f / 64.f);
        const float d = y[hh] - mean;
        const float var = wave_sum(d * d) * (1.f / 64.f);
        const float yn = d * rsqrtf(var + 64e-5f) * p.rw_ln_g[l * RWW + c] + p.rw_ln_b[l * RWW + c];
        p.h[(size_t)t * D + c] = (bf16_t)f2bf((yn + rk[hh] * vv[hh]) * gg[hh]);
    }
}

typedef float f32x16 __attribute__((ext_vector_type(16)));
constexpr float ATT_EXIT = -60.f;
__device__ __forceinline__ float xhalf(float x, int lane) { return __builtin_bit_cast(float, __builtin_amdgcn_ds_bpermute((lane ^ 32) << 2, __builtin_bit_cast(int, x))); }
__device__ __forceinline__ void st_attn(const P& p, int l, int item) {
    const int lane = opaque(threadIdx.x) & 63;
    const int qt = item % (SEQ / 32), bh = item / (SEQ / 32), b = bh / 6, hh = bh % 6;
    const int r = lane & 31, hf = lane >> 5;
    const bf16_t* qkb = p.proj + (size_t)b * SEQ * PJB + RWC + hh * 64 + 8 * hf;
    const bf16_t* vtb = p.vt + ((size_t)(b * 6 + hh) * 64 + r) * SEQ + 4 * hf;
    bf16x8 qf[4];
    {
        const bf16_t* qp = qkb + (size_t)(qt * 32 + r) * PJB;
#pragma unroll
        for (int s = 0; s < 4; ++s) {
            u32x4 t4 = *(const u32x4*)(qp + 16 * s);
            unsigned w[4] = {t4.x, t4.y, t4.z, t4.w};
#pragma unroll
            for (int q = 0; q < 4; ++q) { const float lo = bflo(w[q]) * 0.125f, hi = bfhi(w[q]) * 0.125f; w[q] = (__builtin_bit_cast(unsigned, lo) >> 16) | (__builtin_bit_cast(unsigned, hi) & 0xffff0000u); }
            t4.x = w[0]; t4.y = w[1]; t4.z = w[2]; t4.w = w[3];
            qf[s] = __builtin_bit_cast(bf16x8, t4);
        }
    }
    f32x16 o0, o1;
#pragma unroll
    for (int i = 0; i < 16; ++i) { o0[i] = 0.f; o1[i] = 0.f; }
    float R = 0.f;
    bf16x8 kfn[4]; u32x2 vfn[2][2][2];
#define ATT_LOAD(KT) do { const int _k0 = (KT) * 32; const bf16_t* kp = qkb + SBW + (size_t)(_k0 + r) * PJB; \
        _Pragma("unroll") for (int s = 0; s < 4; ++s) kfn[s] = *(const bf16x8*)(kp + 16 * s); \
        _Pragma("unroll") for (int dt = 0; dt < 2; ++dt) _Pragma("unroll") for (int s = 0; s < 2; ++s) { const bf16_t* vp = vtb + (size_t)dt * 32 * SEQ + _k0 + 16 * s; vfn[dt][s][0] = *(const u32x2*)vp; vfn[dt][s][1] = *(const u32x2*)(vp + 8); } } while (0)
    ATT_LOAD(qt);
    for (int kt = qt; kt >= 0; --kt) {
        const int key0 = kt * 32; (void)key0;
        bf16x8 kf[4]; u32x2 vf[2][2][2];
#pragma unroll
        for (int s = 0; s < 4; ++s) kf[s] = kfn[s];
#pragma unroll
        for (int dt = 0; dt < 2; ++dt)
#pragma unroll
            for (int s = 0; s < 2; ++s) { vf[dt][s][0] = vfn[dt][s][0]; vf[dt][s][1] = vfn[dt][s][1]; }
        if (kt > 0) ATT_LOAD(kt - 1);
        f32x16 z;
#pragma unroll
        for (int i = 0; i < 16; ++i) z[i] = 0.f;
#pragma unroll
        for (int s = 0; s < 4; ++s) z = __builtin_amdgcn_mfma_f32_32x32x16_bf16(kf[s], qf[s], z, 0, 0, 0);
        const bool diag = (kt == qt);
        float c[16], gs[4];
#pragma unroll
        for (int gi = 0; gi < 4; ++gi) {
            float run = 0.f;
#pragma unroll
            for (int e = 3; e >= 0; --e) {
                const int reg = gi * 4 + e;
                const float zz = z[reg];
                float L = -(fmaxf(zz, 0.f) + __logf(1.f + __expf(-fabsf(zz))));
                if (diag && !(r > e + 8 * gi + 4 * hf)) L = 0.f;
                run += L; c[reg] = run;
            }
            gs[gi] = run;
        }
        float go[4], pp[4], ob[4], off[4];
#pragma unroll
        for (int gi = 0; gi < 4; ++gi) { go[gi] = xhalf(gs[gi], lane); pp[gi] = gs[gi] + go[gi]; }
        ob[3] = 0.f; ob[2] = pp[3]; ob[1] = pp[3] + pp[2]; ob[0] = ob[1] + pp[1];
#pragma unroll
        for (int gi = 0; gi < 4; ++gi) off[gi] = ob[gi] + (hf == 0 ? go[gi] : 0.f) + R;
        const float total = ob[0] + pp[0];
        unsigned af[8];
#pragma unroll
        for (int i = 0; i < 8; ++i) {
            float a2[2];
#pragma unroll
            for (int q = 0; q < 2; ++q) {
                const int reg = 2 * i + q, gi = reg >> 2, e = reg & 3;
                float a = __expf(z[reg] + c[reg] + off[gi]);
                if (diag && !(r > e + 8 * gi + 4 * hf)) a = 0.f;
                a2[q] = a;
            }
            af[i] = pk2(a2[0], a2[1]);
        }
        R += total;
        const bf16x8 a0 = __builtin_bit_cast(bf16x8, (u32x4){af[0], af[1], af[2], af[3]});
        const bf16x8 a1 = __builtin_bit_cast(bf16x8, (u32x4){af[4], af[5], af[6], af[7]});
        o0 = __builtin_amdgcn_mfma_f32_32x32x16_bf16(__builtin_bit_cast(bf16x8, (u32x4){vf[0][0][0].x, vf[0][0][0].y, vf[0][0][1].x, vf[0][0][1].y}), a0, o0, 0, 0, 0);
        o0 = __builtin_amdgcn_mfma_f32_32x32x16_bf16(__builtin_bit_cast(bf16x8, (u32x4){vf[0][1][0].x, vf[0][1][0].y, vf[0][1][1].x, vf[0][1][1].y}), a1, o0, 0, 0, 0);
        o1 = __builtin_amdgcn_mfma_f32_32x32x16_bf16(__builtin_bit_cast(bf16x8, (u32x4){vf[1][0][0].x, vf[1][0][0].y, vf[1][0][1].x, vf[1][0][1].y}), a0, o1, 0, 0, 0);
        o1 = __builtin_amdgcn_mfma_f32_32x32x16_bf16(__builtin_bit_cast(bf16x8, (u32x4){vf[1][1][0].x, vf[1][1][0].y, vf[1][1][1].x, vf[1][1][1].y}), a1, o1, 0, 0, 0);
        if (__all(R < ATT_EXIT)) break;
    }
#undef ATT_LOAD
    float ss = 0.f;
#pragma unroll
    for (int i = 0; i < 16; ++i) ss += o0[i] * o0[i] + o1[i] * o1[i];
    ss += xhalf(ss, lane);
    const float rs = rsqrtf(ss * (1.f / 64.f) + 1e-6f);
    bf16_t* op = p.h + ((size_t)b * SEQ + qt * 32 + r) * D + RWW + hh * 64 + 4 * hf;
    const float* gn = p.sb_norm_g + l * SBW + hh * 64 + 4 * hf;
#pragma unroll
    for (int gi = 0; gi < 4; ++gi) {
        const f32x4 g0 = *(const f32x4*)(gn + 8 * gi), g1 = *(const f32x4*)(gn + 32 + 8 * gi);
        u32x2 w0, w1;
        w0.x = pk2(o0[4 * gi] * rs * g0[0], o0[4 * gi + 1] * rs * g0[1]); w0.y = pk2(o0[4 * gi + 2] * rs * g0[2], o0[4 * gi + 3] * rs * g0[3]);
        w1.x = pk2(o1[4 * gi] * rs * g1[0], o1[4 * gi + 1] * rs * g1[1]); w1.y = pk2(o1[4 * gi + 2] * rs * g1[2], o1[4 * gi + 3] * rs * g1[3]);
        *(u32x2*)(op + 8 * gi) = w0; *(u32x2*)(op + 32 + 8 * gi) = w1;
    }
}

__device__ __forceinline__ void st_pool(const P& p, int l, int vb, LAS float* PL  ) {
    const int tid = opaque(threadIdx.x);
    const int t0 = vb * 32, s0 = t0 % SEQ;
    {
        const int col = tid & 255, th = tid >> 8, g = col >> 6, win = 2 << g;
        const int sA = s0 + th * 16;
        const bf16_t* u = p.proj + (size_t)(t0 + th * 16) * PJB + RWC + SBC + col;
        float xv[31];
#pragma unroll
        for (int i = 0; i < 31; ++i) { const int s = sA - 15 + i; xv[i] = (s >= 0 && (i >= 15 || 15 - i < win)) ? bf2f(u[(ptrdiff_t)(i - 15) * PJB]) : 0.f; }
        float run = 0.f;
#pragma unroll
        for (int i = 0; i < 15; ++i) run += (15 - i < win) ? xv[i] : 0.f;
#pragma unroll
        for (int j = 0; j < 16; ++j) {
            run += xv[15 + j];
            const int s = sA + j, n = min(s + 1, win);
            PL[(th * 16 + j) * 256 + col] = run / (float)n - xv[15 + j];
            float drop = 0.f;
#pragma unroll
            for (int q = 1; q <= 4; ++q) if (win == (1 << q)) drop = xv[15 + j - (1 << q) + 1];
            run -= drop;
        }
    }
    __syncthreads();
    {
        const int wave = tid >> 6, lane = tid & 63, g = wave & 3, th = wave >> 2;
        float acc[16];
#pragma unroll
        for (int j = 0; j < 16; ++j) acc[j] = 0.f;
        const float* pw = p.pool_w + ((size_t)l * 4 + g) * 64 * 64 + lane;
        for (int c = 0; c < 64; c += 4) {
            const float w0 = pw[c * 64], w1 = pw[(c + 1) * 64], w2 = pw[(c + 2) * 64], w3 = pw[(c + 3) * 64];
#pragma unroll
            for (int j = 0; j < 16; ++j) { const f32x4 x = *(const LAS f32x4*)(PL + (th * 16 + j) * 256 + g * 64 + c); acc[j] += x[0] * w0 + x[1] * w1 + x[2] * w2 + x[3] * w3; }
        }
        const float sc = p.pool_scale[l * PLW + g * 64 + lane];
#pragma unroll
        for (int j = 0; j < 16; ++j) p.h[(size_t)(t0 + th * 16 + j) * D + 768 + g * 64 + lane] = (bf16_t)f2bf(acc[j] * sc);
    }
    __syncthreads();
}

template <bool TOLDS>
__device__ __forceinline__ void norm_row(const float* xr, const float* md  , bf16_t* hrow, LAS float* hl, int lane) {
    f32x4 v[4]; float ss = 0.f;
#pragma unroll
    for (int i = 0; i < 4; ++i) { v[i] = *(const f32x4*)(xr + i * 256 + lane * 4); ss += v[i][0] * v[i][0] + v[i][1] * v[i][1] + v[i][2] * v[i][2] + v[i][3] * v[i][3]; }
    ss = wave_sum(ss);
    const float rs = rsqrtf(ss * (1.f / D) + 1e-6f);
#pragma unroll
    for (int i = 0; i < 4; ++i) {
        const int cidx = i * 256 + lane * 4;
        const f32x4 sh = *(const f32x4*)(md + cidx), sc = *(const f32x4*)(md + 1024 + cidx);
        const f32x4 o = v[i] * rs * (sc + 1.f) + sh;
        u32x2 w; w.x = pk2(o[0], o[1]); w.y = pk2(o[2], o[3]);
        *(u32x2*)(hrow + cidx) = w;
        if constexpr (TOLDS) *(LAS f32x4*)(hl + cidx) = o;
    }
}

__device__ __forceinline__ void split_bf16(const float (&x)[8], bf16x8& hi, bf16x8& lo) {
    unsigned h[4], l[4];
#pragma unroll
    for (int q = 0; q < 4; ++q) {
        const unsigned ph = cvtpk(x[2 * q], x[2 * q + 1]);
        const float r0 = x[2 * q] - bflo(ph), r1 = x[2 * q + 1] - bfhi(ph);
        h[q] = ph; l[q] = cvtpk(r0, r1);
    }
    hi = mk8(h[0], h[1], h[2], h[3]); lo = mk8(l[0], l[1], l[2], l[3]);
}
__device__ __forceinline__ void st_normrouter(const P& p, int l, int vb0, int vbstride, LAS float* L  ) {
    const int tid = opaque(threadIdx.x), wave = tid >> 6, lane = tid & 63;
    const int fr = lane & 15, fq = lane >> 4;
    constexpr int HS = 1028;
    LAS float* H = L; LAS float* PART = L + 16 * HS; LAS float* SEL = PART + 8 * 16 * 64; LAS int* lcnt = (LAS int*)(SEL + 16 * 72);
    bf16x8 Bh[4][4], Bl[4][4];
    {
        const float* wr = p.w_router + ((size_t)l * D + wave * 128) * NE;
        const int ll = opaque(lane), fr2 = ll & 15, fq2 = ll >> 4;
#pragma unroll
        for (int ks = 0; ks < 4; ++ks)
#pragma unroll
            for (int nt = 0; nt < 4; ++nt) {
                float x[8];
#pragma unroll
                for (int j = 0; j < 8; ++j) x[j] = wr[(32 * ks + 8 * fq2 + j) * NE + 16 * nt + fr2];
                split_bf16(x, Bh[ks][nt], Bl[ks][nt]);
            }
    }
    const float brt = p.b_router[l * NE + lane];
    for (int vb = vb0; vb < T / 16; vb += vbstride) {
        const int t0 = vb * 16, b = t0 / SEQ;
        const float* md = p.mod + ((size_t)l * 8 + b) * 6144 + 3072;
        if (tid < 64) lcnt[tid] = 0;
        unsigned pfv = 0u;
        if (vb + vbstride < T / 16) pfv = pf_lines(p.xb + (size_t)((vb + vbstride) * 16 + wave * 2) * D, 2 * D * 4, lane);
#pragma unroll
        for (int q = 0; q < 2; ++q) { const int tt = wave * 2 + q; norm_row<true>(p.xb + (size_t)(t0 + tt) * D, md, p.h + (size_t)(t0 + tt) * D, H + tt * HS, lane); }
        __syncthreads();
        {
            f32x4 acc[4];
#pragma unroll
            for (int nt = 0; nt < 4; ++nt) acc[nt] = (f32x4){0.f, 0.f, 0.f, 0.f};
#pragma unroll
            for (int ks = 0; ks < 4; ++ks) {
                const LAS float* hp = H + fr * HS + wave * 128 + 32 * ks + 8 * fq;
                const f32x4 h0 = *(const LAS f32x4*)hp, h1 = *(const LAS f32x4*)(hp + 4);
                const float x[8] = {h0[0], h0[1], h0[2], h0[3], h1[0], h1[1], h1[2], h1[3]};
                bf16x8 ah, al; split_bf16(x, ah, al);
#pragma unroll
                for (int nt = 0; nt < 4; ++nt) {
                    acc[nt] = __builtin_amdgcn_mfma_f32_16x16x32_bf16(ah, Bh[ks][nt], acc[nt], 0, 0, 0);
                    acc[nt] = __builtin_amdgcn_mfma_f32_16x16x32_bf16(ah, Bl[ks][nt], acc[nt], 0, 0, 0);
                    acc[nt] = __builtin_amdgcn_mfma_f32_16x16x32_bf16(al, Bh[ks][nt], acc[nt], 0, 0, 0);
                }
            }
#pragma unroll
            for (int nt = 0; nt < 4; ++nt)
#pragma unroll
                for (int rg = 0; rg < 4; ++rg) PART[(wave * 16 + 4 * fq + rg) * 64 + 16 * nt + fr] = acc[nt][rg];
        }
        __syncthreads();
#pragma unroll
        for (int q = 0; q < 2; ++q) {
            const int tt = wave * 2 + q, t = t0 + tt;
            float logit = 0.f;
#pragma unroll
            for (int w = 0; w < 8; ++w) logit += PART[(w * 16 + tt) * 64 + lane];
            float score = sigmoidf_(logit);
            score = (score == score) ? score : 0.f;
            const float sl = score + brt;
            LAS float* sel = SEL + (wave * 2 + q) * 72; LAS float* gs = sel + 64;
            sel[lane] = sl;
            if (lane < 8) {
                float m1 = -INFINITY, m2 = -INFINITY;
                for (int i = 0; i < 8; ++i) { const float v = sel[lane * 8 + i]; if (v > m1) { m2 = m1; m1 = v; } else if (v > m2) m2 = v; }
                gs[lane] = m1 + m2;
            }
            const int gI = lane >> 3;
            int grank = 0;
            for (int i = 0; i < 8; ++i) { const float v = gs[i]; grank += (v > gs[gI] || (v == gs[gI] && i < gI)) ? 1 : 0; }
            const float msk = (grank < 4) ? sl : -INFINITY;
            sel[lane] = msk;
            int rank = 0;
            for (int i = 0; i < 64; ++i) { const float v = sel[i]; rank += (v > msk || (v == msk && i < lane)) ? 1 : 0; }
            const bool chosen = rank < TOPK;
            const float wsum = wave_sum(chosen ? score : 0.f);
            if (chosen) {
                const int pos = __hip_atomic_fetch_add(&lcnt[lane], 1, __ATOMIC_RELAXED, __HIP_MEMORY_SCOPE_WORKGROUP);
                p.seg[((size_t)lane * 1024 + vb) * 16 + pos] = t * TOPK + rank;
                p.topw[(size_t)t * TOPK + rank] = score / (wsum + 1e-20f) * 2.5f;
            }
        }
        __syncthreads();
        if (tid < 64) p.cnt2[tid * 1024 + vb] = lcnt[tid];
        pf_done(pfv);
        __syncthreads();
    }
}

__device__ __forceinline__ void st_compact(const P& p, int e, LAS int* wt  ) {
    const int tid = opaque(threadIdx.x), wave = tid >> 6, lane = tid & 63;
    const int c0 = p.cnt2[e * 1024 + 2 * tid], c1 = p.cnt2[e * 1024 + 2 * tid + 1], s = c0 + c1;
    int incl = s;
#pragma unroll
    for (int o = 1; o < 64; o <<= 1) { const int v = __builtin_amdgcn_ds_bpermute(((lane - o) & 63) << 2, incl); if (lane >= o) incl += v; }
    if (lane == 63) wt[wave] = incl;
    __syncthreads();
    int base = 0;
    for (int w = 0; w < wave; ++w) base += wt[w];
    const int excl = base + incl - s;
    int* dst = p.list + (size_t)e * T + excl;
    const int* s0 = p.seg + ((size_t)e * 1024 + 2 * tid) * 16;
    for (int j = 0; j < c0; ++j) dst[j] = s0[j];
    for (int j = 0; j < c1; ++j) dst[c0 + j] = s0[16 + j];
    if (tid == NTHREADS - 1) p.cnt[e] = base + incl;
    __syncthreads();
}

__device__ __forceinline__ void st_combine(const P& p, int l, int t, int lane) {
    const int b = t / SEQ;
    const float* gt = p.mod + ((size_t)l * 8 + b) * 6144 + 5120;
    const bf16_t* sl = p.slab + (size_t)t * TOPK * D;
    float* xr = p.xb + (size_t)t * D;
    float xv[16]; float ss = 0.f;
#pragma unroll
    for (int i = 0; i < 2; ++i) {
        const int cidx = i * 512 + lane * 8;
        float f[8];
#pragma unroll
        for (int j = 0; j < 8; ++j) f[j] = 0.f;
#pragma unroll
        for (int s = 0; s < TOPK + 1; ++s) {
            const u32x4 q = *(const u32x4*)(s < TOPK ? sl + (size_t)s * D + cidx : p.slab + ((size_t)T * TOPK + t) * D + cidx);
            f[0] += bflo(q.x); f[1] += bfhi(q.x); f[2] += bflo(q.y); f[3] += bfhi(q.y); f[4] += bflo(q.z); f[5] += bfhi(q.z); f[6] += bflo(q.w); f[7] += bfhi(q.w);
        }
        const f32x4 x0 = *(const f32x4*)(xr + cidx), x1 = *(const f32x4*)(xr + cidx + 4);
        const f32x4 g0 = *(const f32x4*)(gt + cidx), g1 = *(const f32x4*)(gt + cidx + 4);
#pragma unroll
        for (int j = 0; j < 4; ++j) { xv[i * 8 + j] = x0[j] + g0[j] * f[j]; xv[i * 8 + 4 + j] = x1[j] + g1[j] * f[4 + j]; }
#pragma unroll
        for (int j = 0; j < 8; ++j) ss += xv[i * 8 + j] * xv[i * 8 + j];
    }
    ss = wave_sum(ss);
    const float rs = rsqrtf(ss * (1.f / D) + 1e-6f);
    if (l + 1 < NL) {
        const float* md = p.mod + ((size_t)(l + 1) * 8 + b) * 6144;
#pragma unroll
        for (int i = 0; i < 2; ++i) {
            const int cidx = i * 512 + lane * 8;
            *(f32x4*)(xr + cidx) = (f32x4){xv[i * 8], xv[i * 8 + 1], xv[i * 8 + 2], xv[i * 8 + 3]};
            *(f32x4*)(xr + cidx + 4) = (f32x4){xv[i * 8 + 4], xv[i * 8 + 5], xv[i * 8 + 6], xv[i * 8 + 7]};
            float o[8];
#pragma unroll
            for (int j = 0; j < 8; ++j) o[j] = xv[i * 8 + j] * rs * (1.f + md[1024 + cidx + j]) + md[cidx + j];
            u32x4 w; w.x = pk2(o[0], o[1]); w.y = pk2(o[2], o[3]); w.z = pk2(o[4], o[5]); w.w = pk2(o[6], o[7]);
            *(u32x4*)(p.h + (size_t)t * D + cidx) = w;
        }
    } else {
#pragma unroll
        for (int i = 0; i < 2; ++i) {
            const int cidx = i * 512 + lane * 8;
            const f32x4 g0 = *(const f32x4*)(p.g_final + cidx), g1 = *(const f32x4*)(p.g_final + cidx + 4);
            *(f32x4*)(p.out + (size_t)t * D + cidx) = (f32x4){xv[i * 8] * rs * g0[0], xv[i * 8 + 1] * rs * g0[1], xv[i * 8 + 2] * rs * g0[2], xv[i * 8 + 3] * rs * g0[3]};
            *(f32x4*)(p.out + (size_t)t * D + cidx + 4) = (f32x4){xv[i * 8 + 4] * rs * g1[0], xv[i * 8 + 5] * rs * g1[1], xv[i * 8 + 6] * rs * g1[2], xv[i * 8 + 7] * rs * g1[3]};
        }
    }
}

struct CvtJob { const float* W; bf16_t* WT; int K, N, k0, n0, dst_row0; };
__device__ __forceinline__ void cvt_load(const CvtJob& j, float (&wv)[32], int lane) {
#pragma unroll
    for (int i = 0; i < 32; ++i) wv[i] = j.W[(size_t)(j.k0 + 2 * i + (lane >> 5)) * j.N + j.n0 + (lane & 31)];
}
__device__ __forceinline__ void cvt_store(const CvtJob& j, const float (&wv)[32], LAS float* scr, int lane) {
#pragma unroll
    for (int i = 0; i < 32; ++i) scr[(2 * i + (lane >> 5)) * 33 + (lane & 31)] = wv[i];
    asm volatile("s_waitcnt lgkmcnt(0)" ::: "memory");
    const int c = lane & 7;
#pragma unroll
    for (int q = 0; q < 4; ++q) { const int n = (lane >> 3) + 8 * q; const LAS float* sp = scr + (8 * c) * 33 + n;
        u32x4 o; o.x = pk2(sp[0 * 33], sp[1 * 33]); o.y = pk2(sp[2 * 33], sp[3 * 33]); o.z = pk2(sp[4 * 33], sp[5 * 33]); o.w = pk2(sp[6 * 33], sp[7 * 33]);
        *(u32x4*)(j.WT + (size_t)(j.dst_row0 + n) * j.K + j.k0 + 8 * c) = o; }
    asm volatile("s_waitcnt lgkmcnt(0)" ::: "memory");
}
__device__ __forceinline__ void cvt_item(const float* W, int K, int N, int k0, int n0, bf16_t* WT, int dst_row0, LAS float* scr, int lane) {
    const CvtJob j{W, WT, K, N, k0, n0, dst_row0};
    float wv[32];
    cvt_load(j, wv, lane);
    cvt_store(j, wv, scr, lane);
}
constexpr int CV_IN = 16 * 84, CV_VR = 16, CV_OUT = 16 * 32, CV_DENSE_L = CV_IN + CV_VR + CV_OUT, CV_DENSE = NL * CV_DENSE_L;
__device__ __forceinline__ void cvt_dense_item(const P& p, int it, LAS float* scr, int lane) {
    const int l = it / CV_DENSE_L; int r = it % CV_DENSE_L;
    bf16_t* wti = p.wt_in + (size_t)l * PJB * D;
    if (r < CV_IN) { const int kb = r / 84, nb = r % 84; cvt_item(p.w_in + (size_t)l * D * INC, D, INC, kb * 64, nb * 32, wti, nb * 32, scr, lane); return; }
    r -= CV_IN;
    if (r < CV_VR) {
        if (l == 1) cvt_item(p.w_vres, D, 32, r * 64, 0, wti, INC, scr, lane);
        const int rz0 = (l == 1) ? INC + 32 : INC;
        for (int row = rz0 + (lane >> 3); row < PJB; row += 8) *(u32x4*)(wti + (size_t)row * D + r * 64 + (lane & 7) * 8) = (u32x4){0u, 0u, 0u, 0u};
        return;
    }
    r -= CV_VR;
    { const int kb = r / 32, nb = r % 32; cvt_item(p.w_out + (size_t)l * D * D, D, D, kb * 64, nb * 32, p.wt_out + (size_t)l * D * D, nb * 32, scr, lane); }
}
constexpr int CV_EXP_E = 128 + 128 + 128, CV_EXP = 65 * CV_EXP_E;
__device__ __forceinline__ CvtJob cvt_exp_job(const P& p, int l, int it) {
    const int e = it / CV_EXP_E; int r = it % CV_EXP_E;
    if (r < 256) {
        const int which = r >> 7; r &= 127; const int kb = r >> 3, nb = r & 7;
        const float* W = e < NE ? (which ? p.w_eu : p.w_eg) + ((size_t)l * NE + e) * D * ED : (which ? p.w_su : p.w_sg) + (size_t)l * D * ED;
        const int n0 = nb * 32, pn = n0 >> 7;
        return CvtJob{W, p.wt1 + (size_t)e * 512 * D, D, ED, kb * 64, n0, pn * 256 + which * 128 + (n0 & 127)};
    } else {
        r -= 256; const int kb = r >> 5, nb = r & 31;
        const float* W = e < NE ? p.w_ed + ((size_t)l * NE + e) * ED * D : p.w_sd + (size_t)l * ED * D;
        return CvtJob{W, p.wt2 + (size_t)e * D * ED, ED, D, kb * 64, nb * 32, nb * 32};
    }
}
__device__ __forceinline__ void cvt_exp_stream(const P& p, int l, int first, int stride, int CV_END, LAS float* scr, int lane) {
    if (first >= CV_END) return;
    float wa[32], wb[32];
    CvtJob ja = cvt_exp_job(p, l, first), jb = ja;
    cvt_load(ja, wa, lane);
    for (int it = first; it < CV_END; it += 2 * stride) {
        const bool hb = it + stride < CV_END;
        if (hb) { jb = cvt_exp_job(p, l, it + stride); cvt_load(jb, wb, lane); }
        cvt_store(ja, wa, scr, lane);
        if (!hb) break;
        const bool ha = it + 2 * stride < CV_END;
        if (ha) { ja = cvt_exp_job(p, l, it + 2 * stride); cvt_load(ja, wa, lane); }
        cvt_store(jb, wb, scr, lane);
        if (!ha) break;
    }
}

#define XB_TMO      128
#define XB_XCNT(j)  (256  + 64 * (j))
#define XB_XSUB(j)  (1280 + 64 * (j))
#define XB_XGEN(j)  (2304 + 64 * (j))
#define XB_TOP      3328
#define XB_TOPGEN   3392
#define XCD_BAR_WORDS 3456
#define XB_SPIN_CAP (1u << 22)
__device__ __forceinline__ unsigned xb_ld(unsigned* p)              { return __hip_atomic_load(p, __ATOMIC_RELAXED, __HIP_MEMORY_SCOPE_AGENT); }
__device__ __forceinline__ unsigned xb_add(unsigned* p, unsigned v) { return __hip_atomic_fetch_add(p, v, __ATOMIC_RELAXED, __HIP_MEMORY_SCOPE_AGENT); }
__device__ __forceinline__ unsigned xb_xcc_id() { return (unsigned)__builtin_amdgcn_s_getreg((3 << 11) | 20) & 0xFu; }
#define XB_SPIN(cond, bar) do { unsigned _sp = 0; while (cond) { __builtin_amdgcn_s_sleep(1); \
    if ((++_sp & 255u) == 0u) { if (xb_ld(&(bar)[XB_TMO])) break; if (_sp > XB_SPIN_CAP) { atomicAdd(&(bar)[XB_TMO], 1u); break; } } } } while (0)
struct XcdBarrier { unsigned* bar; unsigned x; volatile LAS unsigned* st; };
__device__ __forceinline__ XcdBarrier xcd_barrier_post(unsigned* bar, volatile LAS unsigned* st) {
    XcdBarrier b; b.bar = bar; b.x = xb_xcc_id(); b.st = st;
    if (threadIdx.x == 0) (void)xb_add(&bar[XB_XCNT(b.x)], 1u);
    return b;
}
__device__ __forceinline__ void xcd_barrier_complete(unsigned* bar, unsigned x, unsigned& nloc, unsigned& nx) {
    const unsigned G = gridDim.x * gridDim.y * gridDim.z;
    unsigned sum, cnt, mine, sp = 0u;
    for (;;) {
        sum = 0u; cnt = 0u; mine = 0u;
#pragma unroll
        for (unsigned j = 0; j < 16; ++j) { const unsigned c = xb_ld(&bar[XB_XCNT(j)]); sum += c; cnt += (c > 0u) ? 1u : 0u; mine = (j == x) ? c : mine; }
        if (sum == G) break;
        __builtin_amdgcn_s_sleep(1);
        if ((++sp & 255u) == 0u) { if (xb_ld(&bar[XB_TMO])) break; if (sp > XB_SPIN_CAP) { atomicAdd(&bar[XB_TMO], 1u); break; } }
    }
    nloc = mine > 0u ? mine : 1u; nx = cnt > 0u ? cnt : 1u;
}
__device__ __forceinline__ void xcd_barrier(const XcdBarrier& b0) {
    XcdBarrier b = b0; { unsigned xx = b0.x; asm volatile("" : "+s"(xx)); b.x = xx; }
    asm volatile("s_waitcnt vmcnt(0)" ::: "memory");
    __syncthreads();
    if (threadIdx.x == 0) {
        unsigned* bar = b.bar;
        __builtin_amdgcn_s_waitcnt(0);
        unsigned nloc = b.st[0], nx = b.st[1];
        if (nloc == 0u) { xcd_barrier_complete(bar, b.x, nloc, nx); b.st[0] = nloc; b.st[1] = nx; }
        const unsigned old = xb_add(&bar[XB_XSUB(b.x)], 1u);
        const unsigned gen = old / nloc;
        if (old + 1u == (gen + 1u) * nloc) {
            __builtin_amdgcn_fence(__ATOMIC_RELEASE, "agent");
            asm volatile("s_waitcnt vmcnt(0)" ::: "memory");
            const unsigned og = xb_add(&bar[XB_TOP], 1u);
            const unsigned tg = og / nx;
            if (og + 1u == (tg + 1u) * nx) xb_add(&bar[XB_TOPGEN], 1u);
            else XB_SPIN(xb_ld(&bar[XB_TOPGEN]) == tg, bar);
            __builtin_amdgcn_fence(__ATOMIC_ACQUIRE, "agent");
            xb_add(&bar[XB_XGEN(b.x)], 1u);
            asm volatile("s_waitcnt vmcnt(0)" ::: "memory");
        } else {
            XB_SPIN(xb_ld(&bar[XB_XGEN(b.x)]) == gen, bar);
            __builtin_amdgcn_fence(__ATOMIC_ACQUIRE, "agent");
            asm volatile("s_waitcnt vmcnt(0)" ::: "memory");
        }
    }
    __syncthreads();
}

__device__ __forceinline__ P load_args() {
    P q{};
#if defined(__HIP_DEVICE_COMPILE__)
    const __attribute__((address_space(4))) unsigned long long* k = (const __attribute__((address_space(4))) unsigned long long*)__builtin_amdgcn_kernarg_segment_ptr();
    asm volatile("" : "+s"(k));
    unsigned long long w[sizeof(P) / 8];
#pragma unroll
    for (unsigned i = 0; i < sizeof(P) / 8; ++i) w[i] = k[i];
    __builtin_memcpy(&q, w, sizeof(P));
#endif
    return q;
}
enum Ph { PH_NORM1 = 0, PH_INPROJ, PH_PREP, PH_CPRE, PH_MIX, PH_RWOUT, PH_OUTPROJ, PH_ROUTER, PH_COMPACT, PH_EXP1, PH_EXP2, PH_COMBINE, PH_PER_LAYER };

__global__ void __launch_bounds__(NTHREADS, 2) k_fused(P p_arg) {
    (void)p_arg;
#define KARGS() load_args()
    extern __shared__ __attribute__((aligned(16))) unsigned char lds_raw[];
    LAS unsigned char* lds = (LAS unsigned char*)lds_raw;
    LAS int* tstart = (LAS int*)(lds + LDS_STAGE);
    LAS int* cnts = (LAS int*)(lds + LDS_STAGE + 272);
    volatile LAS unsigned* bst = (volatile LAS unsigned*)(lds + LDS_STAGE + 1008);
    if (threadIdx.x < 4) bst[threadIdx.x] = 0u;
    __syncthreads();
    XcdBarrier xb = xcd_barrier_post(load_args().bar, bst);
#define PHASE_COORDS() int G = gridDim.x, bx = blockIdx.x; asm volatile("" : "+s"(G), "+s"(bx)); const int vcu = (G % 8 == 0) ? (bx % 8) * (G / 8) + bx / 8 : bx; (void)vcu; \
    const int tid = opaque(threadIdx.x), half = tid >> 8, lane = tid & 63, wave = __builtin_amdgcn_readfirstlane(tid >> 6); \
    float* smem = (float*)lds_raw + half * 8192; LAS float* scr = (LAS float*)(lds + wave * 16384); (void)lane; (void)smem; (void)scr; (void)tid

    for (int rep = 0; rep < (REP_PH == -1 ? REP_N : 1); ++rep) {
        const P p = KARGS();
        PHASE_COORDS();
        for (int it = bx; it < NL * 96; it += G) st_mod(p, it, (LAS float*)lds);
        __syncthreads();
        for (int it = (bx * 8 + wave); it < CV_DENSE; it += G * 8) cvt_dense_item(p, it, scr, lane);
        for (int idx = bx * NTHREADS + tid; idx < NL * RWW * 160; idx += G * NTHREADS) {
            const int k = idx % 160, c = (idx / 160) % RWW, ly = idx / (160 * RWW);
            float v;
            if (k < 32) v = p.rw_w2[((size_t)ly * 32 + k) * RWW + c];
            else if (k < 64) v = p.rw_a2[((size_t)ly * 32 + (k - 32)) * RWW + c];
            else if (k < 128) v = p.rw_g2[((size_t)ly * 64 + (k - 64)) * RWW + c];
            else v = (ly == 1) ? p.rw_v2[(size_t)(k - 128) * RWW + c] : 0.f;
            p.lwt[idx] = (bf16_t)f2bf(v);
        }
        xcd_barrier(xb);
    }

    constexpr int NPH2 = NL * PH_PER_LAYER + ((REP_PH >= 0) ? REP_N - 1 : 0);
    for (int ph2 = 0; ph2 < NPH2; ++ph2) {
      {
        const int ph = (REP_PH < 0 || ph2 <= REP_PH) ? ph2 : (ph2 < REP_PH + REP_N ? REP_PH : ph2 - (REP_N - 1));
        const int rep = (REP_PH >= 0 && ph2 > REP_PH && ph2 < REP_PH + REP_N) ? 1 : 0; (void)rep;
        const int l = ph / PH_PER_LAYER, st = ph % PH_PER_LAYER;
        const P p = KARGS();
        PHASE_COORDS();
        if (st == PH_NORM1) {
            if (l == 0) {
                for (int t = bx * 8 + wave; t < T; t += G * 8) {
                    const int tn = t + G * 8; unsigned pfv = 0u;
                    if (tn < T) pfv = pf_lines(p.x + (size_t)tn * D, D * 4, lane);
                    norm_row<false>(p.x + (size_t)t * D, p.mod + (size_t)(t / SEQ) * 6144, p.h + (size_t)t * D, (LAS float*)lds, lane);
                    pf_done(pfv);
                }
            }
        } else if (st == PH_INPROJ) {
            pg8::DenseOrder S; S.init(p.h, p.wt_in + (size_t)l * PJB * D, T, PJB, D, G, bx);
            pg8::EpiProj E{p.proj, p.vt};
            pg8::gemm_phase<pg8::EpiProj, pg8::DenseOrder, true, true>(lds, D, S, E);
        } else if (st == PH_PREP) {
            st_prep(p, l, bx, G, lds);
        } else if (st == PH_CPRE) {
            if (wave < CP_WAVES) for (int it = bx * CP_WAVES + wave; it < NBATCH * 6 * (SEQ / 32); it += G * CP_WAVES) st_cpre(p, it, lds + wave * CP_LDS, lane);
        } else if (st == PH_MIX) {
            constexpr int N1 = NBATCH * 6, N2 = NBATCH * 6 * (SEQ / 32) / 8, N3 = T / 32, N4 = (CV_EXP + 7) / 8;
            const int sel = (rep == 0) ? 15 : REP_SEL;
            if (sel & 1) for (int wb = bx; wb < N1; wb += G) st_cscan(p, wb, lds);
            __syncthreads();
            {
                unsigned* ctrA = p.bar + 3500 + 2 * ph2; unsigned* ctrB = ctrA + 1;
                volatile LAS int* gslot = (volatile LAS int*)(lds + LDS_STAGE + 640);
                for (;;) {
                    __syncthreads();
                    if (tid == 0) *gslot = (int)__hip_atomic_fetch_add(ctrA, 2u, __ATOMIC_RELAXED, __HIP_MEMORY_SCOPE_AGENT);
                    __syncthreads();
                    const int base = *gslot;
                    if (base >= N2 + N3) break;
                    for (int wb = base; wb < base + 2 && wb < N2 + N3; ++wb) {
                        if (wb < N2) { if (sel & 2) st_attn(p, l, wb * 8 + wave); }
                        else if (sel & 4) st_pool(p, l, wb - N2, (LAS float*)lds);
                    }
                }
                for (;;) {
                    __syncthreads();
                    if (tid == 0) *gslot = (int)__hip_atomic_fetch_add(ctrB, 8u, __ATOMIC_RELAXED, __HIP_MEMORY_SCOPE_AGENT);
                    __syncthreads();
                    const int base = *gslot;
                    if (base >= N4) break;
                    if (sel & 8) cvt_exp_stream(p, l, base * 8 + wave, 8, min((base + 8) * 8, CV_EXP), scr, lane);
                }
            }
        } else if (st == PH_RWOUT) {
            for (int t = bx * 8 + wave; t < T; t += G * 8) {
                const int tn = t + G * 8; unsigned pfv = 0u;
                if (tn < T) pfv = pf_lines(p.y + (size_t)tn * RWW, RWW * 4, lane) + pf_lines(p.rec + (size_t)tn * REC_TB, REC_TB, lane) + pf_lines(p.g + (size_t)tn * RWW, RWW * 2, lane);
                st_rwout(p, l, t, lane);
                pf_done(pfv);
            }
        } else if (st == PH_OUTPROJ) {
            pg8::DenseOrder S; S.init(p.h, p.wt_out + (size_t)l * D * D, T, D, D, G, bx);
            pg8::EpiOut E{l == 0 ? p.x : p.xb, p.xb, p.mod + (size_t)l * 8 * 6144 + 2048};
            pg8::gemm_phase<pg8::EpiOut, pg8::DenseOrder, true, true>(lds, D, S, E);
        } else if (st == PH_ROUTER) {
            st_normrouter(p, l, bx, G, (LAS float*)lds);
        } else if (st == PH_COMPACT) {
            if (bx < NE) st_compact(p, bx, (LAS int*)lds);
        } else if (st == PH_EXP1 || st == PH_EXP2) {
            __syncthreads();
            if (tid == 0) {
                int acc = 0;
                for (int e = 0; e < 65; ++e) { const int c = e < NE ? p.cnt[e] : T; cnts[e] = c; tstart[e] = acc; acc += (c + 255) >> 8; }
                tstart[65] = acc;
            }
            __syncthreads();
            if (st == PH_EXP1) {
                pg8::MoeOrder<true> S{tstart, cnts, p.list, p.h, p.wt1, D, 512, 1, G, vcu};
                pg8::EpiExp1 E{p.hm};
                pg8::gemm_phase<pg8::EpiExp1, pg8::MoeOrder<true>, true, true>(lds, D, S, E);
            } else {
                pg8::MoeOrder<false> S{tstart, cnts, p.list, p.hm, p.wt2, ED, D, 2, G, vcu};
                pg8::EpiExp2 E{p.slab, p.list, p.topw, cnts};
                pg8::gemm_phase<pg8::EpiExp2, pg8::MoeOrder<false>, true, true>(lds, ED, S, E);
            }
        } else {
            for (int t = bx * 8 + wave; t < T; t += G * 8) {
                const int tn = t + G * 8; unsigned pfv = 0u;
                if (tn < T) pfv = pf_lines(p.slab + (size_t)tn * TOPK * D, TOPK * D * 2, lane) + pf_lines(p.xb + (size_t)tn * D, D * 4, lane) + pf_lines(p.slab + ((size_t)T * TOPK + tn) * D, D * 2, lane);
                st_combine(p, l, t, lane);
                pf_done(pfv);
            }
        }
        if (!(ph2 == NPH2 - 1)) { if (!(st == PH_NORM1 && l > 0)) xcd_barrier(xb); }
      }
    }
#undef PHASE_COORDS
#undef KARGS
}

}

extern "C" void kernel_launch(void* const* d_in, const int* in_sizes, int n_in, void* d_out, int out_size, void* d_ws, size_t ws_size,
                              hipStream_t stream) {
    P p{};
    const float** fp = (const float**)&p;
    for (int i = 0; i < 33; ++i) fp[i] = (const float*)d_in[i];
    p.out = (float*)d_out;
    char* ws = (char*)d_ws;
    size_t off = 0;
    auto take = [&](size_t bytes) { char* r = ws + off; off += (bytes + 255) & ~(size_t)255; return r; };
    p.bar = (unsigned*)take(16384);
    p.cnt = (int*)take(256);
    p.mod = (float*)take((size_t)NL * 8 * 6144 * 4);
    p.list = (int*)take((size_t)NE * T * 4);
    p.cnt2 = (int*)take((size_t)NE * 1024 * 4);
    p.seg = (int*)take((size_t)NE * 1024 * 16 * 4);
    p.topw = (float*)take((size_t)T * TOPK * 4);
    p.wt_in = (bf16_t*)take((size_t)NL * PJB * D * 2);
    p.wt_out = (bf16_t*)take((size_t)NL * D * D * 2);
    p.lwt = (bf16_t*)take((size_t)NL * RWW * 160 * 2);
    p.wt1 = (bf16_t*)take((size_t)65 * 512 * D * 2);
    p.wt2 = (bf16_t*)take((size_t)65 * D * ED * 2);
    p.xb = (float*)take((size_t)T * D * 4);
    p.h = (bf16_t*)take((size_t)T * D * 2);
    p.vfirst = (bf16_t*)take((size_t)T * RWW * 2);
    const size_t ov = off;
    p.proj = (bf16_t*)take((size_t)T * PJB * 2);
    p.vt = (bf16_t*)take((size_t)T * SBW * 2);
    p.rec = (unsigned char*)take((size_t)T * REC_TB);
    p.g = (bf16_t*)take((size_t)T * RWW * 2);
    p.y = (float*)take((size_t)T * RWW * 4);
    p.cb = (unsigned char*)take((size_t)NBATCH * 6 * (SEQ / 32) * CB_BYTES);
    p.hm = (bf16_t*)(ws + ov);
    p.slab = (bf16_t*)(ws + ov + (size_t)MAXRT * 256 * ED * 2);
    const size_t end_moe = ov + (size_t)MAXRT * 256 * ED * 2 + (size_t)T * (TOPK + 1) * D * 2;
    if (end_moe > off) off = end_moe;
    if (off > ws_size) { fprintf(stderr, "kernel_launch: workspace too small: need %zu, have %zu\n", off, ws_size); return; }

    static int cus = 0;
    if (cus == 0) {
        int dev = 0, n = 0;
        if (hipGetDevice(&dev) != hipSuccess || hipDeviceGetAttribute(&n, hipDeviceAttributeMultiprocessorCount, dev) != hipSuccess || n <= 0) n = 256;
        (void)hipFuncSetAttribute((const void*)k_fused, hipFuncAttributeMaxDynamicSharedMemorySize, LDS_BYTES);
        cus = n;
    }
    (void)hipMemsetAsync(p.bar, 0, 16384 + 256, stream);
    void* args[] = {(void*)&p};
    (void)hipLaunchCooperativeKernel((const void*)k_fused, dim3(cus), dim3(NTHREADS), args, LDS_BYTES, stream);
}
```

```cpp
#include <hip/hip_runtime.h>
#include <stdint.h>
#include <stdio.h>

#define REP_PH -2
#define REP_N 1
#define REP_SEL 15

namespace {

typedef unsigned short bf16_t;
typedef short bf16x8 __attribute__((ext_vector_type(8)));
typedef float f32x4 __attribute__((ext_vector_type(4)));
typedef float f32x2 __attribute__((ext_vector_type(2)));
typedef unsigned u32x4 __attribute__((ext_vector_type(4)));
typedef unsigned u32x2 __attribute__((ext_vector_type(2)));
#define LAS __attribute__((address_space(3)))

constexpr int D = 1024, NBATCH = 8, SEQ = 2048, T = NBATCH * SEQ, NL = 2;
constexpr int RWW = 384, SBW = 384, PLW = 256;
constexpr int RWC = 1280, SBC = 1152, INC = 2688;
constexpr int PJB = 2816;
constexpr int NE = 64, TOPK = 6, ED = 256;
constexpr int MAXRT = 512;
constexpr int NTHREADS = 512;
constexpr float SLAB_SC = 16.f;
constexpr int LDS_STAGE = 141312, LDS_CTL = 1024, LDS_BYTES = LDS_STAGE + LDS_CTL;

struct P {
    const float *x, *c, *w_ada, *b_ada, *w_in, *w_vres, *mu_rw, *mu_vres, *rw_w0, *rw_w2, *rw_a0, *rw_a2,
        *rw_v0, *rw_v2, *rw_g2, *rw_k_k, *rw_k_a, *rw_r_k, *rw_ln_g, *rw_ln_b, *sb_norm_g, *pool_w, *pool_scale,
        *w_out, *w_router, *b_router, *w_eg, *w_eu, *w_ed, *w_sg, *w_su, *w_sd, *g_final;
    float* out;
    unsigned* bar;
    float* mod;
    int* cnt;
    int* list;
    int* cnt2;
    int* seg;
    float* topw;
    bf16_t* wt_in;
    bf16_t* wt_out;
    bf16_t* lwt;
    bf16_t* wt1;
    bf16_t* wt2;
    float* xb;
    bf16_t* h;
    bf16_t* vfirst;
    bf16_t* proj;
    bf16_t* vt;
    unsigned char* rec;
    unsigned char* cb;
    bf16_t* g;
    float* y;
    bf16_t* hm;
    unsigned char* slab;
};

__device__ __forceinline__ int opaque(int x) { asm volatile("" : "+v"(x)); return x; }
__device__ __forceinline__ float dpp_add16(float x) {
    x += __builtin_bit_cast(float, __builtin_amdgcn_update_dpp(0, __builtin_bit_cast(int, x), 0xB1, 0xF, 0xF, true));
    x += __builtin_bit_cast(float, __builtin_amdgcn_update_dpp(0, __builtin_bit_cast(int, x), 0x4E, 0xF, 0xF, true));
    x += __builtin_bit_cast(float, __builtin_amdgcn_update_dpp(0, __builtin_bit_cast(int, x), 0x141, 0xF, 0xF, true));
    x += __builtin_bit_cast(float, __builtin_amdgcn_update_dpp(0, __builtin_bit_cast(int, x), 0x140, 0xF, 0xF, true));
    return x;
}
__device__ __forceinline__ float wave_sum(float v) {
    v = dpp_add16(v);
    const int vi = __builtin_bit_cast(int, v);
    return (__builtin_bit_cast(float, __builtin_amdgcn_readlane(vi, 0)) + __builtin_bit_cast(float, __builtin_amdgcn_readlane(vi, 16)))
         + (__builtin_bit_cast(float, __builtin_amdgcn_readlane(vi, 32)) + __builtin_bit_cast(float, __builtin_amdgcn_readlane(vi, 48)));
}
__device__ __forceinline__ unsigned pf_lines(const void* p, int nbytes, int lane) {
    unsigned acc = 0u;
    for (int off = lane * 128; off < nbytes; off += 8192) acc += *(const unsigned*)((const char*)p + off);
    return acc;
}
__device__ __forceinline__ void pf_done(unsigned v) { asm volatile("" :: "v"(v)); }
__device__ __forceinline__ float sigmoidf_(float x) { return 1.f / (1.f + __expf(-x)); }
__device__ __forceinline__ float softplusf_(float x) { return fmaxf(x, 0.f) + __logf(1.f + __expf(-fabsf(x))); }
__device__ __forceinline__ float siluf_(float x) { return x / (1.f + __expf(-x)); }
__device__ __forceinline__ unsigned f2bf_sw(float f) { unsigned u = __builtin_bit_cast(unsigned, f); return (u + 0x7fffu + ((u >> 16) & 1u)) >> 16; }
__device__ __forceinline__ unsigned pk2_sw(float lo, float hi) { return f2bf_sw(lo) | (f2bf_sw(hi) << 16); }
typedef __bf16 bf16x2_t __attribute__((ext_vector_type(2)));
__device__ __forceinline__ unsigned cvtpk(float lo, float hi) { const f32x2 v = {lo, hi}; const bf16x2_t b = __builtin_convertvector(v, bf16x2_t); return __builtin_bit_cast(unsigned, b); }
__device__ __forceinline__ bf16x8 mk8(unsigned a, unsigned b, unsigned c, unsigned d) { return __builtin_bit_cast(bf16x8, (u32x4){a, b, c, d}); }
__device__ __forceinline__ unsigned pk2(float lo, float hi) { return cvtpk(lo, hi); }
__device__ __forceinline__ unsigned f2bf(float f) { return cvtpk(f, 0.f) & 0xffffu; }
__device__ __forceinline__ float bf2f(bf16_t h) { return __builtin_bit_cast(float, (unsigned)h << 16); }
__device__ __forceinline__ float bflo(unsigned u) { return __builtin_bit_cast(float, u << 16); }
__device__ __forceinline__ float bfhi(unsigned u) { return __builtin_bit_cast(float, u & 0xffff0000u); }

namespace pg8 {
constexpr int BM = 256, BK = 64, HALF = 128, HTB = HALF * BK * 2, STAGE_BYTES = 8 * HTB;
__device__ __forceinline__ int lds_byte(int r, int c) { const int st = (r >> 4) * 2 + (c >> 5), rr = r & 15, cc = c & 31, ob = rr * 64 + cc * 2; return st * 1024 + (ob ^ (((ob >> 9) & 1) << 5)); }
__device__ __forceinline__ void stage_rc(int b, int& R, int& C) { const int st = b / 1024, sb = b % 1024, swz = sb ^ (((sb >> 9) & 1) << 5); R = (st >> 1) * 16 + swz / 64; C = (st & 1) * 32 + (swz % 64) / 2; }
__device__ __forceinline__ int perm32(int rho) { const int n = rho >> 4, i = rho & 15; return 8 * (i >> 2) + 4 * n + (i & 3); }

struct Unit { int pm, pn, e, mt; };

template <class Epi, class Sched, bool ALIGN_EPI, bool SP2>
__device__ __forceinline__ void gemm_phase(LAS unsigned char* lds, const int K, const Sched& S, const Epi& E) {
    const int tid = opaque(threadIdx.x), wid = __builtin_amdgcn_readfirstlane(tid >> 6), lane = tid & 63, wr = wid >> 2, wc = wid & 3, fr = lane & 15, fq = lane >> 4;
    const int nt = K / BK;
    unsigned voffA[2], voffB[2];
#pragma unroll
    for (int i = 0; i < 2; ++i) { int R, C; stage_rc(tid * 16 + i * 8192, R, C); const int Rb = Epi::PERM ? ((R & ~31) + perm32(R & 31)) : R;
        voffA[i] = Sched::GATHER ? (unsigned)(C * 2) : (unsigned)(R * K + C) * 2u; voffB[i] = (unsigned)(Rb * K + C) * 2u; }
    const size_t kstep = (size_t)(BK * 2);
    const size_t hstep = (size_t)HALF * K * 2;
    const unsigned ldsw = (unsigned)wid * 1024u;
    const int aoff = lds_byte(wr * 64 + fr, fq * 8), boff = lds_byte(wc * 32 + fr, fq * 8);
#define PG8_SA(b, h) (((b) * 2 + (h)) * HTB)
#define PG8_SB(b, h) ((4 + (b) * 2 + (h)) * HTB)
#define PG8_STAGE(bufoff, gbase, voff) do { _Pragma("unroll") for (int _i = 0; _i < 2; ++_i) \
        __builtin_amdgcn_global_load_lds((const unsigned*)((const char*)(gbase) + (voff)[_i]), (LAS unsigned*)(lds + (bufoff) + ldsw + _i * 8192), 16, 0, 0); } while (0)
#define PG8_LDA(dst, b, h) do { _Pragma("unroll") for (int m = 0; m < 4; ++m) _Pragma("unroll") for (int k = 0; k < 2; ++k) dst[m][k] = *(const LAS bf16x8*)(lds + PG8_SA(b, h) + aoff + m * 2048 + k * 1024); } while (0)
#define PG8_LDB(dst, b, h) do { _Pragma("unroll") for (int n = 0; n < 2; ++n) _Pragma("unroll") for (int k = 0; k < 2; ++k) dst[n][k] = *(const LAS bf16x8*)(lds + PG8_SB(b, h) + boff + n * 2048 + k * 1024); } while (0)
#define PG8_MMA(ai, bj, At, Bt) do { __builtin_amdgcn_s_setprio(1); _Pragma("unroll") for (int m = 0; m < 4; ++m) _Pragma("unroll") for (int n = 0; n < 2; ++n) _Pragma("unroll") for (int k = 0; k < 2; ++k) \
        acc[ai][bj][m][n] = __builtin_amdgcn_mfma_f32_16x16x32_bf16(Bt[n][k], At[m][k], acc[ai][bj][m][n], 0, 0, 0); __builtin_amdgcn_s_setprio(0); } while (0)
#define PG8_WAIT_V(n) asm volatile("s_waitcnt vmcnt(" #n ")" ::: "memory")
#define PG8_WAIT_L(n) asm volatile("s_waitcnt lgkmcnt(" #n ")" ::: "memory")
#define PG8_BAR __builtin_amdgcn_s_barrier()
#define PG8_SCHED __builtin_amdgcn_sched_barrier(0)
    Unit cur, nxt; int ui = 0;
    if (!S.next(0, cur)) return;
    f32x4 acc[2][2][4][2];
#pragma unroll
    for (int a = 0; a < 2; ++a)
#pragma unroll
        for (int b = 0; b < 2; ++b)
#pragma unroll
            for (int m = 0; m < 4; ++m)
#pragma unroll
                for (int n = 0; n < 2; ++n) acc[a][b][m][n] = (f32x4){0.f, 0.f, 0.f, 0.f};
    bf16x8 At[4][2], B0[2][2], B1[2][2];
    const char* cA = S.a_base(cur); const char* cB = S.b_base(cur);
    unsigned pk[2] = {0u, 0u}, npk[2] = {0u, 0u};
    if constexpr (Sched::GATHER) S.a_tok(cur, tid, pk);
    const unsigned k2 = (unsigned)K * 2u;
#define PG8_STAGE_A(bufoff, gbase, hh, PK) do { if constexpr (Sched::GATHER) { unsigned _v[2]; _v[0] = (((PK)[0] >> (16 * (hh))) & 0xffffu) * k2 + voffA[0]; _v[1] = (((PK)[1] >> (16 * (hh))) & 0xffffu) * k2 + voffA[1]; \
        PG8_STAGE(bufoff, gbase, _v); } else { PG8_STAGE(bufoff, (gbase) + (hh) * hstep, voffA); } } while (0)
    static_assert(SP2, "only the SP2 loop is kept");
    PG8_STAGE(PG8_SB(0, 0), cB, voffB); PG8_STAGE(PG8_SB(0, 1), cB + hstep, voffB); PG8_STAGE_A(PG8_SA(0, 0), cA, 0, pk); PG8_STAGE_A(PG8_SA(0, 1), cA, 1, pk);
    if (wr == 1) PG8_BAR;
    PG8_WAIT_V(2); PG8_BAR;
    PG8_STAGE(PG8_SB(1, 0), cB + kstep, voffB); PG8_STAGE_A(PG8_SA(1, 0), cA + kstep, 0, pk); PG8_STAGE(PG8_SB(1, 1), cB + hstep + kstep, voffB);
    PG8_WAIT_V(6); PG8_BAR;
    for (;;) {
        const bool has_next = S.next(ui + 1, nxt);
        const char* nA = has_next ? S.a_base(nxt) : cA; const char* nB = has_next ? S.b_base(nxt) : cB;
        if constexpr (Sched::GATHER) { if (has_next) S.a_tok(nxt, tid, npk); else { npk[0] = pk[0]; npk[1] = pk[1]; } }
#pragma unroll 1
        for (int t = 0; t < nt; t += 2) {
            const bool last = (t == nt - 2);
            const char* a1 = cA + (size_t)(t + 1) * kstep;
            const char* a2 = last ? nA : cA + (size_t)(t + 2) * kstep; const char* b2 = last ? nB : cB + (size_t)(t + 2) * kstep;
            const char* a3 = a2 + kstep; const char* b3 = b2 + kstep;
            unsigned sp[2]; sp[0] = last ? npk[0] : pk[0]; sp[1] = last ? npk[1] : pk[1];
            PG8_LDB(B0, 0, 0); PG8_LDB(B1, 0, 1); PG8_SCHED; PG8_LDA(At, 0, 0); PG8_STAGE_A(PG8_SA(1, 1), a1, 1, pk);
            PG8_WAIT_V(8); PG8_WAIT_L(0); PG8_BAR; PG8_MMA(0, 0, At, B0); PG8_MMA(0, 1, At, B1); PG8_BAR; PG8_SCHED;
            PG8_LDA(At, 0, 1); PG8_STAGE(PG8_SB(0, 0), b2, voffB); PG8_STAGE(PG8_SB(0, 1), b2 + hstep, voffB); PG8_STAGE_A(PG8_SA(0, 0), a2, 0, sp);
            PG8_WAIT_V(8); PG8_WAIT_L(0); PG8_BAR; PG8_MMA(1, 0, At, B0); PG8_MMA(1, 1, At, B1); PG8_BAR; PG8_SCHED;
            PG8_LDB(B0, 1, 0); PG8_LDB(B1, 1, 1); PG8_SCHED; PG8_LDA(At, 1, 0); PG8_STAGE_A(PG8_SA(0, 1), a2, 1, sp);
            PG8_WAIT_V(8); PG8_WAIT_L(0); PG8_BAR; PG8_MMA(0, 0, At, B0); PG8_MMA(0, 1, At, B1); PG8_BAR; PG8_SCHED;
            PG8_LDA(At, 1, 1); PG8_STAGE(PG8_SB(1, 0), b3, voffB); PG8_STAGE(PG8_SB(1, 1), b3 + hstep, voffB); PG8_STAGE_A(PG8_SA(1, 0), a3, 0, sp);
            PG8_WAIT_V(8); PG8_WAIT_L(0); PG8_BAR; PG8_MMA(1, 0, At, B0); PG8_MMA(1, 1, At, B1); PG8_BAR; PG8_SCHED;
        }
        if constexpr (ALIGN_EPI) { if (wr == 0) PG8_BAR; }
        { const int t2 = opaque(threadIdx.x), w2 = __builtin_amdgcn_readfirstlane(t2 >> 6), l2 = t2 & 63; E(acc, cur, w2 >> 2, w2 & 3, l2 & 15, l2 >> 4); }
        if (!has_next) break;
#pragma unroll
        for (int a = 0; a < 2; ++a)
#pragma unroll
            for (int b = 0; b < 2; ++b)
#pragma unroll
                for (int m = 0; m < 4; ++m)
#pragma unroll
                    for (int n = 0; n < 2; ++n) acc[a][b][m][n] = (f32x4){0.f, 0.f, 0.f, 0.f};
        cur = nxt; cA = nA; cB = nB; ++ui;
        pk[0] = npk[0]; pk[1] = npk[1];
        if constexpr (ALIGN_EPI) { if (wr == 1) PG8_BAR; }
    }
    PG8_WAIT_V(0);
    if constexpr (!ALIGN_EPI) { if (wr == 0) PG8_BAR; }
    PG8_BAR;
#undef PG8_SA
#undef PG8_SB
#undef PG8_STAGE
#undef PG8_STAGE_A
#undef PG8_LDA
#undef PG8_LDB
#undef PG8_MMA
#undef PG8_WAIT_V
#undef PG8_WAIT_L
#undef PG8_BAR
#undef PG8_SCHED
}

struct DenseOrder {
    const bf16_t* A; const bf16_t* Bt; int K; int nM, nN, nwg, G, c;
    __device__ __forceinline__ void init(const bf16_t* A_, const bf16_t* Bt_, int M, int N, int K_, int G_, int c_) { A = A_; Bt = Bt_; K = K_; nM = M / BM; nN = N / BM; nwg = nM * nN; G = G_; c = c_; }
    __device__ __forceinline__ bool next(int i, Unit& u) const {
        const long L = (long)i * G + c; if (L >= nwg) return false;
        int wgid = (int)L; { const int q = nwg / 8, r = nwg % 8, xcd = wgid % 8, off = wgid / 8; wgid = (xcd < r ? xcd * (q + 1) : r * (q + 1) + (xcd - r) * q) + off; }
        const int nig = 8 * nN, gid = wgid / nig, fm = gid * 8, gsz = (nM - fm) < 8 ? (nM - fm) : 8;
        u.pm = fm + ((wgid % nig) % gsz); u.pn = (wgid % nig) / gsz; u.e = 0; u.mt = 0; return true;
    }
    __device__ __forceinline__ const char* a_base(const Unit& u) const { return (const char*)A + (size_t)u.pm * BM * K * 2; }
    __device__ __forceinline__ const char* b_base(const Unit& u) const { return (const char*)Bt + (size_t)u.pn * BM * K * 2; }
    static constexpr bool GATHER = false;
    __device__ __forceinline__ void a_tok(const Unit&, int, unsigned (&)[2]) const {}
};

template <bool GATHER_>
struct MoeOrder {
    static constexpr bool GATHER = GATHER_;
    const LAS int* tstart;
    const LAS int* cnts;
    const int* list;
    const bf16_t* A;
    const bf16_t* Bt;
    int K, N, lognpn, G, c;
    __device__ __forceinline__ bool next(int i, Unit& u) const {
        const int L = i * G + c; const int total = __builtin_amdgcn_readfirstlane(tstart[65]) << lognpn; if (L >= total) return false;
        const int rt = L >> lognpn; u.pn = L & ((1 << lognpn) - 1); u.pm = rt;
        int e = 0;
        for (int j = 1; j < 65; ++j) e += (tstart[j] <= rt) ? 1 : 0;
        e = __builtin_amdgcn_readfirstlane(e);
        u.e = e; u.mt = rt - __builtin_amdgcn_readfirstlane(tstart[e]); return true;
    }
    __device__ __forceinline__ const char* a_base(const Unit& u) const { return GATHER ? (const char*)A : (const char*)A + (size_t)u.pm * BM * K * 2; }
    __device__ __forceinline__ const char* b_base(const Unit& u) const { return (const char*)Bt + ((size_t)u.e * N + (size_t)u.pn * BM) * K * 2; }
    __device__ __forceinline__ void a_tok(const Unit& u, int tid, unsigned (&pkv)[2]) const {
        const int ce = cnts[u.e];
#pragma unroll
        for (int i = 0; i < 2; ++i) {
            int R, C; stage_rc(tid * 16 + i * 8192, R, C); (void)C;
            unsigned v = 0u;
#pragma unroll
            for (int hh = 0; hh < 2; ++hh) {
                const int idx = u.mt * BM + hh * HALF + R;
                int tok = 0;
                if (idx < ce) tok = (u.e < NE) ? (list[(size_t)u.e * T + idx] / TOPK) : idx;
                v |= (unsigned)tok << (16 * hh);
            }
            pkv[i] = v;
        }
    }
};

struct EpiProj {
    static constexpr bool PERM = true;
    bf16_t* O; bf16_t* vt;
    __device__ __forceinline__ void operator()(const f32x4 (&acc)[2][2][4][2], const Unit& u, int wr, int wc, int fr, int fq) const {
        const int row0 = u.pm * BM + wr * 64 + fr, col0 = u.pn * BM + wc * 32 + 8 * fq;
#pragma unroll
        for (int bj = 0; bj < 2; ++bj) {
            const bool isv = (u.pn == 8) || (u.pn == 9 && bj == 0);
            if (!isv) {
#pragma unroll
                for (int ai = 0; ai < 2; ++ai)
#pragma unroll
                    for (int m = 0; m < 4; ++m) { bf16_t* rowp = O + (size_t)(row0 + ai * HALF + m * 16) * PJB + col0 + bj * HALF;
                        const f32x4 v0 = acc[ai][bj][m][0], v1 = acc[ai][bj][m][1];
                        u32x4 w; w.x = pk2(v0[0], v0[1]); w.y = pk2(v0[2], v0[3]); w.z = pk2(v1[0], v1[1]); w.w = pk2(v1[2], v1[3]);
                        *(u32x4*)rowp = w; }
            } else {
                const int vc0 = col0 + bj * HALF - 2048;
#pragma unroll
                for (int ai = 0; ai < 2; ++ai)
#pragma unroll
                    for (int m = 0; m < 4; ++m) { const int row = row0 + ai * HALF + m * 16; const int b = row / SEQ, s = row % SEQ;
                        bf16_t* base = vt + ((size_t)b * SBW + vc0) * SEQ + s;
#pragma unroll
                        for (int n = 0; n < 2; ++n)
#pragma unroll
                            for (int j = 0; j < 4; ++j) base[(size_t)(4 * n + j) * SEQ] = (bf16_t)f2bf(acc[ai][bj][m][n][j]); }
            }
        }
    }
};
struct EpiOut {
    static constexpr bool PERM = false;
    const float* xin; float* xo; const float* gt;
    __device__ __forceinline__ void operator()(const f32x4 (&acc)[2][2][4][2], const Unit& u, int wr, int wc, int fr, int fq) const {
        const int row0 = u.pm * BM + wr * 64 + fr, col0 = u.pn * BM + wc * 32 + 4 * fq;
#pragma unroll
        for (int ai = 0; ai < 2; ++ai)
#pragma unroll
            for (int m = 0; m < 4; ++m) { const int row = row0 + ai * HALF + m * 16; const float* gr = gt + (size_t)(row / SEQ) * 6144;
#pragma unroll
                for (int bj = 0; bj < 2; ++bj)
#pragma unroll
                    for (int n = 0; n < 2; ++n) { const int col = col0 + bj * HALF + 16 * n;
                        const f32x4 xi = *(const f32x4*)(xin + (size_t)row * D + col); const f32x4 gg = *(const f32x4*)(gr + col);
                        *(f32x4*)(xo + (size_t)row * D + col) = xi + gg * acc[ai][bj][m][n]; } }
    }
};
struct EpiExp1 {
    static constexpr bool PERM = true;
    bf16_t* hm;
    __device__ __forceinline__ void operator()(const f32x4 (&acc)[2][2][4][2], const Unit& u, int wr, int wc, int fr, int fq) const {
        const int row0 = u.pm * BM + wr * 64 + fr, col0 = u.pn * HALF + wc * 32 + 8 * fq;
#pragma unroll
        for (int ai = 0; ai < 2; ++ai)
#pragma unroll
            for (int m = 0; m < 4; ++m) { bf16_t* rowp = hm + (size_t)(row0 + ai * HALF + m * 16) * ED + col0;
                float o[8];
#pragma unroll
                for (int n = 0; n < 2; ++n)
#pragma unroll
                    for (int j = 0; j < 4; ++j) o[n * 4 + j] = siluf_(acc[ai][0][m][n][j]) * acc[ai][1][m][n][j];
                u32x4 w; w.x = pk2(o[0], o[1]); w.y = pk2(o[2], o[3]); w.z = pk2(o[4], o[5]); w.w = pk2(o[6], o[7]);
                *(u32x4*)rowp = w; }
    }
};
struct EpiExp2 {
    static constexpr bool PERM = true;
    unsigned char* slab; const int* list; const float* topw; const LAS int* cnts;
    __device__ __forceinline__ static unsigned pack4(const f32x4& v, float sc) {
        const float a = fminf(fmaxf(v[0] * sc, -448.f), 448.f), b = fminf(fmaxf(v[1] * sc, -448.f), 448.f), c = fminf(fmaxf(v[2] * sc, -448.f), 448.f), d = fminf(fmaxf(v[3] * sc, -448.f), 448.f);
        int w = __builtin_amdgcn_cvt_pk_fp8_f32(a, b, 0, false);
        w = __builtin_amdgcn_cvt_pk_fp8_f32(c, d, w, true);
        return (unsigned)w;
    }
    __device__ __forceinline__ void operator()(const f32x4 (&acc)[2][2][4][2], const Unit& u, int wr, int wc, int fr, int fq) const {
        const int col0 = u.pn * BM + wc * 32 + 8 * fq; const int ce = cnts[u.e];
#pragma unroll
        for (int ai = 0; ai < 2; ++ai)
#pragma unroll
            for (int m = 0; m < 4; ++m) { const int idx = u.mt * BM + ai * HALF + wr * 64 + m * 16 + fr;
                if (idx < ce) {
                    int row; float sc;
                    if (u.e < NE) { const int aid = list[(size_t)u.e * T + idx]; row = aid; sc = topw[aid] * SLAB_SC; }
                    else { row = T * TOPK + idx; sc = SLAB_SC; }
                    unsigned char* rowp = slab + (size_t)row * D + col0;
#pragma unroll
                    for (int bj = 0; bj < 2; ++bj) *(u32x2*)(rowp + bj * HALF) = (u32x2){pack4(acc[ai][bj][m][0], sc), pack4(acc[ai][bj][m][1], sc)};
                } }
    }
};
}

__device__ __forceinline__ void st_mod(const P& p, int item, LAS float* L  ) {
    const int tid = opaque(threadIdx.x), wave = tid >> 6, lane = tid & 63;
    const int l = item / 96, j0 = (item % 96) * 64;
    for (int i = tid; i < 8 * 1024; i += NTHREADS) L[i] = siluf_(p.c[i]);
    __syncthreads();
    float acc[8];
#pragma unroll
    for (int b = 0; b < 8; ++b) acc[b] = 0.f;
    const float* w = p.w_ada + ((size_t)l * 1024 + wave * 128) * 6144 + j0 + lane;
#pragma unroll 8
    for (int i = 0; i < 128; ++i) {
        const float wv = w[(size_t)i * 6144];
#pragma unroll
        for (int b = 0; b < 8; ++b) acc[b] += L[b * 1024 + wave * 128 + i] * wv;
    }
    LAS float* red = L + 8 * 1024;
#pragma unroll
    for (int b = 0; b < 8; ++b) red[(wave * 8 + b) * 64 + lane] = acc[b];
    __syncthreads();
    {
        const int b = tid >> 6;
        float s = p.b_ada[l * 6144 + j0 + lane];
#pragma unroll
        for (int wv = 0; wv < 8; ++wv) s += red[(wv * 8 + b) * 64 + lane];
        p.mod[((size_t)l * 8 + b) * 6144 + j0 + lane] = s;
    }
    __syncthreads();
}

constexpr int REC_HB = 912, REC_TB = 6 * REC_HB;
constexpr int CB_PHI = 0, CB_RT = 8192, CB_PSI = 12288, CB_G = 16384, CB_V = 18432, CB_BYTES = 22528;
struct CvtJob { const float* W; bf16_t* WT; int K, N, k0, n0, dst_row0; };
__device__ __forceinline__ void cvt_load(const CvtJob& j, float (&wv)[32], int lane) {
#pragma unroll
    for (int i = 0; i < 32; ++i) wv[i] = j.W[(size_t)(j.k0 + 2 * i + (lane >> 5)) * j.N + j.n0 + (lane & 31)];
}
__device__ __forceinline__ void cvt_store(const CvtJob& j, const float (&wv)[32], LAS float* scr, int lane) {
#pragma unroll
    for (int i = 0; i < 32; ++i) scr[(2 * i + (lane >> 5)) * 33 + (lane & 31)] = wv[i];
    asm volatile("s_waitcnt lgkmcnt(0)" ::: "memory");
    const int c = lane & 7;
#pragma unroll
    for (int q = 0; q < 4; ++q) { const int n = (lane >> 3) + 8 * q; const LAS float* sp = scr + (8 * c) * 33 + n;
        u32x4 o; o.x = pk2(sp[0 * 33], sp[1 * 33]); o.y = pk2(sp[2 * 33], sp[3 * 33]); o.z = pk2(sp[4 * 33], sp[5 * 33]); o.w = pk2(sp[6 * 33], sp[7 * 33]);
        *(u32x4*)(j.WT + (size_t)(j.dst_row0 + n) * j.K + j.k0 + 8 * c) = o; }
    asm volatile("s_waitcnt lgkmcnt(0)" ::: "memory");
}
__device__ __forceinline__ void cvt_item(const float* W, int K, int N, int k0, int n0, bf16_t* WT, int dst_row0, LAS float* scr, int lane) {
    const CvtJob j{W, WT, K, N, k0, n0, dst_row0};
    float wv[32];
    cvt_load(j, wv, lane);
    cvt_store(j, wv, scr, lane);
}
constexpr int CV_IN = 16 * 84, CV_VR = 16, CV_OUT = 16 * 32, CV_DENSE_L = CV_IN + CV_VR + CV_OUT, CV_DENSE = NL * CV_DENSE_L;
__device__ __forceinline__ void cvt_dense_item(const P& p, int it, LAS float* scr, int lane) {
    const int l = it / CV_DENSE_L; int r = it % CV_DENSE_L;
    bf16_t* wti = p.wt_in + (size_t)l * PJB * D;
    if (r < CV_IN) { const int kb = r / 84, nb = r % 84; cvt_item(p.w_in + (size_t)l * D * INC, D, INC, kb * 64, nb * 32, wti, nb * 32, scr, lane); return; }
    r -= CV_IN;
    if (r < CV_VR) {
        if (l == 1) cvt_item(p.w_vres, D, 32, r * 64, 0, wti, INC, scr, lane);
        const int rz0 = (l == 1) ? INC + 32 : INC;
        for (int row = rz0 + (lane >> 3); row < PJB; row += 8) *(u32x4*)(wti + (size_t)row * D + r * 64 + (lane & 7) * 8) = (u32x4){0u, 0u, 0u, 0u};
        return;
    }
    r -= CV_VR;
    { const int kb = r / 32, nb = r % 32; cvt_item(p.w_out + (size_t)l * D * D, D, D, kb * 64, nb * 32, p.wt_out + (size_t)l * D * D, nb * 32, scr, lane); }
}
constexpr int CV_EXP_E = 128 + 128 + 128, CV_EXP = 65 * CV_EXP_E;
__device__ __forceinline__ CvtJob cvt_exp_job(const P& p, int l, int it) {
    const int e = it / CV_EXP_E; int r = it % CV_EXP_E;
    if (r < 256) {
        const int which = r >> 7; r &= 127; const int kb = r >> 3, nb = r & 7;
        const float* W = e < NE ? (which ? p.w_eu : p.w_eg) + ((size_t)l * NE + e) * D * ED : (which ? p.w_su : p.w_sg) + (size_t)l * D * ED;
        const int n0 = nb * 32, pn = n0 >> 7;
        return CvtJob{W, p.wt1 + (size_t)e * 512 * D, D, ED, kb * 64, n0, pn * 256 + which * 128 + (n0 & 127)};
    } else {
        r -= 256; const int kb = r >> 5, nb = r & 31;
        const float* W = e < NE ? p.w_ed + ((size_t)l * NE + e) * ED * D : p.w_sd + (size_t)l * ED * D;
        return CvtJob{W, p.wt2 + (size_t)e * D * ED, ED, D, kb * 64, nb * 32, nb * 32};
    }
}
__device__ __forceinline__ void cvt_exp_stream(const P& p, int l, int first, int stride, int CV_END, LAS float* scr, int lane) {
    if (first >= CV_END) return;
    float wa[32], wb[32];
    CvtJob ja = cvt_exp_job(p, l, first), jb = ja;
    cvt_load(ja, wa, lane);
    for (int it = first; it < CV_END; it += 2 * stride) {
        const bool hb = it + stride < CV_END;
        if (hb) { jb = cvt_exp_job(p, l, it + stride); cvt_load(jb, wb, lane); }
        cvt_store(ja, wa, scr, lane);
        if (!hb) break;
        const bool ha = it + 2 * stride < CV_END;
        if (ha) { ja = cvt_exp_job(p, l, it + 2 * stride); cvt_load(ja, wa, lane); }
        cvt_store(jb, wb, scr, lane);
        if (!ha) break;
    }
}

__device__ __forceinline__ void cvt_idle_wave(const P& p, int l, int quota, LAS float* scr, int lane) {
    unsigned* ctr = p.bar + 3600 + l;
    for (int done = 0; done < quota; done += 4) {
        int base = 0;
        if (lane == 0) base = (int)__hip_atomic_fetch_add(ctr, 4u, __ATOMIC_RELAXED, __HIP_MEMORY_SCOPE_AGENT);
        base = __builtin_amdgcn_readfirstlane(base);
        if (base >= CV_EXP) break;
        cvt_exp_stream(p, l, base, 1, min(base + 4, CV_EXP), scr, lane);
    }
}
__device__ __forceinline__ void st_cpre(const P& p, int item, LAS unsigned char* L, int lane_);
constexpr int CP_LDS = 20736;
constexpr int PREP_TOK = 64, PREP_XS = 168;
__device__ __forceinline__ void st_prep(const P& p, int l, int vb0, int vbstride, LAS unsigned char* L) {
    const int tid = opaque(threadIdx.x), wave = __builtin_amdgcn_readfirstlane(tid >> 6), lane = tid & 63, fr = lane & 15, fq = lane >> 4;
    LAS bf16_t* X = (LAS bf16_t*)L;
    for (int vb = vb0; vb < T / PREP_TOK; vb += vbstride) {
        const int t0 = vb * PREP_TOK, s0 = t0 % SEQ;
#pragma unroll 4
        for (int q = 0; q < PREP_TOK * 160 / NTHREADS; ++q) {
            const int it = tid + q * NTHREADS;
            const int tt = it / 160, i = it % 160;
            const int col = (i < 128) ? 1152 + i : INC + (i - 128);
            const float mu = (i < 128) ? p.mu_rw[l * RWC + col] : p.mu_vres[i - 128];
            const bf16_t* u = p.proj + (size_t)(t0 + tt) * PJB + col;
            const float uu = bf2f(u[0]), pv = (s0 + tt) > 0 ? bf2f(u[-PJB]) : 0.f;
            float x = uu + (pv - uu) * mu;
            if (i < 32) x = 1.f - 2.f / (__expf(2.f * x) + 1.f); else if (i >= 64 && i < 128) x = sigmoidf_(x);
            if (i >= 128 && l == 0) x = 0.f;
            X[tt * PREP_XS + i] = (bf16_t)f2bf(x);
        }
        __syncthreads();
        LAS float* iscr = (LAS float*)(L + 6 * CP_LDS + (wave - 6) * 8448);
        if (wave >= 6) cvt_idle_wave(p, l, 16, iscr, lane);
        if (wave < 6) {
            const int hh = wave;
            const int ll = opaque(lane), fr2 = ll & 15, fq2 = ll >> 4;
            const bf16_t* lw = p.lwt + ((size_t)l * RWW + hh * 64) * 160;
#pragma unroll 1
            for (int mt = 0; mt < 4; ++mt) {
                const int tb = t0 + 16 * mt + 4 * fq2, sb = s0 + 16 * mt + 4 * fq2;
                bf16_t rr[4][5], kr[4][5], vr[4][5], vf[4][4];
#pragma unroll
                for (int nt = 0; nt < 4; ++nt) {
                    const bf16_t* u = p.proj + (size_t)tb * PJB + hh * 64 + 16 * nt + fr2;
#pragma unroll
                    for (int rw = 0; rw < 5; ++rw) {
                        const bool ok = (rw > 0) || (sb > 0);
                        rr[nt][rw] = ok ? u[(ptrdiff_t)(rw - 1) * PJB] : (bf16_t)0; kr[nt][rw] = ok ? u[(ptrdiff_t)(rw - 1) * PJB + 384] : (bf16_t)0; vr[nt][rw] = ok ? u[(ptrdiff_t)(rw - 1) * PJB + 768] : (bf16_t)0;
                    }
#pragma unroll
                    for (int rg = 0; rg < 4; ++rg) vf[nt][rg] = (l == 1) ? p.vfirst[(size_t)(tb + rg) * RWW + hh * 64 + 16 * nt + fr2] : (bf16_t)0;
                }
                const LAS bf16_t* xa = X + (16 * mt + fr2) * PREP_XS + 8 * fq2;
                const bf16x8 Aw = *(const LAS bf16x8*)xa, Aa = *(const LAS bf16x8*)(xa + 32), Av = *(const LAS bf16x8*)(xa + 128);
                f32x4 aw[4], aa[4], av[4];
#pragma unroll
                for (int nt = 0; nt < 4; ++nt) {
                    const bf16_t* q = lw + (16 * nt + fr2) * 160 + 8 * fq2;
                    aw[nt] = __builtin_amdgcn_mfma_f32_16x16x32_bf16(Aw, *(const bf16x8*)q, (f32x4){0.f, 0.f, 0.f, 0.f}, 0, 0, 0);
                    aa[nt] = __builtin_amdgcn_mfma_f32_16x16x32_bf16(Aa, *(const bf16x8*)(q + 32), (f32x4){0.f, 0.f, 0.f, 0.f}, 0, 0, 0);
                    av[nt] = __builtin_amdgcn_mfma_f32_16x16x32_bf16(Av, *(const bf16x8*)(q + 128), (f32x4){0.f, 0.f, 0.f, 0.f}, 0, 0, 0);
                }
                float ksh[4][4], ss[4] = {0.f, 0.f, 0.f, 0.f};
#pragma unroll
                for (int nt = 0; nt < 4; ++nt) {
                    const int c = hh * 64 + 16 * nt + fr2;
                    const float muk = p.mu_rw[l * RWC + 384 + c], kkc = p.rw_k_k[l * RWW + c];
#pragma unroll
                    for (int rg = 0; rg < 4; ++rg) {
                        const float kc = bf2f(kr[nt][rg + 1]), kp = bf2f(kr[nt][rg]);
                        const float k = kc + (kp - kc) * muk;
                        ksh[nt][rg] = k; ss[rg] += (k * kkc) * (k * kkc);
                    }
                }
                float inrm[4], rkp[4] = {0.f, 0.f, 0.f, 0.f};
#pragma unroll
                for (int rg = 0; rg < 4; ++rg) inrm[rg] = 1.f / fmaxf(sqrtf(dpp_add16(ss[rg])), 1e-12f);
#pragma unroll
                for (int nt = 0; nt < 4; ++nt) {
                    const int c = hh * 64 + 16 * nt + fr2;
                    const float w0 = p.rw_w0[l * RWW + c], a0 = p.rw_a0[l * RWW + c], v0 = (l == 1) ? p.rw_v0[c] : 0.f;
                    const float kkc = p.rw_k_k[l * RWW + c], kac = p.rw_k_a[l * RWW + c], rkc = p.rw_r_k[l * RWW + c];
                    const float mur = p.mu_rw[l * RWC + c], muv = p.mu_rw[l * RWC + 768 + c];
#pragma unroll
                    for (int rg = 0; rg < 4; ++rg) {
                        const int t = tb + rg;
                        const float rc_ = bf2f(rr[nt][rg + 1]), rp = bf2f(rr[nt][rg]), vc = bf2f(vr[nt][rg + 1]), vp = bf2f(vr[nt][rg]);
                        const float r = rc_ + (rp - rc_) * mur; float v = vc + (vp - vc) * muv; const float k = ksh[nt][rg];
                        const float wlog = -softplusf_(-(aw[nt][rg] + w0)) - 0.5f;
                        const float decay = __expf(-__expf(wlog));
                        const float a = sigmoidf_(aa[nt][rg] + a0);
                        if (l == 1) { const float vg = sigmoidf_(av[nt][rg] + v0); v = v + (bf2f(vf[nt][rg]) - v) * vg; }
                        else p.vfirst[(size_t)t * RWW + c] = (bf16_t)f2bf(v);
                        const float kk = k * kkc * inrm[rg];
                        const float bq = kk * a, k2 = k * (1.f + (a - 1.f) * kac);
                        unsigned char* rc = p.rec + (size_t)t * REC_TB + hh * REC_HB;
                        *(float*)(rc + (16 * nt + fr2) * 4) = decay;
                        bf16_t* rb = (bf16_t*)(rc + 256) + 16 * nt + fr2;
                        rb[0] = (bf16_t)f2bf(-kk); rb[64] = (bf16_t)f2bf(bq); rb[128] = (bf16_t)f2bf(k2); rb[192] = (bf16_t)f2bf(decay * r); rb[256] = (bf16_t)f2bf(v);
                        rkp[rg] += r * k2 * rkc;
                    }
                }
#pragma unroll
                for (int rg = 0; rg < 4; ++rg) { const float rk = dpp_add16(rkp[rg]); if (fr2 == 0) *(float*)(p.rec + (size_t)(tb + rg) * REC_TB + hh * REC_HB + 896) = rk; }
                {
                    const bf16x8 Ag0 = *(const LAS bf16x8*)(xa + 64), Ag1 = *(const LAS bf16x8*)(xa + 96);
#pragma unroll
                    for (int nt = 0; nt < 4; ++nt) {
                        const bf16_t* q = lw + (16 * nt + fr2) * 160 + 64 + 8 * fq2;
                        f32x4 ag = __builtin_amdgcn_mfma_f32_16x16x32_bf16(Ag0, *(const bf16x8*)q, (f32x4){0.f, 0.f, 0.f, 0.f}, 0, 0, 0);
                        ag = __builtin_amdgcn_mfma_f32_16x16x32_bf16(Ag1, *(const bf16x8*)(q + 32), ag, 0, 0, 0);
#pragma unroll
                        for (int rg = 0; rg < 4; ++rg) p.g[(size_t)(tb + rg) * RWW + hh * 64 + 16 * nt + fr2] = (bf16_t)f2bf(ag[rg]);
                    }
                }
            }
        }
        __syncthreads();
        if (wave < 6) {
            const int b = t0 / SEQ, ch0 = s0 / 32;
#pragma unroll 1
            for (int q = 0; q < 2; ++q) st_cpre(p, ((b * 6 + wave) * 64) + ch0 + q, L + wave * CP_LDS, lane);
        } else cvt_idle_wave(p, l, 20, iscr, lane);
        __syncthreads();
    }
}

typedef float f32x16 __attribute__((ext_vector_type(16)));
__device__ __forceinline__ bf16x8 acc_frag(const f32x16& x, int ks) {
    return ks == 0 ? mk8(cvtpk(x[0], x[1]), cvtpk(x[2], x[3]), cvtpk(x[4], x[5]), cvtpk(x[6], x[7])) : mk8(cvtpk(x[8], x[9]), cvtpk(x[10], x[11]), cvtpk(x[12], x[13]), cvtpk(x[14], x[15]));
}
__device__ __forceinline__ bf16x8 lds_perm_frag(const LAS unsigned char* rowp, int ks, int hf) {
    const u32x2 g0 = *(const LAS u32x2*)(rowp + (16 * ks + 4 * hf) * 2), g1 = *(const LAS u32x2*)(rowp + (16 * ks + 4 * hf + 8) * 2);
    return mk8(g0.x, g0.y, g1.x, g1.y);
}
__device__ __forceinline__ void st_cpre(const P& p, int item, LAS unsigned char* L, int lane_) {
    const int lane = opaque(lane_);
    const int ch = item & 63, bh = item >> 6, b = bh / 6, hh = bh % 6;
    const int r = lane & 31, hf = lane >> 5;
    const unsigned char* rec0 = p.rec + ((size_t)(b * SEQ + ch * 32)) * REC_TB + hh * REC_HB;
    unsigned char* cbo = p.cb + (size_t)item * CB_BYTES;
    LAS unsigned char* AbarT = L; LAS unsigned char* RbarT = L + 4096; LAS unsigned char* Bbar = L + 8192; LAS unsigned char* Kbar = L + 12288; LAS unsigned char* BbarT = L + 16384;
    LAS float* PCv = (LAS float*)(L + 20480);
    float Y[32];
    {
        float Pc = 1.f;
        unsigned bt[16], vtw[16];
#pragma unroll
        for (int t8 = 0; t8 < 32; t8 += 16) {
            float wv[16]; bf16_t av[16], bv[16], kv[16], qv[16], vv[16];
#pragma unroll
            for (int j = 0; j < 16; ++j) {
                const unsigned char* rp = rec0 + (size_t)(t8 + j) * REC_TB;
                wv[j] = *(const float*)(rp + lane * 4);
                const bf16_t* hb = (const bf16_t*)(rp + 256) + lane;
                av[j] = hb[0]; bv[j] = hb[64]; kv[j] = hb[128]; qv[j] = hb[192]; vv[j] = hb[256];
            }
#pragma unroll
            for (int j = 0; j < 16; ++j) {
                const int t = t8 + j;
                const float Pm = Pc; Pc *= wv[j]; const float inv = 1.f / Pc;
                const float ab = bf2f(av[j]) * Pm, rb = bf2f(qv[j]) * Pm, bb = bf2f(bv[j]) * inv, kb = bf2f(kv[j]) * inv;
                Y[t] = ab;
                *(LAS bf16_t*)(AbarT + (t * 64 + lane) * 2) = (bf16_t)f2bf(ab);
                *(LAS bf16_t*)(RbarT + (t * 64 + lane) * 2) = (bf16_t)f2bf(rb);
                *(LAS bf16_t*)(Bbar + (t * 64 + lane) * 2) = (bf16_t)f2bf(bb);
                *(LAS bf16_t*)(Kbar + (t * 64 + lane) * 2) = (bf16_t)f2bf(kb);
                if (t & 1) { bt[t >> 1] |= f2bf(bb) << 16; vtw[t >> 1] |= (unsigned)vv[j] << 16; } else { bt[t >> 1] = f2bf(bb); vtw[t >> 1] = (unsigned)vv[j]; }
            }
            asm volatile("" ::: "memory");
        }
        PCv[lane] = Pc;
#pragma unroll
        for (int q = 0; q < 4; ++q) {
            *(LAS u32x4*)(BbarT + lane * 64 + q * 16) = (u32x4){bt[4 * q], bt[4 * q + 1], bt[4 * q + 2], bt[4 * q + 3]};
            *(u32x4*)(cbo + CB_V + lane * 64 + q * 16) = (u32x4){vtw[4 * q], vtw[4 * q + 1], vtw[4 * q + 2], vtw[4 * q + 3]};
        }
    }
    asm volatile("s_waitcnt lgkmcnt(0)" ::: "memory");
    f32x16 Lab, Lak, Mbr, Mkr;
#pragma unroll
    for (int i = 0; i < 16; ++i) { Lab[i] = 0.f; Lak[i] = 0.f; Mbr[i] = 0.f; Mkr[i] = 0.f; }
#pragma unroll
    for (int ks = 0; ks < 4; ++ks) {
        const int off = (r * 64 + 16 * ks + 8 * hf) * 2;
        const bf16x8 fb = *(const LAS bf16x8*)(Bbar + off), fk = *(const LAS bf16x8*)(Kbar + off), fa = *(const LAS bf16x8*)(AbarT + off), fr = *(const LAS bf16x8*)(RbarT + off);
        Lab = __builtin_amdgcn_mfma_f32_32x32x16_bf16(fb, fa, Lab, 0, 0, 0);
        Lak = __builtin_amdgcn_mfma_f32_32x32x16_bf16(fk, fa, Lak, 0, 0, 0);
        Mbr = __builtin_amdgcn_mfma_f32_32x32x16_bf16(fb, fr, Mbr, 0, 0, 0);
        Mkr = __builtin_amdgcn_mfma_f32_32x32x16_bf16(fk, fr, Mkr, 0, 0, 0);
    }
#pragma unroll
    for (int i = 0; i < 16; ++i) {
        const int s = (i & 3) + 8 * (i >> 2) + 4 * hf;
        if (!(s < r)) { Lab[i] = 0.f; Lak[i] = 0.f; }
        if (!(s <= r)) { Mbr[i] = 0.f; Mkr[i] = 0.f; }
    }
    asm volatile("s_waitcnt lgkmcnt(0)" ::: "memory");
    {
        LAS float* LabT = (LAS float*)AbarT; LAS float* LakM = (LAS float*)Bbar;
#pragma unroll
        for (int g = 0; g < 4; ++g) *(LAS f32x4*)(LabT + r * 32 + 8 * g + 4 * hf) = (f32x4){Lab[4 * g], Lab[4 * g + 1], Lab[4 * g + 2], Lab[4 * g + 3]};
#pragma unroll
        for (int i = 0; i < 16; ++i) LakM[((i & 3) + 8 * (i >> 2) + 4 * hf) * 32 + r] = Lak[i];
    }
    asm volatile("s_waitcnt lgkmcnt(0)" ::: "memory");
    unsigned W2p[16];
    {
        const LAS float* LabT = (const LAS float*)AbarT; const LAS float* LakM = (const LAS float*)Bbar;
        float X2[32];
#pragma unroll
        for (int t = 0; t < 32; t += 4) { const f32x4 q = *(const LAS f32x4*)(LakM + r * 32 + t); X2[t] = q[0]; X2[t + 1] = q[1]; X2[t + 2] = q[2]; X2[t + 3] = q[3]; }
        int zdep = 0;
#pragma unroll
        for (int t = 1; t < 32; ++t) {
            float x1 = Y[t], x2 = X2[t];
            const LAS float* row = LabT + t * 32 + zdep;
#pragma unroll
            for (int s4 = 0; s4 < t; s4 += 4) {
                const f32x4 lq = *(const LAS f32x4*)(row + s4);
#pragma unroll
                for (int q = 0; q < 4; ++q) if (s4 + q < t) { x1 = fmaf(Y[s4 + q], lq[q], x1); x2 = fmaf(X2[s4 + q], lq[q], x2); }
            }
            Y[t] = x1; X2[t] = x2;
            asm volatile("v_mov_b32 %0, 0" : "=v"(zdep) : "v"(x1), "v"(x2));
        }
#pragma unroll
        for (int q = 0; q < 16; ++q) W2p[q] = pk2(X2[2 * q], X2[2 * q + 1]);
    }
    asm volatile("s_waitcnt lgkmcnt(0)" ::: "memory");
    LAS unsigned char* Atil = L;
    LAS unsigned char* Wv = L + 8192;
#pragma unroll
    for (int q = 0; q < 4; ++q) {
        *(LAS u32x4*)(Atil + lane * 64 + q * 16) = (u32x4){pk2(Y[8 * q], Y[8 * q + 1]), pk2(Y[8 * q + 2], Y[8 * q + 3]), pk2(Y[8 * q + 4], Y[8 * q + 5]), pk2(Y[8 * q + 6], Y[8 * q + 7])};
        if (lane < 32) *(LAS u32x4*)(Wv + lane * 64 + q * 16) = (u32x4){W2p[4 * q], W2p[4 * q + 1], W2p[4 * q + 2], W2p[4 * q + 3]};
    }
    asm volatile("s_waitcnt lgkmcnt(0)" ::: "memory");
    const bf16x8 mb0 = acc_frag(Mbr, 0), mb1 = acc_frag(Mbr, 1);
#pragma unroll
    for (int i = 0; i < 2; ++i) {
        f32x16 c;
#pragma unroll
        for (int g = 0; g < 4; ++g) { const u32x2 q = *(const LAS u32x2*)(RbarT + (r * 64 + 32 * i + 8 * g + 4 * hf) * 2); c[4 * g] = bflo(q.x); c[4 * g + 1] = bfhi(q.x); c[4 * g + 2] = bflo(q.y); c[4 * g + 3] = bfhi(q.y); }
        c = __builtin_amdgcn_mfma_f32_32x32x16_bf16(lds_perm_frag(Atil + (32 * i + r) * 64, 0, hf), mb0, c, 0, 0, 0);
        c = __builtin_amdgcn_mfma_f32_32x32x16_bf16(lds_perm_frag(Atil + (32 * i + r) * 64, 1, hf), mb1, c, 0, 0, 0);
#pragma unroll
        for (int g = 0; g < 4; ++g) *(u32x2*)(cbo + CB_RT + (r * 64 + 32 * i + 8 * g + 4 * hf) * 2) = (u32x2){cvtpk(c[4 * g], c[4 * g + 1]), cvtpk(c[4 * g + 2], c[4 * g + 3])};
    }
    {
        f32x16 c = Mkr;
        c = __builtin_amdgcn_mfma_f32_32x32x16_bf16(lds_perm_frag(Wv + r * 64, 0, hf), mb0, c, 0, 0, 0);
        c = __builtin_amdgcn_mfma_f32_32x32x16_bf16(lds_perm_frag(Wv + r * 64, 1, hf), mb1, c, 0, 0, 0);
#pragma unroll
        for (int g = 0; g < 4; ++g) *(u32x2*)(cbo + CB_G + (r * 32 + 8 * g + 4 * hf) * 2) = (u32x2){cvtpk(c[4 * g], c[4 * g + 1]), cvtpk(c[4 * g + 2], c[4 * g + 3])};
    }
#pragma unroll
    for (int jt = 0; jt < 2; ++jt) {
        const float pc = PCv[32 * jt + r];
        const bf16x8 fb0 = *(const LAS bf16x8*)(BbarT + (32 * jt + r) * 64 + (8 * hf) * 2), fb1 = *(const LAS bf16x8*)(BbarT + (32 * jt + r) * 64 + (16 + 8 * hf) * 2);
#pragma unroll
        for (int i = 0; i < 2; ++i) {
            f32x16 c;
#pragma unroll
            for (int q = 0; q < 16; ++q) c[q] = 0.f;
            c = __builtin_amdgcn_mfma_f32_32x32x16_bf16(*(const LAS bf16x8*)(Atil + (32 * i + r) * 64 + (8 * hf) * 2), fb0, c, 0, 0, 0);
            c = __builtin_amdgcn_mfma_f32_32x32x16_bf16(*(const LAS bf16x8*)(Atil + (32 * i + r) * 64 + (16 + 8 * hf) * 2), fb1, c, 0, 0, 0);
#pragma unroll
            for (int q = 0; q < 16; ++q) { const int kq = (q & 3) + 8 * (q >> 2) + 4 * hf; c[q] = (c[q] + ((i == jt && kq == r) ? 1.f : 0.f)) * pc; }
#pragma unroll
            for (int g = 0; g < 4; ++g) *(u32x2*)(cbo + CB_PHI + ((32 * jt + r) * 64 + 32 * i + 8 * g + 4 * hf) * 2) = (u32x2){cvtpk(c[4 * g], c[4 * g + 1]), cvtpk(c[4 * g + 2], c[4 * g + 3])};
        }
        {
            f32x16 c;
#pragma unroll
            for (int q = 0; q < 16; ++q) c[q] = bf2f(*(const LAS bf16_t*)(Kbar + (((q & 3) + 8 * (q >> 2) + 4 * hf) * 64 + 32 * jt + r) * 2));
            c = __builtin_amdgcn_mfma_f32_32x32x16_bf16(*(const LAS bf16x8*)(Wv + r * 64 + (8 * hf) * 2), fb0, c, 0, 0, 0);
            c = __builtin_amdgcn_mfma_f32_32x32x16_bf16(*(const LAS bf16x8*)(Wv + r * 64 + (16 + 8 * hf) * 2), fb1, c, 0, 0, 0);
#pragma unroll
            for (int g = 0; g < 4; ++g) *(u32x2*)(cbo + CB_PSI + ((32 * jt + r) * 32 + 8 * g + 4 * hf) * 2) = (u32x2){cvtpk(c[4 * g] * pc, c[4 * g + 1] * pc), cvtpk(c[4 * g + 2] * pc, c[4 * g + 3] * pc)};
        }
    }
    asm volatile("s_waitcnt lgkmcnt(0)" ::: "memory");
}

constexpr int CS_SLOTS = 4, CS_NP = CB_BYTES / 1024;
__device__ __forceinline__ void st_cscan(const P& p, int bh, LAS unsigned char* lds) {
    const int tid = opaque(threadIdx.x), wave = __builtin_amdgcn_readfirstlane(tid >> 6), lane = tid & 63;
    const int b = bh / 6, hh = bh % 6, r = lane & 31, hf = lane >> 5;
    const unsigned char* cb0 = p.cb + (size_t)bh * 64 * CB_BYTES;
    constexpr int NCH = SEQ / 32;
    const int lw = wave - 2;
#define CS_ISSUE(chunk) do { const int _c = (chunk) < NCH ? (chunk) : NCH - 1; const unsigned char* _g = cb0 + (size_t)_c * CB_BYTES + lane * 16; LAS unsigned char* _l = lds + ((chunk) & 3) * CB_BYTES; \
        _Pragma("unroll") for (int _j = 0; _j < 4; ++_j) if (lw + 6 * _j < CS_NP) __builtin_amdgcn_global_load_lds((const unsigned*)(_g + (lw + 6 * _j) * 1024), (LAS unsigned*)(_l + (lw + 6 * _j) * 1024), 16, 0, 0); } while (0)
    f32x16 X0, X1;
#pragma unroll
    for (int i = 0; i < 16; ++i) { X0[i] = 0.f; X1[i] = 0.f; }
    if (wave >= 2) { CS_ISSUE(0); CS_ISSUE(1); CS_ISSUE(2); }
    float* yb = p.y + (size_t)b * SEQ * RWW + hh * 64 + 32 * wave + r;
    for (int c = 0; c < NCH; ++c) {
        if (wave >= 2) { if (lw < 4) asm volatile("s_waitcnt vmcnt(8)" ::: "memory"); else asm volatile("s_waitcnt vmcnt(6)" ::: "memory"); }
        __builtin_amdgcn_s_barrier();
        if (wave >= 2) { CS_ISSUE(c + 3); }
        else {
            const LAS unsigned char* S = lds + (c & 3) * CB_BYTES;
            const int vr = 32 * wave + r;
            const bf16x8 vf0 = *(const LAS bf16x8*)(S + CB_V + vr * 64 + (8 * hf) * 2), vf1 = *(const LAS bf16x8*)(S + CB_V + vr * 64 + (16 + 8 * hf) * 2);
            const LAS unsigned char* rp = S + CB_RT + r * 128;
            const bf16x8 fr0 = lds_perm_frag(rp, 0, hf), fr1 = lds_perm_frag(rp, 1, hf), fr2 = lds_perm_frag(rp + 64, 0, hf), fr3 = lds_perm_frag(rp + 64, 1, hf);
            const bf16x8 fg0 = *(const LAS bf16x8*)(S + CB_G + r * 64 + (8 * hf) * 2), fg1 = *(const LAS bf16x8*)(S + CB_G + r * 64 + (16 + 8 * hf) * 2);
            const LAS unsigned char* p0 = S + CB_PHI + r * 128; const LAS unsigned char* p1 = S + CB_PHI + (32 + r) * 128;
            const bf16x8 fa0 = lds_perm_frag(p0, 0, hf), fa1 = lds_perm_frag(p0, 1, hf), fa2 = lds_perm_frag(p0 + 64, 0, hf), fa3 = lds_perm_frag(p0 + 64, 1, hf);
            const bf16x8 fb0 = lds_perm_frag(p1, 0, hf), fb1 = lds_perm_frag(p1, 1, hf), fb2 = lds_perm_frag(p1 + 64, 0, hf), fb3 = lds_perm_frag(p1 + 64, 1, hf);
            const LAS unsigned char* q0 = S + CB_PSI + r * 64; const LAS unsigned char* q1 = S + CB_PSI + (32 + r) * 64;
            const bf16x8 fp0 = *(const LAS bf16x8*)(q0 + (8 * hf) * 2), fp1 = *(const LAS bf16x8*)(q0 + (16 + 8 * hf) * 2), fp2 = *(const LAS bf16x8*)(q1 + (8 * hf) * 2), fp3 = *(const LAS bf16x8*)(q1 + (16 + 8 * hf) * 2);
            const bf16x8 x00 = acc_frag(X0, 0), x01 = acc_frag(X0, 1), x10 = acc_frag(X1, 0), x11 = acc_frag(X1, 1);
            asm volatile("s_waitcnt lgkmcnt(0)" ::: "memory");
            __builtin_amdgcn_sched_barrier(0);
            f32x16 yc, n0, n1;
#pragma unroll
            for (int i = 0; i < 16; ++i) { yc[i] = 0.f; n0[i] = 0.f; n1[i] = 0.f; }
            n0 = __builtin_amdgcn_mfma_f32_32x32x16_bf16(fa0, x00, n0, 0, 0, 0);
            n1 = __builtin_amdgcn_mfma_f32_32x32x16_bf16(fb0, x00, n1, 0, 0, 0);
            yc = __builtin_amdgcn_mfma_f32_32x32x16_bf16(fr0, x00, yc, 0, 0, 0);
            n0 = __builtin_amdgcn_mfma_f32_32x32x16_bf16(fa1, x01, n0, 0, 0, 0);
            n1 = __builtin_amdgcn_mfma_f32_32x32x16_bf16(fb1, x01, n1, 0, 0, 0);
            yc = __builtin_amdgcn_mfma_f32_32x32x16_bf16(fr1, x01, yc, 0, 0, 0);
            n0 = __builtin_amdgcn_mfma_f32_32x32x16_bf16(fa2, x10, n0, 0, 0, 0);
            n1 = __builtin_amdgcn_mfma_f32_32x32x16_bf16(fb2, x10, n1, 0, 0, 0);
            yc = __builtin_amdgcn_mfma_f32_32x32x16_bf16(fr2, x10, yc, 0, 0, 0);
            n0 = __builtin_amdgcn_mfma_f32_32x32x16_bf16(fa3, x11, n0, 0, 0, 0);
            n1 = __builtin_amdgcn_mfma_f32_32x32x16_bf16(fb3, x11, n1, 0, 0, 0);
            yc = __builtin_amdgcn_mfma_f32_32x32x16_bf16(fr3, x11, yc, 0, 0, 0);
            n0 = __builtin_amdgcn_mfma_f32_32x32x16_bf16(fp0, vf0, n0, 0, 0, 0);
            n1 = __builtin_amdgcn_mfma_f32_32x32x16_bf16(fp2, vf0, n1, 0, 0, 0);
            yc = __builtin_amdgcn_mfma_f32_32x32x16_bf16(fg0, vf0, yc, 0, 0, 0);
            n0 = __builtin_amdgcn_mfma_f32_32x32x16_bf16(fp1, vf1, n0, 0, 0, 0);
            n1 = __builtin_amdgcn_mfma_f32_32x32x16_bf16(fp3, vf1, n1, 0, 0, 0);
            yc = __builtin_amdgcn_mfma_f32_32x32x16_bf16(fg1, vf1, yc, 0, 0, 0);
            X0 = n0; X1 = n1;
#pragma unroll
            for (int i = 0; i < 16; ++i) yb[(size_t)(c * 32 + (i & 3) + 8 * (i >> 2) + 4 * hf) * RWW] = yc[i];
        }
    }
    asm volatile("s_waitcnt vmcnt(0)" ::: "memory");
    __builtin_amdgcn_s_barrier();
#undef CS_ISSUE
}

__device__ __forceinline__ void st_rwout(const P& p, int l, int t, int lane) {
    float y[6], vv[6], gg[6], rk[6];
#pragma unroll
    for (int hh = 0; hh < 6; ++hh) {
        y[hh] = p.y[(size_t)t * RWW + hh * 64 + lane]; vv[hh] = bf2f(*(const bf16_t*)(p.rec + (size_t)t * REC_TB + hh * REC_HB + 768 + lane * 2)); gg[hh] = bf2f(p.g[(size_t)t * RWW + hh * 64 + lane]);
        rk[hh] = *(const float*)(p.rec + (size_t)t * REC_TB + hh * REC_HB + 896);
    }
#pragma unroll
    for (int hh = 0; hh < 6; ++hh) {
        const int c = hh * 64 + lane;
        const float mean = wave_sum(y[hh]) * (1.f / 64.f);
        const float d = y[hh] - mean;
        const float var = wave_sum(d * d) * (1.f / 64.f);
        const float yn = d * rsqrtf(var + 64e-5f) * p.rw_ln_g[l * RWW + c] + p.rw_ln_b[l * RWW + c];
        p.h[(size_t)t * D + c] = (bf16_t)f2bf((yn + rk[hh] * vv[hh]) * gg[hh]);
    }
}

typedef float f32x16 __attribute__((ext_vector_type(16)));
constexpr float ATT_EXIT = -60.f;
__device__ __forceinline__ float xhalf(float x, int lane) { return __builtin_bit_cast(float, __builtin_amdgcn_ds_bpermute((lane ^ 32) << 2, __builtin_bit_cast(int, x))); }
__device__ __forceinline__ void st_attn(const P& p, int l, int item) {
    const int lane = opaque(threadIdx.x) & 63;
    const int qt = item % (SEQ / 32), bh = item / (SEQ / 32), b = bh / 6, hh = bh % 6;
    const int r = lane & 31, hf = lane >> 5;
    const bf16_t* qkb = p.proj + (size_t)b * SEQ * PJB + RWC + hh * 64 + 8 * hf;
    const bf16_t* vtb = p.vt + ((size_t)(b * 6 + hh) * 64 + r) * SEQ + 4 * hf;
    bf16x8 qf[4];
    {
        const bf16_t* qp = qkb + (size_t)(qt * 32 + r) * PJB;
#pragma unroll
        for (int s = 0; s < 4; ++s) {
            u32x4 t4 = *(const u32x4*)(qp + 16 * s);
            unsigned w[4] = {t4.x, t4.y, t4.z, t4.w};
#pragma unroll
            for (int q = 0; q < 4; ++q) { const float lo = bflo(w[q]) * 0.125f, hi = bfhi(w[q]) * 0.125f; w[q] = (__builtin_bit_cast(unsigned, lo) >> 16) | (__builtin_bit_cast(unsigned, hi) & 0xffff0000u); }
            t4.x = w[0]; t4.y = w[1]; t4.z = w[2]; t4.w = w[3];
            qf[s] = __builtin_bit_cast(bf16x8, t4);
        }
    }
    f32x16 o0, o1;
#pragma unroll
    for (int i = 0; i < 16; ++i) { o0[i] = 0.f; o1[i] = 0.f; }
    float R = 0.f;
    bf16x8 kfn[4]; u32x2 vfn[2][2][2];
#define ATT_LOAD(KT) do { const int _k0 = (KT) * 32; const bf16_t* kp = qkb + SBW + (size_t)(_k0 + r) * PJB; \
        _Pragma("unroll") for (int s = 0; s < 4; ++s) kfn[s] = *(const bf16x8*)(kp + 16 * s); \
        _Pragma("unroll") for (int dt = 0; dt < 2; ++dt) _Pragma("unroll") for (int s = 0; s < 2; ++s) { const bf16_t* vp = vtb + (size_t)dt * 32 * SEQ + _k0 + 16 * s; vfn[dt][s][0] = *(const u32x2*)vp; vfn[dt][s][1] = *(const u32x2*)(vp + 8); } } while (0)
    ATT_LOAD(qt);
    for (int kt = qt; kt >= 0; --kt) {
        const int key0 = kt * 32; (void)key0;
        bf16x8 kf[4]; u32x2 vf[2][2][2];
#pragma unroll
        for (int s = 0; s < 4; ++s) kf[s] = kfn[s];
#pragma unroll
        for (int dt = 0; dt < 2; ++dt)
#pragma unroll
            for (int s = 0; s < 2; ++s) { vf[dt][s][0] = vfn[dt][s][0]; vf[dt][s][1] = vfn[dt][s][1]; }
        if (kt > 0) ATT_LOAD(kt - 1);
        f32x16 z;
#pragma unroll
        for (int i = 0; i < 16; ++i) z[i] = 0.f;
#pragma unroll
        for (int s = 0; s < 4; ++s) z = __builtin_amdgcn_mfma_f32_32x32x16_bf16(kf[s], qf[s], z, 0, 0, 0);
        const bool diag = (kt == qt);
        float c[16], gs[4];
#pragma unroll
        for (int gi = 0; gi < 4; ++gi) {
            float run = 0.f;
#pragma unroll
            for (int e = 3; e >= 0; --e) {
                const int reg = gi * 4 + e;
                const float zz = z[reg];
                float L = -(fmaxf(zz, 0.f) + __logf(1.f + __expf(-fabsf(zz))));
                if (diag && !(r > e + 8 * gi + 4 * hf)) L = 0.f;
                run += L; c[reg] = run;
            }
            gs[gi] = run;
        }
        float go[4], pp[4], ob[4], off[4];
#pragma unroll
        for (int gi = 0; gi < 4; ++gi) { go[gi] = xhalf(gs[gi], lane); pp[gi] = gs[gi] + go[gi]; }
        ob[3] = 0.f; ob[2] = pp[3]; ob[1] = pp[3] + pp[2]; ob[0] = ob[1] + pp[1];
#pragma unroll
        for (int gi = 0; gi < 4; ++gi) off[gi] = ob[gi] + (hf == 0 ? go[gi] : 0.f) + R;
        const float total = ob[0] + pp[0];
        unsigned af[8];
#pragma unroll
        for (int i = 0; i < 8; ++i) {
            float a2[2];
#pragma unroll
            for (int q = 0; q < 2; ++q) {
                const int reg = 2 * i + q, gi = reg >> 2, e = reg & 3;
                float a = __expf(z[reg] + c[reg] + off[gi]);
                if (diag && !(r > e + 8 * gi + 4 * hf)) a = 0.f;
                a2[q] = a;
            }
            af[i] = pk2(a2[0], a2[1]);
        }
        R += total;
        const bf16x8 a0 = __builtin_bit_cast(bf16x8, (u32x4){af[0], af[1], af[2], af[3]});
        const bf16x8 a1 = __builtin_bit_cast(bf16x8, (u32x4){af[4], af[5], af[6], af[7]});
        o0 = __builtin_amdgcn_mfma_f32_32x32x16_bf16(__builtin_bit_cast(bf16x8, (u32x4){vf[0][0][0].x, vf[0][0][0].y, vf[0][0][1].x, vf[0][0][1].y}), a0, o0, 0, 0, 0);
        o0 = __builtin_amdgcn_mfma_f32_32x32x16_bf16(__builtin_bit_cast(bf16x8, (u32x4){vf[0][1][0].x, vf[0][1][0].y, vf[0][1][1].x, vf[0][1][1].y}), a1, o0, 0, 0, 0);
        o1 = __builtin_amdgcn_mfma_f32_32x32x16_bf16(__builtin_bit_cast(bf16x8, (u32x4){vf[1][0][0].x, vf[1][0][0].y, vf[1][0][1].x, vf[1][0][1].y}), a0, o1, 0, 0, 0);
        o1 = __builtin_amdgcn_mfma_f32_32x32x16_bf16(__builtin_bit_cast(bf16x8, (u32x4){vf[1][1][0].x, vf[1][1][0].y, vf[1][1][1].x, vf[1][1][1].y}), a1, o1, 0, 0, 0);
        if (__all(R < ATT_EXIT)) break;
    }
#undef ATT_LOAD
    float ss = 0.f;
#pragma unroll
    for (int i = 0; i < 16; ++i) ss += o0[i] * o0[i] + o1[i] * o1[i];
    ss += xhalf(ss, lane);
    const float rs = rsqrtf(ss * (1.f / 64.f) + 1e-6f);
    bf16_t* op = p.h + ((size_t)b * SEQ + qt * 32 + r) * D + RWW + hh * 64 + 4 * hf;
    const float* gn = p.sb_norm_g + l * SBW + hh * 64 + 4 * hf;
#pragma unroll
    for (int gi = 0; gi < 4; ++gi) {
        const f32x4 g0 = *(const f32x4*)(gn + 8 * gi), g1 = *(const f32x4*)(gn + 32 + 8 * gi);
        u32x2 w0, w1;
        w0.x = pk2(o0[4 * gi] * rs * g0[0], o0[4 * gi + 1] * rs * g0[1]); w0.y = pk2(o0[4 * gi + 2] * rs * g0[2], o0[4 * gi + 3] * rs * g0[3]);
        w1.x = pk2(o1[4 * gi] * rs * g1[0], o1[4 * gi + 1] * rs * g1[1]); w1.y = pk2(o1[4 * gi + 2] * rs * g1[2], o1[4 * gi + 3] * rs * g1[3]);
        *(u32x2*)(op + 8 * gi) = w0; *(u32x2*)(op + 32 + 8 * gi) = w1;
    }
}

__device__ __forceinline__ void st_pool(const P& p, int l, int vb, LAS float* PL  ) {
    const int tid = opaque(threadIdx.x);
    const int t0 = vb * 32, s0 = t0 % SEQ;
    {
        const int col = tid & 255, th = tid >> 8, g = col >> 6, win = 2 << g;
        const int sA = s0 + th * 16;
        const bf16_t* u = p.proj + (size_t)(t0 + th * 16) * PJB + RWC + SBC + col;
        float xv[31];
#pragma unroll
        for (int i = 0; i < 31; ++i) { const int s = sA - 15 + i; xv[i] = (s >= 0 && (i >= 15 || 15 - i < win)) ? bf2f(u[(ptrdiff_t)(i - 15) * PJB]) : 0.f; }
        float run = 0.f;
#pragma unroll
        for (int i = 0; i < 15; ++i) run += (15 - i < win) ? xv[i] : 0.f;
#pragma unroll
        for (int j = 0; j < 16; ++j) {
            run += xv[15 + j];
            const int s = sA + j, n = min(s + 1, win);
            PL[(th * 16 + j) * 256 + col] = run / (float)n - xv[15 + j];
            float drop = 0.f;
#pragma unroll
            for (int q = 1; q <= 4; ++q) if (win == (1 << q)) drop = xv[15 + j - (1 << q) + 1];
            run -= drop;
        }
    }
    __syncthreads();
    {
        const int wave = tid >> 6, lane = tid & 63, g = wave & 3, th = wave >> 2;
        float acc[16];
#pragma unroll
        for (int j = 0; j < 16; ++j) acc[j] = 0.f;
        const float* pw = p.pool_w + ((size_t)l * 4 + g) * 64 * 64 + lane;
        for (int c = 0; c < 64; c += 4) {
            const float w0 = pw[c * 64], w1 = pw[(c + 1) * 64], w2 = pw[(c + 2) * 64], w3 = pw[(c + 3) * 64];
#pragma unroll
            for (int j = 0; j < 16; ++j) { const f32x4 x = *(const LAS f32x4*)(PL + (th * 16 + j) * 256 + g * 64 + c); acc[j] += x[0] * w0 + x[1] * w1 + x[2] * w2 + x[3] * w3; }
        }
        const float sc = p.pool_scale[l * PLW + g * 64 + lane];
#pragma unroll
        for (int j = 0; j < 16; ++j) p.h[(size_t)(t0 + th * 16 + j) * D + 768 + g * 64 + lane] = (bf16_t)f2bf(acc[j] * sc);
    }
    __syncthreads();
}

template <bool TOLDS>
__device__ __forceinline__ void norm_row(const float* xr, const float* md  , bf16_t* hrow, LAS float* hl, int lane) {
    f32x4 v[4]; float ss = 0.f;
#pragma unroll
    for (int i = 0; i < 4; ++i) { v[i] = *(const f32x4*)(xr + i * 256 + lane * 4); ss += v[i][0] * v[i][0] + v[i][1] * v[i][1] + v[i][2] * v[i][2] + v[i][3] * v[i][3]; }
    ss = wave_sum(ss);
    const float rs = rsqrtf(ss * (1.f / D) + 1e-6f);
#pragma unroll
    for (int i = 0; i < 4; ++i) {
        const int cidx = i * 256 + lane * 4;
        const f32x4 sh = *(const f32x4*)(md + cidx), sc = *(const f32x4*)(md + 1024 + cidx);
        const f32x4 o = v[i] * rs * (sc + 1.f) + sh;
        u32x2 w; w.x = pk2(o[0], o[1]); w.y = pk2(o[2], o[3]);
        *(u32x2*)(hrow + cidx) = w;
        if constexpr (TOLDS) *(LAS f32x4*)(hl + cidx) = o;
    }
}

__device__ __forceinline__ void split_bf16(const float (&x)[8], bf16x8& hi, bf16x8& lo) {
    unsigned h[4], l[4];
#pragma unroll
    for (int q = 0; q < 4; ++q) {
        const unsigned ph = cvtpk(x[2 * q], x[2 * q + 1]);
        const float r0 = x[2 * q] - bflo(ph), r1 = x[2 * q + 1] - bfhi(ph);
        h[q] = ph; l[q] = cvtpk(r0, r1);
    }
    hi = mk8(h[0], h[1], h[2], h[3]); lo = mk8(l[0], l[1], l[2], l[3]);
}
__device__ __forceinline__ void st_normrouter(const P& p, int l, int vb0, int vbstride, LAS float* L  ) {
    const int tid = opaque(threadIdx.x), wave = tid >> 6, lane = tid & 63;
    const int fr = lane & 15, fq = lane >> 4;
    constexpr int HS = 1028;
    LAS float* H = L; LAS float* PART = L + 16 * HS; LAS float* SEL = PART + 8 * 16 * 64; LAS int* lcnt = (LAS int*)(SEL + 16 * 72);
    bf16x8 Bh[4][4], Bl[4][4];
    {
        const float* wr = p.w_router + ((size_t)l * D + wave * 128) * NE;
        const int ll = opaque(lane), fr2 = ll & 15, fq2 = ll >> 4;
#pragma unroll
        for (int ks = 0; ks < 4; ++ks)
#pragma unroll
            for (int nt = 0; nt < 4; ++nt) {
                float x[8];
#pragma unroll
                for (int j = 0; j < 8; ++j) x[j] = wr[(32 * ks + 8 * fq2 + j) * NE + 16 * nt + fr2];
                split_bf16(x, Bh[ks][nt], Bl[ks][nt]);
            }
    }
    const float brt = p.b_router[l * NE + lane];
    for (int vb = vb0; vb < T / 16; vb += vbstride) {
        const int t0 = vb * 16, b = t0 / SEQ;
        const float* md = p.mod + ((size_t)l * 8 + b) * 6144 + 3072;
        if (tid < 64) lcnt[tid] = 0;
        unsigned pfv = 0u;
        if (vb + vbstride < T / 16) pfv = pf_lines(p.xb + (size_t)((vb + vbstride) * 16 + wave * 2) * D, 2 * D * 4, lane);
#pragma unroll
        for (int q = 0; q < 2; ++q) { const int tt = wave * 2 + q; norm_row<true>(p.xb + (size_t)(t0 + tt) * D, md, p.h + (size_t)(t0 + tt) * D, H + tt * HS, lane); }
        __syncthreads();
        {
            f32x4 acc[4];
#pragma unroll
            for (int nt = 0; nt < 4; ++nt) acc[nt] = (f32x4){0.f, 0.f, 0.f, 0.f};
#pragma unroll
            for (int ks = 0; ks < 4; ++ks) {
                const LAS float* hp = H + fr * HS + wave * 128 + 32 * ks + 8 * fq;
                const f32x4 h0 = *(const LAS f32x4*)hp, h1 = *(const LAS f32x4*)(hp + 4);
                const float x[8] = {h0[0], h0[1], h0[2], h0[3], h1[0], h1[1], h1[2], h1[3]};
                bf16x8 ah, al; split_bf16(x, ah, al);
#pragma unroll
                for (int nt = 0; nt < 4; ++nt) {
                    acc[nt] = __builtin_amdgcn_mfma_f32_16x16x32_bf16(ah, Bh[ks][nt], acc[nt], 0, 0, 0);
                    acc[nt] = __builtin_amdgcn_mfma_f32_16x16x32_bf16(ah, Bl[ks][nt], acc[nt], 0, 0, 0);
                    acc[nt] = __builtin_amdgcn_mfma_f32_16x16x32_bf16(al, Bh[ks][nt], acc[nt], 0, 0, 0);
                }
            }
#pragma unroll
            for (int nt = 0; nt < 4; ++nt)
#pragma unroll
                for (int rg = 0; rg < 4; ++rg) PART[(wave * 16 + 4 * fq + rg) * 64 + 16 * nt + fr] = acc[nt][rg];
        }
        __syncthreads();
#pragma unroll
        for (int q = 0; q < 2; ++q) {
            const int tt = wave * 2 + q, t = t0 + tt;
            float logit = 0.f;
#pragma unroll
            for (int w = 0; w < 8; ++w) logit += PART[(w * 16 + tt) * 64 + lane];
            float score = sigmoidf_(logit);
            score = (score == score) ? score : 0.f;
            const float sl = score + brt;
            LAS float* sel = SEL + (wave * 2 + q) * 72; LAS float* gs = sel + 64;
            sel[lane] = sl;
            if (lane < 8) {
                float m1 = -INFINITY, m2 = -INFINITY;
                for (int i = 0; i < 8; ++i) { const float v = sel[lane * 8 + i]; if (v > m1) { m2 = m1; m1 = v; } else if (v > m2) m2 = v; }
                gs[lane] = m1 + m2;
            }
            const int gI = lane >> 3;
            int grank = 0;
            for (int i = 0; i < 8; ++i) { const float v = gs[i]; grank += (v > gs[gI] || (v == gs[gI] && i < gI)) ? 1 : 0; }
            const float msk = (grank < 4) ? sl : -INFINITY;
            sel[lane] = msk;
            int rank = 0;
            for (int i = 0; i < 64; ++i) { const float v = sel[i]; rank += (v > msk || (v == msk && i < lane)) ? 1 : 0; }
            const bool chosen = rank < TOPK;
            const float wsum = wave_sum(chosen ? score : 0.f);
            if (chosen) {
                const int pos = __hip_atomic_fetch_add(&lcnt[lane], 1, __ATOMIC_RELAXED, __HIP_MEMORY_SCOPE_WORKGROUP);
                p.seg[((size_t)lane * 1024 + vb) * 16 + pos] = t * TOPK + rank;
                p.topw[(size_t)t * TOPK + rank] = score / (wsum + 1e-20f) * 2.5f;
            }
        }
        __syncthreads();
        if (tid < 64) p.cnt2[tid * 1024 + vb] = lcnt[tid];
        pf_done(pfv);
        __syncthreads();
    }
}

__device__ __forceinline__ void st_compact(const P& p, int e, LAS int* wt  ) {
    const int tid = opaque(threadIdx.x), wave = tid >> 6, lane = tid & 63;
    const int c0 = p.cnt2[e * 1024 + 2 * tid], c1 = p.cnt2[e * 1024 + 2 * tid + 1], s = c0 + c1;
    int incl = s;
#pragma unroll
    for (int o = 1; o < 64; o <<= 1) { const int v = __builtin_amdgcn_ds_bpermute(((lane - o) & 63) << 2, incl); if (lane >= o) incl += v; }
    if (lane == 63) wt[wave] = incl;
    __syncthreads();
    int base = 0;
    for (int w = 0; w < wave; ++w) base += wt[w];
    const int excl = base + incl - s;
    int* dst = p.list + (size_t)e * T + excl;
    const int* s0 = p.seg + ((size_t)e * 1024 + 2 * tid) * 16;
    for (int j = 0; j < c0; ++j) dst[j] = s0[j];
    for (int j = 0; j < c1; ++j) dst[c0 + j] = s0[16 + j];
    if (tid == NTHREADS - 1) p.cnt[e] = base + incl;
    __syncthreads();
}

__device__ __forceinline__ void st_combine(const P& p, int l, int t, int lane) {
    const int b = t / SEQ;
    const float* gt = p.mod + ((size_t)l * 8 + b) * 6144 + 5120;
    const unsigned char* sl = p.slab + (size_t)t * TOPK * D;
    float* xr = p.xb + (size_t)t * D;
    float xv[16]; float ss = 0.f;
#pragma unroll
    for (int i = 0; i < 2; ++i) {
        const int cidx = i * 512 + lane * 8;
        float f[8];
#pragma unroll
        for (int j = 0; j < 8; ++j) f[j] = 0.f;
#pragma unroll
        for (int s = 0; s < TOPK + 1; ++s) {
            const u32x2 q = *(const u32x2*)(s < TOPK ? sl + (size_t)s * D + cidx : p.slab + ((size_t)T * TOPK + t) * D + cidx);
            const f32x2 a = __builtin_amdgcn_cvt_pk_f32_fp8((int)q.x, false), b = __builtin_amdgcn_cvt_pk_f32_fp8((int)q.x, true), c = __builtin_amdgcn_cvt_pk_f32_fp8((int)q.y, false), d = __builtin_amdgcn_cvt_pk_f32_fp8((int)q.y, true);
            f[0] += a[0]; f[1] += a[1]; f[2] += b[0]; f[3] += b[1]; f[4] += c[0]; f[5] += c[1]; f[6] += d[0]; f[7] += d[1];
        }
#pragma unroll
        for (int j = 0; j < 8; ++j) f[j] *= (1.f / SLAB_SC);
        const f32x4 x0 = *(const f32x4*)(xr + cidx), x1 = *(const f32x4*)(xr + cidx + 4);
        const f32x4 g0 = *(const f32x4*)(gt + cidx), g1 = *(const f32x4*)(gt + cidx + 4);
#pragma unroll
        for (int j = 0; j < 4; ++j) { xv[i * 8 + j] = x0[j] + g0[j] * f[j]; xv[i * 8 + 4 + j] = x1[j] + g1[j] * f[4 + j]; }
#pragma unroll
        for (int j = 0; j < 8; ++j) ss += xv[i * 8 + j] * xv[i * 8 + j];
    }
    ss = wave_sum(ss);
    const float rs = rsqrtf(ss * (1.f / D) + 1e-6f);
    if (l + 1 < NL) {
        const float* md = p.mod + ((size_t)(l + 1) * 8 + b) * 6144;
#pragma unroll
        for (int i = 0; i < 2; ++i) {
            const int cidx = i * 512 + lane * 8;
            *(f32x4*)(xr + cidx) = (f32x4){xv[i * 8], xv[i * 8 + 1], xv[i * 8 + 2], xv[i * 8 + 3]};
            *(f32x4*)(xr + cidx + 4) = (f32x4){xv[i * 8 + 4], xv[i * 8 + 5], xv[i * 8 + 6], xv[i * 8 + 7]};
            float o[8];
#pragma unroll
            for (int j = 0; j < 8; ++j) o[j] = xv[i * 8 + j] * rs * (1.f + md[1024 + cidx + j]) + md[cidx + j];
            u32x4 w; w.x = pk2(o[0], o[1]); w.y = pk2(o[2], o[3]); w.z = pk2(o[4], o[5]); w.w = pk2(o[6], o[7]);
            *(u32x4*)(p.h + (size_t)t * D + cidx) = w;
        }
    } else {
#pragma unroll
        for (int i = 0; i < 2; ++i) {
            const int cidx = i * 512 + lane * 8;
            const f32x4 g0 = *(const f32x4*)(p.g_final + cidx), g1 = *(const f32x4*)(p.g_final + cidx + 4);
            *(f32x4*)(p.out + (size_t)t * D + cidx) = (f32x4){xv[i * 8] * rs * g0[0], xv[i * 8 + 1] * rs * g0[1], xv[i * 8 + 2] * rs * g0[2], xv[i * 8 + 3] * rs * g0[3]};
            *(f32x4*)(p.out + (size_t)t * D + cidx + 4) = (f32x4){xv[i * 8 + 4] * rs * g1[0], xv[i * 8 + 5] * rs * g1[1], xv[i * 8 + 6] * rs * g1[2], xv[i * 8 + 7] * rs * g1[3]};
        }
    }
}

#define XB_TMO      128
#define XB_XCNT(j)  (256  + 64 * (j))
#define XB_XSUB(j)  (1280 + 64 * (j))
#define XB_XGEN(j)  (2304 + 64 * (j))
#define XB_TOP      3328
#define XB_TOPGEN   3392
#define XCD_BAR_WORDS 3456
#define XB_SPIN_CAP (1u << 22)
__device__ __forceinline__ unsigned xb_ld(unsigned* p)              { return __hip_atomic_load(p, __ATOMIC_RELAXED, __HIP_MEMORY_SCOPE_AGENT); }
__device__ __forceinline__ unsigned xb_add(unsigned* p, unsigned v) { return __hip_atomic_fetch_add(p, v, __ATOMIC_RELAXED, __HIP_MEMORY_SCOPE_AGENT); }
__device__ __forceinline__ unsigned xb_xcc_id() { return (unsigned)__builtin_amdgcn_s_getreg((3 << 11) | 20) & 0xFu; }
#define XB_SPIN(cond, bar) do { unsigned _sp = 0; while (cond) { __builtin_amdgcn_s_sleep(1); \
    if ((++_sp & 255u) == 0u) { if (xb_ld(&(bar)[XB_TMO])) break; if (_sp > XB_SPIN_CAP) { atomicAdd(&(bar)[XB_TMO], 1u); break; } } } } while (0)
struct XcdBarrier { unsigned* bar; unsigned x; volatile LAS unsigned* st; };
__device__ __forceinline__ XcdBarrier xcd_barrier_post(unsigned* bar, volatile LAS unsigned* st) {
    XcdBarrier b; b.bar = bar; b.x = xb_xcc_id(); b.st = st;
    if (threadIdx.x == 0) (void)xb_add(&bar[XB_XCNT(b.x)], 1u);
    return b;
}
__device__ __forceinline__ void xcd_barrier_complete(unsigned* bar, unsigned x, unsigned& nloc, unsigned& nx) {
    const unsigned G = gridDim.x * gridDim.y * gridDim.z;
    unsigned sum, cnt, mine, sp = 0u;
    for (;;) {
        sum = 0u; cnt = 0u; mine = 0u;
#pragma unroll
        for (unsigned j = 0; j < 16; ++j) { const unsigned c = xb_ld(&bar[XB_XCNT(j)]); sum += c; cnt += (c > 0u) ? 1u : 0u; mine = (j == x) ? c : mine; }
        if (sum == G) break;
        __builtin_amdgcn_s_sleep(1);
        if ((++sp & 255u) == 0u) { if (xb_ld(&bar[XB_TMO])) break; if (sp > XB_SPIN_CAP) { atomicAdd(&bar[XB_TMO], 1u); break; } }
    }
    nloc = mine > 0u ? mine : 1u; nx = cnt > 0u ? cnt : 1u;
}
__device__ __forceinline__ void xcd_barrier(const XcdBarrier& b0) {
    XcdBarrier b = b0; { unsigned xx = b0.x; asm volatile("" : "+s"(xx)); b.x = xx; }
    asm volatile("s_waitcnt vmcnt(0)" ::: "memory");
    __syncthreads();
    if (threadIdx.x == 0) {
        unsigned* bar = b.bar;
        __builtin_amdgcn_s_waitcnt(0);
        unsigned nloc = b.st[0], nx = b.st[1];
        if (nloc == 0u) { xcd_barrier_complete(bar, b.x, nloc, nx); b.st[0] = nloc; b.st[1] = nx; }
        const unsigned old = xb_add(&bar[XB_XSUB(b.x)], 1u);
        const unsigned gen = old / nloc;
        if (old + 1u == (gen + 1u) * nloc) {
            __builtin_amdgcn_fence(__ATOMIC_RELEASE, "agent");
            asm volatile("s_waitcnt vmcnt(0)" ::: "memory");
            const unsigned og = xb_add(&bar[XB_TOP], 1u);
            const unsigned tg = og / nx;
            if (og + 1u == (tg + 1u) * nx) xb_add(&bar[XB_TOPGEN], 1u);
            else XB_SPIN(xb_ld(&bar[XB_TOPGEN]) == tg, bar);
            __builtin_amdgcn_fence(__ATOMIC_ACQUIRE, "agent");
            xb_add(&bar[XB_XGEN(b.x)], 1u);
            asm volatile("s_waitcnt vmcnt(0)" ::: "memory");
        } else {
            XB_SPIN(xb_ld(&bar[XB_XGEN(b.x)]) == gen, bar);
            __builtin_amdgcn_fence(__ATOMIC_ACQUIRE, "agent");
            asm volatile("s_waitcnt vmcnt(0)" ::: "memory");
        }
    }
    __syncthreads();
}

__device__ __forceinline__ P load_args() {
    P q{};
#if defined(__HIP_DEVICE_COMPILE__)
    const __attribute__((address_space(4))) unsigned long long* k = (const __attribute__((address_space(4))) unsigned long long*)__builtin_amdgcn_kernarg_segment_ptr();
    asm volatile("" : "+s"(k));
    unsigned long long w[sizeof(P) / 8];
#pragma unroll
    for (unsigned i = 0; i < sizeof(P) / 8; ++i) w[i] = k[i];
    __builtin_memcpy(&q, w, sizeof(P));
#endif
    return q;
}
enum Ph { PH_NORM1 = 0, PH_INPROJ, PH_PREP, PH_MIX, PH_RWOUT, PH_OUTPROJ, PH_ROUTER, PH_COMPACT, PH_EXP1, PH_EXP2, PH_COMBINE, PH_PER_LAYER };

__global__ void __launch_bounds__(NTHREADS, 2) k_fused(P p_arg) {
    (void)p_arg;
#define KARGS() load_args()
    extern __shared__ __attribute__((aligned(16))) unsigned char lds_raw[];
    LAS unsigned char* lds = (LAS unsigned char*)lds_raw;
    LAS int* tstart = (LAS int*)(lds + LDS_STAGE);
    LAS int* cnts = (LAS int*)(lds + LDS_STAGE + 272);
    volatile LAS unsigned* bst = (volatile LAS unsigned*)(lds + LDS_STAGE + 1008);
    if (threadIdx.x < 4) bst[threadIdx.x] = 0u;
    __syncthreads();
    XcdBarrier xb = xcd_barrier_post(load_args().bar, bst);
#define PHASE_COORDS() int G = gridDim.x, bx = blockIdx.x; asm volatile("" : "+s"(G), "+s"(bx)); const int vcu = (G % 8 == 0) ? (bx % 8) * (G / 8) + bx / 8 : bx; (void)vcu; \
    const int tid = opaque(threadIdx.x), half = tid >> 8, lane = tid & 63, wave = __builtin_amdgcn_readfirstlane(tid >> 6); \
    float* smem = (float*)lds_raw + half * 8192; LAS float* scr = (LAS float*)(lds + wave * 16384); (void)lane; (void)smem; (void)scr; (void)tid

    for (int rep = 0; rep < (REP_PH == -1 ? REP_N : 1); ++rep) {
        const P p = KARGS();
        PHASE_COORDS();
        for (int it = bx; it < NL * 96; it += G) st_mod(p, it, (LAS float*)lds);
        __syncthreads();
        for (int it = (bx * 8 + wave); it < CV_DENSE; it += G * 8) cvt_dense_item(p, it, scr, lane);
        for (int idx = bx * NTHREADS + tid; idx < NL * RWW * 160; idx += G * NTHREADS) {
            const int k = idx % 160, c = (idx / 160) % RWW, ly = idx / (160 * RWW);
            float v;
            if (k < 32) v = p.rw_w2[((size_t)ly * 32 + k) * RWW + c];
            else if (k < 64) v = p.rw_a2[((size_t)ly * 32 + (k - 32)) * RWW + c];
            else if (k < 128) v = p.rw_g2[((size_t)ly * 64 + (k - 64)) * RWW + c];
            else v = (ly == 1) ? p.rw_v2[(size_t)(k - 128) * RWW + c] : 0.f;
            p.lwt[idx] = (bf16_t)f2bf(v);
        }
        xcd_barrier(xb);
    }

    constexpr int NPH2 = NL * PH_PER_LAYER + ((REP_PH >= 0) ? REP_N - 1 : 0);
    for (int ph2 = 0; ph2 < NPH2; ++ph2) {
      {
        const int ph = (REP_PH < 0 || ph2 <= REP_PH) ? ph2 : (ph2 < REP_PH + REP_N ? REP_PH : ph2 - (REP_N - 1));
        const int rep = (REP_PH >= 0 && ph2 > REP_PH && ph2 < REP_PH + REP_N) ? 1 : 0; (void)rep;
        const int l = ph / PH_PER_LAYER, st = ph % PH_PER_LAYER;
        const P p = KARGS();
        PHASE_COORDS();
        if (st == PH_NORM1) {
            if (l == 0) {
                for (int t = bx * 8 + wave; t < T; t += G * 8) {
                    const int tn = t + G * 8; unsigned pfv = 0u;
                    if (tn < T) pfv = pf_lines(p.x + (size_t)tn * D, D * 4, lane);
                    norm_row<false>(p.x + (size_t)t * D, p.mod + (size_t)(t / SEQ) * 6144, p.h + (size_t)t * D, (LAS float*)lds, lane);
                    pf_done(pfv);
                }
            }
        } else if (st == PH_INPROJ) {
            pg8::DenseOrder S; S.init(p.h, p.wt_in + (size_t)l * PJB * D, T, PJB, D, G, bx);
            pg8::EpiProj E{p.proj, p.vt};
            pg8::gemm_phase<pg8::EpiProj, pg8::DenseOrder, true, true>(lds, D, S, E);
        } else if (st == PH_PREP) {
            st_prep(p, l, bx, G, lds);
        } else if (st == PH_MIX) {
            constexpr int N1 = NBATCH * 6, N2 = NBATCH * 6 * (SEQ / 32) / 8, N3 = T / 32, N4 = (CV_EXP + 7) / 8;
            const int sel = (rep == 0) ? 15 : REP_SEL;
            if (sel & 1) for (int wb = bx; wb < N1; wb += G) st_cscan(p, wb, lds);
            __syncthreads();
            {
                unsigned* ctrA = p.bar + 3500 + ph2; unsigned* ctrB = p.bar + 3600 + l;
                volatile LAS int* gslot = (volatile LAS int*)(lds + LDS_STAGE + 640);
                for (;;) {
                    __syncthreads();
                    if (tid == 0) *gslot = (int)__hip_atomic_fetch_add(ctrA, 2u, __ATOMIC_RELAXED, __HIP_MEMORY_SCOPE_AGENT);
                    __syncthreads();
                    const int base = *gslot;
                    if (base >= N2 + N3) break;
                    for (int wb = base; wb < base + 2 && wb < N2 + N3; ++wb) {
                        if (wb < N2) { if (sel & 2) st_attn(p, l, wb * 8 + wave); }
                        else if (sel & 4) st_pool(p, l, wb - N2, (LAS float*)lds);
                    }
                }
                for (;;) {
                    __syncthreads();
                    if (tid == 0) *gslot = (int)__hip_atomic_fetch_add(ctrB, 64u, __ATOMIC_RELAXED, __HIP_MEMORY_SCOPE_AGENT);
                    __syncthreads();
                    const int base = *gslot;
                    if (base >= CV_EXP) break;
                    if (sel & 8) cvt_exp_stream(p, l, base + wave, 8, min(base + 64, CV_EXP), scr, lane);
                }
            }
        } else if (st == PH_RWOUT) {
            for (int t = bx * 8 + wave; t < T; t += G * 8) {
                const int tn = t + G * 8; unsigned pfv = 0u;
                if (tn < T) pfv = pf_lines(p.y + (size_t)tn * RWW, RWW * 4, lane) + pf_lines(p.rec + (size_t)tn * REC_TB, REC_TB, lane) + pf_lines(p.g + (size_t)tn * RWW, RWW * 2, lane);
                st_rwout(p, l, t, lane);
                pf_done(pfv);
            }
        } else if (st == PH_OUTPROJ) {
            pg8::DenseOrder S; S.init(p.h, p.wt_out + (size_t)l * D * D, T, D, D, G, bx);
            pg8::EpiOut E{l == 0 ? p.x : p.xb, p.xb, p.mod + (size_t)l * 8 * 6144 + 2048};
            pg8::gemm_phase<pg8::EpiOut, pg8::DenseOrder, true, true>(lds, D, S, E);
        } else if (st == PH_ROUTER) {
            st_normrouter(p, l, bx, G, (LAS float*)lds);
        } else if (st == PH_COMPACT) {
            if (bx < NE) st_compact(p, bx, (LAS int*)lds);
        } else if (st == PH_EXP1 || st == PH_EXP2) {
            __syncthreads();
            if (tid == 0) {
                int acc = 0;
                for (int e = 0; e < 65; ++e) { const int c = e < NE ? p.cnt[e] : T; cnts[e] = c; tstart[e] = acc; acc += (c + 255) >> 8; }
                tstart[65] = acc;
            }
            __syncthreads();
            if (st == PH_EXP1) {
                pg8::MoeOrder<true> S{tstart, cnts, p.list, p.h, p.wt1, D, 512, 1, G, vcu};
                pg8::EpiExp1 E{p.hm};
                pg8::gemm_phase<pg8::EpiExp1, pg8::MoeOrder<true>, true, true>(lds, D, S, E);
            } else {
                pg8::MoeOrder<false> S{tstart, cnts, p.list, p.hm, p.wt2, ED, D, 2, G, vcu};
                pg8::EpiExp2 E{p.slab, p.list, p.topw, cnts};
                pg8::gemm_phase<pg8::EpiExp2, pg8::MoeOrder<false>, true, true>(lds, ED, S, E);
            }
        } else {
            for (int t = bx * 8 + wave; t < T; t += G * 8) {
                const int tn = t + G * 8; unsigned pfv = 0u;
                if (tn < T) pfv = pf_lines(p.slab + (size_t)tn * TOPK * D, TOPK * D, lane) + pf_lines(p.xb + (size_t)tn * D, D * 4, lane) + pf_lines(p.slab + ((size_t)T * TOPK + tn) * D, D, lane);
                st_combine(p, l, t, lane);
                pf_done(pfv);
            }
        }
        if (!(ph2 == NPH2 - 1)) { if (!(st == PH_NORM1 && l > 0)) xcd_barrier(xb); }
      }
    }
#undef PHASE_COORDS
#undef KARGS
}

}

extern "C" void kernel_launch(void* const* d_in, const int* in_sizes, int n_in, void* d_out, int out_size, void* d_ws, size_t ws_size,
                              hipStream_t stream) {
    P p{};
    const float** fp = (const float**)&p;
    for (int i = 0; i < 33; ++i) fp[i] = (const float*)d_in[i];
    p.out = (float*)d_out;
    char* ws = (char*)d_ws;
    size_t off = 0;
    auto take = [&](size_t bytes) { char* r = ws + off; off += (bytes + 255) & ~(size_t)255; return r; };
    p.bar = (unsigned*)take(16384);
    p.cnt = (int*)take(256);
    p.mod = (float*)take((size_t)NL * 8 * 6144 * 4);
    p.list = (int*)take((size_t)NE * T * 4);
    p.cnt2 = (int*)take((size_t)NE * 1024 * 4);
    p.seg = (int*)take((size_t)NE * 1024 * 16 * 4);
    p.topw = (float*)take((size_t)T * TOPK * 4);
    p.wt_in = (bf16_t*)take((size_t)NL * PJB * D * 2);
    p.wt_out = (bf16_t*)take((size_t)NL * D * D * 2);
    p.lwt = (bf16_t*)take((size_t)NL * RWW * 160 * 2);
    p.wt1 = (bf16_t*)take((size_t)65 * 512 * D * 2);
    p.wt2 = (bf16_t*)take((size_t)65 * D * ED * 2);
    p.xb = (float*)take((size_t)T * D * 4);
    p.h = (bf16_t*)take((size_t)T * D * 2);
    p.vfirst = (bf16_t*)take((size_t)T * RWW * 2);
    const size_t ov = off;
    p.proj = (bf16_t*)take((size_t)T * PJB * 2);
    p.vt = (bf16_t*)take((size_t)T * SBW * 2);
    p.rec = (unsigned char*)take((size_t)T * REC_TB);
    p.g = (bf16_t*)take((size_t)T * RWW * 2);
    p.y = (float*)take((size_t)T * RWW * 4);
    p.cb = (unsigned char*)take((size_t)NBATCH * 6 * (SEQ / 32) * CB_BYTES);
    p.hm = (bf16_t*)(ws + ov);
    p.slab = (unsigned char*)(ws + ov + (size_t)MAXRT * 256 * ED * 2);
    const size_t end_moe = ov + (size_t)MAXRT * 256 * ED * 2 + (size_t)T * (TOPK + 1) * D;
    if (end_moe > off) off = end_moe;
    if (off > ws_size) { fprintf(stderr, "kernel_launch: workspace too small: need %zu, have %zu\n", off, ws_size); return; }

    static int cus = 0;
    if (cus == 0) {
        int dev = 0, n = 0;
        if (hipGetDevice(&dev) != hipSuccess || hipDeviceGetAttribute(&n, hipDeviceAttributeMultiprocessorCount, dev) != hipSuccess || n <= 0) n = 256;
        (void)hipFuncSetAttribute((const void*)k_fused, hipFuncAttributeMaxDynamicSharedMemorySize, LDS_BYTES);
        cus = n;
    }
    (void)hipMemsetAsync(p.bar, 0, 16384 + 256, stream);
    void* args[] = {(void*)&p};
    (void)hipLaunchCooperativeKernel((const void*)k_fused, dim3(cus), dim3(NTHREADS), args, LDS_BYTES, stream);
}
```

```cpp
#include <hip/hip_runtime.h>
#include <stdint.h>
#include <stdio.h>

#define REP_PH -2
#define REP_N 1
#define REP_SEL 15

namespace {

typedef unsigned short bf16_t;
typedef short bf16x8 __attribute__((ext_vector_type(8)));
typedef float f32x4 __attribute__((ext_vector_type(4)));
typedef float f32x2 __attribute__((ext_vector_type(2)));
typedef unsigned u32x4 __attribute__((ext_vector_type(4)));
typedef unsigned u32x2 __attribute__((ext_vector_type(2)));
#define LAS __attribute__((address_space(3)))

constexpr int D = 1024, NBATCH = 8, SEQ = 2048, T = NBATCH * SEQ, NL = 2;
constexpr int RWW = 384, SBW = 384, PLW = 256;
constexpr int RWC = 1280, SBC = 1152, INC = 2688;
constexpr int PJB = 2816;
constexpr int NE = 64, TOPK = 6, ED = 256;
constexpr int MAXRT = 512;
constexpr int NTHREADS = 512;
constexpr float SLAB_SC = 16.f;
constexpr int LDS_STAGE = 141312, LDS_CTL = 4096, LDS_BYTES = LDS_STAGE + LDS_CTL;

struct P {
    const float *x, *c, *w_ada, *b_ada, *w_in, *w_vres, *mu_rw, *mu_vres, *rw_w0, *rw_w2, *rw_a0, *rw_a2,
        *rw_v0, *rw_v2, *rw_g2, *rw_k_k, *rw_k_a, *rw_r_k, *rw_ln_g, *rw_ln_b, *sb_norm_g, *pool_w, *pool_scale,
        *w_out, *w_router, *b_router, *w_eg, *w_eu, *w_ed, *w_sg, *w_su, *w_sd, *g_final;
    float* out;
    unsigned* bar;
    float* mod;
    int* cnt;
    int2* list;
    int* cnt2;
    int* seg;
    float* topw;
    bf16_t* wt_in;
    bf16_t* wt_out;
    bf16_t* lwt;
    bf16_t* wt1;
    bf16_t* wt2;
    float* xb;
    bf16_t* h;
    bf16_t* vfirst;
    bf16_t* proj;
    bf16_t* vt;
    unsigned char* rec;
    unsigned char* cb;
    bf16_t* g;
    float* y;
    bf16_t* hm;
    unsigned char* slab;
};

__device__ __forceinline__ int opaque(int x) { asm volatile("" : "+v"(x)); return x; }
__device__ __forceinline__ float dpp_add16(float x) {
    x += __builtin_bit_cast(float, __builtin_amdgcn_update_dpp(0, __builtin_bit_cast(int, x), 0xB1, 0xF, 0xF, true));
    x += __builtin_bit_cast(float, __builtin_amdgcn_update_dpp(0, __builtin_bit_cast(int, x), 0x4E, 0xF, 0xF, true));
    x += __builtin_bit_cast(float, __builtin_amdgcn_update_dpp(0, __builtin_bit_cast(int, x), 0x141, 0xF, 0xF, true));
    x += __builtin_bit_cast(float, __builtin_amdgcn_update_dpp(0, __builtin_bit_cast(int, x), 0x140, 0xF, 0xF, true));
    return x;
}
__device__ __forceinline__ float wave_sum(float v) {
    v = dpp_add16(v);
    const int vi = __builtin_bit_cast(int, v);
    return (__builtin_bit_cast(float, __builtin_amdgcn_readlane(vi, 0)) + __builtin_bit_cast(float, __builtin_amdgcn_readlane(vi, 16)))
         + (__builtin_bit_cast(float, __builtin_amdgcn_readlane(vi, 32)) + __builtin_bit_cast(float, __builtin_amdgcn_readlane(vi, 48)));
}
__device__ __forceinline__ unsigned pf_lines(const void* p, int nbytes, int lane) {
    unsigned acc = 0u;
    for (int off = lane * 128; off < nbytes; off += 8192) acc += *(const unsigned*)((const char*)p + off);
    return acc;
}
__device__ __forceinline__ void pf_done(unsigned v) { asm volatile("" :: "v"(v)); }
__device__ __forceinline__ float sigmoidf_(float x) { return 1.f / (1.f + __expf(-x)); }
__device__ __forceinline__ float softplusf_(float x) { return fmaxf(x, 0.f) + __logf(1.f + __expf(-fabsf(x))); }
__device__ __forceinline__ float siluf_(float x) { return x / (1.f + __expf(-x)); }
__device__ __forceinline__ unsigned f2bf_sw(float f) { unsigned u = __builtin_bit_cast(unsigned, f); return (u + 0x7fffu + ((u >> 16) & 1u)) >> 16; }
__device__ __forceinline__ unsigned pk2_sw(float lo, float hi) { return f2bf_sw(lo) | (f2bf_sw(hi) << 16); }
typedef __bf16 bf16x2_t __attribute__((ext_vector_type(2)));
__device__ __forceinline__ unsigned cvtpk(float lo, float hi) { const f32x2 v = {lo, hi}; const bf16x2_t b = __builtin_convertvector(v, bf16x2_t); return __builtin_bit_cast(unsigned, b); }
__device__ __forceinline__ bf16x8 mk8(unsigned a, unsigned b, unsigned c, unsigned d) { return __builtin_bit_cast(bf16x8, (u32x4){a, b, c, d}); }
__device__ __forceinline__ unsigned pk2(float lo, float hi) { return cvtpk(lo, hi); }
__device__ __forceinline__ unsigned f2bf(float f) { return cvtpk(f, 0.f) & 0xffffu; }
__device__ __forceinline__ float bf2f(bf16_t h) { return __builtin_bit_cast(float, (unsigned)h << 16); }
__device__ __forceinline__ float bflo(unsigned u) { return __builtin_bit_cast(float, u << 16); }
__device__ __forceinline__ float bfhi(unsigned u) { return __builtin_bit_cast(float, u & 0xffff0000u); }

namespace pg8 {
constexpr int BM = 256, BK = 64, HALF = 128, HTB = HALF * BK * 2, STAGE_BYTES = 8 * HTB;
__device__ __forceinline__ int lds_byte(int r, int c) { const int st = (r >> 4) * 2 + (c >> 5), rr = r & 15, cc = c & 31, ob = rr * 64 + cc * 2; return st * 1024 + (ob ^ (((ob >> 9) & 1) << 5)); }
__device__ __forceinline__ void stage_rc(int b, int& R, int& C) { const int st = b / 1024, sb = b % 1024, swz = sb ^ (((sb >> 9) & 1) << 5); R = (st >> 1) * 16 + swz / 64; C = (st & 1) * 32 + (swz % 64) / 2; }
__device__ __forceinline__ int perm32(int rho) { const int n = rho >> 4, i = rho & 15; return 8 * (i >> 2) + 4 * n + (i & 3); }

struct Unit { int pm, pn, e, mt; };

template <class Epi, class Sched, bool ALIGN_EPI, bool SP2>
__device__ __forceinline__ void gemm_phase(LAS unsigned char* lds, const int K, const Sched& S, const Epi& E) {
    const int tid = opaque(threadIdx.x), wid = __builtin_amdgcn_readfirstlane(tid >> 6), lane = tid & 63, wr = wid >> 2, wc = wid & 3, fr = lane & 15, fq = lane >> 4;
    const int nt = K / BK;
    unsigned voffA[2], voffB[2];
#pragma unroll
    for (int i = 0; i < 2; ++i) { int R, C; stage_rc(tid * 16 + i * 8192, R, C); const int Rb = Epi::PERM ? ((R & ~31) + perm32(R & 31)) : R;
        voffA[i] = Sched::GATHER ? (unsigned)(C * 2) : (unsigned)(R * K + C) * 2u; voffB[i] = (unsigned)(Rb * K + C) * 2u; }
    const size_t kstep = (size_t)(BK * 2);
    const size_t hstep = (size_t)HALF * K * 2;
    const unsigned ldsw = (unsigned)wid * 1024u;
    const int aoff = lds_byte(wr * 64 + fr, fq * 8), boff = lds_byte(wc * 32 + fr, fq * 8);
#define PG8_SA(b, h) (((b) * 2 + (h)) * HTB)
#define PG8_SB(b, h) ((4 + (b) * 2 + (h)) * HTB)
#define PG8_STAGE(bufoff, gbase, voff) do { _Pragma("unroll") for (int _i = 0; _i < 2; ++_i) \
        __builtin_amdgcn_global_load_lds((const unsigned*)((const char*)(gbase) + (voff)[_i]), (LAS unsigned*)(lds + (bufoff) + ldsw + _i * 8192), 16, 0, 0); } while (0)
#define PG8_LDA(dst, b, h) do { _Pragma("unroll") for (int m = 0; m < 4; ++m) _Pragma("unroll") for (int k = 0; k < 2; ++k) dst[m][k] = *(const LAS bf16x8*)(lds + PG8_SA(b, h) + aoff + m * 2048 + k * 1024); } while (0)
#define PG8_LDB(dst, b, h) do { _Pragma("unroll") for (int n = 0; n < 2; ++n) _Pragma("unroll") for (int k = 0; k < 2; ++k) dst[n][k] = *(const LAS bf16x8*)(lds + PG8_SB(b, h) + boff + n * 2048 + k * 1024); } while (0)
#define PG8_MMA(ai, bj, At, Bt) do { __builtin_amdgcn_s_setprio(1); _Pragma("unroll") for (int m = 0; m < 4; ++m) _Pragma("unroll") for (int n = 0; n < 2; ++n) _Pragma("unroll") for (int k = 0; k < 2; ++k) \
        acc[ai][bj][m][n] = __builtin_amdgcn_mfma_f32_16x16x32_bf16(Bt[n][k], At[m][k], acc[ai][bj][m][n], 0, 0, 0); __builtin_amdgcn_s_setprio(0); } while (0)
#define PG8_WAIT_V(n) asm volatile("s_waitcnt vmcnt(" #n ")" ::: "memory")
#define PG8_WAIT_L(n) asm volatile("s_waitcnt lgkmcnt(" #n ")" ::: "memory")
#define PG8_BAR __builtin_amdgcn_s_barrier()
#define PG8_SCHED __builtin_amdgcn_sched_barrier(0)
    Unit cur, nxt; int ui = 0;
    if (!S.next(0, cur)) return;
    f32x4 acc[2][2][4][2];
#pragma unroll
    for (int a = 0; a < 2; ++a)
#pragma unroll
        for (int b = 0; b < 2; ++b)
#pragma unroll
            for (int m = 0; m < 4; ++m)
#pragma unroll
                for (int n = 0; n < 2; ++n) acc[a][b][m][n] = (f32x4){0.f, 0.f, 0.f, 0.f};
    bf16x8 At[4][2], B0[2][2], B1[2][2];
    const char* cA = S.a_base(cur); const char* cB = S.b_base(cur);
    unsigned pk[2] = {0u, 0u}, npk[2] = {0u, 0u};
    if constexpr (Sched::GATHER) S.a_tok(cur, tid, pk);
    const unsigned k2 = (unsigned)K * 2u;
#define PG8_STAGE_A(bufoff, gbase, hh, PK) do { if constexpr (Sched::GATHER) { unsigned _v[2]; _v[0] = (((PK)[0] >> (16 * (hh))) & 0xffffu) * k2 + voffA[0]; _v[1] = (((PK)[1] >> (16 * (hh))) & 0xffffu) * k2 + voffA[1]; \
        PG8_STAGE(bufoff, gbase, _v); } else { PG8_STAGE(bufoff, (gbase) + (hh) * hstep, voffA); } } while (0)
    static_assert(SP2, "only the SP2 loop is kept");
    PG8_STAGE(PG8_SB(0, 0), cB, voffB); PG8_STAGE(PG8_SB(0, 1), cB + hstep, voffB); PG8_STAGE_A(PG8_SA(0, 0), cA, 0, pk); PG8_STAGE_A(PG8_SA(0, 1), cA, 1, pk);
    if (wr == 1) PG8_BAR;
    PG8_WAIT_V(2); PG8_BAR;
    PG8_STAGE(PG8_SB(1, 0), cB + kstep, voffB); PG8_STAGE_A(PG8_SA(1, 0), cA + kstep, 0, pk); PG8_STAGE(PG8_SB(1, 1), cB + hstep + kstep, voffB);
    PG8_WAIT_V(6); PG8_BAR;
    for (;;) {
        const bool has_next = S.next(ui + 1, nxt);
        const char* nA = has_next ? S.a_base(nxt) : cA; const char* nB = has_next ? S.b_base(nxt) : cB;
        if constexpr (Sched::GATHER) { if (has_next) S.a_tok(nxt, tid, npk); else { npk[0] = pk[0]; npk[1] = pk[1]; } }
#pragma unroll 1
        for (int t = 0; t < nt; t += 2) {
            const bool last = (t == nt - 2);
            const char* a1 = cA + (size_t)(t + 1) * kstep;
            const char* a2 = last ? nA : cA + (size_t)(t + 2) * kstep; const char* b2 = last ? nB : cB + (size_t)(t + 2) * kstep;
            const char* a3 = a2 + kstep; const char* b3 = b2 + kstep;
            unsigned sp[2]; sp[0] = last ? npk[0] : pk[0]; sp[1] = last ? npk[1] : pk[1];
            PG8_LDB(B0, 0, 0); PG8_LDB(B1, 0, 1); PG8_SCHED; PG8_LDA(At, 0, 0); PG8_STAGE_A(PG8_SA(1, 1), a1, 1, pk);
            PG8_WAIT_V(8); PG8_WAIT_L(0); PG8_BAR; PG8_MMA(0, 0, At, B0); PG8_MMA(0, 1, At, B1); PG8_BAR; PG8_SCHED;
            PG8_LDA(At, 0, 1); PG8_STAGE(PG8_SB(0, 0), b2, voffB); PG8_STAGE(PG8_SB(0, 1), b2 + hstep, voffB); PG8_STAGE_A(PG8_SA(0, 0), a2, 0, sp);
            PG8_WAIT_V(8); PG8_WAIT_L(0); PG8_BAR; PG8_MMA(1, 0, At, B0); PG8_MMA(1, 1, At, B1); PG8_BAR; PG8_SCHED;
            PG8_LDB(B0, 1, 0); PG8_LDB(B1, 1, 1); PG8_SCHED; PG8_LDA(At, 1, 0); PG8_STAGE_A(PG8_SA(0, 1), a2, 1, sp);
            PG8_WAIT_V(8); PG8_WAIT_L(0); PG8_BAR; PG8_MMA(0, 0, At, B0); PG8_MMA(0, 1, At, B1); PG8_BAR; PG8_SCHED;
            PG8_LDA(At, 1, 1); PG8_STAGE(PG8_SB(1, 0), b3, voffB); PG8_STAGE(PG8_SB(1, 1), b3 + hstep, voffB); PG8_STAGE_A(PG8_SA(1, 0), a3, 0, sp);
            PG8_WAIT_V(8); PG8_WAIT_L(0); PG8_BAR; PG8_MMA(1, 0, At, B0); PG8_MMA(1, 1, At, B1); PG8_BAR; PG8_SCHED;
        }
        if constexpr (ALIGN_EPI) { if (wr == 0) PG8_BAR; }
        { const int t2 = opaque(threadIdx.x), w2 = __builtin_amdgcn_readfirstlane(t2 >> 6), l2 = t2 & 63; E(acc, cur, w2 >> 2, w2 & 3, l2 & 15, l2 >> 4); }
        if (!has_next) break;
#pragma unroll
        for (int a = 0; a < 2; ++a)
#pragma unroll
            for (int b = 0; b < 2; ++b)
#pragma unroll
                for (int m = 0; m < 4; ++m)
#pragma unroll
                    for (int n = 0; n < 2; ++n) acc[a][b][m][n] = (f32x4){0.f, 0.f, 0.f, 0.f};
        cur = nxt; cA = nA; cB = nB; ++ui;
        pk[0] = npk[0]; pk[1] = npk[1];
        if constexpr (ALIGN_EPI) { if (wr == 1) PG8_BAR; }
    }
    PG8_WAIT_V(0);
    if constexpr (!ALIGN_EPI) { if (wr == 0) PG8_BAR; }
    PG8_BAR;
#undef PG8_SA
#undef PG8_SB
#undef PG8_STAGE
#undef PG8_STAGE_A
#undef PG8_LDA
#undef PG8_LDB
#undef PG8_MMA
#undef PG8_WAIT_V
#undef PG8_WAIT_L
#undef PG8_BAR
#undef PG8_SCHED
}

struct DenseOrder {
    const bf16_t* A; const bf16_t* Bt; int K; int nM, nN, nwg, G, c;
    __device__ __forceinline__ void init(const bf16_t* A_, const bf16_t* Bt_, int M, int N, int K_, int G_, int c_) { A = A_; Bt = Bt_; K = K_; nM = M / BM; nN = N / BM; nwg = nM * nN; G = G_; c = c_; }
    __device__ __forceinline__ bool next(int i, Unit& u) const {
        const long L = (long)i * G + c; if (L >= nwg) return false;
        int wgid = (int)L; { const int q = nwg / 8, r = nwg % 8, xcd = wgid % 8, off = wgid / 8; wgid = (xcd < r ? xcd * (q + 1) : r * (q + 1) + (xcd - r) * q) + off; }
        const int nig = 8 * nN, gid = wgid / nig, fm = gid * 8, gsz = (nM - fm) < 8 ? (nM - fm) : 8;
        u.pm = fm + ((wgid % nig) % gsz); u.pn = (wgid % nig) / gsz; u.e = 0; u.mt = 0; return true;
    }
    __device__ __forceinline__ const char* a_base(const Unit& u) const { return (const char*)A + (size_t)u.pm * BM * K * 2; }
    __device__ __forceinline__ const char* b_base(const Unit& u) const { return (const char*)Bt + (size_t)u.pn * BM * K * 2; }
    static constexpr bool GATHER = false;
    __device__ __forceinline__ void a_tok(const Unit&, int, unsigned (&)[2]) const {}
};

template <bool GATHER_>
struct MoeOrder {
    static constexpr bool GATHER = GATHER_;
    const LAS int* tstart;
    const LAS int* cnts;
    const LAS int* tmap;
    const int2* list;
    const bf16_t* A;
    const bf16_t* Bt;
    int K, N, lognpn, G, c;
    __device__ __forceinline__ bool next(int i, Unit& u) const {
        const int L = i * G + c; const int total = __builtin_amdgcn_readfirstlane(tstart[65]) << lognpn; if (L >= total) return false;
        const int rt = L >> lognpn; u.pn = L & ((1 << lognpn) - 1); u.pm = rt;
        const int e = __builtin_amdgcn_readfirstlane(tmap[rt]);
        u.e = e; u.mt = rt - __builtin_amdgcn_readfirstlane(tstart[e]); return true;
    }
    __device__ __forceinline__ const char* a_base(const Unit& u) const { return GATHER ? (const char*)A : (const char*)A + (size_t)u.pm * BM * K * 2; }
    __device__ __forceinline__ const char* b_base(const Unit& u) const { return (const char*)Bt + ((size_t)u.e * N + (size_t)u.pn * BM) * K * 2; }
    __device__ __forceinline__ void a_tok(const Unit& u, int tid, unsigned (&pkv)[2]) const {
        const int ce = cnts[u.e];
#pragma unroll
        for (int i = 0; i < 2; ++i) {
            int R, C; stage_rc(tid * 16 + i * 8192, R, C); (void)C;
            unsigned v = 0u;
#pragma unroll
            for (int hh = 0; hh < 2; ++hh) {
                const int idx = u.mt * BM + hh * HALF + R;
                int tok = 0;
                if (idx < ce) tok = (u.e < NE) ? (list[(size_t)u.e * T + idx].x / TOPK) : idx;
                v |= (unsigned)tok << (16 * hh);
            }
            pkv[i] = v;
        }
    }
};

struct EpiProj {
    static constexpr bool PERM = true;
    bf16_t* O; bf16_t* vt;
    __device__ __forceinline__ void operator()(const f32x4 (&acc)[2][2][4][2], const Unit& u, int wr, int wc, int fr, int fq) const {
        const int row0 = u.pm * BM + wr * 64 + fr, col0 = u.pn * BM + wc * 32 + 8 * fq;
#pragma unroll
        for (int bj = 0; bj < 2; ++bj) {
            const bool isv = (u.pn == 8) || (u.pn == 9 && bj == 0);
            if (!isv) {
#pragma unroll
                for (int ai = 0; ai < 2; ++ai)
#pragma unroll
                    for (int m = 0; m < 4; ++m) { bf16_t* rowp = O + (size_t)(row0 + ai * HALF + m * 16) * PJB + col0 + bj * HALF;
                        const f32x4 v0 = acc[ai][bj][m][0], v1 = acc[ai][bj][m][1];
                        u32x4 w; w.x = pk2(v0[0], v0[1]); w.y = pk2(v0[2], v0[3]); w.z = pk2(v1[0], v1[1]); w.w = pk2(v1[2], v1[3]);
                        *(u32x4*)rowp = w; }
            } else {
                const int vc0 = col0 + bj * HALF - 2048;
#pragma unroll
                for (int ai = 0; ai < 2; ++ai)
#pragma unroll
                    for (int m = 0; m < 4; ++m) { const int row = row0 + ai * HALF + m * 16; const int b = row / SEQ, s = row % SEQ;
                        bf16_t* base = vt + ((size_t)b * SBW + vc0) * SEQ + s;
#pragma unroll
                        for (int n = 0; n < 2; ++n)
#pragma unroll
                            for (int j = 0; j < 4; ++j) base[(size_t)(4 * n + j) * SEQ] = (bf16_t)f2bf(acc[ai][bj][m][n][j]); }
            }
        }
    }
};
struct EpiOut {
    static constexpr bool PERM = false;
    const float* xin; float* xo; const float* gt;
    __device__ __forceinline__ void operator()(const f32x4 (&acc)[2][2][4][2], const Unit& u, int wr, int wc, int fr, int fq) const {
        const int row0 = u.pm * BM + wr * 64 + fr, col0 = u.pn * BM + wc * 32 + 4 * fq;
#pragma unroll
        for (int ai = 0; ai < 2; ++ai)
#pragma unroll
            for (int m = 0; m < 4; ++m) { const int row = row0 + ai * HALF + m * 16; const float* gr = gt + (size_t)(row / SEQ) * 6144;
#pragma unroll
                for (int bj = 0; bj < 2; ++bj)
#pragma unroll
                    for (int n = 0; n < 2; ++n) { const int col = col0 + bj * HALF + 16 * n;
                        const f32x4 xi = *(const f32x4*)(xin + (size_t)row * D + col); const f32x4 gg = *(const f32x4*)(gr + col);
                        *(f32x4*)(xo + (size_t)row * D + col) = xi + gg * acc[ai][bj][m][n]; } }
    }
};
struct EpiExp1 {
    static constexpr bool PERM = true;
    bf16_t* hm;
    __device__ __forceinline__ void operator()(const f32x4 (&acc)[2][2][4][2], const Unit& u, int wr, int wc, int fr, int fq) const {
        const int row0 = u.pm * BM + wr * 64 + fr, col0 = u.pn * HALF + wc * 32 + 8 * fq;
#pragma unroll
        for (int ai = 0; ai < 2; ++ai)
#pragma unroll
            for (int m = 0; m < 4; ++m) { bf16_t* rowp = hm + (size_t)(row0 + ai * HALF + m * 16) * ED + col0;
                float o[8];
#pragma unroll
                for (int n = 0; n < 2; ++n)
#pragma unroll
                    for (int j = 0; j < 4; ++j) o[n * 4 + j] = siluf_(acc[ai][0][m][n][j]) * acc[ai][1][m][n][j];
                u32x4 w; w.x = pk2(o[0], o[1]); w.y = pk2(o[2], o[3]); w.z = pk2(o[4], o[5]); w.w = pk2(o[6], o[7]);
                *(u32x4*)rowp = w; }
    }
};
struct EpiExp2 {
    static constexpr bool PERM = true;
    unsigned char* slab; const int2* list; const LAS int* cnts;
    __device__ __forceinline__ static unsigned pack4(const f32x4& v, float sc) {
        const float a = fminf(fmaxf(v[0] * sc, -448.f), 448.f), b = fminf(fmaxf(v[1] * sc, -448.f), 448.f), c = fminf(fmaxf(v[2] * sc, -448.f), 448.f), d = fminf(fmaxf(v[3] * sc, -448.f), 448.f);
        int w = __builtin_amdgcn_cvt_pk_fp8_f32(a, b, 0, false);
        w = __builtin_amdgcn_cvt_pk_fp8_f32(c, d, w, true);
        return (unsigned)w;
    }
    __device__ __forceinline__ void operator()(const f32x4 (&acc)[2][2][4][2], const Unit& u, int wr, int wc, int fr, int fq) const {
        const int col0 = u.pn * BM + wc * 32 + 8 * fq; const int ce = cnts[u.e];
#pragma unroll
        for (int ai = 0; ai < 2; ++ai)
#pragma unroll
            for (int m = 0; m < 4; ++m) { const int idx = u.mt * BM + ai * HALF + wr * 64 + m * 16 + fr;
                if (idx < ce) {
                    int row; float sc;
                    if (u.e < NE) { const int2 ri = list[(size_t)u.e * T + idx]; row = ri.x; sc = __int_as_float(ri.y) * SLAB_SC; }
                    else { row = T * TOPK + idx; sc = SLAB_SC; }
                    unsigned char* rowp = slab + (size_t)row * D + col0;
#pragma unroll
                    for (int bj = 0; bj < 2; ++bj) *(u32x2*)(rowp + bj * HALF) = (u32x2){pack4(acc[ai][bj][m][0], sc), pack4(acc[ai][bj][m][1], sc)};
                } }
    }
};
}

__device__ __forceinline__ void st_mod(const P& p, int item, LAS float* L  ) {
    const int tid = opaque(threadIdx.x), wave = tid >> 6, lane = tid & 63;
    const int l = item / 96, j0 = (item % 96) * 64;
    for (int i = tid; i < 8 * 1024; i += NTHREADS) L[i] = siluf_(p.c[i]);
    __syncthreads();
    float acc[8];
#pragma unroll
    for (int b = 0; b < 8; ++b) acc[b] = 0.f;
    const float* w = p.w_ada + ((size_t)l * 1024 + wave * 128) * 6144 + j0 + lane;
#pragma unroll 8
    for (int i = 0; i < 128; ++i) {
        const float wv = w[(size_t)i * 6144];
#pragma unroll
        for (int b = 0; b < 8; ++b) acc[b] += L[b * 1024 + wave * 128 + i] * wv;
    }
    LAS float* red = L + 8 * 1024;
#pragma unroll
    for (int b = 0; b < 8; ++b) red[(wave * 8 + b) * 64 + lane] = acc[b];
    __syncthreads();
    {
        const int b = tid >> 6;
        float s = p.b_ada[l * 6144 + j0 + lane];
#pragma unroll
        for (int wv = 0; wv < 8; ++wv) s += red[(wv * 8 + b) * 64 + lane];
        p.mod[((size_t)l * 8 + b) * 6144 + j0 + lane] = s;
    }
    __syncthreads();
}

constexpr int REC_HB = 912, REC_TB = 6 * REC_HB;
constexpr int CB_PHI = 0, CB_RT = 8192, CB_PSI = 12288, CB_G = 16384, CB_V = 18432, CB_BYTES = 22528;
struct CvtJob { const float* W; bf16_t* WT; int K, N, k0, n0, dst_row0; };
__device__ __forceinline__ void cvt_load(const CvtJob& j, float (&wv)[32], int lane) {
#pragma unroll
    for (int i = 0; i < 32; ++i) wv[i] = j.W[(size_t)(j.k0 + 2 * i + (lane >> 5)) * j.N + j.n0 + (lane & 31)];
}
__device__ __forceinline__ void cvt_store(const CvtJob& j, const float (&wv)[32], LAS float* scr, int lane) {
#pragma unroll
    for (int i = 0; i < 32; ++i) scr[(2 * i + (lane >> 5)) * 33 + (lane & 31)] = wv[i];
    asm volatile("s_waitcnt lgkmcnt(0)" ::: "memory");
    const int c = lane & 7;
#pragma unroll
    for (int q = 0; q < 4; ++q) { const int n = (lane >> 3) + 8 * q; const LAS float* sp = scr + (8 * c) * 33 + n;
        u32x4 o; o.x = pk2(sp[0 * 33], sp[1 * 33]); o.y = pk2(sp[2 * 33], sp[3 * 33]); o.z = pk2(sp[4 * 33], sp[5 * 33]); o.w = pk2(sp[6 * 33], sp[7 * 33]);
        *(u32x4*)(j.WT + (size_t)(j.dst_row0 + n) * j.K + j.k0 + 8 * c) = o; }
    asm volatile("s_waitcnt lgkmcnt(0)" ::: "memory");
}
__device__ __forceinline__ void cvt_item(const float* W, int K, int N, int k0, int n0, bf16_t* WT, int dst_row0, LAS float* scr, int lane) {
    const CvtJob j{W, WT, K, N, k0, n0, dst_row0};
    float wv[32];
    cvt_load(j, wv, lane);
    cvt_store(j, wv, scr, lane);
}
constexpr int CV_IN = 16 * 84, CV_VR = 16, CV_OUT = 16 * 32, CV_DENSE_L = CV_IN + CV_VR + CV_OUT, CV_DENSE = NL * CV_DENSE_L;
__device__ __forceinline__ void cvt_dense_item(const P& p, int it, LAS float* scr, int lane) {
    const int l = it / CV_DENSE_L; int r = it % CV_DENSE_L;
    bf16_t* wti = p.wt_in + (size_t)l * PJB * D;
    if (r < CV_IN) { const int kb = r / 84, nb = r % 84; cvt_item(p.w_in + (size_t)l * D * INC, D, INC, kb * 64, nb * 32, wti, nb * 32, scr, lane); return; }
    r -= CV_IN;
    if (r < CV_VR) {
        if (l == 1) cvt_item(p.w_vres, D, 32, r * 64, 0, wti, INC, scr, lane);
        const int rz0 = (l == 1) ? INC + 32 : INC;
        for (int row = rz0 + (lane >> 3); row < PJB; row += 8) *(u32x4*)(wti + (size_t)row * D + r * 64 + (lane & 7) * 8) = (u32x4){0u, 0u, 0u, 0u};
        return;
    }
    r -= CV_VR;
    { const int kb = r / 32, nb = r % 32; cvt_item(p.w_out + (size_t)l * D * D, D, D, kb * 64, nb * 32, p.wt_out + (size_t)l * D * D, nb * 32, scr, lane); }
}
constexpr int CV_EXP_E = 128 + 128 + 128, CV_EXP = 65 * CV_EXP_E;
__device__ __forceinline__ CvtJob cvt_exp_job(const P& p, int l, int it) {
    const int e = it / CV_EXP_E; int r = it % CV_EXP_E;
    if (r < 256) {
        const int which = r >> 7; r &= 127; const int kb = r >> 3, nb = r & 7;
        const float* W = e < NE ? (which ? p.w_eu : p.w_eg) + ((size_t)l * NE + e) * D * ED : (which ? p.w_su : p.w_sg) + (size_t)l * D * ED;
        const int n0 = nb * 32, pn = n0 >> 7;
        return CvtJob{W, p.wt1 + (size_t)e * 512 * D, D, ED, kb * 64, n0, pn * 256 + which * 128 + (n0 & 127)};
    } else {
        r -= 256; const int kb = r >> 5, nb = r & 31;
        const float* W = e < NE ? p.w_ed + ((size_t)l * NE + e) * ED * D : p.w_sd + (size_t)l * ED * D;
        return CvtJob{W, p.wt2 + (size_t)e * D * ED, ED, D, kb * 64, nb * 32, nb * 32};
    }
}
__device__ __forceinline__ void cvt_exp_stream(const P& p, int l, int first, int stride, int CV_END, LAS float* scr, int lane) {
    if (first >= CV_END) return;
    float wa[32], wb[32];
    CvtJob ja = cvt_exp_job(p, l, first), jb = ja;
    cvt_load(ja, wa, lane);
    for (int it = first; it < CV_END; it += 2 * stride) {
        const bool hb = it + stride < CV_END;
        if (hb) { jb = cvt_exp_job(p, l, it + stride); cvt_load(jb, wb, lane); }
        cvt_store(ja, wa, scr, lane);
        if (!hb) break;
        const bool ha = it + 2 * stride < CV_END;
        if (ha) { ja = cvt_exp_job(p, l, it + 2 * stride); cvt_load(ja, wa, lane); }
        cvt_store(jb, wb, scr, lane);
        if (!ha) break;
    }
}

__device__ __forceinline__ void cvt_idle_wave(const P& p, int l, int quota, LAS float* scr, int lane) {
    unsigned* ctr = p.bar + 3600 + l;
    for (int done = 0; done < quota; done += 4) {
        int base = 0;
        if (lane == 0) base = (int)__hip_atomic_fetch_add(ctr, 4u, __ATOMIC_RELAXED, __HIP_MEMORY_SCOPE_AGENT);
        base = __builtin_amdgcn_readfirstlane(base);
        if (base >= CV_EXP) break;
        cvt_exp_stream(p, l, base, 1, min(base + 4, CV_EXP), scr, lane);
    }
}
__device__ __forceinline__ void st_cpre(const P& p, int item, LAS unsigned char* L, int lane_);
constexpr int CP_LDS = 20736;
constexpr int PREP_TOK = 64, PREP_XS = 168;
__device__ __forceinline__ void st_prep(const P& p, int l, int vb0, int vbstride, LAS unsigned char* L) {
    const int tid = opaque(threadIdx.x), wave = __builtin_amdgcn_readfirstlane(tid >> 6), lane = tid & 63, fr = lane & 15, fq = lane >> 4;
    LAS bf16_t* X = (LAS bf16_t*)L;
    for (int vb = vb0; vb < T / PREP_TOK; vb += vbstride) {
        const int t0 = vb * PREP_TOK, s0 = t0 % SEQ;
#pragma unroll 4
        for (int q = 0; q < PREP_TOK * 160 / NTHREADS; ++q) {
            const int it = tid + q * NTHREADS;
            const int tt = it / 160, i = it % 160;
            const int col = (i < 128) ? 1152 + i : INC + (i - 128);
            const float mu = (i < 128) ? p.mu_rw[l * RWC + col] : p.mu_vres[i - 128];
            const bf16_t* u = p.proj + (size_t)(t0 + tt) * PJB + col;
            const float uu = bf2f(u[0]), pv = (s0 + tt) > 0 ? bf2f(u[-PJB]) : 0.f;
            float x = uu + (pv - uu) * mu;
            if (i < 32) x = 1.f - 2.f / (__expf(2.f * x) + 1.f); else if (i >= 64 && i < 128) x = sigmoidf_(x);
            if (i >= 128 && l == 0) x = 0.f;
            X[tt * PREP_XS + i] = (bf16_t)f2bf(x);
        }
        __syncthreads();
        LAS float* iscr = (LAS float*)(L + 6 * CP_LDS + (wave - 6) * 8448);
        if (wave >= 6) cvt_idle_wave(p, l, 16, iscr, lane);
        if (wave < 6) {
            const int hh = wave;
            const int ll = opaque(lane), fr2 = ll & 15, fq2 = ll >> 4;
            const bf16_t* lw = p.lwt + ((size_t)l * RWW + hh * 64) * 160;
#pragma unroll 1
            for (int mt = 0; mt < 4; ++mt) {
                const int tb = t0 + 16 * mt + 4 * fq2, sb = s0 + 16 * mt + 4 * fq2;
                bf16_t rr[4][5], kr[4][5], vr[4][5], vf[4][4];
#pragma unroll
                for (int nt = 0; nt < 4; ++nt) {
                    const bf16_t* u = p.proj + (size_t)tb * PJB + hh * 64 + 16 * nt + fr2;
#pragma unroll
                    for (int rw = 0; rw < 5; ++rw) {
                        const bool ok = (rw > 0) || (sb > 0);
                        rr[nt][rw] = ok ? u[(ptrdiff_t)(rw - 1) * PJB] : (bf16_t)0; kr[nt][rw] = ok ? u[(ptrdiff_t)(rw - 1) * PJB + 384] : (bf16_t)0; vr[nt][rw] = ok ? u[(ptrdiff_t)(rw - 1) * PJB + 768] : (bf16_t)0;
                    }
#pragma unroll
                    for (int rg = 0; rg < 4; ++rg) vf[nt][rg] = (l == 1) ? p.vfirst[(size_t)(tb + rg) * RWW + hh * 64 + 16 * nt + fr2] : (bf16_t)0;
                }
                const LAS bf16_t* xa = X + (16 * mt + fr2) * PREP_XS + 8 * fq2;
                const bf16x8 Aw = *(const LAS bf16x8*)xa, Aa = *(const LAS bf16x8*)(xa + 32), Av = *(const LAS bf16x8*)(xa + 128);
                f32x4 aw[4], aa[4], av[4];
#pragma unroll
                for (int nt = 0; nt < 4; ++nt) {
                    const bf16_t* q = lw + (16 * nt + fr2) * 160 + 8 * fq2;
                    aw[nt] = __builtin_amdgcn_mfma_f32_16x16x32_bf16(Aw, *(const bf16x8*)q, (f32x4){0.f, 0.f, 0.f, 0.f}, 0, 0, 0);
                    aa[nt] = __builtin_amdgcn_mfma_f32_16x16x32_bf16(Aa, *(const bf16x8*)(q + 32), (f32x4){0.f, 0.f, 0.f, 0.f}, 0, 0, 0);
                    av[nt] = __builtin_amdgcn_mfma_f32_16x16x32_bf16(Av, *(const bf16x8*)(q + 128), (f32x4){0.f, 0.f, 0.f, 0.f}, 0, 0, 0);
                }
                float ksh[4][4], ss[4] = {0.f, 0.f, 0.f, 0.f};
#pragma unroll
                for (int nt = 0; nt < 4; ++nt) {
                    const int c = hh * 64 + 16 * nt + fr2;
                    const float muk = p.mu_rw[l * RWC + 384 + c], kkc = p.rw_k_k[l * RWW + c];
#pragma unroll
                    for (int rg = 0; rg < 4; ++rg) {
                        const float kc = bf2f(kr[nt][rg + 1]), kp = bf2f(kr[nt][rg]);
                        const float k = kc + (kp - kc) * muk;
                        ksh[nt][rg] = k; ss[rg] += (k * kkc) * (k * kkc);
                    }
                }
                float inrm[4], rkp[4] = {0.f, 0.f, 0.f, 0.f};
#pragma unroll
                for (int rg = 0; rg < 4; ++rg) inrm[rg] = 1.f / fmaxf(sqrtf(dpp_add16(ss[rg])), 1e-12f);
#pragma unroll
                for (int nt = 0; nt < 4; ++nt) {
                    const int c = hh * 64 + 16 * nt + fr2;
                    const float w0 = p.rw_w0[l * RWW + c], a0 = p.rw_a0[l * RWW + c], v0 = (l == 1) ? p.rw_v0[c] : 0.f;
                    const float kkc = p.rw_k_k[l * RWW + c], kac = p.rw_k_a[l * RWW + c], rkc = p.rw_r_k[l * RWW + c];
                    const float mur = p.mu_rw[l * RWC + c], muv = p.mu_rw[l * RWC + 768 + c];
#pragma unroll
                    for (int rg = 0; rg < 4; ++rg) {
                        const int t = tb + rg;
                        const float rc_ = bf2f(rr[nt][rg + 1]), rp = bf2f(rr[nt][rg]), vc = bf2f(vr[nt][rg + 1]), vp = bf2f(vr[nt][rg]);
                        const float r = rc_ + (rp - rc_) * mur; float v = vc + (vp - vc) * muv; const float k = ksh[nt][rg];
                        const float wlog = -softplusf_(-(aw[nt][rg] + w0)) - 0.5f;
                        const float decay = __expf(-__expf(wlog));
                        const float a = sigmoidf_(aa[nt][rg] + a0);
                        if (l == 1) { const float vg = sigmoidf_(av[nt][rg] + v0); v = v + (bf2f(vf[nt][rg]) - v) * vg; }
                        else p.vfirst[(size_t)t * RWW + c] = (bf16_t)f2bf(v);
                        const float kk = k * kkc * inrm[rg];
                        const float bq = kk * a, k2 = k * (1.f + (a - 1.f) * kac);
                        unsigned char* rc = p.rec + (size_t)t * REC_TB + hh * REC_HB;
                        *(float*)(rc + (16 * nt + fr2) * 4) = decay;
                        bf16_t* rb = (bf16_t*)(rc + 256) + 16 * nt + fr2;
                        rb[0] = (bf16_t)f2bf(-kk); rb[64] = (bf16_t)f2bf(bq); rb[128] = (bf16_t)f2bf(k2); rb[192] = (bf16_t)f2bf(decay * r); rb[256] = (bf16_t)f2bf(v);
                        rkp[rg] += r * k2 * rkc;
                    }
                }
#pragma unroll
                for (int rg = 0; rg < 4; ++rg) { const float rk = dpp_add16(rkp[rg]); if (fr2 == 0) *(float*)(p.rec + (size_t)(tb + rg) * REC_TB + hh * REC_HB + 896) = rk; }
                {
                    const bf16x8 Ag0 = *(const LAS bf16x8*)(xa + 64), Ag1 = *(const LAS bf16x8*)(xa + 96);
#pragma unroll
                    for (int nt = 0; nt < 4; ++nt) {
                        const bf16_t* q = lw + (16 * nt + fr2) * 160 + 64 + 8 * fq2;
                        f32x4 ag = __builtin_amdgcn_mfma_f32_16x16x32_bf16(Ag0, *(const bf16x8*)q, (f32x4){0.f, 0.f, 0.f, 0.f}, 0, 0, 0);
                        ag = __builtin_amdgcn_mfma_f32_16x16x32_bf16(Ag1, *(const bf16x8*)(q + 32), ag, 0, 0, 0);
#pragma unroll
                        for (int rg = 0; rg < 4; ++rg) p.g[(size_t)(tb + rg) * RWW + hh * 64 + 16 * nt + fr2] = (bf16_t)f2bf(ag[rg]);
                    }
                }
            }
        }
        __syncthreads();
        if (wave < 6) {
            const int b = t0 / SEQ, ch0 = s0 / 32;
#pragma unroll 1
            for (int q = 0; q < 2; ++q) st_cpre(p, ((b * 6 + wave) * 64) + ch0 + q, L + wave * CP_LDS, lane);
        } else cvt_idle_wave(p, l, 20, iscr, lane);
        __syncthreads();
    }
}

typedef float f32x16 __attribute__((ext_vector_type(16)));
__device__ __forceinline__ bf16x8 acc_frag(const f32x16& x, int ks) {
    return ks == 0 ? mk8(cvtpk(x[0], x[1]), cvtpk(x[2], x[3]), cvtpk(x[4], x[5]), cvtpk(x[6], x[7])) : mk8(cvtpk(x[8], x[9]), cvtpk(x[10], x[11]), cvtpk(x[12], x[13]), cvtpk(x[14], x[15]));
}
__device__ __forceinline__ bf16x8 lds_perm_frag(const LAS unsigned char* rowp, int ks, int hf) {
    const u32x2 g0 = *(const LAS u32x2*)(rowp + (16 * ks + 4 * hf) * 2), g1 = *(const LAS u32x2*)(rowp + (16 * ks + 4 * hf + 8) * 2);
    return mk8(g0.x, g0.y, g1.x, g1.y);
}
__device__ __forceinline__ void st_cpre(const P& p, int item, LAS unsigned char* L, int lane_) {
    const int lane = opaque(lane_);
    const int ch = item & 63, bh = item >> 6, b = bh / 6, hh = bh % 6;
    const int r = lane & 31, hf = lane >> 5;
    const unsigned char* rec0 = p.rec + ((size_t)(b * SEQ + ch * 32)) * REC_TB + hh * REC_HB;
    unsigned char* cbo = p.cb + (size_t)item * CB_BYTES;
    LAS unsigned char* AbarT = L; LAS unsigned char* RbarT = L + 4096; LAS unsigned char* Bbar = L + 8192; LAS unsigned char* Kbar = L + 12288; LAS unsigned char* BbarT = L + 16384;
    LAS float* PCv = (LAS float*)(L + 20480);
    float Y[32];
    {
        float Pc = 1.f;
        unsigned bt[16], vtw[16];
#pragma unroll
        for (int t8 = 0; t8 < 32; t8 += 16) {
            float wv[16]; bf16_t av[16], bv[16], kv[16], qv[16], vv[16];
#pragma unroll
            for (int j = 0; j < 16; ++j) {
                const unsigned char* rp = rec0 + (size_t)(t8 + j) * REC_TB;
                wv[j] = *(const float*)(rp + lane * 4);
                const bf16_t* hb = (const bf16_t*)(rp + 256) + lane;
                av[j] = hb[0]; bv[j] = hb[64]; kv[j] = hb[128]; qv[j] = hb[192]; vv[j] = hb[256];
            }
#pragma unroll
            for (int j = 0; j < 16; ++j) {
                const int t = t8 + j;
                const float Pm = Pc; Pc *= wv[j]; const float inv = 1.f / Pc;
                const float ab = bf2f(av[j]) * Pm, rb = bf2f(qv[j]) * Pm, bb = bf2f(bv[j]) * inv, kb = bf2f(kv[j]) * inv;
                Y[t] = ab;
                *(LAS bf16_t*)(AbarT + (t * 64 + lane) * 2) = (bf16_t)f2bf(ab);
                *(LAS bf16_t*)(RbarT + (t * 64 + lane) * 2) = (bf16_t)f2bf(rb);
                *(LAS bf16_t*)(Bbar + (t * 64 + lane) * 2) = (bf16_t)f2bf(bb);
                *(LAS bf16_t*)(Kbar + (t * 64 + lane) * 2) = (bf16_t)f2bf(kb);
                if (t & 1) { bt[t >> 1] |= f2bf(bb) << 16; vtw[t >> 1] |= (unsigned)vv[j] << 16; } else { bt[t >> 1] = f2bf(bb); vtw[t >> 1] = (unsigned)vv[j]; }
            }
            asm volatile("" ::: "memory");
        }
        PCv[lane] = Pc;
#pragma unroll
        for (int q = 0; q < 4; ++q) {
            *(LAS u32x4*)(BbarT + lane * 64 + q * 16) = (u32x4){bt[4 * q], bt[4 * q + 1], bt[4 * q + 2], bt[4 * q + 3]};
            *(u32x4*)(cbo + CB_V + lane * 64 + q * 16) = (u32x4){vtw[4 * q], vtw[4 * q + 1], vtw[4 * q + 2], vtw[4 * q + 3]};
        }
    }
    asm volatile("s_waitcnt lgkmcnt(0)" ::: "memory");
    f32x16 Lab, Lak, Mbr, Mkr;
#pragma unroll
    for (int i = 0; i < 16; ++i) { Lab[i] = 0.f; Lak[i] = 0.f; Mbr[i] = 0.f; Mkr[i] = 0.f; }
#pragma unroll
    for (int ks = 0; ks < 4; ++ks) {
        const int off = (r * 64 + 16 * ks + 8 * hf) * 2;
        const bf16x8 fb = *(const LAS bf16x8*)(Bbar + off), fk = *(const LAS bf16x8*)(Kbar + off), fa = *(const LAS bf16x8*)(AbarT + off), fr = *(const LAS bf16x8*)(RbarT + off);
        Lab = __builtin_amdgcn_mfma_f32_32x32x16_bf16(fb, fa, Lab, 0, 0, 0);
        Lak = __builtin_amdgcn_mfma_f32_32x32x16_bf16(fk, fa, Lak, 0, 0, 0);
        Mbr = __builtin_amdgcn_mfma_f32_32x32x16_bf16(fb, fr, Mbr, 0, 0, 0);
        Mkr = __builtin_amdgcn_mfma_f32_32x32x16_bf16(fk, fr, Mkr, 0, 0, 0);
    }
#pragma unroll
    for (int i = 0; i < 16; ++i) {
        const int s = (i & 3) + 8 * (i >> 2) + 4 * hf;
        if (!(s < r)) { Lab[i] = 0.f; Lak[i] = 0.f; }
        if (!(s <= r)) { Mbr[i] = 0.f; Mkr[i] = 0.f; }
    }
    asm volatile("s_waitcnt lgkmcnt(0)" ::: "memory");
    {
        LAS float* LabT = (LAS float*)AbarT; LAS float* LakM = (LAS float*)Bbar;
#pragma unroll
        for (int g = 0; g < 4; ++g) *(LAS f32x4*)(LabT + r * 32 + 8 * g + 4 * hf) = (f32x4){Lab[4 * g], Lab[4 * g + 1], Lab[4 * g + 2], Lab[4 * g + 3]};
#pragma unroll
        for (int i = 0; i < 16; ++i) LakM[((i & 3) + 8 * (i >> 2) + 4 * hf) * 32 + r] = Lak[i];
    }
    asm volatile("s_waitcnt lgkmcnt(0)" ::: "memory");
    unsigned W2p[16];
    {
        const LAS float* LabT = (const LAS float*)AbarT; const LAS float* LakM = (const LAS float*)Bbar;
        float X2[32];
#pragma unroll
        for (int t = 0; t < 32; t += 4) { const f32x4 q = *(const LAS f32x4*)(LakM + r * 32 + t); X2[t] = q[0]; X2[t + 1] = q[1]; X2[t + 2] = q[2]; X2[t + 3] = q[3]; }
        int zdep = 0;
#pragma unroll
        for (int t = 1; t < 32; ++t) {
            float x1 = Y[t], x2 = X2[t];
            const LAS float* row = LabT + t * 32 + zdep;
#pragma unroll
            for (int s4 = 0; s4 < t; s4 += 4) {
                const f32x4 lq = *(const LAS f32x4*)(row + s4);
#pragma unroll
                for (int q = 0; q < 4; ++q) if (s4 + q < t) { x1 = fmaf(Y[s4 + q], lq[q], x1); x2 = fmaf(X2[s4 + q], lq[q], x2); }
            }
            Y[t] = x1; X2[t] = x2;
            asm volatile("v_mov_b32 %0, 0" : "=v"(zdep) : "v"(x1), "v"(x2));
        }
#pragma unroll
        for (int q = 0; q < 16; ++q) W2p[q] = pk2(X2[2 * q], X2[2 * q + 1]);
    }
    asm volatile("s_waitcnt lgkmcnt(0)" ::: "memory");
    LAS unsigned char* Atil = L;
    LAS unsigned char* Wv = L + 8192;
#pragma unroll
    for (int q = 0; q < 4; ++q) {
        *(LAS u32x4*)(Atil + lane * 64 + q * 16) = (u32x4){pk2(Y[8 * q], Y[8 * q + 1]), pk2(Y[8 * q + 2], Y[8 * q + 3]), pk2(Y[8 * q + 4], Y[8 * q + 5]), pk2(Y[8 * q + 6], Y[8 * q + 7])};
        if (lane < 32) *(LAS u32x4*)(Wv + lane * 64 + q * 16) = (u32x4){W2p[4 * q], W2p[4 * q + 1], W2p[4 * q + 2], W2p[4 * q + 3]};
    }
    asm volatile("s_waitcnt lgkmcnt(0)" ::: "memory");
    const bf16x8 mb0 = acc_frag(Mbr, 0), mb1 = acc_frag(Mbr, 1);
#pragma unroll
    for (int i = 0; i < 2; ++i) {
        f32x16 c;
#pragma unroll
        for (int g = 0; g < 4; ++g) { const u32x2 q = *(const LAS u32x2*)(RbarT + (r * 64 + 32 * i + 8 * g + 4 * hf) * 2); c[4 * g] = bflo(q.x); c[4 * g + 1] = bfhi(q.x); c[4 * g + 2] = bflo(q.y); c[4 * g + 3] = bfhi(q.y); }
        c = __builtin_amdgcn_mfma_f32_32x32x16_bf16(lds_perm_frag(Atil + (32 * i + r) * 64, 0, hf), mb0, c, 0, 0, 0);
        c = __builtin_amdgcn_mfma_f32_32x32x16_bf16(lds_perm_frag(Atil + (32 * i + r) * 64, 1, hf), mb1, c, 0, 0, 0);
#pragma unroll
        for (int g = 0; g < 4; ++g) *(u32x2*)(cbo + CB_RT + (r * 64 + 32 * i + 8 * g + 4 * hf) * 2) = (u32x2){cvtpk(c[4 * g], c[4 * g + 1]), cvtpk(c[4 * g + 2], c[4 * g + 3])};
    }
    {
        f32x16 c = Mkr;
        c = __builtin_amdgcn_mfma_f32_32x32x16_bf16(lds_perm_frag(Wv + r * 64, 0, hf), mb0, c, 0, 0, 0);
        c = __builtin_amdgcn_mfma_f32_32x32x16_bf16(lds_perm_frag(Wv + r * 64, 1, hf), mb1, c, 0, 0, 0);
#pragma unroll
        for (int g = 0; g < 4; ++g) *(u32x2*)(cbo + CB_G + (r * 32 + 8 * g + 4 * hf) * 2) = (u32x2){cvtpk(c[4 * g], c[4 * g + 1]), cvtpk(c[4 * g + 2], c[4 * g + 3])};
    }
#pragma unroll
    for (int jt = 0; jt < 2; ++jt) {
        const float pc = PCv[32 * jt + r];
        const bf16x8 fb0 = *(const LAS bf16x8*)(BbarT + (32 * jt + r) * 64 + (8 * hf) * 2), fb1 = *(const LAS bf16x8*)(BbarT + (32 * jt + r) * 64 + (16 + 8 * hf) * 2);
#pragma unroll
        for (int i = 0; i < 2; ++i) {
            f32x16 c;
#pragma unroll
            for (int q = 0; q < 16; ++q) c[q] = 0.f;
            c = __builtin_amdgcn_mfma_f32_32x32x16_bf16(*(const LAS bf16x8*)(Atil + (32 * i + r) * 64 + (8 * hf) * 2), fb0, c, 0, 0, 0);
            c = __builtin_amdgcn_mfma_f32_32x32x16_bf16(*(const LAS bf16x8*)(Atil + (32 * i + r) * 64 + (16 + 8 * hf) * 2), fb1, c, 0, 0, 0);
#pragma unroll
            for (int q = 0; q < 16; ++q) { const int kq = (q & 3) + 8 * (q >> 2) + 4 * hf; c[q] = (c[q] + ((i == jt && kq == r) ? 1.f : 0.f)) * pc; }
#pragma unroll
            for (int g = 0; g < 4; ++g) *(u32x2*)(cbo + CB_PHI + ((32 * jt + r) * 64 + 32 * i + 8 * g + 4 * hf) * 2) = (u32x2){cvtpk(c[4 * g], c[4 * g + 1]), cvtpk(c[4 * g + 2], c[4 * g + 3])};
        }
        {
            f32x16 c;
#pragma unroll
            for (int q = 0; q < 16; ++q) c[q] = bf2f(*(const LAS bf16_t*)(Kbar + (((q & 3) + 8 * (q >> 2) + 4 * hf) * 64 + 32 * jt + r) * 2));
            c = __builtin_amdgcn_mfma_f32_32x32x16_bf16(*(const LAS bf16x8*)(Wv + r * 64 + (8 * hf) * 2), fb0, c, 0, 0, 0);
            c = __builtin_amdgcn_mfma_f32_32x32x16_bf16(*(const LAS bf16x8*)(Wv + r * 64 + (16 + 8 * hf) * 2), fb1, c, 0, 0, 0);
#pragma unroll
            for (int g = 0; g < 4; ++g) *(u32x2*)(cbo + CB_PSI + ((32 * jt + r) * 32 + 8 * g + 4 * hf) * 2) = (u32x2){cvtpk(c[4 * g] * pc, c[4 * g + 1] * pc), cvtpk(c[4 * g + 2] * pc, c[4 * g + 3] * pc)};
        }
    }
    asm volatile("s_waitcnt lgkmcnt(0)" ::: "memory");
}

constexpr int CS_SLOTS = 4, CS_NP = CB_BYTES / 1024;
__device__ __forceinline__ void st_cscan(const P& p, int bh, LAS unsigned char* lds) {
    const int tid = opaque(threadIdx.x), wave = __builtin_amdgcn_readfirstlane(tid >> 6), lane = tid & 63;
    const int b = bh / 6, hh = bh % 6, r = lane & 31, hf = lane >> 5;
    const unsigned char* cb0 = p.cb + (size_t)bh * 64 * CB_BYTES;
    constexpr int NCH = SEQ / 32;
    const int lw = wave - 2;
#define CS_ISSUE(chunk) do { const int _c = (chunk) < NCH ? (chunk) : NCH - 1; const unsigned char* _g = cb0 + (size_t)_c * CB_BYTES + lane * 16; LAS unsigned char* _l = lds + ((chunk) & 3) * CB_BYTES; \
        _Pragma("unroll") for (int _j = 0; _j < 4; ++_j) if (lw + 6 * _j < CS_NP) __builtin_amdgcn_global_load_lds((const unsigned*)(_g + (lw + 6 * _j) * 1024), (LAS unsigned*)(_l + (lw + 6 * _j) * 1024), 16, 0, 0); } while (0)
    f32x16 X0, X1;
#pragma unroll
    for (int i = 0; i < 16; ++i) { X0[i] = 0.f; X1[i] = 0.f; }
    if (wave >= 2) { CS_ISSUE(0); CS_ISSUE(1); CS_ISSUE(2); }
    float* yb = p.y + (size_t)b * SEQ * RWW + hh * 64 + 32 * wave + r;
    for (int c = 0; c < NCH; ++c) {
        if (wave >= 2) { if (lw < 4) asm volatile("s_waitcnt vmcnt(8)" ::: "memory"); else asm volatile("s_waitcnt vmcnt(6)" ::: "memory"); }
        __builtin_amdgcn_s_barrier();
        if (wave >= 2) { CS_ISSUE(c + 3); }
        else {
            const LAS unsigned char* S = lds + (c & 3) * CB_BYTES;
            const int vr = 32 * wave + r;
            const bf16x8 vf0 = *(const LAS bf16x8*)(S + CB_V + vr * 64 + (8 * hf) * 2), vf1 = *(const LAS bf16x8*)(S + CB_V + vr * 64 + (16 + 8 * hf) * 2);
            const LAS unsigned char* rp = S + CB_RT + r * 128;
            const bf16x8 fr0 = lds_perm_frag(rp, 0, hf), fr1 = lds_perm_frag(rp, 1, hf), fr2 = lds_perm_frag(rp + 64, 0, hf), fr3 = lds_perm_frag(rp + 64, 1, hf);
            const bf16x8 fg0 = *(const LAS bf16x8*)(S + CB_G + r * 64 + (8 * hf) * 2), fg1 = *(const LAS bf16x8*)(S + CB_G + r * 64 + (16 + 8 * hf) * 2);
            const LAS unsigned char* p0 = S + CB_PHI + r * 128; const LAS unsigned char* p1 = S + CB_PHI + (32 + r) * 128;
            const bf16x8 fa0 = lds_perm_frag(p0, 0, hf), fa1 = lds_perm_frag(p0, 1, hf), fa2 = lds_perm_frag(p0 + 64, 0, hf), fa3 = lds_perm_frag(p0 + 64, 1, hf);
            const bf16x8 fb0 = lds_perm_frag(p1, 0, hf), fb1 = lds_perm_frag(p1, 1, hf), fb2 = lds_perm_frag(p1 + 64, 0, hf), fb3 = lds_perm_frag(p1 + 64, 1, hf);
            const LAS unsigned char* q0 = S + CB_PSI + r * 64; const LAS unsigned char* q1 = S + CB_PSI + (32 + r) * 64;
            const bf16x8 fp0 = *(const LAS bf16x8*)(q0 + (8 * hf) * 2), fp1 = *(const LAS bf16x8*)(q0 + (16 + 8 * hf) * 2), fp2 = *(const LAS bf16x8*)(q1 + (8 * hf) * 2), fp3 = *(const LAS bf16x8*)(q1 + (16 + 8 * hf) * 2);
            const bf16x8 x00 = acc_frag(X0, 0), x01 = acc_frag(X0, 1), x10 = acc_frag(X1, 0), x11 = acc_frag(X1, 1);
            asm volatile("s_waitcnt lgkmcnt(0)" ::: "memory");
            __builtin_amdgcn_sched_barrier(0);
            f32x16 yc, n0, n1;
#pragma unroll
            for (int i = 0; i < 16; ++i) { yc[i] = 0.f; n0[i] = 0.f; n1[i] = 0.f; }
            n0 = __builtin_amdgcn_mfma_f32_32x32x16_bf16(fa0, x00, n0, 0, 0, 0);
            n1 = __builtin_amdgcn_mfma_f32_32x32x16_bf16(fb0, x00, n1, 0, 0, 0);
            yc = __builtin_amdgcn_mfma_f32_32x32x16_bf16(fr0, x00, yc, 0, 0, 0);
            n0 = __builtin_amdgcn_mfma_f32_32x32x16_bf16(fa1, x01, n0, 0, 0, 0);
            n1 = __builtin_amdgcn_mfma_f32_32x32x16_bf16(fb1, x01, n1, 0, 0, 0);
            yc = __builtin_amdgcn_mfma_f32_32x32x16_bf16(fr1, x01, yc, 0, 0, 0);
            n0 = __builtin_amdgcn_mfma_f32_32x32x16_bf16(fa2, x10, n0, 0, 0, 0);
            n1 = __builtin_amdgcn_mfma_f32_32x32x16_bf16(fb2, x10, n1, 0, 0, 0);
            yc = __builtin_amdgcn_mfma_f32_32x32x16_bf16(fr2, x10, yc, 0, 0, 0);
            n0 = __builtin_amdgcn_mfma_f32_32x32x16_bf16(fa3, x11, n0, 0, 0, 0);
            n1 = __builtin_amdgcn_mfma_f32_32x32x16_bf16(fb3, x11, n1, 0, 0, 0);
            yc = __builtin_amdgcn_mfma_f32_32x32x16_bf16(fr3, x11, yc, 0, 0, 0);
            n0 = __builtin_amdgcn_mfma_f32_32x32x16_bf16(fp0, vf0, n0, 0, 0, 0);
            n1 = __builtin_amdgcn_mfma_f32_32x32x16_bf16(fp2, vf0, n1, 0, 0, 0);
            yc = __builtin_amdgcn_mfma_f32_32x32x16_bf16(fg0, vf0, yc, 0, 0, 0);
            n0 = __builtin_amdgcn_mfma_f32_32x32x16_bf16(fp1, vf1, n0, 0, 0, 0);
            n1 = __builtin_amdgcn_mfma_f32_32x32x16_bf16(fp3, vf1, n1, 0, 0, 0);
            yc = __builtin_amdgcn_mfma_f32_32x32x16_bf16(fg1, vf1, yc, 0, 0, 0);
            X0 = n0; X1 = n1;
#pragma unroll
            for (int i = 0; i < 16; ++i) yb[(size_t)(c * 32 + (i & 3) + 8 * (i >> 2) + 4 * hf) * RWW] = yc[i];
        }
    }
    asm volatile("s_waitcnt vmcnt(0)" ::: "memory");
    __builtin_amdgcn_s_barrier();
#undef CS_ISSUE
}

template <int NT>
__device__ __forceinline__ void st_rwout(const P& p, int l, const int (&tok)[NT], int lane) {
    float y[NT][6], vv[NT][6], gg[NT][6], rk[NT][6];
#pragma unroll
    for (int n = 0; n < NT; ++n)
#pragma unroll
        for (int hh = 0; hh < 6; ++hh) {
            const int t = tok[n];
            y[n][hh] = p.y[(size_t)t * RWW + hh * 64 + lane]; vv[n][hh] = bf2f(*(const bf16_t*)(p.rec + (size_t)t * REC_TB + hh * REC_HB + 768 + lane * 2)); gg[n][hh] = bf2f(p.g[(size_t)t * RWW + hh * 64 + lane]);
            rk[n][hh] = *(const float*)(p.rec + (size_t)t * REC_TB + hh * REC_HB + 896);
        }
#pragma unroll
    for (int hh = 0; hh < 6; ++hh) {
        const int c = hh * 64 + lane;
        const float lg = p.rw_ln_g[l * RWW + c], lb = p.rw_ln_b[l * RWW + c];
#pragma unroll
        for (int n = 0; n < NT; ++n) {
            const float mean = wave_sum(y[n][hh]) * (1.f / 64.f);
            const float d = y[n][hh] - mean;
            const float var = wave_sum(d * d) * (1.f / 64.f);
            const float yn = d * rsqrtf(var + 64e-5f) * lg + lb;
            p.h[(size_t)tok[n] * D + c] = (bf16_t)f2bf((yn + rk[n][hh] * vv[n][hh]) * gg[n][hh]);
        }
    }
}

typedef float f32x16 __attribute__((ext_vector_type(16)));
constexpr float ATT_EXIT = -30.f;
__device__ __forceinline__ float xhalf(float x, int lane) { return __builtin_bit_cast(float, __builtin_amdgcn_ds_bpermute((lane ^ 32) << 2, __builtin_bit_cast(int, x))); }
__device__ __forceinline__ void st_attn(const P& p, int l, int item) {
    const int lane = opaque(threadIdx.x) & 63;
    const int qt = item % (SEQ / 32), bh = item / (SEQ / 32), b = bh / 6, hh = bh % 6;
    const int r = lane & 31, hf = lane >> 5;
    const bf16_t* qkb = p.proj + (size_t)b * SEQ * PJB + RWC + hh * 64 + 8 * hf;
    const bf16_t* vtb = p.vt + ((size_t)(b * 6 + hh) * 64 + r) * SEQ + 4 * hf;
    bf16x8 qf[4];
    {
        const bf16_t* qp = qkb + (size_t)(qt * 32 + r) * PJB;
#pragma unroll
        for (int s = 0; s < 4; ++s) {
            u32x4 t4 = *(const u32x4*)(qp + 16 * s);
            unsigned w[4] = {t4.x, t4.y, t4.z, t4.w};
#pragma unroll
            for (int q = 0; q < 4; ++q) { const float lo = bflo(w[q]) * 0.125f, hi = bfhi(w[q]) * 0.125f; w[q] = (__builtin_bit_cast(unsigned, lo) >> 16) | (__builtin_bit_cast(unsigned, hi) & 0xffff0000u); }
            t4.x = w[0]; t4.y = w[1]; t4.z = w[2]; t4.w = w[3];
            qf[s] = __builtin_bit_cast(bf16x8, t4);
        }
    }
    f32x16 o0, o1;
#pragma unroll
    for (int i = 0; i < 16; ++i) { o0[i] = 0.f; o1[i] = 0.f; }
    float R = 0.f;
    bf16x8 kfn[4]; u32x2 vfn[2][2][2];
#define ATT_LOAD(KT) do { const int _k0 = (KT) * 32; const bf16_t* kp = qkb + SBW + (size_t)(_k0 + r) * PJB; \
        _Pragma("unroll") for (int s = 0; s < 4; ++s) kfn[s] = *(const bf16x8*)(kp + 16 * s); \
        _Pragma("unroll") for (int dt = 0; dt < 2; ++dt) _Pragma("unroll") for (int s = 0; s < 2; ++s) { const bf16_t* vp = vtb + (size_t)dt * 32 * SEQ + _k0 + 16 * s; vfn[dt][s][0] = *(const u32x2*)vp; vfn[dt][s][1] = *(const u32x2*)(vp + 8); } } while (0)
    ATT_LOAD(qt);
    for (int kt = qt; kt >= 0; --kt) {
        const int key0 = kt * 32; (void)key0;
        bf16x8 kf[4]; u32x2 vf[2][2][2];
#pragma unroll
        for (int s = 0; s < 4; ++s) kf[s] = kfn[s];
#pragma unroll
        for (int dt = 0; dt < 2; ++dt)
#pragma unroll
            for (int s = 0; s < 2; ++s) { vf[dt][s][0] = vfn[dt][s][0]; vf[dt][s][1] = vfn[dt][s][1]; }
        if (kt > 0) ATT_LOAD(kt - 1);
        f32x16 z;
#pragma unroll
        for (int i = 0; i < 16; ++i) z[i] = 0.f;
#pragma unroll
        for (int s = 0; s < 4; ++s) z = __builtin_amdgcn_mfma_f32_32x32x16_bf16(kf[s], qf[s], z, 0, 0, 0);
        const bool diag = (kt == qt);
        float c[16], gs[4];
#pragma unroll
        for (int gi = 0; gi < 4; ++gi) {
            float run = 0.f;
#pragma unroll
            for (int e = 3; e >= 0; --e) {
                const int reg = gi * 4 + e;
                const float zz = z[reg];
                float L = -(fmaxf(zz, 0.f) + __logf(1.f + __expf(-fabsf(zz))));
                if (diag && !(r > e + 8 * gi + 4 * hf)) L = 0.f;
                run += L; c[reg] = run;
            }
            gs[gi] = run;
        }
        float go[4], pp[4], ob[4], off[4];
#pragma unroll
        for (int gi = 0; gi < 4; ++gi) { go[gi] = xhalf(gs[gi], lane); pp[gi] = gs[gi] + go[gi]; }
        ob[3] = 0.f; ob[2] = pp[3]; ob[1] = pp[3] + pp[2]; ob[0] = ob[1] + pp[1];
#pragma unroll
        for (int gi = 0; gi < 4; ++gi) off[gi] = ob[gi] + (hf == 0 ? go[gi] : 0.f) + R;
        const float total = ob[0] + pp[0];
        unsigned af[8];
#pragma unroll
        for (int i = 0; i < 8; ++i) {
            float a2[2];
#pragma unroll
            for (int q = 0; q < 2; ++q) {
                const int reg = 2 * i + q, gi = reg >> 2, e = reg & 3;
                float a = __expf(z[reg] + c[reg] + off[gi]);
                if (diag && !(r > e + 8 * gi + 4 * hf)) a = 0.f;
                a2[q] = a;
            }
            af[i] = pk2(a2[0], a2[1]);
        }
        R += total;
        const bf16x8 a0 = __builtin_bit_cast(bf16x8, (u32x4){af[0], af[1], af[2], af[3]});
        const bf16x8 a1 = __builtin_bit_cast(bf16x8, (u32x4){af[4], af[5], af[6], af[7]});
        o0 = __builtin_amdgcn_mfma_f32_32x32x16_bf16(__builtin_bit_cast(bf16x8, (u32x4){vf[0][0][0].x, vf[0][0][0].y, vf[0][0][1].x, vf[0][0][1].y}), a0, o0, 0, 0, 0);
        o0 = __builtin_amdgcn_mfma_f32_32x32x16_bf16(__builtin_bit_cast(bf16x8, (u32x4){vf[0][1][0].x, vf[0][1][0].y, vf[0][1][1].x, vf[0][1][1].y}), a1, o0, 0, 0, 0);
        o1 = __builtin_amdgcn_mfma_f32_32x32x16_bf16(__builtin_bit_cast(bf16x8, (u32x4){vf[1][0][0].x, vf[1][0][0].y, vf[1][0][1].x, vf[1][0][1].y}), a0, o1, 0, 0, 0);
        o1 = __builtin_amdgcn_mfma_f32_32x32x16_bf16(__builtin_bit_cast(bf16x8, (u32x4){vf[1][1][0].x, vf[1][1][0].y, vf[1][1][1].x, vf[1][1][1].y}), a1, o1, 0, 0, 0);
        if (__all(R < ATT_EXIT)) break;
    }
#undef ATT_LOAD
    float ss = 0.f;
#pragma unroll
    for (int i = 0; i < 16; ++i) ss += o0[i] * o0[i] + o1[i] * o1[i];
    ss += xhalf(ss, lane);
    const float rs = rsqrtf(ss * (1.f / 64.f) + 1e-6f);
    bf16_t* op = p.h + ((size_t)b * SEQ + qt * 32 + r) * D + RWW + hh * 64 + 4 * hf;
    const float* gn = p.sb_norm_g + l * SBW + hh * 64 + 4 * hf;
#pragma unroll
    for (int gi = 0; gi < 4; ++gi) {
        const f32x4 g0 = *(const f32x4*)(gn + 8 * gi), g1 = *(const f32x4*)(gn + 32 + 8 * gi);
        u32x2 w0, w1;
        w0.x = pk2(o0[4 * gi] * rs * g0[0], o0[4 * gi + 1] * rs * g0[1]); w0.y = pk2(o0[4 * gi + 2] * rs * g0[2], o0[4 * gi + 3] * rs * g0[3]);
        w1.x = pk2(o1[4 * gi] * rs * g1[0], o1[4 * gi + 1] * rs * g1[1]); w1.y = pk2(o1[4 * gi + 2] * rs * g1[2], o1[4 * gi + 3] * rs * g1[3]);
        *(u32x2*)(op + 8 * gi) = w0; *(u32x2*)(op + 32 + 8 * gi) = w1;
    }
}

__device__ __forceinline__ void st_pool(const P& p, int l, int vb, LAS float* PL  ) {
    const int tid = opaque(threadIdx.x);
    const int t0 = vb * 32, s0 = t0 % SEQ;
    {
        const int col = tid & 255, th = tid >> 8, g = col >> 6, win = 2 << g;
        const int sA = s0 + th * 16;
        const bf16_t* u = p.proj + (size_t)(t0 + th * 16) * PJB + RWC + SBC + col;
        float xv[31];
#pragma unroll
        for (int i = 0; i < 31; ++i) { const int s = sA - 15 + i; xv[i] = (s >= 0 && (i >= 15 || 15 - i < win)) ? bf2f(u[(ptrdiff_t)(i - 15) * PJB]) : 0.f; }
        float run = 0.f;
#pragma unroll
        for (int i = 0; i < 15; ++i) run += (15 - i < win) ? xv[i] : 0.f;
#pragma unroll
        for (int j = 0; j < 16; ++j) {
            run += xv[15 + j];
            const int s = sA + j, n = min(s + 1, win);
            PL[(th * 16 + j) * 256 + col] = run / (float)n - xv[15 + j];
            float drop = 0.f;
#pragma unroll
            for (int q = 1; q <= 4; ++q) if (win == (1 << q)) drop = xv[15 + j - (1 << q) + 1];
            run -= drop;
        }
    }
    __syncthreads();
    {
        const int wave = tid >> 6, lane = tid & 63, g = wave & 3, th = wave >> 2;
        float acc[16];
#pragma unroll
        for (int j = 0; j < 16; ++j) acc[j] = 0.f;
        const float* pw = p.pool_w + ((size_t)l * 4 + g) * 64 * 64 + lane;
        for (int c = 0; c < 64; c += 4) {
            const float w0 = pw[c * 64], w1 = pw[(c + 1) * 64], w2 = pw[(c + 2) * 64], w3 = pw[(c + 3) * 64];
#pragma unroll
            for (int j = 0; j < 16; ++j) { const f32x4 x = *(const LAS f32x4*)(PL + (th * 16 + j) * 256 + g * 64 + c); acc[j] += x[0] * w0 + x[1] * w1 + x[2] * w2 + x[3] * w3; }
        }
        const float sc = p.pool_scale[l * PLW + g * 64 + lane];
#pragma unroll
        for (int j = 0; j < 16; ++j) p.h[(size_t)(t0 + th * 16 + j) * D + 768 + g * 64 + lane] = (bf16_t)f2bf(acc[j] * sc);
    }
    __syncthreads();
}

template <bool TOLDS>
__device__ __forceinline__ void norm_row(const float* xr, const float* md  , bf16_t* hrow, LAS float* hl, int lane) {
    f32x4 v[4]; float ss = 0.f;
#pragma unroll
    for (int i = 0; i < 4; ++i) { v[i] = *(const f32x4*)(xr + i * 256 + lane * 4); ss += v[i][0] * v[i][0] + v[i][1] * v[i][1] + v[i][2] * v[i][2] + v[i][3] * v[i][3]; }
    ss = wave_sum(ss);
    const float rs = rsqrtf(ss * (1.f / D) + 1e-6f);
#pragma unroll
    for (int i = 0; i < 4; ++i) {
        const int cidx = i * 256 + lane * 4;
        const f32x4 sh = *(const f32x4*)(md + cidx), sc = *(const f32x4*)(md + 1024 + cidx);
        const f32x4 o = v[i] * rs * (sc + 1.f) + sh;
        u32x2 w; w.x = pk2(o[0], o[1]); w.y = pk2(o[2], o[3]);
        *(u32x2*)(hrow + cidx) = w;
        if constexpr (TOLDS) *(LAS f32x4*)(hl + cidx) = o;
    }
}

__device__ __forceinline__ void split_bf16(const float (&x)[8], bf16x8& hi, bf16x8& lo) {
    unsigned h[4], l[4];
#pragma unroll
    for (int q = 0; q < 4; ++q) {
        const unsigned ph = cvtpk(x[2 * q], x[2 * q + 1]);
        const float r0 = x[2 * q] - bflo(ph), r1 = x[2 * q + 1] - bfhi(ph);
        h[q] = ph; l[q] = cvtpk(r0, r1);
    }
    hi = mk8(h[0], h[1], h[2], h[3]); lo = mk8(l[0], l[1], l[2], l[3]);
}
__device__ __forceinline__ void st_normrouter(const P& p, int l, int vb0, int vbstride, LAS float* L  ) {
    const int tid = opaque(threadIdx.x), wave = tid >> 6, lane = tid & 63;
    const int fr = lane & 15, fq = lane >> 4;
    constexpr int HS = 1028;
    LAS float* H = L; LAS float* PART = L + 16 * HS; LAS float* SEL = PART + 8 * 16 * 64; LAS int* lcnt = (LAS int*)(SEL + 16 * 72);
    bf16x8 Bh[4][4], Bl[4][4];
    {
        const float* wr = p.w_router + ((size_t)l * D + wave * 128) * NE;
        const int ll = opaque(lane), fr2 = ll & 15, fq2 = ll >> 4;
#pragma unroll
        for (int ks = 0; ks < 4; ++ks)
#pragma unroll
            for (int nt = 0; nt < 4; ++nt) {
                float x[8];
#pragma unroll
                for (int j = 0; j < 8; ++j) x[j] = wr[(32 * ks + 8 * fq2 + j) * NE + 16 * nt + fr2];
                split_bf16(x, Bh[ks][nt], Bl[ks][nt]);
            }
    }
    const float brt = p.b_router[l * NE + lane];
    for (int vb = vb0; vb < T / 16; vb += vbstride) {
        const int t0 = vb * 16, b = t0 / SEQ;
        const float* md = p.mod + ((size_t)l * 8 + b) * 6144 + 3072;
        if (tid < 64) lcnt[tid] = 0;
        unsigned pfv = 0u;
        if (vb + vbstride < T / 16) pfv = pf_lines(p.xb + (size_t)((vb + vbstride) * 16 + wave * 2) * D, 2 * D * 4, lane);
#pragma unroll
        for (int q = 0; q < 2; ++q) { const int tt = wave * 2 + q; norm_row<true>(p.xb + (size_t)(t0 + tt) * D, md, p.h + (size_t)(t0 + tt) * D, H + tt * HS, lane); }
        __syncthreads();
        {
            f32x4 acc[4];
#pragma unroll
            for (int nt = 0; nt < 4; ++nt) acc[nt] = (f32x4){0.f, 0.f, 0.f, 0.f};
#pragma unroll
            for (int ks = 0; ks < 4; ++ks) {
                const LAS float* hp = H + fr * HS + wave * 128 + 32 * ks + 8 * fq;
                const f32x4 h0 = *(const LAS f32x4*)hp, h1 = *(const LAS f32x4*)(hp + 4);
                const float x[8] = {h0[0], h0[1], h0[2], h0[3], h1[0], h1[1], h1[2], h1[3]};
                bf16x8 ah, al; split_bf16(x, ah, al);
#pragma unroll
                for (int nt = 0; nt < 4; ++nt) {
                    acc[nt] = __builtin_amdgcn_mfma_f32_16x16x32_bf16(ah, Bh[ks][nt], acc[nt], 0, 0, 0);
                    acc[nt] = __builtin_amdgcn_mfma_f32_16x16x32_bf16(ah, Bl[ks][nt], acc[nt], 0, 0, 0);
                    acc[nt] = __builtin_amdgcn_mfma_f32_16x16x32_bf16(al, Bh[ks][nt], acc[nt], 0, 0, 0);
                }
            }
#pragma unroll
            for (int nt = 0; nt < 4; ++nt)
#pragma unroll
                for (int rg = 0; rg < 4; ++rg) PART[(wave * 16 + 4 * fq + rg) * 64 + 16 * nt + fr] = acc[nt][rg];
        }
        __syncthreads();
#pragma unroll
        for (int q = 0; q < 2; ++q) {
            const int tt = wave * 2 + q, t = t0 + tt;
            float logit = 0.f;
#pragma unroll
            for (int w = 0; w < 8; ++w) logit += PART[(w * 16 + tt) * 64 + lane];
            float score = sigmoidf_(logit);
            score = (score == score) ? score : 0.f;
            const float sl = score + brt;
            LAS float* sel = SEL + (wave * 2 + q) * 72; LAS float* gs = sel + 64;
            sel[lane] = sl;
            if (lane < 8) {
                float m1 = -INFINITY, m2 = -INFINITY;
                for (int i = 0; i < 8; ++i) { const float v = sel[lane * 8 + i]; if (v > m1) { m2 = m1; m1 = v; } else if (v > m2) m2 = v; }
                gs[lane] = m1 + m2;
            }
            const int gI = lane >> 3;
            int grank = 0;
            for (int i = 0; i < 8; ++i) { const float v = gs[i]; grank += (v > gs[gI] || (v == gs[gI] && i < gI)) ? 1 : 0; }
            const float msk = (grank < 4) ? sl : -INFINITY;
            sel[lane] = msk;
            int rank = 0;
            for (int i = 0; i < 64; ++i) { const float v = sel[i]; rank += (v > msk || (v == msk && i < lane)) ? 1 : 0; }
            const bool chosen = rank < TOPK;
            const float wsum = wave_sum(chosen ? score : 0.f);
            if (chosen) {
                const int pos = __hip_atomic_fetch_add(&lcnt[lane], 1, __ATOMIC_RELAXED, __HIP_MEMORY_SCOPE_WORKGROUP);
                p.seg[((size_t)lane * 1024 + vb) * 16 + pos] = t * TOPK + rank;
                p.topw[(size_t)t * TOPK + rank] = score / (wsum + 1e-20f) * 2.5f;
            }
        }
        __syncthreads();
        if (tid < 64) p.cnt2[tid * 1024 + vb] = lcnt[tid];
        pf_done(pfv);
        __syncthreads();
    }
}

__device__ __forceinline__ void st_compact(const P& p, int e, LAS int* wt  ) {
    const int tid = opaque(threadIdx.x), wave = tid >> 6, lane = tid & 63;
    const int c0 = p.cnt2[e * 1024 + 2 * tid], c1 = p.cnt2[e * 1024 + 2 * tid + 1], s = c0 + c1;
    int incl = s;
#pragma unroll
    for (int o = 1; o < 64; o <<= 1) { const int v = __builtin_amdgcn_ds_bpermute(((lane - o) & 63) << 2, incl); if (lane >= o) incl += v; }
    if (lane == 63) wt[wave] = incl;
    __syncthreads();
    int base = 0;
    for (int w = 0; w < wave; ++w) base += wt[w];
    const int excl = base + incl - s;
    int2* dst = p.list + (size_t)e * T + excl;
    const int* s0 = p.seg + ((size_t)e * 1024 + 2 * tid) * 16;
    for (int j = 0; j < c0; ++j) { const int aid = s0[j]; dst[j] = make_int2(aid, __float_as_int(p.topw[aid])); }
    for (int j = 0; j < c1; ++j) { const int aid = s0[16 + j]; dst[c0 + j] = make_int2(aid, __float_as_int(p.topw[aid])); }
    if (tid == NTHREADS - 1) p.cnt[e] = base + incl;
    __syncthreads();
}

template <int NT>
__device__ __forceinline__ void st_combine(const P& p, int l, const int (&tok)[NT], int lane) {
    u32x2 q[NT][2][TOPK + 1]; f32x4 x0[NT][2], x1[NT][2];
#pragma unroll
    for (int n = 0; n < NT; ++n) {
        const int t = tok[n];
        const unsigned char* sl = p.slab + (size_t)t * TOPK * D;
#pragma unroll
        for (int i = 0; i < 2; ++i) {
            const int cidx = i * 512 + lane * 8;
#pragma unroll
            for (int s = 0; s < TOPK + 1; ++s) q[n][i][s] = *(const u32x2*)(s < TOPK ? sl + (size_t)s * D + cidx : p.slab + ((size_t)T * TOPK + t) * D + cidx);
            x0[n][i] = *(const f32x4*)(p.xb + (size_t)t * D + cidx); x1[n][i] = *(const f32x4*)(p.xb + (size_t)t * D + cidx + 4);
        }
    }
#pragma unroll
    for (int n = 0; n < NT; ++n) {
        const int t = tok[n], b = t / SEQ;
        const float* gt = p.mod + ((size_t)l * 8 + b) * 6144 + 5120;
        float* xr = p.xb + (size_t)t * D;
        float xv[16]; float ss = 0.f;
#pragma unroll
        for (int i = 0; i < 2; ++i) {
            const int cidx = i * 512 + lane * 8;
            float f[8];
#pragma unroll
            for (int j = 0; j < 8; ++j) f[j] = 0.f;
#pragma unroll
            for (int s = 0; s < TOPK + 1; ++s) {
                const u32x2 qq = q[n][i][s];
                const f32x2 a = __builtin_amdgcn_cvt_pk_f32_fp8((int)qq.x, false), bq = __builtin_amdgcn_cvt_pk_f32_fp8((int)qq.x, true), c = __builtin_amdgcn_cvt_pk_f32_fp8((int)qq.y, false), d = __builtin_amdgcn_cvt_pk_f32_fp8((int)qq.y, true);
                f[0] += a[0]; f[1] += a[1]; f[2] += bq[0]; f[3] += bq[1]; f[4] += c[0]; f[5] += c[1]; f[6] += d[0]; f[7] += d[1];
            }
            const f32x4 g0 = *(const f32x4*)(gt + cidx), g1 = *(const f32x4*)(gt + cidx + 4);
#pragma unroll
            for (int j = 0; j < 4; ++j) { xv[i * 8 + j] = x0[n][i][j] + g0[j] * f[j] * (1.f / SLAB_SC); xv[i * 8 + 4 + j] = x1[n][i][j] + g1[j] * f[4 + j] * (1.f / SLAB_SC); }
#pragma unroll
            for (int j = 0; j < 8; ++j) ss += xv[i * 8 + j] * xv[i * 8 + j];
        }
        ss = wave_sum(ss);
        const float rs = rsqrtf(ss * (1.f / D) + 1e-6f);
        if (l + 1 < NL) {
            const float* md = p.mod + ((size_t)(l + 1) * 8 + b) * 6144;
#pragma unroll
            for (int i = 0; i < 2; ++i) {
                const int cidx = i * 512 + lane * 8;
                *(f32x4*)(xr + cidx) = (f32x4){xv[i * 8], xv[i * 8 + 1], xv[i * 8 + 2], xv[i * 8 + 3]};
                *(f32x4*)(xr + cidx + 4) = (f32x4){xv[i * 8 + 4], xv[i * 8 + 5], xv[i * 8 + 6], xv[i * 8 + 7]};
                const f32x4 s0 = *(const f32x4*)(md + cidx), s1 = *(const f32x4*)(md + cidx + 4), c0 = *(const f32x4*)(md + 1024 + cidx), c1 = *(const f32x4*)(md + 1024 + cidx + 4);
                float o[8];
#pragma unroll
                for (int j = 0; j < 4; ++j) { o[j] = xv[i * 8 + j] * rs * (1.f + c0[j]) + s0[j]; o[4 + j] = xv[i * 8 + 4 + j] * rs * (1.f + c1[j]) + s1[j]; }
                u32x4 w; w.x = pk2(o[0], o[1]); w.y = pk2(o[2], o[3]); w.z = pk2(o[4], o[5]); w.w = pk2(o[6], o[7]);
                *(u32x4*)(p.h + (size_t)t * D + cidx) = w;
            }
        } else {
#pragma unroll
            for (int i = 0; i < 2; ++i) {
                const int cidx = i * 512 + lane * 8;
                const f32x4 g0 = *(const f32x4*)(p.g_final + cidx), g1 = *(const f32x4*)(p.g_final + cidx + 4);
                *(f32x4*)(p.out + (size_t)t * D + cidx) = (f32x4){xv[i * 8] * rs * g0[0], xv[i * 8 + 1] * rs * g0[1], xv[i * 8 + 2] * rs * g0[2], xv[i * 8 + 3] * rs * g0[3]};
                *(f32x4*)(p.out + (size_t)t * D + cidx + 4) = (f32x4){xv[i * 8 + 4] * rs * g1[0], xv[i * 8 + 5] * rs * g1[1], xv[i * 8 + 6] * rs * g1[2], xv[i * 8 + 7] * rs * g1[3]};
            }
        }
    }
}

#define XB_TMO      128
#define XB_XCNT(j)  (256  + 64 * (j))
#define XB_XSUB(j)  (1280 + 64 * (j))
#define XB_XGEN(j)  (2304 + 64 * (j))
#define XB_TOP      3328
#define XB_TOPGEN   3392
#define XCD_BAR_WORDS 3456
#define XB_SPIN_CAP (1u << 22)
__device__ __forceinline__ unsigned xb_ld(unsigned* p)              { return __hip_atomic_load(p, __ATOMIC_RELAXED, __HIP_MEMORY_SCOPE_AGENT); }
__device__ __forceinline__ unsigned xb_add(unsigned* p, unsigned v) { return __hip_atomic_fetch_add(p, v, __ATOMIC_RELAXED, __HIP_MEMORY_SCOPE_AGENT); }
__device__ __forceinline__ unsigned xb_xcc_id() { return (unsigned)__builtin_amdgcn_s_getreg((3 << 11) | 20) & 0xFu; }
#define XB_SPIN(cond, bar) do { unsigned _sp = 0; while (cond) { __builtin_amdgcn_s_sleep(1); \
    if ((++_sp & 255u) == 0u) { if (xb_ld(&(bar)[XB_TMO])) break; if (_sp > XB_SPIN_CAP) { atomicAdd(&(bar)[XB_TMO], 1u); break; } } } } while (0)
struct XcdBarrier { unsigned* bar; unsigned x; volatile LAS unsigned* st; };
__device__ __forceinline__ XcdBarrier xcd_barrier_post(unsigned* bar, volatile LAS unsigned* st) {
    XcdBarrier b; b.bar = bar; b.x = xb_xcc_id(); b.st = st;
    if (threadIdx.x == 0) (void)xb_add(&bar[XB_XCNT(b.x)], 1u);
    return b;
}
__device__ __forceinline__ void xcd_barrier_complete(unsigned* bar, unsigned x, unsigned& nloc, unsigned& nx) {
    const unsigned G = gridDim.x * gridDim.y * gridDim.z;
    unsigned sum, cnt, mine, sp = 0u;
    for (;;) {
        sum = 0u; cnt = 0u; mine = 0u;
#pragma unroll
        for (unsigned j = 0; j < 16; ++j) { const unsigned c = xb_ld(&bar[XB_XCNT(j)]); sum += c; cnt += (c > 0u) ? 1u : 0u; mine = (j == x) ? c : mine; }
        if (sum == G) break;
        __builtin_amdgcn_s_sleep(1);
        if ((++sp & 255u) == 0u) { if (xb_ld(&bar[XB_TMO])) break; if (sp > XB_SPIN_CAP) { atomicAdd(&bar[XB_TMO], 1u); break; } }
    }
    nloc = mine > 0u ? mine : 1u; nx = cnt > 0u ? cnt : 1u;
}
__device__ __forceinline__ void xcd_barrier(const XcdBarrier& b0) {
    XcdBarrier b = b0; { unsigned xx = b0.x; asm volatile("" : "+s"(xx)); b.x = xx; }
    asm volatile("s_waitcnt vmcnt(0)" ::: "memory");
    __syncthreads();
    if (threadIdx.x == 0) {
        unsigned* bar = b.bar;
        __builtin_amdgcn_s_waitcnt(0);
        unsigned nloc = b.st[0], nx = b.st[1];
        if (nloc == 0u) { xcd_barrier_complete(bar, b.x, nloc, nx); b.st[0] = nloc; b.st[1] = nx; }
        const unsigned old = xb_add(&bar[XB_XSUB(b.x)], 1u);
        const unsigned gen = old / nloc;
        if (old + 1u == (gen + 1u) * nloc) {
            __builtin_amdgcn_fence(__ATOMIC_RELEASE, "agent");
            asm volatile("s_waitcnt vmcnt(0)" ::: "memory");
            const unsigned og = xb_add(&bar[XB_TOP], 1u);
            const unsigned tg = og / nx;
            if (og + 1u == (tg + 1u) * nx) xb_add(&bar[XB_TOPGEN], 1u);
            else XB_SPIN(xb_ld(&bar[XB_TOPGEN]) == tg, bar);
            __builtin_amdgcn_fence(__ATOMIC_ACQUIRE, "agent");
            xb_add(&bar[XB_XGEN(b.x)], 1u);
            asm volatile("s_waitcnt vmcnt(0)" ::: "memory");
        } else {
            XB_SPIN(xb_ld(&bar[XB_XGEN(b.x)]) == gen, bar);
            __builtin_amdgcn_fence(__ATOMIC_ACQUIRE, "agent");
            asm volatile("s_waitcnt vmcnt(0)" ::: "memory");
        }
    }
    __syncthreads();
}

__device__ __forceinline__ P load_args() {
    P q{};
#if defined(__HIP_DEVICE_COMPILE__)
    const __attribute__((address_space(4))) unsigned long long* k = (const __attribute__((address_space(4))) unsigned long long*)__builtin_amdgcn_kernarg_segment_ptr();
    asm volatile("" : "+s"(k));
    unsigned long long w[sizeof(P) / 8];
#pragma unroll
    for (unsigned i = 0; i < sizeof(P) / 8; ++i) w[i] = k[i];
    __builtin_memcpy(&q, w, sizeof(P));
#endif
    return q;
}
enum Ph { PH_NORM1 = 0, PH_INPROJ, PH_PREP, PH_MIX, PH_RWOUT, PH_OUTPROJ, PH_ROUTER, PH_COMPACT, PH_EXP1, PH_EXP2, PH_COMBINE, PH_PER_LAYER };

__global__ void __launch_bounds__(NTHREADS, 2) k_fused(P p_arg) {
    (void)p_arg;
#define KARGS() load_args()
    extern __shared__ __attribute__((aligned(16))) unsigned char lds_raw[];
    LAS unsigned char* lds = (LAS unsigned char*)lds_raw;
    LAS int* tstart = (LAS int*)(lds + LDS_STAGE);
    LAS int* cnts = (LAS int*)(lds + LDS_STAGE + 272);
    LAS int* tmap = (LAS int*)(lds + LDS_STAGE + 2048);
    volatile LAS unsigned* bst = (volatile LAS unsigned*)(lds + LDS_STAGE + 1008);
    if (threadIdx.x < 4) bst[threadIdx.x] = 0u;
    __syncthreads();
    XcdBarrier xb = xcd_barrier_post(load_args().bar, bst);
#define PHASE_COORDS() int G = gridDim.x, bx = blockIdx.x; asm volatile("" : "+s"(G), "+s"(bx)); const int vcu = (G % 8 == 0) ? (bx % 8) * (G / 8) + bx / 8 : bx; (void)vcu; \
    const int tid = opaque(threadIdx.x), half = tid >> 8, lane = tid & 63, wave = __builtin_amdgcn_readfirstlane(tid >> 6); \
    float* smem = (float*)lds_raw + half * 8192; LAS float* scr = (LAS float*)(lds + wave * 16384); (void)lane; (void)smem; (void)scr; (void)tid

    for (int rep = 0; rep < (REP_PH == -1 ? REP_N : 1); ++rep) {
        const P p = KARGS();
        PHASE_COORDS();
        for (int it = bx; it < NL * 96; it += G) st_mod(p, it, (LAS float*)lds);
        __syncthreads();
        for (int it = (bx * 8 + wave); it < CV_DENSE; it += G * 8) cvt_dense_item(p, it, scr, lane);
        for (int idx = bx * NTHREADS + tid; idx < NL * RWW * 160; idx += G * NTHREADS) {
            const int k = idx % 160, c = (idx / 160) % RWW, ly = idx / (160 * RWW);
            float v;
            if (k < 32) v = p.rw_w2[((size_t)ly * 32 + k) * RWW + c];
            else if (k < 64) v = p.rw_a2[((size_t)ly * 32 + (k - 32)) * RWW + c];
            else if (k < 128) v = p.rw_g2[((size_t)ly * 64 + (k - 64)) * RWW + c];
            else v = (ly == 1) ? p.rw_v2[(size_t)(k - 128) * RWW + c] : 0.f;
            p.lwt[idx] = (bf16_t)f2bf(v);
        }
        xcd_barrier(xb);
    }

    constexpr int NPH2 = NL * PH_PER_LAYER + ((REP_PH >= 0) ? REP_N - 1 : 0);
    for (int ph2 = 0; ph2 < NPH2; ++ph2) {
      {
        const int ph = (REP_PH < 0 || ph2 <= REP_PH) ? ph2 : (ph2 < REP_PH + REP_N ? REP_PH : ph2 - (REP_N - 1));
        const int rep = (REP_PH >= 0 && ph2 > REP_PH && ph2 < REP_PH + REP_N) ? 1 : 0; (void)rep;
        const int l = ph / PH_PER_LAYER, st = ph % PH_PER_LAYER;
        const P p = KARGS();
        PHASE_COORDS();
        if (st == PH_NORM1) {
            if (l == 0) {
                for (int t = bx * 8 + wave; t < T; t += G * 8) {
                    const int tn = t + G * 8; unsigned pfv = 0u;
                    if (tn < T) pfv = pf_lines(p.x + (size_t)tn * D, D * 4, lane);
                    norm_row<false>(p.x + (size_t)t * D, p.mod + (size_t)(t / SEQ) * 6144, p.h + (size_t)t * D, (LAS float*)lds, lane);
                    pf_done(pfv);
                }
            }
        } else if (st == PH_INPROJ) {
            pg8::DenseOrder S; S.init(p.h, p.wt_in + (size_t)l * PJB * D, T, PJB, D, G, bx);
            pg8::EpiProj E{p.proj, p.vt};
            pg8::gemm_phase<pg8::EpiProj, pg8::DenseOrder, true, true>(lds, D, S, E);
        } else if (st == PH_PREP) {
            st_prep(p, l, bx, G, lds);
        } else if (st == PH_MIX) {
            constexpr int N1 = NBATCH * 6, N2 = NBATCH * 6 * (SEQ / 32) / 8, N3 = T / 32, N4 = (CV_EXP + 7) / 8;
            const int sel = (rep == 0) ? 15 : REP_SEL;
            if (sel & 1) for (int wb = bx; wb < N1; wb += G) st_cscan(p, wb, lds);
            __syncthreads();
            {
                unsigned* ctrA = p.bar + 3500 + ph2; unsigned* ctrB = p.bar + 3600 + l;
                volatile LAS int* gslot = (volatile LAS int*)(lds + LDS_STAGE + 640);
                for (;;) {
                    __syncthreads();
                    if (tid == 0) *gslot = (int)__hip_atomic_fetch_add(ctrA, 2u, __ATOMIC_RELAXED, __HIP_MEMORY_SCOPE_AGENT);
                    __syncthreads();
                    const int base = *gslot;
                    if (base >= N2 + N3) break;
                    for (int wb = base; wb < base + 2 && wb < N2 + N3; ++wb) {
                        if (wb < N2) { if (sel & 2) st_attn(p, l, wb * 8 + wave); }
                        else if (sel & 4) st_pool(p, l, wb - N2, (LAS float*)lds);
                    }
                }
                for (;;) {
                    __syncthreads();
                    if (tid == 0) *gslot = (int)__hip_atomic_fetch_add(ctrB, 64u, __ATOMIC_RELAXED, __HIP_MEMORY_SCOPE_AGENT);
                    __syncthreads();
                    const int base = *gslot;
                    if (base >= CV_EXP) break;
                    if (sel & 8) cvt_exp_stream(p, l, base + wave, 8, min(base + 64, CV_EXP), scr, lane);
                }
            }
        } else if (st == PH_RWOUT) {
            for (int t = (bx * 8 + wave) * 4; t < T; t += G * 32) { const int tk[4] = {t, t + 1, t + 2, t + 3}; st_rwout<4>(p, l, tk, lane); }
        } else if (st == PH_OUTPROJ) {
            pg8::DenseOrder S; S.init(p.h, p.wt_out + (size_t)l * D * D, T, D, D, G, bx);
            pg8::EpiOut E{l == 0 ? p.x : p.xb, p.xb, p.mod + (size_t)l * 8 * 6144 + 2048};
            pg8::gemm_phase<pg8::EpiOut, pg8::DenseOrder, true, true>(lds, D, S, E);
        } else if (st == PH_ROUTER) {
            st_normrouter(p, l, bx, G, (LAS float*)lds);
        } else if (st == PH_COMPACT) {
            if (bx < NE) st_compact(p, bx, (LAS int*)lds);
        } else if (st == PH_EXP1 || st == PH_EXP2) {
            __syncthreads();
            if (tid == 0) {
                int acc = 0;
                for (int e = 0; e < 65; ++e) { const int c = e < NE ? p.cnt[e] : T; cnts[e] = c; tstart[e] = acc; acc += (c + 255) >> 8; }
                tstart[65] = acc;
            }
            __syncthreads();
            { int e = 0; for (int j = 1; j < 65; ++j) e += (tstart[j] <= tid) ? 1 : 0; tmap[tid] = e; }
            __syncthreads();
            if (st == PH_EXP1) {
                pg8::MoeOrder<true> S{tstart, cnts, tmap, p.list, p.h, p.wt1, D, 512, 1, G, vcu};
                pg8::EpiExp1 E{p.hm};
                pg8::gemm_phase<pg8::EpiExp1, pg8::MoeOrder<true>, true, true>(lds, D, S, E);
            } else {
                pg8::MoeOrder<false> S{tstart, cnts, tmap, p.list, p.hm, p.wt2, ED, D, 2, G, vcu};
                pg8::EpiExp2 E{p.slab, p.list, cnts};
                pg8::gemm_phase<pg8::EpiExp2, pg8::MoeOrder<false>, true, true>(lds, ED, S, E);
            }
        } else {
            for (int t = (bx * 8 + wave) * 2; t < T; t += G * 16) { const int tk[2] = {t, t + 1}; st_combine<2>(p, l, tk, lane); }
        }
        if (!(ph2 == NPH2 - 1)) { if (!(st == PH_NORM1 && l > 0)) xcd_barrier(xb); }
      }
    }
#undef PHASE_COORDS
#undef KARGS
}

}

extern "C" void kernel_launch(void* const* d_in, const int* in_sizes, int n_in, void* d_out, int out_size, void* d_ws, size_t ws_size,
                              hipStream_t stream) {
    P p{};
    const float** fp = (const float**)&p;
    for (int i = 0; i < 33; ++i) fp[i] = (const float*)d_in[i];
    p.out = (float*)d_out;
    char* ws = (char*)d_ws;
    size_t off = 0;
    auto take = [&](size_t bytes) { char* r = ws + off; off += (bytes + 255) & ~(size_t)255; return r; };
    p.bar = (unsigned*)take(16384);
    p.cnt = (int*)take(256);
    p.mod = (float*)take((size_t)NL * 8 * 6144 * 4);
    p.list = (int2*)take((size_t)NE * T * 8);
    p.cnt2 = (int*)take((size_t)NE * 1024 * 4);
    p.seg = (int*)take((size_t)NE * 1024 * 16 * 4);
    p.topw = (float*)take((size_t)T * TOPK * 4);
    p.wt_in = (bf16_t*)take((size_t)NL * PJB * D * 2);
    p.wt_out = (bf16_t*)take((size_t)NL * D * D * 2);
    p.lwt = (bf16_t*)take((size_t)NL * RWW * 160 * 2);
    p.wt1 = (bf16_t*)take((size_t)65 * 512 * D * 2);
    p.wt2 = (bf16_t*)take((size_t)65 * D * ED * 2);
    p.xb = (float*)take((size_t)T * D * 4);
    p.h = (bf16_t*)take((size_t)T * D * 2);
    p.vfirst = (bf16_t*)take((size_t)T * RWW * 2);
    const size_t ov = off;
    p.proj = (bf16_t*)take((size_t)T * PJB * 2);
    p.vt = (bf16_t*)take((size_t)T * SBW * 2);
    p.rec = (unsigned char*)take((size_t)T * REC_TB);
    p.g = (bf16_t*)take((size_t)T * RWW * 2);
    p.y = (float*)take((size_t)T * RWW * 4);
    p.cb = (unsigned char*)take((size_t)NBATCH * 6 * (SEQ / 32) * CB_BYTES);
    p.hm = (bf16_t*)(ws + ov);
    p.slab = (unsigned char*)(ws + ov + (size_t)MAXRT * 256 * ED * 2);
    const size_t end_moe = ov + (size_t)MAXRT * 256 * ED * 2 + (size_t)T * (TOPK + 1) * D;
    if (end_moe > off) off = end_moe;
    if (off > ws_size) { fprintf(stderr, "kernel_launch: workspace too small: need %zu, have %zu\n", off, ws_size); return; }

    static int cus = 0;
    if (cus == 0) {
        int dev = 0, n = 0;
        if (hipGetDevice(&dev) != hipSuccess || hipDeviceGetAttribute(&n, hipDeviceAttributeMultiprocessorCount, dev) != hipSuccess || n <= 0) n = 256;
        (void)hipFuncSetAttribute((const void*)k_fused, hipFuncAttributeMaxDynamicSharedMemorySize, LDS_BYTES);
        cus = n;
    }
    (void)hipMemsetAsync(p.bar, 0, 16384 + 256, stream);
    void* args[] = {(void*)&p};
    (void)hipLaunchCooperativeKernel((const void*)k_fused, dim3(cus), dim3(NTHREADS), args, LDS_BYTES, stream);
}
```

```cpp
#include <hip/hip_runtime.h>
#include <stdint.h>
#include <stdio.h>

#define REP_PH -2
#define REP_N 1
#define REP_SEL 15

namespace {

typedef unsigned short bf16_t;
typedef short bf16x8 __attribute__((ext_vector_type(8)));
typedef float f32x4 __attribute__((ext_vector_type(4)));
typedef float f32x2 __attribute__((ext_vector_type(2)));
typedef unsigned u32x4 __attribute__((ext_vector_type(4)));
typedef unsigned u32x2 __attribute__((ext_vector_type(2)));
#define LAS __attribute__((address_space(3)))

constexpr int D = 1024, NBATCH = 8, SEQ = 2048, T = NBATCH * SEQ, NL = 2;
constexpr int RWW = 384, SBW = 384, PLW = 256;
constexpr int RWC = 1280, SBC = 1152, INC = 2688;
constexpr int PJB = 2816;
constexpr int NE = 64, TOPK = 6, ED = 256;
constexpr int MAXRT = 512;
constexpr int NTHREADS = 512;
constexpr float SLAB_SC = 16.f;
constexpr int LDS_STAGE = 141312, LDS_CTL = 4096, LDS_BYTES = LDS_STAGE + LDS_CTL;

struct P {
    const float *x, *c, *w_ada, *b_ada, *w_in, *w_vres, *mu_rw, *mu_vres, *rw_w0, *rw_w2, *rw_a0, *rw_a2,
        *rw_v0, *rw_v2, *rw_g2, *rw_k_k, *rw_k_a, *rw_r_k, *rw_ln_g, *rw_ln_b, *sb_norm_g, *pool_w, *pool_scale,
        *w_out, *w_router, *b_router, *w_eg, *w_eu, *w_ed, *w_sg, *w_su, *w_sd, *g_final;
    float* out;
    unsigned* bar;
    float* mod;
    int* cnt;
    int2* list;
    int* cnt2;
    int* seg;
    float* topw;
    bf16_t* wt_in;
    bf16_t* wt_out;
    bf16_t* lwt;
    bf16_t* wt1;
    bf16_t* wt2;
    float* xb;
    bf16_t* h;
    bf16_t* vfirst;
    bf16_t* proj;
    bf16_t* vt;
    unsigned char* rec;
    unsigned char* cb;
    bf16_t* g;
    bf16_t* y;
    bf16_t* hm;
    unsigned char* slab;
};

__device__ __forceinline__ int opaque(int x) { asm volatile("" : "+v"(x)); return x; }
__device__ __forceinline__ float dpp_add16(float x) {
    x += __builtin_bit_cast(float, __builtin_amdgcn_update_dpp(0, __builtin_bit_cast(int, x), 0xB1, 0xF, 0xF, true));
    x += __builtin_bit_cast(float, __builtin_amdgcn_update_dpp(0, __builtin_bit_cast(int, x), 0x4E, 0xF, 0xF, true));
    x += __builtin_bit_cast(float, __builtin_amdgcn_update_dpp(0, __builtin_bit_cast(int, x), 0x141, 0xF, 0xF, true));
    x += __builtin_bit_cast(float, __builtin_amdgcn_update_dpp(0, __builtin_bit_cast(int, x), 0x140, 0xF, 0xF, true));
    return x;
}
__device__ __forceinline__ float wave_sum(float v) {
    v = dpp_add16(v);
    const int vi = __builtin_bit_cast(int, v);
    return (__builtin_bit_cast(float, __builtin_amdgcn_readlane(vi, 0)) + __builtin_bit_cast(float, __builtin_amdgcn_readlane(vi, 16)))
         + (__builtin_bit_cast(float, __builtin_amdgcn_readlane(vi, 32)) + __builtin_bit_cast(float, __builtin_amdgcn_readlane(vi, 48)));
}
__device__ __forceinline__ unsigned pf_lines(const void* p, int nbytes, int lane) {
    unsigned acc = 0u;
    for (int off = lane * 128; off < nbytes; off += 8192) acc += *(const unsigned*)((const char*)p + off);
    return acc;
}
__device__ __forceinline__ void pf_done(unsigned v) { asm volatile("" :: "v"(v)); }
__device__ __forceinline__ float sigmoidf_(float x) { return 1.f / (1.f + __expf(-x)); }
__device__ __forceinline__ float softplusf_(float x) { return fmaxf(x, 0.f) + __logf(1.f + __expf(-fabsf(x))); }
__device__ __forceinline__ float siluf_(float x) { return x / (1.f + __expf(-x)); }
__device__ __forceinline__ unsigned f2bf_sw(float f) { unsigned u = __builtin_bit_cast(unsigned, f); return (u + 0x7fffu + ((u >> 16) & 1u)) >> 16; }
__device__ __forceinline__ unsigned pk2_sw(float lo, float hi) { return f2bf_sw(lo) | (f2bf_sw(hi) << 16); }
typedef __bf16 bf16x2_t __attribute__((ext_vector_type(2)));
__device__ __forceinline__ unsigned cvtpk(float lo, float hi) { const f32x2 v = {lo, hi}; const bf16x2_t b = __builtin_convertvector(v, bf16x2_t); return __builtin_bit_cast(unsigned, b); }
__device__ __forceinline__ bf16x8 mk8(unsigned a, unsigned b, unsigned c, unsigned d) { return __builtin_bit_cast(bf16x8, (u32x4){a, b, c, d}); }
__device__ __forceinline__ unsigned pk2(float lo, float hi) { return cvtpk(lo, hi); }
__device__ __forceinline__ unsigned f2bf(float f) { return cvtpk(f, 0.f) & 0xffffu; }
__device__ __forceinline__ float bf2f(bf16_t h) { return __builtin_bit_cast(float, (unsigned)h << 16); }
__device__ __forceinline__ float bflo(unsigned u) { return __builtin_bit_cast(float, u << 16); }
__device__ __forceinline__ float bfhi(unsigned u) { return __builtin_bit_cast(float, u & 0xffff0000u); }

namespace pg8 {
constexpr int BM = 256, BK = 64, HALF = 128, HTB = HALF * BK * 2, STAGE_BYTES = 8 * HTB;
__device__ __forceinline__ int lds_byte(int r, int c) { const int st = (r >> 4) * 2 + (c >> 5), rr = r & 15, cc = c & 31, ob = rr * 64 + cc * 2; return st * 1024 + (ob ^ (((ob >> 9) & 1) << 5)); }
__device__ __forceinline__ void stage_rc(int b, int& R, int& C) { const int st = b / 1024, sb = b % 1024, swz = sb ^ (((sb >> 9) & 1) << 5); R = (st >> 1) * 16 + swz / 64; C = (st & 1) * 32 + (swz % 64) / 2; }
__device__ __forceinline__ int perm32(int rho) { const int n = rho >> 4, i = rho & 15; return 8 * (i >> 2) + 4 * n + (i & 3); }

struct Unit { int pm, pn, e, mt; };

template <class Epi, class Sched, bool ALIGN_EPI, bool SP2>
__device__ __forceinline__ void gemm_phase(LAS unsigned char* lds, const int K, const Sched& S, const Epi& E) {
    const int tid = opaque(threadIdx.x), wid = __builtin_amdgcn_readfirstlane(tid >> 6), lane = tid & 63, wr = wid >> 2, wc = wid & 3, fr = lane & 15, fq = lane >> 4;
    const int nt = K / BK;
    unsigned voffA[2], voffB[2];
#pragma unroll
    for (int i = 0; i < 2; ++i) { int R, C; stage_rc(tid * 16 + i * 8192, R, C); const int Rb = Epi::PERM ? ((R & ~31) + perm32(R & 31)) : R;
        voffA[i] = Sched::GATHER ? (unsigned)(C * 2) : (unsigned)(R * K + C) * 2u; voffB[i] = (unsigned)(Rb * K + C) * 2u; }
    const size_t kstep = (size_t)(BK * 2);
    const size_t hstep = (size_t)HALF * K * 2;
    const unsigned ldsw = (unsigned)wid * 1024u;
    const int aoff = lds_byte(wr * 64 + fr, fq * 8), boff = lds_byte(wc * 32 + fr, fq * 8);
#define PG8_SA(b, h) (((b) * 2 + (h)) * HTB)
#define PG8_SB(b, h) ((4 + (b) * 2 + (h)) * HTB)
#define PG8_STAGE(bufoff, gbase, voff) do { _Pragma("unroll") for (int _i = 0; _i < 2; ++_i) \
        __builtin_amdgcn_global_load_lds((const unsigned*)((const char*)(gbase) + (voff)[_i]), (LAS unsigned*)(lds + (bufoff) + ldsw + _i * 8192), 16, 0, 0); } while (0)
#define PG8_LDA(dst, b, h) do { _Pragma("unroll") for (int m = 0; m < 4; ++m) _Pragma("unroll") for (int k = 0; k < 2; ++k) dst[m][k] = *(const LAS bf16x8*)(lds + PG8_SA(b, h) + aoff + m * 2048 + k * 1024); } while (0)
#define PG8_LDB(dst, b, h) do { _Pragma("unroll") for (int n = 0; n < 2; ++n) _Pragma("unroll") for (int k = 0; k < 2; ++k) dst[n][k] = *(const LAS bf16x8*)(lds + PG8_SB(b, h) + boff + n * 2048 + k * 1024); } while (0)
#define PG8_MMA(ai, bj, At, Bt) do { __builtin_amdgcn_s_setprio(1); _Pragma("unroll") for (int m = 0; m < 4; ++m) _Pragma("unroll") for (int n = 0; n < 2; ++n) _Pragma("unroll") for (int k = 0; k < 2; ++k) \
        acc[ai][bj][m][n] = __builtin_amdgcn_mfma_f32_16x16x32_bf16(Bt[n][k], At[m][k], acc[ai][bj][m][n], 0, 0, 0); __builtin_amdgcn_s_setprio(0); } while (0)
#define PG8_WAIT_V(n) asm volatile("s_waitcnt vmcnt(" #n ")" ::: "memory")
#define PG8_WAIT_L(n) asm volatile("s_waitcnt lgkmcnt(" #n ")" ::: "memory")
#define PG8_BAR __builtin_amdgcn_s_barrier()
#define PG8_SCHED __builtin_amdgcn_sched_barrier(0)
    Unit cur, nxt; int ui = 0;
    if (!S.next(0, cur)) return;
    f32x4 acc[2][2][4][2];
#pragma unroll
    for (int a = 0; a < 2; ++a)
#pragma unroll
        for (int b = 0; b < 2; ++b)
#pragma unroll
            for (int m = 0; m < 4; ++m)
#pragma unroll
                for (int n = 0; n < 2; ++n) acc[a][b][m][n] = (f32x4){0.f, 0.f, 0.f, 0.f};
    bf16x8 At[4][2], B0[2][2], B1[2][2];
    const char* cA = S.a_base(cur); const char* cB = S.b_base(cur);
    unsigned pk[2] = {0u, 0u}, npk[2] = {0u, 0u};
    if constexpr (Sched::GATHER) S.a_tok(cur, tid, pk);
    const unsigned k2 = (unsigned)K * 2u;
#define PG8_STAGE_A(bufoff, gbase, hh, PK) do { if constexpr (Sched::GATHER) { unsigned _v[2]; _v[0] = (((PK)[0] >> (16 * (hh))) & 0xffffu) * k2 + voffA[0]; _v[1] = (((PK)[1] >> (16 * (hh))) & 0xffffu) * k2 + voffA[1]; \
        PG8_STAGE(bufoff, gbase, _v); } else { PG8_STAGE(bufoff, (gbase) + (hh) * hstep, voffA); } } while (0)
    static_assert(SP2, "only the SP2 loop is kept");
    PG8_STAGE(PG8_SB(0, 0), cB, voffB); PG8_STAGE(PG8_SB(0, 1), cB + hstep, voffB); PG8_STAGE_A(PG8_SA(0, 0), cA, 0, pk); PG8_STAGE_A(PG8_SA(0, 1), cA, 1, pk);
    if (wr == 1) PG8_BAR;
    PG8_WAIT_V(2); PG8_BAR;
    PG8_STAGE(PG8_SB(1, 0), cB + kstep, voffB); PG8_STAGE_A(PG8_SA(1, 0), cA + kstep, 0, pk); PG8_STAGE(PG8_SB(1, 1), cB + hstep + kstep, voffB);
    PG8_WAIT_V(6); PG8_BAR;
    for (;;) {
        const bool has_next = S.next(ui + 1, nxt);
        const char* nA = has_next ? S.a_base(nxt) : cA; const char* nB = has_next ? S.b_base(nxt) : cB;
        if constexpr (Sched::GATHER) { if (has_next) S.a_tok(nxt, tid, npk); else { npk[0] = pk[0]; npk[1] = pk[1]; } }
#pragma unroll 1
        for (int t = 0; t < nt; t += 2) {
            const bool last = (t == nt - 2);
            const char* a1 = cA + (size_t)(t + 1) * kstep;
            const char* a2 = last ? nA : cA + (size_t)(t + 2) * kstep; const char* b2 = last ? nB : cB + (size_t)(t + 2) * kstep;
            const char* a3 = a2 + kstep; const char* b3 = b2 + kstep;
            unsigned sp[2]; sp[0] = last ? npk[0] : pk[0]; sp[1] = last ? npk[1] : pk[1];
            PG8_LDB(B0, 0, 0); PG8_LDB(B1, 0, 1); PG8_SCHED; PG8_LDA(At, 0, 0); PG8_STAGE_A(PG8_SA(1, 1), a1, 1, pk);
            PG8_WAIT_V(8); PG8_WAIT_L(0); PG8_BAR; PG8_MMA(0, 0, At, B0); PG8_MMA(0, 1, At, B1); PG8_BAR; PG8_SCHED;
            PG8_LDA(At, 0, 1); PG8_STAGE(PG8_SB(0, 0), b2, voffB); PG8_STAGE(PG8_SB(0, 1), b2 + hstep, voffB); PG8_STAGE_A(PG8_SA(0, 0), a2, 0, sp);
            PG8_WAIT_V(8); PG8_WAIT_L(0); PG8_BAR; PG8_MMA(1, 0, At, B0); PG8_MMA(1, 1, At, B1); PG8_BAR; PG8_SCHED;
            PG8_LDB(B0, 1, 0); PG8_LDB(B1, 1, 1); PG8_SCHED; PG8_LDA(At, 1, 0); PG8_STAGE_A(PG8_SA(0, 1), a2, 1, sp);
            PG8_WAIT_V(8); PG8_WAIT_L(0); PG8_BAR; PG8_MMA(0, 0, At, B0); PG8_MMA(0, 1, At, B1); PG8_BAR; PG8_SCHED;
            PG8_LDA(At, 1, 1); PG8_STAGE(PG8_SB(1, 0), b3, voffB); PG8_STAGE(PG8_SB(1, 1), b3 + hstep, voffB); PG8_STAGE_A(PG8_SA(1, 0), a3, 0, sp);
            PG8_WAIT_V(8); PG8_WAIT_L(0); PG8_BAR; PG8_MMA(1, 0, At, B0); PG8_MMA(1, 1, At, B1); PG8_BAR; PG8_SCHED;
        }
        if constexpr (ALIGN_EPI) { if (wr == 0) PG8_BAR; }
        { const int t2 = opaque(threadIdx.x), w2 = __builtin_amdgcn_readfirstlane(t2 >> 6), l2 = t2 & 63; E(acc, cur, w2 >> 2, w2 & 3, l2 & 15, l2 >> 4); }
        if (!has_next) break;
#pragma unroll
        for (int a = 0; a < 2; ++a)
#pragma unroll
            for (int b = 0; b < 2; ++b)
#pragma unroll
                for (int m = 0; m < 4; ++m)
#pragma unroll
                    for (int n = 0; n < 2; ++n) acc[a][b][m][n] = (f32x4){0.f, 0.f, 0.f, 0.f};
        cur = nxt; cA = nA; cB = nB; ++ui;
        pk[0] = npk[0]; pk[1] = npk[1];
        if constexpr (ALIGN_EPI) { if (wr == 1) PG8_BAR; }
    }
    PG8_WAIT_V(0);
    if constexpr (!ALIGN_EPI) { if (wr == 0) PG8_BAR; }
    PG8_BAR;
#undef PG8_SA
#undef PG8_SB
#undef PG8_STAGE
#undef PG8_STAGE_A
#undef PG8_LDA
#undef PG8_LDB
#undef PG8_MMA
#undef PG8_WAIT_V
#undef PG8_WAIT_L
#undef PG8_BAR
#undef PG8_SCHED
}

struct DenseOrder {
    const bf16_t* A; const bf16_t* Bt; int K; int nM, nN, nwg, G, c;
    __device__ __forceinline__ void init(const bf16_t* A_, const bf16_t* Bt_, int M, int N, int K_, int G_, int c_) { A = A_; Bt = Bt_; K = K_; nM = M / BM; nN = N / BM; nwg = nM * nN; G = G_; c = c_; }
    __device__ __forceinline__ bool next(int i, Unit& u) const {
        const long L = (long)i * G + c; if (L >= nwg) return false;
        int wgid = (int)L; { const int q = nwg / 8, r = nwg % 8, xcd = wgid % 8, off = wgid / 8; wgid = (xcd < r ? xcd * (q + 1) : r * (q + 1) + (xcd - r) * q) + off; }
        const int nig = 8 * nN, gid = wgid / nig, fm = gid * 8, gsz = (nM - fm) < 8 ? (nM - fm) : 8;
        u.pm = fm + ((wgid % nig) % gsz); u.pn = (wgid % nig) / gsz; u.e = 0; u.mt = 0; return true;
    }
    __device__ __forceinline__ const char* a_base(const Unit& u) const { return (const char*)A + (size_t)u.pm * BM * K * 2; }
    __device__ __forceinline__ const char* b_base(const Unit& u) const { return (const char*)Bt + (size_t)u.pn * BM * K * 2; }
    static constexpr bool GATHER = false;
    __device__ __forceinline__ void a_tok(const Unit&, int, unsigned (&)[2]) const {}
};

template <bool GATHER_>
struct MoeOrder {
    static constexpr bool GATHER = GATHER_;
    const LAS int* tstart;
    const LAS int* cnts;
    const LAS int* tmap;
    const int2* list;
    const bf16_t* A;
    const bf16_t* Bt;
    int K, N, lognpn, G, c;
    __device__ __forceinline__ bool next(int i, Unit& u) const {
        const int L = i * G + c; const int total = __builtin_amdgcn_readfirstlane(tstart[65]) << lognpn; if (L >= total) return false;
        const int rt = L >> lognpn; u.pn = L & ((1 << lognpn) - 1); u.pm = rt;
        const int e = __builtin_amdgcn_readfirstlane(tmap[rt]);
        u.e = e; u.mt = rt - __builtin_amdgcn_readfirstlane(tstart[e]); return true;
    }
    __device__ __forceinline__ const char* a_base(const Unit& u) const { return GATHER ? (const char*)A : (const char*)A + (size_t)u.pm * BM * K * 2; }
    __device__ __forceinline__ const char* b_base(const Unit& u) const { return (const char*)Bt + ((size_t)u.e * N + (size_t)u.pn * BM) * K * 2; }
    __device__ __forceinline__ void a_tok(const Unit& u, int tid, unsigned (&pkv)[2]) const {
        const int ce = cnts[u.e];
#pragma unroll
        for (int i = 0; i < 2; ++i) {
            int R, C; stage_rc(tid * 16 + i * 8192, R, C); (void)C;
            unsigned v = 0u;
#pragma unroll
            for (int hh = 0; hh < 2; ++hh) {
                const int idx = u.mt * BM + hh * HALF + R;
                int tok = 0;
                if (idx < ce) tok = (u.e < NE) ? (list[(size_t)u.e * T + idx].x / TOPK) : idx;
                v |= (unsigned)tok << (16 * hh);
            }
            pkv[i] = v;
        }
    }
};

struct EpiProj {
    static constexpr bool PERM = true;
    bf16_t* O; bf16_t* vt;
    __device__ __forceinline__ void operator()(const f32x4 (&acc)[2][2][4][2], const Unit& u, int wr, int wc, int fr, int fq) const {
        const int row0 = u.pm * BM + wr * 64 + fr, col0 = u.pn * BM + wc * 32 + 8 * fq;
#pragma unroll
        for (int bj = 0; bj < 2; ++bj) {
            const bool isv = (u.pn == 8) || (u.pn == 9 && bj == 0);
            if (!isv) {
#pragma unroll
                for (int ai = 0; ai < 2; ++ai)
#pragma unroll
                    for (int m = 0; m < 4; ++m) { bf16_t* rowp = O + (size_t)(row0 + ai * HALF + m * 16) * PJB + col0 + bj * HALF;
                        const f32x4 v0 = acc[ai][bj][m][0], v1 = acc[ai][bj][m][1];
                        u32x4 w; w.x = pk2(v0[0], v0[1]); w.y = pk2(v0[2], v0[3]); w.z = pk2(v1[0], v1[1]); w.w = pk2(v1[2], v1[3]);
                        *(u32x4*)rowp = w; }
            } else {
                const int vc0 = col0 + bj * HALF - 2048;
#pragma unroll
                for (int ai = 0; ai < 2; ++ai)
#pragma unroll
                    for (int m = 0; m < 4; ++m) { const int row = row0 + ai * HALF + m * 16; const int b = row / SEQ, s = row % SEQ;
                        bf16_t* base = vt + ((size_t)b * SBW + vc0) * SEQ + s;
#pragma unroll
                        for (int n = 0; n < 2; ++n)
#pragma unroll
                            for (int j = 0; j < 4; ++j) base[(size_t)(4 * n + j) * SEQ] = (bf16_t)f2bf(acc[ai][bj][m][n][j]); }
            }
        }
    }
};
struct EpiOut {
    static constexpr bool PERM = false;
    const float* xin; float* xo; const float* gt;
    __device__ __forceinline__ void operator()(const f32x4 (&acc)[2][2][4][2], const Unit& u, int wr, int wc, int fr, int fq) const {
        const int row0 = u.pm * BM + wr * 64 + fr, col0 = u.pn * BM + wc * 32 + 4 * fq;
#pragma unroll
        for (int ai = 0; ai < 2; ++ai)
#pragma unroll
            for (int m = 0; m < 4; ++m) { const int row = row0 + ai * HALF + m * 16; const float* gr = gt + (size_t)(row / SEQ) * 6144;
#pragma unroll
                for (int bj = 0; bj < 2; ++bj)
#pragma unroll
                    for (int n = 0; n < 2; ++n) { const int col = col0 + bj * HALF + 16 * n;
                        const f32x4 xi = *(const f32x4*)(xin + (size_t)row * D + col); const f32x4 gg = *(const f32x4*)(gr + col);
                        *(f32x4*)(xo + (size_t)row * D + col) = xi + gg * acc[ai][bj][m][n]; } }
    }
};
struct EpiExp1 {
    static constexpr bool PERM = true;
    bf16_t* hm;
    __device__ __forceinline__ void operator()(const f32x4 (&acc)[2][2][4][2], const Unit& u, int wr, int wc, int fr, int fq) const {
        const int row0 = u.pm * BM + wr * 64 + fr, col0 = u.pn * HALF + wc * 32 + 8 * fq;
#pragma unroll
        for (int ai = 0; ai < 2; ++ai)
#pragma unroll
            for (int m = 0; m < 4; ++m) { bf16_t* rowp = hm + (size_t)(row0 + ai * HALF + m * 16) * ED + col0;
                float o[8];
#pragma unroll
                for (int n = 0; n < 2; ++n)
#pragma unroll
                    for (int j = 0; j < 4; ++j) o[n * 4 + j] = siluf_(acc[ai][0][m][n][j]) * acc[ai][1][m][n][j];
                u32x4 w; w.x = pk2(o[0], o[1]); w.y = pk2(o[2], o[3]); w.z = pk2(o[4], o[5]); w.w = pk2(o[6], o[7]);
                *(u32x4*)rowp = w; }
    }
};
struct EpiExp2 {
    static constexpr bool PERM = true;
    unsigned char* slab; const int2* list; const LAS int* cnts;
    __device__ __forceinline__ static unsigned pack4(const f32x4& v, float sc) {
        const float a = fminf(fmaxf(v[0] * sc, -448.f), 448.f), b = fminf(fmaxf(v[1] * sc, -448.f), 448.f), c = fminf(fmaxf(v[2] * sc, -448.f), 448.f), d = fminf(fmaxf(v[3] * sc, -448.f), 448.f);
        int w = __builtin_amdgcn_cvt_pk_fp8_f32(a, b, 0, false);
        w = __builtin_amdgcn_cvt_pk_fp8_f32(c, d, w, true);
        return (unsigned)w;
    }
    __device__ __forceinline__ void operator()(const f32x4 (&acc)[2][2][4][2], const Unit& u, int wr, int wc, int fr, int fq) const {
        const int col0 = u.pn * BM + wc * 32 + 8 * fq; const int ce = cnts[u.e];
#pragma unroll
        for (int ai = 0; ai < 2; ++ai)
#pragma unroll
            for (int m = 0; m < 4; ++m) { const int idx = u.mt * BM + ai * HALF + wr * 64 + m * 16 + fr;
                if (idx < ce) {
                    int row; float sc;
                    if (u.e < NE) { const int2 ri = list[(size_t)u.e * T + idx]; row = ri.x; sc = __int_as_float(ri.y) * SLAB_SC; }
                    else { row = T * TOPK + idx; sc = SLAB_SC; }
                    unsigned char* rowp = slab + (size_t)row * D + col0;
#pragma unroll
                    for (int bj = 0; bj < 2; ++bj) *(u32x2*)(rowp + bj * HALF) = (u32x2){pack4(acc[ai][bj][m][0], sc), pack4(acc[ai][bj][m][1], sc)};
                } }
    }
};
}

__device__ __forceinline__ void st_mod(const P& p, int item, LAS float* L  ) {
    const int tid = opaque(threadIdx.x), wave = tid >> 6, lane = tid & 63;
    const int l = item / 96, j0 = (item % 96) * 64;
    for (int i = tid; i < 8 * 1024; i += NTHREADS) L[i] = siluf_(p.c[i]);
    __syncthreads();
    float acc[8];
#pragma unroll
    for (int b = 0; b < 8; ++b) acc[b] = 0.f;
    const float* w = p.w_ada + ((size_t)l * 1024 + wave * 128) * 6144 + j0 + lane;
#pragma unroll 8
    for (int i = 0; i < 128; ++i) {
        const float wv = w[(size_t)i * 6144];
#pragma unroll
        for (int b = 0; b < 8; ++b) acc[b] += L[b * 1024 + wave * 128 + i] * wv;
    }
    LAS float* red = L + 8 * 1024;
#pragma unroll
    for (int b = 0; b < 8; ++b) red[(wave * 8 + b) * 64 + lane] = acc[b];
    __syncthreads();
    {
        const int b = tid >> 6;
        float s = p.b_ada[l * 6144 + j0 + lane];
#pragma unroll
        for (int wv = 0; wv < 8; ++wv) s += red[(wv * 8 + b) * 64 + lane];
        p.mod[((size_t)l * 8 + b) * 6144 + j0 + lane] = s;
    }
    __syncthreads();
}

constexpr int REC_HB = 912, REC_TB = 6 * REC_HB;
constexpr int CB_S64 = 136, CB_S32 = 80;
constexpr int CB_PHI = 0, CB_RT = CB_PHI + 64 * CB_S64, CB_PSI = CB_RT + 32 * CB_S64, CB_G = CB_PSI + 64 * CB_S32, CB_V = CB_G + 32 * CB_S32, CB_BYTES = 26624;
static_assert(CB_V + 64 * CB_S32 <= CB_BYTES && CB_BYTES % 1024 == 0, "chunk buffer layout");
struct CvtJob { const float* W; bf16_t* WT; int K, N, k0, n0, dst_row0; };
__device__ __forceinline__ void cvt_load(const CvtJob& j, float (&wv)[32], int lane) {
#pragma unroll
    for (int i = 0; i < 32; ++i) wv[i] = j.W[(size_t)(j.k0 + 2 * i + (lane >> 5)) * j.N + j.n0 + (lane & 31)];
}
__device__ __forceinline__ void cvt_store(const CvtJob& j, const float (&wv)[32], LAS float* scr, int lane) {
#pragma unroll
    for (int i = 0; i < 32; ++i) scr[(2 * i + (lane >> 5)) * 33 + (lane & 31)] = wv[i];
    asm volatile("s_waitcnt lgkmcnt(0)" ::: "memory");
    const int c = lane & 7;
#pragma unroll
    for (int q = 0; q < 4; ++q) { const int n = (lane >> 3) + 8 * q; const LAS float* sp = scr + (8 * c) * 33 + n;
        u32x4 o; o.x = pk2(sp[0 * 33], sp[1 * 33]); o.y = pk2(sp[2 * 33], sp[3 * 33]); o.z = pk2(sp[4 * 33], sp[5 * 33]); o.w = pk2(sp[6 * 33], sp[7 * 33]);
        *(u32x4*)(j.WT + (size_t)(j.dst_row0 + n) * j.K + j.k0 + 8 * c) = o; }
    asm volatile("s_waitcnt lgkmcnt(0)" ::: "memory");
}
__device__ __forceinline__ void cvt_item(const float* W, int K, int N, int k0, int n0, bf16_t* WT, int dst_row0, LAS float* scr, int lane) {
    const CvtJob j{W, WT, K, N, k0, n0, dst_row0};
    float wv[32];
    cvt_load(j, wv, lane);
    cvt_store(j, wv, scr, lane);
}
constexpr int CV_IN = 16 * 84, CV_VR = 16, CV_OUT = 16 * 32, CV_DENSE_L = CV_IN + CV_VR + CV_OUT, CV_DENSE = NL * CV_DENSE_L;
__device__ __forceinline__ void cvt_dense_item(const P& p, int it, LAS float* scr, int lane) {
    const int l = it / CV_DENSE_L; int r = it % CV_DENSE_L;
    bf16_t* wti = p.wt_in + (size_t)l * PJB * D;
    if (r < CV_IN) { const int kb = r / 84, nb = r % 84; cvt_item(p.w_in + (size_t)l * D * INC, D, INC, kb * 64, nb * 32, wti, nb * 32, scr, lane); return; }
    r -= CV_IN;
    if (r < CV_VR) {
        if (l == 1) cvt_item(p.w_vres, D, 32, r * 64, 0, wti, INC, scr, lane);
        const int rz0 = (l == 1) ? INC + 32 : INC;
        for (int row = rz0 + (lane >> 3); row < PJB; row += 8) *(u32x4*)(wti + (size_t)row * D + r * 64 + (lane & 7) * 8) = (u32x4){0u, 0u, 0u, 0u};
        return;
    }
    r -= CV_VR;
    { const int kb = r / 32, nb = r % 32; cvt_item(p.w_out + (size_t)l * D * D, D, D, kb * 64, nb * 32, p.wt_out + (size_t)l * D * D, nb * 32, scr, lane); }
}
constexpr int CV_EXP_E = 128 + 128 + 128, CV_EXP = 65 * CV_EXP_E;
__device__ __forceinline__ CvtJob cvt_exp_job(const P& p, int l, int it) {
    const int e = it / CV_EXP_E; int r = it % CV_EXP_E;
    if (r < 256) {
        const int which = r >> 7; r &= 127; const int kb = r >> 3, nb = r & 7;
        const float* W = e < NE ? (which ? p.w_eu : p.w_eg) + ((size_t)l * NE + e) * D * ED : (which ? p.w_su : p.w_sg) + (size_t)l * D * ED;
        const int n0 = nb * 32, pn = n0 >> 7;
        return CvtJob{W, p.wt1 + (size_t)e * 512 * D, D, ED, kb * 64, n0, pn * 256 + which * 128 + (n0 & 127)};
    } else {
        r -= 256; const int kb = r >> 5, nb = r & 31;
        const float* W = e < NE ? p.w_ed + ((size_t)l * NE + e) * ED * D : p.w_sd + (size_t)l * ED * D;
        return CvtJob{W, p.wt2 + (size_t)e * D * ED, ED, D, kb * 64, nb * 32, nb * 32};
    }
}
__device__ __forceinline__ void cvt_exp_stream(const P& p, int l, int first, int stride, int CV_END, LAS float* scr, int lane) {
    if (first >= CV_END) return;
    float wa[32], wb[32];
    CvtJob ja = cvt_exp_job(p, l, first), jb = ja;
    cvt_load(ja, wa, lane);
    for (int it = first; it < CV_END; it += 2 * stride) {
        const bool hb = it + stride < CV_END;
        if (hb) { jb = cvt_exp_job(p, l, it + stride); cvt_load(jb, wb, lane); }
        cvt_store(ja, wa, scr, lane);
        if (!hb) break;
        const bool ha = it + 2 * stride < CV_END;
        if (ha) { ja = cvt_exp_job(p, l, it + 2 * stride); cvt_load(ja, wa, lane); }
        cvt_store(jb, wb, scr, lane);
        if (!ha) break;
    }
}

__device__ __forceinline__ void cvt_idle_wave(const P& p, int l, int quota, LAS float* scr, int lane) {
    unsigned* ctr = p.bar + 3600 + l;
    for (int done = 0; done < quota; done += 4) {
        int base = 0;
        if (lane == 0) base = (int)__hip_atomic_fetch_add(ctr, 4u, __ATOMIC_RELAXED, __HIP_MEMORY_SCOPE_AGENT);
        base = __builtin_amdgcn_readfirstlane(base);
        if (base >= CV_EXP) break;
        cvt_exp_stream(p, l, base, 1, min(base + 4, CV_EXP), scr, lane);
    }
}
__device__ __forceinline__ void st_cpre(const P& p, int item, LAS unsigned char* L, int lane_);
constexpr int CP_LDS = 20736;
constexpr int PREP_TOK = 64, PREP_XS = 168;
__device__ __forceinline__ void st_prep(const P& p, int l, int vb0, int vbstride, LAS unsigned char* L) {
    const int tid = opaque(threadIdx.x), wave = __builtin_amdgcn_readfirstlane(tid >> 6), lane = tid & 63, fr = lane & 15, fq = lane >> 4;
    LAS bf16_t* X = (LAS bf16_t*)L;
    for (int vb = vb0; vb < T / PREP_TOK; vb += vbstride) {
        const int t0 = vb * PREP_TOK, s0 = t0 % SEQ;
#pragma unroll 4
        for (int q = 0; q < PREP_TOK * 160 / NTHREADS; ++q) {
            const int it = tid + q * NTHREADS;
            const int tt = it / 160, i = it % 160;
            const int col = (i < 128) ? 1152 + i : INC + (i - 128);
            const float mu = (i < 128) ? p.mu_rw[l * RWC + col] : p.mu_vres[i - 128];
            const bf16_t* u = p.proj + (size_t)(t0 + tt) * PJB + col;
            const float uu = bf2f(u[0]), pv = (s0 + tt) > 0 ? bf2f(u[-PJB]) : 0.f;
            float x = uu + (pv - uu) * mu;
            if (i < 32) x = 1.f - 2.f / (__expf(2.f * x) + 1.f); else if (i >= 64 && i < 128) x = sigmoidf_(x);
            if (i >= 128 && l == 0) x = 0.f;
            X[tt * PREP_XS + i] = (bf16_t)f2bf(x);
        }
        __syncthreads();
        LAS float* iscr = (LAS float*)(L + 6 * CP_LDS + (wave - 6) * 8448);
        if (wave >= 6) cvt_idle_wave(p, l, 16, iscr, lane);
        if (wave < 6) {
            const int hh = wave;
            const int ll = opaque(lane), fr2 = ll & 15, fq2 = ll >> 4;
            const bf16_t* lw = p.lwt + ((size_t)l * RWW + hh * 64) * 160;
#pragma unroll 1
            for (int mt = 0; mt < 4; ++mt) {
                const int tb = t0 + 16 * mt + 4 * fq2, sb = s0 + 16 * mt + 4 * fq2;
                bf16_t rr[4][5], kr[4][5], vr[4][5], vf[4][4];
#pragma unroll
                for (int nt = 0; nt < 4; ++nt) {
                    const bf16_t* u = p.proj + (size_t)tb * PJB + hh * 64 + 16 * nt + fr2;
#pragma unroll
                    for (int rw = 0; rw < 5; ++rw) {
                        const bool ok = (rw > 0) || (sb > 0);
                        rr[nt][rw] = ok ? u[(ptrdiff_t)(rw - 1) * PJB] : (bf16_t)0; kr[nt][rw] = ok ? u[(ptrdiff_t)(rw - 1) * PJB + 384] : (bf16_t)0; vr[nt][rw] = ok ? u[(ptrdiff_t)(rw - 1) * PJB + 768] : (bf16_t)0;
                    }
#pragma unroll
                    for (int rg = 0; rg < 4; ++rg) vf[nt][rg] = (l == 1) ? p.vfirst[(size_t)(tb + rg) * RWW + hh * 64 + 16 * nt + fr2] : (bf16_t)0;
                }
                const LAS bf16_t* xa = X + (16 * mt + fr2) * PREP_XS + 8 * fq2;
                const bf16x8 Aw = *(const LAS bf16x8*)xa, Aa = *(const LAS bf16x8*)(xa + 32), Av = *(const LAS bf16x8*)(xa + 128);
                f32x4 aw[4], aa[4], av[4];
#pragma unroll
                for (int nt = 0; nt < 4; ++nt) {
                    const bf16_t* q = lw + (16 * nt + fr2) * 160 + 8 * fq2;
                    aw[nt] = __builtin_amdgcn_mfma_f32_16x16x32_bf16(Aw, *(const bf16x8*)q, (f32x4){0.f, 0.f, 0.f, 0.f}, 0, 0, 0);
                    aa[nt] = __builtin_amdgcn_mfma_f32_16x16x32_bf16(Aa, *(const bf16x8*)(q + 32), (f32x4){0.f, 0.f, 0.f, 0.f}, 0, 0, 0);
                    av[nt] = __builtin_amdgcn_mfma_f32_16x16x32_bf16(Av, *(const bf16x8*)(q + 128), (f32x4){0.f, 0.f, 0.f, 0.f}, 0, 0, 0);
                }
                float ksh[4][4], ss[4] = {0.f, 0.f, 0.f, 0.f};
#pragma unroll
                for (int nt = 0; nt < 4; ++nt) {
                    const int c = hh * 64 + 16 * nt + fr2;
                    const float muk = p.mu_rw[l * RWC + 384 + c], kkc = p.rw_k_k[l * RWW + c];
#pragma unroll
                    for (int rg = 0; rg < 4; ++rg) {
                        const float kc = bf2f(kr[nt][rg + 1]), kp = bf2f(kr[nt][rg]);
                        const float k = kc + (kp - kc) * muk;
                        ksh[nt][rg] = k; ss[rg] += (k * kkc) * (k * kkc);
                    }
                }
                float inrm[4], rkp[4] = {0.f, 0.f, 0.f, 0.f};
#pragma unroll
                for (int rg = 0; rg < 4; ++rg) inrm[rg] = 1.f / fmaxf(sqrtf(dpp_add16(ss[rg])), 1e-12f);
#pragma unroll
                for (int nt = 0; nt < 4; ++nt) {
                    const int c = hh * 64 + 16 * nt + fr2;
                    const float w0 = p.rw_w0[l * RWW + c], a0 = p.rw_a0[l * RWW + c], v0 = (l == 1) ? p.rw_v0[c] : 0.f;
                    const float kkc = p.rw_k_k[l * RWW + c], kac = p.rw_k_a[l * RWW + c], rkc = p.rw_r_k[l * RWW + c];
                    const float mur = p.mu_rw[l * RWC + c], muv = p.mu_rw[l * RWC + 768 + c];
#pragma unroll
                    for (int rg = 0; rg < 4; ++rg) {
                        const int t = tb + rg;
                        const float rc_ = bf2f(rr[nt][rg + 1]), rp = bf2f(rr[nt][rg]), vc = bf2f(vr[nt][rg + 1]), vp = bf2f(vr[nt][rg]);
                        const float r = rc_ + (rp - rc_) * mur; float v = vc + (vp - vc) * muv; const float k = ksh[nt][rg];
                        const float wlog = -softplusf_(-(aw[nt][rg] + w0)) - 0.5f;
                        const float decay = __expf(-__expf(wlog));
                        const float a = sigmoidf_(aa[nt][rg] + a0);
                        if (l == 1) { const float vg = sigmoidf_(av[nt][rg] + v0); v = v + (bf2f(vf[nt][rg]) - v) * vg; }
                        else p.vfirst[(size_t)t * RWW + c] = (bf16_t)f2bf(v);
                        const float kk = k * kkc * inrm[rg];
                        const float bq = kk * a, k2 = k * (1.f + (a - 1.f) * kac);
                        unsigned char* rc = p.rec + (size_t)t * REC_TB + hh * REC_HB;
                        *(float*)(rc + (16 * nt + fr2) * 4) = decay;
                        bf16_t* rb = (bf16_t*)(rc + 256) + 16 * nt + fr2;
                        rb[0] = (bf16_t)f2bf(-kk); rb[64] = (bf16_t)f2bf(bq); rb[128] = (bf16_t)f2bf(k2); rb[192] = (bf16_t)f2bf(decay * r); rb[256] = (bf16_t)f2bf(v);
                        rkp[rg] += r * k2 * rkc;
                    }
                }
#pragma unroll
                for (int rg = 0; rg < 4; ++rg) { const float rk = dpp_add16(rkp[rg]); if (fr2 == 0) *(float*)(p.rec + (size_t)(tb + rg) * REC_TB + hh * REC_HB + 896) = rk; }
                {
                    const bf16x8 Ag0 = *(const LAS bf16x8*)(xa + 64), Ag1 = *(const LAS bf16x8*)(xa + 96);
#pragma unroll
                    for (int nt = 0; nt < 4; ++nt) {
                        const bf16_t* q = lw + (16 * nt + fr2) * 160 + 64 + 8 * fq2;
                        f32x4 ag = __builtin_amdgcn_mfma_f32_16x16x32_bf16(Ag0, *(const bf16x8*)q, (f32x4){0.f, 0.f, 0.f, 0.f}, 0, 0, 0);
                        ag = __builtin_amdgcn_mfma_f32_16x16x32_bf16(Ag1, *(const bf16x8*)(q + 32), ag, 0, 0, 0);
#pragma unroll
                        for (int rg = 0; rg < 4; ++rg) p.g[(size_t)(tb + rg) * RWW + hh * 64 + 16 * nt + fr2] = (bf16_t)f2bf(ag[rg]);
                    }
                }
            }
        }
        __syncthreads();
        if (wave < 6) {
            const int b = t0 / SEQ, ch0 = s0 / 32;
#pragma unroll 1
            for (int q = 0; q < 2; ++q) st_cpre(p, ((b * 6 + wave) * 64) + ch0 + q, L + wave * CP_LDS, lane);
        } else cvt_idle_wave(p, l, 20, iscr, lane);
        __syncthreads();
    }
}

typedef float f32x16 __attribute__((ext_vector_type(16)));
__device__ __forceinline__ bf16x8 acc_frag(const f32x16& x, int ks) {
    return ks == 0 ? mk8(cvtpk(x[0], x[1]), cvtpk(x[2], x[3]), cvtpk(x[4], x[5]), cvtpk(x[6], x[7])) : mk8(cvtpk(x[8], x[9]), cvtpk(x[10], x[11]), cvtpk(x[12], x[13]), cvtpk(x[14], x[15]));
}
__device__ __forceinline__ bf16x8 lds_perm_frag(const LAS unsigned char* rowp, int ks, int hf) {
    const u32x2 g0 = *(const LAS u32x2*)(rowp + (16 * ks + 4 * hf) * 2), g1 = *(const LAS u32x2*)(rowp + (16 * ks + 4 * hf + 8) * 2);
    return mk8(g0.x, g0.y, g1.x, g1.y);
}
__device__ __forceinline__ void st_cpre(const P& p, int item, LAS unsigned char* L, int lane_) {
    const int lane = opaque(lane_);
    const int ch = item & 63, bh = item >> 6, b = bh / 6, hh = bh % 6;
    const int r = lane & 31, hf = lane >> 5;
    const unsigned char* rec0 = p.rec + ((size_t)(b * SEQ + ch * 32)) * REC_TB + hh * REC_HB;
    unsigned char* cbo = p.cb + (size_t)item * CB_BYTES;
    LAS unsigned char* AbarT = L; LAS unsigned char* RbarT = L + 4096; LAS unsigned char* Bbar = L + 8192; LAS unsigned char* Kbar = L + 12288; LAS unsigned char* BbarT = L + 16384;
    LAS float* PCv = (LAS float*)(L + 20480);
    float Y[32];
    {
        float Pc = 1.f;
        unsigned bt[16], vtw[16];
#pragma unroll
        for (int t8 = 0; t8 < 32; t8 += 16) {
            float wv[16]; bf16_t av[16], bv[16], kv[16], qv[16], vv[16];
#pragma unroll
            for (int j = 0; j < 16; ++j) {
                const unsigned char* rp = rec0 + (size_t)(t8 + j) * REC_TB;
                wv[j] = *(const float*)(rp + lane * 4);
                const bf16_t* hb = (const bf16_t*)(rp + 256) + lane;
                av[j] = hb[0]; bv[j] = hb[64]; kv[j] = hb[128]; qv[j] = hb[192]; vv[j] = hb[256];
            }
#pragma unroll
            for (int j = 0; j < 16; ++j) {
                const int t = t8 + j;
                const float Pm = Pc; Pc *= wv[j]; const float inv = 1.f / Pc;
                const float ab = bf2f(av[j]) * Pm, rb = bf2f(qv[j]) * Pm, bb = bf2f(bv[j]) * inv, kb = bf2f(kv[j]) * inv;
                Y[t] = ab;
                *(LAS bf16_t*)(AbarT + (t * 64 + lane) * 2) = (bf16_t)f2bf(ab);
                *(LAS bf16_t*)(RbarT + (t * 64 + lane) * 2) = (bf16_t)f2bf(rb);
                *(LAS bf16_t*)(Bbar + (t * 64 + lane) * 2) = (bf16_t)f2bf(bb);
                *(LAS bf16_t*)(Kbar + (t * 64 + lane) * 2) = (bf16_t)f2bf(kb);
                if (t & 1) { bt[t >> 1] |= f2bf(bb) << 16; vtw[t >> 1] |= (unsigned)vv[j] << 16; } else { bt[t >> 1] = f2bf(bb); vtw[t >> 1] = (unsigned)vv[j]; }
            }
            asm volatile("" ::: "memory");
        }
        PCv[lane] = Pc;
#pragma unroll
        for (int q = 0; q < 4; ++q) {
            *(LAS u32x4*)(BbarT + lane * 64 + q * 16) = (u32x4){bt[4 * q], bt[4 * q + 1], bt[4 * q + 2], bt[4 * q + 3]};
            *(u32x4*)(cbo + CB_V + lane * CB_S32 + q * 16) = (u32x4){vtw[4 * q], vtw[4 * q + 1], vtw[4 * q + 2], vtw[4 * q + 3]};
        }
    }
    asm volatile("s_waitcnt lgkmcnt(0)" ::: "memory");
    f32x16 Lab, Lak, Mbr, Mkr;
#pragma unroll
    for (int i = 0; i < 16; ++i) { Lab[i] = 0.f; Lak[i] = 0.f; Mbr[i] = 0.f; Mkr[i] = 0.f; }
#pragma unroll
    for (int ks = 0; ks < 4; ++ks) {
        const int off = (r * 64 + 16 * ks + 8 * hf) * 2;
        const bf16x8 fb = *(const LAS bf16x8*)(Bbar + off), fk = *(const LAS bf16x8*)(Kbar + off), fa = *(const LAS bf16x8*)(AbarT + off), fr = *(const LAS bf16x8*)(RbarT + off);
        Lab = __builtin_amdgcn_mfma_f32_32x32x16_bf16(fb, fa, Lab, 0, 0, 0);
        Lak = __builtin_amdgcn_mfma_f32_32x32x16_bf16(fk, fa, Lak, 0, 0, 0);
        Mbr = __builtin_amdgcn_mfma_f32_32x32x16_bf16(fb, fr, Mbr, 0, 0, 0);
        Mkr = __builtin_amdgcn_mfma_f32_32x32x16_bf16(fk, fr, Mkr, 0, 0, 0);
    }
#pragma unroll
    for (int i = 0; i < 16; ++i) {
        const int s = (i & 3) + 8 * (i >> 2) + 4 * hf;
        if (!(s < r)) { Lab[i] = 0.f; Lak[i] = 0.f; }
        if (!(s <= r)) { Mbr[i] = 0.f; Mkr[i] = 0.f; }
    }
    asm volatile("s_waitcnt lgkmcnt(0)" ::: "memory");
    {
        LAS float* LabT = (LAS float*)AbarT; LAS float* LakM = (LAS float*)Bbar;
#pragma unroll
        for (int g = 0; g < 4; ++g) *(LAS f32x4*)(LabT + r * 32 + 8 * g + 4 * hf) = (f32x4){Lab[4 * g], Lab[4 * g + 1], Lab[4 * g + 2], Lab[4 * g + 3]};
#pragma unroll
        for (int i = 0; i < 16; ++i) LakM[((i & 3) + 8 * (i >> 2) + 4 * hf) * 32 + r] = Lak[i];
    }
    asm volatile("s_waitcnt lgkmcnt(0)" ::: "memory");
    unsigned W2p[16];
    {
        const LAS float* LabT = (const LAS float*)AbarT; const LAS float* LakM = (const LAS float*)Bbar;
        float X2[32];
#pragma unroll
        for (int t = 0; t < 32; t += 4) { const f32x4 q = *(const LAS f32x4*)(LakM + r * 32 + t); X2[t] = q[0]; X2[t + 1] = q[1]; X2[t + 2] = q[2]; X2[t + 3] = q[3]; }
        int zdep = 0;
#pragma unroll
        for (int t = 1; t < 32; ++t) {
            float x1 = Y[t], x2 = X2[t];
            const LAS float* row = LabT + t * 32 + zdep;
#pragma unroll
            for (int s4 = 0; s4 < t; s4 += 4) {
                const f32x4 lq = *(const LAS f32x4*)(row + s4);
#pragma unroll
                for (int q = 0; q < 4; ++q) if (s4 + q < t) { x1 = fmaf(Y[s4 + q], lq[q], x1); x2 = fmaf(X2[s4 + q], lq[q], x2); }
            }
            Y[t] = x1; X2[t] = x2;
            asm volatile("v_mov_b32 %0, 0" : "=v"(zdep) : "v"(x1), "v"(x2));
        }
#pragma unroll
        for (int q = 0; q < 16; ++q) W2p[q] = pk2(X2[2 * q], X2[2 * q + 1]);
    }
    asm volatile("s_waitcnt lgkmcnt(0)" ::: "memory");
    LAS unsigned char* Atil = L;
    LAS unsigned char* Wv = L + 8192;
#pragma unroll
    for (int q = 0; q < 4; ++q) {
        *(LAS u32x4*)(Atil + lane * 64 + q * 16) = (u32x4){pk2(Y[8 * q], Y[8 * q + 1]), pk2(Y[8 * q + 2], Y[8 * q + 3]), pk2(Y[8 * q + 4], Y[8 * q + 5]), pk2(Y[8 * q + 6], Y[8 * q + 7])};
        if (lane < 32) *(LAS u32x4*)(Wv + lane * 64 + q * 16) = (u32x4){W2p[4 * q], W2p[4 * q + 1], W2p[4 * q + 2], W2p[4 * q + 3]};
    }
    asm volatile("s_waitcnt lgkmcnt(0)" ::: "memory");
    const bf16x8 mb0 = acc_frag(Mbr, 0), mb1 = acc_frag(Mbr, 1);
#pragma unroll
    for (int i = 0; i < 2; ++i) {
        f32x16 c;
#pragma unroll
        for (int g = 0; g < 4; ++g) { const u32x2 q = *(const LAS u32x2*)(RbarT + (r * 64 + 32 * i + 8 * g + 4 * hf) * 2); c[4 * g] = bflo(q.x); c[4 * g + 1] = bfhi(q.x); c[4 * g + 2] = bflo(q.y); c[4 * g + 3] = bfhi(q.y); }
        c = __builtin_amdgcn_mfma_f32_32x32x16_bf16(lds_perm_frag(Atil + (32 * i + r) * 64, 0, hf), mb0, c, 0, 0, 0);
        c = __builtin_amdgcn_mfma_f32_32x32x16_bf16(lds_perm_frag(Atil + (32 * i + r) * 64, 1, hf), mb1, c, 0, 0, 0);
#pragma unroll
        for (int g = 0; g < 4; ++g) *(u32x2*)(cbo + CB_RT + r * CB_S64 + (32 * i + 8 * g + 4 * hf) * 2) = (u32x2){cvtpk(c[4 * g], c[4 * g + 1]), cvtpk(c[4 * g + 2], c[4 * g + 3])};
    }
    {
        f32x16 c = Mkr;
        c = __builtin_amdgcn_mfma_f32_32x32x16_bf16(lds_perm_frag(Wv + r * 64, 0, hf), mb0, c, 0, 0, 0);
        c = __builtin_amdgcn_mfma_f32_32x32x16_bf16(lds_perm_frag(Wv + r * 64, 1, hf), mb1, c, 0, 0, 0);
#pragma unroll
        for (int g = 0; g < 4; ++g) *(u32x2*)(cbo + CB_G + r * CB_S32 + (8 * g + 4 * hf) * 2) = (u32x2){cvtpk(c[4 * g], c[4 * g + 1]), cvtpk(c[4 * g + 2], c[4 * g + 3])};
    }
#pragma unroll
    for (int jt = 0; jt < 2; ++jt) {
        const float pc = PCv[32 * jt + r];
        const bf16x8 fb0 = *(const LAS bf16x8*)(BbarT + (32 * jt + r) * 64 + (8 * hf) * 2), fb1 = *(const LAS bf16x8*)(BbarT + (32 * jt + r) * 64 + (16 + 8 * hf) * 2);
#pragma unroll
        for (int i = 0; i < 2; ++i) {
            f32x16 c;
#pragma unroll
            for (int q = 0; q < 16; ++q) c[q] = 0.f;
            c = __builtin_amdgcn_mfma_f32_32x32x16_bf16(*(const LAS bf16x8*)(Atil + (32 * i + r) * 64 + (8 * hf) * 2), fb0, c, 0, 0, 0);
            c = __builtin_amdgcn_mfma_f32_32x32x16_bf16(*(const LAS bf16x8*)(Atil + (32 * i + r) * 64 + (16 + 8 * hf) * 2), fb1, c, 0, 0, 0);
#pragma unroll
            for (int q = 0; q < 16; ++q) { const int kq = (q & 3) + 8 * (q >> 2) + 4 * hf; c[q] = (c[q] + ((i == jt && kq == r) ? 1.f : 0.f)) * pc; }
#pragma unroll
            for (int g = 0; g < 4; ++g) *(u32x2*)(cbo + CB_PHI + (32 * jt + r) * CB_S64 + (32 * i + 8 * g + 4 * hf) * 2) = (u32x2){cvtpk(c[4 * g], c[4 * g + 1]), cvtpk(c[4 * g + 2], c[4 * g + 3])};
        }
        {
            f32x16 c;
#pragma unroll
            for (int q = 0; q < 16; ++q) c[q] = bf2f(*(const LAS bf16_t*)(Kbar + (((q & 3) + 8 * (q >> 2) + 4 * hf) * 64 + 32 * jt + r) * 2));
            c = __builtin_amdgcn_mfma_f32_32x32x16_bf16(*(const LAS bf16x8*)(Wv + r * 64 + (8 * hf) * 2), fb0, c, 0, 0, 0);
            c = __builtin_amdgcn_mfma_f32_32x32x16_bf16(*(const LAS bf16x8*)(Wv + r * 64 + (16 + 8 * hf) * 2), fb1, c, 0, 0, 0);
#pragma unroll
            for (int g = 0; g < 4; ++g) *(u32x2*)(cbo + CB_PSI + (32 * jt + r) * CB_S32 + (8 * g + 4 * hf) * 2) = (u32x2){cvtpk(c[4 * g] * pc, c[4 * g + 1] * pc), cvtpk(c[4 * g + 2] * pc, c[4 * g + 3] * pc)};
        }
    }
    asm volatile("s_waitcnt lgkmcnt(0)" ::: "memory");
}

constexpr int CS_SLOTS = 4, CS_NP = CB_BYTES / 1024;
__device__ __forceinline__ void st_cscan(const P& p, int bh, LAS unsigned char* lds) {
    const int tid = opaque(threadIdx.x), wave = __builtin_amdgcn_readfirstlane(tid >> 6), lane = tid & 63;
    const int b = bh / 6, hh = bh % 6, r = lane & 31, hf = lane >> 5;
    const unsigned char* cb0 = p.cb + (size_t)bh * 64 * CB_BYTES;
    constexpr int NCH = SEQ / 32;
    const int lw = wave - 2;
#define CS_ISSUE(chunk) do { const int _c = (chunk) < NCH ? (chunk) : NCH - 1; const unsigned char* _g = cb0 + (size_t)_c * CB_BYTES + lane * 16; LAS unsigned char* _l = lds + ((chunk) & 3) * CB_BYTES; \
        _Pragma("unroll") for (int _j = 0; _j < 5; ++_j) if (lw + 6 * _j < CS_NP) __builtin_amdgcn_global_load_lds((const unsigned*)(_g + (lw + 6 * _j) * 1024), (LAS unsigned*)(_l + (lw + 6 * _j) * 1024), 16, 0, 0); } while (0)
    f32x16 X0, X1;
#pragma unroll
    for (int i = 0; i < 16; ++i) { X0[i] = 0.f; X1[i] = 0.f; }
    if (wave >= 2) { CS_ISSUE(0); CS_ISSUE(1); CS_ISSUE(2); }
    bf16_t* yb = p.y + (size_t)b * SEQ * RWW + hh * 64 + 32 * wave + r;
    for (int c = 0; c < NCH; ++c) {
        if (wave >= 2) { if (lw < 2) asm volatile("s_waitcnt vmcnt(10)" ::: "memory"); else asm volatile("s_waitcnt vmcnt(8)" ::: "memory"); }
        __builtin_amdgcn_s_barrier();
        if (wave >= 2) { CS_ISSUE(c + 3); }
        else {
            const LAS unsigned char* S = lds + (c & 3) * CB_BYTES;
            const int vr = 32 * wave + r;
            const bf16x8 vf0 = *(const LAS bf16x8*)(S + CB_V + vr * CB_S32 + (8 * hf) * 2), vf1 = *(const LAS bf16x8*)(S + CB_V + vr * CB_S32 + (16 + 8 * hf) * 2);
            const LAS unsigned char* rp = S + CB_RT + r * CB_S64;
            const bf16x8 fr0 = lds_perm_frag(rp, 0, hf), fr1 = lds_perm_frag(rp, 1, hf), fr2 = lds_perm_frag(rp + 64, 0, hf), fr3 = lds_perm_frag(rp + 64, 1, hf);
            const bf16x8 fg0 = *(const LAS bf16x8*)(S + CB_G + r * CB_S32 + (8 * hf) * 2), fg1 = *(const LAS bf16x8*)(S + CB_G + r * CB_S32 + (16 + 8 * hf) * 2);
            const LAS unsigned char* p0 = S + CB_PHI + r * CB_S64; const LAS unsigned char* p1 = S + CB_PHI + (32 + r) * CB_S64;
            const bf16x8 fa0 = lds_perm_frag(p0, 0, hf), fa1 = lds_perm_frag(p0, 1, hf), fa2 = lds_perm_frag(p0 + 64, 0, hf), fa3 = lds_perm_frag(p0 + 64, 1, hf);
            const bf16x8 fb0 = lds_perm_frag(p1, 0, hf), fb1 = lds_perm_frag(p1, 1, hf), fb2 = lds_perm_frag(p1 + 64, 0, hf), fb3 = lds_perm_frag(p1 + 64, 1, hf);
            const LAS unsigned char* q0 = S + CB_PSI + r * CB_S32; const LAS unsigned char* q1 = S + CB_PSI + (32 + r) * CB_S32;
            const bf16x8 fp0 = *(const LAS bf16x8*)(q0 + (8 * hf) * 2), fp1 = *(const LAS bf16x8*)(q0 + (16 + 8 * hf) * 2), fp2 = *(const LAS bf16x8*)(q1 + (8 * hf) * 2), fp3 = *(const LAS bf16x8*)(q1 + (16 + 8 * hf) * 2);
            const bf16x8 x00 = acc_frag(X0, 0), x01 = acc_frag(X0, 1), x10 = acc_frag(X1, 0), x11 = acc_frag(X1, 1);
            asm volatile("s_waitcnt lgkmcnt(0)" ::: "memory");
            __builtin_amdgcn_sched_barrier(0);
            f32x16 yc, n0, n1;
#pragma unroll
            for (int i = 0; i < 16; ++i) { yc[i] = 0.f; n0[i] = 0.f; n1[i] = 0.f; }
            n0 = __builtin_amdgcn_mfma_f32_32x32x16_bf16(fa0, x00, n0, 0, 0, 0);
            n1 = __builtin_amdgcn_mfma_f32_32x32x16_bf16(fb0, x00, n1, 0, 0, 0);
            yc = __builtin_amdgcn_mfma_f32_32x32x16_bf16(fr0, x00, yc, 0, 0, 0);
            n0 = __builtin_amdgcn_mfma_f32_32x32x16_bf16(fa1, x01, n0, 0, 0, 0);
            n1 = __builtin_amdgcn_mfma_f32_32x32x16_bf16(fb1, x01, n1, 0, 0, 0);
            yc = __builtin_amdgcn_mfma_f32_32x32x16_bf16(fr1, x01, yc, 0, 0, 0);
            n0 = __builtin_amdgcn_mfma_f32_32x32x16_bf16(fa2, x10, n0, 0, 0, 0);
            n1 = __builtin_amdgcn_mfma_f32_32x32x16_bf16(fb2, x10, n1, 0, 0, 0);
            yc = __builtin_amdgcn_mfma_f32_32x32x16_bf16(fr2, x10, yc, 0, 0, 0);
            n0 = __builtin_amdgcn_mfma_f32_32x32x16_bf16(fa3, x11, n0, 0, 0, 0);
            n1 = __builtin_amdgcn_mfma_f32_32x32x16_bf16(fb3, x11, n1, 0, 0, 0);
            yc = __builtin_amdgcn_mfma_f32_32x32x16_bf16(fr3, x11, yc, 0, 0, 0);
            n0 = __builtin_amdgcn_mfma_f32_32x32x16_bf16(fp0, vf0, n0, 0, 0, 0);
            n1 = __builtin_amdgcn_mfma_f32_32x32x16_bf16(fp2, vf0, n1, 0, 0, 0);
            yc = __builtin_amdgcn_mfma_f32_32x32x16_bf16(fg0, vf0, yc, 0, 0, 0);
            n0 = __builtin_amdgcn_mfma_f32_32x32x16_bf16(fp1, vf1, n0, 0, 0, 0);
            n1 = __builtin_amdgcn_mfma_f32_32x32x16_bf16(fp3, vf1, n1, 0, 0, 0);
            yc = __builtin_amdgcn_mfma_f32_32x32x16_bf16(fg1, vf1, yc, 0, 0, 0);
            X0 = n0; X1 = n1;
#pragma unroll
            for (int i = 0; i < 16; ++i) yb[(size_t)(c * 32 + (i & 3) + 8 * (i >> 2) + 4 * hf) * RWW] = (bf16_t)f2bf(yc[i]);
        }
    }
    asm volatile("s_waitcnt vmcnt(0)" ::: "memory");
    __builtin_amdgcn_s_barrier();
#undef CS_ISSUE
}

template <int NT>
__device__ __forceinline__ void st_rwout(const P& p, int l, const int (&tok)[NT], int lane) {
    float y[NT][6], vv[NT][6], gg[NT][6], rk[NT][6];
#pragma unroll
    for (int n = 0; n < NT; ++n)
#pragma unroll
        for (int hh = 0; hh < 6; ++hh) {
            const int t = tok[n];
            y[n][hh] = bf2f(p.y[(size_t)t * RWW + hh * 64 + lane]); vv[n][hh] = bf2f(*(const bf16_t*)(p.rec + (size_t)t * REC_TB + hh * REC_HB + 768 + lane * 2)); gg[n][hh] = bf2f(p.g[(size_t)t * RWW + hh * 64 + lane]);
            rk[n][hh] = *(const float*)(p.rec + (size_t)t * REC_TB + hh * REC_HB + 896);
        }
#pragma unroll
    for (int hh = 0; hh < 6; ++hh) {
        const int c = hh * 64 + lane;
        const float lg = p.rw_ln_g[l * RWW + c], lb = p.rw_ln_b[l * RWW + c];
#pragma unroll
        for (int n = 0; n < NT; ++n) {
            const float mean = wave_sum(y[n][hh]) * (1.f / 64.f);
            const float d = y[n][hh] - mean;
            const float var = wave_sum(d * d) * (1.f / 64.f);
            const float yn = d * rsqrtf(var + 64e-5f) * lg + lb;
            p.h[(size_t)tok[n] * D + c] = (bf16_t)f2bf((yn + rk[n][hh] * vv[n][hh]) * gg[n][hh]);
        }
    }
}

typedef float f32x16 __attribute__((ext_vector_type(16)));
constexpr float ATT_EXIT = -30.f;
__device__ __forceinline__ float xhalf(float x, int lane) { return __builtin_bit_cast(float, __builtin_amdgcn_ds_bpermute((lane ^ 32) << 2, __builtin_bit_cast(int, x))); }
__device__ __forceinline__ void st_attn(const P& p, int l, int item) {
    const int lane = opaque(threadIdx.x) & 63;
    const int qt = item % (SEQ / 32), bh = item / (SEQ / 32), b = bh / 6, hh = bh % 6;
    const int r = lane & 31, hf = lane >> 5;
    const bf16_t* qkb = p.proj + (size_t)b * SEQ * PJB + RWC + hh * 64 + 8 * hf;
    const bf16_t* vtb = p.vt + ((size_t)(b * 6 + hh) * 64 + r) * SEQ + 4 * hf;
    bf16x8 qf[4];
    {
        const bf16_t* qp = qkb + (size_t)(qt * 32 + r) * PJB;
#pragma unroll
        for (int s = 0; s < 4; ++s) {
            u32x4 t4 = *(const u32x4*)(qp + 16 * s);
            unsigned w[4] = {t4.x, t4.y, t4.z, t4.w};
#pragma unroll
            for (int q = 0; q < 4; ++q) { const float lo = bflo(w[q]) * 0.125f, hi = bfhi(w[q]) * 0.125f; w[q] = (__builtin_bit_cast(unsigned, lo) >> 16) | (__builtin_bit_cast(unsigned, hi) & 0xffff0000u); }
            t4.x = w[0]; t4.y = w[1]; t4.z = w[2]; t4.w = w[3];
            qf[s] = __builtin_bit_cast(bf16x8, t4);
        }
    }
    f32x16 o0, o1;
#pragma unroll
    for (int i = 0; i < 16; ++i) { o0[i] = 0.f; o1[i] = 0.f; }
    float R = 0.f;
    bf16x8 kfn[4]; u32x2 vfn[2][2][2];
#define ATT_LOAD(KT) do { const int _k0 = (KT) * 32; const bf16_t* kp = qkb + SBW + (size_t)(_k0 + r) * PJB; \
        _Pragma("unroll") for (int s = 0; s < 4; ++s) kfn[s] = *(const bf16x8*)(kp + 16 * s); \
        _Pragma("unroll") for (int dt = 0; dt < 2; ++dt) _Pragma("unroll") for (int s = 0; s < 2; ++s) { const bf16_t* vp = vtb + (size_t)dt * 32 * SEQ + _k0 + 16 * s; vfn[dt][s][0] = *(const u32x2*)vp; vfn[dt][s][1] = *(const u32x2*)(vp + 8); } } while (0)
    ATT_LOAD(qt);
    for (int kt = qt; kt >= 0; --kt) {
        const int key0 = kt * 32; (void)key0;
        bf16x8 kf[4]; u32x2 vf[2][2][2];
#pragma unroll
        for (int s = 0; s < 4; ++s) kf[s] = kfn[s];
#pragma unroll
        for (int dt = 0; dt < 2; ++dt)
#pragma unroll
            for (int s = 0; s < 2; ++s) { vf[dt][s][0] = vfn[dt][s][0]; vf[dt][s][1] = vfn[dt][s][1]; }
        if (kt > 0) ATT_LOAD(kt - 1);
        f32x16 z;
#pragma unroll
        for (int i = 0; i < 16; ++i) z[i] = 0.f;
#pragma unroll
        for (int s = 0; s < 4; ++s) z = __builtin_amdgcn_mfma_f32_32x32x16_bf16(kf[s], qf[s], z, 0, 0, 0);
        const bool diag = (kt == qt);
        float c[16], gs[4];
#pragma unroll
        for (int gi = 0; gi < 4; ++gi) {
            float run = 0.f;
#pragma unroll
            for (int e = 3; e >= 0; --e) {
                const int reg = gi * 4 + e;
                const float zz = z[reg];
                float L = -(fmaxf(zz, 0.f) + __logf(1.f + __expf(-fabsf(zz))));
                if (diag && !(r > e + 8 * gi + 4 * hf)) L = 0.f;
                run += L; c[reg] = run;
            }
            gs[gi] = run;
        }
        float go[4], pp[4], ob[4], off[4];
#pragma unroll
        for (int gi = 0; gi < 4; ++gi) { go[gi] = xhalf(gs[gi], lane); pp[gi] = gs[gi] + go[gi]; }
        ob[3] = 0.f; ob[2] = pp[3]; ob[1] = pp[3] + pp[2]; ob[0] = ob[1] + pp[1];
#pragma unroll
        for (int gi = 0; gi < 4; ++gi) off[gi] = ob[gi] + (hf == 0 ? go[gi] : 0.f) + R;
        const float total = ob[0] + pp[0];
        unsigned af[8];
#pragma unroll
        for (int i = 0; i < 8; ++i) {
            float a2[2];
#pragma unroll
            for (int q = 0; q < 2; ++q) {
                const int reg = 2 * i + q, gi = reg >> 2, e = reg & 3;
                float a = __expf(z[reg] + c[reg] + off[gi]);
                if (diag && !(r > e + 8 * gi + 4 * hf)) a = 0.f;
                a2[q] = a;
            }
            af[i] = pk2(a2[0], a2[1]);
        }
        R += total;
        const bf16x8 a0 = __builtin_bit_cast(bf16x8, (u32x4){af[0], af[1], af[2], af[3]});
        const bf16x8 a1 = __builtin_bit_cast(bf16x8, (u32x4){af[4], af[5], af[6], af[7]});
        o0 = __builtin_amdgcn_mfma_f32_32x32x16_bf16(__builtin_bit_cast(bf16x8, (u32x4){vf[0][0][0].x, vf[0][0][0].y, vf[0][0][1].x, vf[0][0][1].y}), a0, o0, 0, 0, 0);
        o0 = __builtin_amdgcn_mfma_f32_32x32x16_bf16(__builtin_bit_cast(bf16x8, (u32x4){vf[0][1][0].x, vf[0][1][0].y, vf[0][1][1].x, vf[0][1][1].y}), a1, o0, 0, 0, 0);
        o1 = __builtin_amdgcn_mfma_f32_32x32x16_bf16(__builtin_bit_cast(bf16x8, (u32x4){vf[1][0][0].x, vf[1][0][0].y, vf[1][0][1].x, vf[1][0][1].y}), a0, o1, 0, 0, 0);
        o1 = __builtin_amdgcn_mfma_f32_32x32x16_bf16(__builtin_bit_cast(bf16x8, (u32x4){vf[1][1][0].x, vf[1][1][0].y, vf[1][1][1].x, vf[1][1][1].y}), a1, o1, 0, 0, 0);
        if (__all(R < ATT_EXIT)) break;
    }
#undef ATT_LOAD
    float ss = 0.f;
#pragma unroll
    for (int i = 0; i < 16; ++i) ss += o0[i] * o0[i] + o1[i] * o1[i];
    ss += xhalf(ss, lane);
    const float rs = rsqrtf(ss * (1.f / 64.f) + 1e-6f);
    bf16_t* op = p.h + ((size_t)b * SEQ + qt * 32 + r) * D + RWW + hh * 64 + 4 * hf;
    const float* gn = p.sb_norm_g + l * SBW + hh * 64 + 4 * hf;
#pragma unroll
    for (int gi = 0; gi < 4; ++gi) {
        const f32x4 g0 = *(const f32x4*)(gn + 8 * gi), g1 = *(const f32x4*)(gn + 32 + 8 * gi);
        u32x2 w0, w1;
        w0.x = pk2(o0[4 * gi] * rs * g0[0], o0[4 * gi + 1] * rs * g0[1]); w0.y = pk2(o0[4 * gi + 2] * rs * g0[2], o0[4 * gi + 3] * rs * g0[3]);
        w1.x = pk2(o1[4 * gi] * rs * g1[0], o1[4 * gi + 1] * rs * g1[1]); w1.y = pk2(o1[4 * gi + 2] * rs * g1[2], o1[4 * gi + 3] * rs * g1[3]);
        *(u32x2*)(op + 8 * gi) = w0; *(u32x2*)(op + 32 + 8 * gi) = w1;
    }
}

__device__ __forceinline__ void st_pool(const P& p, int l, int vb, LAS float* PL  ) {
    const int tid = opaque(threadIdx.x);
    const int t0 = vb * 32, s0 = t0 % SEQ;
    {
        const int col = tid & 255, th = tid >> 8, g = col >> 6, win = 2 << g;
        const int sA = s0 + th * 16;
        const bf16_t* u = p.proj + (size_t)(t0 + th * 16) * PJB + RWC + SBC + col;
        float xv[31];
#pragma unroll
        for (int i = 0; i < 31; ++i) { const int s = sA - 15 + i; xv[i] = (s >= 0 && (i >= 15 || 15 - i < win)) ? bf2f(u[(ptrdiff_t)(i - 15) * PJB]) : 0.f; }
        float run = 0.f;
#pragma unroll
        for (int i = 0; i < 15; ++i) run += (15 - i < win) ? xv[i] : 0.f;
#pragma unroll
        for (int j = 0; j < 16; ++j) {
            run += xv[15 + j];
            const int s = sA + j, n = min(s + 1, win);
            PL[(th * 16 + j) * 256 + col] = run / (float)n - xv[15 + j];
            float drop = 0.f;
#pragma unroll
            for (int q = 1; q <= 4; ++q) if (win == (1 << q)) drop = xv[15 + j - (1 << q) + 1];
            run -= drop;
        }
    }
    __syncthreads();
    {
        const int wave = tid >> 6, lane = tid & 63, g = wave & 3, th = wave >> 2;
        float acc[16];
#pragma unroll
        for (int j = 0; j < 16; ++j) acc[j] = 0.f;
        const float* pw = p.pool_w + ((size_t)l * 4 + g) * 64 * 64 + lane;
        for (int c = 0; c < 64; c += 4) {
            const float w0 = pw[c * 64], w1 = pw[(c + 1) * 64], w2 = pw[(c + 2) * 64], w3 = pw[(c + 3) * 64];
#pragma unroll
            for (int j = 0; j < 16; ++j) { const f32x4 x = *(const LAS f32x4*)(PL + (th * 16 + j) * 256 + g * 64 + c); acc[j] += x[0] * w0 + x[1] * w1 + x[2] * w2 + x[3] * w3; }
        }
        const float sc = p.pool_scale[l * PLW + g * 64 + lane];
#pragma unroll
        for (int j = 0; j < 16; ++j) p.h[(size_t)(t0 + th * 16 + j) * D + 768 + g * 64 + lane] = (bf16_t)f2bf(acc[j] * sc);
    }
    __syncthreads();
}

template <bool TOLDS>
__device__ __forceinline__ void norm_row(const float* xr, const float* md  , bf16_t* hrow, LAS float* hl, int lane) {
    f32x4 v[4]; float ss = 0.f;
#pragma unroll
    for (int i = 0; i < 4; ++i) { v[i] = *(const f32x4*)(xr + i * 256 + lane * 4); ss += v[i][0] * v[i][0] + v[i][1] * v[i][1] + v[i][2] * v[i][2] + v[i][3] * v[i][3]; }
    ss = wave_sum(ss);
    const float rs = rsqrtf(ss * (1.f / D) + 1e-6f);
#pragma unroll
    for (int i = 0; i < 4; ++i) {
        const int cidx = i * 256 + lane * 4;
        const f32x4 sh = *(const f32x4*)(md + cidx), sc = *(const f32x4*)(md + 1024 + cidx);
        const f32x4 o = v[i] * rs * (sc + 1.f) + sh;
        u32x2 w; w.x = pk2(o[0], o[1]); w.y = pk2(o[2], o[3]);
        *(u32x2*)(hrow + cidx) = w;
        if constexpr (TOLDS) *(LAS f32x4*)(hl + cidx) = o;
    }
}

__device__ __forceinline__ void split_bf16(const float (&x)[8], bf16x8& hi, bf16x8& lo) {
    unsigned h[4], l[4];
#pragma unroll
    for (int q = 0; q < 4; ++q) {
        const unsigned ph = cvtpk(x[2 * q], x[2 * q + 1]);
        const float r0 = x[2 * q] - bflo(ph), r1 = x[2 * q + 1] - bfhi(ph);
        h[q] = ph; l[q] = cvtpk(r0, r1);
    }
    hi = mk8(h[0], h[1], h[2], h[3]); lo = mk8(l[0], l[1], l[2], l[3]);
}
__device__ __forceinline__ void st_normrouter(const P& p, int l, int vb0, int vbstride, LAS float* L  ) {
    const int tid = opaque(threadIdx.x), wave = tid >> 6, lane = tid & 63;
    const int fr = lane & 15, fq = lane >> 4;
    constexpr int HS = 1028;
    LAS float* H = L; LAS float* PART = L + 16 * HS; LAS float* SEL = PART + 8 * 16 * 64; LAS int* lcnt = (LAS int*)(SEL + 16 * 72);
    bf16x8 Bh[4][4], Bl[4][4];
    {
        const float* wr = p.w_router + ((size_t)l * D + wave * 128) * NE;
        const int ll = opaque(lane), fr2 = ll & 15, fq2 = ll >> 4;
#pragma unroll
        for (int ks = 0; ks < 4; ++ks)
#pragma unroll
            for (int nt = 0; nt < 4; ++nt) {
                float x[8];
#pragma unroll
                for (int j = 0; j < 8; ++j) x[j] = wr[(32 * ks + 8 * fq2 + j) * NE + 16 * nt + fr2];
                split_bf16(x, Bh[ks][nt], Bl[ks][nt]);
            }
    }
    const float brt = p.b_router[l * NE + lane];
    for (int vb = vb0; vb < T / 16; vb += vbstride) {
        const int t0 = vb * 16, b = t0 / SEQ;
        const float* md = p.mod + ((size_t)l * 8 + b) * 6144 + 3072;
        if (tid < 64) lcnt[tid] = 0;
        unsigned pfv = 0u;
        if (vb + vbstride < T / 16) pfv = pf_lines(p.xb + (size_t)((vb + vbstride) * 16 + wave * 2) * D, 2 * D * 4, lane);
#pragma unroll
        for (int q = 0; q < 2; ++q) { const int tt = wave * 2 + q; norm_row<true>(p.xb + (size_t)(t0 + tt) * D, md, p.h + (size_t)(t0 + tt) * D, H + tt * HS, lane); }
        __syncthreads();
        {
            f32x4 acc[4];
#pragma unroll
            for (int nt = 0; nt < 4; ++nt) acc[nt] = (f32x4){0.f, 0.f, 0.f, 0.f};
#pragma unroll
            for (int ks = 0; ks < 4; ++ks) {
                const LAS float* hp = H + fr * HS + wave * 128 + 32 * ks + 8 * fq;
                const f32x4 h0 = *(const LAS f32x4*)hp, h1 = *(const LAS f32x4*)(hp + 4);
                const float x[8] = {h0[0], h0[1], h0[2], h0[3], h1[0], h1[1], h1[2], h1[3]};
                bf16x8 ah, al; split_bf16(x, ah, al);
#pragma unroll
                for (int nt = 0; nt < 4; ++nt) {
                    acc[nt] = __builtin_amdgcn_mfma_f32_16x16x32_bf16(ah, Bh[ks][nt], acc[nt], 0, 0, 0);
                    acc[nt] = __builtin_amdgcn_mfma_f32_16x16x32_bf16(ah, Bl[ks][nt], acc[nt], 0, 0, 0);
                    acc[nt] = __builtin_amdgcn_mfma_f32_16x16x32_bf16(al, Bh[ks][nt], acc[nt], 0, 0, 0);
                }
            }
#pragma unroll
            for (int nt = 0; nt < 4; ++nt)
#pragma unroll
                for (int rg = 0; rg < 4; ++rg) PART[(wave * 16 + 4 * fq + rg) * 64 + 16 * nt + fr] = acc[nt][rg];
        }
        __syncthreads();
#pragma unroll
        for (int q = 0; q < 2; ++q) {
            const int tt = wave * 2 + q, t = t0 + tt;
            float logit = 0.f;
#pragma unroll
            for (int w = 0; w < 8; ++w) logit += PART[(w * 16 + tt) * 64 + lane];
            float score = sigmoidf_(logit);
            score = (score == score) ? score : 0.f;
            const float sl = score + brt;
            LAS float* sel = SEL + (wave * 2 + q) * 72; LAS float* gs = sel + 64;
            sel[lane] = sl;
            if (lane < 8) {
                float m1 = -INFINITY, m2 = -INFINITY;
                for (int i = 0; i < 8; ++i) { const float v = sel[lane * 8 + i]; if (v > m1) { m2 = m1; m1 = v; } else if (v > m2) m2 = v; }
                gs[lane] = m1 + m2;
            }
            const int gI = lane >> 3;
            int grank = 0;
            for (int i = 0; i < 8; ++i) { const float v = gs[i]; grank += (v > gs[gI] || (v == gs[gI] && i < gI)) ? 1 : 0; }
            const float msk = (grank < 4) ? sl : -INFINITY;
            sel[lane] = msk;
            int rank = 0;
            for (int i = 0; i < 64; ++i) { const float v = sel[i]; rank += (v > msk || (v == msk && i < lane)) ? 1 : 0; }
            const bool chosen = rank < TOPK;
            const float wsum = wave_sum(chosen ? score : 0.f);
            if (chosen) {
                const int pos = __hip_atomic_fetch_add(&lcnt[lane], 1, __ATOMIC_RELAXED, __HIP_MEMORY_SCOPE_WORKGROUP);
                p.seg[((size_t)lane * 1024 + vb) * 16 + pos] = t * TOPK + rank;
                p.topw[(size_t)t * TOPK + rank] = score / (wsum + 1e-20f) * 2.5f;
            }
        }
        __syncthreads();
        if (tid < 64) p.cnt2[tid * 1024 + vb] = lcnt[tid];
        pf_done(pfv);
        __syncthreads();
    }
}

__device__ __forceinline__ void st_compact(const P& p, int e, LAS int* wt  ) {
    const int tid = opaque(threadIdx.x), wave = tid >> 6, lane = tid & 63;
    const int c0 = p.cnt2[e * 1024 + 2 * tid], c1 = p.cnt2[e * 1024 + 2 * tid + 1], s = c0 + c1;
    int incl = s;
#pragma unroll
    for (int o = 1; o < 64; o <<= 1) { const int v = __builtin_amdgcn_ds_bpermute(((lane - o) & 63) << 2, incl); if (lane >= o) incl += v; }
    if (lane == 63) wt[wave] = incl;
    __syncthreads();
    int base = 0;
    for (int w = 0; w < wave; ++w) base += wt[w];
    const int excl = base + incl - s;
    int2* dst = p.list + (size_t)e * T + excl;
    const int* s0 = p.seg + ((size_t)e * 1024 + 2 * tid) * 16;
    for (int j = 0; j < c0; ++j) { const int aid = s0[j]; dst[j] = make_int2(aid, __float_as_int(p.topw[aid])); }
    for (int j = 0; j < c1; ++j) { const int aid = s0[16 + j]; dst[c0 + j] = make_int2(aid, __float_as_int(p.topw[aid])); }
    if (tid == NTHREADS - 1) p.cnt[e] = base + incl;
    __syncthreads();
}

template <int NT>
__device__ __forceinline__ void st_combine(const P& p, int l, const int (&tok)[NT], int lane) {
    u32x2 q[NT][2][TOPK + 1]; f32x4 x0[NT][2], x1[NT][2];
#pragma unroll
    for (int n = 0; n < NT; ++n) {
        const int t = tok[n];
        const unsigned char* sl = p.slab + (size_t)t * TOPK * D;
#pragma unroll
        for (int i = 0; i < 2; ++i) {
            const int cidx = i * 512 + lane * 8;
#pragma unroll
            for (int s = 0; s < TOPK + 1; ++s) q[n][i][s] = *(const u32x2*)(s < TOPK ? sl + (size_t)s * D + cidx : p.slab + ((size_t)T * TOPK + t) * D + cidx);
            x0[n][i] = *(const f32x4*)(p.xb + (size_t)t * D + cidx); x1[n][i] = *(const f32x4*)(p.xb + (size_t)t * D + cidx + 4);
        }
    }
#pragma unroll
    for (int n = 0; n < NT; ++n) {
        const int t = tok[n], b = t / SEQ;
        const float* gt = p.mod + ((size_t)l * 8 + b) * 6144 + 5120;
        float* xr = p.xb + (size_t)t * D;
        float xv[16]; float ss = 0.f;
#pragma unroll
        for (int i = 0; i < 2; ++i) {
            const int cidx = i * 512 + lane * 8;
            float f[8];
#pragma unroll
            for (int j = 0; j < 8; ++j) f[j] = 0.f;
#pragma unroll
            for (int s = 0; s < TOPK + 1; ++s) {
                const u32x2 qq = q[n][i][s];
                const f32x2 a = __builtin_amdgcn_cvt_pk_f32_fp8((int)qq.x, false), bq = __builtin_amdgcn_cvt_pk_f32_fp8((int)qq.x, true), c = __builtin_amdgcn_cvt_pk_f32_fp8((int)qq.y, false), d = __builtin_amdgcn_cvt_pk_f32_fp8((int)qq.y, true);
                f[0] += a[0]; f[1] += a[1]; f[2] += bq[0]; f[3] += bq[1]; f[4] += c[0]; f[5] += c[1]; f[6] += d[0]; f[7] += d[1];
            }
            const f32x4 g0 = *(const f32x4*)(gt + cidx), g1 = *(const f32x4*)(gt + cidx + 4);
#pragma unroll
            for (int j = 0; j < 4; ++j) { xv[i * 8 + j] = x0[n][i][j] + g0[j] * f[j] * (1.f / SLAB_SC); xv[i * 8 + 4 + j] = x1[n][i][j] + g1[j] * f[4 + j] * (1.f / SLAB_SC); }
#pragma unroll
            for (int j = 0; j < 8; ++j) ss += xv[i * 8 + j] * xv[i * 8 + j];
        }
        ss = wave_sum(ss);
        const float rs = rsqrtf(ss * (1.f / D) + 1e-6f);
        if (l + 1 < NL) {
            const float* md = p.mod + ((size_t)(l + 1) * 8 + b) * 6144;
#pragma unroll
            for (int i = 0; i < 2; ++i) {
                const int cidx = i * 512 + lane * 8;
                *(f32x4*)(xr + cidx) = (f32x4){xv[i * 8], xv[i * 8 + 1], xv[i * 8 + 2], xv[i * 8 + 3]};
                *(f32x4*)(xr + cidx + 4) = (f32x4){xv[i * 8 + 4], xv[i * 8 + 5], xv[i * 8 + 6], xv[i * 8 + 7]};
                const f32x4 s0 = *(const f32x4*)(md + cidx), s1 = *(const f32x4*)(md + cidx + 4), c0 = *(const f32x4*)(md + 1024 + cidx), c1 = *(const f32x4*)(md + 1024 + cidx + 4);
                float o[8];
#pragma unroll
                for (int j = 0; j < 4; ++j) { o[j] = xv[i * 8 + j] * rs * (1.f + c0[j]) + s0[j]; o[4 + j] = xv[i * 8 + 4 + j] * rs * (1.f + c1[j]) + s1[j]; }
                u32x4 w; w.x = pk2(o[0], o[1]); w.y = pk2(o[2], o[3]); w.z = pk2(o[4], o[5]); w.w = pk2(o[6], o[7]);
                *(u32x4*)(p.h + (size_t)t * D + cidx) = w;
            }
        } else {
#pragma unroll
            for (int i = 0; i < 2; ++i) {
                const int cidx = i * 512 + lane * 8;
                const f32x4 g0 = *(const f32x4*)(p.g_final + cidx), g1 = *(const f32x4*)(p.g_final + cidx + 4);
                *(f32x4*)(p.out + (size_t)t * D + cidx) = (f32x4){xv[i * 8] * rs * g0[0], xv[i * 8 + 1] * rs * g0[1], xv[i * 8 + 2] * rs * g0[2], xv[i * 8 + 3] * rs * g0[3]};
                *(f32x4*)(p.out + (size_t)t * D + cidx + 4) = (f32x4){xv[i * 8 + 4] * rs * g1[0], xv[i * 8 + 5] * rs * g1[1], xv[i * 8 + 6] * rs * g1[2], xv[i * 8 + 7] * rs * g1[3]};
            }
        }
    }
}

#define XB_TMO      128
#define XB_XCNT(j)  (256  + 64 * (j))
#define XB_XSUB(j)  (1280 + 64 * (j))
#define XB_XGEN(j)  (2304 + 64 * (j))
#define XB_TOP      3328
#define XB_TOPGEN   3392
#define XCD_BAR_WORDS 3456
#define XB_SPIN_CAP (1u << 22)
__device__ __forceinline__ unsigned xb_ld(unsigned* p)              { return __hip_atomic_load(p, __ATOMIC_RELAXED, __HIP_MEMORY_SCOPE_AGENT); }
__device__ __forceinline__ unsigned xb_add(unsigned* p, unsigned v) { return __hip_atomic_fetch_add(p, v, __ATOMIC_RELAXED, __HIP_MEMORY_SCOPE_AGENT); }
__device__ __forceinline__ unsigned xb_xcc_id() { return (unsigned)__builtin_amdgcn_s_getreg((3 << 11) | 20) & 0xFu; }
#define XB_SPIN(cond, bar) do { unsigned _sp = 0; while (cond) { __builtin_amdgcn_s_sleep(1); \
    if ((++_sp & 255u) == 0u) { if (xb_ld(&(bar)[XB_TMO])) break; if (_sp > XB_SPIN_CAP) { atomicAdd(&(bar)[XB_TMO], 1u); break; } } } } while (0)
struct XcdBarrier { unsigned* bar; unsigned x; volatile LAS unsigned* st; };
__device__ __forceinline__ XcdBarrier xcd_barrier_post(unsigned* bar, volatile LAS unsigned* st) {
    XcdBarrier b; b.bar = bar; b.x = xb_xcc_id(); b.st = st;
    if (threadIdx.x == 0) (void)xb_add(&bar[XB_XCNT(b.x)], 1u);
    return b;
}
__device__ __forceinline__ void xcd_barrier_complete(unsigned* bar, unsigned x, unsigned& nloc, unsigned& nx) {
    const unsigned G = gridDim.x * gridDim.y * gridDim.z;
    unsigned sum, cnt, mine, sp = 0u;
    for (;;) {
        sum = 0u; cnt = 0u; mine = 0u;
#pragma unroll
        for (unsigned j = 0; j < 16; ++j) { const unsigned c = xb_ld(&bar[XB_XCNT(j)]); sum += c; cnt += (c > 0u) ? 1u : 0u; mine = (j == x) ? c : mine; }
        if (sum == G) break;
        __builtin_amdgcn_s_sleep(1);
        if ((++sp & 255u) == 0u) { if (xb_ld(&bar[XB_TMO])) break; if (sp > XB_SPIN_CAP) { atomicAdd(&bar[XB_TMO], 1u); break; } }
    }
    nloc = mine > 0u ? mine : 1u; nx = cnt > 0u ? cnt : 1u;
}
__device__ __forceinline__ void xcd_barrier(const XcdBarrier& b0) {
    XcdBarrier b = b0; { unsigned xx = b0.x; asm volatile("" : "+s"(xx)); b.x = xx; }
    asm volatile("s_waitcnt vmcnt(0)" ::: "memory");
    __syncthreads();
    if (threadIdx.x == 0) {
        unsigned* bar = b.bar;
        __builtin_amdgcn_s_waitcnt(0);
        unsigned nloc = b.st[0], nx = b.st[1];
        if (nloc == 0u) { xcd_barrier_complete(bar, b.x, nloc, nx); b.st[0] = nloc; b.st[1] = nx; }
        const unsigned old = xb_add(&bar[XB_XSUB(b.x)], 1u);
        const unsigned gen = old / nloc;
        if (old + 1u == (gen + 1u) * nloc) {
            __builtin_amdgcn_fence(__ATOMIC_RELEASE, "agent");
            asm volatile("s_waitcnt vmcnt(0)" ::: "memory");
            const unsigned og = xb_add(&bar[XB_TOP], 1u);
            const unsigned tg = og / nx;
            if (og + 1u == (tg + 1u) * nx) xb_add(&bar[XB_TOPGEN], 1u);
            else XB_SPIN(xb_ld(&bar[XB_TOPGEN]) == tg, bar);
            __builtin_amdgcn_fence(__ATOMIC_ACQUIRE, "agent");
            xb_add(&bar[XB_XGEN(b.x)], 1u);
            asm volatile("s_waitcnt vmcnt(0)" ::: "memory");
        } else {
            XB_SPIN(xb_ld(&bar[XB_XGEN(b.x)]) == gen, bar);
            __builtin_amdgcn_fence(__ATOMIC_ACQUIRE, "agent");
            asm volatile("s_waitcnt vmcnt(0)" ::: "memory");
        }
    }
    __syncthreads();
}

__device__ __forceinline__ P load_args() {
    P q{};
#if defined(__HIP_DEVICE_COMPILE__)
    const __attribute__((address_space(4))) unsigned long long* k = (const __attribute__((address_space(4))) unsigned long long*)__builtin_amdgcn_kernarg_segment_ptr();
    asm volatile("" : "+s"(k));
    unsigned long long w[sizeof(P) / 8];
#pragma unroll
    for (unsigned i = 0; i < sizeof(P) / 8; ++i) w[i] = k[i];
    __builtin_memcpy(&q, w, sizeof(P));
#endif
    return q;
}
enum Ph { PH_NORM1 = 0, PH_INPROJ, PH_PREP, PH_MIX, PH_RWOUT, PH_OUTPROJ, PH_ROUTER, PH_COMPACT, PH_EXP1, PH_EXP2, PH_COMBINE, PH_PER_LAYER };

__global__ void __launch_bounds__(NTHREADS, 2) k_fused(P p_arg) {
    (void)p_arg;
#define KARGS() load_args()
    extern __shared__ __attribute__((aligned(16))) unsigned char lds_raw[];
    LAS unsigned char* lds = (LAS unsigned char*)lds_raw;
    LAS int* tstart = (LAS int*)(lds + LDS_STAGE);
    LAS int* cnts = (LAS int*)(lds + LDS_STAGE + 272);
    LAS int* tmap = (LAS int*)(lds + LDS_STAGE + 2048);
    volatile LAS unsigned* bst = (volatile LAS unsigned*)(lds + LDS_STAGE + 1008);
    if (threadIdx.x < 4) bst[threadIdx.x] = 0u;
    __syncthreads();
    XcdBarrier xb = xcd_barrier_post(load_args().bar, bst);
#define PHASE_COORDS() int G = gridDim.x, bx = blockIdx.x; asm volatile("" : "+s"(G), "+s"(bx)); const int vcu = (G % 8 == 0) ? (bx % 8) * (G / 8) + bx / 8 : bx; (void)vcu; \
    const int tid = opaque(threadIdx.x), half = tid >> 8, lane = tid & 63, wave = __builtin_amdgcn_readfirstlane(tid >> 6); \
    float* smem = (float*)lds_raw + half * 8192; LAS float* scr = (LAS float*)(lds + wave * 16384); (void)lane; (void)smem; (void)scr; (void)tid

    for (int rep = 0; rep < (REP_PH == -1 ? REP_N : 1); ++rep) {
        const P p = KARGS();
        PHASE_COORDS();
        for (int it = bx; it < NL * 96; it += G) st_mod(p, it, (LAS float*)lds);
        __syncthreads();
        for (int it = (bx * 8 + wave); it < CV_DENSE; it += G * 8) cvt_dense_item(p, it, scr, lane);
        for (int idx = bx * NTHREADS + tid; idx < NL * RWW * 160; idx += G * NTHREADS) {
            const int k = idx % 160, c = (idx / 160) % RWW, ly = idx / (160 * RWW);
            float v;
            if (k < 32) v = p.rw_w2[((size_t)ly * 32 + k) * RWW + c];
            else if (k < 64) v = p.rw_a2[((size_t)ly * 32 + (k - 32)) * RWW + c];
            else if (k < 128) v = p.rw_g2[((size_t)ly * 64 + (k - 64)) * RWW + c];
            else v = (ly == 1) ? p.rw_v2[(size_t)(k - 128) * RWW + c] : 0.f;
            p.lwt[idx] = (bf16_t)f2bf(v);
        }
        xcd_barrier(xb);
    }

    constexpr int NPH2 = NL * PH_PER_LAYER + ((REP_PH >= 0) ? REP_N - 1 : 0);
    for (int ph2 = 0; ph2 < NPH2; ++ph2) {
      {
        const int ph = (REP_PH < 0 || ph2 <= REP_PH) ? ph2 : (ph2 < REP_PH + REP_N ? REP_PH : ph2 - (REP_N - 1));
        const int rep = (REP_PH >= 0 && ph2 > REP_PH && ph2 < REP_PH + REP_N) ? 1 : 0; (void)rep;
        const int l = ph / PH_PER_LAYER, st = ph % PH_PER_LAYER;
        const P p = KARGS();
        PHASE_COORDS();
        if (st == PH_NORM1) {
            if (l == 0) {
                for (int t = bx * 8 + wave; t < T; t += G * 8) {
                    const int tn = t + G * 8; unsigned pfv = 0u;
                    if (tn < T) pfv = pf_lines(p.x + (size_t)tn * D, D * 4, lane);
                    norm_row<false>(p.x + (size_t)t * D, p.mod + (size_t)(t / SEQ) * 6144, p.h + (size_t)t * D, (LAS float*)lds, lane);
                    pf_done(pfv);
                }
            }
        } else if (st == PH_INPROJ) {
            pg8::DenseOrder S; S.init(p.h, p.wt_in + (size_t)l * PJB * D, T, PJB, D, G, bx);
            pg8::EpiProj E{p.proj, p.vt};
            pg8::gemm_phase<pg8::EpiProj, pg8::DenseOrder, true, true>(lds, D, S, E);
        } else if (st == PH_PREP) {
            st_prep(p, l, bx, G, lds);
        } else if (st == PH_MIX) {
            constexpr int N1 = NBATCH * 6, N2 = NBATCH * 6 * (SEQ / 32) / 8, N3 = T / 32, N4 = (CV_EXP + 7) / 8;
            const int sel = (rep == 0) ? 15 : REP_SEL;
            if (sel & 1) for (int wb = bx; wb < N1; wb += G) st_cscan(p, wb, lds);
            __syncthreads();
            {
                unsigned* ctrA = p.bar + 3500 + ph2; unsigned* ctrB = p.bar + 3600 + l;
                volatile LAS int* gslot = (volatile LAS int*)(lds + LDS_STAGE + 640);
                for (;;) {
                    __syncthreads();
                    if (tid == 0) *gslot = (int)__hip_atomic_fetch_add(ctrA, 2u, __ATOMIC_RELAXED, __HIP_MEMORY_SCOPE_AGENT);
                    __syncthreads();
                    const int base = *gslot;
                    if (base >= N2 + N3) break;
                    for (int wb = base; wb < base + 2 && wb < N2 + N3; ++wb) {
                        if (wb < N2) { if (sel & 2) st_attn(p, l, wb * 8 + wave); }
                        else if (sel & 4) st_pool(p, l, wb - N2, (LAS float*)lds);
                    }
                }
                for (;;) {
                    __syncthreads();
                    if (tid == 0) *gslot = (int)__hip_atomic_fetch_add(ctrB, 64u, __ATOMIC_RELAXED, __HIP_MEMORY_SCOPE_AGENT);
                    __syncthreads();
                    const int base = *gslot;
                    if (base >= CV_EXP) break;
                    if (sel & 8) cvt_exp_stream(p, l, base + wave, 8, min(base + 64, CV_EXP), scr, lane);
                }
            }
        } else if (st == PH_RWOUT) {
            for (int t = (bx * 8 + wave) * 4; t < T; t += G * 32) { const int tk[4] = {t, t + 1, t + 2, t + 3}; st_rwout<4>(p, l, tk, lane); }
        } else if (st == PH_OUTPROJ) {
            pg8::DenseOrder S; S.init(p.h, p.wt_out + (size_t)l * D * D, T, D, D, G, bx);
            pg8::EpiOut E{l == 0 ? p.x : p.xb, p.xb, p.mod + (size_t)l * 8 * 6144 + 2048};
            pg8::gemm_phase<pg8::EpiOut, pg8::DenseOrder, true, true>(lds, D, S, E);
        } else if (st == PH_ROUTER) {
            st_normrouter(p, l, bx, G, (LAS float*)lds);
        } else if (st == PH_COMPACT) {
            if (bx < NE) st_compact(p, bx, (LAS int*)lds);
        } else if (st == PH_EXP1 || st == PH_EXP2) {
            __syncthreads();
            if (tid == 0) {
                int acc = 0;
                for (int e = 0; e < 65; ++e) { const int c = e < NE ? p.cnt[e] : T; cnts[e] = c; tstart[e] = acc; acc += (c + 255) >> 8; }
                tstart[65] = acc;
            }
            __syncthreads();
            { int e = 0; for (int j = 1; j < 65; ++j) e += (tstart[j] <= tid) ? 1 : 0; tmap[tid] = e; }
            __syncthreads();
            if (st == PH_EXP1) {
                pg8::MoeOrder<true> S{tstart, cnts, tmap, p.list, p.h, p.wt1, D, 512, 1, G, vcu};
                pg8::EpiExp1 E{p.hm};
                pg8::gemm_phase<pg8::EpiExp1, pg8::MoeOrder<true>, true, true>(lds, D, S, E);
            } else {
                pg8::MoeOrder<false> S{tstart, cnts, tmap, p.list, p.hm, p.wt2, ED, D, 2, G, vcu};
                pg8::EpiExp2 E{p.slab, p.list, cnts};
                pg8::gemm_phase<pg8::EpiExp2, pg8::MoeOrder<false>, true, true>(lds, ED, S, E);
            }
        } else {
            for (int t = (bx * 8 + wave) * 2; t < T; t += G * 16) { const int tk[2] = {t, t + 1}; st_combine<2>(p, l, tk, lane); }
        }
        if (!(ph2 == NPH2 - 1)) { if (!(st == PH_NORM1 && l > 0)) xcd_barrier(xb); }
      }
    }
#undef PHASE_COORDS
#undef KARGS
}

}

extern "C" void kernel_launch(void* const* d_in, const int* in_sizes, int n_in, void* d_out, int out_size, void* d_ws, size_t ws_size,
                              hipStream_t stream) {
    P p{};
    const float** fp = (const float**)&p;
    for (int i = 0; i < 33; ++i) fp[i] = (const float*)d_in[i];
    p.out = (float*)d_out;
    char* ws = (char*)d_ws;
    size_t off = 0;
    auto take = [&](size_t bytes) { char* r = ws + off; off += (bytes + 255) & ~(size_t)255; return r; };
    p.bar = (unsigned*)take(16384);
    p.cnt = (int*)take(256);
    p.mod = (float*)take((size_t)NL * 8 * 6144 * 4);
    p.list = (int2*)take((size_t)NE * T * 8);
    p.cnt2 = (int*)take((size_t)NE * 1024 * 4);
    p.seg = (int*)take((size_t)NE * 1024 * 16 * 4);
    p.topw = (float*)take((size_t)T * TOPK * 4);
    p.wt_in = (bf16_t*)take((size_t)NL * PJB * D * 2);
    p.wt_out = (bf16_t*)take((size_t)NL * D * D * 2);
    p.lwt = (bf16_t*)take((size_t)NL * RWW * 160 * 2);
    p.wt1 = (bf16_t*)take((size_t)65 * 512 * D * 2);
    p.wt2 = (bf16_t*)take((size_t)65 * D * ED * 2);
    p.xb = (float*)take((size_t)T * D * 4);
    p.h = (bf16_t*)take((size_t)T * D * 2);
    p.vfirst = (bf16_t*)take((size_t)T * RWW * 2);
    const size_t ov = off;
    p.proj = (bf16_t*)take((size_t)T * PJB * 2);
    p.vt = (bf16_t*)take((size_t)T * SBW * 2);
    p.rec = (unsigned char*)take((size_t)T * REC_TB);
    p.g = (bf16_t*)take((size_t)T * RWW * 2);
    p.y = (bf16_t*)take((size_t)T * RWW * 2);
    p.cb = (unsigned char*)take((size_t)NBATCH * 6 * (SEQ / 32) * CB_BYTES);
    p.hm = (bf16_t*)(ws + ov);
    p.slab = (unsigned char*)(ws + ov + (size_t)MAXRT * 256 * ED * 2);
    const size_t end_moe = ov + (size_t)MAXRT * 256 * ED * 2 + (size_t)T * (TOPK + 1) * D;
    if (end_moe > off) off = end_moe;
    if (off > ws_size) { fprintf(stderr, "kernel_launch: workspace too small: need %zu, have %zu\n", off, ws_size); return; }

    static int cus = 0;
    if (cus == 0) {
        int dev = 0, n = 0;
        if (hipGetDevice(&dev) != hipSuccess || hipDeviceGetAttribute(&n, hipDeviceAttributeMultiprocessorCount, dev) != hipSuccess || n <= 0) n = 256;
        (void)hipFuncSetAttribute((const void*)k_fused, hipFuncAttributeMaxDynamicSharedMemorySize, LDS_BYTES);
        cus = n;
    }
    (void)hipMemsetAsync(p.bar, 0, 16384 + 256, stream);
    void* args[] = {(void*)&p};
    (void)hipLaunchCooperativeKernel((const void*)k_fused, dim3(cus), dim3(NTHREADS), args, LDS_BYTES, stream);
}
```

```cpp
#include <hip/hip_runtime.h>
#include <stdint.h>
#include <stdio.h>

#define REP_PH -2
#define REP_N 1
#define REP_SEL 15

namespace {

typedef unsigned short bf16_t;
typedef short bf16x8 __attribute__((ext_vector_type(8)));
typedef float f32x4 __attribute__((ext_vector_type(4)));
typedef float f32x2 __attribute__((ext_vector_type(2)));
typedef unsigned u32x4 __attribute__((ext_vector_type(4)));
typedef unsigned u32x2 __attribute__((ext_vector_type(2)));
#define LAS __attribute__((address_space(3)))

constexpr int D = 1024, NBATCH = 8, SEQ = 2048, T = NBATCH * SEQ, NL = 2;
constexpr int RWW = 384, SBW = 384, PLW = 256;
constexpr int RWC = 1280, SBC = 1152, INC = 2688;
constexpr int PJB = 2816;
constexpr int NE = 64, TOPK = 6, ED = 256;
constexpr int MAXRT = 512;
constexpr int NTHREADS = 512;
constexpr float SLAB_SC = 16.f;
constexpr int LDS_STAGE = 141312, LDS_CTL = 4096, LDS_BYTES = LDS_STAGE + LDS_CTL;

struct P {
    const float *x, *c, *w_ada, *b_ada, *w_in, *w_vres, *mu_rw, *mu_vres, *rw_w0, *rw_w2, *rw_a0, *rw_a2,
        *rw_v0, *rw_v2, *rw_g2, *rw_k_k, *rw_k_a, *rw_r_k, *rw_ln_g, *rw_ln_b, *sb_norm_g, *pool_w, *pool_scale,
        *w_out, *w_router, *b_router, *w_eg, *w_eu, *w_ed, *w_sg, *w_su, *w_sd, *g_final;
    float* out;
    unsigned* bar;
    float* mod;
    int* cnt;
    int2* list;
    int* cnt2;
    int* seg;
    float* topw;
    bf16_t* wt_in;
    bf16_t* wt_out;
    bf16_t* lwt;
    bf16_t* wt1;
    bf16_t* wt2;
    float* xb;
    bf16_t* h;
    bf16_t* vfirst;
    bf16_t* proj;
    bf16_t* vt;
    unsigned char* rec;
    unsigned char* cb;
    bf16_t* g;
    bf16_t* y;
    bf16_t* hm;
    unsigned char* slab;
};

__device__ __forceinline__ int opaque(int x) { asm volatile("" : "+v"(x)); return x; }
__device__ __forceinline__ float dpp_add16(float x) {
    x += __builtin_bit_cast(float, __builtin_amdgcn_update_dpp(0, __builtin_bit_cast(int, x), 0xB1, 0xF, 0xF, true));
    x += __builtin_bit_cast(float, __builtin_amdgcn_update_dpp(0, __builtin_bit_cast(int, x), 0x4E, 0xF, 0xF, true));
    x += __builtin_bit_cast(float, __builtin_amdgcn_update_dpp(0, __builtin_bit_cast(int, x), 0x141, 0xF, 0xF, true));
    x += __builtin_bit_cast(float, __builtin_amdgcn_update_dpp(0, __builtin_bit_cast(int, x), 0x140, 0xF, 0xF, true));
    return x;
}
__device__ __forceinline__ float wave_sum(float v) {
    v = dpp_add16(v);
    const int vi = __builtin_bit_cast(int, v);
    return (__builtin_bit_cast(float, __builtin_amdgcn_readlane(vi, 0)) + __builtin_bit_cast(float, __builtin_amdgcn_readlane(vi, 16)))
         + (__builtin_bit_cast(float, __builtin_amdgcn_readlane(vi, 32)) + __builtin_bit_cast(float, __builtin_amdgcn_readlane(vi, 48)));
}
__device__ __forceinline__ unsigned pf_lines(const void* p, int nbytes, int lane) {
    unsigned acc = 0u;
    for (int off = lane * 128; off < nbytes; off += 8192) acc += *(const unsigned*)((const char*)p + off);
    return acc;
}
__device__ __forceinline__ void pf_done(unsigned v) { asm volatile("" :: "v"(v)); }
constexpr float LOG2E = 1.4426950408889634f, LN2 = 0.6931471805599453f;
__device__ __forceinline__ float exp2f_(float x) { return __builtin_amdgcn_exp2f(x); }
__device__ __forceinline__ float log2f_(float x) { return __builtin_amdgcn_logf(x); }
__device__ __forceinline__ float rcpf_(float x) { return __builtin_amdgcn_rcpf(x); }
__device__ __forceinline__ float sigmoidf_(float x) { return rcpf_(1.f + exp2f_(-LOG2E * x)); }
__device__ __forceinline__ float softplusf_(float x) { return fmaxf(x, 0.f) + LN2 * log2f_(1.f + exp2f_(-LOG2E * fabsf(x))); }
__device__ __forceinline__ float siluf_(float x) { return x * rcpf_(1.f + exp2f_(-LOG2E * x)); }
__device__ __forceinline__ unsigned f2bf_sw(float f) { unsigned u = __builtin_bit_cast(unsigned, f); return (u + 0x7fffu + ((u >> 16) & 1u)) >> 16; }
__device__ __forceinline__ unsigned pk2_sw(float lo, float hi) { return f2bf_sw(lo) | (f2bf_sw(hi) << 16); }
typedef __bf16 bf16x2_t __attribute__((ext_vector_type(2)));
__device__ __forceinline__ unsigned cvtpk(float lo, float hi) { const f32x2 v = {lo, hi}; const bf16x2_t b = __builtin_convertvector(v, bf16x2_t); return __builtin_bit_cast(unsigned, b); }
__device__ __forceinline__ bf16x8 mk8(unsigned a, unsigned b, unsigned c, unsigned d) { return __builtin_bit_cast(bf16x8, (u32x4){a, b, c, d}); }
__device__ __forceinline__ unsigned pk2(float lo, float hi) { return cvtpk(lo, hi); }
__device__ __forceinline__ unsigned f2bf(float f) { return cvtpk(f, 0.f) & 0xffffu; }
__device__ __forceinline__ float bf2f(bf16_t h) { return __builtin_bit_cast(float, (unsigned)h << 16); }
__device__ __forceinline__ float bflo(unsigned u) { return __builtin_bit_cast(float, u << 16); }
__device__ __forceinline__ float bfhi(unsigned u) { return __builtin_bit_cast(float, u & 0xffff0000u); }

namespace pg8 {
constexpr int BM = 256, BK = 64, HALF = 128, HTB = HALF * BK * 2, STAGE_BYTES = 8 * HTB;
__device__ __forceinline__ int lds_byte(int r, int c) { const int st = (r >> 4) * 2 + (c >> 5), rr = r & 15, cc = c & 31, ob = rr * 64 + cc * 2; return st * 1024 + (ob ^ (((ob >> 9) & 1) << 5)); }
__device__ __forceinline__ void stage_rc(int b, int& R, int& C) { const int st = b / 1024, sb = b % 1024, swz = sb ^ (((sb >> 9) & 1) << 5); R = (st >> 1) * 16 + swz / 64; C = (st & 1) * 32 + (swz % 64) / 2; }
__device__ __forceinline__ int perm32(int rho) { const int n = rho >> 4, i = rho & 15; return 8 * (i >> 2) + 4 * n + (i & 3); }

struct Unit { int pm, pn, e, mt; };

template <class Epi, class Sched, bool ALIGN_EPI, bool SP2>
__device__ __forceinline__ void gemm_phase(LAS unsigned char* lds, const int K, const Sched& S, const Epi& E) {
    const int tid = opaque(threadIdx.x), wid = __builtin_amdgcn_readfirstlane(tid >> 6), lane = tid & 63, wr = wid >> 2, wc = wid & 3, fr = lane & 15, fq = lane >> 4;
    const int nt = K / BK;
    unsigned voffA[2], voffB[2];
#pragma unroll
    for (int i = 0; i < 2; ++i) { int R, C; stage_rc(tid * 16 + i * 8192, R, C); const int Rb = Epi::PERM ? ((R & ~31) + perm32(R & 31)) : R;
        voffA[i] = Sched::GATHER ? (unsigned)(C * 2) : (unsigned)(R * K + C) * 2u; voffB[i] = (unsigned)(Rb * K + C) * 2u; }
    const size_t kstep = (size_t)(BK * 2);
    const size_t hstep = (size_t)HALF * K * 2;
    const unsigned ldsw = (unsigned)wid * 1024u;
    const int aoff = lds_byte(wr * 64 + fr, fq * 8), boff = lds_byte(wc * 32 + fr, fq * 8);
#define PG8_SA(b, h) (((b) * 2 + (h)) * HTB)
#define PG8_SB(b, h) ((4 + (b) * 2 + (h)) * HTB)
#define PG8_STAGE(bufoff, gbase, voff) do { _Pragma("unroll") for (int _i = 0; _i < 2; ++_i) \
        __builtin_amdgcn_global_load_lds((const unsigned*)((const char*)(gbase) + (voff)[_i]), (LAS unsigned*)(lds + (bufoff) + ldsw + _i * 8192), 16, 0, 0); } while (0)
#define PG8_LDA(dst, b, h) do { _Pragma("unroll") for (int m = 0; m < 4; ++m) _Pragma("unroll") for (int k = 0; k < 2; ++k) dst[m][k] = *(const LAS bf16x8*)(lds + PG8_SA(b, h) + aoff + m * 2048 + k * 1024); } while (0)
#define PG8_LDB(dst, b, h) do { _Pragma("unroll") for (int n = 0; n < 2; ++n) _Pragma("unroll") for (int k = 0; k < 2; ++k) dst[n][k] = *(const LAS bf16x8*)(lds + PG8_SB(b, h) + boff + n * 2048 + k * 1024); } while (0)
#define PG8_MMA(ai, bj, At, Bt) do { __builtin_amdgcn_s_setprio(1); _Pragma("unroll") for (int m = 0; m < 4; ++m) _Pragma("unroll") for (int n = 0; n < 2; ++n) _Pragma("unroll") for (int k = 0; k < 2; ++k) \
        acc[ai][bj][m][n] = __builtin_amdgcn_mfma_f32_16x16x32_bf16(Bt[n][k], At[m][k], acc[ai][bj][m][n], 0, 0, 0); __builtin_amdgcn_s_setprio(0); } while (0)
#define PG8_WAIT_V(n) asm volatile("s_waitcnt vmcnt(" #n ")" ::: "memory")
#define PG8_WAIT_L(n) asm volatile("s_waitcnt lgkmcnt(" #n ")" ::: "memory")
#define PG8_BAR __builtin_amdgcn_s_barrier()
#define PG8_SCHED __builtin_amdgcn_sched_barrier(0)
    Unit cur, nxt; int ui = 0;
    if (!S.next(0, cur)) return;
    f32x4 acc[2][2][4][2];
#pragma unroll
    for (int a = 0; a < 2; ++a)
#pragma unroll
        for (int b = 0; b < 2; ++b)
#pragma unroll
            for (int m = 0; m < 4; ++m)
#pragma unroll
                for (int n = 0; n < 2; ++n) acc[a][b][m][n] = (f32x4){0.f, 0.f, 0.f, 0.f};
    bf16x8 At[4][2], B0[2][2], B1[2][2];
    const char* cA = S.a_base(cur); const char* cB = S.b_base(cur);
    unsigned pk[2] = {0u, 0u}, npk[2] = {0u, 0u};
    if constexpr (Sched::GATHER) S.a_tok(cur, tid, pk);
    const unsigned k2 = (unsigned)K * 2u;
#define PG8_STAGE_A(bufoff, gbase, hh, PK) do { if constexpr (Sched::GATHER) { unsigned _v[2]; _v[0] = (((PK)[0] >> (16 * (hh))) & 0xffffu) * k2 + voffA[0]; _v[1] = (((PK)[1] >> (16 * (hh))) & 0xffffu) * k2 + voffA[1]; \
        PG8_STAGE(bufoff, gbase, _v); } else { PG8_STAGE(bufoff, (gbase) + (hh) * hstep, voffA); } } while (0)
    static_assert(SP2, "only the SP2 loop is kept");
    PG8_STAGE(PG8_SB(0, 0), cB, voffB); PG8_STAGE(PG8_SB(0, 1), cB + hstep, voffB); PG8_STAGE_A(PG8_SA(0, 0), cA, 0, pk); PG8_STAGE_A(PG8_SA(0, 1), cA, 1, pk);
    if (wr == 1) PG8_BAR;
    PG8_WAIT_V(2); PG8_BAR;
    PG8_STAGE(PG8_SB(1, 0), cB + kstep, voffB); PG8_STAGE_A(PG8_SA(1, 0), cA + kstep, 0, pk); PG8_STAGE(PG8_SB(1, 1), cB + hstep + kstep, voffB);
    PG8_WAIT_V(6); PG8_BAR;
    for (;;) {
        const bool has_next = S.next(ui + 1, nxt);
        const char* nA = has_next ? S.a_base(nxt) : cA; const char* nB = has_next ? S.b_base(nxt) : cB;
        if constexpr (Sched::GATHER) { if (has_next) S.a_tok(nxt, tid, npk); else { npk[0] = pk[0]; npk[1] = pk[1]; } }
#pragma unroll 1
        for (int t = 0; t < nt; t += 2) {
            const bool last = (t == nt - 2);
            const char* a1 = cA + (size_t)(t + 1) * kstep;
            const char* a2 = last ? nA : cA + (size_t)(t + 2) * kstep; const char* b2 = last ? nB : cB + (size_t)(t + 2) * kstep;
            const char* a3 = a2 + kstep; const char* b3 = b2 + kstep;
            unsigned sp[2]; sp[0] = last ? npk[0] : pk[0]; sp[1] = last ? npk[1] : pk[1];
            PG8_LDB(B0, 0, 0); PG8_LDB(B1, 0, 1); PG8_SCHED; PG8_LDA(At, 0, 0); PG8_STAGE_A(PG8_SA(1, 1), a1, 1, pk);
            PG8_WAIT_V(8); PG8_WAIT_L(0); PG8_BAR; PG8_MMA(0, 0, At, B0); PG8_MMA(0, 1, At, B1); PG8_BAR; PG8_SCHED;
            PG8_LDA(At, 0, 1); PG8_STAGE(PG8_SB(0, 0), b2, voffB); PG8_STAGE(PG8_SB(0, 1), b2 + hstep, voffB); PG8_STAGE_A(PG8_SA(0, 0), a2, 0, sp);
            PG8_WAIT_V(8); PG8_WAIT_L(0); PG8_BAR; PG8_MMA(1, 0, At, B0); PG8_MMA(1, 1, At, B1); PG8_BAR; PG8_SCHED;
            PG8_LDB(B0, 1, 0); PG8_LDB(B1, 1, 1); PG8_SCHED; PG8_LDA(At, 1, 0); PG8_STAGE_A(PG8_SA(0, 1), a2, 1, sp);
            PG8_WAIT_V(8); PG8_WAIT_L(0); PG8_BAR; PG8_MMA(0, 0, At, B0); PG8_MMA(0, 1, At, B1); PG8_BAR; PG8_SCHED;
            PG8_LDA(At, 1, 1); PG8_STAGE(PG8_SB(1, 0), b3, voffB); PG8_STAGE(PG8_SB(1, 1), b3 + hstep, voffB); PG8_STAGE_A(PG8_SA(1, 0), a3, 0, sp);
            PG8_WAIT_V(8); PG8_WAIT_L(0); PG8_BAR; PG8_MMA(1, 0, At, B0); PG8_MMA(1, 1, At, B1); PG8_BAR; PG8_SCHED;
        }
        if constexpr (ALIGN_EPI) { if (wr == 0) PG8_BAR; }
        { const int t2 = opaque(threadIdx.x), w2 = __builtin_amdgcn_readfirstlane(t2 >> 6), l2 = t2 & 63; E(acc, cur, w2 >> 2, w2 & 3, l2 & 15, l2 >> 4); }
        if (!has_next) break;
#pragma unroll
        for (int a = 0; a < 2; ++a)
#pragma unroll
            for (int b = 0; b < 2; ++b)
#pragma unroll
                for (int m = 0; m < 4; ++m)
#pragma unroll
                    for (int n = 0; n < 2; ++n) acc[a][b][m][n] = (f32x4){0.f, 0.f, 0.f, 0.f};
        cur = nxt; cA = nA; cB = nB; ++ui;
        pk[0] = npk[0]; pk[1] = npk[1];
        if constexpr (ALIGN_EPI) { if (wr == 1) PG8_BAR; }
    }
    PG8_WAIT_V(0);
    if constexpr (!ALIGN_EPI) { if (wr == 0) PG8_BAR; }
    PG8_BAR;
#undef PG8_SA
#undef PG8_SB
#undef PG8_STAGE
#undef PG8_STAGE_A
#undef PG8_LDA
#undef PG8_LDB
#undef PG8_MMA
#undef PG8_WAIT_V
#undef PG8_WAIT_L
#undef PG8_BAR
#undef PG8_SCHED
}

struct DenseOrder {
    const bf16_t* A; const bf16_t* Bt; int K; int nM, nN, nwg, G, c;
    __device__ __forceinline__ void init(const bf16_t* A_, const bf16_t* Bt_, int M, int N, int K_, int G_, int c_) { A = A_; Bt = Bt_; K = K_; nM = M / BM; nN = N / BM; nwg = nM * nN; G = G_; c = c_; }
    __device__ __forceinline__ bool next(int i, Unit& u) const {
        const long L = (long)i * G + c; if (L >= nwg) return false;
        int wgid = (int)L; { const int q = nwg / 8, r = nwg % 8, xcd = wgid % 8, off = wgid / 8; wgid = (xcd < r ? xcd * (q + 1) : r * (q + 1) + (xcd - r) * q) + off; }
        const int nig = 8 * nN, gid = wgid / nig, fm = gid * 8, gsz = (nM - fm) < 8 ? (nM - fm) : 8;
        u.pm = fm + ((wgid % nig) % gsz); u.pn = (wgid % nig) / gsz; u.e = 0; u.mt = 0; return true;
    }
    __device__ __forceinline__ const char* a_base(const Unit& u) const { return (const char*)A + (size_t)u.pm * BM * K * 2; }
    __device__ __forceinline__ const char* b_base(const Unit& u) const { return (const char*)Bt + (size_t)u.pn * BM * K * 2; }
    static constexpr bool GATHER = false;
    __device__ __forceinline__ void a_tok(const Unit&, int, unsigned (&)[2]) const {}
};

template <bool GATHER_>
struct MoeOrder {
    static constexpr bool GATHER = GATHER_;
    const LAS int* tstart;
    const LAS int* cnts;
    const LAS int* tmap;
    const int2* list;
    const bf16_t* A;
    const bf16_t* Bt;
    int K, N, lognpn, G, c;
    __device__ __forceinline__ bool next(int i, Unit& u) const {
        const int L = i * G + c; const int total = __builtin_amdgcn_readfirstlane(tstart[65]) << lognpn; if (L >= total) return false;
        const int rt = L >> lognpn; u.pn = L & ((1 << lognpn) - 1); u.pm = rt;
        const int e = __builtin_amdgcn_readfirstlane(tmap[rt]);
        u.e = e; u.mt = rt - __builtin_amdgcn_readfirstlane(tstart[e]); return true;
    }
    __device__ __forceinline__ const char* a_base(const Unit& u) const { return GATHER ? (const char*)A : (const char*)A + (size_t)u.pm * BM * K * 2; }
    __device__ __forceinline__ const char* b_base(const Unit& u) const { return (const char*)Bt + ((size_t)u.e * N + (size_t)u.pn * BM) * K * 2; }
    __device__ __forceinline__ void a_tok(const Unit& u, int tid, unsigned (&pkv)[2]) const {
        const int ce = cnts[u.e];
#pragma unroll
        for (int i = 0; i < 2; ++i) {
            int R, C; stage_rc(tid * 16 + i * 8192, R, C); (void)C;
            unsigned v = 0u;
#pragma unroll
            for (int hh = 0; hh < 2; ++hh) {
                const int idx = u.mt * BM + hh * HALF + R;
                int tok = 0;
                if (idx < ce) tok = (u.e < NE) ? (list[(size_t)u.e * T + idx].x / TOPK) : idx;
                v |= (unsigned)tok << (16 * hh);
            }
            pkv[i] = v;
        }
    }
};

struct EpiProj {
    static constexpr bool PERM = true;
    bf16_t* O; bf16_t* vt;
    __device__ __forceinline__ void operator()(const f32x4 (&acc)[2][2][4][2], const Unit& u, int wr, int wc, int fr, int fq) const {
        const int row0 = u.pm * BM + wr * 64 + fr, col0 = u.pn * BM + wc * 32 + 8 * fq;
#pragma unroll
        for (int bj = 0; bj < 2; ++bj) {
            const bool isv = (u.pn == 8) || (u.pn == 9 && bj == 0);
            if (!isv) {
#pragma unroll
                for (int ai = 0; ai < 2; ++ai)
#pragma unroll
                    for (int m = 0; m < 4; ++m) { bf16_t* rowp = O + (size_t)(row0 + ai * HALF + m * 16) * PJB + col0 + bj * HALF;
                        const f32x4 v0 = acc[ai][bj][m][0], v1 = acc[ai][bj][m][1];
                        u32x4 w; w.x = pk2(v0[0], v0[1]); w.y = pk2(v0[2], v0[3]); w.z = pk2(v1[0], v1[1]); w.w = pk2(v1[2], v1[3]);
                        *(u32x4*)rowp = w; }
            } else {
                const int vc0 = col0 + bj * HALF - 2048;
#pragma unroll
                for (int ai = 0; ai < 2; ++ai)
#pragma unroll
                    for (int m = 0; m < 4; ++m) { const int row = row0 + ai * HALF + m * 16; const int b = row / SEQ, s = row % SEQ;
                        bf16_t* base = vt + ((size_t)b * SBW + vc0) * SEQ + s;
#pragma unroll
                        for (int n = 0; n < 2; ++n)
#pragma unroll
                            for (int j = 0; j < 4; ++j) base[(size_t)(4 * n + j) * SEQ] = (bf16_t)f2bf(acc[ai][bj][m][n][j]); }
            }
        }
    }
};
struct EpiOut {
    static constexpr bool PERM = false;
    const float* xin; float* xo; const float* gt;
    __device__ __forceinline__ void operator()(const f32x4 (&acc)[2][2][4][2], const Unit& u, int wr, int wc, int fr, int fq) const {
        const int row0 = u.pm * BM + wr * 64 + fr, col0 = u.pn * BM + wc * 32 + 4 * fq;
        const float* gr = gt + (size_t)((u.pm * BM) / SEQ) * 6144;
        f32x4 gg[2][2];
#pragma unroll
        for (int bj = 0; bj < 2; ++bj)
#pragma unroll
            for (int n = 0; n < 2; ++n) gg[bj][n] = *(const f32x4*)(gr + col0 + bj * HALF + 16 * n);
#pragma unroll
        for (int am = 0; am < 4; ++am) {
            const int ai = am >> 1, m0 = (am & 1) * 2;
            f32x4 xi[2][2][2];
#pragma unroll
            for (int m = 0; m < 2; ++m)
#pragma unroll
                for (int bj = 0; bj < 2; ++bj)
#pragma unroll
                    for (int n = 0; n < 2; ++n) xi[m][bj][n] = *(const f32x4*)(xin + (size_t)(row0 + ai * HALF + (m0 + m) * 16) * D + col0 + bj * HALF + 16 * n);
#pragma unroll
            for (int m = 0; m < 2; ++m)
#pragma unroll
                for (int bj = 0; bj < 2; ++bj)
#pragma unroll
                    for (int n = 0; n < 2; ++n) *(f32x4*)(xo + (size_t)(row0 + ai * HALF + (m0 + m) * 16) * D + col0 + bj * HALF + 16 * n) = xi[m][bj][n] + gg[bj][n] * acc[ai][bj][m0 + m][n];
        }
    }
};
struct EpiExp1 {
    static constexpr bool PERM = true;
    bf16_t* hm;
    __device__ __forceinline__ void operator()(const f32x4 (&acc)[2][2][4][2], const Unit& u, int wr, int wc, int fr, int fq) const {
        const int row0 = u.pm * BM + wr * 64 + fr, col0 = u.pn * HALF + wc * 32 + 8 * fq;
#pragma unroll
        for (int ai = 0; ai < 2; ++ai)
#pragma unroll
            for (int m = 0; m < 4; ++m) { bf16_t* rowp = hm + (size_t)(row0 + ai * HALF + m * 16) * ED + col0;
                float o[8];
#pragma unroll
                for (int n = 0; n < 2; ++n)
#pragma unroll
                    for (int j = 0; j < 4; ++j) o[n * 4 + j] = siluf_(acc[ai][0][m][n][j]) * acc[ai][1][m][n][j];
                u32x4 w; w.x = pk2(o[0], o[1]); w.y = pk2(o[2], o[3]); w.z = pk2(o[4], o[5]); w.w = pk2(o[6], o[7]);
                *(u32x4*)rowp = w; }
    }
};
struct EpiExp2 {
    static constexpr bool PERM = true;
    unsigned char* slab; const int2* list; const LAS int* cnts;
    __device__ __forceinline__ static unsigned pack4(const f32x4& v, float sc) {
        const float a = __builtin_amdgcn_fmed3f(v[0] * sc, -448.f, 448.f), b = __builtin_amdgcn_fmed3f(v[1] * sc, -448.f, 448.f), c = __builtin_amdgcn_fmed3f(v[2] * sc, -448.f, 448.f), d = __builtin_amdgcn_fmed3f(v[3] * sc, -448.f, 448.f);
        int w = __builtin_amdgcn_cvt_pk_fp8_f32(a, b, 0, false);
        w = __builtin_amdgcn_cvt_pk_fp8_f32(c, d, w, true);
        return (unsigned)w;
    }
    __device__ __forceinline__ void operator()(const f32x4 (&acc)[2][2][4][2], const Unit& u, int wr, int wc, int fr, int fq) const {
        const int col0 = u.pn * BM + wc * 32 + 8 * fq; const int ce = cnts[u.e];
        int2 ri[2][4];
#pragma unroll
        for (int ai = 0; ai < 2; ++ai)
#pragma unroll
            for (int m = 0; m < 4; ++m) { const int idx = u.mt * BM + ai * HALF + wr * 64 + m * 16 + fr;
                ri[ai][m] = make_int2(T * TOPK + idx, __float_as_int(1.f));
                if (u.e < NE && idx < ce) ri[ai][m] = list[(size_t)u.e * T + idx]; }
#pragma unroll
        for (int ai = 0; ai < 2; ++ai)
#pragma unroll
            for (int m = 0; m < 4; ++m) { const int idx = u.mt * BM + ai * HALF + wr * 64 + m * 16 + fr;
                if (idx < ce) {
                    const int row = ri[ai][m].x; const float sc = __int_as_float(ri[ai][m].y) * SLAB_SC;
                    unsigned char* rowp = slab + (size_t)row * D + col0;
#pragma unroll
                    for (int bj = 0; bj < 2; ++bj) *(u32x2*)(rowp + bj * HALF) = (u32x2){pack4(acc[ai][bj][m][0], sc), pack4(acc[ai][bj][m][1], sc)};
                } }
    }
};
}

__device__ __forceinline__ void st_mod(const P& p, int item, LAS float* L  ) {
    const int tid = opaque(threadIdx.x), wave = tid >> 6, lane = tid & 63;
    const int l = item / 96, j0 = (item % 96) * 64;
    for (int i = tid; i < 8 * 1024; i += NTHREADS) L[i] = siluf_(p.c[i]);
    __syncthreads();
    float acc[8];
#pragma unroll
    for (int b = 0; b < 8; ++b) acc[b] = 0.f;
    const float* w = p.w_ada + ((size_t)l * 1024 + wave * 128) * 6144 + j0 + lane;
#pragma unroll 8
    for (int i = 0; i < 128; ++i) {
        const float wv = w[(size_t)i * 6144];
#pragma unroll
        for (int b = 0; b < 8; ++b) acc[b] += L[b * 1024 + wave * 128 + i] * wv;
    }
    LAS float* red = L + 8 * 1024;
#pragma unroll
    for (int b = 0; b < 8; ++b) red[(wave * 8 + b) * 64 + lane] = acc[b];
    __syncthreads();
    {
        const int b = tid >> 6;
        float s = p.b_ada[l * 6144 + j0 + lane];
#pragma unroll
        for (int wv = 0; wv < 8; ++wv) s += red[(wv * 8 + b) * 64 + lane];
        p.mod[((size_t)l * 8 + b) * 6144 + j0 + lane] = s;
    }
    __syncthreads();
}

constexpr int REC_HB = 912, REC_TB = 6 * REC_HB;
constexpr int CB_S64 = 136, CB_S32 = 80;
constexpr int CB_PHI = 0, CB_RT = CB_PHI + 64 * CB_S64, CB_PSI = CB_RT + 32 * CB_S64, CB_G = CB_PSI + 64 * CB_S32, CB_V = CB_G + 32 * CB_S32, CB_BYTES = 26624;
static_assert(CB_V + 64 * CB_S32 <= CB_BYTES && CB_BYTES % 1024 == 0, "chunk buffer layout");
struct CvtJob { const float* W; bf16_t* WT; int K, N, k0, n0, dst_row0; };
__device__ __forceinline__ void cvt_load(const CvtJob& j, float (&wv)[32], int lane) {
#pragma unroll
    for (int i = 0; i < 32; ++i) wv[i] = j.W[(size_t)(j.k0 + 2 * i + (lane >> 5)) * j.N + j.n0 + (lane & 31)];
}
__device__ __forceinline__ void cvt_store(const CvtJob& j, const float (&wv)[32], LAS float* scr, int lane) {
#pragma unroll
    for (int i = 0; i < 32; ++i) scr[(2 * i + (lane >> 5)) * 33 + (lane & 31)] = wv[i];
    asm volatile("s_waitcnt lgkmcnt(0)" ::: "memory");
    const int c = lane & 7;
#pragma unroll
    for (int q = 0; q < 4; ++q) { const int n = (lane >> 3) + 8 * q; const LAS float* sp = scr + (8 * c) * 33 + n;
        u32x4 o; o.x = pk2(sp[0 * 33], sp[1 * 33]); o.y = pk2(sp[2 * 33], sp[3 * 33]); o.z = pk2(sp[4 * 33], sp[5 * 33]); o.w = pk2(sp[6 * 33], sp[7 * 33]);
        *(u32x4*)(j.WT + (size_t)(j.dst_row0 + n) * j.K + j.k0 + 8 * c) = o; }
    asm volatile("s_waitcnt lgkmcnt(0)" ::: "memory");
}
__device__ __forceinline__ void cvt_item(const float* W, int K, int N, int k0, int n0, bf16_t* WT, int dst_row0, LAS float* scr, int lane) {
    const CvtJob j{W, WT, K, N, k0, n0, dst_row0};
    float wv[32];
    cvt_load(j, wv, lane);
    cvt_store(j, wv, scr, lane);
}
constexpr int CV_IN = 16 * 84, CV_VR = 16, CV_OUT = 16 * 32, CV_DENSE_L = CV_IN + CV_VR + CV_OUT, CV_DENSE = NL * CV_DENSE_L;
__device__ __forceinline__ void cvt_dense_item(const P& p, int it, LAS float* scr, int lane) {
    const int l = it / CV_DENSE_L; int r = it % CV_DENSE_L;
    bf16_t* wti = p.wt_in + (size_t)l * PJB * D;
    if (r < CV_IN) { const int kb = r / 84, nb = r % 84; cvt_item(p.w_in + (size_t)l * D * INC, D, INC, kb * 64, nb * 32, wti, nb * 32, scr, lane); return; }
    r -= CV_IN;
    if (r < CV_VR) {
        if (l == 1) cvt_item(p.w_vres, D, 32, r * 64, 0, wti, INC, scr, lane);
        const int rz0 = (l == 1) ? INC + 32 : INC;
        for (int row = rz0 + (lane >> 3); row < PJB; row += 8) *(u32x4*)(wti + (size_t)row * D + r * 64 + (lane & 7) * 8) = (u32x4){0u, 0u, 0u, 0u};
        return;
    }
    r -= CV_VR;
    { const int kb = r / 32, nb = r % 32; cvt_item(p.w_out + (size_t)l * D * D, D, D, kb * 64, nb * 32, p.wt_out + (size_t)l * D * D, nb * 32, scr, lane); }
}
constexpr int CV_EXP_E = 64 + 64 + 64, CV_EXP = 65 * CV_EXP_E, CV_QUOTA1 = 4, CV_QUOTA2 = 5, CV_ROUTER = (T / 16) * 8;
__device__ __forceinline__ CvtJob cvt_exp_job(const P& p, int l, int it) {
    const int e = it / CV_EXP_E; int r = it % CV_EXP_E;
    if (r < 128) {
        const int which = r >> 6; r &= 63; const int kb = r >> 2, nb = r & 3;
        const float* W = e < NE ? (which ? p.w_eu : p.w_eg) + ((size_t)l * NE + e) * D * ED : (which ? p.w_su : p.w_sg) + (size_t)l * D * ED;
        const int n0 = nb * 64, pn = n0 >> 7;
        return CvtJob{W, p.wt1 + (size_t)e * 512 * D, D, ED, kb * 64, n0, pn * 256 + which * 128 + (n0 & 127)};
    } else {
        r -= 128; const int kb = r >> 4, nb = r & 15;
        const float* W = e < NE ? p.w_ed + ((size_t)l * NE + e) * ED * D : p.w_sd + (size_t)l * ED * D;
        return CvtJob{W, p.wt2 + (size_t)e * D * ED, ED, D, kb * 64, nb * 64, nb * 64};
    }
}
__device__ __forceinline__ void cvx_load(const CvtJob& j, float (&wv)[64], int lane) {
    const float* src = j.W + (size_t)j.k0 * j.N + j.n0 + lane;
#pragma unroll
    for (int i = 0; i < 64; ++i) wv[i] = src[(size_t)i * j.N];
}
__device__ __forceinline__ void cvx_store(const CvtJob& j, const float (&wv)[64], int lane) {
    bf16_t* dst = j.WT + (size_t)(j.dst_row0 + lane) * j.K + j.k0;
#pragma unroll
    for (int g = 0; g < 8; ++g) *(u32x4*)(dst + 8 * g) = (u32x4){pk2(wv[8 * g], wv[8 * g + 1]), pk2(wv[8 * g + 2], wv[8 * g + 3]), pk2(wv[8 * g + 4], wv[8 * g + 5]), pk2(wv[8 * g + 6], wv[8 * g + 7])};
}
__device__ __forceinline__ void cvh_load(const CvtJob& j, int hf, float (&wv)[32], int lane) {
    const float* src = j.W + (size_t)(j.k0 + 32 * hf) * j.N + j.n0 + lane;
#pragma unroll
    for (int i = 0; i < 32; ++i) wv[i] = src[(size_t)i * j.N];
}
__device__ __forceinline__ void cvh_store(const CvtJob& j, int hf, const float (&wv)[32], int lane) {
    bf16_t* dst = j.WT + (size_t)(j.dst_row0 + lane) * j.K + j.k0 + 32 * hf;
#pragma unroll
    for (int g = 0; g < 4; ++g) *(u32x4*)(dst + 8 * g) = (u32x4){pk2(wv[8 * g], wv[8 * g + 1]), pk2(wv[8 * g + 2], wv[8 * g + 3]), pk2(wv[8 * g + 4], wv[8 * g + 5]), pk2(wv[8 * g + 6], wv[8 * g + 7])};
}
__device__ __forceinline__ void cvt_exp_stream(const P& p, int l, int first, int stride, int CV_END, int lane) {
    if (first >= CV_END) return;
    float wa[64], wb[64];
    CvtJob ja = cvt_exp_job(p, l, first), jb = ja;
    cvx_load(ja, wa, lane);
    for (int it = first; it < CV_END; it += 2 * stride) {
        const bool hb = it + stride < CV_END;
        if (hb) { jb = cvt_exp_job(p, l, it + stride); cvx_load(jb, wb, lane); }
        cvx_store(ja, wa, lane);
        if (!hb) break;
        const bool ha = it + 2 * stride < CV_END;
        if (ha) { ja = cvt_exp_job(p, l, it + 2 * stride); cvx_load(ja, wa, lane); }
        cvx_store(jb, wb, lane);
        if (!ha) break;
    }
}
__device__ __forceinline__ void st_cpre(const P& p, int item, LAS unsigned char* L, int lane_);
constexpr int CP_LDS = 20736;
constexpr int PREP_TOK = 64, PREP_XS = 168;
__device__ __forceinline__ float xlane_(float x, int lane, int m) { return __builtin_bit_cast(float, __builtin_amdgcn_ds_bpermute((lane ^ m) << 2, __builtin_bit_cast(int, x))); }
template <int LY>
__device__ __forceinline__ void prep_step2(const P& p, int t0, int s0, int hh, const LAS bf16_t* X, const LAS float* PRM  , int lane_) {
    const int ll = opaque(lane_), fr2 = ll & 15, fq2 = ll >> 4;
    const bf16_t* lw = p.lwt + ((size_t)LY * RWW + hh * 64) * 160;
    const int c0 = hh * 64 + 4 * fq2;
    const LAS float* prm = PRM + 4 * fq2;
    {
        bf16x8 fw[4], fa[4], fv[4];
#pragma unroll
        for (int nt = 0; nt < 4; ++nt) {
            const bf16_t* q = lw + (16 * nt + fr2) * 160 + 8 * fq2;
            fw[nt] = *(const bf16x8*)q; fa[nt] = *(const bf16x8*)(q + 32); fv[nt] = *(const bf16x8*)(q + (LY == 1 ? 128 : 0));
        }
#pragma unroll 1
        for (int mt = 0; mt < 4; ++mt) {
            const int tok = t0 + 16 * mt + fr2;
            const bool hasprev = (s0 + 16 * mt + fr2) > 0;
            u32x2 rcu[4], rpv[4], kcu[4], kpv[4], vcu[4], vpv[4], vfi[4];
#pragma unroll
            for (int nt = 0; nt < 4; ++nt) {
                const bf16_t* u = p.proj + (size_t)tok * PJB + c0 + 16 * nt;
                const bf16_t* up = hasprev ? u - PJB : u;
                rcu[nt] = *(const u32x2*)u; kcu[nt] = *(const u32x2*)(u + 384); vcu[nt] = *(const u32x2*)(u + 768);
                rpv[nt] = *(const u32x2*)up; kpv[nt] = *(const u32x2*)(up + 384); vpv[nt] = *(const u32x2*)(up + 768);
                if (LY == 1) vfi[nt] = *(const u32x2*)(p.vfirst + (size_t)tok * RWW + c0 + 16 * nt); else vfi[nt] = (u32x2){0u, 0u};
            }
            const unsigned pm = hasprev ? 0xffffffffu : 0u;
            const LAS bf16_t* xa = X + (16 * mt + fr2) * PREP_XS + 8 * fq2;
            const bf16x8 Aw = *(const LAS bf16x8*)xa, Aa = *(const LAS bf16x8*)(xa + 32), Av = *(const LAS bf16x8*)(xa + 128);
            float ksh[4][4], ss = 0.f;
#pragma unroll
            for (int nt = 0; nt < 4; ++nt) {
                const f32x4 muk = *(const LAS f32x4*)(prm + 7 * 64 + 16 * nt), kkc = *(const LAS f32x4*)(prm + 3 * 64 + 16 * nt);
                const unsigned k0 = kpv[nt].x & pm, k1 = kpv[nt].y & pm;
                const float kc[4] = {bflo(kcu[nt].x), bfhi(kcu[nt].x), bflo(kcu[nt].y), bfhi(kcu[nt].y)}, kp[4] = {bflo(k0), bfhi(k0), bflo(k1), bfhi(k1)};
#pragma unroll
                for (int rg = 0; rg < 4; ++rg) { const float k = kc[rg] + (kp[rg] - kc[rg]) * muk[rg]; ksh[nt][rg] = k; ss += (k * kkc[rg]) * (k * kkc[rg]); }
            }
            ss += xlane_(ss, ll, 16); ss += xlane_(ss, ll, 32);
            const float inrm = rcpf_(fmaxf(__builtin_amdgcn_sqrtf(ss), 1e-12f));
            float rkp = 0.f;
            unsigned char* rc = p.rec + (size_t)tok * REC_TB + hh * REC_HB;
#pragma unroll
            for (int nt = 0; nt < 4; ++nt) {
                const int c = c0 + 16 * nt;
                __builtin_amdgcn_sched_barrier(0);
                const f32x4 awn = __builtin_amdgcn_mfma_f32_16x16x32_bf16(fw[nt], Aw, (f32x4){0.f, 0.f, 0.f, 0.f}, 0, 0, 0);
                const f32x4 aan = __builtin_amdgcn_mfma_f32_16x16x32_bf16(fa[nt], Aa, (f32x4){0.f, 0.f, 0.f, 0.f}, 0, 0, 0);
                f32x4 avn = (f32x4){0.f, 0.f, 0.f, 0.f};
                if (LY == 1) avn = __builtin_amdgcn_mfma_f32_16x16x32_bf16(fv[nt], Av, (f32x4){0.f, 0.f, 0.f, 0.f}, 0, 0, 0);
                const LAS float* pq = prm + 16 * nt;
                const f32x4 w0 = *(const LAS f32x4*)pq, a0 = *(const LAS f32x4*)(pq + 64), v0 = *(const LAS f32x4*)(pq + 128);
                const f32x4 kkc = *(const LAS f32x4*)(pq + 192), kac = *(const LAS f32x4*)(pq + 256), rkc = *(const LAS f32x4*)(pq + 320);
                const f32x4 mur = *(const LAS f32x4*)(pq + 384), muv = *(const LAS f32x4*)(pq + 512);
                const unsigned r0 = rpv[nt].x & pm, r1 = rpv[nt].y & pm, q0 = vpv[nt].x & pm, q1 = vpv[nt].y & pm;
                const float rcv[4] = {bflo(rcu[nt].x), bfhi(rcu[nt].x), bflo(rcu[nt].y), bfhi(rcu[nt].y)}, rpp[4] = {bflo(r0), bfhi(r0), bflo(r1), bfhi(r1)};
                const float vcv[4] = {bflo(vcu[nt].x), bfhi(vcu[nt].x), bflo(vcu[nt].y), bfhi(vcu[nt].y)}, vpp[4] = {bflo(q0), bfhi(q0), bflo(q1), bfhi(q1)};
                const float vfv[4] = {bflo(vfi[nt].x), bfhi(vfi[nt].x), bflo(vfi[nt].y), bfhi(vfi[nt].y)};
                float dec[4], oa[4], ob[4], ok[4], oq[4], ov[4];
#pragma unroll
                for (int rg = 0; rg < 4; ++rg) {
                    const float r = rcv[rg] + (rpp[rg] - rcv[rg]) * mur[rg]; float v = vcv[rg] + (vpp[rg] - vcv[rg]) * muv[rg]; const float k = ksh[nt][rg];
                    const float wlog = -softplusf_(-(awn[rg] + w0[rg])) - 0.5f;
                    const float decay = exp2f_(-LOG2E * exp2f_(LOG2E * wlog));
                    const float a = sigmoidf_(aan[rg] + a0[rg]);
                    if (LY == 1) { const float vg = sigmoidf_(avn[rg] + v0[rg]); v = v + (vfv[rg] - v) * vg; }
                    const float kk = k * kkc[rg] * inrm;
                    const float k2 = k * (1.f + (a - 1.f) * kac[rg]);
                    dec[rg] = decay; oa[rg] = -kk; ob[rg] = kk * a; ok[rg] = k2; oq[rg] = decay * r; ov[rg] = v;
                    rkp += r * k2 * rkc[rg];
                }
                *(f32x4*)(rc + (16 * nt + 4 * fq2) * 4) = (f32x4){dec[0], dec[1], dec[2], dec[3]};
                bf16_t* rb = (bf16_t*)(rc + 256) + 16 * nt + 4 * fq2;
                *(u32x2*)rb = (u32x2){pk2(oa[0], oa[1]), pk2(oa[2], oa[3])};
                *(u32x2*)(rb + 64) = (u32x2){pk2(ob[0], ob[1]), pk2(ob[2], ob[3])};
                *(u32x2*)(rb + 128) = (u32x2){pk2(ok[0], ok[1]), pk2(ok[2], ok[3])};
                *(u32x2*)(rb + 192) = (u32x2){pk2(oq[0], oq[1]), pk2(oq[2], oq[3])};
                *(u32x2*)(rb + 256) = (u32x2){pk2(ov[0], ov[1]), pk2(ov[2], ov[3])};
                if (LY == 0) *(u32x2*)(p.vfirst + (size_t)tok * RWW + c) = (u32x2){pk2(ov[0], ov[1]), pk2(ov[2], ov[3])};
            }
            rkp += xlane_(rkp, ll, 16); rkp += xlane_(rkp, ll, 32);
            if (fq2 == 0) *(float*)(rc + 896) = rkp;
        }
    }
    {
        bf16x8 g0[4], g1[4];
#pragma unroll
        for (int nt = 0; nt < 4; ++nt) { const bf16_t* q = lw + (16 * nt + fr2) * 160 + 64 + 8 * fq2; g0[nt] = *(const bf16x8*)q; g1[nt] = *(const bf16x8*)(q + 32); }
#pragma unroll 1
        for (int mt = 0; mt < 4; ++mt) {
            const int tok = t0 + 16 * mt + fr2;
            const LAS bf16_t* xa = X + (16 * mt + fr2) * PREP_XS + 8 * fq2;
            const bf16x8 Ag0 = *(const LAS bf16x8*)(xa + 64), Ag1 = *(const LAS bf16x8*)(xa + 96);
#pragma unroll
            for (int nt = 0; nt < 4; ++nt) {
                f32x4 ag = __builtin_amdgcn_mfma_f32_16x16x32_bf16(g0[nt], Ag0, (f32x4){0.f, 0.f, 0.f, 0.f}, 0, 0, 0);
                ag = __builtin_amdgcn_mfma_f32_16x16x32_bf16(g1[nt], Ag1, ag, 0, 0, 0);
                *(u32x2*)(p.g + (size_t)tok * RWW + c0 + 16 * nt) = (u32x2){pk2(ag[0], ag[1]), pk2(ag[2], ag[3])};
            }
        }
    }
}
__device__ __forceinline__ void st_prep(const P& p, int l, int vb0, int vbstride, LAS unsigned char* L, int psel) {
    const int tid = opaque(threadIdx.x), wave = __builtin_amdgcn_readfirstlane(tid >> 6), lane = tid & 63;
    LAS bf16_t* X = (LAS bf16_t*)L;
    for (int vb = vb0; vb < T / PREP_TOK; vb += vbstride) {
        const int t0 = vb * PREP_TOK, s0 = t0 % SEQ;
        const int tx = opaque(tid);
        if ((psel & 1) && tx < 480) {
            const int cp = tx % 80, ta = (tx / 80) * 11, i = 2 * cp;
            const int col = (i < 128) ? 1152 + i : INC + (i - 128);
            const f32x2 mu = (i < 128) ? *(const f32x2*)(p.mu_rw + l * RWC + col) : *(const f32x2*)(p.mu_vres + (i - 128));
            const bf16_t* u = p.proj + (size_t)(t0 + ta) * PJB + col;
            unsigned cur[12];
            cur[0] = (s0 + ta > 0) ? *(const unsigned*)(u - PJB) : 0u;
#pragma unroll
            for (int j = 0; j < 11; ++j) cur[j + 1] = *(const unsigned*)(u + (size_t)min(j, 63 - ta) * PJB);
#pragma unroll
            for (int j = 0; j < 11; ++j) {
                const float u0 = bflo(cur[j + 1]), u1 = bfhi(cur[j + 1]), p0 = bflo(cur[j]), p1 = bfhi(cur[j]);
                float x0 = u0 + (p0 - u0) * mu[0], x1 = u1 + (p1 - u1) * mu[1];
                if (i < 32) { x0 = 1.f - 2.f * rcpf_(exp2f_(2.f * LOG2E * x0) + 1.f); x1 = 1.f - 2.f * rcpf_(exp2f_(2.f * LOG2E * x1) + 1.f); }
                else if (i >= 64 && i < 128) { x0 = sigmoidf_(x0); x1 = sigmoidf_(x1); }
                if (i >= 128 && l == 0) { x0 = 0.f; x1 = 0.f; }
                if (ta + j < PREP_TOK) *(LAS unsigned*)(X + (ta + j) * PREP_XS + i) = pk2(x0, x1);
            }
        }
        if (psel & 2) {
            LAS float* PR = (LAS float*)(L + 2 * CP_LDS);
            for (int idx = tx; idx < 6 * 576; idx += NTHREADS) {
                const int hq = idx / 576, ar = (idx % 576) >> 6, c = hq * 64 + (idx & 63);
                float v;
                if (ar == 0) v = p.rw_w0[l * RWW + c]; else if (ar == 1) v = p.rw_a0[l * RWW + c]; else if (ar == 2) v = (l == 1) ? p.rw_v0[c] : 0.f;
                else if (ar == 3) v = p.rw_k_k[l * RWW + c]; else if (ar == 4) v = p.rw_k_a[l * RWW + c]; else if (ar == 5) v = p.rw_r_k[l * RWW + c];
                else if (ar == 6) v = p.mu_rw[l * RWC + c]; else if (ar == 7) v = p.mu_rw[l * RWC + 384 + c]; else v = p.mu_rw[l * RWC + 768 + c];
                PR[idx] = v;
            }
        }
        __syncthreads();
        const int iw = 2 * vb0 + (wave - 6), istr = 2 * vbstride;
        if (wave >= 6) { if ((psel & 8) && vb == vb0) cvt_exp_stream(p, l, iw, istr, min(CV_EXP, iw + CV_QUOTA1 * istr), lane); }
        if (wave < 6 && (psel & 2)) { const LAS float* prm = (const LAS float*)(L + 2 * CP_LDS) + wave * 576; if (l == 0) prep_step2<0>(p, t0, s0, wave, X, prm, lane); else prep_step2<1>(p, t0, s0, wave, X, prm, lane); }
        __syncthreads();
        if (wave < 6) {
            if (psel & 4) {
            const int b = t0 / SEQ, ch0 = s0 / 32;
#pragma unroll 1
            for (int q = 0; q < 2; ++q) st_cpre(p, ((b * 6 + wave) * 64) + ch0 + q, L + wave * CP_LDS, lane);
            }
        } else if ((psel & 8) && vb == vb0) cvt_exp_stream(p, l, iw + CV_QUOTA1 * istr, istr, min(CV_EXP, iw + (CV_QUOTA1 + CV_QUOTA2) * istr), lane);
        __syncthreads();
    }
}

typedef float f32x16 __attribute__((ext_vector_type(16)));
__device__ __forceinline__ bf16x8 acc_frag(const f32x16& x, int ks) {
    return ks == 0 ? mk8(cvtpk(x[0], x[1]), cvtpk(x[2], x[3]), cvtpk(x[4], x[5]), cvtpk(x[6], x[7])) : mk8(cvtpk(x[8], x[9]), cvtpk(x[10], x[11]), cvtpk(x[12], x[13]), cvtpk(x[14], x[15]));
}
__device__ __forceinline__ bf16x8 lds_perm_frag(const LAS unsigned char* rowp, int ks, int hf) {
    const u32x2 g0 = *(const LAS u32x2*)(rowp + (16 * ks + 4 * hf) * 2), g1 = *(const LAS u32x2*)(rowp + (16 * ks + 4 * hf + 8) * 2);
    return mk8(g0.x, g0.y, g1.x, g1.y);
}
__device__ __forceinline__ void st_cpre(const P& p, int item, LAS unsigned char* L, int lane_) {
    const int lane = opaque(lane_);
    const int ch = item & 63, bh = item >> 6, b = bh / 6, hh = bh % 6;
    const int r = lane & 31, hf = lane >> 5;
    const unsigned char* rec0 = p.rec + ((size_t)(b * SEQ + ch * 32)) * REC_TB + hh * REC_HB;
    unsigned char* cbo = p.cb + (size_t)item * CB_BYTES;
    LAS unsigned char* AbarT = L; LAS unsigned char* RbarT = L + 4096; LAS unsigned char* Bbar = L + 8192; LAS unsigned char* Kbar = L + 12288; LAS unsigned char* BbarT = L + 16384;
    LAS float* PCv = (LAS float*)(L + 20480);
    float Y[32];
    {
        float Pc = 1.f;
        unsigned bt[16], vtw[16];
#pragma unroll
        for (int t8 = 0; t8 < 32; t8 += 16) {
            float wv[16]; bf16_t av[16], bv[16], kv[16], qv[16], vv[16];
#pragma unroll
            for (int j = 0; j < 16; ++j) {
                const unsigned char* rp = rec0 + (size_t)(t8 + j) * REC_TB;
                wv[j] = *(const float*)(rp + lane * 4);
                const bf16_t* hb = (const bf16_t*)(rp + 256) + lane;
                av[j] = hb[0]; bv[j] = hb[64]; kv[j] = hb[128]; qv[j] = hb[192]; vv[j] = hb[256];
            }
#pragma unroll
            for (int j = 0; j < 16; ++j) {
                const int t = t8 + j;
                const float Pm = Pc; Pc *= wv[j]; const float inv = rcpf_(Pc);
                const float ab = bf2f(av[j]) * Pm, rb = bf2f(qv[j]) * Pm, bb = bf2f(bv[j]) * inv, kb = bf2f(kv[j]) * inv;
                Y[t] = ab;
                *(LAS bf16_t*)(AbarT + (t * 64 + lane) * 2) = (bf16_t)f2bf(ab);
                *(LAS bf16_t*)(RbarT + (t * 64 + lane) * 2) = (bf16_t)f2bf(rb);
                *(LAS bf16_t*)(Bbar + (t * 64 + lane) * 2) = (bf16_t)f2bf(bb);
                *(LAS bf16_t*)(Kbar + (t * 64 + lane) * 2) = (bf16_t)f2bf(kb);
                if (t & 1) { bt[t >> 1] |= f2bf(bb) << 16; vtw[t >> 1] |= (unsigned)vv[j] << 16; } else { bt[t >> 1] = f2bf(bb); vtw[t >> 1] = (unsigned)vv[j]; }
            }
            asm volatile("" ::: "memory");
        }
        PCv[lane] = Pc;
#pragma unroll
        for (int q = 0; q < 4; ++q) {
            *(LAS u32x4*)(BbarT + lane * 64 + q * 16) = (u32x4){bt[4 * q], bt[4 * q + 1], bt[4 * q + 2], bt[4 * q + 3]};
            *(u32x4*)(cbo + CB_V + lane * CB_S32 + q * 16) = (u32x4){vtw[4 * q], vtw[4 * q + 1], vtw[4 * q + 2], vtw[4 * q + 3]};
        }
    }
    asm volatile("s_waitcnt lgkmcnt(0)" ::: "memory");
    f32x16 Lab, Lak, Mbr, Mkr;
#pragma unroll
    for (int i = 0; i < 16; ++i) { Lab[i] = 0.f; Lak[i] = 0.f; Mbr[i] = 0.f; Mkr[i] = 0.f; }
#pragma unroll
    for (int ks = 0; ks < 4; ++ks) {
        const int off = (r * 64 + 16 * ks + 8 * hf) * 2;
        const bf16x8 fb = *(const LAS bf16x8*)(Bbar + off), fk = *(const LAS bf16x8*)(Kbar + off), fa = *(const LAS bf16x8*)(AbarT + off), fr = *(const LAS bf16x8*)(RbarT + off);
        Lab = __builtin_amdgcn_mfma_f32_32x32x16_bf16(fb, fa, Lab, 0, 0, 0);
        Lak = __builtin_amdgcn_mfma_f32_32x32x16_bf16(fk, fa, Lak, 0, 0, 0);
        Mbr = __builtin_amdgcn_mfma_f32_32x32x16_bf16(fb, fr, Mbr, 0, 0, 0);
        Mkr = __builtin_amdgcn_mfma_f32_32x32x16_bf16(fk, fr, Mkr, 0, 0, 0);
    }
#pragma unroll
    for (int i = 0; i < 16; ++i) {
        const int s = (i & 3) + 8 * (i >> 2) + 4 * hf;
        if (!(s < r)) { Lab[i] = 0.f; Lak[i] = 0.f; }
        if (!(s <= r)) { Mbr[i] = 0.f; Mkr[i] = 0.f; }
    }
    asm volatile("s_waitcnt lgkmcnt(0)" ::: "memory");
    {
        LAS float* LabT = (LAS float*)AbarT; LAS float* LakM = (LAS float*)Bbar;
#pragma unroll
        for (int g = 0; g < 4; ++g) *(LAS f32x4*)(LabT + r * 32 + 8 * g + 4 * hf) = (f32x4){Lab[4 * g], Lab[4 * g + 1], Lab[4 * g + 2], Lab[4 * g + 3]};
#pragma unroll
        for (int i = 0; i < 16; ++i) LakM[((i & 3) + 8 * (i >> 2) + 4 * hf) * 32 + r] = Lak[i];
    }
    asm volatile("s_waitcnt lgkmcnt(0)" ::: "memory");
    unsigned W2p[16];
    {
        const LAS float* LabT = (const LAS float*)AbarT; const LAS float* LakM = (const LAS float*)Bbar;
        float X2[32];
#pragma unroll
        for (int t = 0; t < 32; t += 4) { const f32x4 q = *(const LAS f32x4*)(LakM + r * 32 + t); X2[t] = q[0]; X2[t + 1] = q[1]; X2[t + 2] = q[2]; X2[t + 3] = q[3]; }
        int zdep = 0;
#pragma unroll
        for (int t = 1; t < 32; ++t) {
            float x1 = Y[t], x2 = X2[t];
            const LAS float* row = LabT + t * 32 + zdep;
#pragma unroll
            for (int s4 = 0; s4 < t; s4 += 4) {
                const f32x4 lq = *(const LAS f32x4*)(row + s4);
#pragma unroll
                for (int q = 0; q < 4; ++q) if (s4 + q < t) { x1 = fmaf(Y[s4 + q], lq[q], x1); x2 = fmaf(X2[s4 + q], lq[q], x2); }
            }
            Y[t] = x1; X2[t] = x2;
            asm volatile("v_mov_b32 %0, 0" : "=v"(zdep) : "v"(x1), "v"(x2));
        }
#pragma unroll
        for (int q = 0; q < 16; ++q) W2p[q] = pk2(X2[2 * q], X2[2 * q + 1]);
    }
    asm volatile("s_waitcnt lgkmcnt(0)" ::: "memory");
    LAS unsigned char* Atil = L;
    LAS unsigned char* Wv = L + 8192;
#pragma unroll
    for (int q = 0; q < 4; ++q) {
        *(LAS u32x4*)(Atil + lane * 64 + q * 16) = (u32x4){pk2(Y[8 * q], Y[8 * q + 1]), pk2(Y[8 * q + 2], Y[8 * q + 3]), pk2(Y[8 * q + 4], Y[8 * q + 5]), pk2(Y[8 * q + 6], Y[8 * q + 7])};
        if (lane < 32) *(LAS u32x4*)(Wv + lane * 64 + q * 16) = (u32x4){W2p[4 * q], W2p[4 * q + 1], W2p[4 * q + 2], W2p[4 * q + 3]};
    }
    asm volatile("s_waitcnt lgkmcnt(0)" ::: "memory");
    const bf16x8 mb0 = acc_frag(Mbr, 0), mb1 = acc_frag(Mbr, 1);
#pragma unroll
    for (int i = 0; i < 2; ++i) {
        f32x16 c;
#pragma unroll
        for (int g = 0; g < 4; ++g) { const u32x2 q = *(const LAS u32x2*)(RbarT + (r * 64 + 32 * i + 8 * g + 4 * hf) * 2); c[4 * g] = bflo(q.x); c[4 * g + 1] = bfhi(q.x); c[4 * g + 2] = bflo(q.y); c[4 * g + 3] = bfhi(q.y); }
        c = __builtin_amdgcn_mfma_f32_32x32x16_bf16(lds_perm_frag(Atil + (32 * i + r) * 64, 0, hf), mb0, c, 0, 0, 0);
        c = __builtin_amdgcn_mfma_f32_32x32x16_bf16(lds_perm_frag(Atil + (32 * i + r) * 64, 1, hf), mb1, c, 0, 0, 0);
#pragma unroll
        for (int g = 0; g < 4; ++g) *(u32x2*)(cbo + CB_RT + r * CB_S64 + (32 * i + 8 * g + 4 * hf) * 2) = (u32x2){cvtpk(c[4 * g], c[4 * g + 1]), cvtpk(c[4 * g + 2], c[4 * g + 3])};
    }
    {
        f32x16 c = Mkr;
        c = __builtin_amdgcn_mfma_f32_32x32x16_bf16(lds_perm_frag(Wv + r * 64, 0, hf), mb0, c, 0, 0, 0);
        c = __builtin_amdgcn_mfma_f32_32x32x16_bf16(lds_perm_frag(Wv + r * 64, 1, hf), mb1, c, 0, 0, 0);
#pragma unroll
        for (int g = 0; g < 4; ++g) *(u32x2*)(cbo + CB_G + r * CB_S32 + (8 * g + 4 * hf) * 2) = (u32x2){cvtpk(c[4 * g], c[4 * g + 1]), cvtpk(c[4 * g + 2], c[4 * g + 3])};
    }
#pragma unroll
    for (int jt = 0; jt < 2; ++jt) {
        const float pc = PCv[32 * jt + r];
        const bf16x8 fb0 = *(const LAS bf16x8*)(BbarT + (32 * jt + r) * 64 + (8 * hf) * 2), fb1 = *(const LAS bf16x8*)(BbarT + (32 * jt + r) * 64 + (16 + 8 * hf) * 2);
#pragma unroll
        for (int i = 0; i < 2; ++i) {
            f32x16 c;
#pragma unroll
            for (int q = 0; q < 16; ++q) c[q] = 0.f;
            c = __builtin_amdgcn_mfma_f32_32x32x16_bf16(*(const LAS bf16x8*)(Atil + (32 * i + r) * 64 + (8 * hf) * 2), fb0, c, 0, 0, 0);
            c = __builtin_amdgcn_mfma_f32_32x32x16_bf16(*(const LAS bf16x8*)(Atil + (32 * i + r) * 64 + (16 + 8 * hf) * 2), fb1, c, 0, 0, 0);
#pragma unroll
            for (int q = 0; q < 16; ++q) { const int kq = (q & 3) + 8 * (q >> 2) + 4 * hf; c[q] = (c[q] + ((i == jt && kq == r) ? 1.f : 0.f)) * pc; }
#pragma unroll
            for (int g = 0; g < 4; ++g) *(u32x2*)(cbo + CB_PHI + (32 * jt + r) * CB_S64 + (32 * i + 8 * g + 4 * hf) * 2) = (u32x2){cvtpk(c[4 * g], c[4 * g + 1]), cvtpk(c[4 * g + 2], c[4 * g + 3])};
        }
        {
            f32x16 c;
#pragma unroll
            for (int q = 0; q < 16; ++q) c[q] = bf2f(*(const LAS bf16_t*)(Kbar + (((q & 3) + 8 * (q >> 2) + 4 * hf) * 64 + 32 * jt + r) * 2));
            c = __builtin_amdgcn_mfma_f32_32x32x16_bf16(*(const LAS bf16x8*)(Wv + r * 64 + (8 * hf) * 2), fb0, c, 0, 0, 0);
            c = __builtin_amdgcn_mfma_f32_32x32x16_bf16(*(const LAS bf16x8*)(Wv + r * 64 + (16 + 8 * hf) * 2), fb1, c, 0, 0, 0);
#pragma unroll
            for (int g = 0; g < 4; ++g) *(u32x2*)(cbo + CB_PSI + (32 * jt + r) * CB_S32 + (8 * g + 4 * hf) * 2) = (u32x2){cvtpk(c[4 * g] * pc, c[4 * g + 1] * pc), cvtpk(c[4 * g + 2] * pc, c[4 * g + 3] * pc)};
        }
    }
    asm volatile("s_waitcnt lgkmcnt(0)" ::: "memory");
}

constexpr int CS_SLOTS = 4, CS_NP = CB_BYTES / 1024;
__device__ __forceinline__ void st_cscan(const P& p, int bh, LAS unsigned char* lds) {
    const int tid = opaque(threadIdx.x), wave = __builtin_amdgcn_readfirstlane(tid >> 6), lane = tid & 63;
    const int b = bh / 6, hh = bh % 6, r = lane & 31, hf = lane >> 5;
    const unsigned char* cb0 = p.cb + (size_t)bh * 64 * CB_BYTES;
    constexpr int NCH = SEQ / 32;
    const int lw = wave - 2;
#define CS_ISSUE(chunk) do { const int _c = (chunk) < NCH ? (chunk) : NCH - 1; const unsigned char* _g = cb0 + (size_t)_c * CB_BYTES + lane * 16; LAS unsigned char* _l = lds + ((chunk) & 3) * CB_BYTES; \
        _Pragma("unroll") for (int _j = 0; _j < 5; ++_j) if (lw + 6 * _j < CS_NP) __builtin_amdgcn_global_load_lds((const unsigned*)(_g + (lw + 6 * _j) * 1024), (LAS unsigned*)(_l + (lw + 6 * _j) * 1024), 16, 0, 0); } while (0)
    f32x16 X0, X1;
#pragma unroll
    for (int i = 0; i < 16; ++i) { X0[i] = 0.f; X1[i] = 0.f; }
    if (wave >= 2) { CS_ISSUE(0); CS_ISSUE(1); CS_ISSUE(2); }
    bf16_t* yb = p.y + (size_t)b * SEQ * RWW + hh * 64 + 32 * wave + r;
    for (int c = 0; c < NCH; ++c) {
        if (wave >= 2) { if (lw < 2) asm volatile("s_waitcnt vmcnt(10)" ::: "memory"); else asm volatile("s_waitcnt vmcnt(8)" ::: "memory"); }
        __builtin_amdgcn_s_barrier();
        if (wave >= 2) { CS_ISSUE(c + 3); }
        else {
            const LAS unsigned char* S = lds + (c & 3) * CB_BYTES;
            const int vr = 32 * wave + r;
            const bf16x8 vf0 = *(const LAS bf16x8*)(S + CB_V + vr * CB_S32 + (8 * hf) * 2), vf1 = *(const LAS bf16x8*)(S + CB_V + vr * CB_S32 + (16 + 8 * hf) * 2);
            const LAS unsigned char* rp = S + CB_RT + r * CB_S64;
            const bf16x8 fr0 = lds_perm_frag(rp, 0, hf), fr1 = lds_perm_frag(rp, 1, hf), fr2 = lds_perm_frag(rp + 64, 0, hf), fr3 = lds_perm_frag(rp + 64, 1, hf);
            const bf16x8 fg0 = *(const LAS bf16x8*)(S + CB_G + r * CB_S32 + (8 * hf) * 2), fg1 = *(const LAS bf16x8*)(S + CB_G + r * CB_S32 + (16 + 8 * hf) * 2);
            const LAS unsigned char* p0 = S + CB_PHI + r * CB_S64; const LAS unsigned char* p1 = S + CB_PHI + (32 + r) * CB_S64;
            const bf16x8 fa0 = lds_perm_frag(p0, 0, hf), fa1 = lds_perm_frag(p0, 1, hf), fa2 = lds_perm_frag(p0 + 64, 0, hf), fa3 = lds_perm_frag(p0 + 64, 1, hf);
            const bf16x8 fb0 = lds_perm_frag(p1, 0, hf), fb1 = lds_perm_frag(p1, 1, hf), fb2 = lds_perm_frag(p1 + 64, 0, hf), fb3 = lds_perm_frag(p1 + 64, 1, hf);
            const LAS unsigned char* q0 = S + CB_PSI + r * CB_S32; const LAS unsigned char* q1 = S + CB_PSI + (32 + r) * CB_S32;
            const bf16x8 fp0 = *(const LAS bf16x8*)(q0 + (8 * hf) * 2), fp1 = *(const LAS bf16x8*)(q0 + (16 + 8 * hf) * 2), fp2 = *(const LAS bf16x8*)(q1 + (8 * hf) * 2), fp3 = *(const LAS bf16x8*)(q1 + (16 + 8 * hf) * 2);
            const bf16x8 x00 = acc_frag(X0, 0), x01 = acc_frag(X0, 1), x10 = acc_frag(X1, 0), x11 = acc_frag(X1, 1);
            asm volatile("s_waitcnt lgkmcnt(0)" ::: "memory");
            __builtin_amdgcn_sched_barrier(0);
            f32x16 yc, n0, n1;
#pragma unroll
            for (int i = 0; i < 16; ++i) { yc[i] = 0.f; n0[i] = 0.f; n1[i] = 0.f; }
            n0 = __builtin_amdgcn_mfma_f32_32x32x16_bf16(fa0, x00, n0, 0, 0, 0);
            n1 = __builtin_amdgcn_mfma_f32_32x32x16_bf16(fb0, x00, n1, 0, 0, 0);
            yc = __builtin_amdgcn_mfma_f32_32x32x16_bf16(fr0, x00, yc, 0, 0, 0);
            n0 = __builtin_amdgcn_mfma_f32_32x32x16_bf16(fa1, x01, n0, 0, 0, 0);
            n1 = __builtin_amdgcn_mfma_f32_32x32x16_bf16(fb1, x01, n1, 0, 0, 0);
            yc = __builtin_amdgcn_mfma_f32_32x32x16_bf16(fr1, x01, yc, 0, 0, 0);
            n0 = __builtin_amdgcn_mfma_f32_32x32x16_bf16(fa2, x10, n0, 0, 0, 0);
            n1 = __builtin_amdgcn_mfma_f32_32x32x16_bf16(fb2, x10, n1, 0, 0, 0);
            yc = __builtin_amdgcn_mfma_f32_32x32x16_bf16(fr2, x10, yc, 0, 0, 0);
            n0 = __builtin_amdgcn_mfma_f32_32x32x16_bf16(fa3, x11, n0, 0, 0, 0);
            n1 = __builtin_amdgcn_mfma_f32_32x32x16_bf16(fb3, x11, n1, 0, 0, 0);
            yc = __builtin_amdgcn_mfma_f32_32x32x16_bf16(fr3, x11, yc, 0, 0, 0);
            n0 = __builtin_amdgcn_mfma_f32_32x32x16_bf16(fp0, vf0, n0, 0, 0, 0);
            n1 = __builtin_amdgcn_mfma_f32_32x32x16_bf16(fp2, vf0, n1, 0, 0, 0);
            yc = __builtin_amdgcn_mfma_f32_32x32x16_bf16(fg0, vf0, yc, 0, 0, 0);
            n0 = __builtin_amdgcn_mfma_f32_32x32x16_bf16(fp1, vf1, n0, 0, 0, 0);
            n1 = __builtin_amdgcn_mfma_f32_32x32x16_bf16(fp3, vf1, n1, 0, 0, 0);
            yc = __builtin_amdgcn_mfma_f32_32x32x16_bf16(fg1, vf1, yc, 0, 0, 0);
            X0 = n0; X1 = n1;
#pragma unroll
            for (int i = 0; i < 16; ++i) yb[(size_t)(c * 32 + (i & 3) + 8 * (i >> 2) + 4 * hf) * RWW] = (bf16_t)f2bf(yc[i]);
        }
    }
    asm volatile("s_waitcnt vmcnt(0)" ::: "memory");
    __builtin_amdgcn_s_barrier();
#undef CS_ISSUE
}

template <int NT>
__device__ __forceinline__ void st_rwout(const P& p, int l, const int (&tok)[NT], int lane) {
    float y[NT][6], vv[NT][6], gg[NT][6], rk[NT][6];
#pragma unroll
    for (int n = 0; n < NT; ++n)
#pragma unroll
        for (int hh = 0; hh < 6; ++hh) {
            const int t = tok[n];
            y[n][hh] = bf2f(p.y[(size_t)t * RWW + hh * 64 + lane]); vv[n][hh] = bf2f(*(const bf16_t*)(p.rec + (size_t)t * REC_TB + hh * REC_HB + 768 + lane * 2)); gg[n][hh] = bf2f(p.g[(size_t)t * RWW + hh * 64 + lane]);
            rk[n][hh] = *(const float*)(p.rec + (size_t)t * REC_TB + hh * REC_HB + 896);
        }
#pragma unroll
    for (int hh = 0; hh < 6; ++hh) {
        const int c = hh * 64 + lane;
        const float lg = p.rw_ln_g[l * RWW + c], lb = p.rw_ln_b[l * RWW + c];
#pragma unroll
        for (int n = 0; n < NT; ++n) {
            const float mean = wave_sum(y[n][hh]) * (1.f / 64.f);
            const float d = y[n][hh] - mean;
            const float var = wave_sum(d * d) * (1.f / 64.f);
            const float yn = d * rsqrtf(var + 64e-5f) * lg + lb;
            p.h[(size_t)tok[n] * D + c] = (bf16_t)f2bf((yn + rk[n][hh] * vv[n][hh]) * gg[n][hh]);
        }
    }
}

typedef float f32x16 __attribute__((ext_vector_type(16)));
constexpr float ATT_EXIT = -30.f;
__device__ __forceinline__ float xhalf(float x, int lane) { return __builtin_bit_cast(float, __builtin_amdgcn_ds_bpermute((lane ^ 32) << 2, __builtin_bit_cast(int, x))); }
__device__ __forceinline__ void st_attn(const P& p, int l, int item) {
    const int lane = opaque(threadIdx.x) & 63;
    const int qt = item % (SEQ / 32), bh = item / (SEQ / 32), b = bh / 6, hh = bh % 6;
    const int r = lane & 31, hf = lane >> 5;
    const bf16_t* qkb = p.proj + (size_t)b * SEQ * PJB + RWC + hh * 64 + 8 * hf;
    const bf16_t* vtb = p.vt + ((size_t)(b * 6 + hh) * 64 + r) * SEQ + 4 * hf;
    bf16x8 qf[4];
    {
        const bf16_t* qp = qkb + (size_t)(qt * 32 + r) * PJB;
#pragma unroll
        for (int s = 0; s < 4; ++s) {
            u32x4 t4 = *(const u32x4*)(qp + 16 * s);
            unsigned w[4] = {t4.x, t4.y, t4.z, t4.w};
#pragma unroll
            for (int q = 0; q < 4; ++q) { const float lo = bflo(w[q]) * 0.125f, hi = bfhi(w[q]) * 0.125f; w[q] = (__builtin_bit_cast(unsigned, lo) >> 16) | (__builtin_bit_cast(unsigned, hi) & 0xffff0000u); }
            t4.x = w[0]; t4.y = w[1]; t4.z = w[2]; t4.w = w[3];
            qf[s] = __builtin_bit_cast(bf16x8, t4);
        }
    }
    f32x16 o0, o1;
#pragma unroll
    for (int i = 0; i < 16; ++i) { o0[i] = 0.f; o1[i] = 0.f; }
    float R = 0.f;
    bf16x8 kfn[4]; u32x2 vfn[2][2][2];
#define ATT_LOAD(KT) do { const int _k0 = (KT) * 32; const bf16_t* kp = qkb + SBW + (size_t)(_k0 + r) * PJB; \
        _Pragma("unroll") for (int s = 0; s < 4; ++s) kfn[s] = *(const bf16x8*)(kp + 16 * s); \
        _Pragma("unroll") for (int dt = 0; dt < 2; ++dt) _Pragma("unroll") for (int s = 0; s < 2; ++s) { const bf16_t* vp = vtb + (size_t)dt * 32 * SEQ + _k0 + 16 * s; vfn[dt][s][0] = *(const u32x2*)vp; vfn[dt][s][1] = *(const u32x2*)(vp + 8); } } while (0)
    ATT_LOAD(qt);
    for (int kt = qt; kt >= 0; --kt) {
        const int key0 = kt * 32; (void)key0;
        bf16x8 kf[4]; u32x2 vf[2][2][2];
#pragma unroll
        for (int s = 0; s < 4; ++s) kf[s] = kfn[s];
#pragma unroll
        for (int dt = 0; dt < 2; ++dt)
#pragma unroll
            for (int s = 0; s < 2; ++s) { vf[dt][s][0] = vfn[dt][s][0]; vf[dt][s][1] = vfn[dt][s][1]; }
        if (kt > 0) ATT_LOAD(kt - 1);
        f32x16 z;
#pragma unroll
        for (int i = 0; i < 16; ++i) z[i] = 0.f;
#pragma unroll
        for (int s = 0; s < 4; ++s) z = __builtin_amdgcn_mfma_f32_32x32x16_bf16(kf[s], qf[s], z, 0, 0, 0);
        const bool diag = (kt == qt);
        float c[16], gs[4];
#pragma unroll
        for (int gi = 0; gi < 4; ++gi) {
            float run = 0.f;
#pragma unroll
            for (int e = 3; e >= 0; --e) {
                const int reg = gi * 4 + e;
                const float zz = z[reg] * LOG2E; z[reg] = zz;
                float L = -(__builtin_amdgcn_fmed3f(zz, 0.f, INFINITY) + log2f_(1.f + exp2f_(-fabsf(zz))));
                if (diag && !(r > e + 8 * gi + 4 * hf)) L = 0.f;
                run += L; c[reg] = run;
            }
            gs[gi] = run;
        }
        float go[4], pp[4], ob[4], off[4];
#pragma unroll
        for (int gi = 0; gi < 4; ++gi) { go[gi] = xhalf(gs[gi], lane); pp[gi] = gs[gi] + go[gi]; }
        ob[3] = 0.f; ob[2] = pp[3]; ob[1] = pp[3] + pp[2]; ob[0] = ob[1] + pp[1];
#pragma unroll
        for (int gi = 0; gi < 4; ++gi) off[gi] = ob[gi] + (hf == 0 ? go[gi] : 0.f) + R;
        const float total = ob[0] + pp[0];
        unsigned af[8];
#pragma unroll
        for (int i = 0; i < 8; ++i) {
            float a2[2];
#pragma unroll
            for (int q = 0; q < 2; ++q) {
                const int reg = 2 * i + q, gi = reg >> 2, e = reg & 3;
                float a = exp2f_(z[reg] + c[reg] + off[gi]);
                if (diag && !(r > e + 8 * gi + 4 * hf)) a = 0.f;
                a2[q] = a;
            }
            af[i] = pk2(a2[0], a2[1]);
        }
        R += total;
        const bf16x8 a0 = __builtin_bit_cast(bf16x8, (u32x4){af[0], af[1], af[2], af[3]});
        const bf16x8 a1 = __builtin_bit_cast(bf16x8, (u32x4){af[4], af[5], af[6], af[7]});
        o0 = __builtin_amdgcn_mfma_f32_32x32x16_bf16(__builtin_bit_cast(bf16x8, (u32x4){vf[0][0][0].x, vf[0][0][0].y, vf[0][0][1].x, vf[0][0][1].y}), a0, o0, 0, 0, 0);
        o0 = __builtin_amdgcn_mfma_f32_32x32x16_bf16(__builtin_bit_cast(bf16x8, (u32x4){vf[0][1][0].x, vf[0][1][0].y, vf[0][1][1].x, vf[0][1][1].y}), a1, o0, 0, 0, 0);
        o1 = __builtin_amdgcn_mfma_f32_32x32x16_bf16(__builtin_bit_cast(bf16x8, (u32x4){vf[1][0][0].x, vf[1][0][0].y, vf[1][0][1].x, vf[1][0][1].y}), a0, o1, 0, 0, 0);
        o1 = __builtin_amdgcn_mfma_f32_32x32x16_bf16(__builtin_bit_cast(bf16x8, (u32x4){vf[1][1][0].x, vf[1][1][0].y, vf[1][1][1].x, vf[1][1][1].y}), a1, o1, 0, 0, 0);
        if (__all(R < ATT_EXIT * LOG2E)) break;
    }
#undef ATT_LOAD
    float ss = 0.f;
#pragma unroll
    for (int i = 0; i < 16; ++i) ss += o0[i] * o0[i] + o1[i] * o1[i];
    ss += xhalf(ss, lane);
    const float rs = rsqrtf(ss * (1.f / 64.f) + 1e-6f);
    bf16_t* op = p.h + ((size_t)b * SEQ + qt * 32 + r) * D + RWW + hh * 64 + 4 * hf;
    const float* gn = p.sb_norm_g + l * SBW + hh * 64 + 4 * hf;
#pragma unroll
    for (int gi = 0; gi < 4; ++gi) {
        const f32x4 g0 = *(const f32x4*)(gn + 8 * gi), g1 = *(const f32x4*)(gn + 32 + 8 * gi);
        u32x2 w0, w1;
        w0.x = pk2(o0[4 * gi] * rs * g0[0], o0[4 * gi + 1] * rs * g0[1]); w0.y = pk2(o0[4 * gi + 2] * rs * g0[2], o0[4 * gi + 3] * rs * g0[3]);
        w1.x = pk2(o1[4 * gi] * rs * g1[0], o1[4 * gi + 1] * rs * g1[1]); w1.y = pk2(o1[4 * gi + 2] * rs * g1[2], o1[4 * gi + 3] * rs * g1[3]);
        *(u32x2*)(op + 8 * gi) = w0; *(u32x2*)(op + 32 + 8 * gi) = w1;
    }
}

constexpr int POOL_PS = 528;
__device__ __forceinline__ void st_pool(const P& p, int l, int vb, LAS unsigned char* PLB  ) {
    const int tid = opaque(threadIdx.x);
    const int t0 = vb * 32, s0 = t0 % SEQ;
    {
        const int col = tid & 255, th = tid >> 8, g = col >> 6, win = 2 << g;
        const int sA = s0 + th * 16;
        const bf16_t* u = p.proj + (size_t)(t0 + th * 16) * PJB + RWC + SBC + col;
        float xv[31];
#pragma unroll
        for (int i = 0; i < 31; ++i) { const int s = sA - 15 + i; xv[i] = (s >= 0 && (i >= 15 || 15 - i < win)) ? bf2f(u[(ptrdiff_t)(i - 15) * PJB]) : 0.f; }
        float run = 0.f;
#pragma unroll
        for (int i = 0; i < 15; ++i) run += (15 - i < win) ? xv[i] : 0.f;
#pragma unroll
        for (int j = 0; j < 16; ++j) {
            run += xv[15 + j];
            const int s = sA + j, n = min(s + 1, win);
            *(LAS bf16_t*)(PLB + (th * 16 + j) * POOL_PS + col * 2) = (bf16_t)f2bf(run * rcpf_((float)n) - xv[15 + j]);
            float drop = 0.f;
#pragma unroll
            for (int q = 1; q <= 4; ++q) if (win == (1 << q)) drop = xv[15 + j - (1 << q) + 1];
            run -= drop;
        }
    }
    __syncthreads();
    {
        const int wave = tid >> 6, lane = tid & 63, g = wave & 3, nh = wave >> 2, r = lane & 31, hf = lane >> 5;
        const float* pw = p.pool_w + ((size_t)l * 4 + g) * 64 * 64 + nh * 32 + r;
        bf16x8 bw[4];
#pragma unroll
        for (int ks = 0; ks < 4; ++ks) {
            float w[8];
#pragma unroll
            for (int j = 0; j < 8; ++j) w[j] = pw[(16 * ks + 8 * hf + j) * 64];
            bw[ks] = mk8(pk2(w[0], w[1]), pk2(w[2], w[3]), pk2(w[4], w[5]), pk2(w[6], w[7]));
        }
        f32x16 acc;
#pragma unroll
        for (int i = 0; i < 16; ++i) acc[i] = 0.f;
#pragma unroll
        for (int ks = 0; ks < 4; ++ks) acc = __builtin_amdgcn_mfma_f32_32x32x16_bf16(*(const LAS bf16x8*)(PLB + r * POOL_PS + (g * 64 + 16 * ks + 8 * hf) * 2), bw[ks], acc, 0, 0, 0);
        const float sc = p.pool_scale[l * PLW + g * 64 + nh * 32 + r];
        bf16_t* op = p.h + (size_t)t0 * D + 768 + g * 64 + nh * 32 + r;
#pragma unroll
        for (int i = 0; i < 16; ++i) op[(size_t)((i & 3) + 8 * (i >> 2) + 4 * hf) * D] = (bf16_t)f2bf(acc[i] * sc);
    }
    __syncthreads();
}

template <bool TOLDS>
__device__ __forceinline__ void norm_row(const float* xr, const float* md  , bf16_t* hrow, LAS float* hl, int lane) {
    f32x4 v[4], sh[4], sc[4]; float ss = 0.f;
#pragma unroll
    for (int i = 0; i < 4; ++i) v[i] = *(const f32x4*)(xr + i * 256 + lane * 4);
#pragma unroll
    for (int i = 0; i < 4; ++i) { sh[i] = *(const f32x4*)(md + i * 256 + lane * 4); sc[i] = *(const f32x4*)(md + 1024 + i * 256 + lane * 4); }
#pragma unroll
    for (int i = 0; i < 4; ++i) ss += v[i][0] * v[i][0] + v[i][1] * v[i][1] + v[i][2] * v[i][2] + v[i][3] * v[i][3];
    ss = wave_sum(ss);
    const float rs = rsqrtf(ss * (1.f / D) + 1e-6f);
#pragma unroll
    for (int i = 0; i < 4; ++i) {
        const int cidx = i * 256 + lane * 4;
        const f32x4 o = v[i] * rs * (sc[i] + 1.f) + sh[i];
        u32x2 w; w.x = pk2(o[0], o[1]); w.y = pk2(o[2], o[3]);
        *(u32x2*)(hrow + cidx) = w;
        if constexpr (TOLDS) *(LAS f32x4*)(hl + cidx) = o;
    }
}

__device__ __forceinline__ void norm_row_lds(const float* xr, const float* md, bf16_t* hrow, LAS float* hl, int lane) {
    f32x4 v[4]; float ss = 0.f;
#pragma unroll
    for (int i = 0; i < 4; ++i) { v[i] = *(const f32x4*)(xr + i * 256 + lane * 4); ss += v[i][0] * v[i][0] + v[i][1] * v[i][1] + v[i][2] * v[i][2] + v[i][3] * v[i][3]; }
    ss = wave_sum(ss);
    const float rs = rsqrtf(ss * (1.f / D) + 1e-6f);
#pragma unroll
    for (int i = 0; i < 4; ++i) {
        const int cidx = i * 256 + lane * 4;
        const f32x4 sh = *(const f32x4*)(md + cidx), sc = *(const f32x4*)(md + 1024 + cidx);
        const f32x4 o = v[i] * rs * (sc + 1.f) + sh;
        u32x2 w; w.x = pk2(o[0], o[1]); w.y = pk2(o[2], o[3]);
        *(u32x2*)(hrow + cidx) = w;
        *(LAS f32x4*)(hl + cidx) = o;
    }
}

__device__ __forceinline__ void split_bf16(const float (&x)[8], bf16x8& hi, bf16x8& lo) {
    unsigned h[4], l[4];
#pragma unroll
    for (int q = 0; q < 4; ++q) {
        const unsigned ph = cvtpk(x[2 * q], x[2 * q + 1]);
        const float r0 = x[2 * q] - bflo(ph), r1 = x[2 * q + 1] - bfhi(ph);
        h[q] = ph; l[q] = cvtpk(r0, r1);
    }
    hi = mk8(h[0], h[1], h[2], h[3]); lo = mk8(l[0], l[1], l[2], l[3]);
}
__device__ __forceinline__ void st_normrouter(const P& p, int l, int vb0, int vbstride, int cv_first, LAS float* L  ) {
    const int tid = opaque(threadIdx.x), wave = tid >> 6, lane = tid & 63;
    const int fr = lane & 15, fq = lane >> 4;
    constexpr int HS = 1028;
    LAS float* H = L; LAS float* PART = L + 16 * HS; LAS float* SEL = PART + 8 * 16 * 64; LAS int* lcnt = (LAS int*)(SEL + 16 * 72);
    bf16x8 Bh[4][4], Bl[4][4];
    {
        const float* wr = p.w_router + ((size_t)l * D + wave * 128) * NE;
        const int ll = opaque(lane), fr2 = ll & 15, fq2 = ll >> 4;
#pragma unroll
        for (int ks = 0; ks < 4; ++ks)
#pragma unroll
            for (int nt = 0; nt < 4; ++nt) {
                float x[8];
#pragma unroll
                for (int j = 0; j < 8; ++j) x[j] = wr[(32 * ks + 8 * fq2 + j) * NE + 16 * nt + fr2];
                split_bf16(x, Bh[ks][nt], Bl[ks][nt]);
            }
    }
    const float brt = p.b_router[l * NE + lane];
    for (int vb = vb0; vb < T / 16; vb += vbstride) {
        const int t0 = vb * 16, b = t0 / SEQ;
        const float* md = p.mod + ((size_t)l * 8 + b) * 6144 + 3072;
        if (tid < 64) lcnt[tid] = 0;
        unsigned pfv = 0u;
        if (vb + vbstride < T / 16) pfv = pf_lines(p.xb + (size_t)((vb + vbstride) * 16 + wave * 2) * D, 2 * D * 4, lane);
#pragma unroll
        for (int q = 0; q < 2; ++q) { const int tt = wave * 2 + q; norm_row_lds(p.xb + (size_t)(t0 + tt) * D, md, p.h + (size_t)(t0 + tt) * D, H + tt * HS, lane); }
        const int cit = cv_first + vb * 8 + __builtin_amdgcn_readfirstlane(wave);
        const bool hcv = cit < CV_EXP;
        CvtJob cj = cvt_exp_job(p, l, hcv ? cit : 0);
        float cw[32];
        if (hcv) cvh_load(cj, 0, cw, lane);
        __syncthreads();
        {
            f32x4 acc[4];
#pragma unroll
            for (int nt = 0; nt < 4; ++nt) acc[nt] = (f32x4){0.f, 0.f, 0.f, 0.f};
#pragma unroll
            for (int ks = 0; ks < 4; ++ks) {
                const LAS float* hp = H + fr * HS + wave * 128 + 32 * ks + 8 * fq;
                const f32x4 h0 = *(const LAS f32x4*)hp, h1 = *(const LAS f32x4*)(hp + 4);
                const float x[8] = {h0[0], h0[1], h0[2], h0[3], h1[0], h1[1], h1[2], h1[3]};
                bf16x8 ah, al; split_bf16(x, ah, al);
#pragma unroll
                for (int nt = 0; nt < 4; ++nt) {
                    acc[nt] = __builtin_amdgcn_mfma_f32_16x16x32_bf16(ah, Bh[ks][nt], acc[nt], 0, 0, 0);
                    acc[nt] = __builtin_amdgcn_mfma_f32_16x16x32_bf16(ah, Bl[ks][nt], acc[nt], 0, 0, 0);
                    acc[nt] = __builtin_amdgcn_mfma_f32_16x16x32_bf16(al, Bh[ks][nt], acc[nt], 0, 0, 0);
                }
            }
#pragma unroll
            for (int nt = 0; nt < 4; ++nt)
#pragma unroll
                for (int rg = 0; rg < 4; ++rg) PART[(wave * 16 + 4 * fq + rg) * 64 + 16 * nt + fr] = acc[nt][rg];
        }
        if (hcv) { cvh_store(cj, 0, cw, lane); cvh_load(cj, 1, cw, lane); }
        __syncthreads();
#pragma unroll
        for (int q = 0; q < 2; ++q) {
            const int tt = wave * 2 + q, t = t0 + tt;
            float logit = 0.f;
#pragma unroll
            for (int w = 0; w < 8; ++w) logit += PART[(w * 16 + tt) * 64 + lane];
            float score = sigmoidf_(logit);
            score = (score == score) ? score : 0.f;
            const float sl = score + brt;
            LAS float* sel = SEL + (wave * 2 + q) * 72; LAS float* gs = sel + 64;
            sel[lane] = sl;
            if (lane < 8) {
                float m1 = -INFINITY, m2 = -INFINITY;
                for (int i = 0; i < 8; ++i) { const float v = sel[lane * 8 + i]; if (v > m1) { m2 = m1; m1 = v; } else if (v > m2) m2 = v; }
                gs[lane] = m1 + m2;
            }
            const int gI = lane >> 3;
            int grank = 0;
            for (int i = 0; i < 8; ++i) { const float v = gs[i]; grank += (v > gs[gI] || (v == gs[gI] && i < gI)) ? 1 : 0; }
            const float msk = (grank < 4) ? sl : -INFINITY;
            sel[lane] = msk;
            int rank = 0;
            for (int i = 0; i < 64; ++i) { const float v = sel[i]; rank += (v > msk || (v == msk && i < lane)) ? 1 : 0; }
            const bool chosen = rank < TOPK;
            const float wsum = wave_sum(chosen ? score : 0.f);
            if (chosen) {
                const int pos = __hip_atomic_fetch_add(&lcnt[lane], 1, __ATOMIC_RELAXED, __HIP_MEMORY_SCOPE_WORKGROUP);
                p.seg[((size_t)lane * 1024 + vb) * 16 + pos] = t * TOPK + rank;
                p.topw[(size_t)t * TOPK + rank] = score / (wsum + 1e-20f) * 2.5f;
            }
        }
        if (hcv) cvh_store(cj, 1, cw, lane);
        __syncthreads();
        if (tid < 64) p.cnt2[tid * 1024 + vb] = lcnt[tid];
        pf_done(pfv);
        __syncthreads();
    }
}

__device__ __forceinline__ void st_compact(const P& p, int e, LAS int* wt  ) {
    const int tid = opaque(threadIdx.x), wave = tid >> 6, lane = tid & 63;
    const int c0 = p.cnt2[e * 1024 + 2 * tid], c1 = p.cnt2[e * 1024 + 2 * tid + 1], s = c0 + c1;
    int incl = s;
#pragma unroll
    for (int o = 1; o < 64; o <<= 1) { const int v = __builtin_amdgcn_ds_bpermute(((lane - o) & 63) << 2, incl); if (lane >= o) incl += v; }
    if (lane == 63) wt[wave] = incl;
    __syncthreads();
    int base = 0;
    for (int w = 0; w < wave; ++w) base += wt[w];
    const int excl = base + incl - s;
    int2* dst = p.list + (size_t)e * T + excl;
    const int* s0 = p.seg + ((size_t)e * 1024 + 2 * tid) * 16;
    for (int j = 0; j < c0; ++j) { const int aid = s0[j]; dst[j] = make_int2(aid, __float_as_int(p.topw[aid])); }
    for (int j = 0; j < c1; ++j) { const int aid = s0[16 + j]; dst[c0 + j] = make_int2(aid, __float_as_int(p.topw[aid])); }
    if (tid == NTHREADS - 1) p.cnt[e] = base + incl;
    __syncthreads();
}

template <int NT>
__device__ __forceinline__ void st_combine(const P& p, int l, const int (&tok)[NT], int lane) {
    u32x2 q[NT][2][TOPK + 1]; f32x4 x0[NT][2], x1[NT][2];
#pragma unroll
    for (int n = 0; n < NT; ++n) {
        const int t = tok[n];
        const unsigned char* sl = p.slab + (size_t)t * TOPK * D;
#pragma unroll
        for (int i = 0; i < 2; ++i) {
            const int cidx = i * 512 + lane * 8;
#pragma unroll
            for (int s = 0; s < TOPK + 1; ++s) q[n][i][s] = *(const u32x2*)(s < TOPK ? sl + (size_t)s * D + cidx : p.slab + ((size_t)T * TOPK + t) * D + cidx);
            x0[n][i] = *(const f32x4*)(p.xb + (size_t)t * D + cidx); x1[n][i] = *(const f32x4*)(p.xb + (size_t)t * D + cidx + 4);
        }
    }
#pragma unroll
    for (int n = 0; n < NT; ++n) {
        const int t = tok[n], b = t / SEQ;
        const float* gt = p.mod + ((size_t)l * 8 + b) * 6144 + 5120;
        float* xr = p.xb + (size_t)t * D;
        float xv[16]; float ss = 0.f;
#pragma unroll
        for (int i = 0; i < 2; ++i) {
            const int cidx = i * 512 + lane * 8;
            float f[8];
#pragma unroll
            for (int j = 0; j < 8; ++j) f[j] = 0.f;
#pragma unroll
            for (int s = 0; s < TOPK + 1; ++s) {
                const u32x2 qq = q[n][i][s];
                const f32x2 a = __builtin_amdgcn_cvt_pk_f32_fp8((int)qq.x, false), bq = __builtin_amdgcn_cvt_pk_f32_fp8((int)qq.x, true), c = __builtin_amdgcn_cvt_pk_f32_fp8((int)qq.y, false), d = __builtin_amdgcn_cvt_pk_f32_fp8((int)qq.y, true);
                f[0] += a[0]; f[1] += a[1]; f[2] += bq[0]; f[3] += bq[1]; f[4] += c[0]; f[5] += c[1]; f[6] += d[0]; f[7] += d[1];
            }
            const f32x4 g0 = *(const f32x4*)(gt + cidx), g1 = *(const f32x4*)(gt + cidx + 4);
#pragma unroll
            for (int j = 0; j < 4; ++j) { xv[i * 8 + j] = x0[n][i][j] + g0[j] * f[j] * (1.f / SLAB_SC); xv[i * 8 + 4 + j] = x1[n][i][j] + g1[j] * f[4 + j] * (1.f / SLAB_SC); }
#pragma unroll
            for (int j = 0; j < 8; ++j) ss += xv[i * 8 + j] * xv[i * 8 + j];
        }
        ss = wave_sum(ss);
        const float rs = rsqrtf(ss * (1.f / D) + 1e-6f);
        if (l + 1 < NL) {
            const float* md = p.mod + ((size_t)(l + 1) * 8 + b) * 6144;
#pragma unroll
            for (int i = 0; i < 2; ++i) {
                const int cidx = i * 512 + lane * 8;
                *(f32x4*)(xr + cidx) = (f32x4){xv[i * 8], xv[i * 8 + 1], xv[i * 8 + 2], xv[i * 8 + 3]};
                *(f32x4*)(xr + cidx + 4) = (f32x4){xv[i * 8 + 4], xv[i * 8 + 5], xv[i * 8 + 6], xv[i * 8 + 7]};
                const f32x4 s0 = *(const f32x4*)(md + cidx), s1 = *(const f32x4*)(md + cidx + 4), c0 = *(const f32x4*)(md + 1024 + cidx), c1 = *(const f32x4*)(md + 1024 + cidx + 4);
                float o[8];
#pragma unroll
                for (int j = 0; j < 4; ++j) { o[j] = xv[i * 8 + j] * rs * (1.f + c0[j]) + s0[j]; o[4 + j] = xv[i * 8 + 4 + j] * rs * (1.f + c1[j]) + s1[j]; }
                u32x4 w; w.x = pk2(o[0], o[1]); w.y = pk2(o[2], o[3]); w.z = pk2(o[4], o[5]); w.w = pk2(o[6], o[7]);
                *(u32x4*)(p.h + (size_t)t * D + cidx) = w;
            }
        } else {
#pragma unroll
            for (int i = 0; i < 2; ++i) {
                const int cidx = i * 512 + lane * 8;
                const f32x4 g0 = *(const f32x4*)(p.g_final + cidx), g1 = *(const f32x4*)(p.g_final + cidx + 4);
                *(f32x4*)(p.out + (size_t)t * D + cidx) = (f32x4){xv[i * 8] * rs * g0[0], xv[i * 8 + 1] * rs * g0[1], xv[i * 8 + 2] * rs * g0[2], xv[i * 8 + 3] * rs * g0[3]};
                *(f32x4*)(p.out + (size_t)t * D + cidx + 4) = (f32x4){xv[i * 8 + 4] * rs * g1[0], xv[i * 8 + 5] * rs * g1[1], xv[i * 8 + 6] * rs * g1[2], xv[i * 8 + 7] * rs * g1[3]};
            }
        }
    }
}

#define XB_TMO      128
#define XB_XCNT(j)  (256  + 64 * (j))
#define XB_XSUB(j)  (1280 + 64 * (j))
#define XB_XGEN(j)  (2304 + 64 * (j))
#define XB_TOP      3328
#define XB_TOPGEN   3392
#define XCD_BAR_WORDS 3456
#define XB_SPIN_CAP (1u << 22)
__device__ __forceinline__ unsigned xb_ld(unsigned* p)              { return __hip_atomic_load(p, __ATOMIC_RELAXED, __HIP_MEMORY_SCOPE_AGENT); }
__device__ __forceinline__ unsigned xb_add(unsigned* p, unsigned v) { return __hip_atomic_fetch_add(p, v, __ATOMIC_RELAXED, __HIP_MEMORY_SCOPE_AGENT); }
__device__ __forceinline__ unsigned xb_xcc_id() { return (unsigned)__builtin_amdgcn_s_getreg((3 << 11) | 20) & 0xFu; }
#define XB_SPIN(cond, bar) do { unsigned _sp = 0; while (cond) { __builtin_amdgcn_s_sleep(1); \
    if ((++_sp & 255u) == 0u) { if (xb_ld(&(bar)[XB_TMO])) break; if (_sp > XB_SPIN_CAP) { atomicAdd(&(bar)[XB_TMO], 1u); break; } } } } while (0)
struct XcdBarrier { unsigned* bar; unsigned x; volatile LAS unsigned* st; };
__device__ __forceinline__ XcdBarrier xcd_barrier_post(unsigned* bar, volatile LAS unsigned* st) {
    XcdBarrier b; b.bar = bar; b.x = xb_xcc_id(); b.st = st;
    if (threadIdx.x == 0) (void)xb_add(&bar[XB_XCNT(b.x)], 1u);
    return b;
}
__device__ __forceinline__ void xcd_barrier_complete(unsigned* bar, unsigned x, unsigned& nloc, unsigned& nx) {
    const unsigned G = gridDim.x * gridDim.y * gridDim.z;
    unsigned sum, cnt, mine, sp = 0u;
    for (;;) {
        sum = 0u; cnt = 0u; mine = 0u;
#pragma unroll
        for (unsigned j = 0; j < 16; ++j) { const unsigned c = xb_ld(&bar[XB_XCNT(j)]); sum += c; cnt += (c > 0u) ? 1u : 0u; mine = (j == x) ? c : mine; }
        if (sum == G) break;
        __builtin_amdgcn_s_sleep(1);
        if ((++sp & 255u) == 0u) { if (xb_ld(&bar[XB_TMO])) break; if (sp > XB_SPIN_CAP) { atomicAdd(&bar[XB_TMO], 1u); break; } }
    }
    nloc = mine > 0u ? mine : 1u; nx = cnt > 0u ? cnt : 1u;
}
__device__ __forceinline__ void xcd_barrier(const XcdBarrier& b0) {
    XcdBarrier b = b0; { unsigned xx = b0.x; asm volatile("" : "+s"(xx)); b.x = xx; }
    asm volatile("s_waitcnt vmcnt(0)" ::: "memory");
    __syncthreads();
    if (threadIdx.x == 0) {
        unsigned* bar = b.bar;
        __builtin_amdgcn_s_waitcnt(0);
        unsigned nloc = b.st[0], nx = b.st[1];
        if (nloc == 0u) { xcd_barrier_complete(bar, b.x, nloc, nx); b.st[0] = nloc; b.st[1] = nx; }
        const unsigned old = xb_add(&bar[XB_XSUB(b.x)], 1u);
        const unsigned gen = old / nloc;
        if (old + 1u == (gen + 1u) * nloc) {
            __builtin_amdgcn_fence(__ATOMIC_RELEASE, "agent");
            asm volatile("s_waitcnt vmcnt(0)" ::: "memory");
            const unsigned og = xb_add(&bar[XB_TOP], 1u);
            const unsigned tg = og / nx;
            if (og + 1u == (tg + 1u) * nx) xb_add(&bar[XB_TOPGEN], 1u);
            else XB_SPIN(xb_ld(&bar[XB_TOPGEN]) == tg, bar);
            __builtin_amdgcn_fence(__ATOMIC_ACQUIRE, "agent");
            xb_add(&bar[XB_XGEN(b.x)], 1u);
            asm volatile("s_waitcnt vmcnt(0)" ::: "memory");
        } else {
            XB_SPIN(xb_ld(&bar[XB_XGEN(b.x)]) == gen, bar);
            __builtin_amdgcn_fence(__ATOMIC_ACQUIRE, "agent");
            asm volatile("s_waitcnt vmcnt(0)" ::: "memory");
        }
    }
    __syncthreads();
}

__device__ __forceinline__ P load_args() {
    P q{};
#if defined(__HIP_DEVICE_COMPILE__)
    const __attribute__((address_space(4))) unsigned long long* k = (const __attribute__((address_space(4))) unsigned long long*)__builtin_amdgcn_kernarg_segment_ptr();
    asm volatile("" : "+s"(k));
    typedef __attribute__((address_space(1))) char gchar_t;
#pragma unroll
    for (unsigned i = 0; i < sizeof(P) / 8; ++i) { char* g = (char*)(gchar_t*)k[i]; __builtin_memcpy((char*)&q + 8 * i, &g, 8); }
#endif
    return q;
}
enum Ph { PH_NORM1 = 0, PH_INPROJ, PH_PREP, PH_MIX, PH_RWOUT, PH_OUTPROJ, PH_ROUTER, PH_COMPACT, PH_EXP1, PH_EXP2, PH_COMBINE, PH_PER_LAYER };

__global__ void __launch_bounds__(NTHREADS, 2) k_fused(P p_arg) {
    (void)p_arg;
#define KARGS() load_args()
    extern __shared__ __attribute__((aligned(16))) unsigned char lds_raw[];
    LAS unsigned char* lds = (LAS unsigned char*)lds_raw;
    LAS int* tstart = (LAS int*)(lds + LDS_STAGE);
    LAS int* cnts = (LAS int*)(lds + LDS_STAGE + 272);
    LAS int* tmap = (LAS int*)(lds + LDS_STAGE + 2048);
    volatile LAS unsigned* bst = (volatile LAS unsigned*)(lds + LDS_STAGE + 1008);
    if (threadIdx.x < 4) bst[threadIdx.x] = 0u;
    __syncthreads();
    XcdBarrier xb = xcd_barrier_post(load_args().bar, bst);
#define PHASE_COORDS() int G = gridDim.x, bx = blockIdx.x; asm volatile("" : "+s"(G), "+s"(bx)); const int vcu = (G % 8 == 0) ? (bx % 8) * (G / 8) + bx / 8 : bx; (void)vcu; \
    const int tid = opaque(threadIdx.x), half = tid >> 8, lane = tid & 63, wave = __builtin_amdgcn_readfirstlane(tid >> 6); \
    float* smem = (float*)lds_raw + half * 8192; LAS float* scr = (LAS float*)(lds + wave * 16384); (void)lane; (void)smem; (void)scr; (void)tid

    for (int rep = 0; rep < (REP_PH == -1 ? REP_N : 1); ++rep) {
        const P p = KARGS();
        PHASE_COORDS();
        for (int it = bx; it < NL * 96; it += G) st_mod(p, it, (LAS float*)lds);
        __syncthreads();
        for (int it = (bx * 8 + wave); it < CV_DENSE; it += G * 8) cvt_dense_item(p, it, scr, lane);
        for (int idx = bx * NTHREADS + tid; idx < NL * RWW * 160; idx += G * NTHREADS) {
            const int k = idx % 160, c = (idx / 160) % RWW, ly = idx / (160 * RWW);
            float v;
            if (k < 32) v = p.rw_w2[((size_t)ly * 32 + k) * RWW + c];
            else if (k < 64) v = p.rw_a2[((size_t)ly * 32 + (k - 32)) * RWW + c];
            else if (k < 128) v = p.rw_g2[((size_t)ly * 64 + (k - 64)) * RWW + c];
            else v = (ly == 1) ? p.rw_v2[(size_t)(k - 128) * RWW + c] : 0.f;
            p.lwt[idx] = (bf16_t)f2bf(v);
        }
        xcd_barrier(xb);
    }

    constexpr int NPH2 = NL * PH_PER_LAYER + ((REP_PH >= 0) ? REP_N - 1 : 0);
    for (int ph2 = 0; ph2 < NPH2; ++ph2) {
      {
        const int ph = (REP_PH < 0 || ph2 <= REP_PH) ? ph2 : (ph2 < REP_PH + REP_N ? REP_PH : ph2 - (REP_N - 1));
        const int rep = (REP_PH >= 0 && ph2 > REP_PH && ph2 < REP_PH + REP_N) ? 1 : 0; (void)rep;
        const int l = ph / PH_PER_LAYER, st = ph % PH_PER_LAYER;
        const P p = KARGS();
        PHASE_COORDS();
        if (st == PH_NORM1) {
            if (l == 0) {
                for (int t = bx * 8 + wave; t < T; t += G * 8) {
                    const int tn = t + G * 8; unsigned pfv = 0u;
                    if (tn < T) pfv = pf_lines(p.x + (size_t)tn * D, D * 4, lane);
                    norm_row<false>(p.x + (size_t)t * D, p.mod + (size_t)(t / SEQ) * 6144, p.h + (size_t)t * D, (LAS float*)lds, lane);
                    pf_done(pfv);
                }
            }
        } else if (st == PH_INPROJ) {
            pg8::DenseOrder S; S.init(p.h, p.wt_in + (size_t)l * PJB * D, T, PJB, D, G, bx);
            pg8::EpiProj E{p.proj, p.vt};
            pg8::gemm_phase<pg8::EpiProj, pg8::DenseOrder, true, true>(lds, D, S, E);
        } else if (st == PH_PREP) {
            st_prep(p, l, bx, G, lds, (rep == 0) ? 15 : REP_SEL);
        } else if (st == PH_MIX) {
            constexpr int N1 = NBATCH * 6, N2 = NBATCH * 6 * (SEQ / 32) / 8, N3 = T / 32;
            const int sel = (rep == 0) ? 15 : REP_SEL;
            if (sel & 1) for (int wb = bx; wb < N1; wb += G) st_cscan(p, wb, lds);
            __syncthreads();
            {
                unsigned* ctrA = p.bar + 3500 + ph2; unsigned* ctrB = p.bar + 3600 + l;
                volatile LAS int* gslot = (volatile LAS int*)(lds + LDS_STAGE + 640);
                for (;;) {
                    __syncthreads();
                    if (tid == 0) *gslot = (int)__hip_atomic_fetch_add(ctrA, 2u, __ATOMIC_RELAXED, __HIP_MEMORY_SCOPE_AGENT);
                    __syncthreads();
                    const int base = *gslot;
                    if (base >= N2 + N3) break;
                    for (int wb = base; wb < base + 2 && wb < N2 + N3; ++wb) {
                        if (wb < N2) { if (sel & 2) st_attn(p, l, wb * 8 + wave); }
                        else if (sel & 4) st_pool(p, l, wb - N2, lds);
                    }
                }
                const int cv0 = min(CV_EXP, 2 * G * (CV_QUOTA1 + CV_QUOTA2) + CV_ROUTER);
                for (;;) {
                    __syncthreads();
                    if (tid == 0) *gslot = cv0 + (int)__hip_atomic_fetch_add(ctrB, 32u, __ATOMIC_RELAXED, __HIP_MEMORY_SCOPE_AGENT);
                    __syncthreads();
                    const int base = *gslot;
                    if (base >= CV_EXP) break;
                    if (sel & 8) cvt_exp_stream(p, l, base + wave, 8, min(base + 32, CV_EXP), lane);
                }
            }
        } else if (st == PH_RWOUT) {
            for (int t = (bx * 8 + wave) * 4; t < T; t += G * 32) { const int tk[4] = {t, t + 1, t + 2, t + 3}; st_rwout<4>(p, l, tk, lane); }
        } else if (st == PH_OUTPROJ) {
            pg8::DenseOrder S; S.init(p.h, p.wt_out + (size_t)l * D * D, T, D, D, G, bx);
            pg8::EpiOut E{l == 0 ? p.x : p.xb, p.xb, p.mod + (size_t)l * 8 * 6144 + 2048};
            pg8::gemm_phase<pg8::EpiOut, pg8::DenseOrder, true, true>(lds, D, S, E);
        } else if (st == PH_ROUTER) {
            st_normrouter(p, l, bx, G, min(CV_EXP, 2 * G * (CV_QUOTA1 + CV_QUOTA2)), (LAS float*)lds);
        } else if (st == PH_COMPACT) {
            if (bx < NE) st_compact(p, bx, (LAS int*)lds);
        } else if (st == PH_EXP1 || st == PH_EXP2) {
            __syncthreads();
            if (tid == 0) {
                int acc = 0;
                for (int e = 0; e < 65; ++e) { const int c = e < NE ? p.cnt[e] : T; cnts[e] = c; tstart[e] = acc; acc += (c + 255) >> 8; }
                tstart[65] = acc;
            }
            __syncthreads();
            { int e = 0; for (int j = 1; j < 65; ++j) e += (tstart[j] <= tid) ? 1 : 0; tmap[tid] = e; }
            __syncthreads();
            if (st == PH_EXP1) {
                pg8::MoeOrder<true> S{tstart, cnts, tmap, p.list, p.h, p.wt1, D, 512, 1, G, vcu};
                pg8::EpiExp1 E{p.hm};
                pg8::gemm_phase<pg8::EpiExp1, pg8::MoeOrder<true>, true, true>(lds, D, S, E);
            } else {
                pg8::MoeOrder<false> S{tstart, cnts, tmap, p.list, p.hm, p.wt2, ED, D, 2, G, vcu};
                pg8::EpiExp2 E{p.slab, p.list, cnts};
                pg8::gemm_phase<pg8::EpiExp2, pg8::MoeOrder<false>, true, true>(lds, ED, S, E);
            }
        } else {
            for (int t = (bx * 8 + wave) * 2; t < T; t += G * 16) { const int tk[2] = {t, t + 1}; st_combine<2>(p, l, tk, lane); }
        }
        if (!(ph2 == NPH2 - 1)) { if (!(st == PH_NORM1 && l > 0)) xcd_barrier(xb); }
      }
    }
#undef PHASE_COORDS
#undef KARGS
}

}

extern "C" void kernel_launch(void* const* d_in, const int* in_sizes, int n_in, void* d_out, int out_size, void* d_ws, size_t ws_size,
                              hipStream_t stream) {
    P p{};
    const float** fp = (const float**)&p;
    for (int i = 0; i < 33; ++i) fp[i] = (const float*)d_in[i];
    p.out = (float*)d_out;
    char* ws = (char*)d_ws;
    size_t off = 0;
    auto take = [&](size_t bytes) { char* r = ws + off; off += (bytes + 255) & ~(size_t)255; return r; };
    p.bar = (unsigned*)take(16384);
    p.cnt = (int*)take(256);
    p.mod = (float*)take((size_t)NL * 8 * 6144 * 4);
    p.list = (int2*)take((size_t)NE * T * 8);
    p.cnt2 = (int*)take((size_t)NE * 1024 * 4);
    p.seg = (int*)take((size_t)NE * 1024 * 16 * 4);
    p.topw = (float*)take((size_t)T * TOPK * 4);
    p.wt_in = (bf16_t*)take((size_t)NL * PJB * D * 2);
    p.wt_out = (bf16_t*)take((size_t)NL * D * D * 2);
    p.lwt = (bf16_t*)take((size_t)NL * RWW * 160 * 2);
    p.wt1 = (bf16_t*)take((size_t)65 * 512 * D * 2);
    p.wt2 = (bf16_t*)take((size_t)65 * D * ED * 2);
    p.xb = (float*)take((size_t)T * D * 4);
    p.h = (bf16_t*)take((size_t)T * D * 2);
    p.vfirst = (bf16_t*)take((size_t)T * RWW * 2);
    const size_t ov = off;
    p.proj = (bf16_t*)take((size_t)T * PJB * 2);
    p.vt = (bf16_t*)take((size_t)T * SBW * 2);
    p.rec = (unsigned char*)take((size_t)T * REC_TB);
    p.g = (bf16_t*)take((size_t)T * RWW * 2);
    p.y = (bf16_t*)take((size_t)T * RWW * 2);
    p.cb = (unsigned char*)take((size_t)NBATCH * 6 * (SEQ / 32) * CB_BYTES);
    p.hm = (bf16_t*)(ws + ov);
    p.slab = (unsigned char*)(ws + ov + (size_t)MAXRT * 256 * ED * 2);
    const size_t end_moe = ov + (size_t)MAXRT * 256 * ED * 2 + (size_t)T * (TOPK + 1) * D;
    if (end_moe > off) off = end_moe;
    if (off > ws_size) { fprintf(stderr, "kernel_launch: workspace too small: need %zu, have %zu\n", off, ws_size); return; }

    static int cus = 0;
    if (cus == 0) {
        int dev = 0, n = 0;
        if (hipGetDevice(&dev) != hipSuccess || hipDeviceGetAttribute(&n, hipDeviceAttributeMultiprocessorCount, dev) != hipSuccess || n <= 0) n = 256;
        (void)hipFuncSetAttribute((const void*)k_fused, hipFuncAttributeMaxDynamicSharedMemorySize, LDS_BYTES);
        cus = n;
    }
    (void)hipMemsetAsync(p.bar, 0, 16384 + 256, stream);
    void* args[] = {(void*)&p};
    (void)hipLaunchCooperativeKernel((const void*)k_fused, dim3(cus), dim3(NTHREADS), args, LDS_BYTES, stream);
}
```

```cpp
#include <hip/hip_runtime.h>
#include <stdint.h>
#include <stdio.h>

#define REP_PH -2
#define REP_N 1
#define REP_SEL 15

namespace {

typedef unsigned short bf16_t;
typedef short bf16x8 __attribute__((ext_vector_type(8)));
typedef float f32x4 __attribute__((ext_vector_type(4)));
typedef float f32x2 __attribute__((ext_vector_type(2)));
typedef unsigned u32x4 __attribute__((ext_vector_type(4)));
typedef unsigned u32x2 __attribute__((ext_vector_type(2)));
#define LAS __attribute__((address_space(3)))

constexpr int D = 1024, NBATCH = 8, SEQ = 2048, T = NBATCH * SEQ, NL = 2;
constexpr int RWW = 384, SBW = 384, PLW = 256;
constexpr int RWC = 1280, SBC = 1152, INC = 2688;
constexpr int PJB = 2816;
constexpr int NE = 64, TOPK = 6, ED = 256;
constexpr int MAXRT = 512;
constexpr int NTHREADS = 512;
constexpr float SLAB_SC = 16.f;
constexpr int LDS_STAGE = 141312, LDS_CTL = 4096, LDS_BYTES = LDS_STAGE + LDS_CTL;

struct P {
    const float *x, *c, *w_ada, *b_ada, *w_in, *w_vres, *mu_rw, *mu_vres, *rw_w0, *rw_w2, *rw_a0, *rw_a2,
        *rw_v0, *rw_v2, *rw_g2, *rw_k_k, *rw_k_a, *rw_r_k, *rw_ln_g, *rw_ln_b, *sb_norm_g, *pool_w, *pool_scale,
        *w_out, *w_router, *b_router, *w_eg, *w_eu, *w_ed, *w_sg, *w_su, *w_sd, *g_final;
    float* out;
    unsigned* bar;
    float* mod;
    int* cnt;
    int2* list;
    int* cnt2;
    int* seg;
    float* topw;
    bf16_t* wt_in;
    bf16_t* wt_out;
    bf16_t* lwt;
    bf16_t* wt1;
    bf16_t* wt2;
    float* xb;
    bf16_t* h;
    bf16_t* vfirst;
    bf16_t* proj;
    bf16_t* vt;
    unsigned char* rec;
    unsigned char* cb;
    bf16_t* g;
    bf16_t* y;
    bf16_t* hm;
    unsigned char* slab;
};

__device__ __forceinline__ int opaque(int x) { asm volatile("" : "+v"(x)); return x; }
__device__ __forceinline__ float dpp_add16(float x) {
    x += __builtin_bit_cast(float, __builtin_amdgcn_update_dpp(0, __builtin_bit_cast(int, x), 0xB1, 0xF, 0xF, true));
    x += __builtin_bit_cast(float, __builtin_amdgcn_update_dpp(0, __builtin_bit_cast(int, x), 0x4E, 0xF, 0xF, true));
    x += __builtin_bit_cast(float, __builtin_amdgcn_update_dpp(0, __builtin_bit_cast(int, x), 0x141, 0xF, 0xF, true));
    x += __builtin_bit_cast(float, __builtin_amdgcn_update_dpp(0, __builtin_bit_cast(int, x), 0x140, 0xF, 0xF, true));
    return x;
}
__device__ __forceinline__ float wave_sum(float v) {
    v = dpp_add16(v);
    const int vi = __builtin_bit_cast(int, v);
    return (__builtin_bit_cast(float, __builtin_amdgcn_readlane(vi, 0)) + __builtin_bit_cast(float, __builtin_amdgcn_readlane(vi, 16)))
         + (__builtin_bit_cast(float, __builtin_amdgcn_readlane(vi, 32)) + __builtin_bit_cast(float, __builtin_amdgcn_readlane(vi, 48)));
}
__device__ __forceinline__ unsigned pf_lines(const void* p, int nbytes, int lane) {
    unsigned acc = 0u;
    for (int off = lane * 128; off < nbytes; off += 8192) acc += *(const unsigned*)((const char*)p + off);
    return acc;
}
__device__ __forceinline__ void pf_done(unsigned v) { asm volatile("" :: "v"(v)); }
constexpr float LOG2E = 1.4426950408889634f, LN2 = 0.6931471805599453f;
__device__ __forceinline__ float exp2f_(float x) { return __builtin_amdgcn_exp2f(x); }
__device__ __forceinline__ float log2f_(float x) { return __builtin_amdgcn_logf(x); }
__device__ __forceinline__ float rcpf_(float x) { return __builtin_amdgcn_rcpf(x); }
__device__ __forceinline__ float sigmoidf_(float x) { return rcpf_(1.f + exp2f_(-LOG2E * x)); }
__device__ __forceinline__ float softplusf_(float x) { return fmaxf(x, 0.f) + LN2 * log2f_(1.f + exp2f_(-LOG2E * fabsf(x))); }
__device__ __forceinline__ float siluf_(float x) { return x * rcpf_(1.f + exp2f_(-LOG2E * x)); }
__device__ __forceinline__ unsigned f2bf_sw(float f) { unsigned u = __builtin_bit_cast(unsigned, f); return (u + 0x7fffu + ((u >> 16) & 1u)) >> 16; }
__device__ __forceinline__ unsigned pk2_sw(float lo, float hi) { return f2bf_sw(lo) | (f2bf_sw(hi) << 16); }
typedef __bf16 bf16x2_t __attribute__((ext_vector_type(2)));
__device__ __forceinline__ unsigned cvtpk(float lo, float hi) { const f32x2 v = {lo, hi}; const bf16x2_t b = __builtin_convertvector(v, bf16x2_t); return __builtin_bit_cast(unsigned, b); }
__device__ __forceinline__ bf16x8 mk8(unsigned a, unsigned b, unsigned c, unsigned d) { return __builtin_bit_cast(bf16x8, (u32x4){a, b, c, d}); }
__device__ __forceinline__ unsigned pk2(float lo, float hi) { return cvtpk(lo, hi); }
__device__ __forceinline__ unsigned f2bf(float f) { return cvtpk(f, 0.f) & 0xffffu; }
__device__ __forceinline__ float bf2f(bf16_t h) { return __builtin_bit_cast(float, (unsigned)h << 16); }
__device__ __forceinline__ float bflo(unsigned u) { return __builtin_bit_cast(float, u << 16); }
__device__ __forceinline__ float bfhi(unsigned u) { return __builtin_bit_cast(float, u & 0xffff0000u); }

namespace pg8 {
constexpr int BM = 256, BK = 64, HALF = 128, HTB = HALF * BK * 2, STAGE_BYTES = 8 * HTB;
__device__ __forceinline__ int lds_byte(int r, int c) { const int st = (r >> 4) * 2 + (c >> 5), rr = r & 15, cc = c & 31, ob = rr * 64 + cc * 2; return st * 1024 + (ob ^ (((ob >> 9) & 1) << 5)); }
__device__ __forceinline__ void stage_rc(int b, int& R, int& C) { const int st = b / 1024, sb = b % 1024, swz = sb ^ (((sb >> 9) & 1) << 5); R = (st >> 1) * 16 + swz / 64; C = (st & 1) * 32 + (swz % 64) / 2; }
__device__ __forceinline__ int perm32(int rho) { const int n = rho >> 4, i = rho & 15; return 8 * (i >> 2) + 4 * n + (i & 3); }

struct Unit { int pm, pn, e, mt; };

template <class Epi, class Sched, bool ALIGN_EPI, bool SP2>
__device__ __forceinline__ void gemm_phase(LAS unsigned char* lds, const int K, const Sched& S, const Epi& E) {
    const int tid = opaque(threadIdx.x), wid = __builtin_amdgcn_readfirstlane(tid >> 6), lane = tid & 63, wr = wid >> 2, wc = wid & 3, fr = lane & 15, fq = lane >> 4;
    const int nt = K / BK;
    unsigned voffA[2], voffB[2];
#pragma unroll
    for (int i = 0; i < 2; ++i) { int R, C; stage_rc(tid * 16 + i * 8192, R, C);
        const int Rb = Epi::BX2 ? ((R >> 5) * 64 + 16 * ((R & 15) >> 2) + 4 * ((R & 31) >> 4) + (R & 3)) : Epi::PERM ? ((R & ~31) + perm32(R & 31)) : R;
        voffA[i] = Sched::GATHER ? (unsigned)(C * 2) : (unsigned)(R * K + C) * 2u; voffB[i] = (unsigned)(Rb * K + C) * 2u; }
    const size_t kstep = (size_t)(BK * 2);
    const size_t hstep = (size_t)HALF * K * 2;
    const size_t hstepB = Epi::BX2 ? (size_t)8 * K * 2 : hstep;
    const unsigned ldsw = (unsigned)wid * 1024u;
    const int aoff = lds_byte(wr * 64 + fr, fq * 8), boff = lds_byte(wc * 32 + fr, fq * 8);
#define PG8_SA(b, h) (((b) * 2 + (h)) * HTB)
#define PG8_SB(b, h) ((4 + (b) * 2 + (h)) * HTB)
#define PG8_STAGE(bufoff, gbase, voff) do { _Pragma("unroll") for (int _i = 0; _i < 2; ++_i) \
        __builtin_amdgcn_global_load_lds((const unsigned*)((const char*)(gbase) + (voff)[_i]), (LAS unsigned*)(lds + (bufoff) + ldsw + _i * 8192), 16, 0, 0); } while (0)
#define PG8_LDA(dst, b, h) do { _Pragma("unroll") for (int m = 0; m < 4; ++m) _Pragma("unroll") for (int k = 0; k < 2; ++k) dst[m][k] = *(const LAS bf16x8*)(lds + PG8_SA(b, h) + aoff + m * 2048 + k * 1024); } while (0)
#define PG8_LDB(dst, b, h) do { _Pragma("unroll") for (int n = 0; n < 2; ++n) _Pragma("unroll") for (int k = 0; k < 2; ++k) dst[n][k] = *(const LAS bf16x8*)(lds + PG8_SB(b, h) + boff + n * 2048 + k * 1024); } while (0)
#define PG8_MMA(ai, bj, At, Bt) do { __builtin_amdgcn_s_setprio(1); _Pragma("unroll") for (int m = 0; m < 4; ++m) _Pragma("unroll") for (int n = 0; n < 2; ++n) _Pragma("unroll") for (int k = 0; k < 2; ++k) \
        acc[ai][bj][m][n] = __builtin_amdgcn_mfma_f32_16x16x32_bf16(Bt[n][k], At[m][k], acc[ai][bj][m][n], 0, 0, 0); __builtin_amdgcn_s_setprio(0); } while (0)
#define PG8_WAIT_V(n) asm volatile("s_waitcnt vmcnt(" #n ")" ::: "memory")
#define PG8_WAIT_L(n) asm volatile("s_waitcnt lgkmcnt(" #n ")" ::: "memory")
#define PG8_BAR __builtin_amdgcn_s_barrier()
#define PG8_SCHED __builtin_amdgcn_sched_barrier(0)
    Unit cur, nxt; int ui = 0;
    if (!S.next(0, cur)) return;
    f32x4 acc[2][2][4][2];
#pragma unroll
    for (int a = 0; a < 2; ++a)
#pragma unroll
        for (int b = 0; b < 2; ++b)
#pragma unroll
            for (int m = 0; m < 4; ++m)
#pragma unroll
                for (int n = 0; n < 2; ++n) acc[a][b][m][n] = (f32x4){0.f, 0.f, 0.f, 0.f};
    bf16x8 At[4][2], B0[2][2], B1[2][2];
    const char* cA = S.a_base(cur); const char* cB = S.b_base(cur);
    unsigned pk[2] = {0u, 0u}, npk[2] = {0u, 0u};
    if constexpr (Sched::GATHER) S.a_tok(cur, tid, pk);
    const unsigned k2 = (unsigned)K * 2u;
#define PG8_STAGE_A(bufoff, gbase, hh, PK) do { if constexpr (Sched::GATHER) { unsigned _v[2]; _v[0] = (((PK)[0] >> (16 * (hh))) & 0xffffu) * k2 + voffA[0]; _v[1] = (((PK)[1] >> (16 * (hh))) & 0xffffu) * k2 + voffA[1]; \
        PG8_STAGE(bufoff, gbase, _v); } else { PG8_STAGE(bufoff, (gbase) + (hh) * hstep, voffA); } } while (0)
    static_assert(SP2, "only the SP2 loop is kept");
    PG8_STAGE(PG8_SB(0, 0), cB, voffB); PG8_STAGE(PG8_SB(0, 1), cB + hstepB, voffB); PG8_STAGE_A(PG8_SA(0, 0), cA, 0, pk); PG8_STAGE_A(PG8_SA(0, 1), cA, 1, pk);
    if (wr == 1) PG8_BAR;
    PG8_WAIT_V(2); PG8_BAR;
    PG8_STAGE(PG8_SB(1, 0), cB + kstep, voffB); PG8_STAGE_A(PG8_SA(1, 0), cA + kstep, 0, pk); PG8_STAGE(PG8_SB(1, 1), cB + hstepB + kstep, voffB);
    PG8_WAIT_V(6); PG8_BAR;
    for (;;) {
        const bool has_next = S.next(ui + 1, nxt);
        const char* nA = has_next ? S.a_base(nxt) : cA; const char* nB = has_next ? S.b_base(nxt) : cB;
        if constexpr (Sched::GATHER) { if (has_next) S.a_tok(nxt, tid, npk); else { npk[0] = pk[0]; npk[1] = pk[1]; } }
#pragma unroll 1
        for (int t = 0; t < nt; t += 2) {
            const bool last = (t == nt - 2);
            const char* a1 = cA + (size_t)(t + 1) * kstep;
            const char* a2 = last ? nA : cA + (size_t)(t + 2) * kstep; const char* b2 = last ? nB : cB + (size_t)(t + 2) * kstep;
            const char* a3 = a2 + kstep; const char* b3 = b2 + kstep;
            unsigned sp[2]; sp[0] = last ? npk[0] : pk[0]; sp[1] = last ? npk[1] : pk[1];
            PG8_LDB(B0, 0, 0); PG8_LDB(B1, 0, 1); PG8_SCHED; PG8_LDA(At, 0, 0); PG8_STAGE_A(PG8_SA(1, 1), a1, 1, pk);
            PG8_WAIT_V(8); PG8_WAIT_L(0); PG8_BAR; PG8_MMA(0, 0, At, B0); PG8_MMA(0, 1, At, B1); PG8_BAR; PG8_SCHED;
            PG8_LDA(At, 0, 1); PG8_STAGE(PG8_SB(0, 0), b2, voffB); PG8_STAGE(PG8_SB(0, 1), b2 + hstepB, voffB); PG8_STAGE_A(PG8_SA(0, 0), a2, 0, sp);
            PG8_WAIT_V(8); PG8_WAIT_L(0); PG8_BAR; PG8_MMA(1, 0, At, B0); PG8_MMA(1, 1, At, B1); PG8_BAR; PG8_SCHED;
            PG8_LDB(B0, 1, 0); PG8_LDB(B1, 1, 1); PG8_SCHED; PG8_LDA(At, 1, 0); PG8_STAGE_A(PG8_SA(0, 1), a2, 1, sp);
            PG8_WAIT_V(8); PG8_WAIT_L(0); PG8_BAR; PG8_MMA(0, 0, At, B0); PG8_MMA(0, 1, At, B1); PG8_BAR; PG8_SCHED;
            PG8_LDA(At, 1, 1); PG8_STAGE(PG8_SB(1, 0), b3, voffB); PG8_STAGE(PG8_SB(1, 1), b3 + hstepB, voffB); PG8_STAGE_A(PG8_SA(1, 0), a3, 0, sp);
            PG8_WAIT_V(8); PG8_WAIT_L(0); PG8_BAR; PG8_MMA(1, 0, At, B0); PG8_MMA(1, 1, At, B1); PG8_BAR; PG8_SCHED;
        }
        if constexpr (ALIGN_EPI) { if (wr == 0) PG8_BAR; }
        { const int t2 = opaque(threadIdx.x), w2 = __builtin_amdgcn_readfirstlane(t2 >> 6), l2 = t2 & 63; E(acc, cur, w2 >> 2, w2 & 3, l2 & 15, l2 >> 4); }
        if (!has_next) break;
#pragma unroll
        for (int a = 0; a < 2; ++a)
#pragma unroll
            for (int b = 0; b < 2; ++b)
#pragma unroll
                for (int m = 0; m < 4; ++m)
#pragma unroll
                    for (int n = 0; n < 2; ++n) acc[a][b][m][n] = (f32x4){0.f, 0.f, 0.f, 0.f};
        cur = nxt; cA = nA; cB = nB; ++ui;
        pk[0] = npk[0]; pk[1] = npk[1];
        if constexpr (ALIGN_EPI) { if (wr == 1) PG8_BAR; }
    }
    PG8_WAIT_V(0);
    if constexpr (!ALIGN_EPI) { if (wr == 0) PG8_BAR; }
    PG8_BAR;
#undef PG8_SA
#undef PG8_SB
#undef PG8_STAGE
#undef PG8_STAGE_A
#undef PG8_LDA
#undef PG8_LDB
#undef PG8_MMA
#undef PG8_WAIT_V
#undef PG8_WAIT_L
#undef PG8_BAR
#undef PG8_SCHED
}

struct DenseOrder {
    const bf16_t* A; const bf16_t* Bt; int K; int nM, nN, nwg, G, c;
    __device__ __forceinline__ void init(const bf16_t* A_, const bf16_t* Bt_, int M, int N, int K_, int G_, int c_) { A = A_; Bt = Bt_; K = K_; nM = M / BM; nN = N / BM; nwg = nM * nN; G = G_; c = c_; }
    __device__ __forceinline__ bool next(int i, Unit& u) const {
        const long L = (long)i * G + c; if (L >= nwg) return false;
        int wgid = (int)L; { const int q = nwg / 8, r = nwg % 8, xcd = wgid % 8, off = wgid / 8; wgid = (xcd < r ? xcd * (q + 1) : r * (q + 1) + (xcd - r) * q) + off; }
        const int nig = 8 * nN, gid = wgid / nig, fm = gid * 8, gsz = (nM - fm) < 8 ? (nM - fm) : 8;
        u.pm = fm + ((wgid % nig) % gsz); u.pn = (wgid % nig) / gsz; u.e = 0; u.mt = 0; return true;
    }
    __device__ __forceinline__ const char* a_base(const Unit& u) const { return (const char*)A + (size_t)u.pm * BM * K * 2; }
    __device__ __forceinline__ const char* b_base(const Unit& u) const { return (const char*)Bt + (size_t)u.pn * BM * K * 2; }
    static constexpr bool GATHER = false;
    __device__ __forceinline__ void a_tok(const Unit&, int, unsigned (&)[2]) const {}
};

template <bool GATHER_>
struct MoeOrder {
    static constexpr bool GATHER = GATHER_;
    const LAS int* tstart;
    const LAS int* cnts;
    const LAS int* tmap;
    const int2* list;
    const bf16_t* A;
    const bf16_t* Bt;
    int K, N, lognpn, G, c;
    __device__ __forceinline__ bool next(int i, Unit& u) const {
        const int L = i * G + c; const int total = __builtin_amdgcn_readfirstlane(tstart[65]) << lognpn; if (L >= total) return false;
        const int rt = L >> lognpn; u.pn = L & ((1 << lognpn) - 1); u.pm = rt;
        const int e = __builtin_amdgcn_readfirstlane(tmap[rt]);
        u.e = e; u.mt = rt - __builtin_amdgcn_readfirstlane(tstart[e]); return true;
    }
    __device__ __forceinline__ const char* a_base(const Unit& u) const { return GATHER ? (const char*)A : (const char*)A + (size_t)u.pm * BM * K * 2; }
    __device__ __forceinline__ const char* b_base(const Unit& u) const { return (const char*)Bt + ((size_t)u.e * N + (size_t)u.pn * BM) * K * 2; }
    __device__ __forceinline__ void a_tok(const Unit& u, int tid, unsigned (&pkv)[2]) const {
        const int ce = cnts[u.e];
#pragma unroll
        for (int i = 0; i < 2; ++i) {
            int R, C; stage_rc(tid * 16 + i * 8192, R, C); (void)C;
            unsigned v = 0u;
#pragma unroll
            for (int hh = 0; hh < 2; ++hh) {
                const int idx = u.mt * BM + hh * HALF + R;
                int tok = 0;
                if (idx < ce) tok = (u.e < NE) ? (list[(size_t)u.e * T + idx].x / TOPK) : idx;
                v |= (unsigned)tok << (16 * hh);
            }
            pkv[i] = v;
        }
    }
};

struct EpiProj {
    static constexpr bool PERM = true, BX2 = false;
    bf16_t* O; bf16_t* vt;
    __device__ __forceinline__ void operator()(const f32x4 (&acc)[2][2][4][2], const Unit& u, int wr, int wc, int fr, int fq) const {
        const int row0 = u.pm * BM + wr * 64 + fr, col0 = u.pn * BM + wc * 32 + 8 * fq;
#pragma unroll
        for (int bj = 0; bj < 2; ++bj) {
            const bool isv = (u.pn == 8) || (u.pn == 9 && bj == 0);
            if (!isv) {
#pragma unroll
                for (int ai = 0; ai < 2; ++ai)
#pragma unroll
                    for (int m = 0; m < 4; ++m) { bf16_t* rowp = O + (size_t)(row0 + ai * HALF + m * 16) * PJB + col0 + bj * HALF;
                        const f32x4 v0 = acc[ai][bj][m][0], v1 = acc[ai][bj][m][1];
                        u32x4 w; w.x = pk2(v0[0], v0[1]); w.y = pk2(v0[2], v0[3]); w.z = pk2(v1[0], v1[1]); w.w = pk2(v1[2], v1[3]);
                        *(u32x4*)rowp = w; }
            } else {
                const int vc0 = col0 + bj * HALF - 2048;
#pragma unroll
                for (int ai = 0; ai < 2; ++ai)
#pragma unroll
                    for (int m = 0; m < 4; ++m) { const int row = row0 + ai * HALF + m * 16; const int b = row / SEQ, s = row % SEQ;
                        bf16_t* base = vt + ((size_t)b * SBW + vc0) * SEQ + s;
#pragma unroll
                        for (int n = 0; n < 2; ++n)
#pragma unroll
                            for (int j = 0; j < 4; ++j) base[(size_t)(4 * n + j) * SEQ] = (bf16_t)f2bf(acc[ai][bj][m][n][j]); }
            }
        }
    }
};
struct EpiOut {
    static constexpr bool PERM = false, BX2 = false;
    const float* xin; float* xo; const float* gt;
    __device__ __forceinline__ void operator()(const f32x4 (&acc)[2][2][4][2], const Unit& u, int wr, int wc, int fr, int fq) const {
        const int row0 = u.pm * BM + wr * 64 + fr, col0 = u.pn * BM + wc * 32 + 4 * fq;
        const float* gr = gt + (size_t)((u.pm * BM) / SEQ) * 6144;
        f32x4 gg[2][2];
#pragma unroll
        for (int bj = 0; bj < 2; ++bj)
#pragma unroll
            for (int n = 0; n < 2; ++n) gg[bj][n] = *(const f32x4*)(gr + col0 + bj * HALF + 16 * n);
#pragma unroll
        for (int am = 0; am < 4; ++am) {
            const int ai = am >> 1, m0 = (am & 1) * 2;
            f32x4 xi[2][2][2];
#pragma unroll
            for (int m = 0; m < 2; ++m)
#pragma unroll
                for (int bj = 0; bj < 2; ++bj)
#pragma unroll
                    for (int n = 0; n < 2; ++n) xi[m][bj][n] = *(const f32x4*)(xin + (size_t)(row0 + ai * HALF + (m0 + m) * 16) * D + col0 + bj * HALF + 16 * n);
#pragma unroll
            for (int m = 0; m < 2; ++m)
#pragma unroll
                for (int bj = 0; bj < 2; ++bj)
#pragma unroll
                    for (int n = 0; n < 2; ++n) *(f32x4*)(xo + (size_t)(row0 + ai * HALF + (m0 + m) * 16) * D + col0 + bj * HALF + 16 * n) = xi[m][bj][n] + gg[bj][n] * acc[ai][bj][m0 + m][n];
        }
    }
};
struct EpiExp1 {
    static constexpr bool PERM = true, BX2 = false;
    bf16_t* hm;
    __device__ __forceinline__ void operator()(const f32x4 (&acc)[2][2][4][2], const Unit& u, int wr, int wc, int fr, int fq) const {
        const int row0 = u.pm * BM + wr * 64 + fr, col0 = u.pn * HALF + wc * 32 + 8 * fq;
#pragma unroll
        for (int ai = 0; ai < 2; ++ai)
#pragma unroll
            for (int m = 0; m < 4; ++m) { bf16_t* rowp = hm + (size_t)(row0 + ai * HALF + m * 16) * ED + col0;
                float o[8];
#pragma unroll
                for (int n = 0; n < 2; ++n)
#pragma unroll
                    for (int j = 0; j < 4; ++j) o[n * 4 + j] = siluf_(acc[ai][0][m][n][j]) * acc[ai][1][m][n][j];
                u32x4 w; w.x = pk2(o[0], o[1]); w.y = pk2(o[2], o[3]); w.z = pk2(o[4], o[5]); w.w = pk2(o[6], o[7]);
                *(u32x4*)rowp = w; }
    }
};
struct EpiExp2 {
    static constexpr bool PERM = true, BX2 = true;
    unsigned char* slab; const int2* list; const LAS int* cnts;
    __device__ __forceinline__ static unsigned pack4(const f32x4& v, float sc) {
        const float a = __builtin_amdgcn_fmed3f(v[0] * sc, -448.f, 448.f), b = __builtin_amdgcn_fmed3f(v[1] * sc, -448.f, 448.f), c = __builtin_amdgcn_fmed3f(v[2] * sc, -448.f, 448.f), d = __builtin_amdgcn_fmed3f(v[3] * sc, -448.f, 448.f);
        int w = __builtin_amdgcn_cvt_pk_fp8_f32(a, b, 0, false);
        w = __builtin_amdgcn_cvt_pk_fp8_f32(c, d, w, true);
        return (unsigned)w;
    }
    __device__ __forceinline__ void operator()(const f32x4 (&acc)[2][2][4][2], const Unit& u, int wr, int wc, int fr, int fq) const {
        const int col0 = u.pn * BM + wc * 64 + 16 * fq; const int ce = cnts[u.e];
#pragma unroll
        for (int ai = 0; ai < 2; ++ai)
#pragma unroll
            for (int m = 0; m < 4; ++m) { const int idx = u.mt * BM + ai * HALF + wr * 64 + m * 16 + fr;
                if (idx < ce) {
                    int row; float sc;
                    if (u.e < NE) { const int2 ri = list[(size_t)u.e * T + idx]; row = ri.x; sc = __int_as_float(ri.y) * SLAB_SC; }
                    else { row = T * TOPK + idx; sc = SLAB_SC; }
                    *(u32x4*)(slab + (size_t)row * D + col0) = (u32x4){pack4(acc[ai][0][m][0], sc), pack4(acc[ai][0][m][1], sc), pack4(acc[ai][1][m][0], sc), pack4(acc[ai][1][m][1], sc)};
                } }
    }
};
}

__device__ __forceinline__ void st_mod(const P& p, int item, LAS float* L  ) {
    const int tid = opaque(threadIdx.x), wave = tid >> 6, lane = tid & 63;
    const int l = item / 96, j0 = (item % 96) * 64;
    for (int i = tid; i < 8 * 1024; i += NTHREADS) L[i] = siluf_(p.c[i]);
    __syncthreads();
    float acc[8];
#pragma unroll
    for (int b = 0; b < 8; ++b) acc[b] = 0.f;
    const float* w = p.w_ada + ((size_t)l * 1024 + wave * 128) * 6144 + j0 + lane;
#pragma unroll 8
    for (int i = 0; i < 128; ++i) {
        const float wv = w[(size_t)i * 6144];
#pragma unroll
        for (int b = 0; b < 8; ++b) acc[b] += L[b * 1024 + wave * 128 + i] * wv;
    }
    LAS float* red = L + 8 * 1024;
#pragma unroll
    for (int b = 0; b < 8; ++b) red[(wave * 8 + b) * 64 + lane] = acc[b];
    __syncthreads();
    {
        const int b = tid >> 6;
        float s = p.b_ada[l * 6144 + j0 + lane];
#pragma unroll
        for (int wv = 0; wv < 8; ++wv) s += red[(wv * 8 + b) * 64 + lane];
        p.mod[((size_t)l * 8 + b) * 6144 + j0 + lane] = s;
    }
    __syncthreads();
}

constexpr int REC_HB = 912, REC_TB = 6 * REC_HB;
constexpr int CB_S64 = 136, CB_S32 = 80;
constexpr int CB_PHI = 0, CB_RT = CB_PHI + 64 * CB_S64, CB_PSI = CB_RT + 32 * CB_S64, CB_G = CB_PSI + 64 * CB_S32, CB_V = CB_G + 32 * CB_S32, CB_BYTES = 26624;
static_assert(CB_V + 64 * CB_S32 <= CB_BYTES && CB_BYTES % 1024 == 0, "chunk buffer layout");
struct CvtJob { const float* W; bf16_t* WT; int K, N, k0, n0, dst_row0; };
__device__ __forceinline__ void cvt_load(const CvtJob& j, float (&wv)[32], int lane) {
#pragma unroll
    for (int i = 0; i < 32; ++i) wv[i] = j.W[(size_t)(j.k0 + 2 * i + (lane >> 5)) * j.N + j.n0 + (lane & 31)];
}
__device__ __forceinline__ void cvt_store(const CvtJob& j, const float (&wv)[32], LAS float* scr, int lane) {
#pragma unroll
    for (int i = 0; i < 32; ++i) scr[(2 * i + (lane >> 5)) * 33 + (lane & 31)] = wv[i];
    asm volatile("s_waitcnt lgkmcnt(0)" ::: "memory");
    const int c = lane & 7;
#pragma unroll
    for (int q = 0; q < 4; ++q) { const int n = (lane >> 3) + 8 * q; const LAS float* sp = scr + (8 * c) * 33 + n;
        u32x4 o; o.x = pk2(sp[0 * 33], sp[1 * 33]); o.y = pk2(sp[2 * 33], sp[3 * 33]); o.z = pk2(sp[4 * 33], sp[5 * 33]); o.w = pk2(sp[6 * 33], sp[7 * 33]);
        *(u32x4*)(j.WT + (size_t)(j.dst_row0 + n) * j.K + j.k0 + 8 * c) = o; }
    asm volatile("s_waitcnt lgkmcnt(0)" ::: "memory");
}
__device__ __forceinline__ void cvt_item(const float* W, int K, int N, int k0, int n0, bf16_t* WT, int dst_row0, LAS float* scr, int lane) {
    const CvtJob j{W, WT, K, N, k0, n0, dst_row0};
    float wv[32];
    cvt_load(j, wv, lane);
    cvt_store(j, wv, scr, lane);
}
constexpr int CV_IN = 16 * 84, CV_VR = 16, CV_OUT = 16 * 32, CV_DENSE_L = CV_IN + CV_VR + CV_OUT, CV_DENSE = NL * CV_DENSE_L;
__device__ __forceinline__ void cvt_dense_item(const P& p, int it, LAS float* scr, int lane) {
    const int l = it / CV_DENSE_L; int r = it % CV_DENSE_L;
    bf16_t* wti = p.wt_in + (size_t)l * PJB * D;
    if (r < CV_IN) { const int kb = r / 84, nb = r % 84; cvt_item(p.w_in + (size_t)l * D * INC, D, INC, kb * 64, nb * 32, wti, nb * 32, scr, lane); return; }
    r -= CV_IN;
    if (r < CV_VR) {
        if (l == 1) cvt_item(p.w_vres, D, 32, r * 64, 0, wti, INC, scr, lane);
        const int rz0 = (l == 1) ? INC + 32 : INC;
        for (int row = rz0 + (lane >> 3); row < PJB; row += 8) *(u32x4*)(wti + (size_t)row * D + r * 64 + (lane & 7) * 8) = (u32x4){0u, 0u, 0u, 0u};
        return;
    }
    r -= CV_VR;
    { const int kb = r / 32, nb = r % 32; cvt_item(p.w_out + (size_t)l * D * D, D, D, kb * 64, nb * 32, p.wt_out + (size_t)l * D * D, nb * 32, scr, lane); }
}
constexpr int CV_EXP_E = 64 + 64 + 64, CV_EXP = 65 * CV_EXP_E, CV_QUOTA1 = 4, CV_QUOTA2 = 5, CV_ROUTER = (T / 32) * 8;
__device__ __forceinline__ CvtJob cvt_exp_job(const P& p, int l, int it) {
    const int e = it / CV_EXP_E; int r = it % CV_EXP_E;
    if (r < 128) {
        const int which = r >> 6; r &= 63; const int kb = r >> 2, nb = r & 3;
        const float* W = e < NE ? (which ? p.w_eu : p.w_eg) + ((size_t)l * NE + e) * D * ED : (which ? p.w_su : p.w_sg) + (size_t)l * D * ED;
        const int n0 = nb * 64, pn = n0 >> 7;
        return CvtJob{W, p.wt1 + (size_t)e * 512 * D, D, ED, kb * 64, n0, pn * 256 + which * 128 + (n0 & 127)};
    } else {
        r -= 128; const int kb = r >> 4, nb = r & 15;
        const float* W = e < NE ? p.w_ed + ((size_t)l * NE + e) * ED * D : p.w_sd + (size_t)l * ED * D;
        return CvtJob{W, p.wt2 + (size_t)e * D * ED, ED, D, kb * 64, nb * 64, nb * 64};
    }
}
__device__ __forceinline__ void cvx_load(const CvtJob& j, float (&wv)[64], int lane) {
    const float* src = j.W + (size_t)j.k0 * j.N + j.n0 + lane;
#pragma unroll
    for (int i = 0; i < 64; ++i) wv[i] = src[(size_t)i * j.N];
}
__device__ __forceinline__ unsigned lx1(unsigned v) { return (unsigned)__builtin_amdgcn_mov_dpp((int)v, 0xB1, 0xF, 0xF, true); }
__device__ __forceinline__ unsigned lx2(unsigned v) { return (unsigned)__builtin_amdgcn_mov_dpp((int)v, 0x4E, 0xF, 0xF, true); }
__device__ __forceinline__ unsigned lx4(unsigned v) { return (unsigned)__builtin_amdgcn_ds_swizzle((int)v, 0x101F); }
template <int B, int NCH>
__device__ __forceinline__ void lane_tr_stage(unsigned (&w)[NCH * 4], bool bit) {
#pragma unroll
    for (int c = 0; c < NCH; ++c) if ((c & B) == 0) {
#pragma unroll
        for (int d = 0; d < 4; ++d) {
            const unsigned lo = w[4 * c + d], hi = w[4 * (c | B) + d];
            const unsigned snd = bit ? lo : hi;
            const unsigned rcv = (B == 1) ? lx1(snd) : (B == 2) ? lx2(snd) : lx4(snd);
            w[4 * c + d] = bit ? rcv : lo; w[4 * (c | B) + d] = bit ? hi : rcv;
        }
    }
}
__device__ __forceinline__ void cvx_store(const CvtJob& j, const float (&wv)[64], int lane) {
    unsigned w[32];
#pragma unroll
    for (int q = 0; q < 32; ++q) w[q] = pk2(wv[2 * q], wv[2 * q + 1]);
    lane_tr_stage<1, 8>(w, (lane & 1) != 0); lane_tr_stage<2, 8>(w, (lane & 2) != 0); lane_tr_stage<4, 8>(w, (lane & 4) != 0);
    bf16_t* dst = j.WT + (size_t)(j.dst_row0 + (lane & ~7)) * j.K + j.k0 + 8 * (lane & 7);
#pragma unroll
    for (int sr = 0; sr < 8; ++sr) *(u32x4*)(dst + (size_t)sr * j.K) = (u32x4){w[4 * sr], w[4 * sr + 1], w[4 * sr + 2], w[4 * sr + 3]};
}
__device__ __forceinline__ void cvh_load(const CvtJob& j, int hf, float (&wv)[32], int lane) {
    const float* src = j.W + (size_t)(j.k0 + 32 * hf) * j.N + j.n0 + lane;
#pragma unroll
    for (int i = 0; i < 32; ++i) wv[i] = src[(size_t)i * j.N];
}
__device__ __forceinline__ void cvh_store(const CvtJob& j, int hf, const float (&wv)[32], int lane) {
    unsigned w[16];
#pragma unroll
    for (int q = 0; q < 16; ++q) w[q] = pk2(wv[2 * q], wv[2 * q + 1]);
    lane_tr_stage<1, 4>(w, (lane & 1) != 0); lane_tr_stage<2, 4>(w, (lane & 2) != 0);
    bf16_t* dst = j.WT + (size_t)(j.dst_row0 + (lane & ~3)) * j.K + j.k0 + 32 * hf + 8 * (lane & 3);
#pragma unroll
    for (int sr = 0; sr < 4; ++sr) *(u32x4*)(dst + (size_t)sr * j.K) = (u32x4){w[4 * sr], w[4 * sr + 1], w[4 * sr + 2], w[4 * sr + 3]};
}
__device__ __forceinline__ void cvt_exp_stream(const P& p, int l, int first, int stride, int CV_END, int lane) {
    if (first >= CV_END) return;
    float wa[64], wb[64];
    CvtJob ja = cvt_exp_job(p, l, first), jb = ja;
    cvx_load(ja, wa, lane);
    for (int it = first; it < CV_END; it += 2 * stride) {
        const bool hb = it + stride < CV_END;
        if (hb) { jb = cvt_exp_job(p, l, it + stride); cvx_load(jb, wb, lane); }
        cvx_store(ja, wa, lane);
        if (!hb) break;
        const bool ha = it + 2 * stride < CV_END;
        if (ha) { ja = cvt_exp_job(p, l, it + 2 * stride); cvx_load(ja, wa, lane); }
        cvx_store(jb, wb, lane);
        if (!ha) break;
    }
}
__device__ __forceinline__ void st_cpre(const P& p, int item, LAS unsigned char* L, int lane_);
constexpr int CP_LDS = 23296;
constexpr int PREP_TOK = 64, PREP_XS = 168;
__device__ __forceinline__ float xlane_(float x, int lane, int m) { return __builtin_bit_cast(float, __builtin_amdgcn_ds_bpermute((lane ^ m) << 2, __builtin_bit_cast(int, x))); }
template <int LY>
__device__ __forceinline__ void prep_step2(const P& p, int t0, int s0, int hh, const LAS bf16_t* X, const LAS float* PRM  , LAS unsigned char* RS  , int lane_) {
    const int ll = opaque(lane_), fr2 = ll & 15, fq2 = ll >> 4;
    const bf16_t* lw = p.lwt + ((size_t)LY * RWW + hh * 64) * 160;
    const int c0 = hh * 64 + 4 * fq2;
    const LAS float* prm = PRM + 4 * fq2;
    {
        bf16x8 fw[4], fa[4], fv[4];
#pragma unroll
        for (int nt = 0; nt < 4; ++nt) {
            const bf16_t* q = lw + (16 * nt + fr2) * 160 + 8 * fq2;
            fw[nt] = *(const bf16x8*)q; fa[nt] = *(const bf16x8*)(q + 32); fv[nt] = *(const bf16x8*)(q + (LY == 1 ? 128 : 0));
        }
#pragma unroll 1
        for (int mt = 0; mt < 4; ++mt) {
            const int tok = t0 + 16 * mt + fr2;
            const bool hasprev = (s0 + 16 * mt + fr2) > 0;
            constexpr int RSTR = 400;
            {
                const int tbase = t0 + 16 * mt - 1;
#pragma unroll 3
                for (int sx = 0; sx < 9; ++sx) {
                    const int pc = sx * 64 + ll;
                    if (pc < 17 * 24) {
                        const int row = (pc * 2731) >> 16, q = pc - 24 * row;
                        const int tr = max(tbase + row, 0);
                        const u32x4 v4 = *(const u32x4*)(p.proj + (size_t)tr * PJB + hh * 64 + (q >> 3) * 384 + (q & 7) * 8);
                        *(LAS u32x4*)(RS + row * RSTR + q * 16) = v4;
                    } else if (LY == 1 && pc < 17 * 24 + 128) {
                        const int pv = pc - 17 * 24, row = pv >> 3;
                        const u32x4 v4 = *(const u32x4*)(p.vfirst + (size_t)(t0 + 16 * mt + row) * RWW + hh * 64 + (pv & 7) * 8);
                        *(LAS u32x4*)(RS + 17 * RSTR + pv * 16) = v4;
                    }
                }
            }
            u32x2 rcu[4], rpv[4], kcu[4], kpv[4], vcu[4], vpv[4], vfi[4];
#pragma unroll
            for (int nt = 0; nt < 4; ++nt) {
                const LAS unsigned char* up = RS + fr2 * RSTR + (16 * nt + 4 * fq2) * 2;
                const LAS unsigned char* uc = up + RSTR;
                rcu[nt] = *(const LAS u32x2*)uc; kcu[nt] = *(const LAS u32x2*)(uc + 128); vcu[nt] = *(const LAS u32x2*)(uc + 256);
                rpv[nt] = *(const LAS u32x2*)up; kpv[nt] = *(const LAS u32x2*)(up + 128); vpv[nt] = *(const LAS u32x2*)(up + 256);
                if (LY == 1) vfi[nt] = *(const LAS u32x2*)(RS + 17 * RSTR + fr2 * 128 + (16 * nt + 4 * fq2) * 2); else vfi[nt] = (u32x2){0u, 0u};
            }
            asm volatile("s_waitcnt lgkmcnt(0)" ::: "memory");
            const unsigned pm = hasprev ? 0xffffffffu : 0u;
            const LAS bf16_t* xa = X + (16 * mt + fr2) * PREP_XS + 8 * fq2;
            const bf16x8 Aw = *(const LAS bf16x8*)xa, Aa = *(const LAS bf16x8*)(xa + 32), Av = *(const LAS bf16x8*)(xa + 128);
            float ksh[4][4], ss = 0.f;
#pragma unroll
            for (int nt = 0; nt < 4; ++nt) {
                const f32x4 muk = *(const LAS f32x4*)(prm + 7 * 64 + 16 * nt), kkc = *(const LAS f32x4*)(prm + 3 * 64 + 16 * nt);
                const unsigned k0 = kpv[nt].x & pm, k1 = kpv[nt].y & pm;
                const float kc[4] = {bflo(kcu[nt].x), bfhi(kcu[nt].x), bflo(kcu[nt].y), bfhi(kcu[nt].y)}, kp[4] = {bflo(k0), bfhi(k0), bflo(k1), bfhi(k1)};
#pragma unroll
                for (int rg = 0; rg < 4; ++rg) { const float k = kc[rg] + (kp[rg] - kc[rg]) * muk[rg]; ksh[nt][rg] = k; ss += (k * kkc[rg]) * (k * kkc[rg]); }
            }
            ss += xlane_(ss, ll, 16); ss += xlane_(ss, ll, 32);
            const float inrm = rcpf_(fmaxf(__builtin_amdgcn_sqrtf(ss), 1e-12f));
            float rkp = 0.f;
            LAS unsigned char* rc = RS + fr2 * REC_HB;
#pragma unroll
            for (int nt = 0; nt < 4; ++nt) {
                const int c = c0 + 16 * nt;
                __builtin_amdgcn_sched_barrier(0);
                const f32x4 awn = __builtin_amdgcn_mfma_f32_16x16x32_bf16(fw[nt], Aw, (f32x4){0.f, 0.f, 0.f, 0.f}, 0, 0, 0);
                const f32x4 aan = __builtin_amdgcn_mfma_f32_16x16x32_bf16(fa[nt], Aa, (f32x4){0.f, 0.f, 0.f, 0.f}, 0, 0, 0);
                f32x4 avn = (f32x4){0.f, 0.f, 0.f, 0.f};
                if (LY == 1) avn = __builtin_amdgcn_mfma_f32_16x16x32_bf16(fv[nt], Av, (f32x4){0.f, 0.f, 0.f, 0.f}, 0, 0, 0);
                const LAS float* pq = prm + 16 * nt;
                const f32x4 w0 = *(const LAS f32x4*)pq, a0 = *(const LAS f32x4*)(pq + 64), v0 = *(const LAS f32x4*)(pq + 128);
                const f32x4 kkc = *(const LAS f32x4*)(pq + 192), kac = *(const LAS f32x4*)(pq + 256), rkc = *(const LAS f32x4*)(pq + 320);
                const f32x4 mur = *(const LAS f32x4*)(pq + 384), muv = *(const LAS f32x4*)(pq + 512);
                const unsigned r0 = rpv[nt].x & pm, r1 = rpv[nt].y & pm, q0 = vpv[nt].x & pm, q1 = vpv[nt].y & pm;
                const float rcv[4] = {bflo(rcu[nt].x), bfhi(rcu[nt].x), bflo(rcu[nt].y), bfhi(rcu[nt].y)}, rpp[4] = {bflo(r0), bfhi(r0), bflo(r1), bfhi(r1)};
                const float vcv[4] = {bflo(vcu[nt].x), bfhi(vcu[nt].x), bflo(vcu[nt].y), bfhi(vcu[nt].y)}, vpp[4] = {bflo(q0), bfhi(q0), bflo(q1), bfhi(q1)};
                const float vfv[4] = {bflo(vfi[nt].x), bfhi(vfi[nt].x), bflo(vfi[nt].y), bfhi(vfi[nt].y)};
                float dec[4], oa[4], ob[4], ok[4], oq[4], ov[4];
#pragma unroll
                for (int rg = 0; rg < 4; ++rg) {
                    const float r = rcv[rg] + (rpp[rg] - rcv[rg]) * mur[rg]; float v = vcv[rg] + (vpp[rg] - vcv[rg]) * muv[rg]; const float k = ksh[nt][rg];
                    const float wlog = -softplusf_(-(awn[rg] + w0[rg])) - 0.5f;
                    const float decay = exp2f_(-LOG2E * exp2f_(LOG2E * wlog));
                    const float a = sigmoidf_(aan[rg] + a0[rg]);
                    if (LY == 1) { const float vg = sigmoidf_(avn[rg] + v0[rg]); v = v + (vfv[rg] - v) * vg; }
                    const float kk = k * kkc[rg] * inrm;
                    const float k2 = k * (1.f + (a - 1.f) * kac[rg]);
                    dec[rg] = decay; oa[rg] = -kk; ob[rg] = kk * a; ok[rg] = k2; oq[rg] = decay * r; ov[rg] = v;
                    rkp += r * k2 * rkc[rg];
                }
                *(LAS f32x4*)(rc + (16 * nt + 4 * fq2) * 4) = (f32x4){dec[0], dec[1], dec[2], dec[3]};
                LAS bf16_t* rb = (LAS bf16_t*)(rc + 256) + 16 * nt + 4 * fq2;
                *(LAS u32x2*)rb = (u32x2){pk2(oa[0], oa[1]), pk2(oa[2], oa[3])};
                *(LAS u32x2*)(rb + 64) = (u32x2){pk2(ob[0], ob[1]), pk2(ob[2], ob[3])};
                *(LAS u32x2*)(rb + 128) = (u32x2){pk2(ok[0], ok[1]), pk2(ok[2], ok[3])};
                *(LAS u32x2*)(rb + 192) = (u32x2){pk2(oq[0], oq[1]), pk2(oq[2], oq[3])};
                *(LAS u32x2*)(rb + 256) = (u32x2){pk2(ov[0], ov[1]), pk2(ov[2], ov[3])};
                if (LY == 0) *(u32x2*)(p.vfirst + (size_t)tok * RWW + c) = (u32x2){pk2(ov[0], ov[1]), pk2(ov[2], ov[3])};
            }
            rkp += xlane_(rkp, ll, 16); rkp += xlane_(rkp, ll, 32);
            if (fq2 == 0) *(LAS float*)(rc + 896) = rkp;
            {
                unsigned char* g0 = p.rec + (size_t)(t0 + 16 * mt) * REC_TB + hh * REC_HB;
#pragma unroll 3
                for (int sx = 0; sx < 15; ++sx) {
                    const int pc = sx * 64 + ll;
                    if (pc < 16 * 57) {
                        const int tq = (pc * 1150) >> 16, off = (pc - 57 * tq) * 16;
                        *(u32x4*)(g0 + (size_t)tq * REC_TB + off) = *(const LAS u32x4*)(RS + pc * 16);
                    }
                }
            }
        }
    }
    {
        bf16x8 g0[4], g1[4];
#pragma unroll
        for (int nt = 0; nt < 4; ++nt) { const bf16_t* q = lw + (16 * nt + fr2) * 160 + 64 + 8 * fq2; g0[nt] = *(const bf16x8*)q; g1[nt] = *(const bf16x8*)(q + 32); }
#pragma unroll 1
        for (int mt = 0; mt < 4; ++mt) {
            const int tok = t0 + 16 * mt + fr2;
            const LAS bf16_t* xa = X + (16 * mt + fr2) * PREP_XS + 8 * fq2;
            const bf16x8 Ag0 = *(const LAS bf16x8*)(xa + 64), Ag1 = *(const LAS bf16x8*)(xa + 96);
#pragma unroll
            for (int nt = 0; nt < 4; ++nt) {
                f32x4 ag = __builtin_amdgcn_mfma_f32_16x16x32_bf16(g0[nt], Ag0, (f32x4){0.f, 0.f, 0.f, 0.f}, 0, 0, 0);
                ag = __builtin_amdgcn_mfma_f32_16x16x32_bf16(g1[nt], Ag1, ag, 0, 0, 0);
                *(u32x2*)(p.g + (size_t)tok * RWW + c0 + 16 * nt) = (u32x2){pk2(ag[0], ag[1]), pk2(ag[2], ag[3])};
            }
        }
    }
}
__device__ __forceinline__ void st_prep(const P& p, int l, int vb0, int vbstride, LAS unsigned char* L, int psel) {
    const int tid = opaque(threadIdx.x), wave = __builtin_amdgcn_readfirstlane(tid >> 6), lane = tid & 63;
    LAS bf16_t* X = (LAS bf16_t*)L;
    for (int vb = vb0; vb < T / PREP_TOK; vb += vbstride) {
        const int t0 = vb * PREP_TOK, s0 = t0 % SEQ;
        const int tx = opaque(tid);
        if ((psel & 1) && tx < 480) {
            const int cp = tx % 80, ta = (tx / 80) * 11, i = 2 * cp;
            const int col = (i < 128) ? 1152 + i : INC + (i - 128);
            const f32x2 mu = (i < 128) ? *(const f32x2*)(p.mu_rw + l * RWC + col) : *(const f32x2*)(p.mu_vres + (i - 128));
            const bf16_t* u = p.proj + (size_t)(t0 + ta) * PJB + col;
            unsigned cur[12];
            cur[0] = (s0 + ta > 0) ? *(const unsigned*)(u - PJB) : 0u;
#pragma unroll
            for (int j = 0; j < 11; ++j) cur[j + 1] = *(const unsigned*)(u + (size_t)min(j, 63 - ta) * PJB);
#pragma unroll
            for (int j = 0; j < 11; ++j) {
                const float u0 = bflo(cur[j + 1]), u1 = bfhi(cur[j + 1]), p0 = bflo(cur[j]), p1 = bfhi(cur[j]);
                float x0 = u0 + (p0 - u0) * mu[0], x1 = u1 + (p1 - u1) * mu[1];
                if (i < 32) { x0 = 1.f - 2.f * rcpf_(exp2f_(2.f * LOG2E * x0) + 1.f); x1 = 1.f - 2.f * rcpf_(exp2f_(2.f * LOG2E * x1) + 1.f); }
                else if (i >= 64 && i < 128) { x0 = sigmoidf_(x0); x1 = sigmoidf_(x1); }
                if (i >= 128 && l == 0) { x0 = 0.f; x1 = 0.f; }
                if (ta + j < PREP_TOK) *(LAS unsigned*)(X + (ta + j) * PREP_XS + i) = pk2(x0, x1);
            }
        }
        if (psel & 2) {
            LAS float* PR = (LAS float*)(L + 2 * CP_LDS);
            float pvv[7];
#pragma unroll
            for (int q = 0; q < 7; ++q) {
                const int idx = tx + q * NTHREADS, iu = __builtin_amdgcn_readfirstlane(idx >> 6), hq = iu / 9, ar = iu % 9, c = hq * 64 + (idx & 63);
                const float* src = (ar == 0) ? p.rw_w0 + l * RWW : (ar == 1) ? p.rw_a0 + l * RWW : (ar == 2) ? p.rw_v0 : (ar == 3) ? p.rw_k_k + l * RWW : (ar == 4) ? p.rw_k_a + l * RWW : (ar == 5) ? p.rw_r_k + l * RWW
                                 : p.mu_rw + l * RWC + (ar - 6) * 384;
                pvv[q] = (idx < 6 * 576 && !(ar == 2 && l == 0)) ? src[c] : 0.f;
            }
#pragma unroll
            for (int q = 0; q < 7; ++q) { const int idx = tx + q * NTHREADS; if (idx < 6 * 576) PR[idx] = pvv[q]; }
        }
        __syncthreads();
        const int iw = 2 * vb0 + (wave - 6), istr = 2 * vbstride;
        if (wave >= 6) { if ((psel & 8) && vb == vb0) cvt_exp_stream(p, l, iw, istr, min(CV_EXP, iw + CV_QUOTA1 * istr), lane); }
        if (wave < 6 && (psel & 2)) { const LAS float* prm = (const LAS float*)(L + 2 * CP_LDS) + wave * 576; LAS unsigned char* rs = (wave == 0) ? L + 21504 : L + 2 * CP_LDS + 13824 + (wave - 1) * 14592; if (l == 0) prep_step2<0>(p, t0, s0, wave, X, prm, rs, lane); else prep_step2<1>(p, t0, s0, wave, X, prm, rs, lane); }
        __syncthreads();
        if (wave < 6) {
            if (psel & 4) {
            const int b = t0 / SEQ, ch0 = s0 / 32;
#pragma unroll 1
            for (int q = 0; q < 2; ++q) st_cpre(p, ((b * 6 + wave) * 64) + ch0 + q, L + wave * CP_LDS, lane);
            }
        } else if ((psel & 8) && vb == vb0) cvt_exp_stream(p, l, iw + CV_QUOTA1 * istr, istr, min(CV_EXP, iw + (CV_QUOTA1 + CV_QUOTA2) * istr), lane);
        __syncthreads();
    }
}

typedef float f32x16 __attribute__((ext_vector_type(16)));
__device__ __forceinline__ bf16x8 acc_frag(const f32x16& x, int ks) {
    return ks == 0 ? mk8(cvtpk(x[0], x[1]), cvtpk(x[2], x[3]), cvtpk(x[4], x[5]), cvtpk(x[6], x[7])) : mk8(cvtpk(x[8], x[9]), cvtpk(x[10], x[11]), cvtpk(x[12], x[13]), cvtpk(x[14], x[15]));
}
__device__ __forceinline__ bf16x8 lds_perm_frag(const LAS unsigned char* rowp, int ks, int hf) {
    const u32x2 g0 = *(const LAS u32x2*)(rowp + (16 * ks + 4 * hf) * 2), g1 = *(const LAS u32x2*)(rowp + (16 * ks + 4 * hf + 8) * 2);
    return mk8(g0.x, g0.y, g1.x, g1.y);
}
__device__ __forceinline__ bf16x8 lds_frag2(const LAS unsigned char* p16) { const u32x2 g0 = *(const LAS u32x2*)p16, g1 = *(const LAS u32x2*)(p16 + 8); return mk8(g0.x, g0.y, g1.x, g1.y); }
__device__ __forceinline__ void st_cpre(const P& p, int item, LAS unsigned char* L, int lane_) {
    const int lane = opaque(lane_);
    const int ch = item & 63, bh = item >> 6, b = bh / 6, hh = bh % 6;
    const int r = lane & 31, hf = lane >> 5;
    const unsigned char* rec0 = p.rec + ((size_t)(b * SEQ + ch * 32)) * REC_TB + hh * REC_HB;
    unsigned char* cbo = p.cb + (size_t)item * CB_BYTES;
    constexpr int S1 = 144, S2 = 72, SF = 36;
    LAS unsigned char* AbarT = L; LAS unsigned char* RbarT = L + 4608; LAS unsigned char* Bbar = L + 9216; LAS unsigned char* Kbar = L + 13824; LAS unsigned char* BbarT = L + 18432;
    LAS float* PCv = (LAS float*)(L + 23040);
    float Y[32];
    {
        float Pc = 1.f;
        unsigned bt[16], vtw[16];
#pragma unroll
        for (int t8 = 0; t8 < 32; t8 += 16) {
            float wv[16]; bf16_t av[16], bv[16], kv[16], qv[16], vv[16];
#pragma unroll
            for (int j = 0; j < 16; ++j) {
                const unsigned char* rp = rec0 + (size_t)(t8 + j) * REC_TB;
                wv[j] = *(const float*)(rp + lane * 4);
                const bf16_t* hb = (const bf16_t*)(rp + 256) + lane;
                av[j] = hb[0]; bv[j] = hb[64]; kv[j] = hb[128]; qv[j] = hb[192]; vv[j] = hb[256];
            }
#pragma unroll
            for (int j = 0; j < 16; ++j) {
                const int t = t8 + j;
                const float Pm = Pc; Pc *= wv[j]; const float inv = rcpf_(Pc);
                const float ab = bf2f(av[j]) * Pm, rb = bf2f(qv[j]) * Pm, bb = bf2f(bv[j]) * inv, kb = bf2f(kv[j]) * inv;
                Y[t] = ab;
                *(LAS bf16_t*)(AbarT + t * S1 + lane * 2) = (bf16_t)f2bf(ab);
                *(LAS bf16_t*)(RbarT + t * S1 + lane * 2) = (bf16_t)f2bf(rb);
                *(LAS bf16_t*)(Bbar + t * S1 + lane * 2) = (bf16_t)f2bf(bb);
                *(LAS bf16_t*)(Kbar + t * S1 + lane * 2) = (bf16_t)f2bf(kb);
                if (t & 1) { bt[t >> 1] |= f2bf(bb) << 16; vtw[t >> 1] |= (unsigned)vv[j] << 16; } else { bt[t >> 1] = f2bf(bb); vtw[t >> 1] = (unsigned)vv[j]; }
            }
            asm volatile("" ::: "memory");
        }
        PCv[lane] = Pc;
#pragma unroll
        for (int q = 0; q < 4; ++q) {
            *(LAS u32x2*)(BbarT + lane * S2 + q * 16) = (u32x2){bt[4 * q], bt[4 * q + 1]}; *(LAS u32x2*)(BbarT + lane * S2 + q * 16 + 8) = (u32x2){bt[4 * q + 2], bt[4 * q + 3]};
            *(u32x4*)(cbo + CB_V + lane * CB_S32 + q * 16) = (u32x4){vtw[4 * q], vtw[4 * q + 1], vtw[4 * q + 2], vtw[4 * q + 3]};
        }
    }
    asm volatile("s_waitcnt lgkmcnt(0)" ::: "memory");
    f32x16 Lab, Lak, Mbr, Mkr;
#pragma unroll
    for (int i = 0; i < 16; ++i) { Lab[i] = 0.f; Lak[i] = 0.f; Mbr[i] = 0.f; Mkr[i] = 0.f; }
#pragma unroll
    for (int ks = 0; ks < 4; ++ks) {
        const int off = r * S1 + (16 * ks + 8 * hf) * 2;
        const bf16x8 fb = *(const LAS bf16x8*)(Bbar + off), fk = *(const LAS bf16x8*)(Kbar + off), fa = *(const LAS bf16x8*)(AbarT + off), fr = *(const LAS bf16x8*)(RbarT + off);
        Lab = __builtin_amdgcn_mfma_f32_32x32x16_bf16(fb, fa, Lab, 0, 0, 0);
        Lak = __builtin_amdgcn_mfma_f32_32x32x16_bf16(fk, fa, Lak, 0, 0, 0);
        Mbr = __builtin_amdgcn_mfma_f32_32x32x16_bf16(fb, fr, Mbr, 0, 0, 0);
        Mkr = __builtin_amdgcn_mfma_f32_32x32x16_bf16(fk, fr, Mkr, 0, 0, 0);
    }
#pragma unroll
    for (int i = 0; i < 16; ++i) {
        const int s = (i & 3) + 8 * (i >> 2) + 4 * hf;
        if (!(s < r)) { Lab[i] = 0.f; Lak[i] = 0.f; }
        if (!(s <= r)) { Mbr[i] = 0.f; Mkr[i] = 0.f; }
    }
    asm volatile("s_waitcnt lgkmcnt(0)" ::: "memory");
    {
        LAS float* LabT = (LAS float*)AbarT; LAS float* LakM = (LAS float*)Bbar;
#pragma unroll
        for (int g = 0; g < 4; ++g) *(LAS f32x4*)(LabT + r * SF + 8 * g + 4 * hf) = (f32x4){Lab[4 * g], Lab[4 * g + 1], Lab[4 * g + 2], Lab[4 * g + 3]};
#pragma unroll
        for (int i = 0; i < 16; ++i) LakM[((i & 3) + 8 * (i >> 2) + 4 * hf) * SF + r] = Lak[i];
    }
    asm volatile("s_waitcnt lgkmcnt(0)" ::: "memory");
    unsigned W2p[16];
    {
        const LAS float* LabT = (const LAS float*)AbarT; const LAS float* LakM = (const LAS float*)Bbar;
        float X2[32];
#pragma unroll
        for (int t = 0; t < 32; t += 4) { const f32x4 q = *(const LAS f32x4*)(LakM + r * SF + t); X2[t] = q[0]; X2[t + 1] = q[1]; X2[t + 2] = q[2]; X2[t + 3] = q[3]; }
        int zdep = 0;
#pragma unroll
        for (int t = 1; t < 32; ++t) {
            float x1 = Y[t], x2 = X2[t];
            const LAS float* row = LabT + t * SF + zdep;
#pragma unroll
            for (int s4 = 0; s4 < t; s4 += 4) {
                const f32x4 lq = *(const LAS f32x4*)(row + s4);
#pragma unroll
                for (int q = 0; q < 4; ++q) if (s4 + q < t) { x1 = fmaf(Y[s4 + q], lq[q], x1); x2 = fmaf(X2[s4 + q], lq[q], x2); }
            }
            Y[t] = x1; X2[t] = x2;
            asm volatile("v_mov_b32 %0, 0" : "=v"(zdep) : "v"(x1), "v"(x2));
        }
#pragma unroll
        for (int q = 0; q < 16; ++q) W2p[q] = pk2(X2[2 * q], X2[2 * q + 1]);
    }
    asm volatile("s_waitcnt lgkmcnt(0)" ::: "memory");
    LAS unsigned char* Atil = L;
    LAS unsigned char* Wv = L + 9216;
#pragma unroll
    for (int q = 0; q < 4; ++q) {
        *(LAS u32x2*)(Atil + lane * S2 + q * 16) = (u32x2){pk2(Y[8 * q], Y[8 * q + 1]), pk2(Y[8 * q + 2], Y[8 * q + 3])}; *(LAS u32x2*)(Atil + lane * S2 + q * 16 + 8) = (u32x2){pk2(Y[8 * q + 4], Y[8 * q + 5]), pk2(Y[8 * q + 6], Y[8 * q + 7])};
        if (lane < 32) { *(LAS u32x2*)(Wv + lane * S2 + q * 16) = (u32x2){W2p[4 * q], W2p[4 * q + 1]}; *(LAS u32x2*)(Wv + lane * S2 + q * 16 + 8) = (u32x2){W2p[4 * q + 2], W2p[4 * q + 3]}; }
    }
    asm volatile("s_waitcnt lgkmcnt(0)" ::: "memory");
    const bf16x8 mb0 = acc_frag(Mbr, 0), mb1 = acc_frag(Mbr, 1);
#pragma unroll
    for (int i = 0; i < 2; ++i) {
        f32x16 c;
#pragma unroll
        for (int g = 0; g < 4; ++g) { const u32x2 q = *(const LAS u32x2*)(RbarT + r * S1 + (32 * i + 8 * g + 4 * hf) * 2); c[4 * g] = bflo(q.x); c[4 * g + 1] = bfhi(q.x); c[4 * g + 2] = bflo(q.y); c[4 * g + 3] = bfhi(q.y); }
        c = __builtin_amdgcn_mfma_f32_32x32x16_bf16(lds_perm_frag(Atil + (32 * i + r) * S2, 0, hf), mb0, c, 0, 0, 0);
        c = __builtin_amdgcn_mfma_f32_32x32x16_bf16(lds_perm_frag(Atil + (32 * i + r) * S2, 1, hf), mb1, c, 0, 0, 0);
#pragma unroll
        for (int g = 0; g < 4; ++g) *(u32x2*)(cbo + CB_RT + r * CB_S64 + (32 * i + 8 * g + 4 * hf) * 2) = (u32x2){cvtpk(c[4 * g], c[4 * g + 1]), cvtpk(c[4 * g + 2], c[4 * g + 3])};
    }
    {
        f32x16 c = Mkr;
        c = __builtin_amdgcn_mfma_f32_32x32x16_bf16(lds_perm_frag(Wv + r * S2, 0, hf), mb0, c, 0, 0, 0);
        c = __builtin_amdgcn_mfma_f32_32x32x16_bf16(lds_perm_frag(Wv + r * S2, 1, hf), mb1, c, 0, 0, 0);
#pragma unroll
        for (int g = 0; g < 4; ++g) *(u32x2*)(cbo + CB_G + r * CB_S32 + (8 * g + 4 * hf) * 2) = (u32x2){cvtpk(c[4 * g], c[4 * g + 1]), cvtpk(c[4 * g + 2], c[4 * g + 3])};
    }
#pragma unroll
    for (int jt = 0; jt < 2; ++jt) {
        const float pc = PCv[32 * jt + r];
        const bf16x8 fb0 = lds_frag2(BbarT + (32 * jt + r) * S2 + (8 * hf) * 2), fb1 = lds_frag2(BbarT + (32 * jt + r) * S2 + (16 + 8 * hf) * 2);
#pragma unroll
        for (int i = 0; i < 2; ++i) {
            f32x16 c;
#pragma unroll
            for (int q = 0; q < 16; ++q) c[q] = 0.f;
            c = __builtin_amdgcn_mfma_f32_32x32x16_bf16(lds_frag2(Atil + (32 * i + r) * S2 + (8 * hf) * 2), fb0, c, 0, 0, 0);
            c = __builtin_amdgcn_mfma_f32_32x32x16_bf16(lds_frag2(Atil + (32 * i + r) * S2 + (16 + 8 * hf) * 2), fb1, c, 0, 0, 0);
#pragma unroll
            for (int q = 0; q < 16; ++q) { const int kq = (q & 3) + 8 * (q >> 2) + 4 * hf; c[q] = (c[q] + ((i == jt && kq == r) ? 1.f : 0.f)) * pc; }
#pragma unroll
            for (int g = 0; g < 4; ++g) *(u32x2*)(cbo + CB_PHI + (32 * jt + r) * CB_S64 + (32 * i + 8 * g + 4 * hf) * 2) = (u32x2){cvtpk(c[4 * g], c[4 * g + 1]), cvtpk(c[4 * g + 2], c[4 * g + 3])};
        }
        {
            f32x16 c;
#pragma unroll
            for (int q = 0; q < 16; ++q) c[q] = bf2f(*(const LAS bf16_t*)(Kbar + ((q & 3) + 8 * (q >> 2) + 4 * hf) * S1 + (32 * jt + r) * 2));
            c = __builtin_amdgcn_mfma_f32_32x32x16_bf16(lds_frag2(Wv + r * S2 + (8 * hf) * 2), fb0, c, 0, 0, 0);
            c = __builtin_amdgcn_mfma_f32_32x32x16_bf16(lds_frag2(Wv + r * S2 + (16 + 8 * hf) * 2), fb1, c, 0, 0, 0);
#pragma unroll
            for (int g = 0; g < 4; ++g) *(u32x2*)(cbo + CB_PSI + (32 * jt + r) * CB_S32 + (8 * g + 4 * hf) * 2) = (u32x2){cvtpk(c[4 * g] * pc, c[4 * g + 1] * pc), cvtpk(c[4 * g + 2] * pc, c[4 * g + 3] * pc)};
        }
    }
    asm volatile("s_waitcnt lgkmcnt(0)" ::: "memory");
}

constexpr int CS_SLOTS = 4, CS_NP = CB_BYTES / 1024;
__device__ __forceinline__ void st_cscan(const P& p, int bh, LAS unsigned char* lds) {
    const int tid = opaque(threadIdx.x), wave = __builtin_amdgcn_readfirstlane(tid >> 6), lane = tid & 63;
    const int b = bh / 6, hh = bh % 6, r = lane & 31, hf = lane >> 5;
    const unsigned char* cb0 = p.cb + (size_t)bh * 64 * CB_BYTES;
    constexpr int NCH = SEQ / 32;
    const int lw = wave - 2;
#define CS_ISSUE(chunk) do { const int _c = (chunk) < NCH ? (chunk) : NCH - 1; const unsigned char* _g = cb0 + (size_t)_c * CB_BYTES + lane * 16; LAS unsigned char* _l = lds + ((chunk) & 3) * CB_BYTES; \
        _Pragma("unroll") for (int _j = 0; _j < 5; ++_j) if (lw + 6 * _j < CS_NP) __builtin_amdgcn_global_load_lds((const unsigned*)(_g + (lw + 6 * _j) * 1024), (LAS unsigned*)(_l + (lw + 6 * _j) * 1024), 16, 0, 0); } while (0)
    f32x16 X0, X1;
#pragma unroll
    for (int i = 0; i < 16; ++i) { X0[i] = 0.f; X1[i] = 0.f; }
    if (wave >= 2) { CS_ISSUE(0); CS_ISSUE(1); CS_ISSUE(2); }
    bf16_t* yb = p.y + (size_t)b * SEQ * RWW + hh * 64 + 32 * wave + r;
    for (int c = 0; c < NCH; ++c) {
        if (wave >= 2) { if (lw < 2) asm volatile("s_waitcnt vmcnt(10)" ::: "memory"); else asm volatile("s_waitcnt vmcnt(8)" ::: "memory"); }
        __builtin_amdgcn_s_barrier();
        if (wave >= 2) { CS_ISSUE(c + 3); }
        else {
            const LAS unsigned char* S = lds + (c & 3) * CB_BYTES;
            const int vr = 32 * wave + r;
            const bf16x8 vf0 = *(const LAS bf16x8*)(S + CB_V + vr * CB_S32 + (8 * hf) * 2), vf1 = *(const LAS bf16x8*)(S + CB_V + vr * CB_S32 + (16 + 8 * hf) * 2);
            const LAS unsigned char* rp = S + CB_RT + r * CB_S64;
            const bf16x8 fr0 = lds_perm_frag(rp, 0, hf), fr1 = lds_perm_frag(rp, 1, hf), fr2 = lds_perm_frag(rp + 64, 0, hf), fr3 = lds_perm_frag(rp + 64, 1, hf);
            const bf16x8 fg0 = *(const LAS bf16x8*)(S + CB_G + r * CB_S32 + (8 * hf) * 2), fg1 = *(const LAS bf16x8*)(S + CB_G + r * CB_S32 + (16 + 8 * hf) * 2);
            const LAS unsigned char* p0 = S + CB_PHI + r * CB_S64; const LAS unsigned char* p1 = S + CB_PHI + (32 + r) * CB_S64;
            const bf16x8 fa0 = lds_perm_frag(p0, 0, hf), fa1 = lds_perm_frag(p0, 1, hf), fa2 = lds_perm_frag(p0 + 64, 0, hf), fa3 = lds_perm_frag(p0 + 64, 1, hf);
            const bf16x8 fb0 = lds_perm_frag(p1, 0, hf), fb1 = lds_perm_frag(p1, 1, hf), fb2 = lds_perm_frag(p1 + 64, 0, hf), fb3 = lds_perm_frag(p1 + 64, 1, hf);
            const LAS unsigned char* q0 = S + CB_PSI + r * CB_S32; const LAS unsigned char* q1 = S + CB_PSI + (32 + r) * CB_S32;
            const bf16x8 fp0 = *(const LAS bf16x8*)(q0 + (8 * hf) * 2), fp1 = *(const LAS bf16x8*)(q0 + (16 + 8 * hf) * 2), fp2 = *(const LAS bf16x8*)(q1 + (8 * hf) * 2), fp3 = *(const LAS bf16x8*)(q1 + (16 + 8 * hf) * 2);
            const bf16x8 x00 = acc_frag(X0, 0), x01 = acc_frag(X0, 1), x10 = acc_frag(X1, 0), x11 = acc_frag(X1, 1);
            asm volatile("s_waitcnt lgkmcnt(0)" ::: "memory");
            __builtin_amdgcn_sched_barrier(0);
            f32x16 yc, n0, n1;
#pragma unroll
            for (int i = 0; i < 16; ++i) { yc[i] = 0.f; n0[i] = 0.f; n1[i] = 0.f; }
            n0 = __builtin_amdgcn_mfma_f32_32x32x16_bf16(fa0, x00, n0, 0, 0, 0);
            n1 = __builtin_amdgcn_mfma_f32_32x32x16_bf16(fb0, x00, n1, 0, 0, 0);
            yc = __builtin_amdgcn_mfma_f32_32x32x16_bf16(fr0, x00, yc, 0, 0, 0);
            n0 = __builtin_amdgcn_mfma_f32_32x32x16_bf16(fa1, x01, n0, 0, 0, 0);
            n1 = __builtin_amdgcn_mfma_f32_32x32x16_bf16(fb1, x01, n1, 0, 0, 0);
            yc = __builtin_amdgcn_mfma_f32_32x32x16_bf16(fr1, x01, yc, 0, 0, 0);
            n0 = __builtin_amdgcn_mfma_f32_32x32x16_bf16(fa2, x10, n0, 0, 0, 0);
            n1 = __builtin_amdgcn_mfma_f32_32x32x16_bf16(fb2, x10, n1, 0, 0, 0);
            yc = __builtin_amdgcn_mfma_f32_32x32x16_bf16(fr2, x10, yc, 0, 0, 0);
            n0 = __builtin_amdgcn_mfma_f32_32x32x16_bf16(fa3, x11, n0, 0, 0, 0);
            n1 = __builtin_amdgcn_mfma_f32_32x32x16_bf16(fb3, x11, n1, 0, 0, 0);
            yc = __builtin_amdgcn_mfma_f32_32x32x16_bf16(fr3, x11, yc, 0, 0, 0);
            n0 = __builtin_amdgcn_mfma_f32_32x32x16_bf16(fp0, vf0, n0, 0, 0, 0);
            n1 = __builtin_amdgcn_mfma_f32_32x32x16_bf16(fp2, vf0, n1, 0, 0, 0);
            yc = __builtin_amdgcn_mfma_f32_32x32x16_bf16(fg0, vf0, yc, 0, 0, 0);
            n0 = __builtin_amdgcn_mfma_f32_32x32x16_bf16(fp1, vf1, n0, 0, 0, 0);
            n1 = __builtin_amdgcn_mfma_f32_32x32x16_bf16(fp3, vf1, n1, 0, 0, 0);
            yc = __builtin_amdgcn_mfma_f32_32x32x16_bf16(fg1, vf1, yc, 0, 0, 0);
            X0 = n0; X1 = n1;
#pragma unroll
            for (int i = 0; i < 16; ++i) yb[(size_t)(c * 32 + (i & 3) + 8 * (i >> 2) + 4 * hf) * RWW] = (bf16_t)f2bf(yc[i]);
        }
    }
    asm volatile("s_waitcnt vmcnt(0)" ::: "memory");
    __builtin_amdgcn_s_barrier();
#undef CS_ISSUE
}

template <int NT>
__device__ __forceinline__ void st_rwout(const P& p, int l, const int (&tok)[NT], int lane) {
    float y[NT][6], vv[NT][6], gg[NT][6], rk[NT][6];
    float lgv[6], lbv[6];
#pragma unroll
    for (int hh = 0; hh < 6; ++hh) { lgv[hh] = p.rw_ln_g[l * RWW + hh * 64 + lane]; lbv[hh] = p.rw_ln_b[l * RWW + hh * 64 + lane]; }
    {
        bf16_t yr[NT][6], vr[NT][6], gr[NT][6];
#pragma unroll
        for (int n = 0; n < NT; ++n)
#pragma unroll
            for (int hh = 0; hh < 6; ++hh) {
                const int t = tok[n];
                yr[n][hh] = p.y[(size_t)t * RWW + hh * 64 + lane]; vr[n][hh] = *(const bf16_t*)(p.rec + (size_t)t * REC_TB + hh * REC_HB + 768 + lane * 2); gr[n][hh] = p.g[(size_t)t * RWW + hh * 64 + lane];
                rk[n][hh] = *(const float*)(p.rec + (size_t)t * REC_TB + hh * REC_HB + 896);
            }
        asm volatile("s_waitcnt vmcnt(0)" ::: "memory");
#pragma unroll
        for (int n = 0; n < NT; ++n)
#pragma unroll
            for (int hh = 0; hh < 6; ++hh) { y[n][hh] = bf2f(yr[n][hh]); vv[n][hh] = bf2f(vr[n][hh]); gg[n][hh] = bf2f(gr[n][hh]); }
    }
#pragma unroll
    for (int hh = 0; hh < 6; ++hh) {
        const int c = hh * 64 + lane;
        const float lg = lgv[hh], lb = lbv[hh];
#pragma unroll
        for (int n = 0; n < NT; ++n) {
            const float mean = wave_sum(y[n][hh]) * (1.f / 64.f);
            const float d = y[n][hh] - mean;
            const float var = wave_sum(d * d) * (1.f / 64.f);
            const float yn = d * rsqrtf(var + 64e-5f) * lg + lb;
            p.h[(size_t)tok[n] * D + c] = (bf16_t)f2bf((yn + rk[n][hh] * vv[n][hh]) * gg[n][hh]);
        }
    }
}

typedef float f32x16 __attribute__((ext_vector_type(16)));
constexpr float ATT_EXIT = -30.f;
__device__ __forceinline__ float xhalf(float x, int lane) { return __builtin_bit_cast(float, __builtin_amdgcn_ds_bpermute((lane ^ 32) << 2, __builtin_bit_cast(int, x))); }
__device__ __forceinline__ void st_attn(const P& p, int l, int item, LAS unsigned char* WL  ) {
    const int lane = opaque(threadIdx.x) & 63;
    const int qt = item % (SEQ / 32), bh = item / (SEQ / 32), b = bh / 6, hh = bh % 6;
    const int r = lane & 31, hf = lane >> 5;
    const bf16_t* qkb = p.proj + (size_t)b * SEQ * PJB + RWC + hh * 64 + 8 * hf;
    const bf16_t* vtb = p.vt + ((size_t)(b * 6 + hh) * 64 + r) * SEQ + 4 * hf;
    bf16x8 qf[4];
    {
        const bf16_t* qp = qkb + (size_t)(qt * 32 + r) * PJB;
#pragma unroll
        for (int s = 0; s < 4; ++s) {
            u32x4 t4 = *(const u32x4*)(qp + 16 * s);
            unsigned w[4] = {t4.x, t4.y, t4.z, t4.w};
#pragma unroll
            for (int q = 0; q < 4; ++q) { const float lo = bflo(w[q]) * 0.125f, hi = bfhi(w[q]) * 0.125f; w[q] = (__builtin_bit_cast(unsigned, lo) >> 16) | (__builtin_bit_cast(unsigned, hi) & 0xffff0000u); }
            t4.x = w[0]; t4.y = w[1]; t4.z = w[2]; t4.w = w[3];
            qf[s] = __builtin_bit_cast(bf16x8, t4);
        }
    }
    f32x16 o0, o1;
#pragma unroll
    for (int i = 0; i < 16; ++i) { o0[i] = 0.f; o1[i] = 0.f; }
    float R = 0.f;
    LAS unsigned char* KL = WL; LAS unsigned char* VL = WL + 4608;
    const unsigned char* kg0 = (const unsigned char*)(p.proj + (size_t)b * SEQ * PJB + RWC + SBW + hh * 64) + (size_t)(lane >> 3) * PJB * 2 + (lane & 7) * 16;
    const unsigned char* vg0 = (const unsigned char*)(p.vt + ((size_t)(b * 6 + hh) * 64 + (lane >> 2)) * SEQ) + (lane & 3) * 16;
    u32x4 kraw[4], vraw[4];
#define ATT_GLOAD(KT) do { const int _k0 = (KT) * 32; \
        _Pragma("unroll") for (int i = 0; i < 4; ++i) kraw[i] = *(const u32x4*)(kg0 + (size_t)(_k0 + 8 * i) * PJB * 2); \
        _Pragma("unroll") for (int i = 0; i < 4; ++i) vraw[i] = *(const u32x4*)(vg0 + (size_t)(16 * i) * SEQ * 2 + _k0 * 2); } while (0)
#define ATT_LWRITE() do { \
        _Pragma("unroll") for (int i = 0; i < 4; ++i) *(LAS u32x4*)(KL + (8 * i + (lane >> 3)) * 144 + (lane & 7) * 16) = kraw[i]; \
        _Pragma("unroll") for (int i = 0; i < 4; ++i) *(LAS u32x4*)(VL + (16 * i + (lane >> 2)) * 80 + (lane & 3) * 16) = vraw[i]; } while (0)
    ATT_GLOAD(qt);
    ATT_LWRITE();
    for (int kt = qt; kt >= 0; --kt) {
        const int key0 = kt * 32; (void)key0;
        if (kt > 0) ATT_GLOAD(kt - 1);
        bf16x8 kf[4]; u32x2 vf[2][2][2];
#pragma unroll
        for (int s = 0; s < 4; ++s) kf[s] = *(const LAS bf16x8*)(KL + r * 144 + (16 * s + 8 * hf) * 2);
#pragma unroll
        for (int dt = 0; dt < 2; ++dt)
#pragma unroll
            for (int s = 0; s < 2; ++s) { const LAS unsigned char* vp = VL + (32 * dt + r) * 80 + (16 * s + 4 * hf) * 2; vf[dt][s][0] = *(const LAS u32x2*)vp; vf[dt][s][1] = *(const LAS u32x2*)(vp + 16); }
        f32x16 z;
#pragma unroll
        for (int i = 0; i < 16; ++i) z[i] = 0.f;
#pragma unroll
        for (int s = 0; s < 4; ++s) z = __builtin_amdgcn_mfma_f32_32x32x16_bf16(kf[s], qf[s], z, 0, 0, 0);
        const bool diag = (kt == qt);
        float c[16], gs[4];
#pragma unroll
        for (int gi = 0; gi < 4; ++gi) {
            float run = 0.f;
#pragma unroll
            for (int e = 3; e >= 0; --e) {
                const int reg = gi * 4 + e;
                const float zz = z[reg] * LOG2E; z[reg] = zz;
                float L = -(__builtin_amdgcn_fmed3f(zz, 0.f, INFINITY) + log2f_(1.f + exp2f_(-fabsf(zz))));
                if (diag && !(r > e + 8 * gi + 4 * hf)) L = 0.f;
                run += L; c[reg] = run;
            }
            gs[gi] = run;
        }
        float go[4], pp[4], ob[4], off[4];
#pragma unroll
        for (int gi = 0; gi < 4; ++gi) { go[gi] = xhalf(gs[gi], lane); pp[gi] = gs[gi] + go[gi]; }
        ob[3] = 0.f; ob[2] = pp[3]; ob[1] = pp[3] + pp[2]; ob[0] = ob[1] + pp[1];
#pragma unroll
        for (int gi = 0; gi < 4; ++gi) off[gi] = ob[gi] + (hf == 0 ? go[gi] : 0.f) + R;
        const float total = ob[0] + pp[0];
        unsigned af[8];
#pragma unroll
        for (int i = 0; i < 8; ++i) {
            float a2[2];
#pragma unroll
            for (int q = 0; q < 2; ++q) {
                const int reg = 2 * i + q, gi = reg >> 2, e = reg & 3;
                float a = exp2f_(z[reg] + c[reg] + off[gi]);
                if (diag && !(r > e + 8 * gi + 4 * hf)) a = 0.f;
                a2[q] = a;
            }
            af[i] = pk2(a2[0], a2[1]);
        }
        R += total;
        const bf16x8 a0 = __builtin_bit_cast(bf16x8, (u32x4){af[0], af[1], af[2], af[3]});
        const bf16x8 a1 = __builtin_bit_cast(bf16x8, (u32x4){af[4], af[5], af[6], af[7]});
        o0 = __builtin_amdgcn_mfma_f32_32x32x16_bf16(__builtin_bit_cast(bf16x8, (u32x4){vf[0][0][0].x, vf[0][0][0].y, vf[0][0][1].x, vf[0][0][1].y}), a0, o0, 0, 0, 0);
        o0 = __builtin_amdgcn_mfma_f32_32x32x16_bf16(__builtin_bit_cast(bf16x8, (u32x4){vf[0][1][0].x, vf[0][1][0].y, vf[0][1][1].x, vf[0][1][1].y}), a1, o0, 0, 0, 0);
        o1 = __builtin_amdgcn_mfma_f32_32x32x16_bf16(__builtin_bit_cast(bf16x8, (u32x4){vf[1][0][0].x, vf[1][0][0].y, vf[1][0][1].x, vf[1][0][1].y}), a0, o1, 0, 0, 0);
        o1 = __builtin_amdgcn_mfma_f32_32x32x16_bf16(__builtin_bit_cast(bf16x8, (u32x4){vf[1][1][0].x, vf[1][1][0].y, vf[1][1][1].x, vf[1][1][1].y}), a1, o1, 0, 0, 0);
        if (__all(R < ATT_EXIT * LOG2E)) break;
        if (kt > 0) ATT_LWRITE();
    }
#undef ATT_GLOAD
#undef ATT_LWRITE
    float ss = 0.f;
#pragma unroll
    for (int i = 0; i < 16; ++i) ss += o0[i] * o0[i] + o1[i] * o1[i];
    ss += xhalf(ss, lane);
    const float rs = rsqrtf(ss * (1.f / 64.f) + 1e-6f);
    bf16_t* op = p.h + ((size_t)b * SEQ + qt * 32 + r) * D + RWW + hh * 64 + 4 * hf;
    const float* gn = p.sb_norm_g + l * SBW + hh * 64 + 4 * hf;
    f32x4 gnv[4][2];
#pragma unroll
    for (int gi = 0; gi < 4; ++gi) { gnv[gi][0] = *(const f32x4*)(gn + 8 * gi); gnv[gi][1] = *(const f32x4*)(gn + 32 + 8 * gi); }
#pragma unroll
    for (int gi = 0; gi < 4; ++gi) {
        const f32x4 g0 = gnv[gi][0], g1 = gnv[gi][1];
        u32x2 w0, w1;
        w0.x = pk2(o0[4 * gi] * rs * g0[0], o0[4 * gi + 1] * rs * g0[1]); w0.y = pk2(o0[4 * gi + 2] * rs * g0[2], o0[4 * gi + 3] * rs * g0[3]);
        w1.x = pk2(o1[4 * gi] * rs * g1[0], o1[4 * gi + 1] * rs * g1[1]); w1.y = pk2(o1[4 * gi + 2] * rs * g1[2], o1[4 * gi + 3] * rs * g1[3]);
        *(u32x2*)(op + 8 * gi) = w0; *(u32x2*)(op + 32 + 8 * gi) = w1;
    }
}

constexpr int POOL_PS = 528;
__device__ __forceinline__ void st_pool(const P& p, int l, int vb, LAS unsigned char* PLB  ) {
    const int tid = opaque(threadIdx.x);
    const int wave = tid >> 6, lane = tid & 63, gB = wave & 3, nh = wave >> 2, r = lane & 31, hf = lane >> 5;
    float wraw[4][8];
    {
        const float* pw = p.pool_w + ((size_t)l * 4 + gB) * 64 * 64 + nh * 32 + r;
#pragma unroll
        for (int ks = 0; ks < 4; ++ks)
#pragma unroll
            for (int j = 0; j < 8; ++j) wraw[ks][j] = pw[(16 * ks + 8 * hf + j) * 64];
    }
    const float sc = p.pool_scale[l * PLW + gB * 64 + nh * 32 + r];
    const int col = tid & 255, th = tid >> 8, g = col >> 6, win = 2 << g;
    bf16_t xr[2][31];
#pragma unroll
    for (int un = 0; un < 2; ++un) {
        const int t0 = (vb + un) * 32, sA = t0 % SEQ + th * 16;
        const bf16_t* u = p.proj + (size_t)(t0 + th * 16) * PJB + RWC + SBC + col;
#pragma unroll
        for (int i = 0; i < 31; ++i) { const int s = sA - 15 + i; xr[un][i] = (s >= 0 && (i >= 15 || 15 - i < win)) ? u[(ptrdiff_t)(i - 15) * PJB] : (bf16_t)0; }
    }
    asm volatile("s_waitcnt vmcnt(0)" ::: "memory");
#pragma unroll
    for (int un = 0; un < 2; ++un) {
        const int sA = ((vb + un) * 32) % SEQ + th * 16;
        float xv[31];
#pragma unroll
        for (int i = 0; i < 31; ++i) xv[i] = bf2f(xr[un][i]);
        float run = 0.f;
#pragma unroll
        for (int i = 0; i < 15; ++i) run += (15 - i < win) ? xv[i] : 0.f;
#pragma unroll
        for (int j = 0; j < 16; ++j) {
            run += xv[15 + j];
            const int s = sA + j, n = min(s + 1, win);
            *(LAS bf16_t*)(PLB + un * 32 * POOL_PS + (th * 16 + j) * POOL_PS + col * 2) = (bf16_t)f2bf(run * rcpf_((float)n) - xv[15 + j]);
            float drop = 0.f;
#pragma unroll
            for (int q = 1; q <= 4; ++q) if (win == (1 << q)) drop = xv[15 + j - (1 << q) + 1];
            run -= drop;
        }
    }
    __syncthreads();
    {
        bf16x8 bw[4];
#pragma unroll
        for (int ks = 0; ks < 4; ++ks) bw[ks] = mk8(pk2(wraw[ks][0], wraw[ks][1]), pk2(wraw[ks][2], wraw[ks][3]), pk2(wraw[ks][4], wraw[ks][5]), pk2(wraw[ks][6], wraw[ks][7]));
#pragma unroll
        for (int un = 0; un < 2; ++un) {
            f32x16 acc;
#pragma unroll
            for (int i = 0; i < 16; ++i) acc[i] = 0.f;
#pragma unroll
            for (int ks = 0; ks < 4; ++ks) acc = __builtin_amdgcn_mfma_f32_32x32x16_bf16(*(const LAS bf16x8*)(PLB + un * 32 * POOL_PS + r * POOL_PS + (gB * 64 + 16 * ks + 8 * hf) * 2), bw[ks], acc, 0, 0, 0);
            bf16_t* op = p.h + (size_t)(vb + un) * 32 * D + 768 + gB * 64 + nh * 32 + r;
#pragma unroll
            for (int i = 0; i < 16; ++i) op[(size_t)((i & 3) + 8 * (i >> 2) + 4 * hf) * D] = (bf16_t)f2bf(acc[i] * sc);
        }
    }
    __syncthreads();
}

template <bool TOLDS>
__device__ __forceinline__ void norm_row(const float* xr, const float* md  , bf16_t* hrow, LAS float* hl, int lane) {
    f32x4 v[4], sh[4], sc[4]; float ss = 0.f;
#pragma unroll
    for (int i = 0; i < 4; ++i) v[i] = *(const f32x4*)(xr + i * 256 + lane * 4);
#pragma unroll
    for (int i = 0; i < 4; ++i) { sh[i] = *(const f32x4*)(md + i * 256 + lane * 4); sc[i] = *(const f32x4*)(md + 1024 + i * 256 + lane * 4); }
#pragma unroll
    for (int i = 0; i < 4; ++i) ss += v[i][0] * v[i][0] + v[i][1] * v[i][1] + v[i][2] * v[i][2] + v[i][3] * v[i][3];
    ss = wave_sum(ss);
    const float rs = rsqrtf(ss * (1.f / D) + 1e-6f);
#pragma unroll
    for (int i = 0; i < 4; ++i) {
        const int cidx = i * 256 + lane * 4;
        const f32x4 o = v[i] * rs * (sc[i] + 1.f) + sh[i];
        u32x2 w; w.x = pk2(o[0], o[1]); w.y = pk2(o[2], o[3]);
        *(u32x2*)(hrow + cidx) = w;
        if constexpr (TOLDS) *(LAS f32x4*)(hl + cidx) = o;
    }
}

__device__ __forceinline__ void norm_row_mdl(const float* xr, const LAS float* mdl  , bf16_t* hrow, LAS float* hl, int lane) {
    f32x4 v[4]; float ss = 0.f;
#pragma unroll
    for (int i = 0; i < 4; ++i) v[i] = *(const f32x4*)(xr + i * 256 + lane * 4);
    asm volatile("s_waitcnt vmcnt(0)" ::: "memory");
#pragma unroll
    for (int i = 0; i < 4; ++i) ss += v[i][0] * v[i][0] + v[i][1] * v[i][1] + v[i][2] * v[i][2] + v[i][3] * v[i][3];
    ss = wave_sum(ss);
    const float rs = rsqrtf(ss * (1.f / D) + 1e-6f);
#pragma unroll
    for (int i = 0; i < 4; ++i) {
        const int cidx = i * 256 + lane * 4;
        __builtin_amdgcn_sched_barrier(0);
        const f32x4 sh = *(const LAS f32x4*)(mdl + cidx), sc = *(const LAS f32x4*)(mdl + 1024 + cidx);
        const f32x4 o = v[i] * rs * (sc + 1.f) + sh;
        u32x2 w; w.x = pk2(o[0], o[1]); w.y = pk2(o[2], o[3]);
        *(u32x2*)(hrow + cidx) = w;
        *(LAS f32x4*)(hl + cidx) = o;
    }
}

__device__ __forceinline__ void norm_vals_mdl(const f32x4 (&v)[4], const LAS float* mdl, bf16_t* hrow, LAS float* hl, int lane) {
    float ss = 0.f;
#pragma unroll
    for (int i = 0; i < 4; ++i) ss += v[i][0] * v[i][0] + v[i][1] * v[i][1] + v[i][2] * v[i][2] + v[i][3] * v[i][3];
    ss = wave_sum(ss);
    const float rs = rsqrtf(ss * (1.f / D) + 1e-6f);
#pragma unroll
    for (int i = 0; i < 4; ++i) {
        const int cidx = i * 256 + lane * 4;
        __builtin_amdgcn_sched_barrier(0);
        const f32x4 sh = *(const LAS f32x4*)(mdl + cidx), sc = *(const LAS f32x4*)(mdl + 1024 + cidx);
        const f32x4 o = v[i] * rs * (sc + 1.f) + sh;
        u32x2 w; w.x = pk2(o[0], o[1]); w.y = pk2(o[2], o[3]);
        *(u32x2*)(hrow + cidx) = w;
        *(LAS f32x4*)(hl + cidx) = o;
    }
}

__device__ __forceinline__ void split_bf16(const float (&x)[8], bf16x8& hi, bf16x8& lo) {
    unsigned h[4], l[4];
#pragma unroll
    for (int q = 0; q < 4; ++q) {
        const unsigned ph = cvtpk(x[2 * q], x[2 * q + 1]);
        const float r0 = x[2 * q] - bflo(ph), r1 = x[2 * q + 1] - bfhi(ph);
        h[q] = ph; l[q] = cvtpk(r0, r1);
    }
    hi = mk8(h[0], h[1], h[2], h[3]); lo = mk8(l[0], l[1], l[2], l[3]);
}
__device__ __forceinline__ void st_normrouter(const P& p, int l, int vb0, int vbstride, int cv_first, int cvon, LAS float* L  ) {
    const int tid = opaque(threadIdx.x), wave = tid >> 6, lane = tid & 63;
    const int fr = lane & 15, fq = lane >> 4;
    constexpr int HS = 1028;
    LAS float* H = L; LAS float* PART = L + 16 * HS; LAS float* SEL = PART + 8 * 16 * 64; LAS int* lcnt = (LAS int*)(SEL + 16 * 72); LAS float* MDL = (LAS float*)(lcnt + 64);
    bf16x8 Bh[4][4], Bl[4][4];
    {
        const float* wr = p.w_router + ((size_t)l * D + wave * 128) * NE;
        const int ll = opaque(lane), fr2 = ll & 15, fq2 = ll >> 4;
#pragma unroll
        for (int ks = 0; ks < 4; ++ks)
#pragma unroll
            for (int nt = 0; nt < 4; ++nt) {
                float x[8];
#pragma unroll
                for (int j = 0; j < 8; ++j) x[j] = wr[(32 * ks + 8 * fq2 + j) * NE + 16 * nt + fr2];
                split_bf16(x, Bh[ks][nt], Bl[ks][nt]);
            }
    }
    const float brt = p.b_router[l * NE + lane];
    for (int vb = vb0; vb < T / 16; vb += vbstride) {
        const int t0 = vb * 16, b = t0 / SEQ;
        const float* md = p.mod + ((size_t)l * 8 + b) * 6144 + 3072;
        if (tid < 64) lcnt[tid] = 0;
        f32x4 xrow[4];
#pragma unroll
        for (int i = 0; i < 4; ++i) xrow[i] = *(const f32x4*)(p.xb + (size_t)(t0 + wave * 2) * D + i * 256 + lane * 4);
        *(LAS f32x4*)(MDL + tid * 4) = *(const f32x4*)(md + tid * 4);
        __syncthreads();
        norm_vals_mdl(xrow, MDL, p.h + (size_t)(t0 + wave * 2) * D, H + wave * 2 * HS, lane);
        norm_row_mdl(p.xb + (size_t)(t0 + wave * 2 + 1) * D, MDL, p.h + (size_t)(t0 + wave * 2 + 1) * D, H + (wave * 2 + 1) * HS, lane);
        const int cit = cv_first + vb * 8 + __builtin_amdgcn_readfirstlane(wave);
        const bool hcv = cit < min(CV_EXP, cv_first + CV_ROUTER) && cvon;
        CvtJob cj = cvt_exp_job(p, l, hcv ? cit : 0);
        float cw[32];
        if (hcv) cvh_load(cj, 0, cw, lane);
        __syncthreads();
#pragma unroll
        for (int nh = 0; nh < 2; ++nh) {
            f32x4 acc[2];
#pragma unroll
            for (int n2 = 0; n2 < 2; ++n2) acc[n2] = (f32x4){0.f, 0.f, 0.f, 0.f};
#pragma unroll
            for (int ks = 0; ks < 4; ++ks) {
                const LAS float* hp = H + fr * HS + wave * 128 + 32 * ks + 8 * fq;
                const f32x4 h0 = *(const LAS f32x4*)hp, h1 = *(const LAS f32x4*)(hp + 4);
                const float x[8] = {h0[0], h0[1], h0[2], h0[3], h1[0], h1[1], h1[2], h1[3]};
                bf16x8 ah, al; split_bf16(x, ah, al);
#pragma unroll
                for (int n2 = 0; n2 < 2; ++n2) {
                    const int nt = 2 * nh + n2;
                    acc[n2] = __builtin_amdgcn_mfma_f32_16x16x32_bf16(ah, Bh[ks][nt], acc[n2], 0, 0, 0);
                    acc[n2] = __builtin_amdgcn_mfma_f32_16x16x32_bf16(ah, Bl[ks][nt], acc[n2], 0, 0, 0);
                    acc[n2] = __builtin_amdgcn_mfma_f32_16x16x32_bf16(al, Bh[ks][nt], acc[n2], 0, 0, 0);
                }
            }
#pragma unroll
            for (int n2 = 0; n2 < 2; ++n2)
#pragma unroll
                for (int rg = 0; rg < 4; ++rg) PART[(wave * 16 + 4 * fq + rg) * 64 + 16 * (2 * nh + n2) + fr] = acc[n2][rg];
        }
        if (hcv) { cvh_store(cj, 0, cw, lane); cvh_load(cj, 1, cw, lane); }
        __syncthreads();
#pragma unroll
        for (int q = 0; q < 2; ++q) {
            const int tt = wave * 2 + q, t = t0 + tt;
            float logit = 0.f;
#pragma unroll
            for (int w = 0; w < 8; ++w) logit += PART[(w * 16 + tt) * 64 + lane];
            float score = sigmoidf_(logit);
            score = (score == score) ? score : 0.f;
            const float sl = score + brt;
            float m1 = sl, m2 = -INFINITY;
            {
                float o1, o2, n1;
                o1 = __builtin_bit_cast(float, lx1(__builtin_bit_cast(unsigned, m1))); o2 = __builtin_bit_cast(float, lx1(__builtin_bit_cast(unsigned, m2)));
                n1 = fmaxf(m1, o1); m2 = fmaxf(fminf(m1, o1), fmaxf(m2, o2)); m1 = n1;
                o1 = __builtin_bit_cast(float, lx2(__builtin_bit_cast(unsigned, m1))); o2 = __builtin_bit_cast(float, lx2(__builtin_bit_cast(unsigned, m2)));
                n1 = fmaxf(m1, o1); m2 = fmaxf(fminf(m1, o1), fmaxf(m2, o2)); m1 = n1;
                o1 = __builtin_bit_cast(float, lx4(__builtin_bit_cast(unsigned, m1))); o2 = __builtin_bit_cast(float, lx4(__builtin_bit_cast(unsigned, m2)));
                n1 = fmaxf(m1, o1); m2 = fmaxf(fminf(m1, o1), fmaxf(m2, o2)); m1 = n1;
            }
            const float gsc = m1 + m2;
            const int gI = lane >> 3;
            int grank = 0;
#pragma unroll
            for (int i = 0; i < 8; ++i) { const float v = __builtin_bit_cast(float, __builtin_amdgcn_readlane(__builtin_bit_cast(int, gsc), 8 * i)); grank += (v > gsc || (v == gsc && i < gI)) ? 1 : 0; }
            const float msk = (grank < 4) ? sl : -INFINITY;
            int rank = 0;
#pragma unroll
            for (int i = 0; i < 64; ++i) { const float v = __builtin_bit_cast(float, __builtin_amdgcn_readlane(__builtin_bit_cast(int, msk), i)); rank += (v > msk || (v == msk && i < lane)) ? 1 : 0; }
            const bool chosen = rank < TOPK;
            const float wsum = wave_sum(chosen ? score : 0.f);
            if (chosen) {
                const int pos = __hip_atomic_fetch_add(&lcnt[lane], 1, __ATOMIC_RELAXED, __HIP_MEMORY_SCOPE_WORKGROUP);
                p.seg[((size_t)lane * 1024 + vb) * 16 + pos] = t * TOPK + rank;
                p.topw[(size_t)t * TOPK + rank] = score / (wsum + 1e-20f) * 2.5f;
            }
        }
        if (hcv) cvh_store(cj, 1, cw, lane);
        __syncthreads();
        if (tid < 64) p.cnt2[tid * 1024 + vb] = lcnt[tid];
        __syncthreads();
    }
}

__device__ __forceinline__ void st_compact(const P& p, int e, LAS int* wt  ) {
    const int tid = opaque(threadIdx.x), wave = tid >> 6, lane = tid & 63;
    const int c0 = p.cnt2[e * 1024 + 2 * tid], c1 = p.cnt2[e * 1024 + 2 * tid + 1], s = c0 + c1;
    int incl = s;
#pragma unroll
    for (int o = 1; o < 64; o <<= 1) { const int v = __builtin_amdgcn_ds_bpermute(((lane - o) & 63) << 2, incl); if (lane >= o) incl += v; }
    if (lane == 63) wt[wave] = incl;
    __syncthreads();
    int base = 0;
    for (int w = 0; w < wave; ++w) base += wt[w];
    const int excl = base + incl - s;
    int2* dst = p.list + (size_t)e * T + excl;
    const int* s0 = p.seg + ((size_t)e * 1024 + 2 * tid) * 16;
    for (int j = 0; j < c0; ++j) { const int aid = s0[j]; dst[j] = make_int2(aid, __float_as_int(p.topw[aid])); }
    for (int j = 0; j < c1; ++j) { const int aid = s0[16 + j]; dst[c0 + j] = make_int2(aid, __float_as_int(p.topw[aid])); }
    if (tid == NTHREADS - 1) p.cnt[e] = base + incl;
    __syncthreads();
}

template <int NT>
__device__ __forceinline__ void st_combine(const P& p, int l, const int (&tok)[NT], int lane) {
    unsigned qa[NT][2][TOPK + 1], qb[NT][2][TOPK + 1]; f32x4 x0[NT][2], x1[NT][2];
#pragma unroll
    for (int n = 0; n < NT; ++n) {
        const int t = tok[n];
        const unsigned char* sl = p.slab + (size_t)t * TOPK * D;
#pragma unroll
        for (int i = 0; i < 2; ++i) {
            const int cA = i * 512 + lane * 4, cB = cA + 256;
#pragma unroll
            for (int s = 0; s < TOPK + 1; ++s) {
                const unsigned char* rp = s < TOPK ? sl + (size_t)s * D : p.slab + ((size_t)T * TOPK + t) * D;
                qa[n][i][s] = *(const unsigned*)(rp + cA); qb[n][i][s] = *(const unsigned*)(rp + cB);
            }
            x0[n][i] = *(const f32x4*)(p.xb + (size_t)t * D + cA); x1[n][i] = *(const f32x4*)(p.xb + (size_t)t * D + cB);
        }
    }
    const int b0 = tok[0] / SEQ;
    f32x4 gtv[2][2], mdv[2][4];
#pragma unroll
    for (int i = 0; i < 2; ++i) {
        const int cA = i * 512 + lane * 4, cB = cA + 256;
        const float* gt0 = p.mod + ((size_t)l * 8 + b0) * 6144 + 5120;
        gtv[i][0] = *(const f32x4*)(gt0 + cA); gtv[i][1] = *(const f32x4*)(gt0 + cB);
        if (l + 1 < NL) {
            const float* md0 = p.mod + ((size_t)(l + 1) * 8 + b0) * 6144;
            mdv[i][0] = *(const f32x4*)(md0 + cA); mdv[i][1] = *(const f32x4*)(md0 + cB); mdv[i][2] = *(const f32x4*)(md0 + 1024 + cA); mdv[i][3] = *(const f32x4*)(md0 + 1024 + cB);
        } else {
            mdv[i][0] = *(const f32x4*)(p.g_final + cA); mdv[i][1] = *(const f32x4*)(p.g_final + cB); mdv[i][2] = mdv[i][0]; mdv[i][3] = mdv[i][1];
        }
    }
#pragma unroll
    for (int n = 0; n < NT; ++n) {
        const int t = tok[n];
        float* xr = p.xb + (size_t)t * D;
        float xv[16]; float ss = 0.f;
#pragma unroll
        for (int i = 0; i < 2; ++i) {
            const int cA = i * 512 + lane * 4, cB = cA + 256;
            float f[8];
#pragma unroll
            for (int j = 0; j < 8; ++j) f[j] = 0.f;
#pragma unroll
            for (int s = 0; s < TOPK + 1; ++s) {
                const f32x2 a = __builtin_amdgcn_cvt_pk_f32_fp8((int)qa[n][i][s], false), bq = __builtin_amdgcn_cvt_pk_f32_fp8((int)qa[n][i][s], true);
                const f32x2 c = __builtin_amdgcn_cvt_pk_f32_fp8((int)qb[n][i][s], false), d = __builtin_amdgcn_cvt_pk_f32_fp8((int)qb[n][i][s], true);
                f[0] += a[0]; f[1] += a[1]; f[2] += bq[0]; f[3] += bq[1]; f[4] += c[0]; f[5] += c[1]; f[6] += d[0]; f[7] += d[1];
            }
            const f32x4 g0 = gtv[i][0], g1 = gtv[i][1];
#pragma unroll
            for (int j = 0; j < 4; ++j) { xv[i * 8 + j] = x0[n][i][j] + g0[j] * f[j] * (1.f / SLAB_SC); xv[i * 8 + 4 + j] = x1[n][i][j] + g1[j] * f[4 + j] * (1.f / SLAB_SC); }
#pragma unroll
            for (int j = 0; j < 8; ++j) ss += xv[i * 8 + j] * xv[i * 8 + j];
        }
        ss = wave_sum(ss);
        const float rs = rsqrtf(ss * (1.f / D) + 1e-6f);
        if (l + 1 < NL) {
#pragma unroll
            for (int i = 0; i < 2; ++i) {
                const int cA = i * 512 + lane * 4, cB = cA + 256;
                *(f32x4*)(xr + cA) = (f32x4){xv[i * 8], xv[i * 8 + 1], xv[i * 8 + 2], xv[i * 8 + 3]};
                *(f32x4*)(xr + cB) = (f32x4){xv[i * 8 + 4], xv[i * 8 + 5], xv[i * 8 + 6], xv[i * 8 + 7]};
                const f32x4 s0 = mdv[i][0], s1 = mdv[i][1], c0 = mdv[i][2], c1 = mdv[i][3];
                float o[8];
#pragma unroll
                for (int j = 0; j < 4; ++j) { o[j] = xv[i * 8 + j] * rs * (1.f + c0[j]) + s0[j]; o[4 + j] = xv[i * 8 + 4 + j] * rs * (1.f + c1[j]) + s1[j]; }
                *(u32x2*)(p.h + (size_t)t * D + cA) = (u32x2){pk2(o[0], o[1]), pk2(o[2], o[3])};
                *(u32x2*)(p.h + (size_t)t * D + cB) = (u32x2){pk2(o[4], o[5]), pk2(o[6], o[7])};
            }
        } else {
#pragma unroll
            for (int i = 0; i < 2; ++i) {
                const int cA = i * 512 + lane * 4, cB = cA + 256;
                const f32x4 g0 = mdv[i][0], g1 = mdv[i][1];
                *(f32x4*)(p.out + (size_t)t * D + cA) = (f32x4){xv[i * 8] * rs * g0[0], xv[i * 8 + 1] * rs * g0[1], xv[i * 8 + 2] * rs * g0[2], xv[i * 8 + 3] * rs * g0[3]};
                *(f32x4*)(p.out + (size_t)t * D + cB) = (f32x4){xv[i * 8 + 4] * rs * g1[0], xv[i * 8 + 5] * rs * g1[1], xv[i * 8 + 6] * rs * g1[2], xv[i * 8 + 7] * rs * g1[3]};
            }
        }
    }
}

#define XB_TMO      128
#define XB_XCNT(j)  (256  + 64 * (j))
#define XB_XSUB(j)  (1280 + 64 * (j))
#define XB_XGEN(j)  (2304 + 64 * (j))
#define XB_TOP      3328
#define XB_TOPGEN   3392
#define XCD_BAR_WORDS 3456
#define XB_SPIN_CAP (1u << 22)
__device__ __forceinline__ unsigned xb_ld(unsigned* p)              { return __hip_atomic_load(p, __ATOMIC_RELAXED, __HIP_MEMORY_SCOPE_AGENT); }
__device__ __forceinline__ unsigned xb_add(unsigned* p, unsigned v) { return __hip_atomic_fetch_add(p, v, __ATOMIC_RELAXED, __HIP_MEMORY_SCOPE_AGENT); }
__device__ __forceinline__ unsigned xb_xcc_id() { return (unsigned)__builtin_amdgcn_s_getreg((3 << 11) | 20) & 0xFu; }
#define XB_SPIN(cond, bar) do { unsigned _sp = 0; while (cond) { __builtin_amdgcn_s_sleep(1); \
    if ((++_sp & 255u) == 0u) { if (xb_ld(&(bar)[XB_TMO])) break; if (_sp > XB_SPIN_CAP) { atomicAdd(&(bar)[XB_TMO], 1u); break; } } } } while (0)
struct XcdBarrier { unsigned* bar; unsigned x; volatile LAS unsigned* st; };
__device__ __forceinline__ XcdBarrier xcd_barrier_post(unsigned* bar, volatile LAS unsigned* st) {
    XcdBarrier b; b.bar = bar; b.x = xb_xcc_id(); b.st = st;
    if (threadIdx.x == 0) (void)xb_add(&bar[XB_XCNT(b.x)], 1u);
    return b;
}
__device__ __forceinline__ void xcd_barrier_complete(unsigned* bar, unsigned x, unsigned& nloc, unsigned& nx) {
    const unsigned G = gridDim.x * gridDim.y * gridDim.z;
    unsigned sum, cnt, mine, sp = 0u;
    for (;;) {
        sum = 0u; cnt = 0u; mine = 0u;
#pragma unroll
        for (unsigned j = 0; j < 16; ++j) { const unsigned c = xb_ld(&bar[XB_XCNT(j)]); sum += c; cnt += (c > 0u) ? 1u : 0u; mine = (j == x) ? c : mine; }
        if (sum == G) break;
        __builtin_amdgcn_s_sleep(1);
        if ((++sp & 255u) == 0u) { if (xb_ld(&bar[XB_TMO])) break; if (sp > XB_SPIN_CAP) { atomicAdd(&bar[XB_TMO], 1u); break; } }
    }
    nloc = mine > 0u ? mine : 1u; nx = cnt > 0u ? cnt : 1u;
}
__device__ __forceinline__ void xcd_barrier(const XcdBarrier& b0) {
    XcdBarrier b = b0; { unsigned xx = b0.x; asm volatile("" : "+s"(xx)); b.x = xx; }
    asm volatile("s_waitcnt vmcnt(0)" ::: "memory");
    __syncthreads();
    if (threadIdx.x == 0) {
        unsigned* bar = b.bar;
        __builtin_amdgcn_s_waitcnt(0);
        unsigned nloc = b.st[0], nx = b.st[1];
        if (nloc == 0u) { xcd_barrier_complete(bar, b.x, nloc, nx); b.st[0] = nloc; b.st[1] = nx; }
        const unsigned old = xb_add(&bar[XB_XSUB(b.x)], 1u);
        const unsigned gen = old / nloc;
        if (old + 1u == (gen + 1u) * nloc) {
            __builtin_amdgcn_fence(__ATOMIC_RELEASE, "agent");
            asm volatile("s_waitcnt vmcnt(0)" ::: "memory");
            const unsigned og = xb_add(&bar[XB_TOP], 1u);
            const unsigned tg = og / nx;
            if (og + 1u == (tg + 1u) * nx) xb_add(&bar[XB_TOPGEN], 1u);
            else XB_SPIN(xb_ld(&bar[XB_TOPGEN]) == tg, bar);
            __builtin_amdgcn_fence(__ATOMIC_ACQUIRE, "agent");
            xb_add(&bar[XB_XGEN(b.x)], 1u);
            asm volatile("s_waitcnt vmcnt(0)" ::: "memory");
        } else {
            XB_SPIN(xb_ld(&bar[XB_XGEN(b.x)]) == gen, bar);
            __builtin_amdgcn_fence(__ATOMIC_ACQUIRE, "agent");
            asm volatile("s_waitcnt vmcnt(0)" ::: "memory");
        }
    }
    __syncthreads();
}

__device__ __forceinline__ P load_args() {
    P q{};
#if defined(__HIP_DEVICE_COMPILE__)
    const __attribute__((address_space(4))) unsigned long long* k = (const __attribute__((address_space(4))) unsigned long long*)__builtin_amdgcn_kernarg_segment_ptr();
    asm volatile("" : "+s"(k));
    typedef __attribute__((address_space(1))) char gchar_t;
#pragma unroll
    for (unsigned i = 0; i < sizeof(P) / 8; ++i) { char* g = (char*)(gchar_t*)k[i]; __builtin_memcpy((char*)&q + 8 * i, &g, 8); }
#endif
    return q;
}
enum Ph { PH_NORM1 = 0, PH_INPROJ, PH_PREP, PH_MIX, PH_RWOUT, PH_OUTPROJ, PH_ROUTER, PH_COMPACT, PH_EXP1, PH_EXP2, PH_COMBINE, PH_PER_LAYER };

__global__ void __launch_bounds__(NTHREADS, 2) k_fused(P p_arg) {
    (void)p_arg;
#define KARGS() load_args()
    extern __shared__ __attribute__((aligned(16))) unsigned char lds_raw[];
    LAS unsigned char* lds = (LAS unsigned char*)lds_raw;
    LAS int* tstart = (LAS int*)(lds + LDS_STAGE);
    LAS int* cnts = (LAS int*)(lds + LDS_STAGE + 272);
    LAS int* tmap = (LAS int*)(lds + LDS_STAGE + 2048);
    volatile LAS unsigned* bst = (volatile LAS unsigned*)(lds + LDS_STAGE + 1008);
    if (threadIdx.x < 4) bst[threadIdx.x] = 0u;
    __syncthreads();
    XcdBarrier xb = xcd_barrier_post(load_args().bar, bst);
#define PHASE_COORDS() int G = gridDim.x, bx = blockIdx.x; asm volatile("" : "+s"(G), "+s"(bx)); const int vcu = (G % 8 == 0) ? (bx % 8) * (G / 8) + bx / 8 : bx; (void)vcu; \
    const int tid = opaque(threadIdx.x), half = tid >> 8, lane = tid & 63, wave = __builtin_amdgcn_readfirstlane(tid >> 6); \
    float* smem = (float*)lds_raw + half * 8192; LAS float* scr = (LAS float*)(lds + wave * 16384); (void)lane; (void)smem; (void)scr; (void)tid

    for (int rep = 0; rep < (REP_PH == -1 ? REP_N : 1); ++rep) {
        const P p = KARGS();
        PHASE_COORDS();
        for (int it = bx; it < NL * 96; it += G) st_mod(p, it, (LAS float*)lds);
        __syncthreads();
        for (int it = (bx * 8 + wave); it < CV_DENSE; it += G * 8) cvt_dense_item(p, it, scr, lane);
        for (int idx = bx * NTHREADS + tid; idx < NL * RWW * 160; idx += G * NTHREADS) {
            const int k = idx % 160, c = (idx / 160) % RWW, ly = idx / (160 * RWW);
            float v;
            if (k < 32) v = p.rw_w2[((size_t)ly * 32 + k) * RWW + c];
            else if (k < 64) v = p.rw_a2[((size_t)ly * 32 + (k - 32)) * RWW + c];
            else if (k < 128) v = p.rw_g2[((size_t)ly * 64 + (k - 64)) * RWW + c];
            else v = (ly == 1) ? p.rw_v2[(size_t)(k - 128) * RWW + c] : 0.f;
            p.lwt[idx] = (bf16_t)f2bf(v);
        }
        xcd_barrier(xb);
    }

    constexpr int NPH2 = NL * PH_PER_LAYER + ((REP_PH >= 0) ? REP_N - 1 : 0);
    for (int ph2 = 0; ph2 < NPH2; ++ph2) {
      {
        const int ph = (REP_PH < 0 || ph2 <= REP_PH) ? ph2 : (ph2 < REP_PH + REP_N ? REP_PH : ph2 - (REP_N - 1));
        const int rep = (REP_PH >= 0 && ph2 > REP_PH && ph2 < REP_PH + REP_N) ? 1 : 0; (void)rep;
        const int l = ph / PH_PER_LAYER, st = ph % PH_PER_LAYER;
        const P p = KARGS();
        PHASE_COORDS();
        if (st == PH_NORM1) {
            if (l == 0) {
                for (int t = bx * 8 + wave; t < T; t += G * 8) {
                    const int tn = t + G * 8; unsigned pfv = 0u;
                    if (tn < T) pfv = pf_lines(p.x + (size_t)tn * D, D * 4, lane);
                    norm_row<false>(p.x + (size_t)t * D, p.mod + (size_t)(t / SEQ) * 6144, p.h + (size_t)t * D, (LAS float*)lds, lane);
                    pf_done(pfv);
                }
            }
        } else if (st == PH_INPROJ) {
            pg8::DenseOrder S; S.init(p.h, p.wt_in + (size_t)l * PJB * D, T, PJB, D, G, bx);
            pg8::EpiProj E{p.proj, p.vt};
            pg8::gemm_phase<pg8::EpiProj, pg8::DenseOrder, true, true>(lds, D, S, E);
        } else if (st == PH_PREP) {
            st_prep(p, l, bx, G, lds, (rep == 0) ? 15 : REP_SEL);
        } else if (st == PH_MIX) {
            constexpr int N1 = NBATCH * 6, N2 = NBATCH * 6 * (SEQ / 32) / 8, N3 = T / 32;
            const int sel = (rep == 0) ? 15 : REP_SEL;
            if (sel & 1) for (int wb = bx; wb < N1; wb += G) st_cscan(p, wb, lds);
            __syncthreads();
            {
                unsigned* ctrA = p.bar + 3500 + ph2; unsigned* ctrB = p.bar + 3600 + l;
                volatile LAS int* gslot = (volatile LAS int*)(lds + LDS_STAGE + 640);
                for (;;) {
                    __syncthreads();
                    if (tid == 0) *gslot = (int)__hip_atomic_fetch_add(ctrA, 2u, __ATOMIC_RELAXED, __HIP_MEMORY_SCOPE_AGENT);
                    __syncthreads();
                    const int base = *gslot;
                    if (base >= N2 + N3) break;
                    static_assert(N2 % 2 == 0 && N3 % 2 == 0, "a grab of two units is either two attention units or one pool pair");
                    if (base < N2) {
                        for (int wb = base; wb < base + 2; ++wb) if (sel & 2) st_attn(p, l, (wb % N1) * (SEQ / 32) + (SEQ / 256 - 1 - wb / N1) * 8 + wave, lds + wave * 9728);
                    } else if (sel & 4) st_pool(p, l, base - N2, lds);
                }
                const int cv0 = (G > NE) ? CV_EXP : min(CV_EXP, 2 * G * (CV_QUOTA1 + CV_QUOTA2) + CV_ROUTER);
                if (G > NE && bx >= N1 && (sel & 8)) {
                    const int mc0 = min(CV_EXP, min(CV_EXP, 2 * G * (CV_QUOTA1 + CV_QUOTA2)) + CV_ROUTER) + (bx - N1) * 8 + wave;
                    cvt_exp_stream(p, l, mc0, CV_EXP, CV_EXP, lane);
                }
                if (cv0 < CV_EXP) for (;;) {
                    __syncthreads();
                    if (tid == 0) *gslot = cv0 + (int)__hip_atomic_fetch_add(ctrB, 32u, __ATOMIC_RELAXED, __HIP_MEMORY_SCOPE_AGENT);
                    __syncthreads();
                    const int base = *gslot;
                    if (base >= CV_EXP) break;
                    if (sel & 8) cvt_exp_stream(p, l, base + wave, 8, min(base + 32, CV_EXP), lane);
                }
            }
        } else if (st == PH_RWOUT) {
            for (int t = (bx * 8 + wave) * 4; t < T; t += G * 32) { const int tk[4] = {t, t + 1, t + 2, t + 3}; st_rwout<4>(p, l, tk, lane); }
        } else if (st == PH_OUTPROJ) {
            pg8::DenseOrder S; S.init(p.h, p.wt_out + (size_t)l * D * D, T, D, D, G, bx);
            pg8::EpiOut E{l == 0 ? p.x : p.xb, p.xb, p.mod + (size_t)l * 8 * 6144 + 2048};
            pg8::gemm_phase<pg8::EpiOut, pg8::DenseOrder, true, true>(lds, D, S, E);
        } else if (st == PH_ROUTER) {
            st_normrouter(p, l, bx, G, min(CV_EXP, 2 * G * (CV_QUOTA1 + CV_QUOTA2)), (rep == 0) ? 1 : (REP_SEL & 1), (LAS float*)lds);
        } else if (st == PH_COMPACT) {
            if (bx < NE) st_compact(p, bx, (LAS int*)lds);
            else {
                const int cc0 = min(CV_EXP, min(CV_EXP, 2 * G * (CV_QUOTA1 + CV_QUOTA2)) + CV_ROUTER + (G > NBATCH * 6 ? (G - NBATCH * 6) * 8 : 0));
                cvt_exp_stream(p, l, cc0 + (bx - NE) * 8 + wave, (G - NE) * 8, CV_EXP, lane);
            }
        } else if (st == PH_EXP1 || st == PH_EXP2) {
            __syncthreads();
            if (tid < 64) {
                const int c = p.cnt[tid], ntl = (c + 255) >> 8;
                int incl = ntl;
#pragma unroll
                for (int o = 1; o < 64; o <<= 1) { const int v = __builtin_amdgcn_ds_bpermute(((tid - o) & 63) << 2, incl); if (tid >= o) incl += v; }
                const int excl = incl - ntl;
                cnts[tid] = c; tstart[tid] = excl;
                for (int r = 0; r < ntl; ++r) tmap[excl + r] = tid;
                if (tid == 63) { cnts[64] = T; tstart[64] = incl; tstart[65] = incl + T / 256; for (int r = 0; r < T / 256; ++r) tmap[incl + r] = 64; }
            }
            __syncthreads();
            if (st == PH_EXP1) {
                pg8::MoeOrder<true> S{tstart, cnts, tmap, p.list, p.h, p.wt1, D, 512, 1, G, vcu};
                pg8::EpiExp1 E{p.hm};
                pg8::gemm_phase<pg8::EpiExp1, pg8::MoeOrder<true>, true, true>(lds, D, S, E);
            } else {
                pg8::MoeOrder<false> S{tstart, cnts, tmap, p.list, p.hm, p.wt2, ED, D, 2, G, vcu};
                pg8::EpiExp2 E{p.slab, p.list, cnts};
                pg8::gemm_phase<pg8::EpiExp2, pg8::MoeOrder<false>, true, true>(lds, ED, S, E);
            }
        } else {
            for (int t = (bx * 8 + wave) * 2; t < T; t += G * 16) { const int tk[2] = {t, t + 1}; st_combine<2>(p, l, tk, lane); }
        }
        if (!(ph2 == NPH2 - 1)) { if (!(st == PH_NORM1 && l > 0)) xcd_barrier(xb); }
      }
    }
#undef PHASE_COORDS
#undef KARGS
}

}

extern "C" void kernel_launch(void* const* d_in, const int* in_sizes, int n_in, void* d_out, int out_size, void* d_ws, size_t ws_size,
                              hipStream_t stream) {
    P p{};
    const float** fp = (const float**)&p;
    for (int i = 0; i < 33; ++i) fp[i] = (const float*)d_in[i];
    p.out = (float*)d_out;
    char* ws = (char*)d_ws;
    size_t off = 0;
    auto take = [&](size_t bytes) { char* r = ws + off; off += (bytes + 255) & ~(size_t)255; return r; };
    p.bar = (unsigned*)take(16384);
    p.cnt = (int*)take(256);
    p.mod = (float*)take((size_t)NL * 8 * 6144 * 4);
    p.list = (int2*)take((size_t)NE * T * 8);
    p.cnt2 = (int*)take((size_t)NE * 1024 * 4);
    p.seg = (int*)take((size_t)NE * 1024 * 16 * 4);
    p.topw = (float*)take((size_t)T * TOPK * 4);
    p.wt_in = (bf16_t*)take((size_t)NL * PJB * D * 2);
    p.wt_out = (bf16_t*)take((size_t)NL * D * D * 2);
    p.lwt = (bf16_t*)take((size_t)NL * RWW * 160 * 2);
    p.wt1 = (bf16_t*)take((size_t)65 * 512 * D * 2);
    p.wt2 = (bf16_t*)take((size_t)65 * D * ED * 2);
    p.xb = (float*)take((size_t)T * D * 4);
    p.h = (bf16_t*)take((size_t)T * D * 2);
    p.vfirst = (bf16_t*)take((size_t)T * RWW * 2);
    const size_t ov = off;
    p.proj = (bf16_t*)take((size_t)T * PJB * 2);
    p.vt = (bf16_t*)take((size_t)T * SBW * 2);
    p.rec = (unsigned char*)take((size_t)T * REC_TB);
    p.g = (bf16_t*)take((size_t)T * RWW * 2);
    p.y = (bf16_t*)take((size_t)T * RWW * 2);
    p.cb = (unsigned char*)take((size_t)NBATCH * 6 * (SEQ / 32) * CB_BYTES);
    p.hm = (bf16_t*)(ws + ov);
    p.slab = (unsigned char*)(ws + ov + (size_t)MAXRT * 256 * ED * 2);
    const size_t end_moe = ov + (size_t)MAXRT * 256 * ED * 2 + (size_t)T * (TOPK + 1) * D;
    if (end_moe > off) off = end_moe;
    if (off > ws_size) { fprintf(stderr, "kernel_launch: workspace too small: need %zu, have %zu\n", off, ws_size); return; }

    static int cus = 0;
    if (cus == 0) {
        int dev = 0, n = 0;
        if (hipGetDevice(&dev) != hipSuccess || hipDeviceGetAttribute(&n, hipDeviceAttributeMultiprocessorCount, dev) != hipSuccess || n <= 0) n = 256;
        (void)hipFuncSetAttribute((const void*)k_fused, hipFuncAttributeMaxDynamicSharedMemorySize, LDS_BYTES);
        cus = n;
    }
    (void)hipMemsetAsync(p.bar, 0, 16384 + 256, stream);
    void* args[] = {(void*)&p};
    (void)hipLaunchCooperativeKernel((const void*)k_fused, dim3(cus), dim3(NTHREADS), args, LDS_BYTES, stream);
}
```
